# Optimizing an MI355X kernel written in HIP

```python
import math
import jax
import jax.numpy as jnp
from jax import lax
import numpy as np

D_MODEL = 1024
BATCH = 4
SEQ = 4096
DEPTH = 2

CTX_LEN = 256
GRID_W = 64
D_MIX = 2 * D_MODEL
W_BR = D_MIX // 4
NORM_EPS = 1e-6

HY_ORDER = 2
HY_EMB = 33
HY_BANDS = (HY_EMB - 1) // 2
HY_HID = 64
HY_SHORT = 3
HY_TARGET = 1e-2
HY_MIN_DECAY = math.log(HY_TARGET) / 1.5
HY_MAX_DECAY = math.log(HY_TARGET) / 0.3
HY_EPS = 1e-6

RG_HEADS = 8
RG_HD = W_BR // RG_HEADS
RG_C = 8.0
RG_CONV = 4

HG_DK = 128
HG_HEADS = W_BR // HG_DK
HG_CHUNK = 64

M2_HD = 64
M2_HEADS = W_BR // M2_HD
M2_GROUPS = 2
M2_STATE = 128
M2_CONV = 4
M2_CHUNK = 64
M2_XBC = W_BR + 2 * M2_GROUPS * M2_STATE

PIECES = (3 * W_BR, W_BR, W_BR, W_BR, W_BR, W_BR, W_BR, W_BR, W_BR, M2_XBC, M2_HEADS, W_BR)
IN_COLS = sum(PIECES)
SPLIT_IDX = tuple(int(v) for v in np.cumsum(PIECES)[:-1])

kernel_name = 'hybrid_hyena_rglru_hgrn2_ssd_prefix'


def rmsnorm(x, w):
    xf = x.astype(jnp.float32)
    y = xf * lax.rsqrt(jnp.mean(xf * xf, axis=-1, keepdims=True) + NORM_EPS)
    return (y * w.astype(jnp.float32)).astype(x.dtype)


def dwconv(x, w, b, pad_lo, pad_hi):
    y = lax.conv_general_dilated(x, w.astype(x.dtype)[:, None, :], window_strides=(1,),
                                 padding=[(pad_lo, pad_hi)],
                                 dimension_numbers=('NWC', 'WIO', 'NWC'),
                                 feature_group_count=x.shape[-1])
    return y + b.astype(x.dtype)


def to_colmajor(a, rows):
    b, n, ch = a.shape
    return a.reshape(b, rows, GRID_W, ch).transpose(0, 2, 1, 3).reshape(b, n, ch)


def from_colmajor(a, rows):
    b, n, ch = a.shape
    return a.reshape(b, GRID_W, rows, ch).transpose(0, 2, 1, 3).reshape(b, n, ch)


def bidir(dir_fn, ctx_fwd, lat_fwd, ctx_bwd, lat_bwd, state0, p_fwd, p_bwd):
    rev = lambda t: tuple(jnp.flip(a, 1) for a in t)
    yc_f, s_f = dir_fn(*ctx_fwd, state0, *p_fwd)
    yl_f, _ = dir_fn(*lat_fwd, s_f, *p_fwd)
    yc_b, s_b = dir_fn(*rev(ctx_bwd), state0, *p_bwd)
    yl_b, _ = dir_fn(*rev(lat_bwd), s_b, *p_bwd)
    return yc_f + jnp.flip(yc_b, 1), yl_f + jnp.flip(yl_b, 1)


def hyena_filters(n, w1, b1, w2, b2, w3, freq):
    f32 = jnp.float32
    t = jnp.linspace(0.0, 1.0, n, dtype=f32)[:, None]
    bands = jnp.linspace(1e-4, HY_BANDS - 1, HY_BANDS, dtype=f32)[None]
    ang = (2.0 * math.pi / n) * jnp.arange(n, dtype=f32)[:, None] * bands
    z = jnp.concatenate([t, jnp.cos(ang), -jnp.sin(ang)], axis=-1)
    fr = freq.astype(f32)
    h = jnp.sin(fr * (z @ w1.astype(f32) + b1.astype(f32)))
    h = jnp.sin(fr * (h @ w2.astype(f32) + b2.astype(f32)))
    h = (h @ w3.astype(f32)).reshape(n, HY_ORDER, 2, W_BR)
    deltas = jnp.abs(jnp.linspace(HY_MIN_DECAY, HY_MAX_DECAY, W_BR, dtype=f32))
    return h * jnp.exp(-t[:, :, None, None] * deltas)


def two_sided_kernel(h_fwd, h_bwd):
    k = jnp.concatenate([h_fwd, jnp.zeros_like(h_fwd[:1]), jnp.flip(h_bwd[1:], 0)], axis=0)
    return k / (jnp.sum(jnp.abs(k), axis=0, keepdims=True) + HY_EPS)


def fft_conv(u, k):
    n = u.shape[1]
    y = jnp.fft.irfft(jnp.fft.rfft(u, n=2 * n, axis=1) * jnp.fft.rfft(k, axis=0), n=2 * n, axis=1)
    return y[:, :n]


def hyena_mix(u, conv_w, conv_b, w1, b1, w2, b2, w3, freq, skip):
    n = u.shape[1]
    u = dwconv(u, conv_w, conv_b, HY_SHORT // 2, HY_SHORT // 2).astype(jnp.float32)
    v, x1, x2 = jnp.split(u, 3, axis=-1)
    h = hyena_filters(n, w1, b1, w2, b2, w3, freq)
    z = v
    for o, xg in enumerate((x1, x2)):
        k = two_sided_kernel(h[:, o, 0], h[:, o, 1])
        z = xg * (fft_conv(z, k) + skip[o].astype(jnp.float32) * z)
    return z


def _lin_combine(e1, e2):
    a1, b1 = e1
    a2, b2 = e2
    return a1 * a2, a2 * b1 + b2


def rglru_dir(x, h0, conv_w, conv_b, wa, ba, wx, bx, lam):
    f32 = jnp.float32
    bn, n, _ = x.shape
    xc = dwconv(x, conv_w, conv_b, RG_CONV - 1, 0).astype(f32)
    xh = xc.reshape(bn, n, RG_HEADS, RG_HD)
    r = jax.nn.sigmoid(jnp.einsum('blhi,hij->blhj', xh, wa.astype(f32)).reshape(bn, n, W_BR) + ba.astype(f32))
    gi = jax.nn.sigmoid(jnp.einsum('blhi,hij->blhj', xh, wx.astype(f32)).reshape(bn, n, W_BR) + bx.astype(f32))
    log_a = -RG_C * r * jax.nn.softplus(-lam.astype(f32))
    a = jnp.exp(log_a)
    b = jnp.sqrt(-jnp.expm1(2.0 * log_a)) * (gi * xc)
    a_cum, h = lax.associative_scan(_lin_combine, (a, b), axis=1)
    h = h + a_cum * h0[:, None]
    return h, h[:, -1]


def gla_chunked(q, k, v, log_f, s0):
    bn, n, nh, _ = q.shape
    dv = v.shape[-1]
    nc = n // HG_CHUNK
    to_chunks = lambda a: a.reshape(bn, nc, HG_CHUNK, nh, a.shape[-1]).transpose(1, 0, 3, 2, 4)
    mask = jnp.tril(jnp.ones((HG_CHUNK, HG_CHUNK), dtype=bool))[:, :, None]

    def step(s, inp):
        qc, kc, vc, lf = inp
        g = jnp.cumsum(lf, axis=2)
        o_inter = jnp.einsum('bhtd,bhde->bhte', qc * jnp.exp(g), s)
        diff = g[:, :, :, None, :] - g[:, :, None, :, :]
        decay = jnp.exp(jnp.where(mask, diff, -jnp.inf))
        att = jnp.einsum('bhtd,bhsd,bhtsd->bhts', qc, kc, decay)
        o = o_inter + jnp.einsum('bhts,bhse->bhte', att, vc)
        g_last = g[:, :, -1]
        s = jnp.exp(g_last)[..., None] * s + jnp.einsum('bhsd,bhse->bhde', kc * jnp.exp(g_last[:, :, None] - g), vc)
        return s, o

    s_last, o = lax.scan(step, s0, (to_chunks(q), to_chunks(k), to_chunks(v), to_chunks(log_f)))
    return o.transpose(1, 0, 3, 2, 4).reshape(bn, n, nh, dv), s_last


def hgrn2_dir(q, f_logit, v, s0, lb):
    f32 = jnp.float32
    bn, n, _ = q.shape
    lb = lb.astype(f32)
    z = f_logit.astype(f32)
    f = lb + (1.0 - lb) * jax.nn.sigmoid(z)
    k = (1.0 - lb) * jax.nn.sigmoid(-z)
    heads = lambda a: a.reshape(bn, n, HG_HEADS, HG_DK)
    return gla_chunked(heads(q.astype(f32) * HG_DK ** -0.5), heads(k), heads(v.astype(f32)),
                       heads(jnp.log(f)), s0)


def segsum(a):
    cs = jnp.cumsum(a, axis=-1)
    t = a.shape[-1]
    mask = jnp.tril(jnp.ones((t, t), dtype=bool))
    return jnp.where(mask, cs[..., :, None] - cs[..., None, :], -jnp.inf)


def ssd_chunked(xdt, adt, bm, cm, h0):
    bn, n, nh, hp = xdt.shape
    nc = n // M2_CHUNK
    X = xdt.reshape(bn, nc, M2_CHUNK, nh, hp)
    Bc = bm.reshape(bn, nc, M2_CHUNK, nh, M2_STATE)
    Cc = cm.reshape(bn, nc, M2_CHUNK, nh, M2_STATE)
    A = adt.reshape(bn, nc, M2_CHUNK, nh).transpose(0, 3, 1, 2)
    A_cum = jnp.cumsum(A, axis=-1)
    y_diag = jnp.einsum('bclhn,bcshn,bhcls,bcshp->bclhp', Cc, Bc, jnp.exp(segsum(A)), X)
    decay_states = jnp.exp(A_cum[..., -1:] - A_cum)
    states = jnp.einsum('bclhn,bhcl,bclhp->bchpn', Bc, decay_states, X)
    states = jnp.concatenate([h0[:, None], states], axis=1)
    chunk_decay = jnp.exp(segsum(jnp.pad(A_cum[..., -1], ((0, 0), (0, 0), (1, 0)))))
    states = jnp.einsum('bhzc,bchpn->bzhpn', chunk_decay, states)
    y_off = jnp.einsum('bclhn,bchpn,bhcl->bclhp', Cc, states[:, :-1], jnp.exp(A_cum))
    return (y_diag + y_off).reshape(bn, n, nh, hp), states[:, -1]


def ssd_dir(xbc, dt_raw, h0, conv_w, conv_b, dt_bias, a_log, d_skip):
    f32 = jnp.float32
    bn, n, _ = xbc.shape
    xbc = jax.nn.silu(dwconv(xbc, conv_w, conv_b, M2_CONV - 1, 0).astype(f32))
    xs, bm, cm = jnp.split(xbc, [W_BR, W_BR + M2_GROUPS * M2_STATE], axis=-1)
    xs = xs.reshape(bn, n, M2_HEADS, M2_HD)
    rep = M2_HEADS // M2_GROUPS
    bm = jnp.repeat(bm.reshape(bn, n, M2_GROUPS, M2_STATE), rep, axis=2)
    cm = jnp.repeat(cm.reshape(bn, n, M2_GROUPS, M2_STATE), rep, axis=2)
    dt = jax.nn.softplus(dt_raw.astype(f32) + dt_bias.astype(f32))
    a = -jnp.exp(a_log.astype(f32))
    y, h_last = ssd_chunked(xs * dt[..., None], dt * a, bm, cm, h0)
    return y + d_skip.astype(f32)[:, None] * xs, h_last


def head_rmsnorm(o, w):
    o = o * lax.rsqrt(jnp.mean(o * o, axis=-1, keepdims=True) + NORM_EPS)
    return o.reshape(o.shape[0], o.shape[1], -1) * w.astype(jnp.float32)


def merge_branches(u, y_hy, y_rg, y_hg, y_m2, hg_norm_w, m2_norm_w, w_out):
    f32 = jnp.float32
    bn, n = u[0].shape[:2]
    gate = lambda g: jax.nn.silu(g.astype(f32))
    b_hy = y_hy * gate(u[1])
    b_rg = y_rg * gate(u[3])
    b_hg = head_rmsnorm(y_hg, hg_norm_w) * gate(u[8])
    m2 = (y_m2.reshape(bn, n, W_BR) * gate(u[11])).reshape(bn, n, M2_GROUPS, W_BR // M2_GROUPS)
    b_m2 = (m2 * lax.rsqrt(jnp.mean(m2 * m2, axis=-1, keepdims=True) + NORM_EPS)).reshape(bn, n, W_BR) * m2_norm_w.astype(f32)
    y = jnp.concatenate([b_hy, b_rg, b_hg, b_m2], axis=-1).astype(u[0].dtype)
    return y @ w_out


def setup_inputs(seed: int = 0) -> dict:
    key = jax.random.key(seed)
    ks = iter(jax.random.split(key, 48))
    f32 = jnp.float32
    nrm = lambda shape, scale: scale * jax.random.normal(next(ks), shape, f32)
    D, W, X, L = D_MODEL, W_BR, M2_XBC, DEPTH
    ac = jax.random.uniform(next(ks), (L, 2, W), f32, 0.9, 0.999)
    a = ac ** (1.0 / RG_C)
    rg_lam = jnp.log(a) - jnp.log1p(-a)
    dt = jnp.exp(jax.random.uniform(next(ks), (L, 2, M2_HEADS), f32, math.log(1e-3), math.log(1e-1)))
    m2_dt_bias = dt + jnp.log(-jnp.expm1(-dt))
    m2_a_log = jnp.log(jax.random.uniform(next(ks), (L, 2, M2_HEADS), f32, 1.0, 16.0))
    return {
        'x': nrm((BATCH, SEQ, D), 1.0),
        'c': nrm((BATCH, D), 1.0),
        'ctx': nrm((BATCH, CTX_LEN, D), 1.0),
        'c_ctx': nrm((D,), 1.0),
        'w_mod': nrm((L, D, 3 * D), 0.5 * D ** -0.5),
        'b_mod': nrm((L, 3 * D), 0.02),
        'norm_w': 1.0 + nrm((L, D), 0.02),
        'w_in': nrm((L, D, IN_COLS), D ** -0.5),
        'w_out': nrm((L, D_MIX, D), D_MIX ** -0.5),
        'hy_conv_w': nrm((L, HY_SHORT, 3 * W), HY_SHORT ** -0.5),
        'hy_conv_b': nrm((L, 3 * W), 0.02),
        'hy_w1': nrm((L, HY_EMB, HY_HID), HY_EMB ** -0.5),
        'hy_b1': nrm((L, HY_HID), 0.1),
        'hy_w2': nrm((L, HY_HID, HY_HID), HY_HID ** -0.5),
        'hy_b2': nrm((L, HY_HID), 0.1),
        'hy_w3': nrm((L, HY_HID, HY_ORDER * 2 * W), HY_HID ** -0.5),
        'hy_freq': 1.0 + nrm((L, HY_HID), 0.1),
        'hy_skip': nrm((L, HY_ORDER, W), 1.0),
        'rg_conv_w': nrm((L, 2, RG_CONV, W), RG_CONV ** -0.5),
        'rg_conv_b': nrm((L, 2, W), 0.02),
        'rg_wa': nrm((L, 2, RG_HEADS, RG_HD, RG_HD), RG_HD ** -0.5),
        'rg_ba': nrm((L, 2, W), 0.1),
        'rg_wx': nrm((L, 2, RG_HEADS, RG_HD, RG_HD), RG_HD ** -0.5),
        'rg_bx': nrm((L, 2, W), 0.1),
        'rg_lam': rg_lam,
        'hg_lb': nrm((L, 2, W), 1.0),
        'hg_norm_w': 1.0 + nrm((L, W), 0.02),
        'm2_conv_w': nrm((L, 2, M2_CONV, X), M2_CONV ** -0.5),
        'm2_conv_b': nrm((L, 2, X), 0.02),
        'm2_dt_bias': m2_dt_bias,
        'm2_a_log': m2_a_log,
        'm2_d': 1.0 + nrm((L, 2, M2_HEADS), 0.1),
        'm2_norm_w': 1.0 + nrm((L, W), 0.02),
        'final_norm_w': 1.0 + nrm((D,), 0.02),
    }


def reference(x, c, ctx, c_ctx, w_mod, b_mod, norm_w, w_in, w_out,
              hy_conv_w, hy_conv_b, hy_w1, hy_b1, hy_w2, hy_b2, hy_w3, hy_freq, hy_skip,
              rg_conv_w, rg_conv_b, rg_wa, rg_ba, rg_wx, rg_bx, rg_lam,
              hg_lb, hg_norm_w,
              m2_conv_w, m2_conv_b, m2_dt_bias, m2_a_log, m2_d, m2_norm_w,
              final_norm_w):
    f32 = jnp.float32
    bsz, n_lat, _ = x.shape
    rows = n_lat // GRID_W
    lb_all = jnp.cumsum(jax.nn.softmax(hg_lb.astype(f32), axis=0), axis=0)
    lb_all = lb_all - lb_all[:1]
    cond_l = jax.nn.silu(c)
    cond_c = jax.nn.silu(c_ctx)
    rg0 = jnp.zeros((bsz, W_BR), f32)
    hg0 = jnp.zeros((bsz, HG_HEADS, HG_DK, HG_DK), f32)
    m20 = jnp.zeros((bsz, M2_HEADS, M2_HD, M2_STATE), f32)
    xl, xc = x, ctx
    for i in range(DEPTH):
        need_ctx = i < DEPTH - 1
        sh_l, sc_l, g_l = jnp.split(cond_l @ w_mod[i] + b_mod[i], 3, axis=-1)
        sh_c, sc_c, g_c = jnp.split(cond_c @ w_mod[i] + b_mod[i], 3, axis=-1)
        hl = rmsnorm(xl, norm_w[i]) * (1.0 + sc_l[:, None]) + sh_l[:, None]
        hc = rmsnorm(xc, norm_w[i]) * (1.0 + sc_c) + sh_c
        ul = jnp.split(hl @ w_in[i], SPLIT_IDX, axis=-1)
        uc = jnp.split(hc @ w_in[i], SPLIT_IDX, axis=-1)

        hy_p = (hy_conv_w[i], hy_conv_b[i], hy_w1[i], hy_b1[i], hy_w2[i], hy_b2[i], hy_w3[i], hy_freq[i], hy_skip[i])
        lat_hy = hyena_mix(ul[0], *hy_p)

        rg_f = (rg_conv_w[i, 0], rg_conv_b[i, 0], rg_wa[i, 0], rg_ba[i, 0], rg_wx[i, 0], rg_bx[i, 0], rg_lam[i, 0])
        rg_b = (rg_conv_w[i, 1], rg_conv_b[i, 1], rg_wa[i, 1], rg_ba[i, 1], rg_wx[i, 1], rg_bx[i, 1], rg_lam[i, 1])
        ctx_rg, lat_rg = bidir(rglru_dir, (uc[2],), (ul[2],), (uc[2],), (ul[2],), rg0, rg_f, rg_b)

        ctx_hg, lat_hg = bidir(hgrn2_dir, (uc[4], uc[5], uc[7]), (ul[4], ul[5], ul[7]),
                               (uc[4], uc[6], uc[7]), (ul[4], ul[6], ul[7]), hg0,
                               (lb_all[i, 0],), (lb_all[i, 1],))

        m2_f = (m2_conv_w[i, 0], m2_conv_b[i, 0], m2_dt_bias[i, 0], m2_a_log[i, 0], m2_d[i, 0])
        m2_b = (m2_conv_w[i, 1], m2_conv_b[i, 1], m2_dt_bias[i, 1], m2_a_log[i, 1], m2_d[i, 1])
        m2_ctx_in = (uc[9], uc[10])
        m2_lat_in = (to_colmajor(ul[9], rows), to_colmajor(ul[10], rows))
        ctx_m2, lat_m2 = bidir(ssd_dir, m2_ctx_in, m2_lat_in, m2_ctx_in, m2_lat_in, m20, m2_f, m2_b)
        lat_m2 = from_colmajor(lat_m2.reshape(bsz, n_lat, W_BR), rows)

        xl = xl + g_l[:, None] * merge_branches(ul, lat_hy, lat_rg, lat_hg, lat_m2,
                                                hg_norm_w[i], m2_norm_w[i], w_out[i])
        if need_ctx:
            ctx_hy = hyena_mix(uc[0], *hy_p)
            xc = xc + g_c * merge_branches(uc, ctx_hy, ctx_rg, ctx_hg, ctx_m2,
                                           hg_norm_w[i], m2_norm_w[i], w_out[i])
    return rmsnorm(xl, final_norm_w)
```

```cpp
#include <hip/hip_runtime.h>
#include <hip/hip_bf16.h>
#include <hip/hip_cooperative_groups.h>
#include <cstdio>
#include <cstdint>
namespace cg = cooperative_groups;

typedef unsigned short u16;
using bf16x8 = __attribute__((ext_vector_type(8))) short;
using f32x16 = __attribute__((ext_vector_type(16))) float;

#define NTOK 17408
#define NLAT 16384
#define UW 4096
#define EPS 1e-6f

#ifndef EN_HY
#define EN_HY 1
#endif
#ifndef EN_RG
#define EN_RG 1
#endif
#ifndef EN_HG
#define EN_HG 1
#endif
#ifndef EN_M2
#define EN_M2 1
#endif

struct P {
  const float *x, *c, *ctx, *c_ctx, *w_mod, *b_mod, *norm_w, *w_in, *w_out;
  const float *hy_conv_w, *hy_conv_b, *hy_w1, *hy_b1, *hy_w2, *hy_b2, *hy_w3, *hy_freq, *hy_skip;
  const float *rg_conv_w, *rg_conv_b, *rg_wa, *rg_ba, *rg_wx, *rg_bx, *rg_lam;
  const float *hg_lb, *hg_norm_w, *m2_conv_w, *m2_conv_b, *m2_dt_bias, *m2_a_log, *m2_d, *m2_norm_w, *final_norm_w;
  float* out;
  u16 *U, *HL, *Y2, *WT, *WoT, *KF, *KFC;
  float *XC, *DT, *MOD;
};

__device__ __forceinline__ u16 f2bf(float f) {
  uint32_t u = __float_as_uint(f);
  u += 0x7fffu + ((u >> 16) & 1u);
  return (u16)(u >> 16);
}
__device__ __forceinline__ float bf2f(u16 h) { return __uint_as_float(((uint32_t)h) << 16); }
__device__ __forceinline__ float bflo(uint32_t w) { return __uint_as_float(w << 16); }
__device__ __forceinline__ float bfhi(uint32_t w) { return __uint_as_float(w & 0xffff0000u); }
__device__ __forceinline__ uint32_t pack2(float a, float b) { return (uint32_t)f2bf(a) | ((uint32_t)f2bf(b) << 16); }
__device__ __forceinline__ float siluf(float x) { return x / (1.f + __expf(-x)); }
__device__ __forceinline__ float sigmf(float x) { return 1.f / (1.f + __expf(-x)); }
__device__ __forceinline__ float softplusf(float x) { return x > 20.f ? x : log1pf(__expf(x)); }

__device__ __forceinline__ void unpack8(const uint4& v, float* f) {
  f[0] = bflo(v.x); f[1] = bfhi(v.x); f[2] = bflo(v.y); f[3] = bfhi(v.y);
  f[4] = bflo(v.z); f[5] = bfhi(v.z); f[6] = bflo(v.w); f[7] = bfhi(v.w);
}
__device__ __forceinline__ uint4 pack8(const float* f) {
  uint4 v; v.x = pack2(f[0], f[1]); v.y = pack2(f[2], f[3]); v.z = pack2(f[4], f[5]); v.w = pack2(f[6], f[7]);
  return v;
}
__device__ __forceinline__ float wave_sum(float v) {
#pragma unroll
  for (int o = 32; o >= 1; o >>= 1) v += __shfl_xor(v, o);
  return v;
}

__device__ __forceinline__ int pos2row_seq(int b, int p, int dir) {
  if (p < 256) { int t = dir ? 255 - p : p; return NLAT + b * 256 + t; }
  int j = p - 256; int t = dir ? 4095 - j : j; return b * 4096 + t;
}
__device__ __forceinline__ int pos2row_m2(int b, int p, int dir) {
  if (p < 256) { int t = dir ? 255 - p : p; return NLAT + b * 256 + t; }
  int j = p - 256; int jj = dir ? 4095 - j : j; int c = jj >> 6, r = jj & 63; return b * 4096 + r * 64 + c;
}

__device__ __forceinline__ void ph_mod(const P& p, int bid, int nb, float* sm) {
  const int tid = threadIdx.x;
  for (int task = bid; task < 96; task += nb) {
    int l = task / 48, cgi = task % 48;
    int col = cgi * 64 + (tid & 63);
    int kq = tid >> 6;
    float a0 = 0, a1 = 0, a2 = 0, a3 = 0, a4 = 0;
    for (int k = kq * 256; k < kq * 256 + 256; ++k) {
      float w = p.w_mod[((size_t)l * 1024 + k) * 3072 + col];
      a0 += siluf(p.c[k]) * w; a1 += siluf(p.c[1024 + k]) * w; a2 += siluf(p.c[2048 + k]) * w;
      a3 += siluf(p.c[3072 + k]) * w; a4 += siluf(p.c_ctx[k]) * w;
    }
    sm[(kq * 5 + 0) * 64 + (tid & 63)] = a0; sm[(kq * 5 + 1) * 64 + (tid & 63)] = a1;
    sm[(kq * 5 + 2) * 64 + (tid & 63)] = a2; sm[(kq * 5 + 3) * 64 + (tid & 63)] = a3;
    sm[(kq * 5 + 4) * 64 + (tid & 63)] = a4;
    __syncthreads();
    if (tid < 64) {
      float bm = p.b_mod[l * 3072 + col];
#pragma unroll
      for (int j = 0; j < 5; ++j) {
        float s = sm[(0 * 5 + j) * 64 + tid] + sm[(1 * 5 + j) * 64 + tid] + sm[(2 * 5 + j) * 64 + tid] + sm[(3 * 5 + j) * 64 + tid];
        p.MOD[(size_t)(l * 5 + j) * 3072 + col] = s + bm;
      }
    }
    __syncthreads();
  }
}

__device__ __forceinline__ void ph_norm(const P& p, int l, int bid, int nb) {
  const int tid = threadIdx.x, wave = tid >> 6, lane = tid & 63;
  for (int R = bid * 4 + wave; R < NTOK; R += nb * 4) {
    const float* src; int mj;
    if (R < NLAT) { src = (l == 0 ? p.x : (const float*)p.out) + (size_t)R * 1024; mj = R >> 12; }
    else { int rc = R - NLAT; src = (l == 0 ? p.ctx : (const float*)p.XC) + (size_t)rc * 1024; mj = 4; }
    const float* mod = p.MOD + (size_t)(l * 5 + mj) * 3072;
    float4 v[4]; float ss = 0;
#pragma unroll
    for (int i = 0; i < 4; ++i) {
      v[i] = ((const float4*)src)[lane + i * 64];
      ss += v[i].x * v[i].x + v[i].y * v[i].y + v[i].z * v[i].z + v[i].w * v[i].w;
    }
    ss = wave_sum(ss);
    float rinv = rsqrtf(ss * (1.f / 1024.f) + EPS);
#pragma unroll
    for (int i = 0; i < 4; ++i) {
      int idx = (lane + i * 64) * 4;
      float4 nw = *(const float4*)(p.norm_w + l * 1024 + idx);
      float4 sh = *(const float4*)(mod + idx);
      float4 sc = *(const float4*)(mod + 1024 + idx);
      float h0 = v[i].x * rinv * nw.x * (1.f + sc.x) + sh.x;
      float h1 = v[i].y * rinv * nw.y * (1.f + sc.y) + sh.y;
      float h2 = v[i].z * rinv * nw.z * (1.f + sc.z) + sh.z;
      float h3 = v[i].w * rinv * nw.w * (1.f + sc.w) + sh.w;
      uint2 o; o.x = pack2(h0, h1); o.y = pack2(h2, h3);
      *(uint2*)(p.HL + (size_t)R * 1024 + idx) = o;
    }
  }
}

__device__ __forceinline__ void ph_wconv(const P& p, int l, int bid, int nb, float* sm) {
  const int tid = threadIdx.x;
  const int T1 = 114 * 16, T2 = 16 * 32;
  for (int t = bid; t < T1 + T2; t += nb) {
    const float* src; int ld, K, n0, k0, sc0, nvalid; u16* dst;
    if (t < T1) {
      int nt = t / 16, kt = t % 16; n0 = nt * 64; k0 = kt * 64;
      src = p.w_in + (size_t)l * 1024 * 7176; ld = 7176; K = 1024; dst = p.WT; nvalid = 64;
      if (n0 < 2048) sc0 = 3072 + n0;
      else if (n0 < 3072) sc0 = 5632 + (n0 - 2048);
      else if (n0 < 3200) { sc0 = 6656 + (n0 - 3072); nvalid = (n0 == 3072) ? 8 : 0; }
      else { int m = n0 - 3200; if (m < 3072) sc0 = m; else if (m < 3584) sc0 = 5120 + (m - 3072); else sc0 = 6664 + (m - 3584); }
    } else {
      int tt = t - T1; int nt = tt / 32, kt = tt % 32; n0 = nt * 64; k0 = kt * 64;
      src = p.w_out + (size_t)l * 2048 * 1024; ld = 1024; K = 2048; dst = p.WoT; nvalid = 64; sc0 = n0;
    }
#pragma unroll
    for (int i = 0; i < 4; ++i) {
      int kk = (tid >> 4) + 16 * i, cc = (tid & 15) * 4;
      const float* sp = src + (size_t)(k0 + kk) * ld + sc0 + cc;
      float4 v;
      if (nvalid == 64) v = *(const float4*)sp;
      else { v.x = (cc + 0 < nvalid) ? sp[0] : 0.f; v.y = (cc + 1 < nvalid) ? sp[1] : 0.f; v.z = (cc + 2 < nvalid) ? sp[2] : 0.f; v.w = (cc + 3 < nvalid) ? sp[3] : 0.f; }
      sm[kk * 65 + cc + 0] = v.x; sm[kk * 65 + cc + 1] = v.y; sm[kk * 65 + cc + 2] = v.z; sm[kk * 65 + cc + 3] = v.w;
    }
    __syncthreads();
#pragma unroll
    for (int i = 0; i < 2; ++i) {
      int q = tid + 256 * i; int nn = q >> 3, ks = q & 7;
      float f[8];
#pragma unroll
      for (int j = 0; j < 8; ++j) f[j] = sm[(ks * 8 + j) * 65 + nn];
      *(uint4*)(dst + (size_t)(n0 + nn) * K + k0 + ks * 8) = pack8(f);
    }
    __syncthreads();
  }
}

__device__ __forceinline__ void ph_filt(const P& p, int l, int bid, int nb, float* sm) {
  const int tid = threadIdx.x;
  const float HY_MIN = -3.0701134573253945f, HY_MAX = -15.350567286626972f;
  int ntask = 256 + (l == 0 ? 16 : 0);
  float* zs = sm; float* h1 = sm + 544; float* h2 = sm + 544 + 1024;
  for (int task = bid; task < ntask; task += nb) {
    int n, t0; u16* K;
    if (task < 256) { n = 4096; t0 = task * 16; K = p.KF; } else { n = 256; t0 = (task - 256) * 16; K = p.KFC; }
    float inv_nm1 = 1.f / (float)(n - 1);
    for (int e = tid; e < 16 * 33; e += 256) {
      int tt = e / 33, f = e % 33; int t = t0 + tt; float val;
      if (f == 0) val = (float)t * inv_nm1;
      else {
        int bi = (f - 1) & 15;
        float band = 1e-4f + (float)bi * ((15.f - 1e-4f) / 15.f);
        float ang = (6.283185307179586f / (float)n) * (float)t * band;
        val = (f <= 16) ? cosf(ang) : -sinf(ang);
      }
      zs[e] = val;
    }
    __syncthreads();
    for (int e = tid; e < 1024; e += 256) {
      int tt = e >> 6, j = e & 63; float acc = p.hy_b1[l * 64 + j];
      for (int f = 0; f < 33; ++f) acc += zs[tt * 33 + f] * p.hy_w1[(l * 33 + f) * 64 + j];
      h1[e] = sinf(p.hy_freq[l * 64 + j] * acc);
    }
    __syncthreads();
    for (int e = tid; e < 1024; e += 256) {
      int tt = e >> 6, j = e & 63; float acc = p.hy_b2[l * 64 + j];
      for (int i = 0; i < 64; ++i) acc += h1[tt * 64 + i] * p.hy_w2[(l * 64 + i) * 64 + j];
      h2[e] = sinf(p.hy_freq[l * 64 + j] * acc);
    }
    __syncthreads();
    for (int r = 0; r < 8; ++r) {
      int col = tid + 256 * r; int o = col >> 10, side = (col >> 9) & 1, c = col & 511;
      float w[64];
#pragma unroll
      for (int i = 0; i < 64; ++i) w[i] = p.hy_w3[(size_t)(l * 64 + i) * 2048 + col];
      float delta = fabsf(HY_MIN + (HY_MAX - HY_MIN) * (float)c / 511.f);
      u16* Kc = K + (size_t)(o * 512 + c) * (2 * n);
      for (int tt = 0; tt < 16; ++tt) {
        float acc = 0;
#pragma unroll
        for (int i = 0; i < 64; ++i) acc += h2[tt * 64 + i] * w[i];
        int t = t0 + tt;
        float val = acc * __expf(-(float)t * inv_nm1 * delta);
        int idx;
        if (side == 0) idx = n + t; else { if (t == 0) { idx = 0; val = 0.f; } else idx = n - t; }
        Kc[idx] = f2bf(val);
      }
    }
    __syncthreads();
  }
}

#define LDSTR 72
template <int MODE>
__device__ __forceinline__ void gemm_tile(const P& p, int l, int mt, int nt, u16* sA, u16* sB) {
  const int tid = threadIdx.x, wave = tid >> 6, lane = tid & 63;
  const int wm = wave >> 1, wn = wave & 1;
  const int KT = (MODE == 2) ? 2048 : 1024;
  const u16* Bsrc = (MODE == 0) ? p.WT + (size_t)(nt * 128) * 1024
                  : (MODE == 1) ? p.WT + (size_t)(3200 + nt * 128) * 1024
                                : p.WoT + (size_t)(nt * 128) * 2048;
  f32x16 acc[2][2];
#pragma unroll
  for (int a = 0; a < 2; ++a)
#pragma unroll
    for (int b = 0; b < 2; ++b)
#pragma unroll
      for (int r = 0; r < 16; ++r) acc[a][b][r] = 0.f;

  uint4 ra0, ra1, ra2, ra3, rb0, rb1, rb2, rb3;
  const int lrow = tid >> 3, lseg = tid & 7;
#define GLOAD1(K0, I, RA, RB)                                                                       \
  {                                                                                                 \
    int row = lrow + 32 * (I); int k = (K0) + lseg * 8;                                             \
    const u16* ap;                                                                                  \
    if (MODE == 2) ap = (k < 1024) ? p.HL + (size_t)(mt * 128 + row) * 1024 + k                     \
                                   : p.Y2 + (size_t)(mt * 128 + row) * 1024 + (k - 1024);           \
    else ap = p.HL + (size_t)(mt * 128 + row) * 1024 + k;                                           \
    RA = *(const uint4*)ap;                                                                         \
    RB = *(const uint4*)(Bsrc + (size_t)row * KT + k);                                              \
  }
#define GLOAD(K0) GLOAD1(K0, 0, ra0, rb0) GLOAD1(K0, 1, ra1, rb1) GLOAD1(K0, 2, ra2, rb2) GLOAD1(K0, 3, ra3, rb3)
  GLOAD(0)
  for (int k0 = 0; k0 < KT; k0 += 64) {
    *(uint4*)(sA + (lrow + 0) * LDSTR + lseg * 8) = ra0;  *(uint4*)(sB + (lrow + 0) * LDSTR + lseg * 8) = rb0;
    *(uint4*)(sA + (lrow + 32) * LDSTR + lseg * 8) = ra1; *(uint4*)(sB + (lrow + 32) * LDSTR + lseg * 8) = rb1;
    *(uint4*)(sA + (lrow + 64) * LDSTR + lseg * 8) = ra2; *(uint4*)(sB + (lrow + 64) * LDSTR + lseg * 8) = rb2;
    *(uint4*)(sA + (lrow + 96) * LDSTR + lseg * 8) = ra3; *(uint4*)(sB + (lrow + 96) * LDSTR + lseg * 8) = rb3;
    __syncthreads();
    if (k0 + 64 < KT) { GLOAD(k0 + 64) }
#pragma unroll
    for (int ks = 0; ks < 4; ++ks) {
      bf16x8 fa[2], fb[2];
#pragma unroll
      for (int mi = 0; mi < 2; ++mi)
        fa[mi] = *(const bf16x8*)(sA + (wm * 64 + mi * 32 + (lane & 31)) * LDSTR + ks * 16 + (lane >> 5) * 8);
#pragma unroll
      for (int ni = 0; ni < 2; ++ni)
        fb[ni] = *(const bf16x8*)(sB + (wn * 64 + ni * 32 + (lane & 31)) * LDSTR + ks * 16 + (lane >> 5) * 8);
#pragma unroll
      for (int mi = 0; mi < 2; ++mi)
#pragma unroll
        for (int ni = 0; ni < 2; ++ni)
          acc[mi][ni] = __builtin_amdgcn_mfma_f32_32x32x16_bf16(fa[mi], fb[ni], acc[mi][ni], 0, 0, 0);
    }
    __syncthreads();
  }
  const int mj = (mt < 128) ? (mt >> 5) : 4;
#pragma unroll
  for (int ni = 0; ni < 2; ++ni) {
    const int col = wn * 64 + ni * 32 + (lane & 31);
    const int gcol = nt * 128 + col;
    float lb = 0.f; float gmod = 0.f;
    if (MODE == 0) {
      int piece = gcol >> 9;
      if (l == 1 && (piece == 1 || piece == 2)) {
        int dir = piece - 1, ch = gcol & 511;
        float l0 = p.hg_lb[(0 * 2 + dir) * 512 + ch], l1 = p.hg_lb[(1 * 2 + dir) * 512 + ch];
        lb = 1.f / (1.f + __expf(l0 - l1));
      }
    }
    if (MODE == 2) gmod = p.MOD[(size_t)(l * 5 + mj) * 3072 + 2048 + gcol];
#pragma unroll
    for (int mi = 0; mi < 2; ++mi) {
#pragma unroll
      for (int r = 0; r < 16; ++r) {
        const int row = wm * 64 + mi * 32 + (r & 3) + 8 * (r >> 2) + 4 * (lane >> 5);
        const int R = mt * 128 + row;
        float v = acc[mi][ni][r];
        if (MODE == 0) {
          if (nt < 24) {
            int piece = gcol >> 9;
            if (piece == 0) v *= 0.08838834764831845f;
            else if (piece == 1 || piece == 2) v = (1.f - lb) / (1.f + __expf(v));
            p.U[(size_t)R * UW + gcol] = f2bf(v);
          } else {
            if (col < 8) p.DT[(size_t)R * 8 + col] = v;
          }
        } else if (MODE == 1) {
          int piece = gcol >> 9;
          if (piece == 3 || piece >= 5) v = siluf(v);
          p.U[(size_t)R * UW + gcol] = f2bf(v);
        } else {
          if (R < NLAT) {
            const float* base = (l == 0) ? p.x : (const float*)p.out;
            float xv = base[(size_t)R * 1024 + gcol];
            p.out[(size_t)R * 1024 + gcol] = xv + gmod * v;
          } else {
            int rc = R - NLAT;
            p.XC[(size_t)rc * 1024 + gcol] = p.ctx[(size_t)rc * 1024 + gcol] + gmod * v;
          }
        }
      }
    }
  }
}

template <int MODE>
__device__ __forceinline__ void ph_gemm(const P& p, int l, int bid, int nb, u16* sm) {
  const int NT = (MODE == 0) ? 25 : (MODE == 1) ? 32 : 8;
  const int MT = (MODE == 2 && l == 1) ? 128 : 136;
  u16* sA = sm; u16* sB = sm + 128 * LDSTR;
  for (int t = bid; t < MT * NT; t += nb) {
    int nt = t / MT, mt = t % MT;
    gemm_tile<MODE>(p, l, mt, nt, sA, sB);
  }
}

__device__ __forceinline__ void hg_task(const P& p, int l, int task, float* sm) {
  const int tid = threadIdx.x, wave = tid >> 6, lane = tid & 63;
  const int b = task >> 5, h = (task >> 3) & 3, es = task & 7;
  const int dg = lane & 15, el = lane >> 4;
  float* qs = sm; float* ks = sm + 4096; float* vs = sm + 8192; float* os = sm + 8192 + 512;
  for (int dir = 0; dir < 2; ++dir) {
    float S[8];
#pragma unroll
    for (int r = 0; r < 8; ++r) S[r] = 0.f;
    for (int chunk = 0; chunk < 136; ++chunk) {
#pragma unroll
      for (int i = 0; i < 2; ++i) {
        int q = tid + 256 * i; int pos = q >> 4, seg = q & 15;
        int R = pos2row_seq(b, chunk * 32 + pos, dir);
        const u16* up = p.U + (size_t)R * UW + h * 128 + seg * 8;
        uint4 qv = *(const uint4*)up;
        uint4 kv = *(const uint4*)(up + 512 + dir * 512);
        float f[8];
        unpack8(qv, f);
        *(float4*)(qs + pos * 128 + seg * 8) = make_float4(f[0], f[1], f[2], f[3]);
        *(float4*)(qs + pos * 128 + seg * 8 + 4) = make_float4(f[4], f[5], f[6], f[7]);
        unpack8(kv, f);
        *(float4*)(ks + pos * 128 + seg * 8) = make_float4(f[0], f[1], f[2], f[3]);
        *(float4*)(ks + pos * 128 + seg * 8 + 4) = make_float4(f[4], f[5], f[6], f[7]);
      }
      {
        int pos = tid >> 3, e2 = (tid & 7) * 2;
        int R = pos2row_seq(b, chunk * 32 + pos, dir);
        uint32_t w = *(const uint32_t*)(p.U + (size_t)R * UW + 1536 + h * 128 + es * 16 + e2);
        vs[pos * 16 + e2] = bflo(w); vs[pos * 16 + e2 + 1] = bfhi(w);
      }
      __syncthreads();
#pragma unroll 4
      for (int i = 0; i < 32; ++i) {
        float4 q0 = *(const float4*)(qs + i * 128 + dg * 8), q1 = *(const float4*)(qs + i * 128 + dg * 8 + 4);
        float4 k0 = *(const float4*)(ks + i * 128 + dg * 8), k1 = *(const float4*)(ks + i * 128 + dg * 8 + 4);
        float v = vs[i * 16 + wave * 4 + el];
        S[0] += k0.x * (v - S[0]); S[1] += k0.y * (v - S[1]); S[2] += k0.z * (v - S[2]); S[3] += k0.w * (v - S[3]);
        S[4] += k1.x * (v - S[4]); S[5] += k1.y * (v - S[5]); S[6] += k1.z * (v - S[6]); S[7] += k1.w * (v - S[7]);
        float o = q0.x * S[0] + q0.y * S[1] + q0.z * S[2] + q0.w * S[3] + q1.x * S[4] + q1.y * S[5] + q1.z * S[6] + q1.w * S[7];
        o += __shfl_xor(o, 1); o += __shfl_xor(o, 2); o += __shfl_xor(o, 4); o += __shfl_xor(o, 8);
        if (dg == 0) os[i * 16 + wave * 4 + el] = o;
      }
      __syncthreads();
      {
        int pos = tid >> 3, e2 = (tid & 7) * 2;
        int R = pos2row_seq(b, chunk * 32 + pos, dir);
        uint32_t* yp = (uint32_t*)(p.Y2 + (size_t)R * 1024 + h * 128 + es * 16 + e2);
        float o0 = os[pos * 16 + e2], o1 = os[pos * 16 + e2 + 1];
        if (dir == 1) { uint32_t w = *yp; o0 += bflo(w); o1 += bfhi(w); }
        *yp = pack2(o0, o1);
      }
    }
    __threadfence();
    __syncthreads();
  }
}

__device__ __forceinline__ void m2_task(const P& p, int l, int task, float* sm) {
  const int tid = threadIdx.x, wave = tid >> 6, lane = tid & 63;
  const int b = task >> 5, head = (task >> 2) & 7, ps = task & 3;
  const int g = head >> 2;
  const int dg = lane & 15, el = lane >> 4;
  float* Cs = sm; float* Bs = sm + 4096; float* xs = sm + 8192; float* os = sm + 8192 + 512;
  float* dts = sm + 8192 + 1024; float* decs = dts + 32;
  for (int dir = 0; dir < 2; ++dir) {
    const float* cw = p.m2_conv_w + (size_t)(l * 2 + dir) * 4 * 1024;
    const float* cb = p.m2_conv_b + (size_t)(l * 2 + dir) * 1024;
    const float dtb = p.m2_dt_bias[(l * 2 + dir) * 8 + head];
    const float Aneg = -__expf(p.m2_a_log[(l * 2 + dir) * 8 + head]);
    const float Dsk = p.m2_d[(l * 2 + dir) * 8 + head];
    float S[8];
#pragma unroll
    for (int r = 0; r < 8; ++r) S[r] = 0.f;
    for (int chunk = 0; chunk < 136; ++chunk) {
      const int pbase = chunk * 32;
      const int seg0 = (pbase < 256) ? 0 : 256;
#pragma unroll
      for (int i = 0; i < 2; ++i) {
        int q = tid + 256 * i; int pos = q >> 4, seg = q & 15;
        int pp = pbase + pos;
        int chB = 512 + g * 128 + seg * 8, chC = 768 + g * 128 + seg * 8;
        float aB[8], aC[8];
#pragma unroll
        for (int j = 0; j < 8; ++j) { aB[j] = cb[chB + j]; aC[j] = cb[chC + j]; }
#pragma unroll
        for (int tap = 0; tap < 4; ++tap) {
          int pt = pp - 3 + tap;
          if (pt >= seg0) {
            int R = pos2row_m2(b, pt, dir);
            const u16* up = p.U + (size_t)R * UW + 2048;
            uint4 bv = *(const uint4*)(up + chB);
            uint4 cv = *(const uint4*)(up + chC);
            float f[8];
            unpack8(bv, f);
#pragma unroll
            for (int j = 0; j < 8; ++j) aB[j] += cw[tap * 1024 + chB + j] * f[j];
            unpack8(cv, f);
#pragma unroll
            for (int j = 0; j < 8; ++j) aC[j] += cw[tap * 1024 + chC + j] * f[j];
          }
        }
#pragma unroll
        for (int j = 0; j < 8; ++j) { aB[j] = siluf(aB[j]); aC[j] = siluf(aC[j]); }
        *(float4*)(Bs + pos * 128 + seg * 8) = make_float4(aB[0], aB[1], aB[2], aB[3]);
        *(float4*)(Bs + pos * 128 + seg * 8 + 4) = make_float4(aB[4], aB[5], aB[6], aB[7]);
        *(float4*)(Cs + pos * 128 + seg * 8) = make_float4(aC[0], aC[1], aC[2], aC[3]);
        *(float4*)(Cs + pos * 128 + seg * 8 + 4) = make_float4(aC[4], aC[5], aC[6], aC[7]);
      }
      {
        int pos = tid >> 3, e2 = (tid & 7) * 2;
        int pp = pbase + pos;
        int ch = head * 64 + ps * 16 + e2;
        float a0 = cb[ch], a1 = cb[ch + 1];
#pragma unroll
        for (int tap = 0; tap < 4; ++tap) {
          int pt = pp - 3 + tap;
          if (pt >= seg0) {
            int R = pos2row_m2(b, pt, dir);
            uint32_t w = *(const uint32_t*)(p.U + (size_t)R * UW + 2048 + ch);
            a0 += cw[tap * 1024 + ch] * bflo(w); a1 += cw[tap * 1024 + ch + 1] * bfhi(w);
          }
        }
        xs[pos * 16 + e2] = siluf(a0); xs[pos * 16 + e2 + 1] = siluf(a1);
      }
      if (tid < 32) {
        int R = pos2row_m2(b, pbase + tid, dir);
        float dtv = softplusf(p.DT[(size_t)R * 8 + head] + dtb);
        dts[tid] = dtv; decs[tid] = __expf(dtv * Aneg);
      }
      __syncthreads();
#pragma unroll 4
      for (int i = 0; i < 32; ++i) {
        float4 q0 = *(const float4*)(Cs + i * 128 + dg * 8), q1 = *(const float4*)(Cs + i * 128 + dg * 8 + 4);
        float4 k0 = *(const float4*)(Bs + i * 128 + dg * 8), k1 = *(const float4*)(Bs + i * 128 + dg * 8 + 4);
        float xv = xs[i * 16 + wave * 4 + el];
        float a = decs[i]; float v = xv * dts[i];
        S[0] = a * S[0] + k0.x * v; S[1] = a * S[1] + k0.y * v; S[2] = a * S[2] + k0.z * v; S[3] = a * S[3] + k0.w * v;
        S[4] = a * S[4] + k1.x * v; S[5] = a * S[5] + k1.y * v; S[6] = a * S[6] + k1.z * v; S[7] = a * S[7] + k1.w * v;
        float o = q0.x * S[0] + q0.y * S[1] + q0.z * S[2] + q0.w * S[3] + q1.x * S[4] + q1.y * S[5] + q1.z * S[6] + q1.w * S[7];
        o += __shfl_xor(o, 1); o += __shfl_xor(o, 2); o += __shfl_xor(o, 4); o += __shfl_xor(o, 8);
        if (dg == 0) os[i * 16 + wave * 4 + el] = o + Dsk * xv;
      }
      __syncthreads();
      {
        int pos = tid >> 3, e2 = (tid & 7) * 2;
        int R = pos2row_m2(b, pbase + pos, dir);
        uint32_t* yp = (uint32_t*)(p.Y2 + (size_t)R * 1024 + 512 + head * 64 + ps * 16 + e2);
        float o0 = os[pos * 16 + e2], o1 = os[pos * 16 + e2 + 1];
        if (dir == 1) { uint32_t w = *yp; o0 += bflo(w); o1 += bfhi(w); }
        *yp = pack2(o0, o1);
      }
    }
    __threadfence();
    __syncthreads();
  }
}

__device__ __forceinline__ void ph_mixA(const P& p, int l, int bid, int nb, float* sm) {
  for (int t = bid; t < 256; t += nb) {
    if (t < 128) { if (EN_HG) hg_task(p, l, t, sm); }
    else { if (EN_M2) m2_task(p, l, t - 128, sm); }
    __syncthreads();
  }
}

__device__ __forceinline__ void rg_task(const P& p, int l, int task, float* sm) {
  const int tid = threadIdx.x;
  const int b = task >> 3, head = task & 7;
  float* xc = sm; float* pa = sm + 2048; float* pb = sm + 4096;
  const int j = tid & 63, which = (tid >> 6) & 1, half = tid >> 7;
  for (int dir = 0; dir < 2; ++dir) {
    const int ld = l * 2 + dir;
    float w[64];
    {
      const float* wp = (which ? p.rg_wx : p.rg_wa) + (size_t)(ld * 8 + head) * 4096 + j;
#pragma unroll
      for (int i = 0; i < 64; ++i) w[i] = wp[i * 64];
    }
    const float* cw = p.rg_conv_w + (size_t)ld * 4 * 512;
    const float* cb = p.rg_conv_b + (size_t)ld * 512;
    float hcarry = 0.f;
    for (int chunk = 0; chunk < 136; ++chunk) {
      const int pbase = chunk * 32;
      const int seg0 = (pbase < 256) ? 0 : 256;
      {
        int pos = tid >> 3, seg = tid & 7;
        int ch = head * 64 + seg * 8;
        float a[8];
#pragma unroll
        for (int jj = 0; jj < 8; ++jj) a[jj] = cb[ch + jj];
#pragma unroll
        for (int tap = 0; tap < 4; ++tap) {
          int pt = pbase + pos - 3 + tap;
          if (pt >= seg0) {
            int R = pos2row_seq(b, pt, dir);
            uint4 xv = *(const uint4*)(p.U + (size_t)R * UW + 2048 + ch);
            float f[8]; unpack8(xv, f);
#pragma unroll
            for (int jj = 0; jj < 8; ++jj) a[jj] += cw[tap * 512 + ch + jj] * f[jj];
          }
        }
        *(float4*)(xc + pos * 64 + seg * 8) = make_float4(a[0], a[1], a[2], a[3]);
        *(float4*)(xc + pos * 64 + seg * 8 + 4) = make_float4(a[4], a[5], a[6], a[7]);
      }
      __syncthreads();
      {
        float* dstp = which ? pb : pa;
        for (int pi = 0; pi < 16; ++pi) {
          int pos = half * 16 + pi;
          float acc = 0.f;
#pragma unroll
          for (int i4 = 0; i4 < 16; ++i4) {
            float4 xv = *(const float4*)(xc + pos * 64 + i4 * 4);
            acc += xv.x * w[i4 * 4] + xv.y * w[i4 * 4 + 1] + xv.z * w[i4 * 4 + 2] + xv.w * w[i4 * 4 + 3];
          }
          dstp[pos * 64 + j] = acc;
        }
      }
      __syncthreads();
#pragma unroll
      for (int i = 0; i < 8; ++i) {
        int e = tid + 256 * i; int ch = e & 63; int chg = head * 64 + ch;
        float r = sigmf(pa[e] + p.rg_ba[ld * 512 + chg]);
        float gi = sigmf(pb[e] + p.rg_bx[ld * 512 + chg]);
        float la = -8.0f * r * softplusf(-p.rg_lam[ld * 512 + chg]);
        float a = __expf(la);
        float bt = sqrtf(-expm1f(2.f * la)) * gi * xc[e];
        pa[e] = a; pb[e] = bt;
      }
      __syncthreads();
      if (tid < 64) {
        float hh = hcarry;
        for (int pos = 0; pos < 32; ++pos) { hh = pa[pos * 64 + tid] * hh + pb[pos * 64 + tid]; pb[pos * 64 + tid] = hh; }
        hcarry = hh;
      }
      __syncthreads();
      {
        int pos = tid >> 3, seg = tid & 7;
        int R = pos2row_seq(b, pbase + pos, dir);
        int ch = head * 64 + seg * 8;
        uint4* yp = (uint4*)(p.HL + (size_t)R * 1024 + 512 + ch);
        float hv[8];
#pragma unroll
        for (int jj = 0; jj < 8; ++jj) hv[jj] = pb[pos * 64 + seg * 8 + jj];
        if (dir == 1) {
          uint4 prev = *yp; float f[8]; unpack8(prev, f);
          uint4 gv = *(const uint4*)(p.U + (size_t)R * UW + 2560 + ch); float gf[8]; unpack8(gv, gf);
#pragma unroll
          for (int jj = 0; jj < 8; ++jj) hv[jj] = (hv[jj] + f[jj]) * gf[jj];
        }
        *yp = pack8(hv);
      }
      __syncthreads();
    }
    __threadfence();
    __syncthreads();
  }
}

__device__ __forceinline__ float hy_conv3(const P& p, int l, int ch, int Rbase, int t, int n) {
  const float* w = p.hy_conv_w + (size_t)l * 3 * 1536;
  float a = p.hy_conv_b[l * 1536 + ch];
#pragma unroll
  for (int i = 0; i < 3; ++i) {
    int tt = t - 1 + i;
    if (tt >= 0 && tt < n) a += w[i * 1536 + ch] * bf2f(p.U[(size_t)(Rbase + tt) * UW + ch]);
  }
  return a;
}

__device__ __forceinline__ void hy_task(const P& p, int l, int c, float* sm) {
  const int tid = threadIdx.x;
  u16* kk = (u16*)sm;
  u16* zs = (u16*)sm + 8192;
  float* red = sm + 12288;
  const int t0 = tid * 16;
  for (int o = 0; o < 2; ++o) {
    const u16* K = p.KF + (size_t)(o * 512 + c) * 8192;
    float asum = 0.f;
#pragma unroll
    for (int i = 0; i < 4; ++i) {
      int idx = (tid + 256 * i) * 8;
      uint4 v = *(const uint4*)(K + idx);
      *(uint4*)(kk + idx) = v;
      float f[8]; unpack8(v, f);
#pragma unroll
      for (int j = 0; j < 8; ++j) asum += fabsf(f[j]);
    }
    asum = wave_sum(asum);
    if ((tid & 63) == 0) red[tid >> 6] = asum;
    if (o == 0) {
#pragma unroll 1
      for (int e = tid; e < 16384; e += 256) {
        int b = e >> 12, t = e & 4095;
        zs[t * 4 + b] = f2bf(hy_conv3(p, l, c, b * 4096, t, 4096));
      }
    }
    __syncthreads();
    const float scale = 1.f / (red[0] + red[1] + red[2] + red[3] + 1e-6f);
    const float skip = p.hy_skip[(l * 2 + o) * 512 + c];
#pragma unroll 1
    for (int half = 0; half < 2; ++half) {
      const int th = half * 2048 + tid * 8;
      float acc[8][4];
#pragma unroll
      for (int i = 0; i < 8; ++i) { acc[i][0] = 0.f; acc[i][1] = 0.f; acc[i][2] = 0.f; acc[i][3] = 0.f; }
#pragma unroll 1
      for (int s0 = 0; s0 < 4096; s0 += 16) {
        const int base = 4096 + th - s0;
        float kw[24];
        {
          const uint4* kp = (const uint4*)(kk + base - 16);
          uint4 v0 = kp[0], v1 = kp[1], v2 = kp[2];
          unpack8(v0, kw); unpack8(v1, kw + 8); unpack8(v2, kw + 16);
        }
#pragma unroll
        for (int j = 0; j < 16; ++j) {
          uint2 zv = *(const uint2*)(zs + (s0 + j) * 4);
          float z0 = bflo(zv.x), z1 = bfhi(zv.x), z2 = bflo(zv.y), z3 = bfhi(zv.y);
#pragma unroll
          for (int i = 0; i < 8; ++i) {
            float kv = kw[16 + i - j];
            acc[i][0] += kv * z0; acc[i][1] += kv * z1; acc[i][2] += kv * z2; acc[i][3] += kv * z3;
          }
        }
      }
#pragma unroll
      for (int i = 0; i < 8; ++i) {
        uint2 zv = *(const uint2*)(zs + (th + i) * 4);
        size_t R = (size_t)(th + i);
        p.HL[(R) * 1024 + c] = f2bf(scale * acc[i][0] + skip * bflo(zv.x));
        p.HL[(R + 4096) * 1024 + c] = f2bf(scale * acc[i][1] + skip * bfhi(zv.x));
        p.HL[(R + 8192) * 1024 + c] = f2bf(scale * acc[i][2] + skip * bflo(zv.y));
        p.HL[(R + 12288) * 1024 + c] = f2bf(scale * acc[i][3] + skip * bfhi(zv.y));
      }
    }
    __threadfence();
    __syncthreads();
#pragma unroll 1
    for (int e = tid; e < 16384; e += 256) {
      int b = e >> 12, t = e & 4095;
      float xg = hy_conv3(p, l, (o + 1) * 512 + c, b * 4096, t, 4096);
      float zn = xg * bf2f(p.HL[((size_t)b * 4096 + t) * 1024 + c]);
      if (o == 0) zs[t * 4 + b] = f2bf(zn);
      else {
        size_t R = (size_t)b * 4096 + t;
        float gate = bf2f(p.U[R * UW + 1536 + c]);
        p.HL[R * 1024 + c] = f2bf(zn * gate);
      }
    }
    __syncthreads();
  }
  if (l == 0) {
    const int t = tid;
    for (int o = 0; o < 2; ++o) {
      const u16* K = p.KFC + (size_t)(o * 512 + c) * 512;
      float asum = 0.f;
      {
        uint32_t w2 = *(const uint32_t*)(K + tid * 2);
        *(uint32_t*)(kk + tid * 2) = w2;
        asum = fabsf(bflo(w2)) + fabsf(bfhi(w2));
      }
      asum = wave_sum(asum);
      if ((tid & 63) == 0) red[tid >> 6] = asum;
      if (o == 0) {
        for (int b = 0; b < 4; ++b) zs[t * 4 + b] = f2bf(hy_conv3(p, l, c, NLAT + b * 256, t, 256));
      }
      __syncthreads();
      const float scale = 1.f / (red[0] + red[1] + red[2] + red[3] + 1e-6f);
      float a0 = 0, a1 = 0, a2 = 0, a3 = 0;
      for (int s = 0; s < 256; ++s) {
        float kv = bf2f(kk[256 + t - s]);
        uint2 zv = *(const uint2*)(zs + s * 4);
        a0 += kv * bflo(zv.x); a1 += kv * bfhi(zv.x); a2 += kv * bflo(zv.y); a3 += kv * bfhi(zv.y);
      }
      const float skip = p.hy_skip[(l * 2 + o) * 512 + c];
      uint2 zv = *(const uint2*)(zs + t * 4);
      float y[4];
      y[0] = scale * a0 + skip * bflo(zv.x); y[1] = scale * a1 + skip * bfhi(zv.x);
      y[2] = scale * a2 + skip * bflo(zv.y); y[3] = scale * a3 + skip * bfhi(zv.y);
      __syncthreads();
#pragma unroll
      for (int b = 0; b < 4; ++b) {
        float xg = hy_conv3(p, l, (o + 1) * 512 + c, NLAT + b * 256, t, 256);
        float zn = xg * y[b];
        if (o == 0) zs[t * 4 + b] = f2bf(zn);
        else {
          size_t R = (size_t)NLAT + b * 256 + t;
          float gate = bf2f(p.U[R * UW + 1536 + c]);
          p.HL[R * 1024 + c] = f2bf(zn * gate);
        }
      }
      __syncthreads();
    }
  }
}

__device__ __forceinline__ void fin_rows(const P& p, int l, int chunk) {
  const int tid = threadIdx.x, wave = tid >> 6, lane = tid & 63;
  for (int rr = 0; rr < 16; ++rr) {
    int R = chunk * 64 + wave * 16 + rr;
    {
      uint4* yp = (uint4*)(p.Y2 + (size_t)R * 1024 + lane * 8);
      float o[8]; unpack8(*yp, o);
      float ss = 0;
#pragma unroll
      for (int j = 0; j < 8; ++j) ss += o[j] * o[j];
      ss += __shfl_xor(ss, 1); ss += __shfl_xor(ss, 2); ss += __shfl_xor(ss, 4); ss += __shfl_xor(ss, 8);
      float rinv = rsqrtf(ss * (1.f / 128.f) + EPS);
      float gf[8]; unpack8(*(const uint4*)(p.U + (size_t)R * UW + 3072 + lane * 8), gf);
#pragma unroll
      for (int j = 0; j < 8; ++j) o[j] = o[j] * rinv * p.hg_norm_w[l * 512 + lane * 8 + j] * gf[j];
      *yp = pack8(o);
    }
    {
      uint4* yp = (uint4*)(p.Y2 + (size_t)R * 1024 + 512 + lane * 8);
      float o[8]; unpack8(*yp, o);
      float gf[8]; unpack8(*(const uint4*)(p.U + (size_t)R * UW + 3584 + lane * 8), gf);
      float ss = 0;
#pragma unroll
      for (int j = 0; j < 8; ++j) { o[j] *= gf[j]; ss += o[j] * o[j]; }
      ss += __shfl_xor(ss, 1); ss += __shfl_xor(ss, 2); ss += __shfl_xor(ss, 4); ss += __shfl_xor(ss, 8); ss += __shfl_xor(ss, 16);
      float rinv = rsqrtf(ss * (1.f / 256.f) + EPS);
#pragma unroll
      for (int j = 0; j < 8; ++j) o[j] = o[j] * rinv * p.m2_norm_w[l * 512 + lane * 8 + j];
      *yp = pack8(o);
    }
  }
}

__device__ __forceinline__ void ph_mixB(const P& p, int l, int bid, int nb, float* sm) {
  const int nfin = (l == 0 ? NTOK : NLAT) / 64;
  const int ntask = 32 + 512 + nfin;
  for (int t = bid; t < ntask; t += nb) {
    if (t < 32) { if (EN_RG) rg_task(p, l, t, sm); }
    else if (t < 544) { if (EN_HY) hy_task(p, l, t - 32, sm); }
    else fin_rows(p, l, t - 544);
    __syncthreads();
  }
}

__device__ __forceinline__ void ph_final(const P& p, int bid, int nb) {
  const int tid = threadIdx.x, wave = tid >> 6, lane = tid & 63;
  for (int R = bid * 4 + wave; R < NLAT; R += nb * 4) {
    float4* rp = (float4*)(p.out + (size_t)R * 1024);
    float4 v[4]; float ss = 0;
#pragma unroll
    for (int i = 0; i < 4; ++i) {
      v[i] = rp[lane + i * 64];
      ss += v[i].x * v[i].x + v[i].y * v[i].y + v[i].z * v[i].z + v[i].w * v[i].w;
    }
    ss = wave_sum(ss);
    float rinv = rsqrtf(ss * (1.f / 1024.f) + EPS);
#pragma unroll
    for (int i = 0; i < 4; ++i) {
      float4 w = *(const float4*)(p.final_norm_w + (lane + i * 64) * 4);
      float4 o; o.x = v[i].x * rinv * w.x; o.y = v[i].y * rinv * w.y; o.z = v[i].z * rinv * w.z; o.w = v[i].w * rinv * w.w;
      rp[lane + i * 64] = o;
    }
  }
}

#define SMEM_BYTES 50176
__global__ void __launch_bounds__(256) mega(P p) {
  __shared__ __align__(16) unsigned char smem[SMEM_BYTES];
  cg::grid_group grid = cg::this_grid();
  const int bid = blockIdx.x, nb = gridDim.x;
  float* smf = (float*)smem; u16* smh = (u16*)smem;
#ifndef PHM
#define PHM 0xffff
#endif
  if (PHM & 1) ph_mod(p, bid, nb, smf);
  grid.sync();
  for (int l = 0; l < 2; ++l) {
    if (PHM & 2) ph_norm(p, l, bid, nb);
    if (PHM & 4) ph_wconv(p, l, bid, nb, smf);
    if (PHM & 8) ph_filt(p, l, bid, nb, smf);
    grid.sync();
    if (PHM & 16) ph_gemm<0>(p, l, bid, nb, smh);
    grid.sync();
    if (PHM & 32) ph_mixA(p, l, bid, nb, smf);
    grid.sync();
    if (PHM & 64) ph_gemm<1>(p, l, bid, nb, smh);
    grid.sync();
    if (PHM & 128) ph_mixB(p, l, bid, nb, smf);
    grid.sync();
    if (PHM & 256) ph_gemm<2>(p, l, bid, nb, smh);
    grid.sync();
  }
  if (PHM & 512) ph_final(p, bid, nb);
}

extern "C" void kernel_launch(void* const* d_in, const int* in_sizes, int n_in, void* d_out, int out_size,
                              void* d_ws, size_t ws_size, hipStream_t stream) {
  static int grid_blocks = 0;
  if (!grid_blocks) {
    int dev = 0, cus = 0, per_cu = 0;
    hipGetDevice(&dev);
    hipDeviceGetAttribute(&cus, hipDeviceAttributeMultiprocessorCount, dev);
    hipOccupancyMaxActiveBlocksPerMultiprocessor(&per_cu, mega, 256, 0);
    if (per_cu < 1) per_cu = 1;
    if (per_cu > 2) per_cu = 2;
    grid_blocks = cus * per_cu;
  }
  P p{};
  const float** fp = (const float**)&p;
  for (int i = 0; i < 34; ++i) fp[i] = (const float*)d_in[i];
  p.out = (float*)d_out;
  char* w = (char*)d_ws;
  size_t off = 0;
  auto take = [&](size_t bytes) { char* r = w + off; off += (bytes + 255) & ~(size_t)255; return r; };
  p.U = (u16*)take((size_t)NTOK * UW * 2);
  p.HL = (u16*)take((size_t)NTOK * 1024 * 2);
  p.Y2 = (u16*)take((size_t)NTOK * 1024 * 2);
  p.WT = (u16*)take((size_t)7296 * 1024 * 2);
  p.WoT = (u16*)take((size_t)1024 * 2048 * 2);
  p.KF = (u16*)take((size_t)1024 * 8192 * 2);
  p.KFC = (u16*)take((size_t)1024 * 512 * 2);
  p.XC = (float*)take((size_t)1024 * 1024 * 4);
  p.DT = (float*)take((size_t)NTOK * 8 * 4);
  p.MOD = (float*)take((size_t)2 * 5 * 3072 * 4);
  if (off > ws_size) { fprintf(stderr, "workspace too small: need %zu have %zu\n", off, ws_size); return; }
  void* args[] = {&p};
  hipError_t e = hipLaunchCooperativeKernel((void*)mega, dim3(grid_blocks), dim3(256), args, 0, stream);
  if (e != hipSuccess) fprintf(stderr, "cooperative launch failed: %s (grid %d)\n", hipGetErrorString(e), grid_blocks);
}
```

```cpp
#include <hip/hip_runtime.h>
#include <hip/hip_bf16.h>
#include <hip/hip_cooperative_groups.h>
#include <cstdio>
#include <cstdint>
namespace cg = cooperative_groups;

typedef unsigned short u16;
using bf16x8 = __attribute__((ext_vector_type(8))) short;
using f32x16 = __attribute__((ext_vector_type(16))) float;

#define NTOK 17408
#define NLAT 16384
#define UW 4096
#define EPS 1e-6f

#ifndef PROBE_DUP
#define PROBE_DUP 0
#endif
#ifndef EN_HY
#define EN_HY 1
#endif
#ifndef EN_RG
#define EN_RG 1
#endif
#ifndef EN_HG
#define EN_HG 1
#endif
#ifndef EN_M2
#define EN_M2 1
#endif

struct P {
  const float *x, *c, *ctx, *c_ctx, *w_mod, *b_mod, *norm_w, *w_in, *w_out;
  const float *hy_conv_w, *hy_conv_b, *hy_w1, *hy_b1, *hy_w2, *hy_b2, *hy_w3, *hy_freq, *hy_skip;
  const float *rg_conv_w, *rg_conv_b, *rg_wa, *rg_ba, *rg_wx, *rg_bx, *rg_lam;
  const float *hg_lb, *hg_norm_w, *m2_conv_w, *m2_conv_b, *m2_dt_bias, *m2_a_log, *m2_d, *m2_norm_w, *final_norm_w;
  float* out;
  u16 *U, *HL, *Y2, *WT, *WoT, *KF, *KFC;
  float *XC, *DT, *MOD, *SUM;
};

typedef __bf16 bf2_t __attribute__((ext_vector_type(2)));
typedef float f2_t __attribute__((ext_vector_type(2)));
__device__ __forceinline__ uint32_t pack2(float a, float b) {
  f2_t v = {a, b};
  return __builtin_bit_cast(uint32_t, __builtin_convertvector(v, bf2_t));
}
__device__ __forceinline__ u16 f2bf(float f) { return (u16)(pack2(f, f) & 0xffffu); }
__device__ __forceinline__ float bf2f(u16 h) { return __uint_as_float(((uint32_t)h) << 16); }
__device__ __forceinline__ float bflo(uint32_t w) { return __uint_as_float(w << 16); }
__device__ __forceinline__ float bfhi(uint32_t w) { return __uint_as_float(w & 0xffff0000u); }
__device__ __forceinline__ float siluf(float x) { return x * __builtin_amdgcn_rcpf(1.f + __expf(-x)); }
__device__ __forceinline__ float sigmf(float x) { return __builtin_amdgcn_rcpf(1.f + __expf(-x)); }
__device__ __forceinline__ float softplusf(float x) { return x > 20.f ? x : log1pf(__expf(x)); }

__device__ __forceinline__ void unpack8(const uint4& v, float* f) {
  f[0] = bflo(v.x); f[1] = bfhi(v.x); f[2] = bflo(v.y); f[3] = bfhi(v.y);
  f[4] = bflo(v.z); f[5] = bfhi(v.z); f[6] = bflo(v.w); f[7] = bfhi(v.w);
}
__device__ __forceinline__ uint4 pack8(const float* f) {
  uint4 v; v.x = pack2(f[0], f[1]); v.y = pack2(f[2], f[3]); v.z = pack2(f[4], f[5]); v.w = pack2(f[6], f[7]);
  return v;
}
__device__ __forceinline__ float wave_sum(float v) {
#pragma unroll
  for (int o = 32; o >= 1; o >>= 1) v += __shfl_xor(v, o);
  return v;
}

__device__ __forceinline__ int pos2row_seq(int b, int p, int dir) {
  if (p < 256) { int t = dir ? 255 - p : p; return NLAT + b * 256 + t; }
  int j = p - 256; int t = dir ? 4095 - j : j; return b * 4096 + t;
}
__device__ __forceinline__ int pos2row_m2(int b, int p, int dir) {
  if (p < 256) { int t = dir ? 255 - p : p; return NLAT + b * 256 + t; }
  int j = p - 256; int jj = dir ? 4095 - j : j; int c = jj >> 6, r = jj & 63; return b * 4096 + r * 64 + c;
}

__device__ __forceinline__ void ph_mod(const P& p, int bid, int nb, float* sm) {
  const int tid = threadIdx.x;
  for (int task = bid; task < 96; task += nb) {
    int l = task / 48, cgi = task % 48;
    int col = cgi * 64 + (tid & 63);
    int kq = tid >> 6;
    float a0 = 0, a1 = 0, a2 = 0, a3 = 0, a4 = 0;
    for (int k = kq * 256; k < kq * 256 + 256; ++k) {
      float w = p.w_mod[((size_t)l * 1024 + k) * 3072 + col];
      a0 += siluf(p.c[k]) * w; a1 += siluf(p.c[1024 + k]) * w; a2 += siluf(p.c[2048 + k]) * w;
      a3 += siluf(p.c[3072 + k]) * w; a4 += siluf(p.c_ctx[k]) * w;
    }
    sm[(kq * 5 + 0) * 64 + (tid & 63)] = a0; sm[(kq * 5 + 1) * 64 + (tid & 63)] = a1;
    sm[(kq * 5 + 2) * 64 + (tid & 63)] = a2; sm[(kq * 5 + 3) * 64 + (tid & 63)] = a3;
    sm[(kq * 5 + 4) * 64 + (tid & 63)] = a4;
    __syncthreads();
    if (tid < 64) {
      float bm = p.b_mod[l * 3072 + col];
#pragma unroll
      for (int j = 0; j < 5; ++j) {
        float s = sm[(0 * 5 + j) * 64 + tid] + sm[(1 * 5 + j) * 64 + tid] + sm[(2 * 5 + j) * 64 + tid] + sm[(3 * 5 + j) * 64 + tid];
        p.MOD[(size_t)(l * 5 + j) * 3072 + col] = s + bm;
      }
    }
    __syncthreads();
  }
}

__device__ __forceinline__ void ph_norm(const P& p, int l, int bid, int nb) {
  const int tid = threadIdx.x, wave = tid >> 6, lane = tid & 63;
  for (int R = bid * 4 + wave; R < NTOK; R += nb * 4) {
    const float* src; int mj;
    if (R < NLAT) { src = (l == 0 ? p.x : (const float*)p.out) + (size_t)R * 1024; mj = R >> 12; }
    else { int rc = R - NLAT; src = (l == 0 ? p.ctx : (const float*)p.XC) + (size_t)rc * 1024; mj = 4; }
    const float* mod = p.MOD + (size_t)(l * 5 + mj) * 3072;
    float4 v[4]; float ss = 0;
#pragma unroll
    for (int i = 0; i < 4; ++i) {
      v[i] = ((const float4*)src)[lane + i * 64];
      ss += v[i].x * v[i].x + v[i].y * v[i].y + v[i].z * v[i].z + v[i].w * v[i].w;
    }
    ss = wave_sum(ss);
    float rinv = rsqrtf(ss * (1.f / 1024.f) + EPS);
#pragma unroll
    for (int i = 0; i < 4; ++i) {
      int idx = (lane + i * 64) * 4;
      float4 nw = *(const float4*)(p.norm_w + l * 1024 + idx);
      float4 sh = *(const float4*)(mod + idx);
      float4 sc = *(const float4*)(mod + 1024 + idx);
      float h0 = v[i].x * rinv * nw.x * (1.f + sc.x) + sh.x;
      float h1 = v[i].y * rinv * nw.y * (1.f + sc.y) + sh.y;
      float h2 = v[i].z * rinv * nw.z * (1.f + sc.z) + sh.z;
      float h3 = v[i].w * rinv * nw.w * (1.f + sc.w) + sh.w;
      uint2 o; o.x = pack2(h0, h1); o.y = pack2(h2, h3);
      *(uint2*)(p.HL + (size_t)R * 1024 + idx) = o;
    }
  }
}

__device__ __forceinline__ void ph_wconv(const P& p, int l, int bid, int nb, float* sm) {
  const int tid = threadIdx.x;
  const int T1 = 114 * 16, T2 = 16 * 32;
  for (int t = bid; t < T1 + T2; t += nb) {
    const float* src; int ld, K, n0, k0, sc0, nvalid; u16* dst;
    if (t < T1) {
      int nt = t / 16, kt = t % 16; n0 = nt * 64; k0 = kt * 64;
      src = p.w_in + (size_t)l * 1024 * 7176; ld = 7176; K = 1024; dst = p.WT; nvalid = 64;
      if (n0 < 2048) sc0 = 3072 + n0;
      else if (n0 < 3072) sc0 = 5632 + (n0 - 2048);
      else if (n0 < 3200) { sc0 = 6656 + (n0 - 3072); nvalid = (n0 == 3072) ? 8 : 0; }
      else { int m = n0 - 3200; if (m < 3072) sc0 = m; else if (m < 3584) sc0 = 5120 + (m - 3072); else sc0 = 6664 + (m - 3584); }
    } else {
      int tt = t - T1; int nt = tt / 32, kt = tt % 32; n0 = nt * 64; k0 = kt * 64;
      src = p.w_out + (size_t)l * 2048 * 1024; ld = 1024; K = 2048; dst = p.WoT; nvalid = 64; sc0 = n0;
    }
#pragma unroll
    for (int i = 0; i < 4; ++i) {
      int kk = (tid >> 4) + 16 * i, cc = (tid & 15) * 4;
      const float* sp = src + (size_t)(k0 + kk) * ld + sc0 + cc;
      float4 v;
      if (nvalid == 64) v = *(const float4*)sp;
      else { v.x = (cc + 0 < nvalid) ? sp[0] : 0.f; v.y = (cc + 1 < nvalid) ? sp[1] : 0.f; v.z = (cc + 2 < nvalid) ? sp[2] : 0.f; v.w = (cc + 3 < nvalid) ? sp[3] : 0.f; }
      sm[kk * 65 + cc + 0] = v.x; sm[kk * 65 + cc + 1] = v.y; sm[kk * 65 + cc + 2] = v.z; sm[kk * 65 + cc + 3] = v.w;
    }
    __syncthreads();
#pragma unroll
    for (int i = 0; i < 2; ++i) {
      int q = tid + 256 * i; int nn = q >> 3, ks = q & 7;
      float f[8];
#pragma unroll
      for (int j = 0; j < 8; ++j) f[j] = sm[(ks * 8 + j) * 65 + nn];
      *(uint4*)(dst + (size_t)(n0 + nn) * K + k0 + ks * 8) = pack8(f);
    }
    __syncthreads();
  }
}

__device__ __forceinline__ void ph_filt(const P& p, int l, int bid, int nb, float* sm) {
  const int tid = threadIdx.x;
  const float HY_MIN = -3.0701134573253945f, HY_MAX = -15.350567286626972f;
  int ntask = 256 + (l == 0 ? 16 : 0);
  float* zs = sm; float* h1 = sm + 544; float* h2 = sm + 544 + 1024;
  for (int task = bid; task < ntask; task += nb) {
    int n, t0; u16* K;
    if (task < 256) { n = 4096; t0 = task * 16; K = p.KF; } else { n = 256; t0 = (task - 256) * 16; K = p.KFC; }
    float inv_nm1 = 1.f / (float)(n - 1);
    for (int e = tid; e < 16 * 33; e += 256) {
      int tt = e / 33, f = e % 33; int t = t0 + tt; float val;
      if (f == 0) val = (float)t * inv_nm1;
      else {
        int bi = (f - 1) & 15;
        float band = 1e-4f + (float)bi * ((15.f - 1e-4f) / 15.f);
        float ang = (6.283185307179586f / (float)n) * (float)t * band;
        val = (f <= 16) ? cosf(ang) : -sinf(ang);
      }
      zs[e] = val;
    }
    __syncthreads();
    for (int e = tid; e < 1024; e += 256) {
      int tt = e >> 6, j = e & 63; float acc = p.hy_b1[l * 64 + j];
      for (int f = 0; f < 33; ++f) acc += zs[tt * 33 + f] * p.hy_w1[(l * 33 + f) * 64 + j];
      h1[e] = sinf(p.hy_freq[l * 64 + j] * acc);
    }
    __syncthreads();
    for (int e = tid; e < 1024; e += 256) {
      int tt = e >> 6, j = e & 63; float acc = p.hy_b2[l * 64 + j];
      for (int i = 0; i < 64; ++i) acc += h1[tt * 64 + i] * p.hy_w2[(l * 64 + i) * 64 + j];
      h2[e] = sinf(p.hy_freq[l * 64 + j] * acc);
    }
    __syncthreads();
    for (int r = 0; r < 8; ++r) {
      int col = tid + 256 * r; int o = col >> 10, side = (col >> 9) & 1, c = col & 511;
      float w[64];
#pragma unroll
      for (int i = 0; i < 64; ++i) w[i] = p.hy_w3[(size_t)(l * 64 + i) * 2048 + col];
      float delta = fabsf(HY_MIN + (HY_MAX - HY_MIN) * (float)c / 511.f);
      u16* Kc = K + (size_t)(o * 512 + c) * (2 * n);
      for (int tt = 0; tt < 16; ++tt) {
        float acc = 0;
#pragma unroll
        for (int i = 0; i < 64; ++i) acc += h2[tt * 64 + i] * w[i];
        int t = t0 + tt;
        float val = acc * __expf(-(float)t * inv_nm1 * delta);
        int idx;
        if (side == 0) idx = n - t; else { if (t == 0) { idx = 0; val = 0.f; } else idx = n + t; }
        Kc[idx] = f2bf(val);
      }
    }
    __syncthreads();
  }
}

#define LDSTR 72
template <int MODE>
__device__ __forceinline__ void gemm_tile(const P& p, int l, int mt, int nt, u16* sA, u16* sB) {
  const int tid = threadIdx.x, wave = tid >> 6, lane = tid & 63;
  const int wm = wave >> 1, wn = wave & 1;
  const int KT = (MODE == 2) ? 2048 : 1024;
  const u16* Bsrc = (MODE == 0) ? p.WT + (size_t)(nt * 128) * 1024
                  : (MODE == 1) ? p.WT + (size_t)(3200 + nt * 128) * 1024
                                : p.WoT + (size_t)(nt * 128) * 2048;
  f32x16 acc[2][2];
#pragma unroll
  for (int a = 0; a < 2; ++a)
#pragma unroll
    for (int b = 0; b < 2; ++b)
#pragma unroll
      for (int r = 0; r < 16; ++r) acc[a][b][r] = 0.f;

  uint4 ra0, ra1, ra2, ra3, rb0, rb1, rb2, rb3;
  const int lrow = tid >> 3, lseg = tid & 7;
#define GLOAD1(K0, I, RA, RB)                                                                       \
  {                                                                                                 \
    int row = lrow + 32 * (I); int k = (K0) + lseg * 8;                                             \
    const u16* ap;                                                                                  \
    if (MODE == 2) ap = (k < 1024) ? p.HL + (size_t)(mt * 128 + row) * 1024 + k                     \
                                   : p.Y2 + (size_t)(mt * 128 + row) * 1024 + (k - 1024);           \
    else ap = p.HL + (size_t)(mt * 128 + row) * 1024 + k;                                           \
    RA = *(const uint4*)ap;                                                                         \
    RB = *(const uint4*)(Bsrc + (size_t)row * KT + k);                                              \
  }
#define GLOAD(K0) GLOAD1(K0, 0, ra0, rb0) GLOAD1(K0, 1, ra1, rb1) GLOAD1(K0, 2, ra2, rb2) GLOAD1(K0, 3, ra3, rb3)
  GLOAD(0)
  for (int k0 = 0; k0 < KT; k0 += 64) {
    *(uint4*)(sA + (lrow + 0) * LDSTR + lseg * 8) = ra0;  *(uint4*)(sB + (lrow + 0) * LDSTR + lseg * 8) = rb0;
    *(uint4*)(sA + (lrow + 32) * LDSTR + lseg * 8) = ra1; *(uint4*)(sB + (lrow + 32) * LDSTR + lseg * 8) = rb1;
    *(uint4*)(sA + (lrow + 64) * LDSTR + lseg * 8) = ra2; *(uint4*)(sB + (lrow + 64) * LDSTR + lseg * 8) = rb2;
    *(uint4*)(sA + (lrow + 96) * LDSTR + lseg * 8) = ra3; *(uint4*)(sB + (lrow + 96) * LDSTR + lseg * 8) = rb3;
    __syncthreads();
    if (k0 + 64 < KT) { GLOAD(k0 + 64) }
#pragma unroll
    for (int ks = 0; ks < 4; ++ks) {
      bf16x8 fa[2], fb[2];
#pragma unroll
      for (int mi = 0; mi < 2; ++mi)
        fa[mi] = *(const bf16x8*)(sA + (wm * 64 + mi * 32 + (lane & 31)) * LDSTR + ks * 16 + (lane >> 5) * 8);
#pragma unroll
      for (int ni = 0; ni < 2; ++ni)
        fb[ni] = *(const bf16x8*)(sB + (wn * 64 + ni * 32 + (lane & 31)) * LDSTR + ks * 16 + (lane >> 5) * 8);
#pragma unroll
      for (int mi = 0; mi < 2; ++mi)
#pragma unroll
        for (int ni = 0; ni < 2; ++ni)
          acc[mi][ni] = __builtin_amdgcn_mfma_f32_32x32x16_bf16(fa[mi], fb[ni], acc[mi][ni], 0, 0, 0);
    }
    __syncthreads();
  }
  const int mj = (mt < 128) ? (mt >> 5) : 4;
#pragma unroll
  for (int ni = 0; ni < 2; ++ni) {
    const int col = wn * 64 + ni * 32 + (lane & 31);
    const int gcol = nt * 128 + col;
    float lb = 0.f; float gmod = 0.f;
    if (MODE == 0) {
      int piece = gcol >> 9;
      if (l == 1 && (piece == 1 || piece == 2)) {
        int dir = piece - 1, ch = gcol & 511;
        float l0 = p.hg_lb[(0 * 2 + dir) * 512 + ch], l1 = p.hg_lb[(1 * 2 + dir) * 512 + ch];
        lb = 1.f / (1.f + __expf(l0 - l1));
      }
    }
    if (MODE == 2) gmod = p.MOD[(size_t)(l * 5 + mj) * 3072 + 2048 + gcol];
#pragma unroll
    for (int mi = 0; mi < 2; ++mi) {
#pragma unroll
      for (int r = 0; r < 16; ++r) {
        const int row = wm * 64 + mi * 32 + (r & 3) + 8 * (r >> 2) + 4 * (lane >> 5);
        const int R = mt * 128 + row;
        float v = acc[mi][ni][r];
        if (MODE == 0) {
          if (nt < 24) {
            int piece = gcol >> 9;
            if (piece == 0) v *= 0.08838834764831845f;
            else if (piece == 1 || piece == 2) v = (1.f - lb) * __builtin_amdgcn_rcpf(1.f + __expf(v));
            p.U[(size_t)R * UW + gcol] = f2bf(v);
          } else {
            if (col < 8) p.DT[(size_t)R * 8 + col] = v;
          }
        } else if (MODE == 1) {
          int piece = gcol >> 9;
          if (piece == 3 || piece >= 5) v = siluf(v);
          if (nt >= 16) p.U[(size_t)NTOK * 2048 + (size_t)R * 2048 + (gcol - 2048)] = f2bf(v);
          else acc[mi][ni][r] = v;
        } else {
          if (R < NLAT) {
            const float* base = (l == 0) ? p.x : (const float*)p.out;
            float xv = base[(size_t)R * 1024 + gcol];
            p.out[(size_t)R * 1024 + gcol] = xv + gmod * v;
          } else {
            int rc = R - NLAT;
            p.XC[(size_t)rc * 1024 + gcol] = p.ctx[(size_t)rc * 1024 + gcol] + gmod * v;
          }
        }
      }
      if (MODE == 1 && nt < 16) {
#pragma unroll
        for (int g4 = 0; g4 < 4; ++g4) {
          int R0 = mt * 128 + wm * 64 + mi * 32 + 8 * g4 + 4 * (lane >> 5);
          uint2 o; o.x = pack2(acc[mi][ni][4 * g4], acc[mi][ni][4 * g4 + 1]); o.y = pack2(acc[mi][ni][4 * g4 + 2], acc[mi][ni][4 * g4 + 3]);
          *(uint2*)(p.U + (size_t)gcol * NTOK + R0) = o;
        }
      }
    }
  }
}

template <int MODE>
__device__ __forceinline__ void ph_gemm(const P& p, int l, int bid, int nb, u16* sm) {
  const int NT = (MODE == 0) ? 25 : (MODE == 1) ? 32 : 8;
  const int MT = (MODE == 2 && l == 1) ? 128 : 136;
  u16* sA = sm; u16* sB = sm + 128 * LDSTR;
  for (int t = bid; t < MT * NT; t += nb) {
    int nt = t / MT, mt = t % MT;
    gemm_tile<MODE>(p, l, mt, nt, sA, sB);
  }
}

__device__ __forceinline__ void hg_task(const P& p, int l, int task, float* sm) {
  const int tid = threadIdx.x, wave = tid >> 6, lane = tid & 63;
  const int b = task >> 5, h = (task >> 3) & 3, es = task & 7;
  const int dg = lane & 15, el = lane >> 4;
  float* qs = sm; float* ks = sm + 4096; float* vs = sm + 8192; float* os = sm + 8192 + 512;
  for (int dir = 0; dir < 2; ++dir) {
    float S[8];
#pragma unroll
    for (int r = 0; r < 8; ++r) S[r] = 0.f;
    for (int chunk = 0; chunk < 136; ++chunk) {
#pragma unroll
      for (int i = 0; i < 2; ++i) {
        int q = tid + 256 * i; int pos = q >> 4, seg = q & 15;
        int R = pos2row_seq(b, chunk * 32 + pos, dir);
        const u16* up = p.U + (size_t)R * UW + h * 128 + seg * 8;
        uint4 qv = *(const uint4*)up;
        uint4 kv = *(const uint4*)(up + 512 + dir * 512);
        float f[8];
        unpack8(qv, f);
        *(float4*)(qs + pos * 128 + seg * 8) = make_float4(f[0], f[1], f[2], f[3]);
        *(float4*)(qs + pos * 128 + seg * 8 + 4) = make_float4(f[4], f[5], f[6], f[7]);
        unpack8(kv, f);
        *(float4*)(ks + pos * 128 + seg * 8) = make_float4(f[0], f[1], f[2], f[3]);
        *(float4*)(ks + pos * 128 + seg * 8 + 4) = make_float4(f[4], f[5], f[6], f[7]);
      }
      {
        int pos = tid >> 3, e2 = (tid & 7) * 2;
        int R = pos2row_seq(b, chunk * 32 + pos, dir);
        uint32_t w = *(const uint32_t*)(p.U + (size_t)R * UW + 1536 + h * 128 + es * 16 + e2);
        vs[pos * 16 + e2] = bflo(w); vs[pos * 16 + e2 + 1] = bfhi(w);
      }
      __syncthreads();
#pragma unroll 4
      for (int i = 0; i < 32; ++i) {
        float4 q0 = *(const float4*)(qs + i * 128 + dg * 8), q1 = *(const float4*)(qs + i * 128 + dg * 8 + 4);
        float4 k0 = *(const float4*)(ks + i * 128 + dg * 8), k1 = *(const float4*)(ks + i * 128 + dg * 8 + 4);
        float v = vs[i * 16 + wave * 4 + el];
        S[0] += k0.x * (v - S[0]); S[1] += k0.y * (v - S[1]); S[2] += k0.z * (v - S[2]); S[3] += k0.w * (v - S[3]);
        S[4] += k1.x * (v - S[4]); S[5] += k1.y * (v - S[5]); S[6] += k1.z * (v - S[6]); S[7] += k1.w * (v - S[7]);
        float o = q0.x * S[0] + q0.y * S[1] + q0.z * S[2] + q0.w * S[3] + q1.x * S[4] + q1.y * S[5] + q1.z * S[6] + q1.w * S[7];
        o += __shfl_xor(o, 1); o += __shfl_xor(o, 2); o += __shfl_xor(o, 4); o += __shfl_xor(o, 8);
        if (dg == 0) os[i * 16 + wave * 4 + el] = o;
      }
      __syncthreads();
      {
        int pos = tid >> 3, e2 = (tid & 7) * 2;
        int R = pos2row_seq(b, chunk * 32 + pos, dir);
        uint32_t* yp = (uint32_t*)(p.Y2 + (size_t)R * 1024 + h * 128 + es * 16 + e2);
        float o0 = os[pos * 16 + e2], o1 = os[pos * 16 + e2 + 1];
        if (dir == 1) { uint32_t w = *yp; o0 += bflo(w); o1 += bfhi(w); }
        *yp = pack2(o0, o1);
      }
    }
    __threadfence();
    __syncthreads();
  }
}

__device__ __forceinline__ void m2_task(const P& p, int l, int task, float* sm) {
  const int tid = threadIdx.x, wave = tid >> 6, lane = tid & 63;
  const int b = task >> 5, head = (task >> 2) & 7, ps = task & 3;
  const int g = head >> 2;
  const int dg = lane & 15, el = lane >> 4;
  float* Cs = sm; float* Bs = sm + 4096; float* xs = sm + 8192; float* os = sm + 8192 + 512;
  float* dts = sm + 8192 + 1024; float* decs = dts + 32;
  for (int dir = 0; dir < 2; ++dir) {
    const float* cw = p.m2_conv_w + (size_t)(l * 2 + dir) * 4 * 1024;
    const float* cb = p.m2_conv_b + (size_t)(l * 2 + dir) * 1024;
    const float dtb = p.m2_dt_bias[(l * 2 + dir) * 8 + head];
    const float Aneg = -__expf(p.m2_a_log[(l * 2 + dir) * 8 + head]);
    const float Dsk = p.m2_d[(l * 2 + dir) * 8 + head];
    float S[8];
#pragma unroll
    for (int r = 0; r < 8; ++r) S[r] = 0.f;
    for (int chunk = 0; chunk < 136; ++chunk) {
      const int pbase = chunk * 32;
      const int seg0 = (pbase < 256) ? 0 : 256;
#pragma unroll
      for (int i = 0; i < 2; ++i) {
        int q = tid + 256 * i; int pos = q >> 4, seg = q & 15;
        int pp = pbase + pos;
        int chB = 512 + g * 128 + seg * 8, chC = 768 + g * 128 + seg * 8;
        float aB[8], aC[8];
#pragma unroll
        for (int j = 0; j < 8; ++j) { aB[j] = cb[chB + j]; aC[j] = cb[chC + j]; }
#pragma unroll
        for (int tap = 0; tap < 4; ++tap) {
          int pt = pp - 3 + tap;
          if (pt >= seg0) {
            int R = pos2row_m2(b, pt, dir);
            const u16* up = p.U + (size_t)R * UW + 2048;
            uint4 bv = *(const uint4*)(up + chB);
            uint4 cv = *(const uint4*)(up + chC);
            float f[8];
            unpack8(bv, f);
#pragma unroll
            for (int j = 0; j < 8; ++j) aB[j] += cw[tap * 1024 + chB + j] * f[j];
            unpack8(cv, f);
#pragma unroll
            for (int j = 0; j < 8; ++j) aC[j] += cw[tap * 1024 + chC + j] * f[j];
          }
        }
#pragma unroll
        for (int j = 0; j < 8; ++j) { aB[j] = siluf(aB[j]); aC[j] = siluf(aC[j]); }
        *(float4*)(Bs + pos * 128 + seg * 8) = make_float4(aB[0], aB[1], aB[2], aB[3]);
        *(float4*)(Bs + pos * 128 + seg * 8 + 4) = make_float4(aB[4], aB[5], aB[6], aB[7]);
        *(float4*)(Cs + pos * 128 + seg * 8) = make_float4(aC[0], aC[1], aC[2], aC[3]);
        *(float4*)(Cs + pos * 128 + seg * 8 + 4) = make_float4(aC[4], aC[5], aC[6], aC[7]);
      }
      {
        int pos = tid >> 3, e2 = (tid & 7) * 2;
        int pp = pbase + pos;
        int ch = head * 64 + ps * 16 + e2;
        float a0 = cb[ch], a1 = cb[ch + 1];
#pragma unroll
        for (int tap = 0; tap < 4; ++tap) {
          int pt = pp - 3 + tap;
          if (pt >= seg0) {
            int R = pos2row_m2(b, pt, dir);
            uint32_t w = *(const uint32_t*)(p.U + (size_t)R * UW + 2048 + ch);
            a0 += cw[tap * 1024 + ch] * bflo(w); a1 += cw[tap * 1024 + ch + 1] * bfhi(w);
          }
        }
        xs[pos * 16 + e2] = siluf(a0); xs[pos * 16 + e2 + 1] = siluf(a1);
      }
      if (tid < 32) {
        int R = pos2row_m2(b, pbase + tid, dir);
        float dtv = softplusf(p.DT[(size_t)R * 8 + head] + dtb);
        dts[tid] = dtv; decs[tid] = __expf(dtv * Aneg);
      }
      __syncthreads();
#pragma unroll 4
      for (int i = 0; i < 32; ++i) {
        float4 q0 = *(const float4*)(Cs + i * 128 + dg * 8), q1 = *(const float4*)(Cs + i * 128 + dg * 8 + 4);
        float4 k0 = *(const float4*)(Bs + i * 128 + dg * 8), k1 = *(const float4*)(Bs + i * 128 + dg * 8 + 4);
        float xv = xs[i * 16 + wave * 4 + el];
        float a = decs[i]; float v = xv * dts[i];
        S[0] = a * S[0] + k0.x * v; S[1] = a * S[1] + k0.y * v; S[2] = a * S[2] + k0.z * v; S[3] = a * S[3] + k0.w * v;
        S[4] = a * S[4] + k1.x * v; S[5] = a * S[5] + k1.y * v; S[6] = a * S[6] + k1.z * v; S[7] = a * S[7] + k1.w * v;
        float o = q0.x * S[0] + q0.y * S[1] + q0.z * S[2] + q0.w * S[3] + q1.x * S[4] + q1.y * S[5] + q1.z * S[6] + q1.w * S[7];
        o += __shfl_xor(o, 1); o += __shfl_xor(o, 2); o += __shfl_xor(o, 4); o += __shfl_xor(o, 8);
        if (dg == 0) os[i * 16 + wave * 4 + el] = o + Dsk * xv;
      }
      __syncthreads();
      {
        int pos = tid >> 3, e2 = (tid & 7) * 2;
        int R = pos2row_m2(b, pbase + pos, dir);
        uint32_t* yp = (uint32_t*)(p.Y2 + (size_t)R * 1024 + 512 + head * 64 + ps * 16 + e2);
        float o0 = os[pos * 16 + e2], o1 = os[pos * 16 + e2 + 1];
        if (dir == 1) { uint32_t w = *yp; o0 += bflo(w); o1 += bfhi(w); }
        *yp = pack2(o0, o1);
      }
    }
    __threadfence();
    __syncthreads();
  }
}

#ifndef M2_MFMA
#define M2_MFMA 1
#endif
#define QS 136
#define TS 40
union FragU { bf16x8 v; uint32_t u[4]; uint2 d[2]; uint4 q; };
__device__ __forceinline__ bf16x8 cvt_frag(const f32x16& x, int s2) {
  FragU f;
  f.u[0] = pack2(x[8 * s2 + 0], x[8 * s2 + 1]); f.u[1] = pack2(x[8 * s2 + 2], x[8 * s2 + 3]);
  f.u[2] = pack2(x[8 * s2 + 4], x[8 * s2 + 5]); f.u[3] = pack2(x[8 * s2 + 6], x[8 * s2 + 7]);
  return f.v;
}
__device__ __forceinline__ bf16x8 ld_frag_perm(const u16* base) {
  FragU f; f.d[0] = *(const uint2*)base; f.d[1] = *(const uint2*)(base + 8); return f.v;
}

__device__ __forceinline__ void hg_mfma(const P& p, int l, int task, unsigned char* smem) {
  const int tid = threadIdx.x, wave = tid >> 6, lane = tid & 63;
  const int r = lane & 31, hh = lane >> 5;
  const int b = task >> 2, h = task & 3;
  u16* ks = (u16*)smem;
  u16* qs = ks + 32 * QS;
  u16* kT = qs + 32 * QS;
  u16* vT = kT + 128 * TS;
  float* tot = (float*)(vT + 128 * TS);
  float* eg = tot + 256;
  const int dd = tid & 127, half = tid >> 7;
  for (int dir = 0; dir < 2; ++dir) {
    f32x16 S[4];
#pragma unroll
    for (int i = 0; i < 4; ++i)
#pragma unroll
      for (int q = 0; q < 16; ++q) S[i][q] = 0.f;
    uint4 pq0, pq1, pk0, pk1, pv0, pv1;
#define HG_PREFETCH(CH)                                                                     \
    {                                                                                       \
      int pos0 = tid >> 4, seg = tid & 15;                                                  \
      int R0 = pos2row_seq(b, (CH) * 32 + pos0, dir), R1 = pos2row_seq(b, (CH) * 32 + pos0 + 16, dir); \
      const u16* u0 = p.U + (size_t)R0 * UW + h * 128 + seg * 8;                            \
      const u16* u1 = p.U + (size_t)R1 * UW + h * 128 + seg * 8;                            \
      pq0 = *(const uint4*)u0; pq1 = *(const uint4*)u1;                                     \
      pk0 = *(const uint4*)(u0 + 512 + dir * 512); pk1 = *(const uint4*)(u1 + 512 + dir * 512); \
      pv0 = *(const uint4*)(u0 + 1536); pv1 = *(const uint4*)(u1 + 1536);                   \
    }
    HG_PREFETCH(0)
#pragma unroll 1
    for (int chunk = 0; chunk < 136; ++chunk) {
      {
        int pos0 = tid >> 4, seg = tid & 15;
        *(uint4*)(qs + pos0 * QS + seg * 8) = pq0; *(uint4*)(qs + (pos0 + 16) * QS + seg * 8) = pq1;
        *(uint4*)(ks + pos0 * QS + seg * 8) = pk0; *(uint4*)(ks + (pos0 + 16) * QS + seg * 8) = pk1;
        FragU f0, f1; f0.q = pv0; f1.q = pv1;
#pragma unroll
        for (int j = 0; j < 4; ++j) {
          vT[(seg * 8 + 2 * j) * TS + pos0] = (u16)(f0.u[j] & 0xffffu); vT[(seg * 8 + 2 * j + 1) * TS + pos0] = (u16)(f0.u[j] >> 16);
          vT[(seg * 8 + 2 * j) * TS + pos0 + 16] = (u16)(f1.u[j] & 0xffffu); vT[(seg * 8 + 2 * j + 1) * TS + pos0 + 16] = (u16)(f1.u[j] >> 16);
        }
      }
      __syncthreads();
      if (chunk + 1 < 136) HG_PREFETCH(chunk + 1)
      const int Rout = pos2row_seq(b, chunk * 32 + r, dir);
      u16* yrow = p.Y2 + (size_t)Rout * 1024 + h * 128 + wave * 32 + 4 * hh;
      uint2 yold[4];
      if (dir == 1) {
#pragma unroll
        for (int q4 = 0; q4 < 4; ++q4) yold[q4] = *(const uint2*)(yrow + 8 * q4);
      }
      float gl[16];
      {
        float run = 0.f;
#pragma unroll
        for (int i = 0; i < 16; ++i) {
          float kkv = bf2f(ks[(half * 16 + i) * QS + dd]);
          run += __logf(fmaxf(1.f - kkv, 1e-6f));
          gl[i] = run;
        }
        tot[half * 128 + dd] = run;
      }
      __syncthreads();
      {
        const float t0 = tot[dd], t1 = tot[128 + dd];
        const float off = half ? t0 : 0.f;
        const float g31 = t0 + t1;
        float k2[16];
#pragma unroll
        for (int i = 0; i < 16; ++i) {
          const int pos = half * 16 + i;
          const float g = gl[i] + off;
          const float kkv = bf2f(ks[pos * QS + dd]);
          const float qv = bf2f(qs[pos * QS + dd]);
          qs[pos * QS + dd] = f2bf(qv * __expf(g));
          ks[pos * QS + dd] = f2bf(kkv * __expf(fminf(-g, 60.f)));
          k2[i] = kkv * __expf(g31 - g);
        }
        *(uint4*)(kT + dd * TS + half * 16) = pack8(k2);
        *(uint4*)(kT + dd * TS + half * 16 + 8) = pack8(k2 + 8);
        if (half == 0) eg[dd] = __expf(g31);
      }
      __syncthreads();
      f32x16 att;
#pragma unroll
      for (int q = 0; q < 16; ++q) att[q] = 0.f;
#pragma unroll
      for (int k8 = 0; k8 < 8; ++k8) {
        bf16x8 A = *(const bf16x8*)(ks + r * QS + 16 * k8 + 8 * hh);
        bf16x8 B = *(const bf16x8*)(qs + r * QS + 16 * k8 + 8 * hh);
        att = __builtin_amdgcn_mfma_f32_32x32x16_bf16(A, B, att, 0, 0, 0);
      }
#pragma unroll
      for (int q = 0; q < 16; ++q) {
        int sidx = (q & 3) + 8 * (q >> 2) + 4 * hh;
        if (sidx > r) att[q] = 0.f;
      }
      f32x16 O;
#pragma unroll
      for (int q = 0; q < 16; ++q) O[q] = 0.f;
#pragma unroll
      for (int dt = 0; dt < 4; ++dt)
#pragma unroll
        for (int s2 = 0; s2 < 2; ++s2) {
          bf16x8 A = cvt_frag(S[dt], s2);
          bf16x8 B = ld_frag_perm(qs + r * QS + 32 * dt + 16 * s2 + 4 * hh);
          O = __builtin_amdgcn_mfma_f32_32x32x16_bf16(A, B, O, 0, 0, 0);
        }
#pragma unroll
      for (int s2 = 0; s2 < 2; ++s2) {
        bf16x8 A = ld_frag_perm(vT + (32 * wave + r) * TS + 16 * s2 + 4 * hh);
        bf16x8 B = cvt_frag(att, s2);
        O = __builtin_amdgcn_mfma_f32_32x32x16_bf16(A, B, O, 0, 0, 0);
      }
#pragma unroll
      for (int dt = 0; dt < 4; ++dt) {
#pragma unroll
        for (int q4 = 0; q4 < 4; ++q4) {
          float4 e4 = *(const float4*)(eg + 32 * dt + 8 * q4 + 4 * hh);
          S[dt][4 * q4 + 0] *= e4.x; S[dt][4 * q4 + 1] *= e4.y; S[dt][4 * q4 + 2] *= e4.z; S[dt][4 * q4 + 3] *= e4.w;
        }
#pragma unroll
        for (int s2 = 0; s2 < 2; ++s2) {
          bf16x8 A = *(const bf16x8*)(kT + (32 * dt + r) * TS + 16 * s2 + 8 * hh);
          bf16x8 B = *(const bf16x8*)(vT + (32 * wave + r) * TS + 16 * s2 + 8 * hh);
          S[dt] = __builtin_amdgcn_mfma_f32_32x32x16_bf16(A, B, S[dt], 0, 0, 0);
        }
      }
#pragma unroll
      for (int q4 = 0; q4 < 4; ++q4) {
        float o0 = O[4 * q4], o1 = O[4 * q4 + 1], o2 = O[4 * q4 + 2], o3 = O[4 * q4 + 3];
        if (dir == 1) { o0 += bflo(yold[q4].x); o1 += bfhi(yold[q4].x); o2 += bflo(yold[q4].y); o3 += bfhi(yold[q4].y); }
        uint2 ov; ov.x = pack2(o0, o1); ov.y = pack2(o2, o3);
        *(uint2*)(yrow + 8 * q4) = ov;
      }
      __syncthreads();
    }
    __threadfence();
    __syncthreads();
  }
}

#if M2_MFMA
#define M2_NTASK 16
__device__ __forceinline__ void m2_mfma(const P& p, int l, int task, unsigned char* smem) {
  const int tid = threadIdx.x, wave = tid >> 6, lane = tid & 63;
  const int r = lane & 31, hh = lane >> 5;
  const int b = task >> 2, g = (task >> 1) & 1, hp = task & 1;
  const int hq = wave >> 1, ph = wave & 1;
  const int head = 4 * g + 2 * hp + hq;
  u16* Bm = (u16*)smem;
  u16* Cm = Bm + 32 * QS;
  u16* BmT = Cm + 32 * QS;
  u16* xsT = BmT + 128 * TS;
  float* Gs = (float*)(xsT + 128 * TS);
  float* dts = Gs + 64;
  float* wl = dts + 64;
  const int cp = (lane < 48) ? lane : 47;
  const bool act = lane < 48;
  const int chW = (cp < 16) ? ((4 * g + 2 * hp) * 64 + cp * 8) : (cp < 32) ? (512 + g * 128 + (cp - 16) * 8) : (768 + g * 128 + (cp - 32) * 8);
  const int chU = 2048 + chW;
  for (int dir = 0; dir < 2; ++dir) {
    const float* cw = p.m2_conv_w + (size_t)(l * 2 + dir) * 4 * 1024;
    const float* cb = p.m2_conv_b + (size_t)(l * 2 + dir) * 1024;
    if (wave == 0) {
#pragma unroll
      for (int j = 0; j < 8; ++j) {
        wl[(4 * 8 + j) * 64 + lane] = cb[chW + j];
#pragma unroll
        for (int tap = 0; tap < 4; ++tap) wl[(tap * 8 + j) * 64 + lane] = cw[tap * 1024 + chW + j];
      }
    }
    __syncthreads();
    const int hd_t = 4 * g + 2 * hp + ((tid >> 5) & 1);
    const float dtb = p.m2_dt_bias[(l * 2 + dir) * 8 + hd_t];
    const float Aneg_t = -__expf(p.m2_a_log[(l * 2 + dir) * 8 + hd_t]);
    const float Dsk = p.m2_d[(l * 2 + dir) * 8 + head];
    f32x16 S[4];
#pragma unroll
    for (int i = 0; i < 4; ++i)
#pragma unroll
      for (int q = 0; q < 16; ++q) S[i][q] = 0.f;
    uint4 raw0, raw1, raw2, raw3, raw4, raw5, raw6, raw7, raw8, raw9, raw10;
    float dtraw = 0.f;
#define M2_LD1(RW, I, CH)                                                                  \
    {                                                                                      \
      int pt = (CH) * 32 + wave * 8 + (I) - 3;                                             \
      int sg0 = ((CH) * 32 < 256) ? 0 : 256;                                               \
      if (pt >= sg0) { int Rr = pos2row_m2(b, pt, dir); RW = *(const uint4*)(p.U + (size_t)Rr * UW + chU); } \
      else RW = make_uint4(0u, 0u, 0u, 0u);                                                \
    }
#define M2_PREFETCH(CH)                                                                    \
    M2_LD1(raw0, 0, CH) M2_LD1(raw1, 1, CH) M2_LD1(raw2, 2, CH) M2_LD1(raw3, 3, CH) M2_LD1(raw4, 4, CH) M2_LD1(raw5, 5, CH) \
    M2_LD1(raw6, 6, CH) M2_LD1(raw7, 7, CH) M2_LD1(raw8, 8, CH) M2_LD1(raw9, 9, CH) M2_LD1(raw10, 10, CH)            \
    if (tid < 64) { int Rr = pos2row_m2(b, (CH) * 32 + (tid & 31), dir); dtraw = p.DT[(size_t)Rr * 8 + hd_t]; }
    M2_PREFETCH(0)
#pragma unroll 1
    for (int chunk = 0; chunk < 136; ++chunk) {
      {
#define M2_RAWF(RW, J) (((J) & 1) ? bfhi((RW)) : bflo((RW)))
#define M2_CH(J, C0, C1, C2, C3, C4, C5, C6, C7, C8, C9, C10)                               \
        {                                                                                  \
          const float q0 = wl[(0 * 8 + (J)) * 64 + lane], q1 = wl[(1 * 8 + (J)) * 64 + lane]; \
          const float q2 = wl[(2 * 8 + (J)) * 64 + lane], q3 = wl[(3 * 8 + (J)) * 64 + lane]; \
          const float qb = wl[(4 * 8 + (J)) * 64 + lane];                                  \
          const float v0 = M2_RAWF(C0, J), v1 = M2_RAWF(C1, J), v2 = M2_RAWF(C2, J), v3 = M2_RAWF(C3, J); \
          const float v4 = M2_RAWF(C4, J), v5 = M2_RAWF(C5, J), v6 = M2_RAWF(C6, J), v7 = M2_RAWF(C7, J); \
          const float v8 = M2_RAWF(C8, J), v9 = M2_RAWF(C9, J), v10 = M2_RAWF(C10, J);      \
          float o[8];                                                                      \
          o[0] = siluf(qb + q0 * v0 + q1 * v1 + q2 * v2 + q3 * v3);                        \
          o[1] = siluf(qb + q0 * v1 + q1 * v2 + q2 * v3 + q3 * v4);                        \
          o[2] = siluf(qb + q0 * v2 + q1 * v3 + q2 * v4 + q3 * v5);                        \
          o[3] = siluf(qb + q0 * v3 + q1 * v4 + q2 * v5 + q3 * v6);                        \
          o[4] = siluf(qb + q0 * v4 + q1 * v5 + q2 * v6 + q3 * v7);                        \
          o[5] = siluf(qb + q0 * v5 + q1 * v6 + q2 * v7 + q3 * v8);                        \
          o[6] = siluf(qb + q0 * v6 + q1 * v7 + q2 * v8 + q3 * v9);                        \
          o[7] = siluf(qb + q0 * v7 + q1 * v8 + q2 * v9 + q3 * v10);                       \
          if (act) {                                                                       \
            if (cp < 16) {                                                                 \
              *(uint4*)(xsT + (cp * 8 + (J)) * TS + wave * 8) = pack8(o);                  \
            } else if (cp < 32) {                                                          \
              *(uint4*)(BmT + ((cp - 16) * 8 + (J)) * TS + wave * 8) = pack8(o);           \
              _Pragma("unroll") for (int i = 0; i < 8; ++i) Bm[(wave * 8 + i) * QS + (cp - 16) * 8 + (J)] = f2bf(o[i]); \
            } else {                                                                       \
              _Pragma("unroll") for (int i = 0; i < 8; ++i) Cm[(wave * 8 + i) * QS + (cp - 32) * 8 + (J)] = f2bf(o[i]); \
            }                                                                              \
          }                                                                                \
        }
        M2_CH(0, raw0.x, raw1.x, raw2.x, raw3.x, raw4.x, raw5.x, raw6.x, raw7.x, raw8.x, raw9.x, raw10.x)
        M2_CH(1, raw0.x, raw1.x, raw2.x, raw3.x, raw4.x, raw5.x, raw6.x, raw7.x, raw8.x, raw9.x, raw10.x)
        M2_CH(2, raw0.y, raw1.y, raw2.y, raw3.y, raw4.y, raw5.y, raw6.y, raw7.y, raw8.y, raw9.y, raw10.y)
        M2_CH(3, raw0.y, raw1.y, raw2.y, raw3.y, raw4.y, raw5.y, raw6.y, raw7.y, raw8.y, raw9.y, raw10.y)
        M2_CH(4, raw0.z, raw1.z, raw2.z, raw3.z, raw4.z, raw5.z, raw6.z, raw7.z, raw8.z, raw9.z, raw10.z)
        M2_CH(5, raw0.z, raw1.z, raw2.z, raw3.z, raw4.z, raw5.z, raw6.z, raw7.z, raw8.z, raw9.z, raw10.z)
        M2_CH(6, raw0.w, raw1.w, raw2.w, raw3.w, raw4.w, raw5.w, raw6.w, raw7.w, raw8.w, raw9.w, raw10.w)
        M2_CH(7, raw0.w, raw1.w, raw2.w, raw3.w, raw4.w, raw5.w, raw6.w, raw7.w, raw8.w, raw9.w, raw10.w)
      }
      if (tid < 64) {
        float dtv = softplusf(dtraw + dtb);
        float run = dtv * Aneg_t;
#pragma unroll
        for (int o = 1; o < 32; o <<= 1) { float n = __shfl_up(run, o, 32); if ((tid & 31) >= o) run += n; }
        Gs[tid] = run; dts[tid] = dtv;
      }
      __syncthreads();
      if (chunk + 1 < 136) { M2_PREFETCH(chunk + 1) }
      const int Rout = pos2row_m2(b, chunk * 32 + r, dir);
      u16* yrow = p.Y2 + (size_t)Rout * 1024 + 512 + head * 64 + 32 * ph + 4 * hh;
      uint2 yold[4];
      if (dir == 1) {
#pragma unroll
        for (int i = 0; i < 4; ++i) yold[i] = *(const uint2*)(yrow + 8 * i);
      }
      const float* Gw = Gs + hq * 32; const float* dw = dts + hq * 32;
      const float Gt = Gw[r], G31 = Gw[31];
      f32x16 att;
#pragma unroll
      for (int q = 0; q < 16; ++q) att[q] = 0.f;
#pragma unroll
      for (int k8 = 0; k8 < 8; ++k8) {
        bf16x8 A = *(const bf16x8*)(Bm + r * QS + 16 * k8 + 8 * hh);
        bf16x8 B = *(const bf16x8*)(Cm + r * QS + 16 * k8 + 8 * hh);
        att = __builtin_amdgcn_mfma_f32_32x32x16_bf16(A, B, att, 0, 0, 0);
      }
#pragma unroll
      for (int q4 = 0; q4 < 4; ++q4) {
        float4 gs4 = *(const float4*)(Gw + 8 * q4 + 4 * hh);
        float4 dt4 = *(const float4*)(dw + 8 * q4 + 4 * hh);
        int s0 = 8 * q4 + 4 * hh;
        att[4 * q4 + 0] = (s0 + 0 <= r) ? att[4 * q4 + 0] * __expf(Gt - gs4.x) * dt4.x : 0.f;
        att[4 * q4 + 1] = (s0 + 1 <= r) ? att[4 * q4 + 1] * __expf(Gt - gs4.y) * dt4.y : 0.f;
        att[4 * q4 + 2] = (s0 + 2 <= r) ? att[4 * q4 + 2] * __expf(Gt - gs4.z) * dt4.z : 0.f;
        att[4 * q4 + 3] = (s0 + 3 <= r) ? att[4 * q4 + 3] * __expf(Gt - gs4.w) * dt4.w : 0.f;
      }
      f32x16 O0;
#pragma unroll
      for (int q = 0; q < 16; ++q) O0[q] = 0.f;
#pragma unroll
      for (int nt = 0; nt < 4; ++nt)
#pragma unroll
        for (int s2 = 0; s2 < 2; ++s2) {
          bf16x8 B = ld_frag_perm(Cm + r * QS + 32 * nt + 16 * s2 + 4 * hh);
          O0 = __builtin_amdgcn_mfma_f32_32x32x16_bf16(cvt_frag(S[nt], s2), B, O0, 0, 0, 0);
        }
      {
        const float eGt = __expf(Gt);
#pragma unroll
        for (int q = 0; q < 16; ++q) O0[q] *= eGt;
      }
      const u16* xw = xsT + (hq * 64 + ph * 32) * TS;
#pragma unroll
      for (int s2 = 0; s2 < 2; ++s2) {
        bf16x8 B = cvt_frag(att, s2);
        O0 = __builtin_amdgcn_mfma_f32_32x32x16_bf16(ld_frag_perm(xw + r * TS + 16 * s2 + 4 * hh), B, O0, 0, 0, 0);
      }
#pragma unroll
      for (int q = 0; q < 16; ++q) {
        int pp = (q & 3) + 8 * (q >> 2) + 4 * hh;
        O0[q] += Dsk * bf2f(xw[pp * TS + r]);
      }
      {
        const float eG31 = __expf(G31);
#pragma unroll
        for (int nt = 0; nt < 4; ++nt)
#pragma unroll
          for (int q = 0; q < 16; ++q) S[nt][q] *= eG31;
#pragma unroll
        for (int s2 = 0; s2 < 2; ++s2) {
          float ws[8];
          {
            float4 ga = *(const float4*)(Gw + 16 * s2 + 8 * hh), gb = *(const float4*)(Gw + 16 * s2 + 8 * hh + 4);
            float4 da = *(const float4*)(dw + 16 * s2 + 8 * hh), db = *(const float4*)(dw + 16 * s2 + 8 * hh + 4);
            ws[0] = da.x * __expf(G31 - ga.x); ws[1] = da.y * __expf(G31 - ga.y); ws[2] = da.z * __expf(G31 - ga.z); ws[3] = da.w * __expf(G31 - ga.w);
            ws[4] = db.x * __expf(G31 - gb.x); ws[5] = db.y * __expf(G31 - gb.y); ws[6] = db.z * __expf(G31 - gb.z); ws[7] = db.w * __expf(G31 - gb.w);
          }
          bf16x8 Bf0;
          {
            float f[8]; unpack8(*(const uint4*)(xw + r * TS + 16 * s2 + 8 * hh), f);
#pragma unroll
            for (int j = 0; j < 8; ++j) f[j] *= ws[j];
            FragU u; u.q = pack8(f); Bf0 = u.v;
          }
#pragma unroll
          for (int nt = 0; nt < 4; ++nt) {
            bf16x8 A = *(const bf16x8*)(BmT + (32 * nt + r) * TS + 16 * s2 + 8 * hh);
            S[nt] = __builtin_amdgcn_mfma_f32_32x32x16_bf16(A, Bf0, S[nt], 0, 0, 0);
          }
        }
      }
#pragma unroll
      for (int q4 = 0; q4 < 4; ++q4) {
        float o0 = O0[4 * q4], o1 = O0[4 * q4 + 1], o2 = O0[4 * q4 + 2], o3 = O0[4 * q4 + 3];
        if (dir == 1) { o0 += bflo(yold[q4].x); o1 += bfhi(yold[q4].x); o2 += bflo(yold[q4].y); o3 += bfhi(yold[q4].y); }
        uint2 ov; ov.x = pack2(o0, o1); ov.y = pack2(o2, o3);
        *(uint2*)(yrow + 8 * q4) = ov;
      }
      __syncthreads();
    }
    __threadfence();
    __syncthreads();
  }
}
#endif
#ifndef M2_MFMA
#define M2_MFMA 0
#endif
__device__ __forceinline__ void ph_mixA(const P& p, int l, int bid, int nb, float* sm) {
#if M2_MFMA
  for (int t = bid; t < 16 + M2_NTASK; t += nb) {
    if (t < M2_NTASK) { if (EN_M2) m2_mfma(p, l, t, (unsigned char*)sm); }
    else { if (EN_HG) hg_mfma(p, l, t - M2_NTASK, (unsigned char*)sm); }
    __syncthreads();
  }
#else
  for (int t = bid; t < 16 + 128; t += nb) {
    if (t < 16) { if (EN_HG) hg_mfma(p, l, t, (unsigned char*)sm); }
    else { if (EN_M2) m2_task(p, l, t - 16, sm); }
    __syncthreads();
  }
#endif
}

template <int PASS>
__device__ __forceinline__ void rg_task(const P& p, int l, int task, float* sm) {
  const int tid = threadIdx.x;
  const int b = task / 136, rem = task % 136, head = rem / 17, sb = rem % 17;
  float* xc = sm; float* pa = sm + 2048; float* pb = sm + 4096;
  const int j = tid & 63, which = (tid >> 6) & 1, half = tid >> 7;
  for (int dir = 0; dir < 2; ++dir) {
    const int ld = l * 2 + dir;
    float w[64];
    {
      const float* wp = (which ? p.rg_wx : p.rg_wa) + (size_t)(ld * 8 + head) * 4096 + j;
#pragma unroll
      for (int i = 0; i < 64; ++i) w[i] = wp[i * 64];
    }
    const float* cw = p.rg_conv_w + (size_t)ld * 4 * 512;
    const float* cb = p.rg_conv_b + (size_t)ld * 512;
    const int sbd = (PASS == 0) ? sb : (dir ? (sb == 0 ? 0 : 17 - sb) : sb);
    float hcarry = 0.f, aprod = 1.f;
    if (PASS == 1 && tid < 64) {
      for (int q = 0; q < sbd; ++q) {
        const float* sp = p.SUM + ((((size_t)b * 2 + dir) * 17 + q) * 512 + head * 64 + tid) * 2;
        hcarry = sp[0] * hcarry + sp[1];
      }
    }
    for (int chunk = sbd * 8; chunk < sbd * 8 + 8; ++chunk) {
      const int pbase = chunk * 32;
      const int seg0 = (pbase < 256) ? 0 : 256;
      {
        int pos = tid >> 3, seg = tid & 7;
        int ch = head * 64 + seg * 8;
        float a[8];
#pragma unroll
        for (int jj = 0; jj < 8; ++jj) a[jj] = cb[ch + jj];
#pragma unroll
        for (int tap = 0; tap < 4; ++tap) {
          int pt = pbase + pos - 3 + tap;
          if (pt >= seg0) {
            int R = pos2row_seq(b, pt, dir);
            uint4 xv = *(const uint4*)(p.U + (size_t)NTOK * 2048 + (size_t)R * 2048 + ch);
            float f[8]; unpack8(xv, f);
#pragma unroll
            for (int jj = 0; jj < 8; ++jj) a[jj] += cw[tap * 512 + ch + jj] * f[jj];
          }
        }
        *(float4*)(xc + pos * 64 + seg * 8) = make_float4(a[0], a[1], a[2], a[3]);
        *(float4*)(xc + pos * 64 + seg * 8 + 4) = make_float4(a[4], a[5], a[6], a[7]);
      }
      __syncthreads();
      {
        float* dstp = which ? pb : pa;
        for (int pi = 0; pi < 16; ++pi) {
          int pos = half * 16 + pi;
          float acc = 0.f;
#pragma unroll
          for (int i4 = 0; i4 < 16; ++i4) {
            float4 xv = *(const float4*)(xc + pos * 64 + i4 * 4);
            acc += xv.x * w[i4 * 4] + xv.y * w[i4 * 4 + 1] + xv.z * w[i4 * 4 + 2] + xv.w * w[i4 * 4 + 3];
          }
          dstp[pos * 64 + j] = acc;
        }
      }
      __syncthreads();
#pragma unroll
      for (int i = 0; i < 8; ++i) {
        int e = tid + 256 * i; int ch = e & 63; int chg = head * 64 + ch;
        float r = sigmf(pa[e] + p.rg_ba[ld * 512 + chg]);
        float gi = sigmf(pb[e] + p.rg_bx[ld * 512 + chg]);
        float la = -8.0f * r * softplusf(-p.rg_lam[ld * 512 + chg]);
        float a = __expf(la);
        float bt = sqrtf(-expm1f(2.f * la)) * gi * xc[e];
        pa[e] = a; pb[e] = bt;
      }
      __syncthreads();
      if (tid < 64) {
        float hh = hcarry;
        for (int pos = 0; pos < 32; ++pos) { float av = pa[pos * 64 + tid]; hh = av * hh + pb[pos * 64 + tid]; pb[pos * 64 + tid] = hh; aprod *= av; }
        hcarry = hh;
      }
      __syncthreads();
      if (PASS == 1) {
        int pos = tid >> 3, seg = tid & 7;
        int R = pos2row_seq(b, pbase + pos, dir);
        int ch = head * 64 + seg * 8;
        uint4* yp = (uint4*)(p.HL + (size_t)R * 1024 + 512 + ch);
        float hv[8];
#pragma unroll
        for (int jj = 0; jj < 8; ++jj) hv[jj] = pb[pos * 64 + seg * 8 + jj];
        if (dir == 1) {
          uint4 prev = *yp; float f[8]; unpack8(prev, f);
          uint4 gv = *(const uint4*)(p.U + (size_t)NTOK * 2048 + (size_t)R * 2048 + 512 + ch); float gf[8]; unpack8(gv, gf);
#pragma unroll
          for (int jj = 0; jj < 8; ++jj) hv[jj] = (hv[jj] + f[jj]) * gf[jj];
        }
        *yp = pack8(hv);
      }
      __syncthreads();
    }
    if (PASS == 0 && tid < 64) {
      float* sp = p.SUM + ((((size_t)b * 2 + dir) * 17 + sbd) * 512 + head * 64 + tid) * 2;
      sp[0] = aprod; sp[1] = hcarry;
    }
    __threadfence();
    __syncthreads();
  }
}

typedef bf16x8 __attribute__((aligned(2))) bf16x8_u;

__device__ __forceinline__ void hy_conv3x8(const u16* col, int t8, int n, float w0, float w1, float w2, float bias, float* out) {
  float f[8]; unpack8(*(const uint4*)(col + t8), f);
  float prev = (t8 > 0) ? bf2f(col[t8 - 1]) : 0.f;
  float next = (t8 + 8 < n) ? bf2f(col[t8 + 8]) : 0.f;
#pragma unroll
  for (int j = 0; j < 8; ++j) {
    float a = (j == 0) ? prev : f[j - 1];
    float cnx = (j == 7) ? next : f[j + 1];
    out[j] = bias + w0 * a + w1 * f[j] + w2 * cnx;
  }
}

__device__ __forceinline__ void hy_task(const P& p, int l, int c, float* sm) {
  const int tid = threadIdx.x, wave = tid >> 6, lane = tid & 63;
  const int r = lane & 31, h = lane >> 5;
  u16* krr = (u16*)sm;
  u16* zs = krr + 8192 + 64;
  float* red = (float*)(zs + 16384);
  const u16* UT = p.U;
  const float* cwp = p.hy_conv_w + (size_t)l * 3 * 1536;
  const float* cbp = p.hy_conv_b + (size_t)l * 1536;
  for (int o = 0; o < 2; ++o) {
    const u16* K = p.KF + (size_t)(o * 512 + c) * 8192;
    float asum = 0.f;
#pragma unroll
    for (int i = 0; i < 4; ++i) {
      int idx = (tid + 256 * i) * 8;
      uint4 v = *(const uint4*)(K + idx);
      *(uint4*)(krr + idx) = v;
      float f[8]; unpack8(v, f);
#pragma unroll
      for (int j = 0; j < 8; ++j) asum += fabsf(f[j]);
    }
    asum = wave_sum(asum);
    if (lane == 0) red[wave] = asum;
    if (o == 0) {
      const float w0 = cwp[c], w1 = cwp[1536 + c], w2 = cwp[3072 + c], bs = cbp[c];
#pragma unroll 1
      for (int e = tid; e < 2048; e += 256) {
        int b = e >> 9, t8 = (e & 511) * 8;
        float f[8];
        hy_conv3x8(UT + (size_t)c * NTOK + b * 4096, t8, 4096, w0, w1, w2, bs, f);
        *(uint4*)(zs + b * 4096 + t8) = pack8(f);
      }
    }
    __syncthreads();
    const float scale = 1.f / (red[0] + red[1] + red[2] + red[3] + 1e-6f);
    const float skip = p.hy_skip[(l * 2 + o) * 512 + c];
    f32x16 acc[2][2];
#pragma unroll
    for (int a = 0; a < 2; ++a)
#pragma unroll
      for (int b = 0; b < 2; ++b)
#pragma unroll
        for (int q = 0; q < 16; ++q) acc[a][b][q] = 0.f;
    const int I0 = wave * 16;
    const int Il0 = I0 + (r >> 2), Il1 = I0 + 8 + (r >> 2);
    const u16* zb = zs + (r & 3) * 4096 + 8 * h;
    const int ybase = 4096 - r + 8 * h + 48;
    bf16x8 F0, F1, F2, F3, F4, F5;
    {
      const u16* kp = krr + (ybase - 64 * (I0 - 63));
      F0 = *(const bf16x8_u*)(kp); F1 = *(const bf16x8_u*)(kp - 16); F2 = *(const bf16x8_u*)(kp - 32);
      F3 = *(const bf16x8_u*)(kp - 48); F4 = *(const bf16x8_u*)(kp - 64); F5 = *(const bf16x8_u*)(kp - 80);
    }
#pragma unroll 1
    for (int D = I0 - 63; D <= I0 + 15; ++D) {
      bf16x8 B0[4], B1[4];
      {
        int J0 = Il0 - D, J1 = Il1 - D;
        bool ok0 = (unsigned)J0 < 64u, ok1 = (unsigned)J1 < 64u;
        const u16* zp0 = zb + 64 * J0; const u16* zp1 = zb + 64 * J1;
#pragma unroll
        for (int ks = 0; ks < 4; ++ks) {
          bf16x8 z0 = {0, 0, 0, 0, 0, 0, 0, 0}, z1 = {0, 0, 0, 0, 0, 0, 0, 0};
          if (ok0) z0 = *(const bf16x8*)(zp0 + 16 * ks);
          if (ok1) z1 = *(const bf16x8*)(zp1 + 16 * ks);
          B0[ks] = z0; B1[ks] = z1;
        }
      }
      acc[0][0] = __builtin_amdgcn_mfma_f32_32x32x16_bf16(F3, B0[0], acc[0][0], 0, 0, 0);
      acc[0][1] = __builtin_amdgcn_mfma_f32_32x32x16_bf16(F3, B1[0], acc[0][1], 0, 0, 0);
      acc[1][0] = __builtin_amdgcn_mfma_f32_32x32x16_bf16(F5, B0[0], acc[1][0], 0, 0, 0);
      acc[1][1] = __builtin_amdgcn_mfma_f32_32x32x16_bf16(F5, B1[0], acc[1][1], 0, 0, 0);
      acc[0][0] = __builtin_amdgcn_mfma_f32_32x32x16_bf16(F2, B0[1], acc[0][0], 0, 0, 0);
      acc[0][1] = __builtin_amdgcn_mfma_f32_32x32x16_bf16(F2, B1[1], acc[0][1], 0, 0, 0);
      acc[1][0] = __builtin_amdgcn_mfma_f32_32x32x16_bf16(F4, B0[1], acc[1][0], 0, 0, 0);
      acc[1][1] = __builtin_amdgcn_mfma_f32_32x32x16_bf16(F4, B1[1], acc[1][1], 0, 0, 0);
      acc[0][0] = __builtin_amdgcn_mfma_f32_32x32x16_bf16(F1, B0[2], acc[0][0], 0, 0, 0);
      acc[0][1] = __builtin_amdgcn_mfma_f32_32x32x16_bf16(F1, B1[2], acc[0][1], 0, 0, 0);
      acc[1][0] = __builtin_amdgcn_mfma_f32_32x32x16_bf16(F3, B0[2], acc[1][0], 0, 0, 0);
      acc[1][1] = __builtin_amdgcn_mfma_f32_32x32x16_bf16(F3, B1[2], acc[1][1], 0, 0, 0);
      acc[0][0] = __builtin_amdgcn_mfma_f32_32x32x16_bf16(F0, B0[3], acc[0][0], 0, 0, 0);
      acc[0][1] = __builtin_amdgcn_mfma_f32_32x32x16_bf16(F0, B1[3], acc[0][1], 0, 0, 0);
      acc[1][0] = __builtin_amdgcn_mfma_f32_32x32x16_bf16(F2, B0[3], acc[1][0], 0, 0, 0);
      acc[1][1] = __builtin_amdgcn_mfma_f32_32x32x16_bf16(F2, B1[3], acc[1][1], 0, 0, 0);
      F0 = F4; F1 = F5;
      if (D < I0 + 15) {
        const u16* kp = krr + (ybase - 64 * (D + 1));
        F2 = *(const bf16x8_u*)(kp - 32); F3 = *(const bf16x8_u*)(kp - 48);
        F4 = *(const bf16x8_u*)(kp - 64); F5 = *(const bf16x8_u*)(kp - 80);
      }
    }
    __syncthreads();
#pragma unroll
    for (int ni = 0; ni < 2; ++ni) {
      u16* zc = zs + (r & 3) * 4096 + 64 * (ni ? Il1 : Il0);
#pragma unroll
      for (int mi = 0; mi < 2; ++mi)
#pragma unroll
        for (int q = 0; q < 16; ++q) {
          int i = 32 * mi + (q & 3) + 8 * (q >> 2) + 4 * h;
          float zo = bf2f(zc[i]);
          zc[i] = f2bf(scale * acc[mi][ni][q] + skip * zo);
        }
    }
    __syncthreads();
    {
      const int ch = (o + 1) * 512 + c;
      const float w0 = cwp[ch], w1 = cwp[1536 + ch], w2 = cwp[3072 + ch], bs = cbp[ch];
#pragma unroll 1
      for (int e = tid; e < 2048; e += 256) {
        int b = e >> 9, t8 = (e & 511) * 8;
        float xg[8], y[8];
        hy_conv3x8(UT + (size_t)ch * NTOK + b * 4096, t8, 4096, w0, w1, w2, bs, xg);
        unpack8(*(const uint4*)(zs + b * 4096 + t8), y);
#pragma unroll
        for (int j = 0; j < 8; ++j) y[j] *= xg[j];
        if (o == 0) *(uint4*)(zs + b * 4096 + t8) = pack8(y);
        else {
          float gf[8]; unpack8(*(const uint4*)(UT + (size_t)(1536 + c) * NTOK + b * 4096 + t8), gf);
          size_t R = (size_t)b * 4096 + t8;
#pragma unroll
          for (int j = 0; j < 8; ++j) p.HL[(R + j) * 1024 + c] = f2bf(y[j] * gf[j]);
        }
      }
    }
    __syncthreads();
  }
  if (l == 0) {
    const int t = tid;
    for (int o = 0; o < 2; ++o) {
      const u16* K = p.KFC + (size_t)(o * 512 + c) * 512;
      float asum = 0.f;
      {
        uint32_t w2 = *(const uint32_t*)(K + tid * 2);
        *(uint32_t*)(krr + tid * 2) = w2;
        asum = fabsf(bflo(w2)) + fabsf(bfhi(w2));
      }
      asum = wave_sum(asum);
      if (lane == 0) red[wave] = asum;
      if (o == 0) {
        const float w0 = cwp[c], w1 = cwp[1536 + c], w2 = cwp[3072 + c], bs = cbp[c];
        if (tid < 128) {
          int b = tid >> 5, t8 = (tid & 31) * 8;
          float f[8];
          hy_conv3x8(UT + (size_t)c * NTOK + NLAT + b * 256, t8, 256, w0, w1, w2, bs, f);
          *(uint4*)(zs + b * 4096 + t8) = pack8(f);
        }
      }
      __syncthreads();
      const float scale = 1.f / (red[0] + red[1] + red[2] + red[3] + 1e-6f);
      float a0 = 0, a1 = 0, a2 = 0, a3 = 0;
      for (int s2 = 0; s2 < 256; ++s2) {
        float kv = bf2f(krr[256 - t + s2]);
        a0 += kv * bf2f(zs[s2]); a1 += kv * bf2f(zs[4096 + s2]); a2 += kv * bf2f(zs[8192 + s2]); a3 += kv * bf2f(zs[12288 + s2]);
      }
      const float skip = p.hy_skip[(l * 2 + o) * 512 + c];
      float y[4];
      y[0] = scale * a0 + skip * bf2f(zs[t]); y[1] = scale * a1 + skip * bf2f(zs[4096 + t]);
      y[2] = scale * a2 + skip * bf2f(zs[8192 + t]); y[3] = scale * a3 + skip * bf2f(zs[12288 + t]);
      __syncthreads();
      {
        const int ch = (o + 1) * 512 + c;
        const float w0 = cwp[ch], w1 = cwp[1536 + ch], w2 = cwp[3072 + ch], bs = cbp[ch];
#pragma unroll
        for (int b = 0; b < 4; ++b) {
          const u16* col = UT + (size_t)ch * NTOK + NLAT + b * 256;
          float xg = bs + w1 * bf2f(col[t]);
          if (t > 0) xg += w0 * bf2f(col[t - 1]);
          if (t < 255) xg += w2 * bf2f(col[t + 1]);
          float zn = xg * y[b];
          if (o == 0) zs[b * 4096 + t] = f2bf(zn);
          else {
            size_t R = (size_t)NLAT + b * 256 + t;
            float gate = bf2f(UT[(size_t)(1536 + c) * NTOK + R]);
            p.HL[R * 1024 + c] = f2bf(zn * gate);
          }
        }
      }
      __syncthreads();
    }
  }
}

__device__ __forceinline__ void fin_rows(const P& p, int l, int chunk) {
  const int tid = threadIdx.x, wave = tid >> 6, lane = tid & 63;
  for (int rr = 0; rr < 16; ++rr) {
    int R = chunk * 64 + wave * 16 + rr;
    {
      uint4* yp = (uint4*)(p.Y2 + (size_t)R * 1024 + lane * 8);
      float o[8]; unpack8(*yp, o);
      float ss = 0;
#pragma unroll
      for (int j = 0; j < 8; ++j) ss += o[j] * o[j];
      ss += __shfl_xor(ss, 1); ss += __shfl_xor(ss, 2); ss += __shfl_xor(ss, 4); ss += __shfl_xor(ss, 8);
      float rinv = rsqrtf(ss * (1.f / 128.f) + EPS);
      float gf[8]; unpack8(*(const uint4*)(p.U + (size_t)NTOK * 2048 + (size_t)R * 2048 + 1024 + lane * 8), gf);
#pragma unroll
      for (int j = 0; j < 8; ++j) o[j] = o[j] * rinv * p.hg_norm_w[l * 512 + lane * 8 + j] * gf[j];
      *yp = pack8(o);
    }
    {
      uint4* yp = (uint4*)(p.Y2 + (size_t)R * 1024 + 512 + lane * 8);
      float o[8]; unpack8(*yp, o);
      float gf[8]; unpack8(*(const uint4*)(p.U + (size_t)NTOK * 2048 + (size_t)R * 2048 + 1536 + lane * 8), gf);
      float ss = 0;
#pragma unroll
      for (int j = 0; j < 8; ++j) { o[j] *= gf[j]; ss += o[j] * o[j]; }
      ss += __shfl_xor(ss, 1); ss += __shfl_xor(ss, 2); ss += __shfl_xor(ss, 4); ss += __shfl_xor(ss, 8); ss += __shfl_xor(ss, 16);
      float rinv = rsqrtf(ss * (1.f / 256.f) + EPS);
#pragma unroll
      for (int j = 0; j < 8; ++j) o[j] = o[j] * rinv * p.m2_norm_w[l * 512 + lane * 8 + j];
      *yp = pack8(o);
    }
  }
}

__device__ __forceinline__ void ph_mixB(const P& p, int l, int bid, int nb, float* sm) {
  for (int t = bid; t < 544 + 512; t += nb) {
    if (t < 544) { if (EN_RG) rg_task<0>(p, l, t, sm); }
    else { if (EN_HY) hy_task(p, l, t - 544, sm); }
    __syncthreads();
  }
}
__device__ __forceinline__ void ph_mixB2(const P& p, int l, int bid, int nb, float* sm) {
  const int nfin = (l == 0 ? NTOK : NLAT) / 64;
  for (int t = bid; t < 544 + nfin; t += nb) {
    if (t < 544) { if (EN_RG) rg_task<1>(p, l, t, sm); }
    else fin_rows(p, l, t - 544);
    __syncthreads();
  }
}
__device__ __forceinline__ void ph_final(const P& p, int bid, int nb) {
  const int tid = threadIdx.x, wave = tid >> 6, lane = tid & 63;
  for (int R = bid * 4 + wave; R < NLAT; R += nb * 4) {
    float4* rp = (float4*)(p.out + (size_t)R * 1024);
    float4 v[4]; float ss = 0;
#pragma unroll
    for (int i = 0; i < 4; ++i) {
      v[i] = rp[lane + i * 64];
      ss += v[i].x * v[i].x + v[i].y * v[i].y + v[i].z * v[i].z + v[i].w * v[i].w;
    }
    ss = wave_sum(ss);
    float rinv = rsqrtf(ss * (1.f / 1024.f) + EPS);
#pragma unroll
    for (int i = 0; i < 4; ++i) {
      float4 w = *(const float4*)(p.final_norm_w + (lane + i * 64) * 4);
      float4 o; o.x = v[i].x * rinv * w.x; o.y = v[i].y * rinv * w.y; o.z = v[i].z * rinv * w.z; o.w = v[i].w * rinv * w.w;
      rp[lane + i * 64] = o;
    }
  }
}

#define SMEM_BYTES 50176
__global__ void __launch_bounds__(256) mega(P p) {
  __shared__ __align__(16) unsigned char smem[SMEM_BYTES];
  cg::grid_group grid = cg::this_grid();
  const int bid = blockIdx.x, nb = gridDim.x;
  float* smf = (float*)smem; u16* smh = (u16*)smem;
#ifndef PHM
#define PHM 0xffff
#endif
  if (PHM & 1) ph_mod(p, bid, nb, smf);
  grid.sync();
  for (int l = 0; l < 2; ++l) {
    if (PHM & 2) ph_norm(p, l, bid, nb);
    if (PHM & 4) ph_wconv(p, l, bid, nb, smf);
    if (PHM & 8) ph_filt(p, l, bid, nb, smf);
    grid.sync();
    if (PHM & 16) ph_gemm<0>(p, l, bid, nb, smh);
    grid.sync();
    if (PHM & 32) ph_mixA(p, l, bid, nb, smf);
    grid.sync();
#if PROBE_DUP == 1
    ph_mixA(p, l, bid, nb, smf);
    grid.sync();
#endif
#if PROBE_DUP == 5
    for (int t = bid; t < 16; t += nb) { hg_mfma(p, l, t, smem); __syncthreads(); }
    grid.sync();
#endif
#if PROBE_DUP == 6
    for (int t = bid; t < 16; t += nb) { m2_mfma(p, l, t, smem); __syncthreads(); }
    grid.sync();
#endif
#if PROBE_DUP == 3
    ph_gemm<0>(p, l, bid, nb, smh);
    grid.sync();
#endif
    if (PHM & 64) ph_gemm<1>(p, l, bid, nb, smh);
    grid.sync();
#if PROBE_DUP == 2
    ph_mixB(p, l, bid, nb, smf);
    grid.sync();
#endif
#if PROBE_DUP == 4
    ph_gemm<1>(p, l, bid, nb, smh);
    grid.sync();
#endif
    if (PHM & 128) ph_mixB(p, l, bid, nb, smf);
    grid.sync();
    if (PHM & 128) ph_mixB2(p, l, bid, nb, smf);
    grid.sync();
    if (PHM & 256) ph_gemm<2>(p, l, bid, nb, smh);
    grid.sync();
  }
  if (PHM & 512) ph_final(p, bid, nb);
}

extern "C" void kernel_launch(void* const* d_in, const int* in_sizes, int n_in, void* d_out, int out_size,
                              void* d_ws, size_t ws_size, hipStream_t stream) {
  static int grid_blocks = 0;
  if (!grid_blocks) {
    int dev = 0, cus = 0, per_cu = 0;
    hipGetDevice(&dev);
    hipDeviceGetAttribute(&cus, hipDeviceAttributeMultiprocessorCount, dev);
    hipOccupancyMaxActiveBlocksPerMultiprocessor(&per_cu, mega, 256, 0);
    if (per_cu < 1) per_cu = 1;
    if (per_cu > 2) per_cu = 2;
    grid_blocks = cus * per_cu;
  }
  P p{};
  const float** fp = (const float**)&p;
  for (int i = 0; i < 34; ++i) fp[i] = (const float*)d_in[i];
  p.out = (float*)d_out;
  char* w = (char*)d_ws;
  size_t off = 0;
  auto take = [&](size_t bytes) { char* r = w + off; off += (bytes + 255) & ~(size_t)255; return r; };
  p.U = (u16*)take((size_t)NTOK * UW * 2);
  p.HL = (u16*)take((size_t)NTOK * 1024 * 2);
  p.Y2 = (u16*)take((size_t)NTOK * 1024 * 2);
  p.WT = (u16*)take((size_t)7296 * 1024 * 2);
  p.WoT = (u16*)take((size_t)1024 * 2048 * 2);
  p.KF = (u16*)take((size_t)1024 * 8192 * 2);
  p.KFC = (u16*)take((size_t)1024 * 512 * 2);
  p.XC = (float*)take((size_t)1024 * 1024 * 4);
  p.DT = (float*)take((size_t)NTOK * 8 * 4);
  p.MOD = (float*)take((size_t)2 * 5 * 3072 * 4);
  p.SUM = (float*)take((size_t)4 * 2 * 17 * 512 * 2 * 4);
  if (off > ws_size) { fprintf(stderr, "workspace too small: need %zu have %zu\n", off, ws_size); return; }
  void* args[] = {&p};
  hipError_t e = hipLaunchCooperativeKernel((void*)mega, dim3(grid_blocks), dim3(256), args, 0, stream);
  if (e != hipSuccess) fprintf(stderr, "cooperative launch failed: %s (grid %d)\n", hipGetErrorString(e), grid_blocks);
}
```

```cpp
#include <hip/hip_runtime.h>
#include <hip/hip_bf16.h>
#include <hip/hip_cooperative_groups.h>
#include <cstdio>
#include <cstdint>
namespace cg = cooperative_groups;

typedef unsigned short u16;
using bf16x8 = __attribute__((ext_vector_type(8))) short;
using f32x16 = __attribute__((ext_vector_type(16))) float;

#define NTOK 17408
#define NLAT 16384
#define UW 4096
#define EPS 1e-6f

#ifndef PROBE_DUP
#define PROBE_DUP 0
#endif
#ifndef EN_HY
#define EN_HY 1
#endif
#ifndef EN_RG
#define EN_RG 1
#endif
#ifndef EN_HG
#define EN_HG 1
#endif
#ifndef EN_M2
#define EN_M2 1
#endif

struct P {
  const float *x, *c, *ctx, *c_ctx, *w_mod, *b_mod, *norm_w, *w_in, *w_out;
  const float *hy_conv_w, *hy_conv_b, *hy_w1, *hy_b1, *hy_w2, *hy_b2, *hy_w3, *hy_freq, *hy_skip;
  const float *rg_conv_w, *rg_conv_b, *rg_wa, *rg_ba, *rg_wx, *rg_bx, *rg_lam;
  const float *hg_lb, *hg_norm_w, *m2_conv_w, *m2_conv_b, *m2_dt_bias, *m2_a_log, *m2_d, *m2_norm_w, *final_norm_w;
  float* out;
  u16 *U, *HL, *Y2, *WT, *WoT, *KF, *KFC;
  float *XC, *DT, *MOD, *SUM, *SSH, *PS, *PA;
};

typedef __bf16 bf2_t __attribute__((ext_vector_type(2)));
typedef float f2_t __attribute__((ext_vector_type(2)));
__device__ __forceinline__ uint32_t pack2(float a, float b) {
  f2_t v = {a, b};
  return __builtin_bit_cast(uint32_t, __builtin_convertvector(v, bf2_t));
}
__device__ __forceinline__ u16 f2bf(float f) { return (u16)(pack2(f, f) & 0xffffu); }
__device__ __forceinline__ float bf2f(u16 h) { return __uint_as_float(((uint32_t)h) << 16); }
__device__ __forceinline__ float bflo(uint32_t w) { return __uint_as_float(w << 16); }
__device__ __forceinline__ float bfhi(uint32_t w) { return __uint_as_float(w & 0xffff0000u); }
__device__ __forceinline__ float siluf(float x) { return x * __builtin_amdgcn_rcpf(1.f + __expf(-x)); }
__device__ __forceinline__ float sigmf(float x) { return __builtin_amdgcn_rcpf(1.f + __expf(-x)); }
__device__ __forceinline__ float softplusf(float x) { return x > 20.f ? x : log1pf(__expf(x)); }

__device__ __forceinline__ void unpack8(const uint4& v, float* f) {
  f[0] = bflo(v.x); f[1] = bfhi(v.x); f[2] = bflo(v.y); f[3] = bfhi(v.y);
  f[4] = bflo(v.z); f[5] = bfhi(v.z); f[6] = bflo(v.w); f[7] = bfhi(v.w);
}
__device__ __forceinline__ uint4 pack8(const float* f) {
  uint4 v; v.x = pack2(f[0], f[1]); v.y = pack2(f[2], f[3]); v.z = pack2(f[4], f[5]); v.w = pack2(f[6], f[7]);
  return v;
}
__device__ __forceinline__ float wave_sum(float v) {
#pragma unroll
  for (int o = 32; o >= 1; o >>= 1) v += __shfl_xor(v, o);
  return v;
}

__device__ __forceinline__ int pos2row_seq(int b, int p, int dir) {
  if (p < 256) { int t = dir ? 255 - p : p; return NLAT + b * 256 + t; }
  int j = p - 256; int t = dir ? 4095 - j : j; return b * 4096 + t;
}
__device__ __forceinline__ int pos2row_m2(int b, int p, int dir) {
  if (p < 256) { int t = dir ? 255 - p : p; return NLAT + b * 256 + t; }
  int j = p - 256; int jj = dir ? 4095 - j : j; int c = jj >> 6, r = jj & 63; return b * 4096 + r * 64 + c;
}

__device__ __forceinline__ void ph_mod(const P& p, int bid, int nb, float* sm) {
  const int tid = threadIdx.x;
  for (int task = bid; task < 96; task += nb) {
    int l = task / 48, cgi = task % 48;
    int col = cgi * 64 + (tid & 63);
    int kq = tid >> 6;
    float a0 = 0, a1 = 0, a2 = 0, a3 = 0, a4 = 0;
    for (int k = kq * 256; k < kq * 256 + 256; ++k) {
      float w = p.w_mod[((size_t)l * 1024 + k) * 3072 + col];
      a0 += siluf(p.c[k]) * w; a1 += siluf(p.c[1024 + k]) * w; a2 += siluf(p.c[2048 + k]) * w;
      a3 += siluf(p.c[3072 + k]) * w; a4 += siluf(p.c_ctx[k]) * w;
    }
    sm[(kq * 5 + 0) * 64 + (tid & 63)] = a0; sm[(kq * 5 + 1) * 64 + (tid & 63)] = a1;
    sm[(kq * 5 + 2) * 64 + (tid & 63)] = a2; sm[(kq * 5 + 3) * 64 + (tid & 63)] = a3;
    sm[(kq * 5 + 4) * 64 + (tid & 63)] = a4;
    __syncthreads();
    if (tid < 64) {
      float bm = p.b_mod[l * 3072 + col];
#pragma unroll
      for (int j = 0; j < 5; ++j) {
        float s = sm[(0 * 5 + j) * 64 + tid] + sm[(1 * 5 + j) * 64 + tid] + sm[(2 * 5 + j) * 64 + tid] + sm[(3 * 5 + j) * 64 + tid];
        p.MOD[(size_t)(l * 5 + j) * 3072 + col] = s + bm;
      }
    }
    __syncthreads();
  }
}

__device__ __forceinline__ void ph_norm(const P& p, int l, int bid, int nb) {
  const int tid = threadIdx.x, wave = tid >> 6, lane = tid & 63;
  for (int R = bid * 4 + wave; R < NTOK; R += nb * 4) {
    const float* src; int mj;
    if (R < NLAT) { src = (l == 0 ? p.x : (const float*)p.out) + (size_t)R * 1024; mj = R >> 12; }
    else { int rc = R - NLAT; src = (l == 0 ? p.ctx : (const float*)p.XC) + (size_t)rc * 1024; mj = 4; }
    const float* mod = p.MOD + (size_t)(l * 5 + mj) * 3072;
    float4 v[4]; float ss = 0;
#pragma unroll
    for (int i = 0; i < 4; ++i) {
      v[i] = ((const float4*)src)[lane + i * 64];
      ss += v[i].x * v[i].x + v[i].y * v[i].y + v[i].z * v[i].z + v[i].w * v[i].w;
    }
    ss = wave_sum(ss);
    float rinv = rsqrtf(ss * (1.f / 1024.f) + EPS);
#pragma unroll
    for (int i = 0; i < 4; ++i) {
      int idx = (lane + i * 64) * 4;
      float4 nw = *(const float4*)(p.norm_w + l * 1024 + idx);
      float4 sh = *(const float4*)(mod + idx);
      float4 sc = *(const float4*)(mod + 1024 + idx);
      float h0 = v[i].x * rinv * nw.x * (1.f + sc.x) + sh.x;
      float h1 = v[i].y * rinv * nw.y * (1.f + sc.y) + sh.y;
      float h2 = v[i].z * rinv * nw.z * (1.f + sc.z) + sh.z;
      float h3 = v[i].w * rinv * nw.w * (1.f + sc.w) + sh.w;
      uint2 o; o.x = pack2(h0, h1); o.y = pack2(h2, h3);
      *(uint2*)(p.HL + (size_t)R * 1024 + idx) = o;
    }
  }
}

__device__ __forceinline__ void ph_wconv(const P& p, int l, int bid, int nb, float* sm) {
  const int tid = threadIdx.x;
  const int T1 = 114 * 16, T2 = 16 * 32;
  for (int t = bid; t < T1 + T2; t += nb) {
    const float* src; int ld, K, n0, k0, sc0, nvalid; u16* dst;
    if (t < T1) {
      int nt = t / 16, kt = t % 16; n0 = nt * 64; k0 = kt * 64;
      src = p.w_in + (size_t)l * 1024 * 7176; ld = 7176; K = 1024; dst = p.WT; nvalid = 64;
      if (n0 < 2048) sc0 = 3072 + n0;
      else if (n0 < 3072) sc0 = 5632 + (n0 - 2048);
      else if (n0 < 3200) { sc0 = 6656 + (n0 - 3072); nvalid = (n0 == 3072) ? 8 : 0; }
      else { int m = n0 - 3200; if (m < 3072) sc0 = m; else if (m < 3584) sc0 = 5120 + (m - 3072); else sc0 = 6664 + (m - 3584); }
    } else {
      int tt = t - T1; int nt = tt / 32, kt = tt % 32; n0 = nt * 64; k0 = kt * 64;
      src = p.w_out + (size_t)l * 2048 * 1024; ld = 1024; K = 2048; dst = p.WoT; nvalid = 64; sc0 = n0;
    }
#pragma unroll
    for (int i = 0; i < 4; ++i) {
      int kk = (tid >> 4) + 16 * i, cc = (tid & 15) * 4;
      const float* sp = src + (size_t)(k0 + kk) * ld + sc0 + cc;
      float4 v;
      if (nvalid == 64) v = *(const float4*)sp;
      else { v.x = (cc + 0 < nvalid) ? sp[0] : 0.f; v.y = (cc + 1 < nvalid) ? sp[1] : 0.f; v.z = (cc + 2 < nvalid) ? sp[2] : 0.f; v.w = (cc + 3 < nvalid) ? sp[3] : 0.f; }
      sm[kk * 65 + cc + 0] = v.x; sm[kk * 65 + cc + 1] = v.y; sm[kk * 65 + cc + 2] = v.z; sm[kk * 65 + cc + 3] = v.w;
    }
    __syncthreads();
#pragma unroll
    for (int i = 0; i < 2; ++i) {
      int q = tid + 256 * i; int nn = q >> 3, ks = q & 7;
      float f[8];
#pragma unroll
      for (int j = 0; j < 8; ++j) f[j] = sm[(ks * 8 + j) * 65 + nn];
      *(uint4*)(dst + (size_t)(n0 + nn) * K + k0 + ks * 8) = pack8(f);
    }
    __syncthreads();
  }
}

__device__ __forceinline__ void ph_filt(const P& p, int l, int bid, int nb, float* sm) {
  const int tid = threadIdx.x;
  const float HY_MIN = -3.0701134573253945f, HY_MAX = -15.350567286626972f;
  int ntask = 256 + (l == 0 ? 16 : 0);
  float* zs = sm; float* h1 = sm + 544; float* h2 = sm + 544 + 1024;
  for (int task = bid; task < ntask; task += nb) {
    int n, t0; u16* K;
    if (task < 256) { n = 4096; t0 = task * 16; K = p.KF; } else { n = 256; t0 = (task - 256) * 16; K = p.KFC; }
    float inv_nm1 = 1.f / (float)(n - 1);
    for (int e = tid; e < 16 * 33; e += 256) {
      int tt = e / 33, f = e % 33; int t = t0 + tt; float val;
      if (f == 0) val = (float)t * inv_nm1;
      else {
        int bi = (f - 1) & 15;
        float band = 1e-4f + (float)bi * ((15.f - 1e-4f) / 15.f);
        float ang = (6.283185307179586f / (float)n) * (float)t * band;
        val = (f <= 16) ? cosf(ang) : -sinf(ang);
      }
      zs[e] = val;
    }
    __syncthreads();
    for (int e = tid; e < 1024; e += 256) {
      int tt = e >> 6, j = e & 63; float acc = p.hy_b1[l * 64 + j];
      for (int f = 0; f < 33; ++f) acc += zs[tt * 33 + f] * p.hy_w1[(l * 33 + f) * 64 + j];
      h1[e] = sinf(p.hy_freq[l * 64 + j] * acc);
    }
    __syncthreads();
    for (int e = tid; e < 1024; e += 256) {
      int tt = e >> 6, j = e & 63; float acc = p.hy_b2[l * 64 + j];
      for (int i = 0; i < 64; ++i) acc += h1[tt * 64 + i] * p.hy_w2[(l * 64 + i) * 64 + j];
      h2[e] = sinf(p.hy_freq[l * 64 + j] * acc);
    }
    __syncthreads();
    for (int r = 0; r < 8; ++r) {
      int col = tid + 256 * r; int o = col >> 10, side = (col >> 9) & 1, c = col & 511;
      float w[64];
#pragma unroll
      for (int i = 0; i < 64; ++i) w[i] = p.hy_w3[(size_t)(l * 64 + i) * 2048 + col];
      float delta = fabsf(HY_MIN + (HY_MAX - HY_MIN) * (float)c / 511.f);
      u16* Kc = K + (size_t)(o * 512 + c) * (2 * n);
      for (int tt = 0; tt < 16; ++tt) {
        float acc = 0;
#pragma unroll
        for (int i = 0; i < 64; ++i) acc += h2[tt * 64 + i] * w[i];
        int t = t0 + tt;
        float val = acc * __expf(-(float)t * inv_nm1 * delta);
        int idx;
        if (side == 0) idx = n - t; else { if (t == 0) { idx = 0; val = 0.f; } else idx = n + t; }
        Kc[idx] = f2bf(val);
      }
    }
    __syncthreads();
  }
}

#define LDSTR 72
template <int MODE>
__device__ __forceinline__ void gemm_tile(const P& p, int l, int mt, int nt, u16* sA, u16* sB) {
  const int tid = threadIdx.x, wave = tid >> 6, lane = tid & 63;
  const int wm = wave >> 1, wn = wave & 1;
  const int KT = (MODE == 2) ? 2048 : 1024;
  const u16* Bsrc = (MODE == 0) ? p.WT + (size_t)(nt * 128) * 1024
                  : (MODE == 1) ? p.WT + (size_t)(3200 + nt * 128) * 1024
                                : p.WoT + (size_t)(nt * 128) * 2048;
  f32x16 acc[2][2];
#pragma unroll
  for (int a = 0; a < 2; ++a)
#pragma unroll
    for (int b = 0; b < 2; ++b)
#pragma unroll
      for (int r = 0; r < 16; ++r) acc[a][b][r] = 0.f;

  uint4 ra0, ra1, ra2, ra3, rb0, rb1, rb2, rb3;
  const int lrow = tid >> 3, lseg = tid & 7;
#define GLOAD1(K0, I, RA, RB)                                                                       \
  {                                                                                                 \
    int row = lrow + 32 * (I); int k = (K0) + lseg * 8;                                             \
    const u16* ap;                                                                                  \
    if (MODE == 2) ap = (k < 1024) ? p.HL + (size_t)(mt * 128 + row) * 1024 + k                     \
                                   : p.Y2 + (size_t)(mt * 128 + row) * 1024 + (k - 1024);           \
    else ap = p.HL + (size_t)(mt * 128 + row) * 1024 + k;                                           \
    RA = *(const uint4*)ap;                                                                         \
    RB = *(const uint4*)(Bsrc + (size_t)row * KT + k);                                              \
  }
#define GLOAD(K0) GLOAD1(K0, 0, ra0, rb0) GLOAD1(K0, 1, ra1, rb1) GLOAD1(K0, 2, ra2, rb2) GLOAD1(K0, 3, ra3, rb3)
  GLOAD(0)
  for (int k0 = 0; k0 < KT; k0 += 64) {
    *(uint4*)(sA + (lrow + 0) * LDSTR + lseg * 8) = ra0;  *(uint4*)(sB + (lrow + 0) * LDSTR + lseg * 8) = rb0;
    *(uint4*)(sA + (lrow + 32) * LDSTR + lseg * 8) = ra1; *(uint4*)(sB + (lrow + 32) * LDSTR + lseg * 8) = rb1;
    *(uint4*)(sA + (lrow + 64) * LDSTR + lseg * 8) = ra2; *(uint4*)(sB + (lrow + 64) * LDSTR + lseg * 8) = rb2;
    *(uint4*)(sA + (lrow + 96) * LDSTR + lseg * 8) = ra3; *(uint4*)(sB + (lrow + 96) * LDSTR + lseg * 8) = rb3;
    __syncthreads();
    if (k0 + 64 < KT) { GLOAD(k0 + 64) }
#pragma unroll
    for (int ks = 0; ks < 4; ++ks) {
      bf16x8 fa[2], fb[2];
#pragma unroll
      for (int mi = 0; mi < 2; ++mi)
        fa[mi] = *(const bf16x8*)(sA + (wm * 64 + mi * 32 + (lane & 31)) * LDSTR + ks * 16 + (lane >> 5) * 8);
#pragma unroll
      for (int ni = 0; ni < 2; ++ni)
        fb[ni] = *(const bf16x8*)(sB + (wn * 64 + ni * 32 + (lane & 31)) * LDSTR + ks * 16 + (lane >> 5) * 8);
#pragma unroll
      for (int mi = 0; mi < 2; ++mi)
#pragma unroll
        for (int ni = 0; ni < 2; ++ni)
          acc[mi][ni] = __builtin_amdgcn_mfma_f32_32x32x16_bf16(fa[mi], fb[ni], acc[mi][ni], 0, 0, 0);
    }
    __syncthreads();
  }
  const int mj = (mt < 128) ? (mt >> 5) : 4;
#pragma unroll
  for (int ni = 0; ni < 2; ++ni) {
    const int col = wn * 64 + ni * 32 + (lane & 31);
    const int gcol = nt * 128 + col;
    float lb = 0.f; float gmod = 0.f;
    if (MODE == 0) {
      int piece = gcol >> 9;
      if (l == 1 && (piece == 1 || piece == 2)) {
        int dir = piece - 1, ch = gcol & 511;
        float l0 = p.hg_lb[(0 * 2 + dir) * 512 + ch], l1 = p.hg_lb[(1 * 2 + dir) * 512 + ch];
        lb = 1.f / (1.f + __expf(l0 - l1));
      }
    }
    if (MODE == 2) gmod = p.MOD[(size_t)(l * 5 + mj) * 3072 + 2048 + gcol];
#pragma unroll
    for (int mi = 0; mi < 2; ++mi) {
#pragma unroll
      for (int r = 0; r < 16; ++r) {
        const int row = wm * 64 + mi * 32 + (r & 3) + 8 * (r >> 2) + 4 * (lane >> 5);
        const int R = mt * 128 + row;
        float v = acc[mi][ni][r];
        if (MODE == 0) {
          if (nt < 24) {
            int piece = gcol >> 9;
            if (piece == 0) v *= 0.08838834764831845f;
            else if (piece == 1 || piece == 2) v = (1.f - lb) * __builtin_amdgcn_rcpf(1.f + __expf(v));
            p.U[(size_t)R * UW + gcol] = f2bf(v);
          } else {
            if (col < 8) p.DT[(size_t)R * 8 + col] = v;
          }
        } else if (MODE == 1) {
          int piece = gcol >> 9;
          if (piece == 3 || piece >= 5) v = siluf(v);
          if (nt >= 16) p.U[(size_t)NTOK * 2048 + (size_t)R * 2048 + (gcol - 2048)] = f2bf(v);
          else acc[mi][ni][r] = v;
        } else {
          if (R < NLAT) {
            const float* base = (l == 0) ? p.x : (const float*)p.out;
            float xv = base[(size_t)R * 1024 + gcol];
            p.out[(size_t)R * 1024 + gcol] = xv + gmod * v;
          } else {
            int rc = R - NLAT;
            p.XC[(size_t)rc * 1024 + gcol] = p.ctx[(size_t)rc * 1024 + gcol] + gmod * v;
          }
        }
      }
      if (MODE == 1 && nt < 16) {
#pragma unroll
        for (int g4 = 0; g4 < 4; ++g4) {
          int R0 = mt * 128 + wm * 64 + mi * 32 + 8 * g4 + 4 * (lane >> 5);
          uint2 o; o.x = pack2(acc[mi][ni][4 * g4], acc[mi][ni][4 * g4 + 1]); o.y = pack2(acc[mi][ni][4 * g4 + 2], acc[mi][ni][4 * g4 + 3]);
          *(uint2*)(p.U + (size_t)gcol * NTOK + R0) = o;
        }
      }
    }
  }
}

template <int MODE>
__device__ __forceinline__ void ph_gemm(const P& p, int l, int bid, int nb, u16* sm) {
  const int NT = (MODE == 0) ? 25 : (MODE == 1) ? 32 : 8;
  const int MT = (MODE == 2 && l == 1) ? 128 : 136;
  u16* sA = sm; u16* sB = sm + 128 * LDSTR;
  for (int t = bid; t < MT * NT; t += nb) {
    int nt = t / MT, mt = t % MT;
    gemm_tile<MODE>(p, l, mt, nt, sA, sB);
  }
}

__device__ __forceinline__ void hg_task(const P& p, int l, int task, float* sm) {
  const int tid = threadIdx.x, wave = tid >> 6, lane = tid & 63;
  const int b = task >> 5, h = (task >> 3) & 3, es = task & 7;
  const int dg = lane & 15, el = lane >> 4;
  float* qs = sm; float* ks = sm + 4096; float* vs = sm + 8192; float* os = sm + 8192 + 512;
  for (int dir = 0; dir < 2; ++dir) {
    float S[8];
#pragma unroll
    for (int r = 0; r < 8; ++r) S[r] = 0.f;
    for (int chunk = 0; chunk < 136; ++chunk) {
#pragma unroll
      for (int i = 0; i < 2; ++i) {
        int q = tid + 256 * i; int pos = q >> 4, seg = q & 15;
        int R = pos2row_seq(b, chunk * 32 + pos, dir);
        const u16* up = p.U + (size_t)R * UW + h * 128 + seg * 8;
        uint4 qv = *(const uint4*)up;
        uint4 kv = *(const uint4*)(up + 512 + dir * 512);
        float f[8];
        unpack8(qv, f);
        *(float4*)(qs + pos * 128 + seg * 8) = make_float4(f[0], f[1], f[2], f[3]);
        *(float4*)(qs + pos * 128 + seg * 8 + 4) = make_float4(f[4], f[5], f[6], f[7]);
        unpack8(kv, f);
        *(float4*)(ks + pos * 128 + seg * 8) = make_float4(f[0], f[1], f[2], f[3]);
        *(float4*)(ks + pos * 128 + seg * 8 + 4) = make_float4(f[4], f[5], f[6], f[7]);
      }
      {
        int pos = tid >> 3, e2 = (tid & 7) * 2;
        int R = pos2row_seq(b, chunk * 32 + pos, dir);
        uint32_t w = *(const uint32_t*)(p.U + (size_t)R * UW + 1536 + h * 128 + es * 16 + e2);
        vs[pos * 16 + e2] = bflo(w); vs[pos * 16 + e2 + 1] = bfhi(w);
      }
      __syncthreads();
#pragma unroll 4
      for (int i = 0; i < 32; ++i) {
        float4 q0 = *(const float4*)(qs + i * 128 + dg * 8), q1 = *(const float4*)(qs + i * 128 + dg * 8 + 4);
        float4 k0 = *(const float4*)(ks + i * 128 + dg * 8), k1 = *(const float4*)(ks + i * 128 + dg * 8 + 4);
        float v = vs[i * 16 + wave * 4 + el];
        S[0] += k0.x * (v - S[0]); S[1] += k0.y * (v - S[1]); S[2] += k0.z * (v - S[2]); S[3] += k0.w * (v - S[3]);
        S[4] += k1.x * (v - S[4]); S[5] += k1.y * (v - S[5]); S[6] += k1.z * (v - S[6]); S[7] += k1.w * (v - S[7]);
        float o = q0.x * S[0] + q0.y * S[1] + q0.z * S[2] + q0.w * S[3] + q1.x * S[4] + q1.y * S[5] + q1.z * S[6] + q1.w * S[7];
        o += __shfl_xor(o, 1); o += __shfl_xor(o, 2); o += __shfl_xor(o, 4); o += __shfl_xor(o, 8);
        if (dg == 0) os[i * 16 + wave * 4 + el] = o;
      }
      __syncthreads();
      {
        int pos = tid >> 3, e2 = (tid & 7) * 2;
        int R = pos2row_seq(b, chunk * 32 + pos, dir);
        uint32_t* yp = (uint32_t*)(p.Y2 + (size_t)R * 1024 + h * 128 + es * 16 + e2);
        float o0 = os[pos * 16 + e2], o1 = os[pos * 16 + e2 + 1];
        if (dir == 1) { uint32_t w = *yp; o0 += bflo(w); o1 += bfhi(w); }
        *yp = pack2(o0, o1);
      }
    }
    __threadfence();
    __syncthreads();
  }
}

__device__ __forceinline__ void m2_task(const P& p, int l, int task, float* sm) {
  const int tid = threadIdx.x, wave = tid >> 6, lane = tid & 63;
  const int b = task >> 5, head = (task >> 2) & 7, ps = task & 3;
  const int g = head >> 2;
  const int dg = lane & 15, el = lane >> 4;
  float* Cs = sm; float* Bs = sm + 4096; float* xs = sm + 8192; float* os = sm + 8192 + 512;
  float* dts = sm + 8192 + 1024; float* decs = dts + 32;
  for (int dir = 0; dir < 2; ++dir) {
    const float* cw = p.m2_conv_w + (size_t)(l * 2 + dir) * 4 * 1024;
    const float* cb = p.m2_conv_b + (size_t)(l * 2 + dir) * 1024;
    const float dtb = p.m2_dt_bias[(l * 2 + dir) * 8 + head];
    const float Aneg = -__expf(p.m2_a_log[(l * 2 + dir) * 8 + head]);
    const float Dsk = p.m2_d[(l * 2 + dir) * 8 + head];
    float S[8];
#pragma unroll
    for (int r = 0; r < 8; ++r) S[r] = 0.f;
    for (int chunk = 0; chunk < 136; ++chunk) {
      const int pbase = chunk * 32;
      const int seg0 = (pbase < 256) ? 0 : 256;
#pragma unroll
      for (int i = 0; i < 2; ++i) {
        int q = tid + 256 * i; int pos = q >> 4, seg = q & 15;
        int pp = pbase + pos;
        int chB = 512 + g * 128 + seg * 8, chC = 768 + g * 128 + seg * 8;
        float aB[8], aC[8];
#pragma unroll
        for (int j = 0; j < 8; ++j) { aB[j] = cb[chB + j]; aC[j] = cb[chC + j]; }
#pragma unroll
        for (int tap = 0; tap < 4; ++tap) {
          int pt = pp - 3 + tap;
          if (pt >= seg0) {
            int R = pos2row_m2(b, pt, dir);
            const u16* up = p.U + (size_t)R * UW + 2048;
            uint4 bv = *(const uint4*)(up + chB);
            uint4 cv = *(const uint4*)(up + chC);
            float f[8];
            unpack8(bv, f);
#pragma unroll
            for (int j = 0; j < 8; ++j) aB[j] += cw[tap * 1024 + chB + j] * f[j];
            unpack8(cv, f);
#pragma unroll
            for (int j = 0; j < 8; ++j) aC[j] += cw[tap * 1024 + chC + j] * f[j];
          }
        }
#pragma unroll
        for (int j = 0; j < 8; ++j) { aB[j] = siluf(aB[j]); aC[j] = siluf(aC[j]); }
        *(float4*)(Bs + pos * 128 + seg * 8) = make_float4(aB[0], aB[1], aB[2], aB[3]);
        *(float4*)(Bs + pos * 128 + seg * 8 + 4) = make_float4(aB[4], aB[5], aB[6], aB[7]);
        *(float4*)(Cs + pos * 128 + seg * 8) = make_float4(aC[0], aC[1], aC[2], aC[3]);
        *(float4*)(Cs + pos * 128 + seg * 8 + 4) = make_float4(aC[4], aC[5], aC[6], aC[7]);
      }
      {
        int pos = tid >> 3, e2 = (tid & 7) * 2;
        int pp = pbase + pos;
        int ch = head * 64 + ps * 16 + e2;
        float a0 = cb[ch], a1 = cb[ch + 1];
#pragma unroll
        for (int tap = 0; tap < 4; ++tap) {
          int pt = pp - 3 + tap;
          if (pt >= seg0) {
            int R = pos2row_m2(b, pt, dir);
            uint32_t w = *(const uint32_t*)(p.U + (size_t)R * UW + 2048 + ch);
            a0 += cw[tap * 1024 + ch] * bflo(w); a1 += cw[tap * 1024 + ch + 1] * bfhi(w);
          }
        }
        xs[pos * 16 + e2] = siluf(a0); xs[pos * 16 + e2 + 1] = siluf(a1);
      }
      if (tid < 32) {
        int R = pos2row_m2(b, pbase + tid, dir);
        float dtv = softplusf(p.DT[(size_t)R * 8 + head] + dtb);
        dts[tid] = dtv; decs[tid] = __expf(dtv * Aneg);
      }
      __syncthreads();
#pragma unroll 4
      for (int i = 0; i < 32; ++i) {
        float4 q0 = *(const float4*)(Cs + i * 128 + dg * 8), q1 = *(const float4*)(Cs + i * 128 + dg * 8 + 4);
        float4 k0 = *(const float4*)(Bs + i * 128 + dg * 8), k1 = *(const float4*)(Bs + i * 128 + dg * 8 + 4);
        float xv = xs[i * 16 + wave * 4 + el];
        float a = decs[i]; float v = xv * dts[i];
        S[0] = a * S[0] + k0.x * v; S[1] = a * S[1] + k0.y * v; S[2] = a * S[2] + k0.z * v; S[3] = a * S[3] + k0.w * v;
        S[4] = a * S[4] + k1.x * v; S[5] = a * S[5] + k1.y * v; S[6] = a * S[6] + k1.z * v; S[7] = a * S[7] + k1.w * v;
        float o = q0.x * S[0] + q0.y * S[1] + q0.z * S[2] + q0.w * S[3] + q1.x * S[4] + q1.y * S[5] + q1.z * S[6] + q1.w * S[7];
        o += __shfl_xor(o, 1); o += __shfl_xor(o, 2); o += __shfl_xor(o, 4); o += __shfl_xor(o, 8);
        if (dg == 0) os[i * 16 + wave * 4 + el] = o + Dsk * xv;
      }
      __syncthreads();
      {
        int pos = tid >> 3, e2 = (tid & 7) * 2;
        int R = pos2row_m2(b, pbase + pos, dir);
        uint32_t* yp = (uint32_t*)(p.Y2 + (size_t)R * 1024 + 512 + head * 64 + ps * 16 + e2);
        float o0 = os[pos * 16 + e2], o1 = os[pos * 16 + e2 + 1];
        if (dir == 1) { uint32_t w = *yp; o0 += bflo(w); o1 += bfhi(w); }
        *yp = pack2(o0, o1);
      }
    }
    __threadfence();
    __syncthreads();
  }
}

#ifndef M2_MFMA
#define M2_MFMA 1
#endif
#define QS 136
#define TS 40
union FragU { bf16x8 v; uint32_t u[4]; uint2 d[2]; uint4 q; };
__device__ __forceinline__ bf16x8 cvt_frag(const f32x16& x, int s2) {
  FragU f;
  f.u[0] = pack2(x[8 * s2 + 0], x[8 * s2 + 1]); f.u[1] = pack2(x[8 * s2 + 2], x[8 * s2 + 3]);
  f.u[2] = pack2(x[8 * s2 + 4], x[8 * s2 + 5]); f.u[3] = pack2(x[8 * s2 + 6], x[8 * s2 + 7]);
  return f.v;
}
__device__ __forceinline__ bf16x8 ld_frag_perm(const u16* base) {
  FragU f; f.d[0] = *(const uint2*)base; f.d[1] = *(const uint2*)(base + 8); return f.v;
}

template <int PASS>
__device__ __forceinline__ void hg_mfma(const P& p, int l, int task, int blk, int dir0, unsigned char* smem) {
  const int tid = threadIdx.x, wave = tid >> 6, lane = tid & 63;
  const int r = lane & 31, hh = lane >> 5;
  const int b = task >> 2, h = task & 3;
  u16* ks = (u16*)smem;
  u16* qs = ks + 32 * QS;
  u16* kT = qs + 32 * QS;
  u16* vT = kT + 128 * TS;
  float* tot = (float*)(vT + 128 * TS);
  float* eg = tot + 256;
  const int dd = tid & 127, half = tid >> 7;
  for (int dir = (PASS == 0 ? dir0 : 0); dir < (PASS == 0 ? dir0 + 1 : 2); ++dir) {
    const int sbd = (PASS == 0) ? blk : ((blk == 0) ? 0 : (dir ? 5 - blk : blk));
    const int c0 = (sbd == 0) ? 0 : 8 + 32 * (sbd - 1);
    const int c1 = (sbd == 0) ? 8 : 8 + 32 * sbd;
    float gsum = 0.f;
    f32x16 S[4];
#pragma unroll
    for (int i = 0; i < 4; ++i)
#pragma unroll
      for (int q = 0; q < 16; ++q) S[i][q] = 0.f;
    if (PASS == 1) {
      for (int qb = 0; qb < sbd; ++qb) {
        const size_t sidx = (size_t)((task * 2 + dir) * 4 + qb);
        if (half == 0) eg[dd] = __expf(p.PS[sidx * 128 + dd]);
        __syncthreads();
        const float* sp = p.SSH + sidx * 16384 + (size_t)wave * 4096 + lane;
#pragma unroll
        for (int dt = 0; dt < 4; ++dt)
#pragma unroll
          for (int q4 = 0; q4 < 4; ++q4) {
            float4 e4 = *(const float4*)(eg + 32 * dt + 8 * q4 + 4 * hh);
            S[dt][4 * q4 + 0] = S[dt][4 * q4 + 0] * e4.x + sp[(dt * 16 + 4 * q4 + 0) * 64];
            S[dt][4 * q4 + 1] = S[dt][4 * q4 + 1] * e4.y + sp[(dt * 16 + 4 * q4 + 1) * 64];
            S[dt][4 * q4 + 2] = S[dt][4 * q4 + 2] * e4.z + sp[(dt * 16 + 4 * q4 + 2) * 64];
            S[dt][4 * q4 + 3] = S[dt][4 * q4 + 3] * e4.w + sp[(dt * 16 + 4 * q4 + 3) * 64];
          }
        __syncthreads();
      }
    }
    uint4 pq0, pq1, pk0, pk1, pv0, pv1;
#define HG_PREFETCH(CH)                                                                     \
    {                                                                                       \
      int pos0 = tid >> 4, seg = tid & 15;                                                  \
      int R0 = pos2row_seq(b, (CH) * 32 + pos0, dir), R1 = pos2row_seq(b, (CH) * 32 + pos0 + 16, dir); \
      const u16* u0 = p.U + (size_t)R0 * UW + h * 128 + seg * 8;                            \
      const u16* u1 = p.U + (size_t)R1 * UW + h * 128 + seg * 8;                            \
      pq0 = *(const uint4*)u0; pq1 = *(const uint4*)u1;                                     \
      pk0 = *(const uint4*)(u0 + 512 + dir * 512); pk1 = *(const uint4*)(u1 + 512 + dir * 512); \
      pv0 = *(const uint4*)(u0 + 1536); pv1 = *(const uint4*)(u1 + 1536);                   \
    }
    HG_PREFETCH(c0)
#pragma unroll 1
    for (int chunk = c0; chunk < c1; ++chunk) {
      {
        int pos0 = tid >> 4, seg = tid & 15;
        *(uint4*)(qs + pos0 * QS + seg * 8) = pq0; *(uint4*)(qs + (pos0 + 16) * QS + seg * 8) = pq1;
        *(uint4*)(ks + pos0 * QS + seg * 8) = pk0; *(uint4*)(ks + (pos0 + 16) * QS + seg * 8) = pk1;
        FragU f0, f1; f0.q = pv0; f1.q = pv1;
#pragma unroll
        for (int j = 0; j < 4; ++j) {
          vT[(seg * 8 + 2 * j) * TS + pos0] = (u16)(f0.u[j] & 0xffffu); vT[(seg * 8 + 2 * j + 1) * TS + pos0] = (u16)(f0.u[j] >> 16);
          vT[(seg * 8 + 2 * j) * TS + pos0 + 16] = (u16)(f1.u[j] & 0xffffu); vT[(seg * 8 + 2 * j + 1) * TS + pos0 + 16] = (u16)(f1.u[j] >> 16);
        }
      }
      __syncthreads();
      if (chunk + 1 < c1) HG_PREFETCH(chunk + 1)
      const int Rout = pos2row_seq(b, chunk * 32 + r, dir);
      u16* yrow = p.Y2 + (size_t)Rout * 1024 + h * 128 + wave * 32 + 4 * hh;
      uint2 yold[4];
      if (PASS == 1 && dir == 1) {
#pragma unroll
        for (int q4 = 0; q4 < 4; ++q4) yold[q4] = *(const uint2*)(yrow + 8 * q4);
      }
      float gl[16];
      {
        float run = 0.f;
#pragma unroll
        for (int i = 0; i < 16; ++i) {
          float kkv = bf2f(ks[(half * 16 + i) * QS + dd]);
          run += __logf(fmaxf(1.f - kkv, 1e-6f));
          gl[i] = run;
        }
        tot[half * 128 + dd] = run;
      }
      __syncthreads();
      {
        const float t0 = tot[dd], t1 = tot[128 + dd];
        const float off = half ? t0 : 0.f;
        const float g31 = t0 + t1;
        float k2[16];
#pragma unroll
        for (int i = 0; i < 16; ++i) {
          const int pos = half * 16 + i;
          const float g = gl[i] + off;
          const float kkv = bf2f(ks[pos * QS + dd]);
          const float qv = bf2f(qs[pos * QS + dd]);
          qs[pos * QS + dd] = f2bf(qv * __expf(g));
          ks[pos * QS + dd] = f2bf(kkv * __expf(fminf(-g, 60.f)));
          k2[i] = kkv * __expf(g31 - g);
        }
        *(uint4*)(kT + dd * TS + half * 16) = pack8(k2);
        *(uint4*)(kT + dd * TS + half * 16 + 8) = pack8(k2 + 8);
        if (half == 0) eg[dd] = __expf(g31);
        gsum += g31;
      }
      __syncthreads();
      f32x16 O;
      if (PASS == 1) {
      f32x16 att;
#pragma unroll
      for (int q = 0; q < 16; ++q) att[q] = 0.f;
#pragma unroll
      for (int k8 = 0; k8 < 8; ++k8) {
        bf16x8 A = *(const bf16x8*)(ks + r * QS + 16 * k8 + 8 * hh);
        bf16x8 B = *(const bf16x8*)(qs + r * QS + 16 * k8 + 8 * hh);
        att = __builtin_amdgcn_mfma_f32_32x32x16_bf16(A, B, att, 0, 0, 0);
      }
#pragma unroll
      for (int q = 0; q < 16; ++q) {
        int sidx = (q & 3) + 8 * (q >> 2) + 4 * hh;
        if (sidx > r) att[q] = 0.f;
      }
#pragma unroll
      for (int q = 0; q < 16; ++q) O[q] = 0.f;
#pragma unroll
      for (int dt = 0; dt < 4; ++dt)
#pragma unroll
        for (int s2 = 0; s2 < 2; ++s2) {
          bf16x8 A = cvt_frag(S[dt], s2);
          bf16x8 B = ld_frag_perm(qs + r * QS + 32 * dt + 16 * s2 + 4 * hh);
          O = __builtin_amdgcn_mfma_f32_32x32x16_bf16(A, B, O, 0, 0, 0);
        }
#pragma unroll
      for (int s2 = 0; s2 < 2; ++s2) {
        bf16x8 A = ld_frag_perm(vT + (32 * wave + r) * TS + 16 * s2 + 4 * hh);
        bf16x8 B = cvt_frag(att, s2);
        O = __builtin_amdgcn_mfma_f32_32x32x16_bf16(A, B, O, 0, 0, 0);
      }
      }
#pragma unroll
      for (int dt = 0; dt < 4; ++dt) {
#pragma unroll
        for (int q4 = 0; q4 < 4; ++q4) {
          float4 e4 = *(const float4*)(eg + 32 * dt + 8 * q4 + 4 * hh);
          S[dt][4 * q4 + 0] *= e4.x; S[dt][4 * q4 + 1] *= e4.y; S[dt][4 * q4 + 2] *= e4.z; S[dt][4 * q4 + 3] *= e4.w;
        }
#pragma unroll
        for (int s2 = 0; s2 < 2; ++s2) {
          bf16x8 A = *(const bf16x8*)(kT + (32 * dt + r) * TS + 16 * s2 + 8 * hh);
          bf16x8 B = *(const bf16x8*)(vT + (32 * wave + r) * TS + 16 * s2 + 8 * hh);
          S[dt] = __builtin_amdgcn_mfma_f32_32x32x16_bf16(A, B, S[dt], 0, 0, 0);
        }
      }
      if (PASS == 1) {
#pragma unroll
      for (int q4 = 0; q4 < 4; ++q4) {
        float o0 = O[4 * q4], o1 = O[4 * q4 + 1], o2 = O[4 * q4 + 2], o3 = O[4 * q4 + 3];
        if (dir == 1) { o0 += bflo(yold[q4].x); o1 += bfhi(yold[q4].x); o2 += bflo(yold[q4].y); o3 += bfhi(yold[q4].y); }
        uint2 ov; ov.x = pack2(o0, o1); ov.y = pack2(o2, o3);
        *(uint2*)(yrow + 8 * q4) = ov;
      }
      }
      __syncthreads();
    }
    if (PASS == 0) {
      const size_t sidx = (size_t)((task * 2 + dir) * 4 + sbd);
      if (half == 0) p.PS[sidx * 128 + dd] = gsum;
      float* sp = p.SSH + sidx * 16384 + (size_t)wave * 4096 + lane;
#pragma unroll
      for (int dt = 0; dt < 4; ++dt)
#pragma unroll
        for (int q = 0; q < 16; ++q) sp[(dt * 16 + q) * 64] = S[dt][q];
    }
    __threadfence();
    __syncthreads();
  }
}

#if M2_MFMA
#define M2_NTASK 16
template <int PASS>
__device__ __forceinline__ void m2_mfma(const P& p, int l, int task, int blk, int dir0, unsigned char* smem) {
  const int tid = threadIdx.x, wave = tid >> 6, lane = tid & 63;
  const int r = lane & 31, hh = lane >> 5;
  const int b = task >> 2, g = (task >> 1) & 1, hp = task & 1;
  const int hq = wave >> 1, ph = wave & 1;
  const int head = 4 * g + 2 * hp + hq;
  u16* Bm = (u16*)smem;
  u16* Cm = Bm + 32 * QS;
  u16* BmT = Cm + 32 * QS;
  u16* xsT = BmT + 128 * TS;
  float* Gs = (float*)(xsT + 128 * TS);
  float* dts = Gs + 64;
  float* wl = dts + 64;
  const int cp = (lane < 48) ? lane : 47;
  const bool act = lane < 48;
  const int chW = (cp < 16) ? ((4 * g + 2 * hp) * 64 + cp * 8) : (cp < 32) ? (512 + g * 128 + (cp - 16) * 8) : (768 + g * 128 + (cp - 32) * 8);
  const int chU = 2048 + chW;
  float* SSM = (float*)p.KF;
  for (int dir = (PASS == 0 ? dir0 : 0); dir < (PASS == 0 ? dir0 + 1 : 2); ++dir) {
    const int sbd = (PASS == 0) ? blk : ((blk == 0) ? 0 : (dir ? 9 - blk : blk));
    const int c0 = (sbd == 0) ? 0 : 8 + 16 * (sbd - 1);
    const int c1 = (sbd == 0) ? 8 : 8 + 16 * sbd;
    float lsum = 0.f;
    const float* cw = p.m2_conv_w + (size_t)(l * 2 + dir) * 4 * 1024;
    const float* cb = p.m2_conv_b + (size_t)(l * 2 + dir) * 1024;
    if (wave == 0) {
#pragma unroll
      for (int j = 0; j < 8; ++j) {
        wl[(4 * 8 + j) * 64 + lane] = cb[chW + j];
#pragma unroll
        for (int tap = 0; tap < 4; ++tap) wl[(tap * 8 + j) * 64 + lane] = cw[tap * 1024 + chW + j];
      }
    }
    __syncthreads();
    const int hd_t = 4 * g + 2 * hp + ((tid >> 5) & 1);
    const float dtb = p.m2_dt_bias[(l * 2 + dir) * 8 + hd_t];
    const float Aneg_t = -__expf(p.m2_a_log[(l * 2 + dir) * 8 + hd_t]);
    const float Dsk = p.m2_d[(l * 2 + dir) * 8 + head];
    f32x16 S[4];
#pragma unroll
    for (int i = 0; i < 4; ++i)
#pragma unroll
      for (int q = 0; q < 16; ++q) S[i][q] = 0.f;
    if (PASS == 1) {
      for (int qb = 0; qb < sbd; ++qb) {
        const size_t sidx = (size_t)((task * 2 + dir) * 8 + qb);
        const float a = __expf(p.PA[sidx * 4 + wave]);
        const float* sp = SSM + sidx * 16384 + (size_t)wave * 4096 + lane;
#pragma unroll
        for (int nt = 0; nt < 4; ++nt)
#pragma unroll
          for (int q = 0; q < 16; ++q) S[nt][q] = S[nt][q] * a + sp[(nt * 16 + q) * 64];
      }
    }
    uint4 raw0, raw1, raw2, raw3, raw4, raw5, raw6, raw7, raw8, raw9, raw10;
    float dtraw = 0.f;
#define M2_LD1(RW, I, CH)                                                                  \
    {                                                                                      \
      int pt = (CH) * 32 + wave * 8 + (I) - 3;                                             \
      int sg0 = ((CH) * 32 < 256) ? 0 : 256;                                               \
      if (pt >= sg0) { int Rr = pos2row_m2(b, pt, dir); RW = *(const uint4*)(p.U + (size_t)Rr * UW + chU); } \
      else RW = make_uint4(0u, 0u, 0u, 0u);                                                \
    }
#define M2_PREFETCH(CH)                                                                    \
    M2_LD1(raw0, 0, CH) M2_LD1(raw1, 1, CH) M2_LD1(raw2, 2, CH) M2_LD1(raw3, 3, CH) M2_LD1(raw4, 4, CH) M2_LD1(raw5, 5, CH) \
    M2_LD1(raw6, 6, CH) M2_LD1(raw7, 7, CH) M2_LD1(raw8, 8, CH) M2_LD1(raw9, 9, CH) M2_LD1(raw10, 10, CH)            \
    if (tid < 64) { int Rr = pos2row_m2(b, (CH) * 32 + (tid & 31), dir); dtraw = p.DT[(size_t)Rr * 8 + hd_t]; }
    M2_PREFETCH(c0)
#pragma unroll 1
    for (int chunk = c0; chunk < c1; ++chunk) {
      {
#define M2_RAWF(RW, J) (((J) & 1) ? bfhi((RW)) : bflo((RW)))
#define M2_CH(J, C0, C1, C2, C3, C4, C5, C6, C7, C8, C9, C10)                               \
        {                                                                                  \
          const float q0 = wl[(0 * 8 + (J)) * 64 + lane], q1 = wl[(1 * 8 + (J)) * 64 + lane]; \
          const float q2 = wl[(2 * 8 + (J)) * 64 + lane], q3 = wl[(3 * 8 + (J)) * 64 + lane]; \
          const float qb = wl[(4 * 8 + (J)) * 64 + lane];                                  \
          const float v0 = M2_RAWF(C0, J), v1 = M2_RAWF(C1, J), v2 = M2_RAWF(C2, J), v3 = M2_RAWF(C3, J); \
          const float v4 = M2_RAWF(C4, J), v5 = M2_RAWF(C5, J), v6 = M2_RAWF(C6, J), v7 = M2_RAWF(C7, J); \
          const float v8 = M2_RAWF(C8, J), v9 = M2_RAWF(C9, J), v10 = M2_RAWF(C10, J);      \
          float o[8];                                                                      \
          o[0] = siluf(qb + q0 * v0 + q1 * v1 + q2 * v2 + q3 * v3);                        \
          o[1] = siluf(qb + q0 * v1 + q1 * v2 + q2 * v3 + q3 * v4);                        \
          o[2] = siluf(qb + q0 * v2 + q1 * v3 + q2 * v4 + q3 * v5);                        \
          o[3] = siluf(qb + q0 * v3 + q1 * v4 + q2 * v5 + q3 * v6);                        \
          o[4] = siluf(qb + q0 * v4 + q1 * v5 + q2 * v6 + q3 * v7);                        \
          o[5] = siluf(qb + q0 * v5 + q1 * v6 + q2 * v7 + q3 * v8);                        \
          o[6] = siluf(qb + q0 * v6 + q1 * v7 + q2 * v8 + q3 * v9);                        \
          o[7] = siluf(qb + q0 * v7 + q1 * v8 + q2 * v9 + q3 * v10);                       \
          if (act) {                                                                       \
            if (cp < 16) {                                                                 \
              *(uint4*)(xsT + (cp * 8 + (J)) * TS + wave * 8) = pack8(o);                  \
            } else if (cp < 32) {                                                          \
              *(uint4*)(BmT + ((cp - 16) * 8 + (J)) * TS + wave * 8) = pack8(o);           \
              _Pragma("unroll") for (int i = 0; i < 8; ++i) Bm[(wave * 8 + i) * QS + (cp - 16) * 8 + (J)] = f2bf(o[i]); \
            } else {                                                                       \
              _Pragma("unroll") for (int i = 0; i < 8; ++i) Cm[(wave * 8 + i) * QS + (cp - 32) * 8 + (J)] = f2bf(o[i]); \
            }                                                                              \
          }                                                                                \
        }
        M2_CH(0, raw0.x, raw1.x, raw2.x, raw3.x, raw4.x, raw5.x, raw6.x, raw7.x, raw8.x, raw9.x, raw10.x)
        M2_CH(1, raw0.x, raw1.x, raw2.x, raw3.x, raw4.x, raw5.x, raw6.x, raw7.x, raw8.x, raw9.x, raw10.x)
        M2_CH(2, raw0.y, raw1.y, raw2.y, raw3.y, raw4.y, raw5.y, raw6.y, raw7.y, raw8.y, raw9.y, raw10.y)
        M2_CH(3, raw0.y, raw1.y, raw2.y, raw3.y, raw4.y, raw5.y, raw6.y, raw7.y, raw8.y, raw9.y, raw10.y)
        M2_CH(4, raw0.z, raw1.z, raw2.z, raw3.z, raw4.z, raw5.z, raw6.z, raw7.z, raw8.z, raw9.z, raw10.z)
        M2_CH(5, raw0.z, raw1.z, raw2.z, raw3.z, raw4.z, raw5.z, raw6.z, raw7.z, raw8.z, raw9.z, raw10.z)
        M2_CH(6, raw0.w, raw1.w, raw2.w, raw3.w, raw4.w, raw5.w, raw6.w, raw7.w, raw8.w, raw9.w, raw10.w)
        M2_CH(7, raw0.w, raw1.w, raw2.w, raw3.w, raw4.w, raw5.w, raw6.w, raw7.w, raw8.w, raw9.w, raw10.w)
      }
      if (tid < 64) {
        float dtv = softplusf(dtraw + dtb);
        float run = dtv * Aneg_t;
#pragma unroll
        for (int o = 1; o < 32; o <<= 1) { float n = __shfl_up(run, o, 32); if ((tid & 31) >= o) run += n; }
        Gs[tid] = run; dts[tid] = dtv;
      }
      __syncthreads();
      if (chunk + 1 < c1) { M2_PREFETCH(chunk + 1) }
      const int Rout = pos2row_m2(b, chunk * 32 + r, dir);
      u16* yrow = p.Y2 + (size_t)Rout * 1024 + 512 + head * 64 + 32 * ph + 4 * hh;
      uint2 yold[4];
      if (PASS == 1 && dir == 1) {
#pragma unroll
        for (int i = 0; i < 4; ++i) yold[i] = *(const uint2*)(yrow + 8 * i);
      }
      const float* Gw = Gs + hq * 32; const float* dw = dts + hq * 32;
      const float Gt = Gw[r], G31 = Gw[31];
      lsum += G31;
      const u16* xw = xsT + (hq * 64 + ph * 32) * TS;
      f32x16 O0;
      if (PASS == 1) {
      f32x16 att;
#pragma unroll
      for (int q = 0; q < 16; ++q) att[q] = 0.f;
#pragma unroll
      for (int k8 = 0; k8 < 8; ++k8) {
        bf16x8 A = *(const bf16x8*)(Bm + r * QS + 16 * k8 + 8 * hh);
        bf16x8 B = *(const bf16x8*)(Cm + r * QS + 16 * k8 + 8 * hh);
        att = __builtin_amdgcn_mfma_f32_32x32x16_bf16(A, B, att, 0, 0, 0);
      }
#pragma unroll
      for (int q4 = 0; q4 < 4; ++q4) {
        float4 gs4 = *(const float4*)(Gw + 8 * q4 + 4 * hh);
        float4 dt4 = *(const float4*)(dw + 8 * q4 + 4 * hh);
        int s0 = 8 * q4 + 4 * hh;
        att[4 * q4 + 0] = (s0 + 0 <= r) ? att[4 * q4 + 0] * __expf(Gt - gs4.x) * dt4.x : 0.f;
        att[4 * q4 + 1] = (s0 + 1 <= r) ? att[4 * q4 + 1] * __expf(Gt - gs4.y) * dt4.y : 0.f;
        att[4 * q4 + 2] = (s0 + 2 <= r) ? att[4 * q4 + 2] * __expf(Gt - gs4.z) * dt4.z : 0.f;
        att[4 * q4 + 3] = (s0 + 3 <= r) ? att[4 * q4 + 3] * __expf(Gt - gs4.w) * dt4.w : 0.f;
      }
#pragma unroll
      for (int q = 0; q < 16; ++q) O0[q] = 0.f;
#pragma unroll
      for (int nt = 0; nt < 4; ++nt)
#pragma unroll
        for (int s2 = 0; s2 < 2; ++s2) {
          bf16x8 B = ld_frag_perm(Cm + r * QS + 32 * nt + 16 * s2 + 4 * hh);
          O0 = __builtin_amdgcn_mfma_f32_32x32x16_bf16(cvt_frag(S[nt], s2), B, O0, 0, 0, 0);
        }
      {
        const float eGt = __expf(Gt);
#pragma unroll
        for (int q = 0; q < 16; ++q) O0[q] *= eGt;
      }
#pragma unroll
      for (int s2 = 0; s2 < 2; ++s2) {
        bf16x8 B = cvt_frag(att, s2);
        O0 = __builtin_amdgcn_mfma_f32_32x32x16_bf16(ld_frag_perm(xw + r * TS + 16 * s2 + 4 * hh), B, O0, 0, 0, 0);
      }
#pragma unroll
      for (int q = 0; q < 16; ++q) {
        int pp = (q & 3) + 8 * (q >> 2) + 4 * hh;
        O0[q] += Dsk * bf2f(xw[pp * TS + r]);
      }
      }
      {
        const float eG31 = __expf(G31);
#pragma unroll
        for (int nt = 0; nt < 4; ++nt)
#pragma unroll
          for (int q = 0; q < 16; ++q) S[nt][q] *= eG31;
#pragma unroll
        for (int s2 = 0; s2 < 2; ++s2) {
          float ws[8];
          {
            float4 ga = *(const float4*)(Gw + 16 * s2 + 8 * hh), gb = *(const float4*)(Gw + 16 * s2 + 8 * hh + 4);
            float4 da = *(const float4*)(dw + 16 * s2 + 8 * hh), db = *(const float4*)(dw + 16 * s2 + 8 * hh + 4);
            ws[0] = da.x * __expf(G31 - ga.x); ws[1] = da.y * __expf(G31 - ga.y); ws[2] = da.z * __expf(G31 - ga.z); ws[3] = da.w * __expf(G31 - ga.w);
            ws[4] = db.x * __expf(G31 - gb.x); ws[5] = db.y * __expf(G31 - gb.y); ws[6] = db.z * __expf(G31 - gb.z); ws[7] = db.w * __expf(G31 - gb.w);
          }
          bf16x8 Bf0;
          {
            float f[8]; unpack8(*(const uint4*)(xw + r * TS + 16 * s2 + 8 * hh), f);
#pragma unroll
            for (int j = 0; j < 8; ++j) f[j] *= ws[j];
            FragU u; u.q = pack8(f); Bf0 = u.v;
          }
#pragma unroll
          for (int nt = 0; nt < 4; ++nt) {
            bf16x8 A = *(const bf16x8*)(BmT + (32 * nt + r) * TS + 16 * s2 + 8 * hh);
            S[nt] = __builtin_amdgcn_mfma_f32_32x32x16_bf16(A, Bf0, S[nt], 0, 0, 0);
          }
        }
      }
      if (PASS == 1) {
#pragma unroll
      for (int q4 = 0; q4 < 4; ++q4) {
        float o0 = O0[4 * q4], o1 = O0[4 * q4 + 1], o2 = O0[4 * q4 + 2], o3 = O0[4 * q4 + 3];
        if (dir == 1) { o0 += bflo(yold[q4].x); o1 += bfhi(yold[q4].x); o2 += bflo(yold[q4].y); o3 += bfhi(yold[q4].y); }
        uint2 ov; ov.x = pack2(o0, o1); ov.y = pack2(o2, o3);
        *(uint2*)(yrow + 8 * q4) = ov;
      }
      }
      __syncthreads();
    }
    if (PASS == 0) {
      const size_t sidx = (size_t)((task * 2 + dir) * 8 + sbd);
      if (lane == 0) p.PA[sidx * 4 + wave] = lsum;
      float* sp = SSM + sidx * 16384 + (size_t)wave * 4096 + lane;
#pragma unroll
      for (int nt = 0; nt < 4; ++nt)
#pragma unroll
        for (int q = 0; q < 16; ++q) sp[(nt * 16 + q) * 64] = S[nt][q];
    }
    __threadfence();
    __syncthreads();
  }
}
#endif
__device__ __forceinline__ void ph_mixA0(const P& p, int l, int bid, int nb, unsigned char* sm) {
  for (int t = bid; t < 128 + 256; t += nb) {
    if (t < 128) hg_mfma<0>(p, l, t >> 3, (t >> 1) & 3, t & 1, sm);
    else { int u = t - 128; m2_mfma<0>(p, l, u >> 4, (u >> 1) & 7, u & 1, sm); }
    __syncthreads();
  }
}
__device__ __forceinline__ void ph_mixA1(const P& p, int l, int bid, int nb, unsigned char* sm) {
  for (int t = bid; t < 80 + 144; t += nb) {
    if (t < 80) hg_mfma<1>(p, l, t / 5, t % 5, 0, sm);
    else { int u = t - 80; m2_mfma<1>(p, l, u / 9, u % 9, 0, sm); }
    __syncthreads();
  }
}

template <int PASS>
__device__ __forceinline__ void rg_task(const P& p, int l, int task, float* sm) {
  const int tid = threadIdx.x;
  const int b = task / 136, rem = task % 136, head = rem / 17, sb = rem % 17;
  float* xc = sm; float* pa = sm + 2048; float* pb = sm + 4096;
  const int j = tid & 63, which = (tid >> 6) & 1, half = tid >> 7;
  for (int dir = 0; dir < 2; ++dir) {
    const int ld = l * 2 + dir;
    float w[64];
    {
      const float* wp = (which ? p.rg_wx : p.rg_wa) + (size_t)(ld * 8 + head) * 4096 + j;
#pragma unroll
      for (int i = 0; i < 64; ++i) w[i] = wp[i * 64];
    }
    const float* cw = p.rg_conv_w + (size_t)ld * 4 * 512;
    const float* cb = p.rg_conv_b + (size_t)ld * 512;
    const int sbd = (PASS == 0) ? sb : (dir ? (sb == 0 ? 0 : 17 - sb) : sb);
    float hcarry = 0.f, aprod = 1.f;
    if (PASS == 1 && tid < 64) {
      for (int q = 0; q < sbd; ++q) {
        const float* sp = p.SUM + ((((size_t)b * 2 + dir) * 17 + q) * 512 + head * 64 + tid) * 2;
        hcarry = sp[0] * hcarry + sp[1];
      }
    }
    for (int chunk = sbd * 8; chunk < sbd * 8 + 8; ++chunk) {
      const int pbase = chunk * 32;
      const int seg0 = (pbase < 256) ? 0 : 256;
      {
        int pos = tid >> 3, seg = tid & 7;
        int ch = head * 64 + seg * 8;
        float a[8];
#pragma unroll
        for (int jj = 0; jj < 8; ++jj) a[jj] = cb[ch + jj];
#pragma unroll
        for (int tap = 0; tap < 4; ++tap) {
          int pt = pbase + pos - 3 + tap;
          if (pt >= seg0) {
            int R = pos2row_seq(b, pt, dir);
            uint4 xv = *(const uint4*)(p.U + (size_t)NTOK * 2048 + (size_t)R * 2048 + ch);
            float f[8]; unpack8(xv, f);
#pragma unroll
            for (int jj = 0; jj < 8; ++jj) a[jj] += cw[tap * 512 + ch + jj] * f[jj];
          }
        }
        *(float4*)(xc + pos * 64 + seg * 8) = make_float4(a[0], a[1], a[2], a[3]);
        *(float4*)(xc + pos * 64 + seg * 8 + 4) = make_float4(a[4], a[5], a[6], a[7]);
      }
      __syncthreads();
      {
        float* dstp = which ? pb : pa;
        for (int pi = 0; pi < 16; ++pi) {
          int pos = half * 16 + pi;
          float acc = 0.f;
#pragma unroll
          for (int i4 = 0; i4 < 16; ++i4) {
            float4 xv = *(const float4*)(xc + pos * 64 + i4 * 4);
            acc += xv.x * w[i4 * 4] + xv.y * w[i4 * 4 + 1] + xv.z * w[i4 * 4 + 2] + xv.w * w[i4 * 4 + 3];
          }
          dstp[pos * 64 + j] = acc;
        }
      }
      __syncthreads();
#pragma unroll
      for (int i = 0; i < 8; ++i) {
        int e = tid + 256 * i; int ch = e & 63; int chg = head * 64 + ch;
        float r = sigmf(pa[e] + p.rg_ba[ld * 512 + chg]);
        float gi = sigmf(pb[e] + p.rg_bx[ld * 512 + chg]);
        float la = -8.0f * r * softplusf(-p.rg_lam[ld * 512 + chg]);
        float a = __expf(la);
        float bt = sqrtf(-expm1f(2.f * la)) * gi * xc[e];
        pa[e] = a; pb[e] = bt;
      }
      __syncthreads();
      if (tid < 64) {
        float hh = hcarry;
        for (int pos = 0; pos < 32; ++pos) { float av = pa[pos * 64 + tid]; hh = av * hh + pb[pos * 64 + tid]; pb[pos * 64 + tid] = hh; aprod *= av; }
        hcarry = hh;
      }
      __syncthreads();
      if (PASS == 1) {
        int pos = tid >> 3, seg = tid & 7;
        int R = pos2row_seq(b, pbase + pos, dir);
        int ch = head * 64 + seg * 8;
        uint4* yp = (uint4*)(p.HL + (size_t)R * 1024 + 512 + ch);
        float hv[8];
#pragma unroll
        for (int jj = 0; jj < 8; ++jj) hv[jj] = pb[pos * 64 + seg * 8 + jj];
        if (dir == 1) {
          uint4 prev = *yp; float f[8]; unpack8(prev, f);
          uint4 gv = *(const uint4*)(p.U + (size_t)NTOK * 2048 + (size_t)R * 2048 + 512 + ch); float gf[8]; unpack8(gv, gf);
#pragma unroll
          for (int jj = 0; jj < 8; ++jj) hv[jj] = (hv[jj] + f[jj]) * gf[jj];
        }
        *yp = pack8(hv);
      }
      __syncthreads();
    }
    if (PASS == 0 && tid < 64) {
      float* sp = p.SUM + ((((size_t)b * 2 + dir) * 17 + sbd) * 512 + head * 64 + tid) * 2;
      sp[0] = aprod; sp[1] = hcarry;
    }
    __threadfence();
    __syncthreads();
  }
}

typedef bf16x8 __attribute__((aligned(2))) bf16x8_u;

__device__ __forceinline__ void hy_conv3x8(const u16* col, int t8, int n, float w0, float w1, float w2, float bias, float* out) {
  float f[8]; unpack8(*(const uint4*)(col + t8), f);
  float prev = (t8 > 0) ? bf2f(col[t8 - 1]) : 0.f;
  float next = (t8 + 8 < n) ? bf2f(col[t8 + 8]) : 0.f;
#pragma unroll
  for (int j = 0; j < 8; ++j) {
    float a = (j == 0) ? prev : f[j - 1];
    float cnx = (j == 7) ? next : f[j + 1];
    out[j] = bias + w0 * a + w1 * f[j] + w2 * cnx;
  }
}

__device__ __forceinline__ void hy_task(const P& p, int l, int c, float* sm) {
  const int tid = threadIdx.x, wave = tid >> 6, lane = tid & 63;
  const int r = lane & 31, h = lane >> 5;
  u16* krr = (u16*)sm;
  u16* zs = krr + 8192 + 64;
  float* red = (float*)(zs + 16384);
  const u16* UT = p.U;
  const float* cwp = p.hy_conv_w + (size_t)l * 3 * 1536;
  const float* cbp = p.hy_conv_b + (size_t)l * 1536;
  for (int o = 0; o < 2; ++o) {
    const u16* K = p.KF + (size_t)(o * 512 + c) * 8192;
    float asum = 0.f;
#pragma unroll
    for (int i = 0; i < 4; ++i) {
      int idx = (tid + 256 * i) * 8;
      uint4 v = *(const uint4*)(K + idx);
      *(uint4*)(krr + idx) = v;
      float f[8]; unpack8(v, f);
#pragma unroll
      for (int j = 0; j < 8; ++j) asum += fabsf(f[j]);
    }
    asum = wave_sum(asum);
    if (lane == 0) red[wave] = asum;
    if (o == 0) {
      const float w0 = cwp[c], w1 = cwp[1536 + c], w2 = cwp[3072 + c], bs = cbp[c];
#pragma unroll 1
      for (int e = tid; e < 2048; e += 256) {
        int b = e >> 9, t8 = (e & 511) * 8;
        float f[8];
        hy_conv3x8(UT + (size_t)c * NTOK + b * 4096, t8, 4096, w0, w1, w2, bs, f);
        *(uint4*)(zs + b * 4096 + t8) = pack8(f);
      }
    }
    __syncthreads();
    const float scale = 1.f / (red[0] + red[1] + red[2] + red[3] + 1e-6f);
    const float skip = p.hy_skip[(l * 2 + o) * 512 + c];
    f32x16 acc[2][2];
#pragma unroll
    for (int a = 0; a < 2; ++a)
#pragma unroll
      for (int b = 0; b < 2; ++b)
#pragma unroll
        for (int q = 0; q < 16; ++q) acc[a][b][q] = 0.f;
    const int I0 = wave * 16;
    const int Il0 = I0 + (r >> 2), Il1 = I0 + 8 + (r >> 2);
    const u16* zb = zs + (r & 3) * 4096 + 8 * h;
    const int ybase = 4096 - r + 8 * h + 48;
    bf16x8 F0, F1, F2, F3, F4, F5;
    {
      const u16* kp = krr + (ybase - 64 * (I0 - 63));
      F0 = *(const bf16x8_u*)(kp); F1 = *(const bf16x8_u*)(kp - 16); F2 = *(const bf16x8_u*)(kp - 32);
      F3 = *(const bf16x8_u*)(kp - 48); F4 = *(const bf16x8_u*)(kp - 64); F5 = *(const bf16x8_u*)(kp - 80);
    }
#pragma unroll 1
    for (int D = I0 - 63; D <= I0 + 15; ++D) {
      bf16x8 B0[4], B1[4];
      {
        int J0 = Il0 - D, J1 = Il1 - D;
        bool ok0 = (unsigned)J0 < 64u, ok1 = (unsigned)J1 < 64u;
        const u16* zp0 = zb + 64 * J0; const u16* zp1 = zb + 64 * J1;
#pragma unroll
        for (int ks = 0; ks < 4; ++ks) {
          bf16x8 z0 = {0, 0, 0, 0, 0, 0, 0, 0}, z1 = {0, 0, 0, 0, 0, 0, 0, 0};
          if (ok0) z0 = *(const bf16x8*)(zp0 + 16 * ks);
          if (ok1) z1 = *(const bf16x8*)(zp1 + 16 * ks);
          B0[ks] = z0; B1[ks] = z1;
        }
      }
      acc[0][0] = __builtin_amdgcn_mfma_f32_32x32x16_bf16(F3, B0[0], acc[0][0], 0, 0, 0);
      acc[0][1] = __builtin_amdgcn_mfma_f32_32x32x16_bf16(F3, B1[0], acc[0][1], 0, 0, 0);
      acc[1][0] = __builtin_amdgcn_mfma_f32_32x32x16_bf16(F5, B0[0], acc[1][0], 0, 0, 0);
      acc[1][1] = __builtin_amdgcn_mfma_f32_32x32x16_bf16(F5, B1[0], acc[1][1], 0, 0, 0);
      acc[0][0] = __builtin_amdgcn_mfma_f32_32x32x16_bf16(F2, B0[1], acc[0][0], 0, 0, 0);
      acc[0][1] = __builtin_amdgcn_mfma_f32_32x32x16_bf16(F2, B1[1], acc[0][1], 0, 0, 0);
      acc[1][0] = __builtin_amdgcn_mfma_f32_32x32x16_bf16(F4, B0[1], acc[1][0], 0, 0, 0);
      acc[1][1] = __builtin_amdgcn_mfma_f32_32x32x16_bf16(F4, B1[1], acc[1][1], 0, 0, 0);
      acc[0][0] = __builtin_amdgcn_mfma_f32_32x32x16_bf16(F1, B0[2], acc[0][0], 0, 0, 0);
      acc[0][1] = __builtin_amdgcn_mfma_f32_32x32x16_bf16(F1, B1[2], acc[0][1], 0, 0, 0);
      acc[1][0] = __builtin_amdgcn_mfma_f32_32x32x16_bf16(F3, B0[2], acc[1][0], 0, 0, 0);
      acc[1][1] = __builtin_amdgcn_mfma_f32_32x32x16_bf16(F3, B1[2], acc[1][1], 0, 0, 0);
      acc[0][0] = __builtin_amdgcn_mfma_f32_32x32x16_bf16(F0, B0[3], acc[0][0], 0, 0, 0);
      acc[0][1] = __builtin_amdgcn_mfma_f32_32x32x16_bf16(F0, B1[3], acc[0][1], 0, 0, 0);
      acc[1][0] = __builtin_amdgcn_mfma_f32_32x32x16_bf16(F2, B0[3], acc[1][0], 0, 0, 0);
      acc[1][1] = __builtin_amdgcn_mfma_f32_32x32x16_bf16(F2, B1[3], acc[1][1], 0, 0, 0);
      F0 = F4; F1 = F5;
      if (D < I0 + 15) {
        const u16* kp = krr + (ybase - 64 * (D + 1));
        F2 = *(const bf16x8_u*)(kp - 32); F3 = *(const bf16x8_u*)(kp - 48);
        F4 = *(const bf16x8_u*)(kp - 64); F5 = *(const bf16x8_u*)(kp - 80);
      }
    }
    __syncthreads();
#pragma unroll
    for (int ni = 0; ni < 2; ++ni) {
      u16* zc = zs + (r & 3) * 4096 + 64 * (ni ? Il1 : Il0);
#pragma unroll
      for (int mi = 0; mi < 2; ++mi)
#pragma unroll
        for (int q = 0; q < 16; ++q) {
          int i = 32 * mi + (q & 3) + 8 * (q >> 2) + 4 * h;
          float zo = bf2f(zc[i]);
          zc[i] = f2bf(scale * acc[mi][ni][q] + skip * zo);
        }
    }
    __syncthreads();
    {
      const int ch = (o + 1) * 512 + c;
      const float w0 = cwp[ch], w1 = cwp[1536 + ch], w2 = cwp[3072 + ch], bs = cbp[ch];
#pragma unroll 1
      for (int e = tid; e < 2048; e += 256) {
        int b = e >> 9, t8 = (e & 511) * 8;
        float xg[8], y[8];
        hy_conv3x8(UT + (size_t)ch * NTOK + b * 4096, t8, 4096, w0, w1, w2, bs, xg);
        unpack8(*(const uint4*)(zs + b * 4096 + t8), y);
#pragma unroll
        for (int j = 0; j < 8; ++j) y[j] *= xg[j];
        if (o == 0) *(uint4*)(zs + b * 4096 + t8) = pack8(y);
        else {
          float gf[8]; unpack8(*(const uint4*)(UT + (size_t)(1536 + c) * NTOK + b * 4096 + t8), gf);
          size_t R = (size_t)b * 4096 + t8;
#pragma unroll
          for (int j = 0; j < 8; ++j) p.HL[(R + j) * 1024 + c] = f2bf(y[j] * gf[j]);
        }
      }
    }
    __syncthreads();
  }
  if (l == 0) {
    const int t = tid;
    for (int o = 0; o < 2; ++o) {
      const u16* K = p.KFC + (size_t)(o * 512 + c) * 512;
      float asum = 0.f;
      {
        uint32_t w2 = *(const uint32_t*)(K + tid * 2);
        *(uint32_t*)(krr + tid * 2) = w2;
        asum = fabsf(bflo(w2)) + fabsf(bfhi(w2));
      }
      asum = wave_sum(asum);
      if (lane == 0) red[wave] = asum;
      if (o == 0) {
        const float w0 = cwp[c], w1 = cwp[1536 + c], w2 = cwp[3072 + c], bs = cbp[c];
        if (tid < 128) {
          int b = tid >> 5, t8 = (tid & 31) * 8;
          float f[8];
          hy_conv3x8(UT + (size_t)c * NTOK + NLAT + b * 256, t8, 256, w0, w1, w2, bs, f);
          *(uint4*)(zs + b * 4096 + t8) = pack8(f);
        }
      }
      __syncthreads();
      const float scale = 1.f / (red[0] + red[1] + red[2] + red[3] + 1e-6f);
      float a0 = 0, a1 = 0, a2 = 0, a3 = 0;
      for (int s2 = 0; s2 < 256; ++s2) {
        float kv = bf2f(krr[256 - t + s2]);
        a0 += kv * bf2f(zs[s2]); a1 += kv * bf2f(zs[4096 + s2]); a2 += kv * bf2f(zs[8192 + s2]); a3 += kv * bf2f(zs[12288 + s2]);
      }
      const float skip = p.hy_skip[(l * 2 + o) * 512 + c];
      float y[4];
      y[0] = scale * a0 + skip * bf2f(zs[t]); y[1] = scale * a1 + skip * bf2f(zs[4096 + t]);
      y[2] = scale * a2 + skip * bf2f(zs[8192 + t]); y[3] = scale * a3 + skip * bf2f(zs[12288 + t]);
      __syncthreads();
      {
        const int ch = (o + 1) * 512 + c;
        const float w0 = cwp[ch], w1 = cwp[1536 + ch], w2 = cwp[3072 + ch], bs = cbp[ch];
#pragma unroll
        for (int b = 0; b < 4; ++b) {
          const u16* col = UT + (size_t)ch * NTOK + NLAT + b * 256;
          float xg = bs + w1 * bf2f(col[t]);
          if (t > 0) xg += w0 * bf2f(col[t - 1]);
          if (t < 255) xg += w2 * bf2f(col[t + 1]);
          float zn = xg * y[b];
          if (o == 0) zs[b * 4096 + t] = f2bf(zn);
          else {
            size_t R = (size_t)NLAT + b * 256 + t;
            float gate = bf2f(UT[(size_t)(1536 + c) * NTOK + R]);
            p.HL[R * 1024 + c] = f2bf(zn * gate);
          }
        }
      }
      __syncthreads();
    }
  }
}

__device__ __forceinline__ void fin_rows(const P& p, int l, int chunk) {
  const int tid = threadIdx.x, wave = tid >> 6, lane = tid & 63;
  for (int rr = 0; rr < 16; ++rr) {
    int R = chunk * 64 + wave * 16 + rr;
    {
      uint4* yp = (uint4*)(p.Y2 + (size_t)R * 1024 + lane * 8);
      float o[8]; unpack8(*yp, o);
      float ss = 0;
#pragma unroll
      for (int j = 0; j < 8; ++j) ss += o[j] * o[j];
      ss += __shfl_xor(ss, 1); ss += __shfl_xor(ss, 2); ss += __shfl_xor(ss, 4); ss += __shfl_xor(ss, 8);
      float rinv = rsqrtf(ss * (1.f / 128.f) + EPS);
      float gf[8]; unpack8(*(const uint4*)(p.U + (size_t)NTOK * 2048 + (size_t)R * 2048 + 1024 + lane * 8), gf);
#pragma unroll
      for (int j = 0; j < 8; ++j) o[j] = o[j] * rinv * p.hg_norm_w[l * 512 + lane * 8 + j] * gf[j];
      *yp = pack8(o);
    }
    {
      uint4* yp = (uint4*)(p.Y2 + (size_t)R * 1024 + 512 + lane * 8);
      float o[8]; unpack8(*yp, o);
      float gf[8]; unpack8(*(const uint4*)(p.U + (size_t)NTOK * 2048 + (size_t)R * 2048 + 1536 + lane * 8), gf);
      float ss = 0;
#pragma unroll
      for (int j = 0; j < 8; ++j) { o[j] *= gf[j]; ss += o[j] * o[j]; }
      ss += __shfl_xor(ss, 1); ss += __shfl_xor(ss, 2); ss += __shfl_xor(ss, 4); ss += __shfl_xor(ss, 8); ss += __shfl_xor(ss, 16);
      float rinv = rsqrtf(ss * (1.f / 256.f) + EPS);
#pragma unroll
      for (int j = 0; j < 8; ++j) o[j] = o[j] * rinv * p.m2_norm_w[l * 512 + lane * 8 + j];
      *yp = pack8(o);
    }
  }
}

__device__ __forceinline__ void ph_mixB(const P& p, int l, int bid, int nb, float* sm) {
  for (int t = bid; t < 544 + 512; t += nb) {
    if (t < 544) { if (EN_RG) rg_task<0>(p, l, t, sm); }
    else { if (EN_HY) hy_task(p, l, t - 544, sm); }
    __syncthreads();
  }
}
__device__ __forceinline__ void ph_mixB2(const P& p, int l, int bid, int nb, float* sm) {
  const int nfin = (l == 0 ? NTOK : NLAT) / 64;
  for (int t = bid; t < 544 + nfin; t += nb) {
    if (t < 544) { if (EN_RG) rg_task<1>(p, l, t, sm); }
    else fin_rows(p, l, t - 544);
    __syncthreads();
  }
}
__device__ __forceinline__ void ph_final(const P& p, int bid, int nb) {
  const int tid = threadIdx.x, wave = tid >> 6, lane = tid & 63;
  for (int R = bid * 4 + wave; R < NLAT; R += nb * 4) {
    float4* rp = (float4*)(p.out + (size_t)R * 1024);
    float4 v[4]; float ss = 0;
#pragma unroll
    for (int i = 0; i < 4; ++i) {
      v[i] = rp[lane + i * 64];
      ss += v[i].x * v[i].x + v[i].y * v[i].y + v[i].z * v[i].z + v[i].w * v[i].w;
    }
    ss = wave_sum(ss);
    float rinv = rsqrtf(ss * (1.f / 1024.f) + EPS);
#pragma unroll
    for (int i = 0; i < 4; ++i) {
      float4 w = *(const float4*)(p.final_norm_w + (lane + i * 64) * 4);
      float4 o; o.x = v[i].x * rinv * w.x; o.y = v[i].y * rinv * w.y; o.z = v[i].z * rinv * w.z; o.w = v[i].w * rinv * w.w;
      rp[lane + i * 64] = o;
    }
  }
}

#define SMEM_BYTES 50176
__global__ void __launch_bounds__(256) mega(P p) {
  __shared__ __align__(16) unsigned char smem[SMEM_BYTES];
  cg::grid_group grid = cg::this_grid();
  const int bid = blockIdx.x, nb = gridDim.x;
  float* smf = (float*)smem; u16* smh = (u16*)smem;
#ifndef PHM
#define PHM 0xffff
#endif
  if (PHM & 1) ph_mod(p, bid, nb, smf);
  grid.sync();
  for (int l = 0; l < 2; ++l) {
    if (PHM & 2) ph_norm(p, l, bid, nb);
    if (PHM & 4) ph_wconv(p, l, bid, nb, smf);
    grid.sync();
    if (PHM & 16) ph_gemm<0>(p, l, bid, nb, smh);
    grid.sync();
    if (PHM & 32) ph_mixA0(p, l, bid, nb, smem);
    grid.sync();
    if (PHM & 32) ph_mixA1(p, l, bid, nb, smem);
    grid.sync();
    if (PHM & 64) ph_gemm<1>(p, l, bid, nb, smh);
    if (PHM & 8) ph_filt(p, l, bid, nb, smf);
    grid.sync();
#if PROBE_DUP == 2
    ph_mixB(p, l, bid, nb, smf);
    grid.sync();
#endif
#if PROBE_DUP == 4
    ph_gemm<1>(p, l, bid, nb, smh);
    grid.sync();
#endif
    if (PHM & 128) ph_mixB(p, l, bid, nb, smf);
    grid.sync();
    if (PHM & 128) ph_mixB2(p, l, bid, nb, smf);
    grid.sync();
    if (PHM & 256) ph_gemm<2>(p, l, bid, nb, smh);
    grid.sync();
  }
  if (PHM & 512) ph_final(p, bid, nb);
}

extern "C" void kernel_launch(void* const* d_in, const int* in_sizes, int n_in, void* d_out, int out_size,
                              void* d_ws, size_t ws_size, hipStream_t stream) {
  static int grid_blocks = 0;
  if (!grid_blocks) {
    int dev = 0, cus = 0, per_cu = 0;
    hipGetDevice(&dev);
    hipDeviceGetAttribute(&cus, hipDeviceAttributeMultiprocessorCount, dev);
    hipOccupancyMaxActiveBlocksPerMultiprocessor(&per_cu, mega, 256, 0);
    if (per_cu < 1) per_cu = 1;
    if (per_cu > 2) per_cu = 2;
    grid_blocks = cus * per_cu;
  }
  P p{};
  const float** fp = (const float**)&p;
  for (int i = 0; i < 34; ++i) fp[i] = (const float*)d_in[i];
  p.out = (float*)d_out;
  char* w = (char*)d_ws;
  size_t off = 0;
  auto take = [&](size_t bytes) { char* r = w + off; off += (bytes + 255) & ~(size_t)255; return r; };
  p.U = (u16*)take((size_t)NTOK * UW * 2);
  p.HL = (u16*)take((size_t)NTOK * 1024 * 2);
  p.Y2 = (u16*)take((size_t)NTOK * 1024 * 2);
  p.WT = (u16*)take((size_t)7296 * 1024 * 2);
  p.WoT = (u16*)take((size_t)1024 * 2048 * 2);
  p.KF = (u16*)take((size_t)1024 * 8192 * 2);
  p.KFC = (u16*)take((size_t)1024 * 512 * 2);
  p.XC = (float*)take((size_t)1024 * 1024 * 4);
  p.DT = (float*)take((size_t)NTOK * 8 * 4);
  p.MOD = (float*)take((size_t)2 * 5 * 3072 * 4);
  p.SUM = (float*)take((size_t)4 * 2 * 17 * 512 * 2 * 4);
  p.SSH = (float*)take((size_t)16 * 2 * 4 * 65536);
  p.PS = (float*)take((size_t)16 * 2 * 4 * 128 * 4);
  p.PA = (float*)take((size_t)16 * 2 * 8 * 4 * 4);
  if (off > ws_size) { fprintf(stderr, "workspace too small: need %zu have %zu\n", off, ws_size); return; }
  void* args[] = {&p};
  hipError_t e = hipLaunchCooperativeKernel((void*)mega, dim3(grid_blocks), dim3(256), args, 0, stream);
  if (e != hipSuccess) fprintf(stderr, "cooperative launch failed: %s (grid %d)\n", hipGetErrorString(e), grid_blocks);
}
```

```cpp
#include <hip/hip_runtime.h>
#include <hip/hip_bf16.h>
#include <hip/hip_cooperative_groups.h>
#include <cstdio>
#include <cstdint>
namespace cg = cooperative_groups;

typedef unsigned short u16;
using bf16x8 = __attribute__((ext_vector_type(8))) short;
using f32x16 = __attribute__((ext_vector_type(16))) float;

#define NTOK 17408
#define NLAT 16384
#define UW 4096
#define EPS 1e-6f

#ifndef PROBE_DUP
#define PROBE_DUP 0
#endif
#ifndef EN_HY
#define EN_HY 1
#endif
#ifndef EN_RG
#define EN_RG 1
#endif
#ifndef EN_HG
#define EN_HG 1
#endif
#ifndef EN_M2
#define EN_M2 1
#endif

struct P {
  const float *x, *c, *ctx, *c_ctx, *w_mod, *b_mod, *norm_w, *w_in, *w_out;
  const float *hy_conv_w, *hy_conv_b, *hy_w1, *hy_b1, *hy_w2, *hy_b2, *hy_w3, *hy_freq, *hy_skip;
  const float *rg_conv_w, *rg_conv_b, *rg_wa, *rg_ba, *rg_wx, *rg_bx, *rg_lam;
  const float *hg_lb, *hg_norm_w, *m2_conv_w, *m2_conv_b, *m2_dt_bias, *m2_a_log, *m2_d, *m2_norm_w, *final_norm_w;
  float* out;
  u16 *U, *HL, *Y2, *WT, *WoT, *KF, *KFC;
  float *XC, *DT, *MOD, *SUM, *SSH, *PS, *PA;
};

typedef __bf16 bf2_t __attribute__((ext_vector_type(2)));
typedef float f2_t __attribute__((ext_vector_type(2)));
__device__ __forceinline__ uint32_t pack2(float a, float b) {
  f2_t v = {a, b};
  return __builtin_bit_cast(uint32_t, __builtin_convertvector(v, bf2_t));
}
__device__ __forceinline__ u16 f2bf(float f) { return (u16)(pack2(f, f) & 0xffffu); }
__device__ __forceinline__ float bf2f(u16 h) { return __uint_as_float(((uint32_t)h) << 16); }
__device__ __forceinline__ float bflo(uint32_t w) { return __uint_as_float(w << 16); }
__device__ __forceinline__ float bfhi(uint32_t w) { return __uint_as_float(w & 0xffff0000u); }
__device__ __forceinline__ float siluf(float x) { return x * __builtin_amdgcn_rcpf(1.f + __expf(-x)); }
__device__ __forceinline__ float sigmf(float x) { return __builtin_amdgcn_rcpf(1.f + __expf(-x)); }
__device__ __forceinline__ float softplusf(float x) { return x > 20.f ? x : log1pf(__expf(x)); }

__device__ __forceinline__ void unpack8(const uint4& v, float* f) {
  f[0] = bflo(v.x); f[1] = bfhi(v.x); f[2] = bflo(v.y); f[3] = bfhi(v.y);
  f[4] = bflo(v.z); f[5] = bfhi(v.z); f[6] = bflo(v.w); f[7] = bfhi(v.w);
}
__device__ __forceinline__ uint4 pack8(const float* f) {
  uint4 v; v.x = pack2(f[0], f[1]); v.y = pack2(f[2], f[3]); v.z = pack2(f[4], f[5]); v.w = pack2(f[6], f[7]);
  return v;
}
__device__ __forceinline__ float wave_sum(float v) {
#pragma unroll
  for (int o = 32; o >= 1; o >>= 1) v += __shfl_xor(v, o);
  return v;
}

__device__ __forceinline__ int pos2row_seq(int b, int p, int dir) {
  if (p < 256) { int t = dir ? 255 - p : p; return NLAT + b * 256 + t; }
  int j = p - 256; int t = dir ? 4095 - j : j; return b * 4096 + t;
}
__device__ __forceinline__ int pos2row_m2(int b, int p, int dir) {
  if (p < 256) { int t = dir ? 255 - p : p; return NLAT + b * 256 + t; }
  int j = p - 256; int jj = dir ? 4095 - j : j; int c = jj >> 6, r = jj & 63; return b * 4096 + r * 64 + c;
}

__device__ __forceinline__ void ph_mod(const P& p, int bid, int nb, float* sm) {
  const int tid = threadIdx.x;
  for (int task = bid; task < 96; task += nb) {
    int l = task / 48, cgi = task % 48;
    int col = cgi * 64 + (tid & 63);
    int kq = tid >> 6;
    float a0 = 0, a1 = 0, a2 = 0, a3 = 0, a4 = 0;
    for (int k = kq * 256; k < kq * 256 + 256; ++k) {
      float w = p.w_mod[((size_t)l * 1024 + k) * 3072 + col];
      a0 += siluf(p.c[k]) * w; a1 += siluf(p.c[1024 + k]) * w; a2 += siluf(p.c[2048 + k]) * w;
      a3 += siluf(p.c[3072 + k]) * w; a4 += siluf(p.c_ctx[k]) * w;
    }
    sm[(kq * 5 + 0) * 64 + (tid & 63)] = a0; sm[(kq * 5 + 1) * 64 + (tid & 63)] = a1;
    sm[(kq * 5 + 2) * 64 + (tid & 63)] = a2; sm[(kq * 5 + 3) * 64 + (tid & 63)] = a3;
    sm[(kq * 5 + 4) * 64 + (tid & 63)] = a4;
    __syncthreads();
    if (tid < 64) {
      float bm = p.b_mod[l * 3072 + col];
#pragma unroll
      for (int j = 0; j < 5; ++j) {
        float s = sm[(0 * 5 + j) * 64 + tid] + sm[(1 * 5 + j) * 64 + tid] + sm[(2 * 5 + j) * 64 + tid] + sm[(3 * 5 + j) * 64 + tid];
        p.MOD[(size_t)(l * 5 + j) * 3072 + col] = s + bm;
      }
    }
    __syncthreads();
  }
}

__device__ __forceinline__ void ph_norm(const P& p, int l, int bid, int nb) {
  const int tid = threadIdx.x, wave = tid >> 6, lane = tid & 63;
  for (int R = bid * 4 + wave; R < NTOK; R += nb * 4) {
    const float* src; int mj;
    if (R < NLAT) { src = (l == 0 ? p.x : (const float*)p.out) + (size_t)R * 1024; mj = R >> 12; }
    else { int rc = R - NLAT; src = (l == 0 ? p.ctx : (const float*)p.XC) + (size_t)rc * 1024; mj = 4; }
    const float* mod = p.MOD + (size_t)(l * 5 + mj) * 3072;
    float4 v[4]; float ss = 0;
#pragma unroll
    for (int i = 0; i < 4; ++i) {
      v[i] = ((const float4*)src)[lane + i * 64];
      ss += v[i].x * v[i].x + v[i].y * v[i].y + v[i].z * v[i].z + v[i].w * v[i].w;
    }
    ss = wave_sum(ss);
    float rinv = rsqrtf(ss * (1.f / 1024.f) + EPS);
#pragma unroll
    for (int i = 0; i < 4; ++i) {
      int idx = (lane + i * 64) * 4;
      float4 nw = *(const float4*)(p.norm_w + l * 1024 + idx);
      float4 sh = *(const float4*)(mod + idx);
      float4 sc = *(const float4*)(mod + 1024 + idx);
      float h0 = v[i].x * rinv * nw.x * (1.f + sc.x) + sh.x;
      float h1 = v[i].y * rinv * nw.y * (1.f + sc.y) + sh.y;
      float h2 = v[i].z * rinv * nw.z * (1.f + sc.z) + sh.z;
      float h3 = v[i].w * rinv * nw.w * (1.f + sc.w) + sh.w;
      uint2 o; o.x = pack2(h0, h1); o.y = pack2(h2, h3);
      *(uint2*)(p.HL + (size_t)R * 1024 + idx) = o;
    }
  }
}

__device__ __forceinline__ void ph_wconv(const P& p, int l, int bid, int nb, float* sm) {
  const int tid = threadIdx.x;
  const int T1 = 114 * 16, T2 = 16 * 32;
  for (int t = bid; t < T1 + T2; t += nb) {
    const float* src; int ld, K, n0, k0, sc0, nvalid; u16* dst;
    if (t < T1) {
      int nt = t / 16, kt = t % 16; n0 = nt * 64; k0 = kt * 64;
      src = p.w_in + (size_t)l * 1024 * 7176; ld = 7176; K = 1024; dst = p.WT; nvalid = 64;
      if (n0 < 2048) sc0 = 3072 + n0;
      else if (n0 < 3072) sc0 = 5632 + (n0 - 2048);
      else if (n0 < 3200) { sc0 = 6656 + (n0 - 3072); nvalid = (n0 == 3072) ? 8 : 0; }
      else { int m = n0 - 3200; if (m < 3072) sc0 = m; else if (m < 3584) sc0 = 5120 + (m - 3072); else sc0 = 6664 + (m - 3584); }
    } else {
      int tt = t - T1; int nt = tt / 32, kt = tt % 32; n0 = nt * 64; k0 = kt * 64;
      src = p.w_out + (size_t)l * 2048 * 1024; ld = 1024; K = 2048; dst = p.WoT; nvalid = 64; sc0 = n0;
    }
#pragma unroll
    for (int i = 0; i < 4; ++i) {
      int kk = (tid >> 4) + 16 * i, cc = (tid & 15) * 4;
      const float* sp = src + (size_t)(k0 + kk) * ld + sc0 + cc;
      float4 v;
      if (nvalid == 64) v = *(const float4*)sp;
      else { v.x = (cc + 0 < nvalid) ? sp[0] : 0.f; v.y = (cc + 1 < nvalid) ? sp[1] : 0.f; v.z = (cc + 2 < nvalid) ? sp[2] : 0.f; v.w = (cc + 3 < nvalid) ? sp[3] : 0.f; }
      sm[kk * 65 + cc + 0] = v.x; sm[kk * 65 + cc + 1] = v.y; sm[kk * 65 + cc + 2] = v.z; sm[kk * 65 + cc + 3] = v.w;
    }
    __syncthreads();
#pragma unroll
    for (int i = 0; i < 2; ++i) {
      int q = tid + 256 * i; int nn = q >> 3, ks = q & 7;
      float f[8];
#pragma unroll
      for (int j = 0; j < 8; ++j) f[j] = sm[(ks * 8 + j) * 65 + nn];
      *(uint4*)(dst + (size_t)(n0 + nn) * K + k0 + ks * 8) = pack8(f);
    }
    __syncthreads();
  }
}

__device__ __forceinline__ void ph_filt(const P& p, int l, int bid, int nb, float* sm) {
  const int tid = threadIdx.x;
  const float HY_MIN = -3.0701134573253945f, HY_MAX = -15.350567286626972f;
  int ntask = 256 + (l == 0 ? 16 : 0);
  float* zs = sm; float* h1 = sm + 544; float* h2 = sm + 544 + 1024;
  for (int task = bid; task < ntask; task += nb) {
    int n, t0; u16* K;
    if (task < 256) { n = 4096; t0 = task * 16; K = p.KF; } else { n = 256; t0 = (task - 256) * 16; K = p.KFC; }
    float inv_nm1 = 1.f / (float)(n - 1);
    for (int e = tid; e < 16 * 33; e += 256) {
      int tt = e / 33, f = e % 33; int t = t0 + tt; float val;
      if (f == 0) val = (float)t * inv_nm1;
      else {
        int bi = (f - 1) & 15;
        float band = 1e-4f + (float)bi * ((15.f - 1e-4f) / 15.f);
        float ang = (6.283185307179586f / (float)n) * (float)t * band;
        val = (f <= 16) ? cosf(ang) : -sinf(ang);
      }
      zs[e] = val;
    }
    __syncthreads();
    for (int e = tid; e < 1024; e += 256) {
      int tt = e >> 6, j = e & 63; float acc = p.hy_b1[l * 64 + j];
      for (int f = 0; f < 33; ++f) acc += zs[tt * 33 + f] * p.hy_w1[(l * 33 + f) * 64 + j];
      h1[e] = sinf(p.hy_freq[l * 64 + j] * acc);
    }
    __syncthreads();
    for (int e = tid; e < 1024; e += 256) {
      int tt = e >> 6, j = e & 63; float acc = p.hy_b2[l * 64 + j];
      for (int i = 0; i < 64; ++i) acc += h1[tt * 64 + i] * p.hy_w2[(l * 64 + i) * 64 + j];
      h2[e] = sinf(p.hy_freq[l * 64 + j] * acc);
    }
    __syncthreads();
    for (int r = 0; r < 8; ++r) {
      int col = tid + 256 * r; int o = col >> 10, side = (col >> 9) & 1, c = col & 511;
      float w[64];
#pragma unroll
      for (int i = 0; i < 64; ++i) w[i] = p.hy_w3[(size_t)(l * 64 + i) * 2048 + col];
      float delta = fabsf(HY_MIN + (HY_MAX - HY_MIN) * (float)c / 511.f);
      u16* Kc = K + (size_t)(o * 512 + c) * (2 * n);
      for (int tt = 0; tt < 16; ++tt) {
        float acc = 0;
#pragma unroll
        for (int i = 0; i < 64; ++i) acc += h2[tt * 64 + i] * w[i];
        int t = t0 + tt;
        float val = acc * __expf(-(float)t * inv_nm1 * delta);
        int idx;
        if (side == 0) idx = n - t; else { if (t == 0) { idx = 0; val = 0.f; } else idx = n + t; }
        Kc[idx] = f2bf(val);
      }
    }
    __syncthreads();
  }
}

#define LDSTR 72
template <int MODE>
__device__ __forceinline__ void gemm_tile(const P& p, int l, int mt, int nt, u16* sA, u16* sB) {
  const int tid = threadIdx.x, wave = tid >> 6, lane = tid & 63;
  const int wm = wave >> 1, wn = wave & 1;
  const int KT = (MODE == 2) ? 2048 : 1024;
  const u16* Bsrc = (MODE == 0) ? p.WT + (size_t)(nt * 128) * 1024
                  : (MODE == 1) ? p.WT + (size_t)(3200 + nt * 128) * 1024
                                : p.WoT + (size_t)(nt * 128) * 2048;
  f32x16 acc[2][2];
#pragma unroll
  for (int a = 0; a < 2; ++a)
#pragma unroll
    for (int b = 0; b < 2; ++b)
#pragma unroll
      for (int r = 0; r < 16; ++r) acc[a][b][r] = 0.f;

  uint4 ra0, ra1, ra2, ra3, rb0, rb1, rb2, rb3;
  const int lrow = tid >> 3, lseg = tid & 7;
#define GLOAD1(K0, I, RA, RB)                                                                       \
  {                                                                                                 \
    int row = lrow + 32 * (I); int k = (K0) + lseg * 8;                                             \
    const u16* ap;                                                                                  \
    if (MODE == 2) ap = (k < 1024) ? p.HL + (size_t)(mt * 128 + row) * 1024 + k                     \
                                   : p.Y2 + (size_t)(mt * 128 + row) * 1024 + (k - 1024);           \
    else ap = p.HL + (size_t)(mt * 128 + row) * 1024 + k;                                           \
    RA = *(const uint4*)ap;                                                                         \
    RB = *(const uint4*)(Bsrc + (size_t)row * KT + k);                                              \
  }
#define GLOAD(K0) GLOAD1(K0, 0, ra0, rb0) GLOAD1(K0, 1, ra1, rb1) GLOAD1(K0, 2, ra2, rb2) GLOAD1(K0, 3, ra3, rb3)
  GLOAD(0)
  for (int k0 = 0; k0 < KT; k0 += 64) {
    *(uint4*)(sA + (lrow + 0) * LDSTR + lseg * 8) = ra0;  *(uint4*)(sB + (lrow + 0) * LDSTR + lseg * 8) = rb0;
    *(uint4*)(sA + (lrow + 32) * LDSTR + lseg * 8) = ra1; *(uint4*)(sB + (lrow + 32) * LDSTR + lseg * 8) = rb1;
    *(uint4*)(sA + (lrow + 64) * LDSTR + lseg * 8) = ra2; *(uint4*)(sB + (lrow + 64) * LDSTR + lseg * 8) = rb2;
    *(uint4*)(sA + (lrow + 96) * LDSTR + lseg * 8) = ra3; *(uint4*)(sB + (lrow + 96) * LDSTR + lseg * 8) = rb3;
    __syncthreads();
    if (k0 + 64 < KT) { GLOAD(k0 + 64) }
#pragma unroll
    for (int ks = 0; ks < 4; ++ks) {
      bf16x8 fa[2], fb[2];
#pragma unroll
      for (int mi = 0; mi < 2; ++mi)
        fa[mi] = *(const bf16x8*)(sA + (wm * 64 + mi * 32 + (lane & 31)) * LDSTR + ks * 16 + (lane >> 5) * 8);
#pragma unroll
      for (int ni = 0; ni < 2; ++ni)
        fb[ni] = *(const bf16x8*)(sB + (wn * 64 + ni * 32 + (lane & 31)) * LDSTR + ks * 16 + (lane >> 5) * 8);
#pragma unroll
      for (int mi = 0; mi < 2; ++mi)
#pragma unroll
        for (int ni = 0; ni < 2; ++ni)
          acc[mi][ni] = __builtin_amdgcn_mfma_f32_32x32x16_bf16(fa[mi], fb[ni], acc[mi][ni], 0, 0, 0);
    }
    __syncthreads();
  }
  const int mj = (mt < 128) ? (mt >> 5) : 4;
#pragma unroll
  for (int ni = 0; ni < 2; ++ni) {
    const int col = wn * 64 + ni * 32 + (lane & 31);
    const int gcol = nt * 128 + col;
    float lb = 0.f; float gmod = 0.f;
    if (MODE == 0) {
      int piece = gcol >> 9;
      if (l == 1 && (piece == 1 || piece == 2)) {
        int dir = piece - 1, ch = gcol & 511;
        float l0 = p.hg_lb[(0 * 2 + dir) * 512 + ch], l1 = p.hg_lb[(1 * 2 + dir) * 512 + ch];
        lb = 1.f / (1.f + __expf(l0 - l1));
      }
    }
    if (MODE == 2) gmod = p.MOD[(size_t)(l * 5 + mj) * 3072 + 2048 + gcol];
#pragma unroll
    for (int mi = 0; mi < 2; ++mi) {
#pragma unroll
      for (int r = 0; r < 16; ++r) {
        const int row = wm * 64 + mi * 32 + (r & 3) + 8 * (r >> 2) + 4 * (lane >> 5);
        const int R = mt * 128 + row;
        float v = acc[mi][ni][r];
        if (MODE == 0) {
          if (nt < 24) {
            int piece = gcol >> 9;
            if (piece == 0) v *= 0.08838834764831845f;
            else if (piece == 1 || piece == 2) v = (1.f - lb) * __builtin_amdgcn_rcpf(1.f + __expf(v));
            p.U[(size_t)R * UW + gcol] = f2bf(v);
          } else {
            if (col < 8) p.DT[(size_t)R * 8 + col] = v;
          }
        } else if (MODE == 1) {
          int piece = gcol >> 9;
          if (piece == 3 || piece >= 5) v = siluf(v);
          if (nt >= 16) p.U[(size_t)NTOK * 2048 + (size_t)R * 2048 + (gcol - 2048)] = f2bf(v);
          else acc[mi][ni][r] = v;
        } else {
          if (R < NLAT) {
            const float* base = (l == 0) ? p.x : (const float*)p.out;
            float xv = base[(size_t)R * 1024 + gcol];
            p.out[(size_t)R * 1024 + gcol] = xv + gmod * v;
          } else {
            int rc = R - NLAT;
            p.XC[(size_t)rc * 1024 + gcol] = p.ctx[(size_t)rc * 1024 + gcol] + gmod * v;
          }
        }
      }
      if (MODE == 1 && nt < 16) {
#pragma unroll
        for (int g4 = 0; g4 < 4; ++g4) {
          int R0 = mt * 128 + wm * 64 + mi * 32 + 8 * g4 + 4 * (lane >> 5);
          uint2 o; o.x = pack2(acc[mi][ni][4 * g4], acc[mi][ni][4 * g4 + 1]); o.y = pack2(acc[mi][ni][4 * g4 + 2], acc[mi][ni][4 * g4 + 3]);
          *(uint2*)(p.U + (size_t)gcol * NTOK + R0) = o;
        }
      }
    }
  }
}

template <int MODE>
__device__ __forceinline__ void ph_gemm(const P& p, int l, int bid, int nb, u16* sm) {
  const int NT = (MODE == 0) ? 25 : (MODE == 1) ? 32 : 8;
  const int MT = (MODE == 2 && l == 1) ? 128 : 136;
  u16* sA = sm; u16* sB = sm + 128 * LDSTR;
  for (int t = bid; t < MT * NT; t += nb) {
    int nt = t / MT, mt = t % MT;
    gemm_tile<MODE>(p, l, mt, nt, sA, sB);
  }
}

__device__ __forceinline__ void hg_task(const P& p, int l, int task, float* sm) {
  const int tid = threadIdx.x, wave = tid >> 6, lane = tid & 63;
  const int b = task >> 5, h = (task >> 3) & 3, es = task & 7;
  const int dg = lane & 15, el = lane >> 4;
  float* qs = sm; float* ks = sm + 4096; float* vs = sm + 8192; float* os = sm + 8192 + 512;
  for (int dir = 0; dir < 2; ++dir) {
    float S[8];
#pragma unroll
    for (int r = 0; r < 8; ++r) S[r] = 0.f;
    for (int chunk = 0; chunk < 136; ++chunk) {
#pragma unroll
      for (int i = 0; i < 2; ++i) {
        int q = tid + 256 * i; int pos = q >> 4, seg = q & 15;
        int R = pos2row_seq(b, chunk * 32 + pos, dir);
        const u16* up = p.U + (size_t)R * UW + h * 128 + seg * 8;
        uint4 qv = *(const uint4*)up;
        uint4 kv = *(const uint4*)(up + 512 + dir * 512);
        float f[8];
        unpack8(qv, f);
        *(float4*)(qs + pos * 128 + seg * 8) = make_float4(f[0], f[1], f[2], f[3]);
        *(float4*)(qs + pos * 128 + seg * 8 + 4) = make_float4(f[4], f[5], f[6], f[7]);
        unpack8(kv, f);
        *(float4*)(ks + pos * 128 + seg * 8) = make_float4(f[0], f[1], f[2], f[3]);
        *(float4*)(ks + pos * 128 + seg * 8 + 4) = make_float4(f[4], f[5], f[6], f[7]);
      }
      {
        int pos = tid >> 3, e2 = (tid & 7) * 2;
        int R = pos2row_seq(b, chunk * 32 + pos, dir);
        uint32_t w = *(const uint32_t*)(p.U + (size_t)R * UW + 1536 + h * 128 + es * 16 + e2);
        vs[pos * 16 + e2] = bflo(w); vs[pos * 16 + e2 + 1] = bfhi(w);
      }
      __syncthreads();
#pragma unroll 4
      for (int i = 0; i < 32; ++i) {
        float4 q0 = *(const float4*)(qs + i * 128 + dg * 8), q1 = *(const float4*)(qs + i * 128 + dg * 8 + 4);
        float4 k0 = *(const float4*)(ks + i * 128 + dg * 8), k1 = *(const float4*)(ks + i * 128 + dg * 8 + 4);
        float v = vs[i * 16 + wave * 4 + el];
        S[0] += k0.x * (v - S[0]); S[1] += k0.y * (v - S[1]); S[2] += k0.z * (v - S[2]); S[3] += k0.w * (v - S[3]);
        S[4] += k1.x * (v - S[4]); S[5] += k1.y * (v - S[5]); S[6] += k1.z * (v - S[6]); S[7] += k1.w * (v - S[7]);
        float o = q0.x * S[0] + q0.y * S[1] + q0.z * S[2] + q0.w * S[3] + q1.x * S[4] + q1.y * S[5] + q1.z * S[6] + q1.w * S[7];
        o += __shfl_xor(o, 1); o += __shfl_xor(o, 2); o += __shfl_xor(o, 4); o += __shfl_xor(o, 8);
        if (dg == 0) os[i * 16 + wave * 4 + el] = o;
      }
      __syncthreads();
      {
        int pos = tid >> 3, e2 = (tid & 7) * 2;
        int R = pos2row_seq(b, chunk * 32 + pos, dir);
        uint32_t* yp = (uint32_t*)(p.Y2 + (size_t)R * 1024 + h * 128 + es * 16 + e2);
        float o0 = os[pos * 16 + e2], o1 = os[pos * 16 + e2 + 1];
        if (dir == 1) { uint32_t w = *yp; o0 += bflo(w); o1 += bfhi(w); }
        *yp = pack2(o0, o1);
      }
    }
    __threadfence();
    __syncthreads();
  }
}

__device__ __forceinline__ void m2_task(const P& p, int l, int task, float* sm) {
  const int tid = threadIdx.x, wave = tid >> 6, lane = tid & 63;
  const int b = task >> 5, head = (task >> 2) & 7, ps = task & 3;
  const int g = head >> 2;
  const int dg = lane & 15, el = lane >> 4;
  float* Cs = sm; float* Bs = sm + 4096; float* xs = sm + 8192; float* os = sm + 8192 + 512;
  float* dts = sm + 8192 + 1024; float* decs = dts + 32;
  for (int dir = 0; dir < 2; ++dir) {
    const float* cw = p.m2_conv_w + (size_t)(l * 2 + dir) * 4 * 1024;
    const float* cb = p.m2_conv_b + (size_t)(l * 2 + dir) * 1024;
    const float dtb = p.m2_dt_bias[(l * 2 + dir) * 8 + head];
    const float Aneg = -__expf(p.m2_a_log[(l * 2 + dir) * 8 + head]);
    const float Dsk = p.m2_d[(l * 2 + dir) * 8 + head];
    float S[8];
#pragma unroll
    for (int r = 0; r < 8; ++r) S[r] = 0.f;
    for (int chunk = 0; chunk < 136; ++chunk) {
      const int pbase = chunk * 32;
      const int seg0 = (pbase < 256) ? 0 : 256;
#pragma unroll
      for (int i = 0; i < 2; ++i) {
        int q = tid + 256 * i; int pos = q >> 4, seg = q & 15;
        int pp = pbase + pos;
        int chB = 512 + g * 128 + seg * 8, chC = 768 + g * 128 + seg * 8;
        float aB[8], aC[8];
#pragma unroll
        for (int j = 0; j < 8; ++j) { aB[j] = cb[chB + j]; aC[j] = cb[chC + j]; }
#pragma unroll
        for (int tap = 0; tap < 4; ++tap) {
          int pt = pp - 3 + tap;
          if (pt >= seg0) {
            int R = pos2row_m2(b, pt, dir);
            const u16* up = p.U + (size_t)R * UW + 2048;
            uint4 bv = *(const uint4*)(up + chB);
            uint4 cv = *(const uint4*)(up + chC);
            float f[8];
            unpack8(bv, f);
#pragma unroll
            for (int j = 0; j < 8; ++j) aB[j] += cw[tap * 1024 + chB + j] * f[j];
            unpack8(cv, f);
#pragma unroll
            for (int j = 0; j < 8; ++j) aC[j] += cw[tap * 1024 + chC + j] * f[j];
          }
        }
#pragma unroll
        for (int j = 0; j < 8; ++j) { aB[j] = siluf(aB[j]); aC[j] = siluf(aC[j]); }
        *(float4*)(Bs + pos * 128 + seg * 8) = make_float4(aB[0], aB[1], aB[2], aB[3]);
        *(float4*)(Bs + pos * 128 + seg * 8 + 4) = make_float4(aB[4], aB[5], aB[6], aB[7]);
        *(float4*)(Cs + pos * 128 + seg * 8) = make_float4(aC[0], aC[1], aC[2], aC[3]);
        *(float4*)(Cs + pos * 128 + seg * 8 + 4) = make_float4(aC[4], aC[5], aC[6], aC[7]);
      }
      {
        int pos = tid >> 3, e2 = (tid & 7) * 2;
        int pp = pbase + pos;
        int ch = head * 64 + ps * 16 + e2;
        float a0 = cb[ch], a1 = cb[ch + 1];
#pragma unroll
        for (int tap = 0; tap < 4; ++tap) {
          int pt = pp - 3 + tap;
          if (pt >= seg0) {
            int R = pos2row_m2(b, pt, dir);
            uint32_t w = *(const uint32_t*)(p.U + (size_t)R * UW + 2048 + ch);
            a0 += cw[tap * 1024 + ch] * bflo(w); a1 += cw[tap * 1024 + ch + 1] * bfhi(w);
          }
        }
        xs[pos * 16 + e2] = siluf(a0); xs[pos * 16 + e2 + 1] = siluf(a1);
      }
      if (tid < 32) {
        int R = pos2row_m2(b, pbase + tid, dir);
        float dtv = softplusf(p.DT[(size_t)R * 8 + head] + dtb);
        dts[tid] = dtv; decs[tid] = __expf(dtv * Aneg);
      }
      __syncthreads();
#pragma unroll 4
      for (int i = 0; i < 32; ++i) {
        float4 q0 = *(const float4*)(Cs + i * 128 + dg * 8), q1 = *(const float4*)(Cs + i * 128 + dg * 8 + 4);
        float4 k0 = *(const float4*)(Bs + i * 128 + dg * 8), k1 = *(const float4*)(Bs + i * 128 + dg * 8 + 4);
        float xv = xs[i * 16 + wave * 4 + el];
        float a = decs[i]; float v = xv * dts[i];
        S[0] = a * S[0] + k0.x * v; S[1] = a * S[1] + k0.y * v; S[2] = a * S[2] + k0.z * v; S[3] = a * S[3] + k0.w * v;
        S[4] = a * S[4] + k1.x * v; S[5] = a * S[5] + k1.y * v; S[6] = a * S[6] + k1.z * v; S[7] = a * S[7] + k1.w * v;
        float o = q0.x * S[0] + q0.y * S[1] + q0.z * S[2] + q0.w * S[3] + q1.x * S[4] + q1.y * S[5] + q1.z * S[6] + q1.w * S[7];
        o += __shfl_xor(o, 1); o += __shfl_xor(o, 2); o += __shfl_xor(o, 4); o += __shfl_xor(o, 8);
        if (dg == 0) os[i * 16 + wave * 4 + el] = o + Dsk * xv;
      }
      __syncthreads();
      {
        int pos = tid >> 3, e2 = (tid & 7) * 2;
        int R = pos2row_m2(b, pbase + pos, dir);
        uint32_t* yp = (uint32_t*)(p.Y2 + (size_t)R * 1024 + 512 + head * 64 + ps * 16 + e2);
        float o0 = os[pos * 16 + e2], o1 = os[pos * 16 + e2 + 1];
        if (dir == 1) { uint32_t w = *yp; o0 += bflo(w); o1 += bfhi(w); }
        *yp = pack2(o0, o1);
      }
    }
    __threadfence();
    __syncthreads();
  }
}

#ifndef M2_MFMA
#define M2_MFMA 1
#endif
#define QS 136
#define TS 40
union FragU { bf16x8 v; uint32_t u[4]; uint2 d[2]; uint4 q; };
__device__ __forceinline__ bf16x8 cvt_frag(const f32x16& x, int s2) {
  FragU f;
  f.u[0] = pack2(x[8 * s2 + 0], x[8 * s2 + 1]); f.u[1] = pack2(x[8 * s2 + 2], x[8 * s2 + 3]);
  f.u[2] = pack2(x[8 * s2 + 4], x[8 * s2 + 5]); f.u[3] = pack2(x[8 * s2 + 6], x[8 * s2 + 7]);
  return f.v;
}
__device__ __forceinline__ bf16x8 ld_frag_perm(const u16* base) {
  FragU f; f.d[0] = *(const uint2*)base; f.d[1] = *(const uint2*)(base + 8); return f.v;
}

template <int PASS>
__device__ __forceinline__ void hg_mfma(const P& p, int l, int task, int blk, int dir0, unsigned char* smem) {
  const int tid = threadIdx.x, wave = tid >> 6, lane = tid & 63;
  const int r = lane & 31, hh = lane >> 5;
  const int b = task >> 2, h = task & 3;
  u16* ks = (u16*)smem;
  u16* qs = ks + 32 * QS;
  u16* kT = qs + 32 * QS;
  u16* vT = kT + 128 * TS;
  float* tot = (float*)(vT + 128 * TS);
  float* eg = tot + 256;
  const int dd = tid & 127, half = tid >> 7;
  for (int dir = (PASS == 0 ? dir0 : 0); dir < (PASS == 0 ? dir0 + 1 : 2); ++dir) {
    const int sbd = (PASS == 0) ? blk : ((blk == 0) ? 0 : (dir ? 5 - blk : blk));
    const int c0 = (sbd == 0) ? 0 : 8 + 32 * (sbd - 1);
    const int c1 = (sbd == 0) ? 8 : 8 + 32 * sbd;
    float gsum = 0.f;
    f32x16 S[4];
#pragma unroll
    for (int i = 0; i < 4; ++i)
#pragma unroll
      for (int q = 0; q < 16; ++q) S[i][q] = 0.f;
    if (PASS == 1) {
      for (int qb = 0; qb < sbd; ++qb) {
        const size_t sidx = (size_t)((task * 2 + dir) * 4 + qb);
        if (half == 0) eg[dd] = __expf(p.PS[sidx * 128 + dd]);
        __syncthreads();
        const float* sp = p.SSH + sidx * 16384 + (size_t)wave * 4096 + lane;
#pragma unroll
        for (int dt = 0; dt < 4; ++dt)
#pragma unroll
          for (int q4 = 0; q4 < 4; ++q4) {
            float4 e4 = *(const float4*)(eg + 32 * dt + 8 * q4 + 4 * hh);
            S[dt][4 * q4 + 0] = S[dt][4 * q4 + 0] * e4.x + sp[(dt * 16 + 4 * q4 + 0) * 64];
            S[dt][4 * q4 + 1] = S[dt][4 * q4 + 1] * e4.y + sp[(dt * 16 + 4 * q4 + 1) * 64];
            S[dt][4 * q4 + 2] = S[dt][4 * q4 + 2] * e4.z + sp[(dt * 16 + 4 * q4 + 2) * 64];
            S[dt][4 * q4 + 3] = S[dt][4 * q4 + 3] * e4.w + sp[(dt * 16 + 4 * q4 + 3) * 64];
          }
        __syncthreads();
      }
    }
    uint4 pq0, pq1, pk0, pk1, pv0, pv1;
#define HG_PREFETCH(CH)                                                                     \
    {                                                                                       \
      int pos0 = tid >> 4, seg = tid & 15;                                                  \
      int R0 = pos2row_seq(b, (CH) * 32 + pos0, dir), R1 = pos2row_seq(b, (CH) * 32 + pos0 + 16, dir); \
      const u16* u0 = p.U + (size_t)R0 * UW + h * 128 + seg * 8;                            \
      const u16* u1 = p.U + (size_t)R1 * UW + h * 128 + seg * 8;                            \
      pq0 = *(const uint4*)u0; pq1 = *(const uint4*)u1;                                     \
      pk0 = *(const uint4*)(u0 + 512 + dir * 512); pk1 = *(const uint4*)(u1 + 512 + dir * 512); \
      pv0 = *(const uint4*)(u0 + 1536); pv1 = *(const uint4*)(u1 + 1536);                   \
    }
    HG_PREFETCH(c0)
#pragma unroll 1
    for (int chunk = c0; chunk < c1; ++chunk) {
      {
        int pos0 = tid >> 4, seg = tid & 15;
        *(uint4*)(qs + pos0 * QS + seg * 8) = pq0; *(uint4*)(qs + (pos0 + 16) * QS + seg * 8) = pq1;
        *(uint4*)(ks + pos0 * QS + seg * 8) = pk0; *(uint4*)(ks + (pos0 + 16) * QS + seg * 8) = pk1;
        FragU f0, f1; f0.q = pv0; f1.q = pv1;
#pragma unroll
        for (int j = 0; j < 4; ++j) {
          vT[(seg * 8 + 2 * j) * TS + pos0] = (u16)(f0.u[j] & 0xffffu); vT[(seg * 8 + 2 * j + 1) * TS + pos0] = (u16)(f0.u[j] >> 16);
          vT[(seg * 8 + 2 * j) * TS + pos0 + 16] = (u16)(f1.u[j] & 0xffffu); vT[(seg * 8 + 2 * j + 1) * TS + pos0 + 16] = (u16)(f1.u[j] >> 16);
        }
      }
      __syncthreads();
      if (chunk + 1 < c1) HG_PREFETCH(chunk + 1)
      const int Rout = pos2row_seq(b, chunk * 32 + r, dir);
      u16* yrow = p.Y2 + (size_t)Rout * 1024 + h * 128 + wave * 32 + 4 * hh;
      uint2 yold[4];
      if (PASS == 1 && dir == 1) {
#pragma unroll
        for (int q4 = 0; q4 < 4; ++q4) yold[q4] = *(const uint2*)(yrow + 8 * q4);
      }
      float gl[16];
      {
        float run = 0.f;
#pragma unroll
        for (int i = 0; i < 16; ++i) {
          float kkv = bf2f(ks[(half * 16 + i) * QS + dd]);
          run += __logf(fmaxf(1.f - kkv, 1e-6f));
          gl[i] = run;
        }
        tot[half * 128 + dd] = run;
      }
      __syncthreads();
      {
        const float t0 = tot[dd], t1 = tot[128 + dd];
        const float off = half ? t0 : 0.f;
        const float g31 = t0 + t1;
        float k2[16];
#pragma unroll
        for (int i = 0; i < 16; ++i) {
          const int pos = half * 16 + i;
          const float g = gl[i] + off;
          const float kkv = bf2f(ks[pos * QS + dd]);
          const float qv = bf2f(qs[pos * QS + dd]);
          qs[pos * QS + dd] = f2bf(qv * __expf(g));
          ks[pos * QS + dd] = f2bf(kkv * __expf(fminf(-g, 60.f)));
          k2[i] = kkv * __expf(g31 - g);
        }
        *(uint4*)(kT + dd * TS + half * 16) = pack8(k2);
        *(uint4*)(kT + dd * TS + half * 16 + 8) = pack8(k2 + 8);
        if (half == 0) eg[dd] = __expf(g31);
        gsum += g31;
      }
      __syncthreads();
      f32x16 O;
      if (PASS == 1) {
      f32x16 att;
#pragma unroll
      for (int q = 0; q < 16; ++q) att[q] = 0.f;
#pragma unroll
      for (int k8 = 0; k8 < 8; ++k8) {
        bf16x8 A = *(const bf16x8*)(ks + r * QS + 16 * k8 + 8 * hh);
        bf16x8 B = *(const bf16x8*)(qs + r * QS + 16 * k8 + 8 * hh);
        att = __builtin_amdgcn_mfma_f32_32x32x16_bf16(A, B, att, 0, 0, 0);
      }
#pragma unroll
      for (int q = 0; q < 16; ++q) {
        int sidx = (q & 3) + 8 * (q >> 2) + 4 * hh;
        if (sidx > r) att[q] = 0.f;
      }
#pragma unroll
      for (int q = 0; q < 16; ++q) O[q] = 0.f;
#pragma unroll
      for (int dt = 0; dt < 4; ++dt)
#pragma unroll
        for (int s2 = 0; s2 < 2; ++s2) {
          bf16x8 A = cvt_frag(S[dt], s2);
          bf16x8 B = ld_frag_perm(qs + r * QS + 32 * dt + 16 * s2 + 4 * hh);
          O = __builtin_amdgcn_mfma_f32_32x32x16_bf16(A, B, O, 0, 0, 0);
        }
#pragma unroll
      for (int s2 = 0; s2 < 2; ++s2) {
        bf16x8 A = ld_frag_perm(vT + (32 * wave + r) * TS + 16 * s2 + 4 * hh);
        bf16x8 B = cvt_frag(att, s2);
        O = __builtin_amdgcn_mfma_f32_32x32x16_bf16(A, B, O, 0, 0, 0);
      }
      }
#pragma unroll
      for (int dt = 0; dt < 4; ++dt) {
#pragma unroll
        for (int q4 = 0; q4 < 4; ++q4) {
          float4 e4 = *(const float4*)(eg + 32 * dt + 8 * q4 + 4 * hh);
          S[dt][4 * q4 + 0] *= e4.x; S[dt][4 * q4 + 1] *= e4.y; S[dt][4 * q4 + 2] *= e4.z; S[dt][4 * q4 + 3] *= e4.w;
        }
#pragma unroll
        for (int s2 = 0; s2 < 2; ++s2) {
          bf16x8 A = *(const bf16x8*)(kT + (32 * dt + r) * TS + 16 * s2 + 8 * hh);
          bf16x8 B = *(const bf16x8*)(vT + (32 * wave + r) * TS + 16 * s2 + 8 * hh);
          S[dt] = __builtin_amdgcn_mfma_f32_32x32x16_bf16(A, B, S[dt], 0, 0, 0);
        }
      }
      if (PASS == 1) {
#pragma unroll
      for (int q4 = 0; q4 < 4; ++q4) {
        float o0 = O[4 * q4], o1 = O[4 * q4 + 1], o2 = O[4 * q4 + 2], o3 = O[4 * q4 + 3];
        if (dir == 1) { o0 += bflo(yold[q4].x); o1 += bfhi(yold[q4].x); o2 += bflo(yold[q4].y); o3 += bfhi(yold[q4].y); }
        uint2 ov; ov.x = pack2(o0, o1); ov.y = pack2(o2, o3);
        *(uint2*)(yrow + 8 * q4) = ov;
      }
      }
      __syncthreads();
    }
    if (PASS == 0) {
      const size_t sidx = (size_t)((task * 2 + dir) * 4 + sbd);
      if (half == 0) p.PS[sidx * 128 + dd] = gsum;
      float* sp = p.SSH + sidx * 16384 + (size_t)wave * 4096 + lane;
#pragma unroll
      for (int dt = 0; dt < 4; ++dt)
#pragma unroll
        for (int q = 0; q < 16; ++q) sp[(dt * 16 + q) * 64] = S[dt][q];
    }
    __threadfence();
    __syncthreads();
  }
}

#if M2_MFMA
#define M2_NTASK 16
template <int PASS>
__device__ __forceinline__ void m2_mfma(const P& p, int l, int task, int blk, int dir0, unsigned char* smem) {
  const int tid = threadIdx.x, wave = tid >> 6, lane = tid & 63;
  const int r = lane & 31, hh = lane >> 5;
  const int b = task >> 2, g = (task >> 1) & 1, hp = task & 1;
  const int hq = wave >> 1, ph = wave & 1;
  const int head = 4 * g + 2 * hp + hq;
  u16* Bm = (u16*)smem;
  u16* Cm = Bm + 32 * QS;
  u16* BmT = Cm + 32 * QS;
  u16* xsT = BmT + 128 * TS;
  float* Gs = (float*)(xsT + 128 * TS);
  float* dts = Gs + 64;
  float* wl = dts + 64;
  const int cp = (lane < 48) ? lane : 47;
  const bool act = lane < 48;
  const int chW = (cp < 16) ? ((4 * g + 2 * hp) * 64 + cp * 8) : (cp < 32) ? (512 + g * 128 + (cp - 16) * 8) : (768 + g * 128 + (cp - 32) * 8);
  const int chU = 2048 + chW;
  float* SSM = (float*)p.KF;
  for (int dir = (PASS == 0 ? dir0 : 0); dir < (PASS == 0 ? dir0 + 1 : 2); ++dir) {
    const int sbd = (PASS == 0) ? blk : ((blk == 0) ? 0 : (dir ? 9 - blk : blk));
    const int c0 = (sbd == 0) ? 0 : 8 + 16 * (sbd - 1);
    const int c1 = (sbd == 0) ? 8 : 8 + 16 * sbd;
    float lsum = 0.f;
    const float* cw = p.m2_conv_w + (size_t)(l * 2 + dir) * 4 * 1024;
    const float* cb = p.m2_conv_b + (size_t)(l * 2 + dir) * 1024;
    if (wave == 0) {
#pragma unroll
      for (int j = 0; j < 8; ++j) {
        wl[(4 * 8 + j) * 64 + lane] = cb[chW + j];
#pragma unroll
        for (int tap = 0; tap < 4; ++tap) wl[(tap * 8 + j) * 64 + lane] = cw[tap * 1024 + chW + j];
      }
    }
    __syncthreads();
    const int hd_t = 4 * g + 2 * hp + ((tid >> 5) & 1);
    const float dtb = p.m2_dt_bias[(l * 2 + dir) * 8 + hd_t];
    const float Aneg_t = -__expf(p.m2_a_log[(l * 2 + dir) * 8 + hd_t]);
    const float Dsk = p.m2_d[(l * 2 + dir) * 8 + head];
    f32x16 S[4];
#pragma unroll
    for (int i = 0; i < 4; ++i)
#pragma unroll
      for (int q = 0; q < 16; ++q) S[i][q] = 0.f;
    if (PASS == 1) {
      for (int qb = 0; qb < sbd; ++qb) {
        const size_t sidx = (size_t)((task * 2 + dir) * 8 + qb);
        const float a = __expf(p.PA[sidx * 4 + wave]);
        const float* sp = SSM + sidx * 16384 + (size_t)wave * 4096 + lane;
#pragma unroll
        for (int nt = 0; nt < 4; ++nt)
#pragma unroll
          for (int q = 0; q < 16; ++q) S[nt][q] = S[nt][q] * a + sp[(nt * 16 + q) * 64];
      }
    }
    uint4 raw0, raw1, raw2, raw3, raw4, raw5, raw6, raw7, raw8, raw9, raw10;
    float dtraw = 0.f;
#define M2_LD1(RW, I, CH)                                                                  \
    {                                                                                      \
      int pt = (CH) * 32 + wave * 8 + (I) - 3;                                             \
      int sg0 = ((CH) * 32 < 256) ? 0 : 256;                                               \
      if (pt >= sg0) { int Rr = pos2row_m2(b, pt, dir); RW = *(const uint4*)(p.U + (size_t)Rr * UW + chU); } \
      else RW = make_uint4(0u, 0u, 0u, 0u);                                                \
    }
#define M2_PREFETCH(CH)                                                                    \
    M2_LD1(raw0, 0, CH) M2_LD1(raw1, 1, CH) M2_LD1(raw2, 2, CH) M2_LD1(raw3, 3, CH) M2_LD1(raw4, 4, CH) M2_LD1(raw5, 5, CH) \
    M2_LD1(raw6, 6, CH) M2_LD1(raw7, 7, CH) M2_LD1(raw8, 8, CH) M2_LD1(raw9, 9, CH) M2_LD1(raw10, 10, CH)            \
    if (tid < 64) { int Rr = pos2row_m2(b, (CH) * 32 + (tid & 31), dir); dtraw = p.DT[(size_t)Rr * 8 + hd_t]; }
    M2_PREFETCH(c0)
#pragma unroll 1
    for (int chunk = c0; chunk < c1; ++chunk) {
      {
#define M2_RAWF(RW, J) (((J) & 1) ? bfhi((RW)) : bflo((RW)))
#define M2_CH(J, C0, C1, C2, C3, C4, C5, C6, C7, C8, C9, C10)                               \
        {                                                                                  \
          const float q0 = wl[(0 * 8 + (J)) * 64 + lane], q1 = wl[(1 * 8 + (J)) * 64 + lane]; \
          const float q2 = wl[(2 * 8 + (J)) * 64 + lane], q3 = wl[(3 * 8 + (J)) * 64 + lane]; \
          const float qb = wl[(4 * 8 + (J)) * 64 + lane];                                  \
          const float v0 = M2_RAWF(C0, J), v1 = M2_RAWF(C1, J), v2 = M2_RAWF(C2, J), v3 = M2_RAWF(C3, J); \
          const float v4 = M2_RAWF(C4, J), v5 = M2_RAWF(C5, J), v6 = M2_RAWF(C6, J), v7 = M2_RAWF(C7, J); \
          const float v8 = M2_RAWF(C8, J), v9 = M2_RAWF(C9, J), v10 = M2_RAWF(C10, J);      \
          float o[8];                                                                      \
          o[0] = siluf(qb + q0 * v0 + q1 * v1 + q2 * v2 + q3 * v3);                        \
          o[1] = siluf(qb + q0 * v1 + q1 * v2 + q2 * v3 + q3 * v4);                        \
          o[2] = siluf(qb + q0 * v2 + q1 * v3 + q2 * v4 + q3 * v5);                        \
          o[3] = siluf(qb + q0 * v3 + q1 * v4 + q2 * v5 + q3 * v6);                        \
          o[4] = siluf(qb + q0 * v4 + q1 * v5 + q2 * v6 + q3 * v7);                        \
          o[5] = siluf(qb + q0 * v5 + q1 * v6 + q2 * v7 + q3 * v8);                        \
          o[6] = siluf(qb + q0 * v6 + q1 * v7 + q2 * v8 + q3 * v9);                        \
          o[7] = siluf(qb + q0 * v7 + q1 * v8 + q2 * v9 + q3 * v10);                       \
          if (act) {                                                                       \
            if (cp < 16) {                                                                 \
              *(uint4*)(xsT + (cp * 8 + (J)) * TS + wave * 8) = pack8(o);                  \
            } else if (cp < 32) {                                                          \
              *(uint4*)(BmT + ((cp - 16) * 8 + (J)) * TS + wave * 8) = pack8(o);           \
              _Pragma("unroll") for (int i = 0; i < 8; ++i) Bm[(wave * 8 + i) * QS + (cp - 16) * 8 + (J)] = f2bf(o[i]); \
            } else {                                                                       \
              _Pragma("unroll") for (int i = 0; i < 8; ++i) Cm[(wave * 8 + i) * QS + (cp - 32) * 8 + (J)] = f2bf(o[i]); \
            }                                                                              \
          }                                                                                \
        }
        M2_CH(0, raw0.x, raw1.x, raw2.x, raw3.x, raw4.x, raw5.x, raw6.x, raw7.x, raw8.x, raw9.x, raw10.x)
        M2_CH(1, raw0.x, raw1.x, raw2.x, raw3.x, raw4.x, raw5.x, raw6.x, raw7.x, raw8.x, raw9.x, raw10.x)
        M2_CH(2, raw0.y, raw1.y, raw2.y, raw3.y, raw4.y, raw5.y, raw6.y, raw7.y, raw8.y, raw9.y, raw10.y)
        M2_CH(3, raw0.y, raw1.y, raw2.y, raw3.y, raw4.y, raw5.y, raw6.y, raw7.y, raw8.y, raw9.y, raw10.y)
        M2_CH(4, raw0.z, raw1.z, raw2.z, raw3.z, raw4.z, raw5.z, raw6.z, raw7.z, raw8.z, raw9.z, raw10.z)
        M2_CH(5, raw0.z, raw1.z, raw2.z, raw3.z, raw4.z, raw5.z, raw6.z, raw7.z, raw8.z, raw9.z, raw10.z)
        M2_CH(6, raw0.w, raw1.w, raw2.w, raw3.w, raw4.w, raw5.w, raw6.w, raw7.w, raw8.w, raw9.w, raw10.w)
        M2_CH(7, raw0.w, raw1.w, raw2.w, raw3.w, raw4.w, raw5.w, raw6.w, raw7.w, raw8.w, raw9.w, raw10.w)
      }
      if (tid < 64) {
        float dtv = softplusf(dtraw + dtb);
        float run = dtv * Aneg_t;
#pragma unroll
        for (int o = 1; o < 32; o <<= 1) { float n = __shfl_up(run, o, 32); if ((tid & 31) >= o) run += n; }
        Gs[tid] = run; dts[tid] = dtv;
      }
      __syncthreads();
      if (chunk + 1 < c1) { M2_PREFETCH(chunk + 1) }
      const int Rout = pos2row_m2(b, chunk * 32 + r, dir);
      u16* yrow = p.Y2 + (size_t)Rout * 1024 + 512 + head * 64 + 32 * ph + 4 * hh;
      uint2 yold[4];
      if (PASS == 1 && dir == 1) {
#pragma unroll
        for (int i = 0; i < 4; ++i) yold[i] = *(const uint2*)(yrow + 8 * i);
      }
      const float* Gw = Gs + hq * 32; const float* dw = dts + hq * 32;
      const float Gt = Gw[r], G31 = Gw[31];
      lsum += G31;
      const u16* xw = xsT + (hq * 64 + ph * 32) * TS;
      f32x16 O0;
      if (PASS == 1) {
      f32x16 att;
#pragma unroll
      for (int q = 0; q < 16; ++q) att[q] = 0.f;
#pragma unroll
      for (int k8 = 0; k8 < 8; ++k8) {
        bf16x8 A = *(const bf16x8*)(Bm + r * QS + 16 * k8 + 8 * hh);
        bf16x8 B = *(const bf16x8*)(Cm + r * QS + 16 * k8 + 8 * hh);
        att = __builtin_amdgcn_mfma_f32_32x32x16_bf16(A, B, att, 0, 0, 0);
      }
#pragma unroll
      for (int q4 = 0; q4 < 4; ++q4) {
        float4 gs4 = *(const float4*)(Gw + 8 * q4 + 4 * hh);
        float4 dt4 = *(const float4*)(dw + 8 * q4 + 4 * hh);
        int s0 = 8 * q4 + 4 * hh;
        att[4 * q4 + 0] = (s0 + 0 <= r) ? att[4 * q4 + 0] * __expf(Gt - gs4.x) * dt4.x : 0.f;
        att[4 * q4 + 1] = (s0 + 1 <= r) ? att[4 * q4 + 1] * __expf(Gt - gs4.y) * dt4.y : 0.f;
        att[4 * q4 + 2] = (s0 + 2 <= r) ? att[4 * q4 + 2] * __expf(Gt - gs4.z) * dt4.z : 0.f;
        att[4 * q4 + 3] = (s0 + 3 <= r) ? att[4 * q4 + 3] * __expf(Gt - gs4.w) * dt4.w : 0.f;
      }
#pragma unroll
      for (int q = 0; q < 16; ++q) O0[q] = 0.f;
#pragma unroll
      for (int nt = 0; nt < 4; ++nt)
#pragma unroll
        for (int s2 = 0; s2 < 2; ++s2) {
          bf16x8 B = ld_frag_perm(Cm + r * QS + 32 * nt + 16 * s2 + 4 * hh);
          O0 = __builtin_amdgcn_mfma_f32_32x32x16_bf16(cvt_frag(S[nt], s2), B, O0, 0, 0, 0);
        }
      {
        const float eGt = __expf(Gt);
#pragma unroll
        for (int q = 0; q < 16; ++q) O0[q] *= eGt;
      }
#pragma unroll
      for (int s2 = 0; s2 < 2; ++s2) {
        bf16x8 B = cvt_frag(att, s2);
        O0 = __builtin_amdgcn_mfma_f32_32x32x16_bf16(ld_frag_perm(xw + r * TS + 16 * s2 + 4 * hh), B, O0, 0, 0, 0);
      }
#pragma unroll
      for (int q = 0; q < 16; ++q) {
        int pp = (q & 3) + 8 * (q >> 2) + 4 * hh;
        O0[q] += Dsk * bf2f(xw[pp * TS + r]);
      }
      }
      {
        const float eG31 = __expf(G31);
#pragma unroll
        for (int nt = 0; nt < 4; ++nt)
#pragma unroll
          for (int q = 0; q < 16; ++q) S[nt][q] *= eG31;
#pragma unroll
        for (int s2 = 0; s2 < 2; ++s2) {
          float ws[8];
          {
            float4 ga = *(const float4*)(Gw + 16 * s2 + 8 * hh), gb = *(const float4*)(Gw + 16 * s2 + 8 * hh + 4);
            float4 da = *(const float4*)(dw + 16 * s2 + 8 * hh), db = *(const float4*)(dw + 16 * s2 + 8 * hh + 4);
            ws[0] = da.x * __expf(G31 - ga.x); ws[1] = da.y * __expf(G31 - ga.y); ws[2] = da.z * __expf(G31 - ga.z); ws[3] = da.w * __expf(G31 - ga.w);
            ws[4] = db.x * __expf(G31 - gb.x); ws[5] = db.y * __expf(G31 - gb.y); ws[6] = db.z * __expf(G31 - gb.z); ws[7] = db.w * __expf(G31 - gb.w);
          }
          bf16x8 Bf0;
          {
            float f[8]; unpack8(*(const uint4*)(xw + r * TS + 16 * s2 + 8 * hh), f);
#pragma unroll
            for (int j = 0; j < 8; ++j) f[j] *= ws[j];
            FragU u; u.q = pack8(f); Bf0 = u.v;
          }
#pragma unroll
          for (int nt = 0; nt < 4; ++nt) {
            bf16x8 A = *(const bf16x8*)(BmT + (32 * nt + r) * TS + 16 * s2 + 8 * hh);
            S[nt] = __builtin_amdgcn_mfma_f32_32x32x16_bf16(A, Bf0, S[nt], 0, 0, 0);
          }
        }
      }
      if (PASS == 1) {
#pragma unroll
      for (int q4 = 0; q4 < 4; ++q4) {
        float o0 = O0[4 * q4], o1 = O0[4 * q4 + 1], o2 = O0[4 * q4 + 2], o3 = O0[4 * q4 + 3];
        if (dir == 1) { o0 += bflo(yold[q4].x); o1 += bfhi(yold[q4].x); o2 += bflo(yold[q4].y); o3 += bfhi(yold[q4].y); }
        uint2 ov; ov.x = pack2(o0, o1); ov.y = pack2(o2, o3);
        *(uint2*)(yrow + 8 * q4) = ov;
      }
      }
      __syncthreads();
    }
    if (PASS == 0) {
      const size_t sidx = (size_t)((task * 2 + dir) * 8 + sbd);
      if (lane == 0) p.PA[sidx * 4 + wave] = lsum;
      float* sp = SSM + sidx * 16384 + (size_t)wave * 4096 + lane;
#pragma unroll
      for (int nt = 0; nt < 4; ++nt)
#pragma unroll
        for (int q = 0; q < 16; ++q) sp[(nt * 16 + q) * 64] = S[nt][q];
    }
    __threadfence();
    __syncthreads();
  }
}
#endif
__device__ __forceinline__ void ph_mixA0(const P& p, int l, int bid, int nb, unsigned char* sm) {
  for (int i = 0;; ++i) {
    int t;
    if (nb == 256) {
      if (bid < 128) { if (i >= 1) break; t = bid; }
      else { if (i >= 2) break; t = 128 + (bid - 128) + 128 * i; }
    } else { t = bid + i * nb; if (t >= 384) break; }
    if (t < 128) hg_mfma<0>(p, l, t >> 3, (t >> 1) & 3, t & 1, sm);
    else { int u = t - 128; m2_mfma<0>(p, l, u >> 4, (u >> 1) & 7, u & 1, sm); }
    __syncthreads();
  }
}
__device__ __forceinline__ void ph_mixA1(const P& p, int l, int bid, int nb, unsigned char* sm) {
  for (int t = bid; t < 80 + 144; t += nb) {
    if (t < 80) hg_mfma<1>(p, l, t / 5, t % 5, 0, sm);
    else { int u = t - 80; m2_mfma<1>(p, l, u / 9, u % 9, 0, sm); }
    __syncthreads();
  }
}

template <int PASS>
__device__ __forceinline__ void rg_task(const P& p, int l, int task, float* sm) {
  const int tid = threadIdx.x;
  const int b = task / 136, rem = task % 136, head = rem / 17, sb = rem % 17;
  float* xc = sm; float* pa = sm + 2048; float* pb = sm + 4096;
  const int j = tid & 63, which = (tid >> 6) & 1, half = tid >> 7;
  const int spos = tid >> 3, sseg = tid & 7;
  const int sch = head * 64 + sseg * 8;
  const u16* UB2 = p.U + (size_t)NTOK * 2048;
  for (int dir = 0; dir < 2; ++dir) {
    const int ld = l * 2 + dir;
    float w[64];
    {
      const float* wp = (which ? p.rg_wx : p.rg_wa) + (size_t)(ld * 8 + head) * 4096 + j;
#pragma unroll
      for (int i = 0; i < 64; ++i) w[i] = wp[i * 64];
    }
    float wcv[4][8], bcv[8];
#pragma unroll
    for (int jj = 0; jj < 8; ++jj) {
      bcv[jj] = p.rg_conv_b[(size_t)ld * 512 + sch + jj];
#pragma unroll
      for (int tap = 0; tap < 4; ++tap) wcv[tap][jj] = p.rg_conv_w[((size_t)ld * 4 + tap) * 512 + sch + jj];
    }
    const int chg = head * 64 + j;
    const float g_ba = p.rg_ba[ld * 512 + chg], g_bx = p.rg_bx[ld * 512 + chg];
    const float g_sp = -8.0f * softplusf(-p.rg_lam[ld * 512 + chg]);
    const int sbd = (PASS == 0) ? sb : (dir ? (sb == 0 ? 0 : 17 - sb) : sb);
    float hcarry = 0.f, aprod = 1.f;
    if (PASS == 1 && tid < 64) {
      for (int q = 0; q < sbd; ++q) {
        const float* sp = p.SUM + ((((size_t)b * 2 + dir) * 17 + q) * 512 + head * 64 + tid) * 2;
        hcarry = sp[0] * hcarry + sp[1];
      }
    }
    uint4 xr0, xr1, xr2, xr3;
#define RG_LD1(XR, TAP, CH)                                                               \
    {                                                                                     \
      int pt = (CH) * 32 + spos - 3 + (TAP);                                              \
      int sg0 = ((CH) * 32 < 256) ? 0 : 256;                                              \
      if (pt >= sg0) { int Rr = pos2row_seq(b, pt, dir); XR = *(const uint4*)(UB2 + (size_t)Rr * 2048 + sch); } \
      else XR = make_uint4(0u, 0u, 0u, 0u);                                               \
    }
#define RG_PREFETCH(CH) RG_LD1(xr0, 0, CH) RG_LD1(xr1, 1, CH) RG_LD1(xr2, 2, CH) RG_LD1(xr3, 3, CH)
    RG_PREFETCH(sbd * 8)
#pragma unroll 1
    for (int chunk = sbd * 8; chunk < sbd * 8 + 8; ++chunk) {
      const int pbase = chunk * 32;
      {
        float a[8], f[8];
#pragma unroll
        for (int jj = 0; jj < 8; ++jj) a[jj] = bcv[jj];
        unpack8(xr0, f);
#pragma unroll
        for (int jj = 0; jj < 8; ++jj) a[jj] += wcv[0][jj] * f[jj];
        unpack8(xr1, f);
#pragma unroll
        for (int jj = 0; jj < 8; ++jj) a[jj] += wcv[1][jj] * f[jj];
        unpack8(xr2, f);
#pragma unroll
        for (int jj = 0; jj < 8; ++jj) a[jj] += wcv[2][jj] * f[jj];
        unpack8(xr3, f);
#pragma unroll
        for (int jj = 0; jj < 8; ++jj) a[jj] += wcv[3][jj] * f[jj];
        *(float4*)(xc + spos * 64 + sseg * 8) = make_float4(a[0], a[1], a[2], a[3]);
        *(float4*)(xc + spos * 64 + sseg * 8 + 4) = make_float4(a[4], a[5], a[6], a[7]);
      }
      __syncthreads();
      if (chunk + 1 < sbd * 8 + 8) { RG_PREFETCH(chunk + 1) }
      const int Rout = pos2row_seq(b, pbase + spos, dir);
      uint4* yp = (uint4*)(p.HL + (size_t)Rout * 1024 + 512 + sch);
      uint4 prev, gv;
      if (PASS == 1 && dir == 1) { prev = *yp; gv = *(const uint4*)(UB2 + (size_t)Rout * 2048 + 512 + sch); }
      {
        float* dstp = which ? pb : pa;
#pragma unroll 4
        for (int pi = 0; pi < 16; ++pi) {
          int pos = half * 16 + pi;
          float acc = 0.f;
#pragma unroll
          for (int i4 = 0; i4 < 16; ++i4) {
            float4 xv = *(const float4*)(xc + pos * 64 + i4 * 4);
            acc += xv.x * w[i4 * 4] + xv.y * w[i4 * 4 + 1] + xv.z * w[i4 * 4 + 2] + xv.w * w[i4 * 4 + 3];
          }
          dstp[pos * 64 + j] = acc;
        }
      }
      __syncthreads();
#pragma unroll
      for (int i = 0; i < 8; ++i) {
        int e = tid + 256 * i;
        float r = sigmf(pa[e] + g_ba);
        float gi = sigmf(pb[e] + g_bx);
        float la = g_sp * r;
        float a = __expf(la);
        float bt = sqrtf(fmaxf(1.f - a * a, 0.f)) * gi * xc[e];
        pa[e] = a; pb[e] = bt;
      }
      __syncthreads();
      if (tid < 64) {
        float hh = hcarry;
#pragma unroll 8
        for (int pos = 0; pos < 32; ++pos) { float av = pa[pos * 64 + tid]; hh = av * hh + pb[pos * 64 + tid]; pb[pos * 64 + tid] = hh; aprod *= av; }
        hcarry = hh;
      }
      __syncthreads();
      if (PASS == 1) {
        float hv[8];
#pragma unroll
        for (int jj = 0; jj < 8; ++jj) hv[jj] = pb[spos * 64 + sseg * 8 + jj];
        if (dir == 1) {
          float f[8]; unpack8(prev, f);
          float gf[8]; unpack8(gv, gf);
#pragma unroll
          for (int jj = 0; jj < 8; ++jj) hv[jj] = (hv[jj] + f[jj]) * gf[jj];
        }
        *yp = pack8(hv);
      }
      __syncthreads();
    }
    if (PASS == 0 && tid < 64) {
      float* sp = p.SUM + ((((size_t)b * 2 + dir) * 17 + sbd) * 512 + head * 64 + tid) * 2;
      sp[0] = aprod; sp[1] = hcarry;
    }
    __threadfence();
    __syncthreads();
  }
}

typedef bf16x8 __attribute__((aligned(2))) bf16x8_u;

__device__ __forceinline__ void hy_conv3x8(const u16* col, int t8, int n, float w0, float w1, float w2, float bias, float* out) {
  float f[8]; unpack8(*(const uint4*)(col + t8), f);
  float prev = (t8 > 0) ? bf2f(col[t8 - 1]) : 0.f;
  float next = (t8 + 8 < n) ? bf2f(col[t8 + 8]) : 0.f;
#pragma unroll
  for (int j = 0; j < 8; ++j) {
    float a = (j == 0) ? prev : f[j - 1];
    float cnx = (j == 7) ? next : f[j + 1];
    out[j] = bias + w0 * a + w1 * f[j] + w2 * cnx;
  }
}

__device__ __forceinline__ void hy_task(const P& p, int l, int c, float* sm) {
  const int tid = threadIdx.x, wave = tid >> 6, lane = tid & 63;
  const int r = lane & 31, h = lane >> 5;
  u16* krr = (u16*)sm;
  u16* zs = krr + 8192 + 64;
  float* red = (float*)(zs + 16384);
  const u16* UT = p.U;
  const float* cwp = p.hy_conv_w + (size_t)l * 3 * 1536;
  const float* cbp = p.hy_conv_b + (size_t)l * 1536;
  for (int o = 0; o < 2; ++o) {
    const u16* K = p.KF + (size_t)(o * 512 + c) * 8192;
    float asum = 0.f;
#pragma unroll
    for (int i = 0; i < 4; ++i) {
      int idx = (tid + 256 * i) * 8;
      uint4 v = *(const uint4*)(K + idx);
      *(uint4*)(krr + idx) = v;
      float f[8]; unpack8(v, f);
#pragma unroll
      for (int j = 0; j < 8; ++j) asum += fabsf(f[j]);
    }
    asum = wave_sum(asum);
    if (lane == 0) red[wave] = asum;
    if (o == 0) {
      const float w0 = cwp[c], w1 = cwp[1536 + c], w2 = cwp[3072 + c], bs = cbp[c];
#pragma unroll 1
      for (int e = tid; e < 2048; e += 256) {
        int b = e >> 9, t8 = (e & 511) * 8;
        float f[8];
        hy_conv3x8(UT + (size_t)c * NTOK + b * 4096, t8, 4096, w0, w1, w2, bs, f);
        *(uint4*)(zs + b * 4096 + t8) = pack8(f);
      }
    }
    __syncthreads();
    const float scale = 1.f / (red[0] + red[1] + red[2] + red[3] + 1e-6f);
    const float skip = p.hy_skip[(l * 2 + o) * 512 + c];
    f32x16 acc[2][2];
#pragma unroll
    for (int a = 0; a < 2; ++a)
#pragma unroll
      for (int b = 0; b < 2; ++b)
#pragma unroll
        for (int q = 0; q < 16; ++q) acc[a][b][q] = 0.f;
    const int I0 = wave * 16;
    const int Il0 = I0 + (r >> 2), Il1 = I0 + 8 + (r >> 2);
    const u16* zb = zs + (r & 3) * 4096 + 8 * h;
    const int ybase = 4096 - r + 8 * h + 48;
    bf16x8 F0, F1, F2, F3, F4, F5;
    {
      const u16* kp = krr + (ybase - 64 * (I0 - 63));
      F0 = *(const bf16x8_u*)(kp); F1 = *(const bf16x8_u*)(kp - 16); F2 = *(const bf16x8_u*)(kp - 32);
      F3 = *(const bf16x8_u*)(kp - 48); F4 = *(const bf16x8_u*)(kp - 64); F5 = *(const bf16x8_u*)(kp - 80);
    }
#pragma unroll 1
    for (int D = I0 - 63; D <= I0 + 15; ++D) {
      bf16x8 B0[4], B1[4];
      {
        int J0 = Il0 - D, J1 = Il1 - D;
        bool ok0 = (unsigned)J0 < 64u, ok1 = (unsigned)J1 < 64u;
        const u16* zp0 = zb + 64 * J0; const u16* zp1 = zb + 64 * J1;
#pragma unroll
        for (int ks = 0; ks < 4; ++ks) {
          bf16x8 z0 = {0, 0, 0, 0, 0, 0, 0, 0}, z1 = {0, 0, 0, 0, 0, 0, 0, 0};
          if (ok0) z0 = *(const bf16x8*)(zp0 + 16 * ks);
          if (ok1) z1 = *(const bf16x8*)(zp1 + 16 * ks);
          B0[ks] = z0; B1[ks] = z1;
        }
      }
      acc[0][0] = __builtin_amdgcn_mfma_f32_32x32x16_bf16(F3, B0[0], acc[0][0], 0, 0, 0);
      acc[0][1] = __builtin_amdgcn_mfma_f32_32x32x16_bf16(F3, B1[0], acc[0][1], 0, 0, 0);
      acc[1][0] = __builtin_amdgcn_mfma_f32_32x32x16_bf16(F5, B0[0], acc[1][0], 0, 0, 0);
      acc[1][1] = __builtin_amdgcn_mfma_f32_32x32x16_bf16(F5, B1[0], acc[1][1], 0, 0, 0);
      acc[0][0] = __builtin_amdgcn_mfma_f32_32x32x16_bf16(F2, B0[1], acc[0][0], 0, 0, 0);
      acc[0][1] = __builtin_amdgcn_mfma_f32_32x32x16_bf16(F2, B1[1], acc[0][1], 0, 0, 0);
      acc[1][0] = __builtin_amdgcn_mfma_f32_32x32x16_bf16(F4, B0[1], acc[1][0], 0, 0, 0);
      acc[1][1] = __builtin_amdgcn_mfma_f32_32x32x16_bf16(F4, B1[1], acc[1][1], 0, 0, 0);
      acc[0][0] = __builtin_amdgcn_mfma_f32_32x32x16_bf16(F1, B0[2], acc[0][0], 0, 0, 0);
      acc[0][1] = __builtin_amdgcn_mfma_f32_32x32x16_bf16(F1, B1[2], acc[0][1], 0, 0, 0);
      acc[1][0] = __builtin_amdgcn_mfma_f32_32x32x16_bf16(F3, B0[2], acc[1][0], 0, 0, 0);
      acc[1][1] = __builtin_amdgcn_mfma_f32_32x32x16_bf16(F3, B1[2], acc[1][1], 0, 0, 0);
      acc[0][0] = __builtin_amdgcn_mfma_f32_32x32x16_bf16(F0, B0[3], acc[0][0], 0, 0, 0);
      acc[0][1] = __builtin_amdgcn_mfma_f32_32x32x16_bf16(F0, B1[3], acc[0][1], 0, 0, 0);
      acc[1][0] = __builtin_amdgcn_mfma_f32_32x32x16_bf16(F2, B0[3], acc[1][0], 0, 0, 0);
      acc[1][1] = __builtin_amdgcn_mfma_f32_32x32x16_bf16(F2, B1[3], acc[1][1], 0, 0, 0);
      F0 = F4; F1 = F5;
      if (D < I0 + 15) {
        const u16* kp = krr + (ybase - 64 * (D + 1));
        F2 = *(const bf16x8_u*)(kp - 32); F3 = *(const bf16x8_u*)(kp - 48);
        F4 = *(const bf16x8_u*)(kp - 64); F5 = *(const bf16x8_u*)(kp - 80);
      }
    }
    __syncthreads();
#pragma unroll
    for (int ni = 0; ni < 2; ++ni) {
      u16* zc = zs + (r & 3) * 4096 + 64 * (ni ? Il1 : Il0);
#pragma unroll
      for (int mi = 0; mi < 2; ++mi)
#pragma unroll
        for (int q = 0; q < 16; ++q) {
          int i = 32 * mi + (q & 3) + 8 * (q >> 2) + 4 * h;
          float zo = bf2f(zc[i]);
          zc[i] = f2bf(scale * acc[mi][ni][q] + skip * zo);
        }
    }
    __syncthreads();
    {
      const int ch = (o + 1) * 512 + c;
      const float w0 = cwp[ch], w1 = cwp[1536 + ch], w2 = cwp[3072 + ch], bs = cbp[ch];
#pragma unroll 1
      for (int e = tid; e < 2048; e += 256) {
        int b = e >> 9, t8 = (e & 511) * 8;
        float xg[8], y[8];
        hy_conv3x8(UT + (size_t)ch * NTOK + b * 4096, t8, 4096, w0, w1, w2, bs, xg);
        unpack8(*(const uint4*)(zs + b * 4096 + t8), y);
#pragma unroll
        for (int j = 0; j < 8; ++j) y[j] *= xg[j];
        if (o == 0) *(uint4*)(zs + b * 4096 + t8) = pack8(y);
        else {
          float gf[8]; unpack8(*(const uint4*)(UT + (size_t)(1536 + c) * NTOK + b * 4096 + t8), gf);
#pragma unroll
          for (int j = 0; j < 8; ++j) y[j] *= gf[j];
          *(uint4*)(p.U + (size_t)c * NTOK + b * 4096 + t8) = pack8(y);
        }
      }
    }
    __syncthreads();
  }
  if (l == 0) {
    const int t = tid;
    for (int o = 0; o < 2; ++o) {
      const u16* K = p.KFC + (size_t)(o * 512 + c) * 512;
      float asum = 0.f;
      {
        uint32_t w2 = *(const uint32_t*)(K + tid * 2);
        *(uint32_t*)(krr + tid * 2) = w2;
        asum = fabsf(bflo(w2)) + fabsf(bfhi(w2));
      }
      asum = wave_sum(asum);
      if (lane == 0) red[wave] = asum;
      if (o == 0) {
        const float w0 = cwp[c], w1 = cwp[1536 + c], w2 = cwp[3072 + c], bs = cbp[c];
        if (tid < 128) {
          int b = tid >> 5, t8 = (tid & 31) * 8;
          float f[8];
          hy_conv3x8(UT + (size_t)c * NTOK + NLAT + b * 256, t8, 256, w0, w1, w2, bs, f);
          *(uint4*)(zs + b * 4096 + t8) = pack8(f);
        }
      }
      __syncthreads();
      const float scale = 1.f / (red[0] + red[1] + red[2] + red[3] + 1e-6f);
      float a0 = 0, a1 = 0, a2 = 0, a3 = 0;
      for (int s2 = 0; s2 < 256; ++s2) {
        float kv = bf2f(krr[256 - t + s2]);
        a0 += kv * bf2f(zs[s2]); a1 += kv * bf2f(zs[4096 + s2]); a2 += kv * bf2f(zs[8192 + s2]); a3 += kv * bf2f(zs[12288 + s2]);
      }
      const float skip = p.hy_skip[(l * 2 + o) * 512 + c];
      float y[4];
      y[0] = scale * a0 + skip * bf2f(zs[t]); y[1] = scale * a1 + skip * bf2f(zs[4096 + t]);
      y[2] = scale * a2 + skip * bf2f(zs[8192 + t]); y[3] = scale * a3 + skip * bf2f(zs[12288 + t]);
      __syncthreads();
      {
        const int ch = (o + 1) * 512 + c;
        const float w0 = cwp[ch], w1 = cwp[1536 + ch], w2 = cwp[3072 + ch], bs = cbp[ch];
#pragma unroll
        for (int b = 0; b < 4; ++b) {
          const u16* col = UT + (size_t)ch * NTOK + NLAT + b * 256;
          float xg = bs + w1 * bf2f(col[t]);
          if (t > 0) xg += w0 * bf2f(col[t - 1]);
          if (t < 255) xg += w2 * bf2f(col[t + 1]);
          float zn = xg * y[b];
          if (o == 0) zs[b * 4096 + t] = f2bf(zn);
          else {
            size_t R = (size_t)NLAT + b * 256 + t;
            float gate = bf2f(UT[(size_t)(1536 + c) * NTOK + R]);
            p.U[(size_t)c * NTOK + R] = f2bf(zn * gate);
          }
        }
      }
      __syncthreads();
    }
  }
}

__device__ __forceinline__ void fin_rows(const P& p, int l, int chunk) {
  const int tid = threadIdx.x, wave = tid >> 6, lane = tid & 63;
  for (int rr = 0; rr < 16; ++rr) {
    int R = chunk * 64 + wave * 16 + rr;
    {
      uint4* yp = (uint4*)(p.Y2 + (size_t)R * 1024 + lane * 8);
      float o[8]; unpack8(*yp, o);
      float ss = 0;
#pragma unroll
      for (int j = 0; j < 8; ++j) ss += o[j] * o[j];
      ss += __shfl_xor(ss, 1); ss += __shfl_xor(ss, 2); ss += __shfl_xor(ss, 4); ss += __shfl_xor(ss, 8);
      float rinv = rsqrtf(ss * (1.f / 128.f) + EPS);
      float gf[8]; unpack8(*(const uint4*)(p.U + (size_t)NTOK * 2048 + (size_t)R * 2048 + 1024 + lane * 8), gf);
#pragma unroll
      for (int j = 0; j < 8; ++j) o[j] = o[j] * rinv * p.hg_norm_w[l * 512 + lane * 8 + j] * gf[j];
      *yp = pack8(o);
    }
    {
      uint4* yp = (uint4*)(p.Y2 + (size_t)R * 1024 + 512 + lane * 8);
      float o[8]; unpack8(*yp, o);
      float gf[8]; unpack8(*(const uint4*)(p.U + (size_t)NTOK * 2048 + (size_t)R * 2048 + 1536 + lane * 8), gf);
      float ss = 0;
#pragma unroll
      for (int j = 0; j < 8; ++j) { o[j] *= gf[j]; ss += o[j] * o[j]; }
      ss += __shfl_xor(ss, 1); ss += __shfl_xor(ss, 2); ss += __shfl_xor(ss, 4); ss += __shfl_xor(ss, 8); ss += __shfl_xor(ss, 16);
      float rinv = rsqrtf(ss * (1.f / 256.f) + EPS);
#pragma unroll
      for (int j = 0; j < 8; ++j) o[j] = o[j] * rinv * p.m2_norm_w[l * 512 + lane * 8 + j];
      *yp = pack8(o);
    }
  }
}

__device__ __forceinline__ void ph_mixB(const P& p, int l, int bid, int nb, float* sm) {
  for (int t = bid; t < 544 + 512; t += nb) {
    if (t < 544) { if (EN_RG) rg_task<0>(p, l, t, sm); }
    else { if (EN_HY) hy_task(p, l, t - 544, sm); }
    __syncthreads();
  }
}
__device__ __forceinline__ void hy_transpose(const P& p, int tile, u16* sm) {
  const int tid = threadIdx.x;
  const int ct = tile & 7, rt = tile >> 3;
  const int c0 = ct * 64, R0 = rt * 64;
#pragma unroll
  for (int i = 0; i < 2; ++i) {
    int q = tid + 256 * i; int cc = q >> 3, seg = q & 7;
    *(uint4*)(sm + cc * 72 + seg * 8) = *(const uint4*)(p.U + (size_t)(c0 + cc) * NTOK + R0 + seg * 8);
  }
  __syncthreads();
#pragma unroll
  for (int i = 0; i < 2; ++i) {
    int q = tid + 256 * i; int rr = q >> 3, seg = q & 7;
    FragU f;
#pragma unroll
    for (int j = 0; j < 4; ++j)
      f.u[j] = (uint32_t)sm[(seg * 8 + 2 * j) * 72 + rr] | ((uint32_t)sm[(seg * 8 + 2 * j + 1) * 72 + rr] << 16);
    *(uint4*)(p.HL + (size_t)(R0 + rr) * 1024 + c0 + seg * 8) = f.q;
  }
}
__device__ __forceinline__ void ph_mixB2(const P& p, int l, int bid, int nb, float* sm) {
  const int nfin = (l == 0 ? NTOK : NLAT) / 64;
  const int ntr = nfin * 8;
  for (int t = bid; t < 544 + nfin + ntr; t += nb) {
    if (t < 544) { if (EN_RG) rg_task<1>(p, l, t, sm); }
    else if (t < 544 + nfin) fin_rows(p, l, t - 544);
    else hy_transpose(p, t - 544 - nfin, (u16*)sm);
    __syncthreads();
  }
}
__device__ __forceinline__ void ph_final(const P& p, int bid, int nb) {
  const int tid = threadIdx.x, wave = tid >> 6, lane = tid & 63;
  for (int R = bid * 4 + wave; R < NLAT; R += nb * 4) {
    float4* rp = (float4*)(p.out + (size_t)R * 1024);
    float4 v[4]; float ss = 0;
#pragma unroll
    for (int i = 0; i < 4; ++i) {
      v[i] = rp[lane + i * 64];
      ss += v[i].x * v[i].x + v[i].y * v[i].y + v[i].z * v[i].z + v[i].w * v[i].w;
    }
    ss = wave_sum(ss);
    float rinv = rsqrtf(ss * (1.f / 1024.f) + EPS);
#pragma unroll
    for (int i = 0; i < 4; ++i) {
      float4 w = *(const float4*)(p.final_norm_w + (lane + i * 64) * 4);
      float4 o; o.x = v[i].x * rinv * w.x; o.y = v[i].y * rinv * w.y; o.z = v[i].z * rinv * w.z; o.w = v[i].w * rinv * w.w;
      rp[lane + i * 64] = o;
    }
  }
}

#define SMEM_BYTES 50176
__global__ void __launch_bounds__(256) mega(P p) {
  __shared__ __align__(16) unsigned char smem[SMEM_BYTES];
  cg::grid_group grid = cg::this_grid();
  const int bid = blockIdx.x, nb = gridDim.x;
  float* smf = (float*)smem; u16* smh = (u16*)smem;
#ifndef PHM
#define PHM 0xffff
#endif
  if (PHM & 1) ph_mod(p, bid, nb, smf);
  grid.sync();
  for (int l = 0; l < 2; ++l) {
    if (PHM & 2) ph_norm(p, l, bid, nb);
    if (PHM & 4) ph_wconv(p, l, bid, nb, smf);
    grid.sync();
    if (PHM & 16) ph_gemm<0>(p, l, bid, nb, smh);
    grid.sync();
    if (PHM & 32) ph_mixA0(p, l, bid, nb, smem);
    grid.sync();
    if (PHM & 32) ph_mixA1(p, l, bid, nb, smem);
    grid.sync();
#if PROBE_DUP == 8
    ph_mixA0(p, l, bid, nb, smem);
    grid.sync();
    ph_mixA1(p, l, bid, nb, smem);
    grid.sync();
#endif
    if (PHM & 64) ph_gemm<1>(p, l, bid, nb, smh);
    if (PHM & 8) ph_filt(p, l, bid, nb, smf);
    grid.sync();
#if PROBE_DUP == 2
    ph_mixB(p, l, bid, nb, smf);
    grid.sync();
#endif
#if PROBE_DUP == 4
    ph_gemm<1>(p, l, bid, nb, smh);
    grid.sync();
#endif
    if (PHM & 128) ph_mixB(p, l, bid, nb, smf);
    grid.sync();
    if (PHM & 128) ph_mixB2(p, l, bid, nb, smf);
    grid.sync();
#if PROBE_DUP == 7
    for (int t = bid; t < 544; t += nb) { rg_task<1>(p, l, t, smf); __syncthreads(); }
    grid.sync();
#endif
    if (PHM & 256) ph_gemm<2>(p, l, bid, nb, smh);
    grid.sync();
  }
  if (PHM & 512) ph_final(p, bid, nb);
}

extern "C" void kernel_launch(void* const* d_in, const int* in_sizes, int n_in, void* d_out, int out_size,
                              void* d_ws, size_t ws_size, hipStream_t stream) {
  static int grid_blocks = 0;
  if (!grid_blocks) {
    int dev = 0, cus = 0, per_cu = 0;
    hipGetDevice(&dev);
    hipDeviceGetAttribute(&cus, hipDeviceAttributeMultiprocessorCount, dev);
    hipOccupancyMaxActiveBlocksPerMultiprocessor(&per_cu, mega, 256, 0);
    if (per_cu < 1) per_cu = 1;
    if (per_cu > 2) per_cu = 2;
    grid_blocks = cus * per_cu;
  }
  P p{};
  const float** fp = (const float**)&p;
  for (int i = 0; i < 34; ++i) fp[i] = (const float*)d_in[i];
  p.out = (float*)d_out;
  char* w = (char*)d_ws;
  size_t off = 0;
  auto take = [&](size_t bytes) { char* r = w + off; off += (bytes + 255) & ~(size_t)255; return r; };
  p.U = (u16*)take((size_t)NTOK * UW * 2);
  p.HL = (u16*)take((size_t)NTOK * 1024 * 2);
  p.Y2 = (u16*)take((size_t)NTOK * 1024 * 2);
  p.WT = (u16*)take((size_t)7296 * 1024 * 2);
  p.WoT = (u16*)take((size_t)1024 * 2048 * 2);
  p.KF = (u16*)take((size_t)1024 * 8192 * 2);
  p.KFC = (u16*)take((size_t)1024 * 512 * 2);
  p.XC = (float*)take((size_t)1024 * 1024 * 4);
  p.DT = (float*)take((size_t)NTOK * 8 * 4);
  p.MOD = (float*)take((size_t)2 * 5 * 3072 * 4);
  p.SUM = (float*)take((size_t)4 * 2 * 17 * 512 * 2 * 4);
  p.SSH = (float*)take((size_t)16 * 2 * 4 * 65536);
  p.PS = (float*)take((size_t)16 * 2 * 4 * 128 * 4);
  p.PA = (float*)take((size_t)16 * 2 * 8 * 4 * 4);
  if (off > ws_size) { fprintf(stderr, "workspace too small: need %zu have %zu\n", off, ws_size); return; }
  void* args[] = {&p};
  hipError_t e = hipLaunchCooperativeKernel((void*)mega, dim3(grid_blocks), dim3(256), args, 0, stream);
  if (e != hipSuccess) fprintf(stderr, "cooperative launch failed: %s (grid %d)\n", hipGetErrorString(e), grid_blocks);
}
```

```cpp
#include <hip/hip_runtime.h>
#include <hip/hip_bf16.h>
#include <hip/hip_cooperative_groups.h>
#include <cstdio>
#include <cstdint>
namespace cg = cooperative_groups;

typedef unsigned short u16;
using bf16x8 = __attribute__((ext_vector_type(8))) short;
using f32x16 = __attribute__((ext_vector_type(16))) float;

#define NTOK 17408
#define NLAT 16384
#define UW 4096
#define EPS 1e-6f

#ifndef PROBE_DUP
#define PROBE_DUP 0
#endif
#ifndef EN_HY
#define EN_HY 1
#endif
#ifndef EN_RG
#define EN_RG 1
#endif
#ifndef EN_HG
#define EN_HG 1
#endif
#ifndef EN_M2
#define EN_M2 1
#endif

struct P {
  const float *x, *c, *ctx, *c_ctx, *w_mod, *b_mod, *norm_w, *w_in, *w_out;
  const float *hy_conv_w, *hy_conv_b, *hy_w1, *hy_b1, *hy_w2, *hy_b2, *hy_w3, *hy_freq, *hy_skip;
  const float *rg_conv_w, *rg_conv_b, *rg_wa, *rg_ba, *rg_wx, *rg_bx, *rg_lam;
  const float *hg_lb, *hg_norm_w, *m2_conv_w, *m2_conv_b, *m2_dt_bias, *m2_a_log, *m2_d, *m2_norm_w, *final_norm_w;
  float* out;
  u16 *U, *HL, *Y2, *WT, *WoT, *KF, *KFC;
  float *XC, *DT, *MOD, *SUM, *SSH, *PS, *PA;
};

typedef __bf16 bf2_t __attribute__((ext_vector_type(2)));
typedef float f2_t __attribute__((ext_vector_type(2)));
__device__ __forceinline__ uint32_t pack2(float a, float b) {
  f2_t v = {a, b};
  return __builtin_bit_cast(uint32_t, __builtin_convertvector(v, bf2_t));
}
__device__ __forceinline__ u16 f2bf(float f) { return (u16)(pack2(f, f) & 0xffffu); }
__device__ __forceinline__ float bf2f(u16 h) { return __uint_as_float(((uint32_t)h) << 16); }
__device__ __forceinline__ float bflo(uint32_t w) { return __uint_as_float(w << 16); }
__device__ __forceinline__ float bfhi(uint32_t w) { return __uint_as_float(w & 0xffff0000u); }
__device__ __forceinline__ float siluf(float x) { return x * __builtin_amdgcn_rcpf(1.f + __expf(-x)); }
__device__ __forceinline__ float sigmf(float x) { return __builtin_amdgcn_rcpf(1.f + __expf(-x)); }
__device__ __forceinline__ float softplusf(float x) { return x > 20.f ? x : log1pf(__expf(x)); }

__device__ __forceinline__ void unpack8(const uint4& v, float* f) {
  f[0] = bflo(v.x); f[1] = bfhi(v.x); f[2] = bflo(v.y); f[3] = bfhi(v.y);
  f[4] = bflo(v.z); f[5] = bfhi(v.z); f[6] = bflo(v.w); f[7] = bfhi(v.w);
}
__device__ __forceinline__ uint4 pack8(const float* f) {
  uint4 v; v.x = pack2(f[0], f[1]); v.y = pack2(f[2], f[3]); v.z = pack2(f[4], f[5]); v.w = pack2(f[6], f[7]);
  return v;
}
__device__ __forceinline__ float wave_sum(float v) {
#pragma unroll
  for (int o = 32; o >= 1; o >>= 1) v += __shfl_xor(v, o);
  return v;
}

__device__ __forceinline__ int pos2row_seq(int b, int p, int dir) {
  if (p < 256) { int t = dir ? 255 - p : p; return NLAT + b * 256 + t; }
  int j = p - 256; int t = dir ? 4095 - j : j; return b * 4096 + t;
}
__device__ __forceinline__ int pos2row_m2(int b, int p, int dir) {
  if (p < 256) { int t = dir ? 255 - p : p; return NLAT + b * 256 + t; }
  int j = p - 256; int jj = dir ? 4095 - j : j; int c = jj >> 6, r = jj & 63; return b * 4096 + r * 64 + c;
}

__device__ __forceinline__ void ph_mod(const P& p, int bid, int nb, float* sm) {
  int tid = threadIdx.x; asm volatile("" : "+v"(tid));
  for (int task = bid; task < 96; task += nb) {
    int l = task / 48, cgi = task % 48;
    int col = cgi * 64 + (tid & 63);
    int kq = tid >> 6;
    float a0 = 0, a1 = 0, a2 = 0, a3 = 0, a4 = 0;
    for (int k = kq * 256; k < kq * 256 + 256; ++k) {
      float w = p.w_mod[((size_t)l * 1024 + k) * 3072 + col];
      a0 += siluf(p.c[k]) * w; a1 += siluf(p.c[1024 + k]) * w; a2 += siluf(p.c[2048 + k]) * w;
      a3 += siluf(p.c[3072 + k]) * w; a4 += siluf(p.c_ctx[k]) * w;
    }
    sm[(kq * 5 + 0) * 64 + (tid & 63)] = a0; sm[(kq * 5 + 1) * 64 + (tid & 63)] = a1;
    sm[(kq * 5 + 2) * 64 + (tid & 63)] = a2; sm[(kq * 5 + 3) * 64 + (tid & 63)] = a3;
    sm[(kq * 5 + 4) * 64 + (tid & 63)] = a4;
    __syncthreads();
    if (tid < 64) {
      float bm = p.b_mod[l * 3072 + col];
#pragma unroll
      for (int j = 0; j < 5; ++j) {
        float s = sm[(0 * 5 + j) * 64 + tid] + sm[(1 * 5 + j) * 64 + tid] + sm[(2 * 5 + j) * 64 + tid] + sm[(3 * 5 + j) * 64 + tid];
        p.MOD[(size_t)(l * 5 + j) * 3072 + col] = s + bm;
      }
    }
    __syncthreads();
  }
}

__device__ __forceinline__ void ph_norm(const P& p, int l, int bid, int nb) {
  int tid = threadIdx.x; asm volatile("" : "+v"(tid)); const int wave = tid >> 6, lane = tid & 63;
  for (int R = bid * 4 + wave; R < NTOK; R += nb * 4) {
    const float* src; int mj;
    if (R < NLAT) { src = (l == 0 ? p.x : (const float*)p.out) + (size_t)R * 1024; mj = R >> 12; }
    else { int rc = R - NLAT; src = (l == 0 ? p.ctx : (const float*)p.XC) + (size_t)rc * 1024; mj = 4; }
    const float* mod = p.MOD + (size_t)(l * 5 + mj) * 3072;
    float4 v[4]; float ss = 0;
#pragma unroll
    for (int i = 0; i < 4; ++i) {
      v[i] = ((const float4*)src)[lane + i * 64];
      ss += v[i].x * v[i].x + v[i].y * v[i].y + v[i].z * v[i].z + v[i].w * v[i].w;
    }
    ss = wave_sum(ss);
    float rinv = rsqrtf(ss * (1.f / 1024.f) + EPS);
#pragma unroll
    for (int i = 0; i < 4; ++i) {
      int idx = (lane + i * 64) * 4;
      float4 nw = *(const float4*)(p.norm_w + l * 1024 + idx);
      float4 sh = *(const float4*)(mod + idx);
      float4 sc = *(const float4*)(mod + 1024 + idx);
      float h0 = v[i].x * rinv * nw.x * (1.f + sc.x) + sh.x;
      float h1 = v[i].y * rinv * nw.y * (1.f + sc.y) + sh.y;
      float h2 = v[i].z * rinv * nw.z * (1.f + sc.z) + sh.z;
      float h3 = v[i].w * rinv * nw.w * (1.f + sc.w) + sh.w;
      uint2 o; o.x = pack2(h0, h1); o.y = pack2(h2, h3);
      *(uint2*)(p.HL + (size_t)R * 1024 + idx) = o;
    }
  }
}

__device__ __forceinline__ void ph_wconv(const P& p, int l, int bid, int nb, float* sm) {
  int tid = threadIdx.x; asm volatile("" : "+v"(tid));
  const int T1 = 114 * 16, T2 = 16 * 32;
  for (int t = bid; t < T1 + T2; t += nb) {
    const float* src; int ld, K, n0, k0, sc0, nvalid; u16* dst;
    if (t < T1) {
      int nt = t / 16, kt = t % 16; n0 = nt * 64; k0 = kt * 64;
      src = p.w_in + (size_t)l * 1024 * 7176; ld = 7176; K = 1024; dst = p.WT; nvalid = 64;
      if (n0 < 2048) sc0 = 3072 + n0;
      else if (n0 < 3072) sc0 = 5632 + (n0 - 2048);
      else if (n0 < 3200) { sc0 = 6656 + (n0 - 3072); nvalid = (n0 == 3072) ? 8 : 0; }
      else { int m = n0 - 3200; if (m < 3072) sc0 = m; else if (m < 3584) sc0 = 5120 + (m - 3072); else sc0 = 6664 + (m - 3584); }
    } else {
      int tt = t - T1; int nt = tt / 32, kt = tt % 32; n0 = nt * 64; k0 = kt * 64;
      src = p.w_out + (size_t)l * 2048 * 1024; ld = 1024; K = 2048; dst = p.WoT; nvalid = 64; sc0 = n0;
    }
#pragma unroll
    for (int i = 0; i < 4; ++i) {
      int kk = (tid >> 4) + 16 * i, cc = (tid & 15) * 4;
      const float* sp = src + (size_t)(k0 + kk) * ld + sc0 + cc;
      float4 v;
      if (nvalid == 64) v = *(const float4*)sp;
      else { v.x = (cc + 0 < nvalid) ? sp[0] : 0.f; v.y = (cc + 1 < nvalid) ? sp[1] : 0.f; v.z = (cc + 2 < nvalid) ? sp[2] : 0.f; v.w = (cc + 3 < nvalid) ? sp[3] : 0.f; }
      sm[kk * 65 + cc + 0] = v.x; sm[kk * 65 + cc + 1] = v.y; sm[kk * 65 + cc + 2] = v.z; sm[kk * 65 + cc + 3] = v.w;
    }
    __syncthreads();
#pragma unroll
    for (int i = 0; i < 2; ++i) {
      int q = tid + 256 * i; int nn = q >> 3, ks = q & 7;
      float f[8];
#pragma unroll
      for (int j = 0; j < 8; ++j) f[j] = sm[(ks * 8 + j) * 65 + nn];
      *(uint4*)(dst + (size_t)(n0 + nn) * K + k0 + ks * 8) = pack8(f);
    }
    __syncthreads();
  }
}

__device__ __forceinline__ void ph_filt(const P& p, int l, int bid, int nb, float* sm) {
  int tid = threadIdx.x; asm volatile("" : "+v"(tid));
  const float HY_MIN = -3.0701134573253945f, HY_MAX = -15.350567286626972f;
  int ntask = 256 + (l == 0 ? 16 : 0);
  float* zs = sm; float* h1 = sm + 544; float* h2 = sm + 544 + 1024;
  for (int task = bid; task < ntask; task += nb) {
    int n, t0; u16* K;
    if (task < 256) { n = 4096; t0 = task * 16; K = p.KF; } else { n = 256; t0 = (task - 256) * 16; K = p.KFC; }
    float inv_nm1 = 1.f / (float)(n - 1);
    for (int e = tid; e < 16 * 33; e += 256) {
      int tt = e / 33, f = e % 33; int t = t0 + tt; float val;
      if (f == 0) val = (float)t * inv_nm1;
      else {
        int bi = (f - 1) & 15;
        float band = 1e-4f + (float)bi * ((15.f - 1e-4f) / 15.f);
        float ang = (6.283185307179586f / (float)n) * (float)t * band;
        val = (f <= 16) ? cosf(ang) : -sinf(ang);
      }
      zs[e] = val;
    }
    __syncthreads();
    for (int e = tid; e < 1024; e += 256) {
      int tt = e >> 6, j = e & 63; float acc = p.hy_b1[l * 64 + j];
      for (int f = 0; f < 33; ++f) acc += zs[tt * 33 + f] * p.hy_w1[(l * 33 + f) * 64 + j];
      h1[e] = sinf(p.hy_freq[l * 64 + j] * acc);
    }
    __syncthreads();
    for (int e = tid; e < 1024; e += 256) {
      int tt = e >> 6, j = e & 63; float acc = p.hy_b2[l * 64 + j];
      for (int i = 0; i < 64; ++i) acc += h1[tt * 64 + i] * p.hy_w2[(l * 64 + i) * 64 + j];
      h2[e] = sinf(p.hy_freq[l * 64 + j] * acc);
    }
    __syncthreads();
    for (int r = 0; r < 8; ++r) {
      int col = tid + 256 * r; int o = col >> 10, side = (col >> 9) & 1, c = col & 511;
      float w[64];
#pragma unroll
      for (int i = 0; i < 64; ++i) w[i] = p.hy_w3[(size_t)(l * 64 + i) * 2048 + col];
      float delta = fabsf(HY_MIN + (HY_MAX - HY_MIN) * (float)c / 511.f);
      u16* Kc = K + (size_t)(o * 512 + c) * (2 * n);
      for (int tt = 0; tt < 16; ++tt) {
        float acc = 0;
#pragma unroll
        for (int i = 0; i < 64; ++i) acc += h2[tt * 64 + i] * w[i];
        int t = t0 + tt;
        float val = acc * __expf(-(float)t * inv_nm1 * delta);
        int idx;
        if (side == 0) idx = n - t; else { if (t == 0) { idx = 0; val = 0.f; } else idx = n + t; }
        Kc[idx] = f2bf(val);
      }
    }
    __syncthreads();
  }
}

#define LDSTR 72
template <int MODE>
__device__ __forceinline__ void gemm_tile(const P& p, int l, int mt, int nt, u16* sA, u16* sB, int noepi) {
  int tid = threadIdx.x; asm volatile("" : "+v"(tid)); const int wave = tid >> 6, lane = tid & 63;
  const int wm = wave >> 1, wn = wave & 1;
  const int KT = (MODE == 2) ? 2048 : 1024;
  const u16* Bsrc = (MODE == 0) ? p.WT + (size_t)(nt * 128) * 1024
                  : (MODE == 1) ? p.WT + (size_t)(3200 + nt * 128) * 1024
                                : p.WoT + (size_t)(nt * 128) * 2048;
  f32x16 acc[4][2];
#pragma unroll
  for (int a = 0; a < 4; ++a)
#pragma unroll
    for (int b = 0; b < 2; ++b)
#pragma unroll
      for (int r = 0; r < 16; ++r) acc[a][b][r] = 0.f;
  uint4 ra0, ra1, ra2, ra3, ra4, ra5, ra6, ra7, rb0, rb1, rb2, rb3;
  const int lrow = tid >> 3, lseg = tid & 7;
  const u16* Ab0 = p.HL + (size_t)(mt * 256 + lrow) * 1024 + lseg * 8;
  const u16* Ab1 = p.Y2 + (size_t)(mt * 256 + lrow) * 1024 + lseg * 8;
  const u16* Bb = Bsrc + (size_t)lrow * KT + lseg * 8;
#define GLOADS(K0)                                                                                  \
  {                                                                                                 \
    const u16* ap = (MODE == 2 && (K0) >= 1024) ? Ab1 + ((K0) - 1024) : Ab0 + (K0);                 \
    ra0 = *(const uint4*)(ap); ra1 = *(const uint4*)(ap + 32 * 1024);                               \
    ra2 = *(const uint4*)(ap + 64 * 1024); ra3 = *(const uint4*)(ap + 96 * 1024);                   \
    ra4 = *(const uint4*)(ap + 128 * 1024); ra5 = *(const uint4*)(ap + 160 * 1024);                 \
    ra6 = *(const uint4*)(ap + 192 * 1024); ra7 = *(const uint4*)(ap + 224 * 1024);                 \
    const u16* bp = Bb + (K0);                                                                      \
    rb0 = *(const uint4*)(bp); rb1 = *(const uint4*)(bp + (size_t)32 * KT);                         \
    rb2 = *(const uint4*)(bp + (size_t)64 * KT); rb3 = *(const uint4*)(bp + (size_t)96 * KT);       \
  }
  GLOADS(0)
#pragma unroll 1
  for (int k0 = 0; k0 < KT; k0 += 64) {
    *(uint4*)(sA + (lrow + 0) * LDSTR + lseg * 8) = ra0;   *(uint4*)(sA + (lrow + 32) * LDSTR + lseg * 8) = ra1;
    *(uint4*)(sA + (lrow + 64) * LDSTR + lseg * 8) = ra2;  *(uint4*)(sA + (lrow + 96) * LDSTR + lseg * 8) = ra3;
    *(uint4*)(sA + (lrow + 128) * LDSTR + lseg * 8) = ra4; *(uint4*)(sA + (lrow + 160) * LDSTR + lseg * 8) = ra5;
    *(uint4*)(sA + (lrow + 192) * LDSTR + lseg * 8) = ra6; *(uint4*)(sA + (lrow + 224) * LDSTR + lseg * 8) = ra7;
    *(uint4*)(sB + (lrow + 0) * LDSTR + lseg * 8) = rb0;   *(uint4*)(sB + (lrow + 32) * LDSTR + lseg * 8) = rb1;
    *(uint4*)(sB + (lrow + 64) * LDSTR + lseg * 8) = rb2;  *(uint4*)(sB + (lrow + 96) * LDSTR + lseg * 8) = rb3;
    __syncthreads();
    if (k0 + 64 < KT) GLOADS(k0 + 64)
#pragma unroll
    for (int ks = 0; ks < 4; ++ks) {
      bf16x8 fa[4], fb[2];
#pragma unroll
      for (int mi = 0; mi < 4; ++mi)
        fa[mi] = *(const bf16x8*)(sA + (wm * 128 + mi * 32 + (lane & 31)) * LDSTR + ks * 16 + (lane >> 5) * 8);
#pragma unroll
      for (int ni = 0; ni < 2; ++ni)
        fb[ni] = *(const bf16x8*)(sB + (wn * 64 + ni * 32 + (lane & 31)) * LDSTR + ks * 16 + (lane >> 5) * 8);
#pragma unroll
      for (int mi = 0; mi < 4; ++mi)
#pragma unroll
        for (int ni = 0; ni < 2; ++ni)
          acc[mi][ni] = __builtin_amdgcn_mfma_f32_32x32x16_bf16(fa[mi], fb[ni], acc[mi][ni], 0, 0, 0);
    }
    __syncthreads();
  }
  if (noepi) {
    float sacc = 0.f;
#pragma unroll
    for (int a = 0; a < 4; ++a)
#pragma unroll
      for (int b = 0; b < 2; ++b) sacc += acc[a][b][3];
    if (sacc == 1.2345e30f) p.DT[0] = sacc;
    return;
  }
  const int mj = (mt < 64) ? (mt >> 4) : 4;
#pragma unroll
  for (int ni = 0; ni < 2; ++ni) {
    const int col = wn * 64 + ni * 32 + (lane & 31);
    const int gcol = nt * 128 + col;
    float lb = 0.f; float gmod = 0.f;
    if (MODE == 0) {
      int piece = gcol >> 9;
      if (l == 1 && (piece == 1 || piece == 2)) {
        int dir = piece - 1, ch = gcol & 511;
        float l0 = p.hg_lb[(0 * 2 + dir) * 512 + ch], l1 = p.hg_lb[(1 * 2 + dir) * 512 + ch];
        lb = 1.f / (1.f + __expf(l0 - l1));
      }
    }
    if (MODE == 2) gmod = p.MOD[(size_t)(l * 5 + mj) * 3072 + 2048 + gcol];
#pragma unroll
    for (int mi = 0; mi < 4; ++mi) {
#pragma unroll
      for (int r = 0; r < 16; ++r) {
        const int row = wm * 128 + mi * 32 + (r & 3) + 8 * (r >> 2) + 4 * (lane >> 5);
        const int R = mt * 256 + row;
        float v = acc[mi][ni][r];
        if (MODE == 0) {
          if (nt < 24) {
            int piece = gcol >> 9;
            if (piece == 0) v *= 0.08838834764831845f;
            else if (piece == 1 || piece == 2) v = (1.f - lb) * __builtin_amdgcn_rcpf(1.f + __expf(v));
            p.U[(size_t)R * UW + gcol] = f2bf(v);
          } else {
            if (col < 8) p.DT[(size_t)R * 8 + col] = v;
          }
        } else if (MODE == 1) {
          int piece = gcol >> 9;
          if (piece == 3 || piece >= 5) v = siluf(v);
          if (nt >= 16) p.U[(size_t)NTOK * 2048 + (size_t)R * 2048 + (gcol - 2048)] = f2bf(v);
          else acc[mi][ni][r] = v;
        } else {
          if (R < NLAT) {
            const float* base = (l == 0) ? p.x : (const float*)p.out;
            float xv = base[(size_t)R * 1024 + gcol];
            p.out[(size_t)R * 1024 + gcol] = xv + gmod * v;
          } else {
            int rc = R - NLAT;
            p.XC[(size_t)rc * 1024 + gcol] = p.ctx[(size_t)rc * 1024 + gcol] + gmod * v;
          }
        }
      }
      if (MODE == 1 && nt < 16) {
#pragma unroll
        for (int g4 = 0; g4 < 4; ++g4) {
          int R0 = mt * 256 + wm * 128 + mi * 32 + 8 * g4 + 4 * (lane >> 5);
          uint2 o; o.x = pack2(acc[mi][ni][4 * g4], acc[mi][ni][4 * g4 + 1]); o.y = pack2(acc[mi][ni][4 * g4 + 2], acc[mi][ni][4 * g4 + 3]);
          *(uint2*)(p.U + (size_t)gcol * NTOK + R0) = o;
        }
      }
    }
  }
}

template <int MODE>
__device__ __forceinline__ void ph_gemm(const P& p, int l, int bid, int nb, u16* sm, int noepi = 0) {
  const int NT = (MODE == 0) ? 25 : (MODE == 1) ? 32 : 8;
  const int MT = (MODE == 2 && l == 1) ? 64 : 68;
  u16* sA = sm; u16* sB = sm + 256 * LDSTR;
  const int xcd = bid & 7, local = bid >> 3;
  const int mbase = MT >> 3, mextra = MT & 7;
  const int mper = mbase + (xcd < mextra ? 1 : 0);
  const int mstart = (xcd < mextra) ? xcd * (mbase + 1) : mextra * (mbase + 1) + (xcd - mextra) * mbase;
  const int total = mper * NT;
  const int fullb = NT >> 3, rem = NT & 7;
  for (int it = 0;; ++it) {
    int mt, nt;
    if (nb == 256) {
      int q = local + 32 * it;
      if (q >= total) break;
      int b, i, bw;
      if (q < fullb * mper * 8) { b = q / (mper * 8); i = q - b * mper * 8; bw = 8; }
      else { b = fullb; i = q - fullb * mper * 8; bw = rem; }
      int sub = i / (4 * bw);
      const int nsub = mper >> 2;
      int mt_off, nt_off;
      if (sub < nsub) { int j = i - sub * 4 * bw; mt_off = j & 3; nt_off = j >> 2; }
      else { int j = i - nsub * 4 * bw; sub = nsub; mt_off = 0; nt_off = j; }
      mt = mstart + sub * 4 + mt_off; nt = b * 8 + nt_off;
    } else {
      int t = bid + it * nb;
      if (t >= MT * NT) break;
      nt = t / MT; mt = t % MT;
    }
    gemm_tile<MODE>(p, l, mt, nt, sA, sB, noepi);
  }
}

__device__ __forceinline__ void hg_task(const P& p, int l, int task, float* sm) {
  int tid = threadIdx.x; asm volatile("" : "+v"(tid)); const int wave = tid >> 6, lane = tid & 63;
  const int b = task >> 5, h = (task >> 3) & 3, es = task & 7;
  const int dg = lane & 15, el = lane >> 4;
  float* qs = sm; float* ks = sm + 4096; float* vs = sm + 8192; float* os = sm + 8192 + 512;
  for (int dir = 0; dir < 2; ++dir) {
    float S[8];
#pragma unroll
    for (int r = 0; r < 8; ++r) S[r] = 0.f;
    for (int chunk = 0; chunk < 136; ++chunk) {
#pragma unroll
      for (int i = 0; i < 2; ++i) {
        int q = tid + 256 * i; int pos = q >> 4, seg = q & 15;
        int R = pos2row_seq(b, chunk * 32 + pos, dir);
        const u16* up = p.U + (size_t)R * UW + h * 128 + seg * 8;
        uint4 qv = *(const uint4*)up;
        uint4 kv = *(const uint4*)(up + 512 + dir * 512);
        float f[8];
        unpack8(qv, f);
        *(float4*)(qs + pos * 128 + seg * 8) = make_float4(f[0], f[1], f[2], f[3]);
        *(float4*)(qs + pos * 128 + seg * 8 + 4) = make_float4(f[4], f[5], f[6], f[7]);
        unpack8(kv, f);
        *(float4*)(ks + pos * 128 + seg * 8) = make_float4(f[0], f[1], f[2], f[3]);
        *(float4*)(ks + pos * 128 + seg * 8 + 4) = make_float4(f[4], f[5], f[6], f[7]);
      }
      {
        int pos = tid >> 3, e2 = (tid & 7) * 2;
        int R = pos2row_seq(b, chunk * 32 + pos, dir);
        uint32_t w = *(const uint32_t*)(p.U + (size_t)R * UW + 1536 + h * 128 + es * 16 + e2);
        vs[pos * 16 + e2] = bflo(w); vs[pos * 16 + e2 + 1] = bfhi(w);
      }
      __syncthreads();
#pragma unroll 4
      for (int i = 0; i < 32; ++i) {
        float4 q0 = *(const float4*)(qs + i * 128 + dg * 8), q1 = *(const float4*)(qs + i * 128 + dg * 8 + 4);
        float4 k0 = *(const float4*)(ks + i * 128 + dg * 8), k1 = *(const float4*)(ks + i * 128 + dg * 8 + 4);
        float v = vs[i * 16 + wave * 4 + el];
        S[0] += k0.x * (v - S[0]); S[1] += k0.y * (v - S[1]); S[2] += k0.z * (v - S[2]); S[3] += k0.w * (v - S[3]);
        S[4] += k1.x * (v - S[4]); S[5] += k1.y * (v - S[5]); S[6] += k1.z * (v - S[6]); S[7] += k1.w * (v - S[7]);
        float o = q0.x * S[0] + q0.y * S[1] + q0.z * S[2] + q0.w * S[3] + q1.x * S[4] + q1.y * S[5] + q1.z * S[6] + q1.w * S[7];
        o += __shfl_xor(o, 1); o += __shfl_xor(o, 2); o += __shfl_xor(o, 4); o += __shfl_xor(o, 8);
        if (dg == 0) os[i * 16 + wave * 4 + el] = o;
      }
      __syncthreads();
      {
        int pos = tid >> 3, e2 = (tid & 7) * 2;
        int R = pos2row_seq(b, chunk * 32 + pos, dir);
        uint32_t* yp = (uint32_t*)(p.Y2 + (size_t)R * 1024 + h * 128 + es * 16 + e2);
        float o0 = os[pos * 16 + e2], o1 = os[pos * 16 + e2 + 1];
        if (dir == 1) { uint32_t w = *yp; o0 += bflo(w); o1 += bfhi(w); }
        *yp = pack2(o0, o1);
      }
    }
    __threadfence();
    __syncthreads();
  }
}

__device__ __forceinline__ void m2_task(const P& p, int l, int task, float* sm) {
  int tid = threadIdx.x; asm volatile("" : "+v"(tid)); const int wave = tid >> 6, lane = tid & 63;
  const int b = task >> 5, head = (task >> 2) & 7, ps = task & 3;
  const int g = head >> 2;
  const int dg = lane & 15, el = lane >> 4;
  float* Cs = sm; float* Bs = sm + 4096; float* xs = sm + 8192; float* os = sm + 8192 + 512;
  float* dts = sm + 8192 + 1024; float* decs = dts + 32;
  for (int dir = 0; dir < 2; ++dir) {
    const float* cw = p.m2_conv_w + (size_t)(l * 2 + dir) * 4 * 1024;
    const float* cb = p.m2_conv_b + (size_t)(l * 2 + dir) * 1024;
    const float dtb = p.m2_dt_bias[(l * 2 + dir) * 8 + head];
    const float Aneg = -__expf(p.m2_a_log[(l * 2 + dir) * 8 + head]);
    const float Dsk = p.m2_d[(l * 2 + dir) * 8 + head];
    float S[8];
#pragma unroll
    for (int r = 0; r < 8; ++r) S[r] = 0.f;
    for (int chunk = 0; chunk < 136; ++chunk) {
      const int pbase = chunk * 32;
      const int seg0 = (pbase < 256) ? 0 : 256;
#pragma unroll
      for (int i = 0; i < 2; ++i) {
        int q = tid + 256 * i; int pos = q >> 4, seg = q & 15;
        int pp = pbase + pos;
        int chB = 512 + g * 128 + seg * 8, chC = 768 + g * 128 + seg * 8;
        float aB[8], aC[8];
#pragma unroll
        for (int j = 0; j < 8; ++j) { aB[j] = cb[chB + j]; aC[j] = cb[chC + j]; }
#pragma unroll
        for (int tap = 0; tap < 4; ++tap) {
          int pt = pp - 3 + tap;
          if (pt >= seg0) {
            int R = pos2row_m2(b, pt, dir);
            const u16* up = p.U + (size_t)R * UW + 2048;
            uint4 bv = *(const uint4*)(up + chB);
            uint4 cv = *(const uint4*)(up + chC);
            float f[8];
            unpack8(bv, f);
#pragma unroll
            for (int j = 0; j < 8; ++j) aB[j] += cw[tap * 1024 + chB + j] * f[j];
            unpack8(cv, f);
#pragma unroll
            for (int j = 0; j < 8; ++j) aC[j] += cw[tap * 1024 + chC + j] * f[j];
          }
        }
#pragma unroll
        for (int j = 0; j < 8; ++j) { aB[j] = siluf(aB[j]); aC[j] = siluf(aC[j]); }
        *(float4*)(Bs + pos * 128 + seg * 8) = make_float4(aB[0], aB[1], aB[2], aB[3]);
        *(float4*)(Bs + pos * 128 + seg * 8 + 4) = make_float4(aB[4], aB[5], aB[6], aB[7]);
        *(float4*)(Cs + pos * 128 + seg * 8) = make_float4(aC[0], aC[1], aC[2], aC[3]);
        *(float4*)(Cs + pos * 128 + seg * 8 + 4) = make_float4(aC[4], aC[5], aC[6], aC[7]);
      }
      {
        int pos = tid >> 3, e2 = (tid & 7) * 2;
        int pp = pbase + pos;
        int ch = head * 64 + ps * 16 + e2;
        float a0 = cb[ch], a1 = cb[ch + 1];
#pragma unroll
        for (int tap = 0; tap < 4; ++tap) {
          int pt = pp - 3 + tap;
          if (pt >= seg0) {
            int R = pos2row_m2(b, pt, dir);
            uint32_t w = *(const uint32_t*)(p.U + (size_t)R * UW + 2048 + ch);
            a0 += cw[tap * 1024 + ch] * bflo(w); a1 += cw[tap * 1024 + ch + 1] * bfhi(w);
          }
        }
        xs[pos * 16 + e2] = siluf(a0); xs[pos * 16 + e2 + 1] = siluf(a1);
      }
      if (tid < 32) {
        int R = pos2row_m2(b, pbase + tid, dir);
        float dtv = softplusf(p.DT[(size_t)R * 8 + head] + dtb);
        dts[tid] = dtv; decs[tid] = __expf(dtv * Aneg);
      }
      __syncthreads();
#pragma unroll 4
      for (int i = 0; i < 32; ++i) {
        float4 q0 = *(const float4*)(Cs + i * 128 + dg * 8), q1 = *(const float4*)(Cs + i * 128 + dg * 8 + 4);
        float4 k0 = *(const float4*)(Bs + i * 128 + dg * 8), k1 = *(const float4*)(Bs + i * 128 + dg * 8 + 4);
        float xv = xs[i * 16 + wave * 4 + el];
        float a = decs[i]; float v = xv * dts[i];
        S[0] = a * S[0] + k0.x * v; S[1] = a * S[1] + k0.y * v; S[2] = a * S[2] + k0.z * v; S[3] = a * S[3] + k0.w * v;
        S[4] = a * S[4] + k1.x * v; S[5] = a * S[5] + k1.y * v; S[6] = a * S[6] + k1.z * v; S[7] = a * S[7] + k1.w * v;
        float o = q0.x * S[0] + q0.y * S[1] + q0.z * S[2] + q0.w * S[3] + q1.x * S[4] + q1.y * S[5] + q1.z * S[6] + q1.w * S[7];
        o += __shfl_xor(o, 1); o += __shfl_xor(o, 2); o += __shfl_xor(o, 4); o += __shfl_xor(o, 8);
        if (dg == 0) os[i * 16 + wave * 4 + el] = o + Dsk * xv;
      }
      __syncthreads();
      {
        int pos = tid >> 3, e2 = (tid & 7) * 2;
        int R = pos2row_m2(b, pbase + pos, dir);
        uint32_t* yp = (uint32_t*)(p.Y2 + (size_t)R * 1024 + 512 + head * 64 + ps * 16 + e2);
        float o0 = os[pos * 16 + e2], o1 = os[pos * 16 + e2 + 1];
        if (dir == 1) { uint32_t w = *yp; o0 += bflo(w); o1 += bfhi(w); }
        *yp = pack2(o0, o1);
      }
    }
    __threadfence();
    __syncthreads();
  }
}

#ifndef M2_MFMA
#define M2_MFMA 1
#endif
#define QS 136
#define TS 40
union FragU { bf16x8 v; uint32_t u[4]; uint2 d[2]; uint4 q; };
__device__ __forceinline__ bf16x8 cvt_frag(const f32x16& x, int s2) {
  FragU f;
  f.u[0] = pack2(x[8 * s2 + 0], x[8 * s2 + 1]); f.u[1] = pack2(x[8 * s2 + 2], x[8 * s2 + 3]);
  f.u[2] = pack2(x[8 * s2 + 4], x[8 * s2 + 5]); f.u[3] = pack2(x[8 * s2 + 6], x[8 * s2 + 7]);
  return f.v;
}
__device__ __forceinline__ bf16x8 ld_frag_perm(const u16* base) {
  FragU f; f.d[0] = *(const uint2*)base; f.d[1] = *(const uint2*)(base + 8); return f.v;
}

template <int PASS>
__device__ __forceinline__ void hg_mfma(const P& p, int l, int task, int blk, int dir0, unsigned char* smem) {
  int tid = threadIdx.x; asm volatile("" : "+v"(tid)); const int wave = tid >> 6, lane = tid & 63;
  const int r = lane & 31, hh = lane >> 5;
  const int b = task >> 2, h = task & 3;
  u16* ks = (u16*)smem;
  u16* qs = ks + 32 * QS;
  u16* kT = qs + 32 * QS;
  u16* vT = kT + 128 * TS;
  float* tot = (float*)(vT + 128 * TS);
  float* eg = tot + 256;
  const int dd = tid & 127, half = tid >> 7;
  for (int dir = (PASS == 0 ? dir0 : 0); dir < (PASS == 0 ? dir0 + 1 : 2); ++dir) {
    const int sbd = (PASS == 0) ? blk : ((blk == 0) ? 0 : (dir ? 5 - blk : blk));
    const int c0 = (sbd == 0) ? 0 : 8 + 32 * (sbd - 1);
    const int c1 = (sbd == 0) ? 8 : 8 + 32 * sbd;
    float gsum = 0.f;
    f32x16 S[4];
#pragma unroll
    for (int i = 0; i < 4; ++i)
#pragma unroll
      for (int q = 0; q < 16; ++q) S[i][q] = 0.f;
    if (PASS == 1) {
      for (int qb = 0; qb < sbd; ++qb) {
        const size_t sidx = (size_t)((task * 2 + dir) * 4 + qb);
        if (half == 0) eg[dd] = __expf(p.PS[sidx * 128 + dd]);
        __syncthreads();
        const float* sp = p.SSH + sidx * 16384 + (size_t)wave * 4096 + lane;
#pragma unroll
        for (int dt = 0; dt < 4; ++dt)
#pragma unroll
          for (int q4 = 0; q4 < 4; ++q4) {
            float4 e4 = *(const float4*)(eg + 32 * dt + 8 * q4 + 4 * hh);
            S[dt][4 * q4 + 0] = S[dt][4 * q4 + 0] * e4.x + sp[(dt * 16 + 4 * q4 + 0) * 64];
            S[dt][4 * q4 + 1] = S[dt][4 * q4 + 1] * e4.y + sp[(dt * 16 + 4 * q4 + 1) * 64];
            S[dt][4 * q4 + 2] = S[dt][4 * q4 + 2] * e4.z + sp[(dt * 16 + 4 * q4 + 2) * 64];
            S[dt][4 * q4 + 3] = S[dt][4 * q4 + 3] * e4.w + sp[(dt * 16 + 4 * q4 + 3) * 64];
          }
        __syncthreads();
      }
    }
    uint4 pq0, pq1, pk0, pk1, pv0, pv1;
#define HG_PREFETCH(CH)                                                                     \
    {                                                                                       \
      int pos0 = tid >> 4, seg = tid & 15;                                                  \
      int R0 = pos2row_seq(b, (CH) * 32 + pos0, dir), R1 = pos2row_seq(b, (CH) * 32 + pos0 + 16, dir); \
      const u16* u0 = p.U + (size_t)R0 * UW + h * 128 + seg * 8;                            \
      const u16* u1 = p.U + (size_t)R1 * UW + h * 128 + seg * 8;                            \
      pq0 = *(const uint4*)u0; pq1 = *(const uint4*)u1;                                     \
      pk0 = *(const uint4*)(u0 + 512 + dir * 512); pk1 = *(const uint4*)(u1 + 512 + dir * 512); \
      pv0 = *(const uint4*)(u0 + 1536); pv1 = *(const uint4*)(u1 + 1536);                   \
    }
    HG_PREFETCH(c0)
#pragma unroll 1
    for (int chunk = c0; chunk < c1; ++chunk) {
      {
        int pos0 = tid >> 4, seg = tid & 15;
        *(uint4*)(qs + pos0 * QS + seg * 8) = pq0; *(uint4*)(qs + (pos0 + 16) * QS + seg * 8) = pq1;
        *(uint4*)(ks + pos0 * QS + seg * 8) = pk0; *(uint4*)(ks + (pos0 + 16) * QS + seg * 8) = pk1;
        FragU f0, f1; f0.q = pv0; f1.q = pv1;
#pragma unroll
        for (int j = 0; j < 4; ++j) {
          vT[(seg * 8 + 2 * j) * TS + pos0] = (u16)(f0.u[j] & 0xffffu); vT[(seg * 8 + 2 * j + 1) * TS + pos0] = (u16)(f0.u[j] >> 16);
          vT[(seg * 8 + 2 * j) * TS + pos0 + 16] = (u16)(f1.u[j] & 0xffffu); vT[(seg * 8 + 2 * j + 1) * TS + pos0 + 16] = (u16)(f1.u[j] >> 16);
        }
      }
      __syncthreads();
      if (chunk + 1 < c1) HG_PREFETCH(chunk + 1)
      const int Rout = pos2row_seq(b, chunk * 32 + r, dir);
      u16* yrow = p.Y2 + (size_t)Rout * 1024 + h * 128 + wave * 32 + 4 * hh;
      uint2 yold[4];
      if (PASS == 1 && dir == 1) {
#pragma unroll
        for (int q4 = 0; q4 < 4; ++q4) yold[q4] = *(const uint2*)(yrow + 8 * q4);
      }
      float gl[16];
      {
        float run = 0.f;
#pragma unroll
        for (int i = 0; i < 16; ++i) {
          float kkv = bf2f(ks[(half * 16 + i) * QS + dd]);
          run += __logf(fmaxf(1.f - kkv, 1e-6f));
          gl[i] = run;
        }
        tot[half * 128 + dd] = run;
      }
      __syncthreads();
      {
        const float t0 = tot[dd], t1 = tot[128 + dd];
        const float off = half ? t0 : 0.f;
        const float g31 = t0 + t1;
        float k2[16];
#pragma unroll
        for (int i = 0; i < 16; ++i) {
          const int pos = half * 16 + i;
          const float g = gl[i] + off;
          const float kkv = bf2f(ks[pos * QS + dd]);
          const float qv = bf2f(qs[pos * QS + dd]);
          qs[pos * QS + dd] = f2bf(qv * __expf(g));
          ks[pos * QS + dd] = f2bf(kkv * __expf(fminf(-g, 60.f)));
          k2[i] = kkv * __expf(g31 - g);
        }
        *(uint4*)(kT + dd * TS + half * 16) = pack8(k2);
        *(uint4*)(kT + dd * TS + half * 16 + 8) = pack8(k2 + 8);
        if (half == 0) eg[dd] = __expf(g31);
        gsum += g31;
      }
      __syncthreads();
      f32x16 O;
      if (PASS == 1) {
      f32x16 att;
#pragma unroll
      for (int q = 0; q < 16; ++q) att[q] = 0.f;
#pragma unroll
      for (int k8 = 0; k8 < 8; ++k8) {
        bf16x8 A = *(const bf16x8*)(ks + r * QS + 16 * k8 + 8 * hh);
        bf16x8 B = *(const bf16x8*)(qs + r * QS + 16 * k8 + 8 * hh);
        att = __builtin_amdgcn_mfma_f32_32x32x16_bf16(A, B, att, 0, 0, 0);
      }
#pragma unroll
      for (int q = 0; q < 16; ++q) {
        int sidx = (q & 3) + 8 * (q >> 2) + 4 * hh;
        if (sidx > r) att[q] = 0.f;
      }
#pragma unroll
      for (int q = 0; q < 16; ++q) O[q] = 0.f;
#pragma unroll
      for (int dt = 0; dt < 4; ++dt)
#pragma unroll
        for (int s2 = 0; s2 < 2; ++s2) {
          bf16x8 A = cvt_frag(S[dt], s2);
          bf16x8 B = ld_frag_perm(qs + r * QS + 32 * dt + 16 * s2 + 4 * hh);
          O = __builtin_amdgcn_mfma_f32_32x32x16_bf16(A, B, O, 0, 0, 0);
        }
#pragma unroll
      for (int s2 = 0; s2 < 2; ++s2) {
        bf16x8 A = ld_frag_perm(vT + (32 * wave + r) * TS + 16 * s2 + 4 * hh);
        bf16x8 B = cvt_frag(att, s2);
        O = __builtin_amdgcn_mfma_f32_32x32x16_bf16(A, B, O, 0, 0, 0);
      }
      }
#pragma unroll
      for (int dt = 0; dt < 4; ++dt) {
#pragma unroll
        for (int q4 = 0; q4 < 4; ++q4) {
          float4 e4 = *(const float4*)(eg + 32 * dt + 8 * q4 + 4 * hh);
          S[dt][4 * q4 + 0] *= e4.x; S[dt][4 * q4 + 1] *= e4.y; S[dt][4 * q4 + 2] *= e4.z; S[dt][4 * q4 + 3] *= e4.w;
        }
#pragma unroll
        for (int s2 = 0; s2 < 2; ++s2) {
          bf16x8 A = *(const bf16x8*)(kT + (32 * dt + r) * TS + 16 * s2 + 8 * hh);
          bf16x8 B = *(const bf16x8*)(vT + (32 * wave + r) * TS + 16 * s2 + 8 * hh);
          S[dt] = __builtin_amdgcn_mfma_f32_32x32x16_bf16(A, B, S[dt], 0, 0, 0);
        }
      }
      if (PASS == 1) {
#pragma unroll
      for (int q4 = 0; q4 < 4; ++q4) {
        float o0 = O[4 * q4], o1 = O[4 * q4 + 1], o2 = O[4 * q4 + 2], o3 = O[4 * q4 + 3];
        if (dir == 1) { o0 += bflo(yold[q4].x); o1 += bfhi(yold[q4].x); o2 += bflo(yold[q4].y); o3 += bfhi(yold[q4].y); }
        uint2 ov; ov.x = pack2(o0, o1); ov.y = pack2(o2, o3);
        *(uint2*)(yrow + 8 * q4) = ov;
      }
      }
      __syncthreads();
    }
    if (PASS == 0) {
      const size_t sidx = (size_t)((task * 2 + dir) * 4 + sbd);
      if (half == 0) p.PS[sidx * 128 + dd] = gsum;
      float* sp = p.SSH + sidx * 16384 + (size_t)wave * 4096 + lane;
#pragma unroll
      for (int dt = 0; dt < 4; ++dt)
#pragma unroll
        for (int q = 0; q < 16; ++q) sp[(dt * 16 + q) * 64] = S[dt][q];
    }
    __threadfence();
    __syncthreads();
  }
}

#if M2_MFMA
#define M2_NTASK 16
template <int PASS>
__device__ __forceinline__ void m2_mfma(const P& p, int l, int task, int blk, int dir0, unsigned char* smem) {
  int tid = threadIdx.x; asm volatile("" : "+v"(tid)); const int wave = tid >> 6, lane = tid & 63;
  const int r = lane & 31, hh = lane >> 5;
  const int b = task >> 2, g = (task >> 1) & 1, hp = task & 1;
  const int hq = wave >> 1, ph = wave & 1;
  const int head = 4 * g + 2 * hp + hq;
  u16* Bm = (u16*)smem;
  u16* Cm = Bm + 32 * QS;
  u16* BmT = Cm + 32 * QS;
  u16* xsT = BmT + 128 * TS;
  float* Gs = (float*)(xsT + 128 * TS);
  float* dts = Gs + 64;
  float* wl = dts + 64;
  const int cp = (lane < 48) ? lane : 47;
  const bool act = lane < 48;
  const int chW = (cp < 16) ? ((4 * g + 2 * hp) * 64 + cp * 8) : (cp < 32) ? (512 + g * 128 + (cp - 16) * 8) : (768 + g * 128 + (cp - 32) * 8);
  const int chU = 2048 + chW;
  float* SSM = (float*)p.KF;
  for (int dir = (PASS == 0 ? dir0 : 0); dir < (PASS == 0 ? dir0 + 1 : 2); ++dir) {
    const int sbd = (PASS == 0) ? blk : ((blk == 0) ? 0 : (dir ? 9 - blk : blk));
    const int c0 = (sbd == 0) ? 0 : 8 + 16 * (sbd - 1);
    const int c1 = (sbd == 0) ? 8 : 8 + 16 * sbd;
    float lsum = 0.f;
    const float* cw = p.m2_conv_w + (size_t)(l * 2 + dir) * 4 * 1024;
    const float* cb = p.m2_conv_b + (size_t)(l * 2 + dir) * 1024;
    if (wave == 0) {
#pragma unroll
      for (int j = 0; j < 8; ++j) {
        wl[(4 * 8 + j) * 64 + lane] = cb[chW + j];
#pragma unroll
        for (int tap = 0; tap < 4; ++tap) wl[(tap * 8 + j) * 64 + lane] = cw[tap * 1024 + chW + j];
      }
    }
    __syncthreads();
    const int hd_t = 4 * g + 2 * hp + ((tid >> 5) & 1);
    const float dtb = p.m2_dt_bias[(l * 2 + dir) * 8 + hd_t];
    const float Aneg_t = -__expf(p.m2_a_log[(l * 2 + dir) * 8 + hd_t]);
    const float Dsk = p.m2_d[(l * 2 + dir) * 8 + head];
    f32x16 S[4];
#pragma unroll
    for (int i = 0; i < 4; ++i)
#pragma unroll
      for (int q = 0; q < 16; ++q) S[i][q] = 0.f;
    if (PASS == 1) {
      for (int qb = 0; qb < sbd; ++qb) {
        const size_t sidx = (size_t)((task * 2 + dir) * 8 + qb);
        const float a = __expf(p.PA[sidx * 4 + wave]);
        const float* sp = SSM + sidx * 16384 + (size_t)wave * 4096 + lane;
#pragma unroll
        for (int nt = 0; nt < 4; ++nt)
#pragma unroll
          for (int q = 0; q < 16; ++q) S[nt][q] = S[nt][q] * a + sp[(nt * 16 + q) * 64];
      }
    }
    uint4 raw0, raw1, raw2, raw3, raw4, raw5, raw6, raw7, raw8, raw9, raw10;
    float dtraw = 0.f;
#define M2_LD1(RW, I, CH)                                                                  \
    {                                                                                      \
      int pt = (CH) * 32 + wave * 8 + (I) - 3;                                             \
      int sg0 = ((CH) * 32 < 256) ? 0 : 256;                                               \
      if (pt >= sg0) { int Rr = pos2row_m2(b, pt, dir); RW = *(const uint4*)(p.U + (size_t)Rr * UW + chU); } \
      else RW = make_uint4(0u, 0u, 0u, 0u);                                                \
    }
#define M2_PREFETCH(CH)                                                                    \
    M2_LD1(raw0, 0, CH) M2_LD1(raw1, 1, CH) M2_LD1(raw2, 2, CH) M2_LD1(raw3, 3, CH) M2_LD1(raw4, 4, CH) M2_LD1(raw5, 5, CH) \
    M2_LD1(raw6, 6, CH) M2_LD1(raw7, 7, CH) M2_LD1(raw8, 8, CH) M2_LD1(raw9, 9, CH) M2_LD1(raw10, 10, CH)            \
    if (tid < 64) { int Rr = pos2row_m2(b, (CH) * 32 + (tid & 31), dir); dtraw = p.DT[(size_t)Rr * 8 + hd_t]; }
    M2_PREFETCH(c0)
#pragma unroll 1
    for (int chunk = c0; chunk < c1; ++chunk) {
      {
#define M2_RAWF(RW, J) (((J) & 1) ? bfhi((RW)) : bflo((RW)))
#define M2_CH(J, C0, C1, C2, C3, C4, C5, C6, C7, C8, C9, C10)                               \
        {                                                                                  \
          const float q0 = wl[(0 * 8 + (J)) * 64 + lane], q1 = wl[(1 * 8 + (J)) * 64 + lane]; \
          const float q2 = wl[(2 * 8 + (J)) * 64 + lane], q3 = wl[(3 * 8 + (J)) * 64 + lane]; \
          const float qb = wl[(4 * 8 + (J)) * 64 + lane];                                  \
          const float v0 = M2_RAWF(C0, J), v1 = M2_RAWF(C1, J), v2 = M2_RAWF(C2, J), v3 = M2_RAWF(C3, J); \
          const float v4 = M2_RAWF(C4, J), v5 = M2_RAWF(C5, J), v6 = M2_RAWF(C6, J), v7 = M2_RAWF(C7, J); \
          const float v8 = M2_RAWF(C8, J), v9 = M2_RAWF(C9, J), v10 = M2_RAWF(C10, J);      \
          float o[8];                                                                      \
          o[0] = siluf(qb + q0 * v0 + q1 * v1 + q2 * v2 + q3 * v3);                        \
          o[1] = siluf(qb + q0 * v1 + q1 * v2 + q2 * v3 + q3 * v4);                        \
          o[2] = siluf(qb + q0 * v2 + q1 * v3 + q2 * v4 + q3 * v5);                        \
          o[3] = siluf(qb + q0 * v3 + q1 * v4 + q2 * v5 + q3 * v6);                        \
          o[4] = siluf(qb + q0 * v4 + q1 * v5 + q2 * v6 + q3 * v7);                        \
          o[5] = siluf(qb + q0 * v5 + q1 * v6 + q2 * v7 + q3 * v8);                        \
          o[6] = siluf(qb + q0 * v6 + q1 * v7 + q2 * v8 + q3 * v9);                        \
          o[7] = siluf(qb + q0 * v7 + q1 * v8 + q2 * v9 + q3 * v10);                       \
          if (act) {                                                                       \
            if (cp < 16) {                                                                 \
              *(uint4*)(xsT + (cp * 8 + (J)) * TS + wave * 8) = pack8(o);                  \
            } else if (cp < 32) {                                                          \
              *(uint4*)(BmT + ((cp - 16) * 8 + (J)) * TS + wave * 8) = pack8(o);           \
              _Pragma("unroll") for (int i = 0; i < 8; ++i) Bm[(wave * 8 + i) * QS + (cp - 16) * 8 + (J)] = f2bf(o[i]); \
            } else {                                                                       \
              _Pragma("unroll") for (int i = 0; i < 8; ++i) Cm[(wave * 8 + i) * QS + (cp - 32) * 8 + (J)] = f2bf(o[i]); \
            }                                                                              \
          }                                                                                \
        }
        M2_CH(0, raw0.x, raw1.x, raw2.x, raw3.x, raw4.x, raw5.x, raw6.x, raw7.x, raw8.x, raw9.x, raw10.x)
        M2_CH(1, raw0.x, raw1.x, raw2.x, raw3.x, raw4.x, raw5.x, raw6.x, raw7.x, raw8.x, raw9.x, raw10.x)
        M2_CH(2, raw0.y, raw1.y, raw2.y, raw3.y, raw4.y, raw5.y, raw6.y, raw7.y, raw8.y, raw9.y, raw10.y)
        M2_CH(3, raw0.y, raw1.y, raw2.y, raw3.y, raw4.y, raw5.y, raw6.y, raw7.y, raw8.y, raw9.y, raw10.y)
        M2_CH(4, raw0.z, raw1.z, raw2.z, raw3.z, raw4.z, raw5.z, raw6.z, raw7.z, raw8.z, raw9.z, raw10.z)
        M2_CH(5, raw0.z, raw1.z, raw2.z, raw3.z, raw4.z, raw5.z, raw6.z, raw7.z, raw8.z, raw9.z, raw10.z)
        M2_CH(6, raw0.w, raw1.w, raw2.w, raw3.w, raw4.w, raw5.w, raw6.w, raw7.w, raw8.w, raw9.w, raw10.w)
        M2_CH(7, raw0.w, raw1.w, raw2.w, raw3.w, raw4.w, raw5.w, raw6.w, raw7.w, raw8.w, raw9.w, raw10.w)
      }
      if (tid < 64) {
        float dtv = softplusf(dtraw + dtb);
        float run = dtv * Aneg_t;
#pragma unroll
        for (int o = 1; o < 32; o <<= 1) { float n = __shfl_up(run, o, 32); if ((tid & 31) >= o) run += n; }
        Gs[tid] = run; dts[tid] = dtv;
      }
      __syncthreads();
      if (chunk + 1 < c1) { M2_PREFETCH(chunk + 1) }
      const int Rout = pos2row_m2(b, chunk * 32 + r, dir);
      u16* yrow = p.Y2 + (size_t)Rout * 1024 + 512 + head * 64 + 32 * ph + 4 * hh;
      uint2 yold[4];
      if (PASS == 1 && dir == 1) {
#pragma unroll
        for (int i = 0; i < 4; ++i) yold[i] = *(const uint2*)(yrow + 8 * i);
      }
      const float* Gw = Gs + hq * 32; const float* dw = dts + hq * 32;
      const float Gt = Gw[r], G31 = Gw[31];
      lsum += G31;
      const u16* xw = xsT + (hq * 64 + ph * 32) * TS;
      f32x16 O0;
      if (PASS == 1) {
      f32x16 att;
#pragma unroll
      for (int q = 0; q < 16; ++q) att[q] = 0.f;
#pragma unroll
      for (int k8 = 0; k8 < 8; ++k8) {
        bf16x8 A = *(const bf16x8*)(Bm + r * QS + 16 * k8 + 8 * hh);
        bf16x8 B = *(const bf16x8*)(Cm + r * QS + 16 * k8 + 8 * hh);
        att = __builtin_amdgcn_mfma_f32_32x32x16_bf16(A, B, att, 0, 0, 0);
      }
#pragma unroll
      for (int q4 = 0; q4 < 4; ++q4) {
        float4 gs4 = *(const float4*)(Gw + 8 * q4 + 4 * hh);
        float4 dt4 = *(const float4*)(dw + 8 * q4 + 4 * hh);
        int s0 = 8 * q4 + 4 * hh;
        att[4 * q4 + 0] = (s0 + 0 <= r) ? att[4 * q4 + 0] * __expf(Gt - gs4.x) * dt4.x : 0.f;
        att[4 * q4 + 1] = (s0 + 1 <= r) ? att[4 * q4 + 1] * __expf(Gt - gs4.y) * dt4.y : 0.f;
        att[4 * q4 + 2] = (s0 + 2 <= r) ? att[4 * q4 + 2] * __expf(Gt - gs4.z) * dt4.z : 0.f;
        att[4 * q4 + 3] = (s0 + 3 <= r) ? att[4 * q4 + 3] * __expf(Gt - gs4.w) * dt4.w : 0.f;
      }
#pragma unroll
      for (int q = 0; q < 16; ++q) O0[q] = 0.f;
#pragma unroll
      for (int nt = 0; nt < 4; ++nt)
#pragma unroll
        for (int s2 = 0; s2 < 2; ++s2) {
          bf16x8 B = ld_frag_perm(Cm + r * QS + 32 * nt + 16 * s2 + 4 * hh);
          O0 = __builtin_amdgcn_mfma_f32_32x32x16_bf16(cvt_frag(S[nt], s2), B, O0, 0, 0, 0);
        }
      {
        const float eGt = __expf(Gt);
#pragma unroll
        for (int q = 0; q < 16; ++q) O0[q] *= eGt;
      }
#pragma unroll
      for (int s2 = 0; s2 < 2; ++s2) {
        bf16x8 B = cvt_frag(att, s2);
        O0 = __builtin_amdgcn_mfma_f32_32x32x16_bf16(ld_frag_perm(xw + r * TS + 16 * s2 + 4 * hh), B, O0, 0, 0, 0);
      }
#pragma unroll
      for (int q = 0; q < 16; ++q) {
        int pp = (q & 3) + 8 * (q >> 2) + 4 * hh;
        O0[q] += Dsk * bf2f(xw[pp * TS + r]);
      }
      }
      {
        const float eG31 = __expf(G31);
#pragma unroll
        for (int nt = 0; nt < 4; ++nt)
#pragma unroll
          for (int q = 0; q < 16; ++q) S[nt][q] *= eG31;
#pragma unroll
        for (int s2 = 0; s2 < 2; ++s2) {
          float ws[8];
          {
            float4 ga = *(const float4*)(Gw + 16 * s2 + 8 * hh), gb = *(const float4*)(Gw + 16 * s2 + 8 * hh + 4);
            float4 da = *(const float4*)(dw + 16 * s2 + 8 * hh), db = *(const float4*)(dw + 16 * s2 + 8 * hh + 4);
            ws[0] = da.x * __expf(G31 - ga.x); ws[1] = da.y * __expf(G31 - ga.y); ws[2] = da.z * __expf(G31 - ga.z); ws[3] = da.w * __expf(G31 - ga.w);
            ws[4] = db.x * __expf(G31 - gb.x); ws[5] = db.y * __expf(G31 - gb.y); ws[6] = db.z * __expf(G31 - gb.z); ws[7] = db.w * __expf(G31 - gb.w);
          }
          bf16x8 Bf0;
          {
            float f[8]; unpack8(*(const uint4*)(xw + r * TS + 16 * s2 + 8 * hh), f);
#pragma unroll
            for (int j = 0; j < 8; ++j) f[j] *= ws[j];
            FragU u; u.q = pack8(f); Bf0 = u.v;
          }
#pragma unroll
          for (int nt = 0; nt < 4; ++nt) {
            bf16x8 A = *(const bf16x8*)(BmT + (32 * nt + r) * TS + 16 * s2 + 8 * hh);
            S[nt] = __builtin_amdgcn_mfma_f32_32x32x16_bf16(A, Bf0, S[nt], 0, 0, 0);
          }
        }
      }
      if (PASS == 1) {
#pragma unroll
      for (int q4 = 0; q4 < 4; ++q4) {
        float o0 = O0[4 * q4], o1 = O0[4 * q4 + 1], o2 = O0[4 * q4 + 2], o3 = O0[4 * q4 + 3];
        if (dir == 1) { o0 += bflo(yold[q4].x); o1 += bfhi(yold[q4].x); o2 += bflo(yold[q4].y); o3 += bfhi(yold[q4].y); }
        uint2 ov; ov.x = pack2(o0, o1); ov.y = pack2(o2, o3);
        *(uint2*)(yrow + 8 * q4) = ov;
      }
      }
      __syncthreads();
    }
    if (PASS == 0) {
      const size_t sidx = (size_t)((task * 2 + dir) * 8 + sbd);
      if (lane == 0) p.PA[sidx * 4 + wave] = lsum;
      float* sp = SSM + sidx * 16384 + (size_t)wave * 4096 + lane;
#pragma unroll
      for (int nt = 0; nt < 4; ++nt)
#pragma unroll
        for (int q = 0; q < 16; ++q) sp[(nt * 16 + q) * 64] = S[nt][q];
    }
    __threadfence();
    __syncthreads();
  }
}
#endif
__device__ __forceinline__ void ph_mixA0(const P& p, int l, int bid, int nb, unsigned char* sm) {
  for (int i = 0;; ++i) {
    int t;
    if (nb == 256) {
      if (bid < 128) { if (i >= 1) break; t = bid; }
      else { if (i >= 2) break; t = 128 + (bid - 128) + 128 * i; }
    } else { t = bid + i * nb; if (t >= 384) break; }
    if (t < 128) hg_mfma<0>(p, l, t >> 3, (t >> 1) & 3, t & 1, sm);
    else { int u = t - 128; m2_mfma<0>(p, l, u >> 4, (u >> 1) & 7, u & 1, sm); }
    __syncthreads();
  }
}
__device__ __forceinline__ void ph_mixA1(const P& p, int l, int bid, int nb, unsigned char* sm) {
  for (int t = bid; t < 80 + 144; t += nb) {
    if (t < 80) hg_mfma<1>(p, l, t / 5, t % 5, 0, sm);
    else { int u = t - 80; m2_mfma<1>(p, l, u / 9, u % 9, 0, sm); }
    __syncthreads();
  }
}

template <int PASS>
__device__ __forceinline__ void rg_task(const P& p, int l, int task, float* sm) {
  int tid = threadIdx.x; asm volatile("" : "+v"(tid));
  const int wave = tid >> 6, lane = tid & 63;
  const int b = task / 136, rem = task % 136, head = rem / 17, sb = rem % 17;
  float* xc = sm;
  float* pa = sm + 2048;
  float* pb = sm + 4096;
  u16* xcb = (u16*)(sm + 6144);
  u16* WTl = xcb + 32 * 72;
  const int j = tid & 63;
  const int spos = tid >> 3, sseg = tid & 7;
  const int sch = head * 64 + sseg * 8;
  const u16* UB2 = p.U + (size_t)NTOK * 2048;
  for (int dir = 0; dir < 2; ++dir) {
    const int ld = l * 2 + dir;
    {
      const float* wa = p.rg_wa + (size_t)(ld * 8 + head) * 4096;
      const float* wx = p.rg_wx + (size_t)(ld * 8 + head) * 4096;
#pragma unroll
      for (int it = 0; it < 4; ++it) {
        int i = (tid >> 4) + 16 * it, j4 = (tid & 15) * 4;
        float4 va = *(const float4*)(wa + i * 64 + j4);
        float4 vx = *(const float4*)(wx + i * 64 + j4);
        WTl[(j4 + 0) * 72 + i] = f2bf(va.x); WTl[(j4 + 1) * 72 + i] = f2bf(va.y);
        WTl[(j4 + 2) * 72 + i] = f2bf(va.z); WTl[(j4 + 3) * 72 + i] = f2bf(va.w);
        WTl[(64 + j4 + 0) * 72 + i] = f2bf(vx.x); WTl[(64 + j4 + 1) * 72 + i] = f2bf(vx.y);
        WTl[(64 + j4 + 2) * 72 + i] = f2bf(vx.z); WTl[(64 + j4 + 3) * 72 + i] = f2bf(vx.w);
      }
    }
    float wcv[4][8], bcv[8];
#pragma unroll
    for (int jj = 0; jj < 8; ++jj) {
      bcv[jj] = p.rg_conv_b[(size_t)ld * 512 + sch + jj];
#pragma unroll
      for (int tap = 0; tap < 4; ++tap) wcv[tap][jj] = p.rg_conv_w[((size_t)ld * 4 + tap) * 512 + sch + jj];
    }
    const int chg = head * 64 + j;
    const float g_ba = p.rg_ba[ld * 512 + chg], g_bx = p.rg_bx[ld * 512 + chg];
    const float g_sp = -8.0f * softplusf(-p.rg_lam[ld * 512 + chg]);
    const int sbd = (PASS == 0) ? sb : (dir ? (sb == 0 ? 0 : 17 - sb) : sb);
    float hcarry = 0.f, aprod = 1.f;
    if (PASS == 1 && tid < 64) {
      for (int q = 0; q < sbd; ++q) {
        const float* sp = p.SUM + ((((size_t)b * 2 + dir) * 17 + q) * 512 + head * 64 + tid) * 2;
        hcarry = sp[0] * hcarry + sp[1];
      }
    }
    uint4 xr0, xr1, xr2, xr3;
#define RG_LD1(XR, TAP, CH)                                                               \
    {                                                                                     \
      int pt = (CH) * 32 + spos - 3 + (TAP);                                              \
      int sg0 = ((CH) * 32 < 256) ? 0 : 256;                                              \
      if (pt >= sg0) { int Rr = pos2row_seq(b, pt, dir); XR = *(const uint4*)(UB2 + (size_t)Rr * 2048 + sch); } \
      else XR = make_uint4(0u, 0u, 0u, 0u);                                               \
    }
#define RG_PREFETCH(CH) RG_LD1(xr0, 0, CH) RG_LD1(xr1, 1, CH) RG_LD1(xr2, 2, CH) RG_LD1(xr3, 3, CH)
    RG_PREFETCH(sbd * 8)
#pragma unroll 1
    for (int chunk = sbd * 8; chunk < sbd * 8 + 8; ++chunk) {
      const int pbase = chunk * 32;
      {
        float a[8], f[8];
#pragma unroll
        for (int jj = 0; jj < 8; ++jj) a[jj] = bcv[jj];
        unpack8(xr0, f);
#pragma unroll
        for (int jj = 0; jj < 8; ++jj) a[jj] += wcv[0][jj] * f[jj];
        unpack8(xr1, f);
#pragma unroll
        for (int jj = 0; jj < 8; ++jj) a[jj] += wcv[1][jj] * f[jj];
        unpack8(xr2, f);
#pragma unroll
        for (int jj = 0; jj < 8; ++jj) a[jj] += wcv[2][jj] * f[jj];
        unpack8(xr3, f);
#pragma unroll
        for (int jj = 0; jj < 8; ++jj) a[jj] += wcv[3][jj] * f[jj];
        *(float4*)(xc + spos * 64 + sseg * 8) = make_float4(a[0], a[1], a[2], a[3]);
        *(float4*)(xc + spos * 64 + sseg * 8 + 4) = make_float4(a[4], a[5], a[6], a[7]);
        *(uint4*)(xcb + spos * 72 + sseg * 8) = pack8(a);
      }
      __syncthreads();
      if (chunk + 1 < sbd * 8 + 8) { RG_PREFETCH(chunk + 1) }
      const int Rout = pos2row_seq(b, pbase + spos, dir);
      uint4* yp = (uint4*)(p.HL + (size_t)Rout * 1024 + 512 + sch);
      uint4 prev, gv;
      if (PASS == 1 && dir == 1) { prev = *yp; gv = *(const uint4*)(UB2 + (size_t)Rout * 2048 + 512 + sch); }
      {
        const int r = lane & 31, hh = lane >> 5;
        f32x16 acc;
#pragma unroll
        for (int q = 0; q < 16; ++q) acc[q] = 0.f;
#pragma unroll
        for (int ks = 0; ks < 4; ++ks) {
          bf16x8 A = *(const bf16x8*)(xcb + r * 72 + 16 * ks + 8 * hh);
          bf16x8 B = *(const bf16x8*)(WTl + (32 * wave + r) * 72 + 16 * ks + 8 * hh);
          acc = __builtin_amdgcn_mfma_f32_32x32x16_bf16(A, B, acc, 0, 0, 0);
        }
        float* dstp = (wave < 2) ? pa : pb;
        const int jc = (wave & 1) * 32 + r;
#pragma unroll
        for (int q = 0; q < 16; ++q) dstp[((q & 3) + 8 * (q >> 2) + 4 * hh) * 64 + jc] = acc[q];
      }
      __syncthreads();
#pragma unroll
      for (int i = 0; i < 8; ++i) {
        int e = tid + 256 * i;
        float r = sigmf(pa[e] + g_ba);
        float gi = sigmf(pb[e] + g_bx);
        float la = g_sp * r;
        float a = __expf(la);
        float bt = sqrtf(fmaxf(1.f - a * a, 0.f)) * gi * xc[e];
        pa[e] = a; pb[e] = bt;
      }
      __syncthreads();
      if (tid < 64) {
        float hh = hcarry;
#pragma unroll 8
        for (int pos = 0; pos < 32; ++pos) { float av = pa[pos * 64 + tid]; hh = av * hh + pb[pos * 64 + tid]; pb[pos * 64 + tid] = hh; aprod *= av; }
        hcarry = hh;
      }
      __syncthreads();
      if (PASS == 1) {
        float hv[8];
#pragma unroll
        for (int jj = 0; jj < 8; ++jj) hv[jj] = pb[spos * 64 + sseg * 8 + jj];
        if (dir == 1) {
          float f[8]; unpack8(prev, f);
          float gf[8]; unpack8(gv, gf);
#pragma unroll
          for (int jj = 0; jj < 8; ++jj) hv[jj] = (hv[jj] + f[jj]) * gf[jj];
        }
        *yp = pack8(hv);
      }
    }
    if (PASS == 0 && tid < 64) {
      float* sp = p.SUM + ((((size_t)b * 2 + dir) * 17 + sbd) * 512 + head * 64 + tid) * 2;
      sp[0] = aprod; sp[1] = hcarry;
    }
    __threadfence();
    __syncthreads();
  }
}

typedef bf16x8 __attribute__((aligned(2))) bf16x8_u;

__device__ __forceinline__ void hy_conv3x8(const u16* col, int t8, int n, float w0, float w1, float w2, float bias, float* out) {
  float f[8]; unpack8(*(const uint4*)(col + t8), f);
  float prev = (t8 > 0) ? bf2f(col[t8 - 1]) : 0.f;
  float next = (t8 + 8 < n) ? bf2f(col[t8 + 8]) : 0.f;
#pragma unroll
  for (int j = 0; j < 8; ++j) {
    float a = (j == 0) ? prev : f[j - 1];
    float cnx = (j == 7) ? next : f[j + 1];
    out[j] = bias + w0 * a + w1 * f[j] + w2 * cnx;
  }
}

__device__ __forceinline__ void hy_task(const P& p, int l, int c, float* sm) {
  int tid = threadIdx.x; asm volatile("" : "+v"(tid)); const int wave = tid >> 6, lane = tid & 63;
  const int r = lane & 31, h = lane >> 5;
  u16* krr = (u16*)sm;
  u16* zs = krr + 8192 + 64;
  float* red = (float*)(zs + 16384);
  const u16* UT = p.U;
  const float* cwp = p.hy_conv_w + (size_t)l * 3 * 1536;
  const float* cbp = p.hy_conv_b + (size_t)l * 1536;
  for (int o = 0; o < 2; ++o) {
    const u16* K = p.KF + (size_t)(o * 512 + c) * 8192;
    float asum = 0.f;
#pragma unroll
    for (int i = 0; i < 4; ++i) {
      int idx = (tid + 256 * i) * 8;
      uint4 v = *(const uint4*)(K + idx);
      *(uint4*)(krr + idx) = v;
      float f[8]; unpack8(v, f);
#pragma unroll
      for (int j = 0; j < 8; ++j) asum += fabsf(f[j]);
    }
    asum = wave_sum(asum);
    if (lane == 0) red[wave] = asum;
    if (o == 0) {
      const float w0 = cwp[c], w1 = cwp[1536 + c], w2 = cwp[3072 + c], bs = cbp[c];
#pragma unroll 1
      for (int e = tid; e < 2048; e += 256) {
        int b = e >> 9, t8 = (e & 511) * 8;
        float f[8];
        hy_conv3x8(UT + (size_t)c * NTOK + b * 4096, t8, 4096, w0, w1, w2, bs, f);
        *(uint4*)(zs + b * 4096 + t8) = pack8(f);
      }
    }
    __syncthreads();
    const float scale = 1.f / (red[0] + red[1] + red[2] + red[3] + 1e-6f);
    const float skip = p.hy_skip[(l * 2 + o) * 512 + c];
    f32x16 acc[2][2];
#pragma unroll
    for (int a = 0; a < 2; ++a)
#pragma unroll
      for (int b = 0; b < 2; ++b)
#pragma unroll
        for (int q = 0; q < 16; ++q) acc[a][b][q] = 0.f;
    const int I0 = wave * 16;
    const int Il0 = I0 + (r >> 2), Il1 = I0 + 8 + (r >> 2);
    const u16* zb = zs + (r & 3) * 4096 + 8 * h;
    const int ybase = 4096 - r + 8 * h + 48;
    bf16x8 F0, F1, F2, F3, F4, F5;
    {
      const u16* kp = krr + (ybase - 64 * (I0 - 63));
      F0 = *(const bf16x8_u*)(kp); F1 = *(const bf16x8_u*)(kp - 16); F2 = *(const bf16x8_u*)(kp - 32);
      F3 = *(const bf16x8_u*)(kp - 48); F4 = *(const bf16x8_u*)(kp - 64); F5 = *(const bf16x8_u*)(kp - 80);
    }
#pragma unroll 1
    for (int D = I0 - 63; D <= I0 + 15; ++D) {
      bf16x8 B0[4], B1[4];
      {
        int J0 = Il0 - D, J1 = Il1 - D;
        bool ok0 = (unsigned)J0 < 64u, ok1 = (unsigned)J1 < 64u;
        const u16* zp0 = zb + 64 * J0; const u16* zp1 = zb + 64 * J1;
#pragma unroll
        for (int ks = 0; ks < 4; ++ks) {
          bf16x8 z0 = {0, 0, 0, 0, 0, 0, 0, 0}, z1 = {0, 0, 0, 0, 0, 0, 0, 0};
          if (ok0) z0 = *(const bf16x8*)(zp0 + 16 * ks);
          if (ok1) z1 = *(const bf16x8*)(zp1 + 16 * ks);
          B0[ks] = z0; B1[ks] = z1;
        }
      }
      acc[0][0] = __builtin_amdgcn_mfma_f32_32x32x16_bf16(F3, B0[0], acc[0][0], 0, 0, 0);
      acc[0][1] = __builtin_amdgcn_mfma_f32_32x32x16_bf16(F3, B1[0], acc[0][1], 0, 0, 0);
      acc[1][0] = __builtin_amdgcn_mfma_f32_32x32x16_bf16(F5, B0[0], acc[1][0], 0, 0, 0);
      acc[1][1] = __builtin_amdgcn_mfma_f32_32x32x16_bf16(F5, B1[0], acc[1][1], 0, 0, 0);
      acc[0][0] = __builtin_amdgcn_mfma_f32_32x32x16_bf16(F2, B0[1], acc[0][0], 0, 0, 0);
      acc[0][1] = __builtin_amdgcn_mfma_f32_32x32x16_bf16(F2, B1[1], acc[0][1], 0, 0, 0);
      acc[1][0] = __builtin_amdgcn_mfma_f32_32x32x16_bf16(F4, B0[1], acc[1][0], 0, 0, 0);
      acc[1][1] = __builtin_amdgcn_mfma_f32_32x32x16_bf16(F4, B1[1], acc[1][1], 0, 0, 0);
      acc[0][0] = __builtin_amdgcn_mfma_f32_32x32x16_bf16(F1, B0[2], acc[0][0], 0, 0, 0);
      acc[0][1] = __builtin_amdgcn_mfma_f32_32x32x16_bf16(F1, B1[2], acc[0][1], 0, 0, 0);
      acc[1][0] = __builtin_amdgcn_mfma_f32_32x32x16_bf16(F3, B0[2], acc[1][0], 0, 0, 0);
      acc[1][1] = __builtin_amdgcn_mfma_f32_32x32x16_bf16(F3, B1[2], acc[1][1], 0, 0, 0);
      acc[0][0] = __builtin_amdgcn_mfma_f32_32x32x16_bf16(F0, B0[3], acc[0][0], 0, 0, 0);
      acc[0][1] = __builtin_amdgcn_mfma_f32_32x32x16_bf16(F0, B1[3], acc[0][1], 0, 0, 0);
      acc[1][0] = __builtin_amdgcn_mfma_f32_32x32x16_bf16(F2, B0[3], acc[1][0], 0, 0, 0);
      acc[1][1] = __builtin_amdgcn_mfma_f32_32x32x16_bf16(F2, B1[3], acc[1][1], 0, 0, 0);
      F0 = F4; F1 = F5;
      if (D < I0 + 15) {
        const u16* kp = krr + (ybase - 64 * (D + 1));
        F2 = *(const bf16x8_u*)(kp - 32); F3 = *(const bf16x8_u*)(kp - 48);
        F4 = *(const bf16x8_u*)(kp - 64); F5 = *(const bf16x8_u*)(kp - 80);
      }
    }
    __syncthreads();
#pragma unroll
    for (int ni = 0; ni < 2; ++ni) {
      u16* zc = zs + (r & 3) * 4096 + 64 * (ni ? Il1 : Il0);
#pragma unroll
      for (int mi = 0; mi < 2; ++mi)
#pragma unroll
        for (int q = 0; q < 16; ++q) {
          int i = 32 * mi + (q & 3) + 8 * (q >> 2) + 4 * h;
          float zo = bf2f(zc[i]);
          zc[i] = f2bf(scale * acc[mi][ni][q] + skip * zo);
        }
    }
    __syncthreads();
    {
      const int ch = (o + 1) * 512 + c;
      const float w0 = cwp[ch], w1 = cwp[1536 + ch], w2 = cwp[3072 + ch], bs = cbp[ch];
#pragma unroll 1
      for (int e = tid; e < 2048; e += 256) {
        int b = e >> 9, t8 = (e & 511) * 8;
        float xg[8], y[8];
        hy_conv3x8(UT + (size_t)ch * NTOK + b * 4096, t8, 4096, w0, w1, w2, bs, xg);
        unpack8(*(const uint4*)(zs + b * 4096 + t8), y);
#pragma unroll
        for (int j = 0; j < 8; ++j) y[j] *= xg[j];
        if (o == 0) *(uint4*)(zs + b * 4096 + t8) = pack8(y);
        else {
          float gf[8]; unpack8(*(const uint4*)(UT + (size_t)(1536 + c) * NTOK + b * 4096 + t8), gf);
#pragma unroll
          for (int j = 0; j < 8; ++j) y[j] *= gf[j];
          *(uint4*)(p.U + (size_t)c * NTOK + b * 4096 + t8) = pack8(y);
        }
      }
    }
    __syncthreads();
  }
  if (l == 0) {
    const int t = tid;
    for (int o = 0; o < 2; ++o) {
      const u16* K = p.KFC + (size_t)(o * 512 + c) * 512;
      float asum = 0.f;
      {
        uint32_t w2 = *(const uint32_t*)(K + tid * 2);
        *(uint32_t*)(krr + tid * 2) = w2;
        asum = fabsf(bflo(w2)) + fabsf(bfhi(w2));
      }
      asum = wave_sum(asum);
      if (lane == 0) red[wave] = asum;
      if (o == 0) {
        const float w0 = cwp[c], w1 = cwp[1536 + c], w2 = cwp[3072 + c], bs = cbp[c];
        if (tid < 128) {
          int b = tid >> 5, t8 = (tid & 31) * 8;
          float f[8];
          hy_conv3x8(UT + (size_t)c * NTOK + NLAT + b * 256, t8, 256, w0, w1, w2, bs, f);
          *(uint4*)(zs + b * 4096 + t8) = pack8(f);
        }
      }
      __syncthreads();
      const float scale = 1.f / (red[0] + red[1] + red[2] + red[3] + 1e-6f);
      float a0 = 0, a1 = 0, a2 = 0, a3 = 0;
      for (int s2 = 0; s2 < 256; ++s2) {
        float kv = bf2f(krr[256 - t + s2]);
        a0 += kv * bf2f(zs[s2]); a1 += kv * bf2f(zs[4096 + s2]); a2 += kv * bf2f(zs[8192 + s2]); a3 += kv * bf2f(zs[12288 + s2]);
      }
      const float skip = p.hy_skip[(l * 2 + o) * 512 + c];
      float y[4];
      y[0] = scale * a0 + skip * bf2f(zs[t]); y[1] = scale * a1 + skip * bf2f(zs[4096 + t]);
      y[2] = scale * a2 + skip * bf2f(zs[8192 + t]); y[3] = scale * a3 + skip * bf2f(zs[12288 + t]);
      __syncthreads();
      {
        const int ch = (o + 1) * 512 + c;
        const float w0 = cwp[ch], w1 = cwp[1536 + ch], w2 = cwp[3072 + ch], bs = cbp[ch];
#pragma unroll
        for (int b = 0; b < 4; ++b) {
          const u16* col = UT + (size_t)ch * NTOK + NLAT + b * 256;
          float xg = bs + w1 * bf2f(col[t]);
          if (t > 0) xg += w0 * bf2f(col[t - 1]);
          if (t < 255) xg += w2 * bf2f(col[t + 1]);
          float zn = xg * y[b];
          if (o == 0) zs[b * 4096 + t] = f2bf(zn);
          else {
            size_t R = (size_t)NLAT + b * 256 + t;
            float gate = bf2f(UT[(size_t)(1536 + c) * NTOK + R]);
            p.U[(size_t)c * NTOK + R] = f2bf(zn * gate);
          }
        }
      }
      __syncthreads();
    }
  }
}

__device__ __forceinline__ void fin_rows(const P& p, int l, int chunk) {
  int tid = threadIdx.x; asm volatile("" : "+v"(tid)); const int wave = tid >> 6, lane = tid & 63;
  for (int rr = 0; rr < 16; ++rr) {
    int R = chunk * 64 + wave * 16 + rr;
    {
      uint4* yp = (uint4*)(p.Y2 + (size_t)R * 1024 + lane * 8);
      float o[8]; unpack8(*yp, o);
      float ss = 0;
#pragma unroll
      for (int j = 0; j < 8; ++j) ss += o[j] * o[j];
      ss += __shfl_xor(ss, 1); ss += __shfl_xor(ss, 2); ss += __shfl_xor(ss, 4); ss += __shfl_xor(ss, 8);
      float rinv = rsqrtf(ss * (1.f / 128.f) + EPS);
      float gf[8]; unpack8(*(const uint4*)(p.U + (size_t)NTOK * 2048 + (size_t)R * 2048 + 1024 + lane * 8), gf);
#pragma unroll
      for (int j = 0; j < 8; ++j) o[j] = o[j] * rinv * p.hg_norm_w[l * 512 + lane * 8 + j] * gf[j];
      *yp = pack8(o);
    }
    {
      uint4* yp = (uint4*)(p.Y2 + (size_t)R * 1024 + 512 + lane * 8);
      float o[8]; unpack8(*yp, o);
      float gf[8]; unpack8(*(const uint4*)(p.U + (size_t)NTOK * 2048 + (size_t)R * 2048 + 1536 + lane * 8), gf);
      float ss = 0;
#pragma unroll
      for (int j = 0; j < 8; ++j) { o[j] *= gf[j]; ss += o[j] * o[j]; }
      ss += __shfl_xor(ss, 1); ss += __shfl_xor(ss, 2); ss += __shfl_xor(ss, 4); ss += __shfl_xor(ss, 8); ss += __shfl_xor(ss, 16);
      float rinv = rsqrtf(ss * (1.f / 256.f) + EPS);
#pragma unroll
      for (int j = 0; j < 8; ++j) o[j] = o[j] * rinv * p.m2_norm_w[l * 512 + lane * 8 + j];
      *yp = pack8(o);
    }
  }
}

__device__ __forceinline__ void ph_mixB(const P& p, int l, int bid, int nb, float* sm) {
  for (int t = bid; t < 544 + 512; t += nb) {
    if (t < 544) { if (EN_RG) rg_task<0>(p, l, t, sm); }
    else { if (EN_HY) hy_task(p, l, t - 544, sm); }
    __syncthreads();
  }
}
__device__ __forceinline__ void hy_transpose(const P& p, int tile, u16* sm) {
  int tid = threadIdx.x; asm volatile("" : "+v"(tid));
  const int ct = tile & 7, rt = tile >> 3;
  const int c0 = ct * 64, R0 = rt * 64;
#pragma unroll
  for (int i = 0; i < 2; ++i) {
    int q = tid + 256 * i; int cc = q >> 3, seg = q & 7;
    *(uint4*)(sm + cc * 72 + seg * 8) = *(const uint4*)(p.U + (size_t)(c0 + cc) * NTOK + R0 + seg * 8);
  }
  __syncthreads();
#pragma unroll
  for (int i = 0; i < 2; ++i) {
    int q = tid + 256 * i; int rr = q >> 3, seg = q & 7;
    FragU f;
#pragma unroll
    for (int j = 0; j < 4; ++j)
      f.u[j] = (uint32_t)sm[(seg * 8 + 2 * j) * 72 + rr] | ((uint32_t)sm[(seg * 8 + 2 * j + 1) * 72 + rr] << 16);
    *(uint4*)(p.HL + (size_t)(R0 + rr) * 1024 + c0 + seg * 8) = f.q;
  }
}
__device__ __forceinline__ void ph_mixB2(const P& p, int l, int bid, int nb, float* sm) {
  const int nfin = (l == 0 ? NTOK : NLAT) / 64;
  const int ntr = nfin * 8;
  for (int t = bid; t < 544 + nfin + ntr; t += nb) {
    if (t < 544) { if (EN_RG) rg_task<1>(p, l, t, sm); }
    else if (t < 544 + nfin) fin_rows(p, l, t - 544);
    else hy_transpose(p, t - 544 - nfin, (u16*)sm);
    __syncthreads();
  }
}
__device__ __forceinline__ void ph_final(const P& p, int bid, int nb) {
  int tid = threadIdx.x; asm volatile("" : "+v"(tid)); const int wave = tid >> 6, lane = tid & 63;
  for (int R = bid * 4 + wave; R < NLAT; R += nb * 4) {
    float4* rp = (float4*)(p.out + (size_t)R * 1024);
    float4 v[4]; float ss = 0;
#pragma unroll
    for (int i = 0; i < 4; ++i) {
      v[i] = rp[lane + i * 64];
      ss += v[i].x * v[i].x + v[i].y * v[i].y + v[i].z * v[i].z + v[i].w * v[i].w;
    }
    ss = wave_sum(ss);
    float rinv = rsqrtf(ss * (1.f / 1024.f) + EPS);
#pragma unroll
    for (int i = 0; i < 4; ++i) {
      float4 w = *(const float4*)(p.final_norm_w + (lane + i * 64) * 4);
      float4 o; o.x = v[i].x * rinv * w.x; o.y = v[i].y * rinv * w.y; o.z = v[i].z * rinv * w.z; o.w = v[i].w * rinv * w.w;
      rp[lane + i * 64] = o;
    }
  }
}

#define SMEM_BYTES 56320
__global__ void __launch_bounds__(256) mega(P p) {
  __shared__ __align__(16) unsigned char smem[SMEM_BYTES];
  cg::grid_group grid = cg::this_grid();
  const int bid = blockIdx.x, nb = gridDim.x;
  float* smf = (float*)smem; u16* smh = (u16*)smem;
#ifndef PHM
#define PHM 0xffff
#endif
  if (PHM & 1) ph_mod(p, bid, nb, smf);
  grid.sync();
  for (int l = 0; l < 2; ++l) {
    if (PHM & 2) ph_norm(p, l, bid, nb);
    if (PHM & 4) ph_wconv(p, l, bid, nb, smf);
    grid.sync();
    if (PHM & 16) ph_gemm<0>(p, l, bid, nb, smh);
    grid.sync();
    if (PHM & 32) ph_mixA0(p, l, bid, nb, smem);
    grid.sync();
    if (PHM & 32) ph_mixA1(p, l, bid, nb, smem);
    grid.sync();
#if PROBE_DUP == 8
    ph_mixA0(p, l, bid, nb, smem);
    grid.sync();
    ph_mixA1(p, l, bid, nb, smem);
    grid.sync();
#endif
    if (PHM & 64) ph_gemm<1>(p, l, bid, nb, smh);
    if (PHM & 8) ph_filt(p, l, bid, nb, smf);
    grid.sync();
#if PROBE_DUP == 2
    ph_mixB(p, l, bid, nb, smf);
    grid.sync();
#endif
#if PROBE_DUP == 4
    ph_gemm<1>(p, l, bid, nb, smh);
    grid.sync();
#endif
#if PROBE_DUP == 9
    ph_gemm<1>(p, l, bid, nb, smh, 1);
    grid.sync();
#endif
    if (PHM & 128) ph_mixB(p, l, bid, nb, smf);
    grid.sync();
    if (PHM & 128) ph_mixB2(p, l, bid, nb, smf);
    grid.sync();
#if PROBE_DUP == 7
    for (int t = bid; t < 544; t += nb) { rg_task<1>(p, l, t, smf); __syncthreads(); }
    grid.sync();
#endif
    if (PHM & 256) ph_gemm<2>(p, l, bid, nb, smh);
    grid.sync();
  }
  if (PHM & 512) ph_final(p, bid, nb);
}

extern "C" void kernel_launch(void* const* d_in, const int* in_sizes, int n_in, void* d_out, int out_size,
                              void* d_ws, size_t ws_size, hipStream_t stream) {
  static int grid_blocks = 0;
  if (!grid_blocks) {
    int dev = 0, cus = 0, per_cu = 0;
    hipGetDevice(&dev);
    hipDeviceGetAttribute(&cus, hipDeviceAttributeMultiprocessorCount, dev);
    hipOccupancyMaxActiveBlocksPerMultiprocessor(&per_cu, mega, 256, 0);
    if (per_cu < 1) per_cu = 1;
    if (per_cu > 2) per_cu = 2;
    grid_blocks = cus * per_cu;
  }
  P p{};
  const float** fp = (const float**)&p;
  for (int i = 0; i < 34; ++i) fp[i] = (const float*)d_in[i];
  p.out = (float*)d_out;
  char* w = (char*)d_ws;
  size_t off = 0;
  auto take = [&](size_t bytes) { char* r = w + off; off += (bytes + 255) & ~(size_t)255; return r; };
  p.U = (u16*)take((size_t)NTOK * UW * 2);
  p.HL = (u16*)take((size_t)NTOK * 1024 * 2);
  p.Y2 = (u16*)take((size_t)NTOK * 1024 * 2);
  p.WT = (u16*)take((size_t)7296 * 1024 * 2);
  p.WoT = (u16*)take((size_t)1024 * 2048 * 2);
  p.KF = (u16*)take((size_t)1024 * 8192 * 2);
  p.KFC = (u16*)take((size_t)1024 * 512 * 2);
  p.XC = (float*)take((size_t)1024 * 1024 * 4);
  p.DT = (float*)take((size_t)NTOK * 8 * 4);
  p.MOD = (float*)take((size_t)2 * 5 * 3072 * 4);
  p.SUM = (float*)take((size_t)4 * 2 * 17 * 512 * 2 * 4);
  p.SSH = (float*)take((size_t)16 * 2 * 4 * 65536);
  p.PS = (float*)take((size_t)16 * 2 * 4 * 128 * 4);
  p.PA = (float*)take((size_t)16 * 2 * 8 * 4 * 4);
  if (off > ws_size) { fprintf(stderr, "workspace too small: need %zu have %zu\n", off, ws_size); return; }
  void* args[] = {&p};
  hipError_t e = hipLaunchCooperativeKernel((void*)mega, dim3(grid_blocks), dim3(256), args, 0, stream);
  if (e != hipSuccess) fprintf(stderr, "cooperative launch failed: %s (grid %d)\n", hipGetErrorString(e), grid_blocks);
}
```

```cpp
#include <hip/hip_runtime.h>
#include <hip/hip_bf16.h>
#include <hip/hip_cooperative_groups.h>
#include <cstdio>
#include <cstdint>
namespace cg = cooperative_groups;

typedef unsigned short u16;
using bf16x8 = __attribute__((ext_vector_type(8))) short;
using f32x16 = __attribute__((ext_vector_type(16))) float;

#define NTOK 17408
#define NLAT 16384
#define UW 4096
#define EPS 1e-6f

#ifndef PROBE_DUP
#define PROBE_DUP 0
#endif
#ifndef EN_HY
#define EN_HY 1
#endif
#ifndef EN_RG
#define EN_RG 1
#endif
#ifndef EN_HG
#define EN_HG 1
#endif
#ifndef EN_M2
#define EN_M2 1
#endif

struct P {
  const float *x, *c, *ctx, *c_ctx, *w_mod, *b_mod, *norm_w, *w_in, *w_out;
  const float *hy_conv_w, *hy_conv_b, *hy_w1, *hy_b1, *hy_w2, *hy_b2, *hy_w3, *hy_freq, *hy_skip;
  const float *rg_conv_w, *rg_conv_b, *rg_wa, *rg_ba, *rg_wx, *rg_bx, *rg_lam;
  const float *hg_lb, *hg_norm_w, *m2_conv_w, *m2_conv_b, *m2_dt_bias, *m2_a_log, *m2_d, *m2_norm_w, *final_norm_w;
  float* out;
  u16 *U, *HL, *Y2, *WT, *WoT, *KF, *KFC;
  float *XC, *DT, *MOD, *SUM, *SSH, *PS, *PA;
};

typedef __bf16 bf2_t __attribute__((ext_vector_type(2)));
typedef float f2_t __attribute__((ext_vector_type(2)));
__device__ __forceinline__ uint32_t pack2(float a, float b) {
  f2_t v = {a, b};
  return __builtin_bit_cast(uint32_t, __builtin_convertvector(v, bf2_t));
}
__device__ __forceinline__ u16 f2bf(float f) { return (u16)(pack2(f, f) & 0xffffu); }
__device__ __forceinline__ float bf2f(u16 h) { return __uint_as_float(((uint32_t)h) << 16); }
__device__ __forceinline__ float bflo(uint32_t w) { return __uint_as_float(w << 16); }
__device__ __forceinline__ float bfhi(uint32_t w) { return __uint_as_float(w & 0xffff0000u); }
__device__ __forceinline__ float siluf(float x) { return x * __builtin_amdgcn_rcpf(1.f + __expf(-x)); }
__device__ __forceinline__ float sigmf(float x) { return __builtin_amdgcn_rcpf(1.f + __expf(-x)); }
__device__ __forceinline__ float softplusf(float x) { return x > 20.f ? x : log1pf(__expf(x)); }

__device__ __forceinline__ void unpack8(const uint4& v, float* f) {
  f[0] = bflo(v.x); f[1] = bfhi(v.x); f[2] = bflo(v.y); f[3] = bfhi(v.y);
  f[4] = bflo(v.z); f[5] = bfhi(v.z); f[6] = bflo(v.w); f[7] = bfhi(v.w);
}
__device__ __forceinline__ uint4 pack8(const float* f) {
  uint4 v; v.x = pack2(f[0], f[1]); v.y = pack2(f[2], f[3]); v.z = pack2(f[4], f[5]); v.w = pack2(f[6], f[7]);
  return v;
}
__device__ __forceinline__ float wave_sum(float v) {
#pragma unroll
  for (int o = 32; o >= 1; o >>= 1) v += __shfl_xor(v, o);
  return v;
}

__device__ __forceinline__ int pos2row_seq(int b, int p, int dir) {
  if (p < 256) { int t = dir ? 255 - p : p; return NLAT + b * 256 + t; }
  int j = p - 256; int t = dir ? 4095 - j : j; return b * 4096 + t;
}
__device__ __forceinline__ int pos2row_m2(int b, int p, int dir) {
  if (p < 256) { int t = dir ? 255 - p : p; return NLAT + b * 256 + t; }
  int j = p - 256; int jj = dir ? 4095 - j : j; int c = jj >> 6, r = jj & 63; return b * 4096 + r * 64 + c;
}

__device__ __forceinline__ void ph_mod(const P& p, int bid, int nb, float* sm) {
  int tid = threadIdx.x; asm volatile("" : "+v"(tid));
  for (int task = bid; task < 96; task += nb) {
    int l = task / 48, cgi = task % 48;
    int col = cgi * 64 + (tid & 63);
    int kq = tid >> 6;
    float a0 = 0, a1 = 0, a2 = 0, a3 = 0, a4 = 0;
    for (int k = kq * 256; k < kq * 256 + 256; ++k) {
      float w = p.w_mod[((size_t)l * 1024 + k) * 3072 + col];
      a0 += siluf(p.c[k]) * w; a1 += siluf(p.c[1024 + k]) * w; a2 += siluf(p.c[2048 + k]) * w;
      a3 += siluf(p.c[3072 + k]) * w; a4 += siluf(p.c_ctx[k]) * w;
    }
    sm[(kq * 5 + 0) * 64 + (tid & 63)] = a0; sm[(kq * 5 + 1) * 64 + (tid & 63)] = a1;
    sm[(kq * 5 + 2) * 64 + (tid & 63)] = a2; sm[(kq * 5 + 3) * 64 + (tid & 63)] = a3;
    sm[(kq * 5 + 4) * 64 + (tid & 63)] = a4;
    __syncthreads();
    if (tid < 64) {
      float bm = p.b_mod[l * 3072 + col];
#pragma unroll
      for (int j = 0; j < 5; ++j) {
        float s = sm[(0 * 5 + j) * 64 + tid] + sm[(1 * 5 + j) * 64 + tid] + sm[(2 * 5 + j) * 64 + tid] + sm[(3 * 5 + j) * 64 + tid];
        p.MOD[(size_t)(l * 5 + j) * 3072 + col] = s + bm;
      }
    }
    __syncthreads();
  }
}

__device__ __forceinline__ void ph_norm(const P& p, int l, int bid, int nb) {
  int tid = threadIdx.x; asm volatile("" : "+v"(tid)); const int wave = tid >> 6, lane = tid & 63;
  for (int R = bid * 4 + wave; R < NTOK; R += nb * 4) {
    const float* src; int mj;
    if (R < NLAT) { src = (l == 0 ? p.x : (const float*)p.out) + (size_t)R * 1024; mj = R >> 12; }
    else { int rc = R - NLAT; src = (l == 0 ? p.ctx : (const float*)p.XC) + (size_t)rc * 1024; mj = 4; }
    const float* mod = p.MOD + (size_t)(l * 5 + mj) * 3072;
    float4 v[4]; float ss = 0;
#pragma unroll
    for (int i = 0; i < 4; ++i) {
      v[i] = ((const float4*)src)[lane + i * 64];
      ss += v[i].x * v[i].x + v[i].y * v[i].y + v[i].z * v[i].z + v[i].w * v[i].w;
    }
    ss = wave_sum(ss);
    float rinv = rsqrtf(ss * (1.f / 1024.f) + EPS);
#pragma unroll
    for (int i = 0; i < 4; ++i) {
      int idx = (lane + i * 64) * 4;
      float4 nw = *(const float4*)(p.norm_w + l * 1024 + idx);
      float4 sh = *(const float4*)(mod + idx);
      float4 sc = *(const float4*)(mod + 1024 + idx);
      float h0 = v[i].x * rinv * nw.x * (1.f + sc.x) + sh.x;
      float h1 = v[i].y * rinv * nw.y * (1.f + sc.y) + sh.y;
      float h2 = v[i].z * rinv * nw.z * (1.f + sc.z) + sh.z;
      float h3 = v[i].w * rinv * nw.w * (1.f + sc.w) + sh.w;
      uint2 o; o.x = pack2(h0, h1); o.y = pack2(h2, h3);
      *(uint2*)(p.HL + (size_t)R * 1024 + idx) = o;
    }
  }
}

__device__ __forceinline__ void ph_wconv(const P& p, int l, int bid, int nb, float* sm) {
  int tid = threadIdx.x; asm volatile("" : "+v"(tid));
  const int T1 = 114 * 16, T2 = 16 * 32;
  for (int t = bid; t < T1 + T2; t += nb) {
    const float* src; int ld, K, n0, k0, sc0, nvalid; u16* dst;
    if (t < T1) {
      int nt = t / 16, kt = t % 16; n0 = nt * 64; k0 = kt * 64;
      src = p.w_in + (size_t)l * 1024 * 7176; ld = 7176; K = 1024; dst = p.WT; nvalid = 64;
      if (n0 < 2048) sc0 = 3072 + n0;
      else if (n0 < 3072) sc0 = 5632 + (n0 - 2048);
      else if (n0 < 3200) { sc0 = 6656 + (n0 - 3072); nvalid = (n0 == 3072) ? 8 : 0; }
      else { int m = n0 - 3200; if (m < 3072) sc0 = m; else if (m < 3584) sc0 = 5120 + (m - 3072); else sc0 = 6664 + (m - 3584); }
    } else {
      int tt = t - T1; int nt = tt / 32, kt = tt % 32; n0 = nt * 64; k0 = kt * 64;
      src = p.w_out + (size_t)l * 2048 * 1024; ld = 1024; K = 2048; dst = p.WoT; nvalid = 64; sc0 = n0;
    }
#pragma unroll
    for (int i = 0; i < 4; ++i) {
      int kk = (tid >> 4) + 16 * i, cc = (tid & 15) * 4;
      const float* sp = src + (size_t)(k0 + kk) * ld + sc0 + cc;
      float4 v;
      if (nvalid == 64) v = *(const float4*)sp;
      else { v.x = (cc + 0 < nvalid) ? sp[0] : 0.f; v.y = (cc + 1 < nvalid) ? sp[1] : 0.f; v.z = (cc + 2 < nvalid) ? sp[2] : 0.f; v.w = (cc + 3 < nvalid) ? sp[3] : 0.f; }
      sm[kk * 65 + cc + 0] = v.x; sm[kk * 65 + cc + 1] = v.y; sm[kk * 65 + cc + 2] = v.z; sm[kk * 65 + cc + 3] = v.w;
    }
    __syncthreads();
#pragma unroll
    for (int i = 0; i < 2; ++i) {
      int q = tid + 256 * i; int nn = q >> 3, ks = q & 7;
      float f[8];
#pragma unroll
      for (int j = 0; j < 8; ++j) f[j] = sm[(ks * 8 + j) * 65 + nn];
      *(uint4*)(dst + (size_t)(n0 + nn) * K + k0 + ks * 8) = pack8(f);
    }
    __syncthreads();
  }
}

__device__ __forceinline__ void ph_filt(const P& p, int l, int bid, int nb, float* sm) {
  int tid = threadIdx.x; asm volatile("" : "+v"(tid));
  const float HY_MIN = -3.0701134573253945f, HY_MAX = -15.350567286626972f;
  int ntask = 256 + (l == 0 ? 16 : 0);
  float* zs = sm; float* h1 = sm + 544; float* h2 = sm + 544 + 1024;
  for (int task = bid; task < ntask; task += nb) {
    int n, t0; u16* K;
    if (task < 256) { n = 4096; t0 = task * 16; K = p.KF; } else { n = 256; t0 = (task - 256) * 16; K = p.KFC; }
    float inv_nm1 = 1.f / (float)(n - 1);
    for (int e = tid; e < 16 * 33; e += 256) {
      int tt = e / 33, f = e % 33; int t = t0 + tt; float val;
      if (f == 0) val = (float)t * inv_nm1;
      else {
        int bi = (f - 1) & 15;
        float band = 1e-4f + (float)bi * ((15.f - 1e-4f) / 15.f);
        float ang = (6.283185307179586f / (float)n) * (float)t * band;
        val = (f <= 16) ? cosf(ang) : -sinf(ang);
      }
      zs[e] = val;
    }
    __syncthreads();
    for (int e = tid; e < 1024; e += 256) {
      int tt = e >> 6, j = e & 63; float acc = p.hy_b1[l * 64 + j];
      for (int f = 0; f < 33; ++f) acc += zs[tt * 33 + f] * p.hy_w1[(l * 33 + f) * 64 + j];
      h1[e] = sinf(p.hy_freq[l * 64 + j] * acc);
    }
    __syncthreads();
    for (int e = tid; e < 1024; e += 256) {
      int tt = e >> 6, j = e & 63; float acc = p.hy_b2[l * 64 + j];
      for (int i = 0; i < 64; ++i) acc += h1[tt * 64 + i] * p.hy_w2[(l * 64 + i) * 64 + j];
      h2[e] = sinf(p.hy_freq[l * 64 + j] * acc);
    }
    __syncthreads();
    for (int r = 0; r < 8; ++r) {
      int col = tid + 256 * r; int o = col >> 10, side = (col >> 9) & 1, c = col & 511;
      float w[64];
#pragma unroll
      for (int i = 0; i < 64; ++i) w[i] = p.hy_w3[(size_t)(l * 64 + i) * 2048 + col];
      float delta = fabsf(HY_MIN + (HY_MAX - HY_MIN) * (float)c / 511.f);
      u16* Kc = K + (size_t)(o * 512 + c) * (2 * n);
      for (int tt = 0; tt < 16; ++tt) {
        float acc = 0;
#pragma unroll
        for (int i = 0; i < 64; ++i) acc += h2[tt * 64 + i] * w[i];
        int t = t0 + tt;
        float val = acc * __expf(-(float)t * inv_nm1 * delta);
        int idx;
        if (side == 0) idx = n - t; else { if (t == 0) { idx = 0; val = 0.f; } else idx = n + t; }
        Kc[idx] = f2bf(val);
      }
    }
    __syncthreads();
  }
}

#define LDSTR 72
template <int MODE>
__device__ __forceinline__ void gemm_tile(const P& p, int l, int mt, int nt, u16* sA, u16* sB, int noepi) {
  int tid = threadIdx.x; asm volatile("" : "+v"(tid)); const int wave = tid >> 6, lane = tid & 63;
  const int wm = wave >> 1, wn = wave & 1;
  const int KT = (MODE == 2) ? 2048 : 1024;
  const u16* Bsrc = (MODE == 0) ? p.WT + (size_t)(nt * 128) * 1024
                  : (MODE == 1) ? p.WT + (size_t)(3200 + nt * 128) * 1024
                                : p.WoT + (size_t)(nt * 128) * 2048;
  f32x16 acc[4][2];
#pragma unroll
  for (int a = 0; a < 4; ++a)
#pragma unroll
    for (int b = 0; b < 2; ++b)
#pragma unroll
      for (int r = 0; r < 16; ++r) acc[a][b][r] = 0.f;
  uint4 ra0, ra1, ra2, ra3, ra4, ra5, ra6, ra7, rb0, rb1, rb2, rb3;
  const int lrow = tid >> 3, lseg = tid & 7;
  const u16* Ab0 = p.HL + (size_t)(mt * 256 + lrow) * 1024 + lseg * 8;
  const u16* Ab1 = p.Y2 + (size_t)(mt * 256 + lrow) * 1024 + lseg * 8;
  const u16* Bb = Bsrc + (size_t)lrow * KT + lseg * 8;
#define GLOADS(K0)                                                                                  \
  {                                                                                                 \
    const u16* ap = (MODE == 2 && (K0) >= 1024) ? Ab1 + ((K0) - 1024) : Ab0 + (K0);                 \
    ra0 = *(const uint4*)(ap); ra1 = *(const uint4*)(ap + 32 * 1024);                               \
    ra2 = *(const uint4*)(ap + 64 * 1024); ra3 = *(const uint4*)(ap + 96 * 1024);                   \
    ra4 = *(const uint4*)(ap + 128 * 1024); ra5 = *(const uint4*)(ap + 160 * 1024);                 \
    ra6 = *(const uint4*)(ap + 192 * 1024); ra7 = *(const uint4*)(ap + 224 * 1024);                 \
    const u16* bp = Bb + (K0);                                                                      \
    rb0 = *(const uint4*)(bp); rb1 = *(const uint4*)(bp + (size_t)32 * KT);                         \
    rb2 = *(const uint4*)(bp + (size_t)64 * KT); rb3 = *(const uint4*)(bp + (size_t)96 * KT);       \
  }
  GLOADS(0)
#pragma unroll 1
  for (int k0 = 0; k0 < KT; k0 += 64) {
    *(uint4*)(sA + (lrow + 0) * LDSTR + lseg * 8) = ra0;   *(uint4*)(sA + (lrow + 32) * LDSTR + lseg * 8) = ra1;
    *(uint4*)(sA + (lrow + 64) * LDSTR + lseg * 8) = ra2;  *(uint4*)(sA + (lrow + 96) * LDSTR + lseg * 8) = ra3;
    *(uint4*)(sA + (lrow + 128) * LDSTR + lseg * 8) = ra4; *(uint4*)(sA + (lrow + 160) * LDSTR + lseg * 8) = ra5;
    *(uint4*)(sA + (lrow + 192) * LDSTR + lseg * 8) = ra6; *(uint4*)(sA + (lrow + 224) * LDSTR + lseg * 8) = ra7;
    *(uint4*)(sB + (lrow + 0) * LDSTR + lseg * 8) = rb0;   *(uint4*)(sB + (lrow + 32) * LDSTR + lseg * 8) = rb1;
    *(uint4*)(sB + (lrow + 64) * LDSTR + lseg * 8) = rb2;  *(uint4*)(sB + (lrow + 96) * LDSTR + lseg * 8) = rb3;
    __syncthreads();
    if (k0 + 64 < KT) GLOADS(k0 + 64)
#pragma unroll
    for (int ks = 0; ks < 4; ++ks) {
      bf16x8 fa[4], fb[2];
#pragma unroll
      for (int mi = 0; mi < 4; ++mi)
        fa[mi] = *(const bf16x8*)(sA + (wm * 128 + mi * 32 + (lane & 31)) * LDSTR + ks * 16 + (lane >> 5) * 8);
#pragma unroll
      for (int ni = 0; ni < 2; ++ni)
        fb[ni] = *(const bf16x8*)(sB + (wn * 64 + ni * 32 + (lane & 31)) * LDSTR + ks * 16 + (lane >> 5) * 8);
#pragma unroll
      for (int mi = 0; mi < 4; ++mi)
#pragma unroll
        for (int ni = 0; ni < 2; ++ni)
          acc[mi][ni] = __builtin_amdgcn_mfma_f32_32x32x16_bf16(fa[mi], fb[ni], acc[mi][ni], 0, 0, 0);
    }
    __syncthreads();
  }
  if (noepi) {
    float sacc = 0.f;
#pragma unroll
    for (int a = 0; a < 4; ++a)
#pragma unroll
      for (int b = 0; b < 2; ++b) sacc += acc[a][b][3];
    if (sacc == 1.2345e30f) p.DT[0] = sacc;
    return;
  }
  const int mj = (mt < 64) ? (mt >> 4) : 4;
#pragma unroll
  for (int ni = 0; ni < 2; ++ni) {
    const int col = wn * 64 + ni * 32 + (lane & 31);
    const int gcol = nt * 128 + col;
    float lb = 0.f; float gmod = 0.f;
    if (MODE == 0) {
      int piece = gcol >> 9;
      if (l == 1 && (piece == 1 || piece == 2)) {
        int dir = piece - 1, ch = gcol & 511;
        float l0 = p.hg_lb[(0 * 2 + dir) * 512 + ch], l1 = p.hg_lb[(1 * 2 + dir) * 512 + ch];
        lb = 1.f / (1.f + __expf(l0 - l1));
      }
    }
    if (MODE == 2) gmod = p.MOD[(size_t)(l * 5 + mj) * 3072 + 2048 + gcol];
#pragma unroll
    for (int mi = 0; mi < 4; ++mi) {
#pragma unroll
      for (int r = 0; r < 16; ++r) {
        const int row = wm * 128 + mi * 32 + (r & 3) + 8 * (r >> 2) + 4 * (lane >> 5);
        const int R = mt * 256 + row;
        float v = acc[mi][ni][r];
        if (MODE == 0) {
          if (nt < 24) {
            int piece = gcol >> 9;
            if (piece == 0) v *= 0.08838834764831845f;
            else if (piece == 1 || piece == 2) v = (1.f - lb) * __builtin_amdgcn_rcpf(1.f + __expf(v));
            p.U[(size_t)R * UW + gcol] = f2bf(v);
          } else {
            if (col < 8) p.DT[(size_t)R * 8 + col] = v;
          }
        } else if (MODE == 1) {
          int piece = gcol >> 9;
          if (piece == 3 || piece >= 5) v = siluf(v);
          if (nt >= 16) p.U[(size_t)NTOK * 2048 + (size_t)R * 2048 + (gcol - 2048)] = f2bf(v);
          else acc[mi][ni][r] = v;
        } else {
          if (R < NLAT) {
            const float* base = (l == 0) ? p.x : (const float*)p.out;
            float xv = base[(size_t)R * 1024 + gcol];
            p.out[(size_t)R * 1024 + gcol] = xv + gmod * v;
          } else {
            int rc = R - NLAT;
            p.XC[(size_t)rc * 1024 + gcol] = p.ctx[(size_t)rc * 1024 + gcol] + gmod * v;
          }
        }
      }
      if (MODE == 1 && nt < 16) {
#pragma unroll
        for (int g4 = 0; g4 < 4; ++g4) {
          int R0 = mt * 256 + wm * 128 + mi * 32 + 8 * g4 + 4 * (lane >> 5);
          uint2 o; o.x = pack2(acc[mi][ni][4 * g4], acc[mi][ni][4 * g4 + 1]); o.y = pack2(acc[mi][ni][4 * g4 + 2], acc[mi][ni][4 * g4 + 3]);
          *(uint2*)(p.U + (size_t)gcol * NTOK + R0) = o;
        }
      }
    }
  }
}

template <int MODE>
__device__ __forceinline__ void ph_gemm(const P& p, int l, int bid, int nb, u16* sm, int noepi = 0) {
  const int NT = (MODE == 0) ? 25 : (MODE == 1) ? 32 : 8;
  const int MT = (MODE == 2 && l == 1) ? 64 : 68;
  u16* sA = sm; u16* sB = sm + 256 * LDSTR;
  const int xcd = bid & 7, local = bid >> 3;
  const int mbase = MT >> 3, mextra = MT & 7;
  const int mper = mbase + (xcd < mextra ? 1 : 0);
  const int mstart = (xcd < mextra) ? xcd * (mbase + 1) : mextra * (mbase + 1) + (xcd - mextra) * mbase;
  const int total = mper * NT;
  const int fullb = NT >> 3, rem = NT & 7;
  for (int it = 0;; ++it) {
    int mt, nt;
    if (nb == 256) {
      int q = local + 32 * it;
      if (q >= total) break;
      int b, i, bw;
      if (q < fullb * mper * 8) { b = q / (mper * 8); i = q - b * mper * 8; bw = 8; }
      else { b = fullb; i = q - fullb * mper * 8; bw = rem; }
      int sub = i / (4 * bw);
      const int nsub = mper >> 2;
      int mt_off, nt_off;
      if (sub < nsub) { int j = i - sub * 4 * bw; mt_off = j & 3; nt_off = j >> 2; }
      else { int j = i - nsub * 4 * bw; sub = nsub; mt_off = 0; nt_off = j; }
      mt = mstart + sub * 4 + mt_off; nt = b * 8 + nt_off;
    } else {
      int t = bid + it * nb;
      if (t >= MT * NT) break;
      nt = t / MT; mt = t % MT;
    }
    gemm_tile<MODE>(p, l, mt, nt, sA, sB, noepi);
  }
}

__device__ __forceinline__ void hg_task(const P& p, int l, int task, float* sm) {
  int tid = threadIdx.x; asm volatile("" : "+v"(tid)); const int wave = tid >> 6, lane = tid & 63;
  const int b = task >> 5, h = (task >> 3) & 3, es = task & 7;
  const int dg = lane & 15, el = lane >> 4;
  float* qs = sm; float* ks = sm + 4096; float* vs = sm + 8192; float* os = sm + 8192 + 512;
  for (int dir = 0; dir < 2; ++dir) {
    float S[8];
#pragma unroll
    for (int r = 0; r < 8; ++r) S[r] = 0.f;
    for (int chunk = 0; chunk < 136; ++chunk) {
#pragma unroll
      for (int i = 0; i < 2; ++i) {
        int q = tid + 256 * i; int pos = q >> 4, seg = q & 15;
        int R = pos2row_seq(b, chunk * 32 + pos, dir);
        const u16* up = p.U + (size_t)R * UW + h * 128 + seg * 8;
        uint4 qv = *(const uint4*)up;
        uint4 kv = *(const uint4*)(up + 512 + dir * 512);
        float f[8];
        unpack8(qv, f);
        *(float4*)(qs + pos * 128 + seg * 8) = make_float4(f[0], f[1], f[2], f[3]);
        *(float4*)(qs + pos * 128 + seg * 8 + 4) = make_float4(f[4], f[5], f[6], f[7]);
        unpack8(kv, f);
        *(float4*)(ks + pos * 128 + seg * 8) = make_float4(f[0], f[1], f[2], f[3]);
        *(float4*)(ks + pos * 128 + seg * 8 + 4) = make_float4(f[4], f[5], f[6], f[7]);
      }
      {
        int pos = tid >> 3, e2 = (tid & 7) * 2;
        int R = pos2row_seq(b, chunk * 32 + pos, dir);
        uint32_t w = *(const uint32_t*)(p.U + (size_t)R * UW + 1536 + h * 128 + es * 16 + e2);
        vs[pos * 16 + e2] = bflo(w); vs[pos * 16 + e2 + 1] = bfhi(w);
      }
      __syncthreads();
#pragma unroll 4
      for (int i = 0; i < 32; ++i) {
        float4 q0 = *(const float4*)(qs + i * 128 + dg * 8), q1 = *(const float4*)(qs + i * 128 + dg * 8 + 4);
        float4 k0 = *(const float4*)(ks + i * 128 + dg * 8), k1 = *(const float4*)(ks + i * 128 + dg * 8 + 4);
        float v = vs[i * 16 + wave * 4 + el];
        S[0] += k0.x * (v - S[0]); S[1] += k0.y * (v - S[1]); S[2] += k0.z * (v - S[2]); S[3] += k0.w * (v - S[3]);
        S[4] += k1.x * (v - S[4]); S[5] += k1.y * (v - S[5]); S[6] += k1.z * (v - S[6]); S[7] += k1.w * (v - S[7]);
        float o = q0.x * S[0] + q0.y * S[1] + q0.z * S[2] + q0.w * S[3] + q1.x * S[4] + q1.y * S[5] + q1.z * S[6] + q1.w * S[7];
        o += __shfl_xor(o, 1); o += __shfl_xor(o, 2); o += __shfl_xor(o, 4); o += __shfl_xor(o, 8);
        if (dg == 0) os[i * 16 + wave * 4 + el] = o;
      }
      __syncthreads();
      {
        int pos = tid >> 3, e2 = (tid & 7) * 2;
        int R = pos2row_seq(b, chunk * 32 + pos, dir);
        uint32_t* yp = (uint32_t*)(p.Y2 + (size_t)R * 1024 + h * 128 + es * 16 + e2);
        float o0 = os[pos * 16 + e2], o1 = os[pos * 16 + e2 + 1];
        if (dir == 1) { uint32_t w = *yp; o0 += bflo(w); o1 += bfhi(w); }
        *yp = pack2(o0, o1);
      }
    }
    __syncthreads();
  }
}

__device__ __forceinline__ void m2_task(const P& p, int l, int task, float* sm) {
  int tid = threadIdx.x; asm volatile("" : "+v"(tid)); const int wave = tid >> 6, lane = tid & 63;
  const int b = task >> 5, head = (task >> 2) & 7, ps = task & 3;
  const int g = head >> 2;
  const int dg = lane & 15, el = lane >> 4;
  float* Cs = sm; float* Bs = sm + 4096; float* xs = sm + 8192; float* os = sm + 8192 + 512;
  float* dts = sm + 8192 + 1024; float* decs = dts + 32;
  for (int dir = 0; dir < 2; ++dir) {
    const float* cw = p.m2_conv_w + (size_t)(l * 2 + dir) * 4 * 1024;
    const float* cb = p.m2_conv_b + (size_t)(l * 2 + dir) * 1024;
    const float dtb = p.m2_dt_bias[(l * 2 + dir) * 8 + head];
    const float Aneg = -__expf(p.m2_a_log[(l * 2 + dir) * 8 + head]);
    const float Dsk = p.m2_d[(l * 2 + dir) * 8 + head];
    float S[8];
#pragma unroll
    for (int r = 0; r < 8; ++r) S[r] = 0.f;
    for (int chunk = 0; chunk < 136; ++chunk) {
      const int pbase = chunk * 32;
      const int seg0 = (pbase < 256) ? 0 : 256;
#pragma unroll
      for (int i = 0; i < 2; ++i) {
        int q = tid + 256 * i; int pos = q >> 4, seg = q & 15;
        int pp = pbase + pos;
        int chB = 512 + g * 128 + seg * 8, chC = 768 + g * 128 + seg * 8;
        float aB[8], aC[8];
#pragma unroll
        for (int j = 0; j < 8; ++j) { aB[j] = cb[chB + j]; aC[j] = cb[chC + j]; }
#pragma unroll
        for (int tap = 0; tap < 4; ++tap) {
          int pt = pp - 3 + tap;
          if (pt >= seg0) {
            int R = pos2row_m2(b, pt, dir);
            const u16* up = p.U + (size_t)R * UW + 2048;
            uint4 bv = *(const uint4*)(up + chB);
            uint4 cv = *(const uint4*)(up + chC);
            float f[8];
            unpack8(bv, f);
#pragma unroll
            for (int j = 0; j < 8; ++j) aB[j] += cw[tap * 1024 + chB + j] * f[j];
            unpack8(cv, f);
#pragma unroll
            for (int j = 0; j < 8; ++j) aC[j] += cw[tap * 1024 + chC + j] * f[j];
          }
        }
#pragma unroll
        for (int j = 0; j < 8; ++j) { aB[j] = siluf(aB[j]); aC[j] = siluf(aC[j]); }
        *(float4*)(Bs + pos * 128 + seg * 8) = make_float4(aB[0], aB[1], aB[2], aB[3]);
        *(float4*)(Bs + pos * 128 + seg * 8 + 4) = make_float4(aB[4], aB[5], aB[6], aB[7]);
        *(float4*)(Cs + pos * 128 + seg * 8) = make_float4(aC[0], aC[1], aC[2], aC[3]);
        *(float4*)(Cs + pos * 128 + seg * 8 + 4) = make_float4(aC[4], aC[5], aC[6], aC[7]);
      }
      {
        int pos = tid >> 3, e2 = (tid & 7) * 2;
        int pp = pbase + pos;
        int ch = head * 64 + ps * 16 + e2;
        float a0 = cb[ch], a1 = cb[ch + 1];
#pragma unroll
        for (int tap = 0; tap < 4; ++tap) {
          int pt = pp - 3 + tap;
          if (pt >= seg0) {
            int R = pos2row_m2(b, pt, dir);
            uint32_t w = *(const uint32_t*)(p.U + (size_t)R * UW + 2048 + ch);
            a0 += cw[tap * 1024 + ch] * bflo(w); a1 += cw[tap * 1024 + ch + 1] * bfhi(w);
          }
        }
        xs[pos * 16 + e2] = siluf(a0); xs[pos * 16 + e2 + 1] = siluf(a1);
      }
      if (tid < 32) {
        int R = pos2row_m2(b, pbase + tid, dir);
        float dtv = softplusf(p.DT[(size_t)R * 8 + head] + dtb);
        dts[tid] = dtv; decs[tid] = __expf(dtv * Aneg);
      }
      __syncthreads();
#pragma unroll 4
      for (int i = 0; i < 32; ++i) {
        float4 q0 = *(const float4*)(Cs + i * 128 + dg * 8), q1 = *(const float4*)(Cs + i * 128 + dg * 8 + 4);
        float4 k0 = *(const float4*)(Bs + i * 128 + dg * 8), k1 = *(const float4*)(Bs + i * 128 + dg * 8 + 4);
        float xv = xs[i * 16 + wave * 4 + el];
        float a = decs[i]; float v = xv * dts[i];
        S[0] = a * S[0] + k0.x * v; S[1] = a * S[1] + k0.y * v; S[2] = a * S[2] + k0.z * v; S[3] = a * S[3] + k0.w * v;
        S[4] = a * S[4] + k1.x * v; S[5] = a * S[5] + k1.y * v; S[6] = a * S[6] + k1.z * v; S[7] = a * S[7] + k1.w * v;
        float o = q0.x * S[0] + q0.y * S[1] + q0.z * S[2] + q0.w * S[3] + q1.x * S[4] + q1.y * S[5] + q1.z * S[6] + q1.w * S[7];
        o += __shfl_xor(o, 1); o += __shfl_xor(o, 2); o += __shfl_xor(o, 4); o += __shfl_xor(o, 8);
        if (dg == 0) os[i * 16 + wave * 4 + el] = o + Dsk * xv;
      }
      __syncthreads();
      {
        int pos = tid >> 3, e2 = (tid & 7) * 2;
        int R = pos2row_m2(b, pbase + pos, dir);
        uint32_t* yp = (uint32_t*)(p.Y2 + (size_t)R * 1024 + 512 + head * 64 + ps * 16 + e2);
        float o0 = os[pos * 16 + e2], o1 = os[pos * 16 + e2 + 1];
        if (dir == 1) { uint32_t w = *yp; o0 += bflo(w); o1 += bfhi(w); }
        *yp = pack2(o0, o1);
      }
    }
    __syncthreads();
  }
}

#ifndef M2_MFMA
#define M2_MFMA 1
#endif
#define QS 136
#define TS 40
union FragU { bf16x8 v; uint32_t u[4]; uint2 d[2]; uint4 q; };
__device__ __forceinline__ bf16x8 cvt_frag(const f32x16& x, int s2) {
  FragU f;
  f.u[0] = pack2(x[8 * s2 + 0], x[8 * s2 + 1]); f.u[1] = pack2(x[8 * s2 + 2], x[8 * s2 + 3]);
  f.u[2] = pack2(x[8 * s2 + 4], x[8 * s2 + 5]); f.u[3] = pack2(x[8 * s2 + 6], x[8 * s2 + 7]);
  return f.v;
}
__device__ __forceinline__ bf16x8 ld_frag_perm(const u16* base) {
  FragU f; f.d[0] = *(const uint2*)base; f.d[1] = *(const uint2*)(base + 8); return f.v;
}

template <int PASS>
__device__ __forceinline__ void hg_mfma(const P& p, int l, int task, int blk, int dir0, unsigned char* smem) {
  int tid = threadIdx.x; asm volatile("" : "+v"(tid)); const int wave = tid >> 6, lane = tid & 63;
  const int r = lane & 31, hh = lane >> 5;
  const int b = task >> 2, h = task & 3;
  u16* ks = (u16*)smem;
  u16* qs = ks + 32 * QS;
  u16* kT = qs + 32 * QS;
  u16* vT = kT + 128 * TS;
  float* tot = (float*)(vT + 128 * TS);
  float* eg = tot + 256;
  const int dd = tid & 127, half = tid >> 7;
  for (int dir = (PASS == 0 ? dir0 : 0); dir < (PASS == 0 ? dir0 + 1 : 2); ++dir) {
    const int sbd = (PASS == 0) ? blk : ((blk == 0) ? 0 : (dir ? 5 - blk : blk));
    const int c0 = (sbd == 0) ? 0 : 8 + 32 * (sbd - 1);
    const int c1 = (sbd == 0) ? 8 : 8 + 32 * sbd;
    float gsum = 0.f;
    f32x16 S[4];
#pragma unroll
    for (int i = 0; i < 4; ++i)
#pragma unroll
      for (int q = 0; q < 16; ++q) S[i][q] = 0.f;
    if (PASS == 1) {
      for (int qb = 0; qb < sbd; ++qb) {
        const size_t sidx = (size_t)((task * 2 + dir) * 4 + qb);
        if (half == 0) eg[dd] = __expf(p.PS[sidx * 128 + dd]);
        __syncthreads();
        const float* sp = p.SSH + sidx * 16384 + (size_t)wave * 4096 + lane;
#pragma unroll
        for (int dt = 0; dt < 4; ++dt)
#pragma unroll
          for (int q4 = 0; q4 < 4; ++q4) {
            float4 e4 = *(const float4*)(eg + 32 * dt + 8 * q4 + 4 * hh);
            S[dt][4 * q4 + 0] = S[dt][4 * q4 + 0] * e4.x + sp[(dt * 16 + 4 * q4 + 0) * 64];
            S[dt][4 * q4 + 1] = S[dt][4 * q4 + 1] * e4.y + sp[(dt * 16 + 4 * q4 + 1) * 64];
            S[dt][4 * q4 + 2] = S[dt][4 * q4 + 2] * e4.z + sp[(dt * 16 + 4 * q4 + 2) * 64];
            S[dt][4 * q4 + 3] = S[dt][4 * q4 + 3] * e4.w + sp[(dt * 16 + 4 * q4 + 3) * 64];
          }
        __syncthreads();
      }
    }
    uint4 pq0, pq1, pk0, pk1, pv0, pv1;
#define HG_PREFETCH(CH)                                                                     \
    {                                                                                       \
      int pos0 = tid >> 4, seg = tid & 15;                                                  \
      int R0 = pos2row_seq(b, (CH) * 32 + pos0, dir), R1 = pos2row_seq(b, (CH) * 32 + pos0 + 16, dir); \
      const u16* u0 = p.U + (size_t)R0 * UW + h * 128 + seg * 8;                            \
      const u16* u1 = p.U + (size_t)R1 * UW + h * 128 + seg * 8;                            \
      pq0 = *(const uint4*)u0; pq1 = *(const uint4*)u1;                                     \
      pk0 = *(const uint4*)(u0 + 512 + dir * 512); pk1 = *(const uint4*)(u1 + 512 + dir * 512); \
      pv0 = *(const uint4*)(u0 + 1536); pv1 = *(const uint4*)(u1 + 1536);                   \
    }
    HG_PREFETCH(c0)
#pragma unroll 1
    for (int chunk = c0; chunk < c1; ++chunk) {
      {
        int pos0 = tid >> 4, seg = tid & 15;
        *(uint4*)(qs + pos0 * QS + seg * 8) = pq0; *(uint4*)(qs + (pos0 + 16) * QS + seg * 8) = pq1;
        *(uint4*)(ks + pos0 * QS + seg * 8) = pk0; *(uint4*)(ks + (pos0 + 16) * QS + seg * 8) = pk1;
        FragU f0, f1; f0.q = pv0; f1.q = pv1;
#pragma unroll
        for (int j = 0; j < 4; ++j) {
          vT[(seg * 8 + 2 * j) * TS + pos0] = (u16)(f0.u[j] & 0xffffu); vT[(seg * 8 + 2 * j + 1) * TS + pos0] = (u16)(f0.u[j] >> 16);
          vT[(seg * 8 + 2 * j) * TS + pos0 + 16] = (u16)(f1.u[j] & 0xffffu); vT[(seg * 8 + 2 * j + 1) * TS + pos0 + 16] = (u16)(f1.u[j] >> 16);
        }
      }
      __syncthreads();
      if (chunk + 1 < c1) HG_PREFETCH(chunk + 1)
      const int Rout = pos2row_seq(b, chunk * 32 + r, dir);
      u16* yrow = p.Y2 + (size_t)Rout * 1024 + h * 128 + wave * 32 + 4 * hh;
      uint2 yold[4];
      if (PASS == 1 && dir == 1) {
#pragma unroll
        for (int q4 = 0; q4 < 4; ++q4) yold[q4] = *(const uint2*)(yrow + 8 * q4);
      }
      float gl[16];
      {
        float run = 0.f;
#pragma unroll
        for (int i = 0; i < 16; ++i) {
          float kkv = bf2f(ks[(half * 16 + i) * QS + dd]);
          run += __logf(fmaxf(1.f - kkv, 1e-6f));
          gl[i] = run;
        }
        tot[half * 128 + dd] = run;
      }
      __syncthreads();
      {
        const float t0 = tot[dd], t1 = tot[128 + dd];
        const float off = half ? t0 : 0.f;
        const float g31 = t0 + t1;
        float k2[16];
#pragma unroll
        for (int i = 0; i < 16; ++i) {
          const int pos = half * 16 + i;
          const float g = gl[i] + off;
          const float kkv = bf2f(ks[pos * QS + dd]);
          const float qv = bf2f(qs[pos * QS + dd]);
          qs[pos * QS + dd] = f2bf(qv * __expf(g));
          ks[pos * QS + dd] = f2bf(kkv * __expf(fminf(-g, 60.f)));
          k2[i] = kkv * __expf(g31 - g);
        }
        *(uint4*)(kT + dd * TS + half * 16) = pack8(k2);
        *(uint4*)(kT + dd * TS + half * 16 + 8) = pack8(k2 + 8);
        if (half == 0) eg[dd] = __expf(g31);
        gsum += g31;
      }
      __syncthreads();
      f32x16 O;
      if (PASS == 1) {
      f32x16 att;
#pragma unroll
      for (int q = 0; q < 16; ++q) att[q] = 0.f;
#pragma unroll
      for (int k8 = 0; k8 < 8; ++k8) {
        bf16x8 A = *(const bf16x8*)(ks + r * QS + 16 * k8 + 8 * hh);
        bf16x8 B = *(const bf16x8*)(qs + r * QS + 16 * k8 + 8 * hh);
        att = __builtin_amdgcn_mfma_f32_32x32x16_bf16(A, B, att, 0, 0, 0);
      }
#pragma unroll
      for (int q = 0; q < 16; ++q) {
        int sidx = (q & 3) + 8 * (q >> 2) + 4 * hh;
        if (sidx > r) att[q] = 0.f;
      }
#pragma unroll
      for (int q = 0; q < 16; ++q) O[q] = 0.f;
#pragma unroll
      for (int dt = 0; dt < 4; ++dt)
#pragma unroll
        for (int s2 = 0; s2 < 2; ++s2) {
          bf16x8 A = cvt_frag(S[dt], s2);
          bf16x8 B = ld_frag_perm(qs + r * QS + 32 * dt + 16 * s2 + 4 * hh);
          O = __builtin_amdgcn_mfma_f32_32x32x16_bf16(A, B, O, 0, 0, 0);
        }
#pragma unroll
      for (int s2 = 0; s2 < 2; ++s2) {
        bf16x8 A = ld_frag_perm(vT + (32 * wave + r) * TS + 16 * s2 + 4 * hh);
        bf16x8 B = cvt_frag(att, s2);
        O = __builtin_amdgcn_mfma_f32_32x32x16_bf16(A, B, O, 0, 0, 0);
      }
      }
#pragma unroll
      for (int dt = 0; dt < 4; ++dt) {
#pragma unroll
        for (int q4 = 0; q4 < 4; ++q4) {
          float4 e4 = *(const float4*)(eg + 32 * dt + 8 * q4 + 4 * hh);
          S[dt][4 * q4 + 0] *= e4.x; S[dt][4 * q4 + 1] *= e4.y; S[dt][4 * q4 + 2] *= e4.z; S[dt][4 * q4 + 3] *= e4.w;
        }
#pragma unroll
        for (int s2 = 0; s2 < 2; ++s2) {
          bf16x8 A = *(const bf16x8*)(kT + (32 * dt + r) * TS + 16 * s2 + 8 * hh);
          bf16x8 B = *(const bf16x8*)(vT + (32 * wave + r) * TS + 16 * s2 + 8 * hh);
          S[dt] = __builtin_amdgcn_mfma_f32_32x32x16_bf16(A, B, S[dt], 0, 0, 0);
        }
      }
      if (PASS == 1) {
#pragma unroll
      for (int q4 = 0; q4 < 4; ++q4) {
        float o0 = O[4 * q4], o1 = O[4 * q4 + 1], o2 = O[4 * q4 + 2], o3 = O[4 * q4 + 3];
        if (dir == 1) { o0 += bflo(yold[q4].x); o1 += bfhi(yold[q4].x); o2 += bflo(yold[q4].y); o3 += bfhi(yold[q4].y); }
        uint2 ov; ov.x = pack2(o0, o1); ov.y = pack2(o2, o3);
        *(uint2*)(yrow + 8 * q4) = ov;
      }
      }
      __syncthreads();
    }
    if (PASS == 0) {
      const size_t sidx = (size_t)((task * 2 + dir) * 4 + sbd);
      if (half == 0) p.PS[sidx * 128 + dd] = gsum;
      float* sp = p.SSH + sidx * 16384 + (size_t)wave * 4096 + lane;
#pragma unroll
      for (int dt = 0; dt < 4; ++dt)
#pragma unroll
        for (int q = 0; q < 16; ++q) sp[(dt * 16 + q) * 64] = S[dt][q];
    }
    __syncthreads();
  }
}

#if M2_MFMA
#define M2_NTASK 16
template <int PASS>
__device__ __forceinline__ void m2_mfma(const P& p, int l, int task, int blk, int dir0, unsigned char* smem) {
  int tid = threadIdx.x; asm volatile("" : "+v"(tid)); const int wave = tid >> 6, lane = tid & 63;
  const int r = lane & 31, hh = lane >> 5;
  const int b = task >> 2, g = (task >> 1) & 1, hp = task & 1;
  const int hq = wave >> 1, ph = wave & 1;
  const int head = 4 * g + 2 * hp + hq;
  u16* Bm = (u16*)smem;
  u16* Cm = Bm + 32 * QS;
  u16* BmT = Cm + 32 * QS;
  u16* xsT = BmT + 128 * TS;
  float* Gs = (float*)(xsT + 128 * TS);
  float* dts = Gs + 64;
  float* wl = dts + 64;
  const int cp = (lane < 48) ? lane : 47;
  const bool act = lane < 48;
  const int chW = (cp < 16) ? ((4 * g + 2 * hp) * 64 + cp * 8) : (cp < 32) ? (512 + g * 128 + (cp - 16) * 8) : (768 + g * 128 + (cp - 32) * 8);
  const int chU = 2048 + chW;
  float* SSM = (float*)p.KF;
  for (int dir = (PASS == 0 ? dir0 : 0); dir < (PASS == 0 ? dir0 + 1 : 2); ++dir) {
    const int sbd = (PASS == 0) ? blk : ((blk == 0) ? 0 : (dir ? 9 - blk : blk));
    const int c0 = (sbd == 0) ? 0 : 8 + 16 * (sbd - 1);
    const int c1 = (sbd == 0) ? 8 : 8 + 16 * sbd;
    float lsum = 0.f;
    const float* cw = p.m2_conv_w + (size_t)(l * 2 + dir) * 4 * 1024;
    const float* cb = p.m2_conv_b + (size_t)(l * 2 + dir) * 1024;
    if (wave == 0) {
#pragma unroll
      for (int j = 0; j < 8; ++j) {
        wl[(4 * 8 + j) * 64 + lane] = cb[chW + j];
#pragma unroll
        for (int tap = 0; tap < 4; ++tap) wl[(tap * 8 + j) * 64 + lane] = cw[tap * 1024 + chW + j];
      }
    }
    __syncthreads();
    const int hd_t = 4 * g + 2 * hp + ((tid >> 5) & 1);
    const float dtb = p.m2_dt_bias[(l * 2 + dir) * 8 + hd_t];
    const float Aneg_t = -__expf(p.m2_a_log[(l * 2 + dir) * 8 + hd_t]);
    const float Dsk = p.m2_d[(l * 2 + dir) * 8 + head];
    f32x16 S[4];
#pragma unroll
    for (int i = 0; i < 4; ++i)
#pragma unroll
      for (int q = 0; q < 16; ++q) S[i][q] = 0.f;
    if (PASS == 1) {
      for (int qb = 0; qb < sbd; ++qb) {
        const size_t sidx = (size_t)((task * 2 + dir) * 8 + qb);
        const float a = __expf(p.PA[sidx * 4 + wave]);
        const float* sp = SSM + sidx * 16384 + (size_t)wave * 4096 + lane;
#pragma unroll
        for (int nt = 0; nt < 4; ++nt)
#pragma unroll
          for (int q = 0; q < 16; ++q) S[nt][q] = S[nt][q] * a + sp[(nt * 16 + q) * 64];
      }
    }
    uint4 raw0, raw1, raw2, raw3, raw4, raw5, raw6, raw7, raw8, raw9, raw10;
    float dtraw = 0.f;
#define M2_LD1(RW, I, CH)                                                                  \
    {                                                                                      \
      int pt = (CH) * 32 + wave * 8 + (I) - 3;                                             \
      int sg0 = ((CH) * 32 < 256) ? 0 : 256;                                               \
      if (pt >= sg0) { int Rr = pos2row_m2(b, pt, dir); RW = *(const uint4*)(p.U + (size_t)Rr * UW + chU); } \
      else RW = make_uint4(0u, 0u, 0u, 0u);                                                \
    }
#define M2_PREFETCH(CH)                                                                    \
    M2_LD1(raw0, 0, CH) M2_LD1(raw1, 1, CH) M2_LD1(raw2, 2, CH) M2_LD1(raw3, 3, CH) M2_LD1(raw4, 4, CH) M2_LD1(raw5, 5, CH) \
    M2_LD1(raw6, 6, CH) M2_LD1(raw7, 7, CH) M2_LD1(raw8, 8, CH) M2_LD1(raw9, 9, CH) M2_LD1(raw10, 10, CH)            \
    if (tid < 64) { int Rr = pos2row_m2(b, (CH) * 32 + (tid & 31), dir); dtraw = p.DT[(size_t)Rr * 8 + hd_t]; }
    M2_PREFETCH(c0)
#pragma unroll 1
    for (int chunk = c0; chunk < c1; ++chunk) {
      {
#define M2_RAWF(RW, J) (((J) & 1) ? bfhi((RW)) : bflo((RW)))
#define M2_CH(J, C0, C1, C2, C3, C4, C5, C6, C7, C8, C9, C10)                               \
        {                                                                                  \
          const float q0 = wl[(0 * 8 + (J)) * 64 + lane], q1 = wl[(1 * 8 + (J)) * 64 + lane]; \
          const float q2 = wl[(2 * 8 + (J)) * 64 + lane], q3 = wl[(3 * 8 + (J)) * 64 + lane]; \
          const float qb = wl[(4 * 8 + (J)) * 64 + lane];                                  \
          const float v0 = M2_RAWF(C0, J), v1 = M2_RAWF(C1, J), v2 = M2_RAWF(C2, J), v3 = M2_RAWF(C3, J); \
          const float v4 = M2_RAWF(C4, J), v5 = M2_RAWF(C5, J), v6 = M2_RAWF(C6, J), v7 = M2_RAWF(C7, J); \
          const float v8 = M2_RAWF(C8, J), v9 = M2_RAWF(C9, J), v10 = M2_RAWF(C10, J);      \
          float o[8];                                                                      \
          o[0] = siluf(qb + q0 * v0 + q1 * v1 + q2 * v2 + q3 * v3);                        \
          o[1] = siluf(qb + q0 * v1 + q1 * v2 + q2 * v3 + q3 * v4);                        \
          o[2] = siluf(qb + q0 * v2 + q1 * v3 + q2 * v4 + q3 * v5);                        \
          o[3] = siluf(qb + q0 * v3 + q1 * v4 + q2 * v5 + q3 * v6);                        \
          o[4] = siluf(qb + q0 * v4 + q1 * v5 + q2 * v6 + q3 * v7);                        \
          o[5] = siluf(qb + q0 * v5 + q1 * v6 + q2 * v7 + q3 * v8);                        \
          o[6] = siluf(qb + q0 * v6 + q1 * v7 + q2 * v8 + q3 * v9);                        \
          o[7] = siluf(qb + q0 * v7 + q1 * v8 + q2 * v9 + q3 * v10);                       \
          if (act) {                                                                       \
            if (cp < 16) {                                                                 \
              *(uint4*)(xsT + (cp * 8 + (J)) * TS + wave * 8) = pack8(o);                  \
            } else if (cp < 32) {                                                          \
              *(uint4*)(BmT + ((cp - 16) * 8 + (J)) * TS + wave * 8) = pack8(o);           \
              _Pragma("unroll") for (int i = 0; i < 8; ++i) Bm[(wave * 8 + i) * QS + (cp - 16) * 8 + (J)] = f2bf(o[i]); \
            } else {                                                                       \
              _Pragma("unroll") for (int i = 0; i < 8; ++i) Cm[(wave * 8 + i) * QS + (cp - 32) * 8 + (J)] = f2bf(o[i]); \
            }                                                                              \
          }                                                                                \
        }
        M2_CH(0, raw0.x, raw1.x, raw2.x, raw3.x, raw4.x, raw5.x, raw6.x, raw7.x, raw8.x, raw9.x, raw10.x)
        M2_CH(1, raw0.x, raw1.x, raw2.x, raw3.x, raw4.x, raw5.x, raw6.x, raw7.x, raw8.x, raw9.x, raw10.x)
        M2_CH(2, raw0.y, raw1.y, raw2.y, raw3.y, raw4.y, raw5.y, raw6.y, raw7.y, raw8.y, raw9.y, raw10.y)
        M2_CH(3, raw0.y, raw1.y, raw2.y, raw3.y, raw4.y, raw5.y, raw6.y, raw7.y, raw8.y, raw9.y, raw10.y)
        M2_CH(4, raw0.z, raw1.z, raw2.z, raw3.z, raw4.z, raw5.z, raw6.z, raw7.z, raw8.z, raw9.z, raw10.z)
        M2_CH(5, raw0.z, raw1.z, raw2.z, raw3.z, raw4.z, raw5.z, raw6.z, raw7.z, raw8.z, raw9.z, raw10.z)
        M2_CH(6, raw0.w, raw1.w, raw2.w, raw3.w, raw4.w, raw5.w, raw6.w, raw7.w, raw8.w, raw9.w, raw10.w)
        M2_CH(7, raw0.w, raw1.w, raw2.w, raw3.w, raw4.w, raw5.w, raw6.w, raw7.w, raw8.w, raw9.w, raw10.w)
      }
      if (tid < 64) {
        float dtv = softplusf(dtraw + dtb);
        float run = dtv * Aneg_t;
#pragma unroll
        for (int o = 1; o < 32; o <<= 1) { float n = __shfl_up(run, o, 32); if ((tid & 31) >= o) run += n; }
        Gs[tid] = run; dts[tid] = dtv;
      }
      __syncthreads();
      if (chunk + 1 < c1) { M2_PREFETCH(chunk + 1) }
      const int Rout = pos2row_m2(b, chunk * 32 + r, dir);
      u16* yrow = p.Y2 + (size_t)Rout * 1024 + 512 + head * 64 + 32 * ph + 4 * hh;
      uint2 yold[4];
      if (PASS == 1 && dir == 1) {
#pragma unroll
        for (int i = 0; i < 4; ++i) yold[i] = *(const uint2*)(yrow + 8 * i);
      }
      const float* Gw = Gs + hq * 32; const float* dw = dts + hq * 32;
      const float Gt = Gw[r], G31 = Gw[31];
      lsum += G31;
      const u16* xw = xsT + (hq * 64 + ph * 32) * TS;
      f32x16 O0;
      if (PASS == 1) {
      f32x16 att;
#pragma unroll
      for (int q = 0; q < 16; ++q) att[q] = 0.f;
#pragma unroll
      for (int k8 = 0; k8 < 8; ++k8) {
        bf16x8 A = *(const bf16x8*)(Bm + r * QS + 16 * k8 + 8 * hh);
        bf16x8 B = *(const bf16x8*)(Cm + r * QS + 16 * k8 + 8 * hh);
        att = __builtin_amdgcn_mfma_f32_32x32x16_bf16(A, B, att, 0, 0, 0);
      }
#pragma unroll
      for (int q4 = 0; q4 < 4; ++q4) {
        float4 gs4 = *(const float4*)(Gw + 8 * q4 + 4 * hh);
        float4 dt4 = *(const float4*)(dw + 8 * q4 + 4 * hh);
        int s0 = 8 * q4 + 4 * hh;
        att[4 * q4 + 0] = (s0 + 0 <= r) ? att[4 * q4 + 0] * __expf(Gt - gs4.x) * dt4.x : 0.f;
        att[4 * q4 + 1] = (s0 + 1 <= r) ? att[4 * q4 + 1] * __expf(Gt - gs4.y) * dt4.y : 0.f;
        att[4 * q4 + 2] = (s0 + 2 <= r) ? att[4 * q4 + 2] * __expf(Gt - gs4.z) * dt4.z : 0.f;
        att[4 * q4 + 3] = (s0 + 3 <= r) ? att[4 * q4 + 3] * __expf(Gt - gs4.w) * dt4.w : 0.f;
      }
#pragma unroll
      for (int q = 0; q < 16; ++q) O0[q] = 0.f;
#pragma unroll
      for (int nt = 0; nt < 4; ++nt)
#pragma unroll
        for (int s2 = 0; s2 < 2; ++s2) {
          bf16x8 B = ld_frag_perm(Cm + r * QS + 32 * nt + 16 * s2 + 4 * hh);
          O0 = __builtin_amdgcn_mfma_f32_32x32x16_bf16(cvt_frag(S[nt], s2), B, O0, 0, 0, 0);
        }
      {
        const float eGt = __expf(Gt);
#pragma unroll
        for (int q = 0; q < 16; ++q) O0[q] *= eGt;
      }
#pragma unroll
      for (int s2 = 0; s2 < 2; ++s2) {
        bf16x8 B = cvt_frag(att, s2);
        O0 = __builtin_amdgcn_mfma_f32_32x32x16_bf16(ld_frag_perm(xw + r * TS + 16 * s2 + 4 * hh), B, O0, 0, 0, 0);
      }
#pragma unroll
      for (int q = 0; q < 16; ++q) {
        int pp = (q & 3) + 8 * (q >> 2) + 4 * hh;
        O0[q] += Dsk * bf2f(xw[pp * TS + r]);
      }
      }
      {
        const float eG31 = __expf(G31);
#pragma unroll
        for (int nt = 0; nt < 4; ++nt)
#pragma unroll
          for (int q = 0; q < 16; ++q) S[nt][q] *= eG31;
#pragma unroll
        for (int s2 = 0; s2 < 2; ++s2) {
          float ws[8];
          {
            float4 ga = *(const float4*)(Gw + 16 * s2 + 8 * hh), gb = *(const float4*)(Gw + 16 * s2 + 8 * hh + 4);
            float4 da = *(const float4*)(dw + 16 * s2 + 8 * hh), db = *(const float4*)(dw + 16 * s2 + 8 * hh + 4);
            ws[0] = da.x * __expf(G31 - ga.x); ws[1] = da.y * __expf(G31 - ga.y); ws[2] = da.z * __expf(G31 - ga.z); ws[3] = da.w * __expf(G31 - ga.w);
            ws[4] = db.x * __expf(G31 - gb.x); ws[5] = db.y * __expf(G31 - gb.y); ws[6] = db.z * __expf(G31 - gb.z); ws[7] = db.w * __expf(G31 - gb.w);
          }
          bf16x8 Bf0;
          {
            float f[8]; unpack8(*(const uint4*)(xw + r * TS + 16 * s2 + 8 * hh), f);
#pragma unroll
            for (int j = 0; j < 8; ++j) f[j] *= ws[j];
            FragU u; u.q = pack8(f); Bf0 = u.v;
          }
#pragma unroll
          for (int nt = 0; nt < 4; ++nt) {
            bf16x8 A = *(const bf16x8*)(BmT + (32 * nt + r) * TS + 16 * s2 + 8 * hh);
            S[nt] = __builtin_amdgcn_mfma_f32_32x32x16_bf16(A, Bf0, S[nt], 0, 0, 0);
          }
        }
      }
      if (PASS == 1) {
#pragma unroll
      for (int q4 = 0; q4 < 4; ++q4) {
        float o0 = O0[4 * q4], o1 = O0[4 * q4 + 1], o2 = O0[4 * q4 + 2], o3 = O0[4 * q4 + 3];
        if (dir == 1) { o0 += bflo(yold[q4].x); o1 += bfhi(yold[q4].x); o2 += bflo(yold[q4].y); o3 += bfhi(yold[q4].y); }
        uint2 ov; ov.x = pack2(o0, o1); ov.y = pack2(o2, o3);
        *(uint2*)(yrow + 8 * q4) = ov;
      }
      }
      __syncthreads();
    }
    if (PASS == 0) {
      const size_t sidx = (size_t)((task * 2 + dir) * 8 + sbd);
      if (lane == 0) p.PA[sidx * 4 + wave] = lsum;
      float* sp = SSM + sidx * 16384 + (size_t)wave * 4096 + lane;
#pragma unroll
      for (int nt = 0; nt < 4; ++nt)
#pragma unroll
        for (int q = 0; q < 16; ++q) sp[(nt * 16 + q) * 64] = S[nt][q];
    }
    __syncthreads();
  }
}
#endif
__device__ __forceinline__ void ph_mixA0(const P& p, int l, int bid, int nb, unsigned char* sm) {
  for (int i = 0;; ++i) {
    int t;
    if (nb == 256) {
      if (bid < 128) { if (i >= 1) break; t = bid; }
      else { if (i >= 2) break; t = 128 + (bid - 128) + 128 * i; }
    } else { t = bid + i * nb; if (t >= 384) break; }
    if (t < 128) hg_mfma<0>(p, l, t >> 3, (t >> 1) & 3, t & 1, sm);
    else { int u = t - 128; m2_mfma<0>(p, l, u >> 4, (u >> 1) & 7, u & 1, sm); }
    __syncthreads();
  }
}
__device__ __forceinline__ void ph_mixA1(const P& p, int l, int bid, int nb, unsigned char* sm) {
  for (int t = bid; t < 80 + 144; t += nb) {
    if (t < 80) hg_mfma<1>(p, l, t / 5, t % 5, 0, sm);
    else { int u = t - 80; m2_mfma<1>(p, l, u / 9, u % 9, 0, sm); }
    __syncthreads();
  }
}

template <int PASS>
__device__ __forceinline__ void rg_task(const P& p, int l, int task, float* sm) {
  int tid = threadIdx.x; asm volatile("" : "+v"(tid));
  const int wave = tid >> 6, lane = tid & 63;
  const int b = task / 136, rem = task % 136, head = rem / 17, sb = rem % 17;
  float* xc = sm;
  float* pa = sm + 2048;
  float* pb = sm + 4096;
  u16* xcb = (u16*)(sm + 6144);
  u16* WTl = xcb + 32 * 72;
  const int j = tid & 63;
  const int spos = tid >> 3, sseg = tid & 7;
  const int sch = head * 64 + sseg * 8;
  const u16* UB2 = p.U + (size_t)NTOK * 2048;
  for (int dir = 0; dir < 2; ++dir) {
    const int ld = l * 2 + dir;
    {
      const float* wa = p.rg_wa + (size_t)(ld * 8 + head) * 4096;
      const float* wx = p.rg_wx + (size_t)(ld * 8 + head) * 4096;
#pragma unroll
      for (int it = 0; it < 4; ++it) {
        int i = (tid >> 4) + 16 * it, j4 = (tid & 15) * 4;
        float4 va = *(const float4*)(wa + i * 64 + j4);
        float4 vx = *(const float4*)(wx + i * 64 + j4);
        WTl[(j4 + 0) * 72 + i] = f2bf(va.x); WTl[(j4 + 1) * 72 + i] = f2bf(va.y);
        WTl[(j4 + 2) * 72 + i] = f2bf(va.z); WTl[(j4 + 3) * 72 + i] = f2bf(va.w);
        WTl[(64 + j4 + 0) * 72 + i] = f2bf(vx.x); WTl[(64 + j4 + 1) * 72 + i] = f2bf(vx.y);
        WTl[(64 + j4 + 2) * 72 + i] = f2bf(vx.z); WTl[(64 + j4 + 3) * 72 + i] = f2bf(vx.w);
      }
    }
    float wcv[4][8], bcv[8];
#pragma unroll
    for (int jj = 0; jj < 8; ++jj) {
      bcv[jj] = p.rg_conv_b[(size_t)ld * 512 + sch + jj];
#pragma unroll
      for (int tap = 0; tap < 4; ++tap) wcv[tap][jj] = p.rg_conv_w[((size_t)ld * 4 + tap) * 512 + sch + jj];
    }
    const int chg = head * 64 + j;
    const float g_ba = p.rg_ba[ld * 512 + chg], g_bx = p.rg_bx[ld * 512 + chg];
    const float g_sp = -8.0f * softplusf(-p.rg_lam[ld * 512 + chg]);
    const int sbd = (PASS == 0) ? sb : (dir ? (sb == 0 ? 0 : 17 - sb) : sb);
    float hcarry = 0.f, aprod = 1.f;
    if (PASS == 1 && tid < 64) {
      for (int q = 0; q < sbd; ++q) {
        const float* sp = p.SUM + ((((size_t)b * 2 + dir) * 17 + q) * 512 + head * 64 + tid) * 2;
        hcarry = sp[0] * hcarry + sp[1];
      }
    }
    uint4 xr0, xr1, xr2, xr3;
#define RG_LD1(XR, TAP, CH)                                                               \
    {                                                                                     \
      int pt = (CH) * 32 + spos - 3 + (TAP);                                              \
      int sg0 = ((CH) * 32 < 256) ? 0 : 256;                                              \
      if (pt >= sg0) { int Rr = pos2row_seq(b, pt, dir); XR = *(const uint4*)(UB2 + (size_t)Rr * 2048 + sch); } \
      else XR = make_uint4(0u, 0u, 0u, 0u);                                               \
    }
#define RG_PREFETCH(CH) RG_LD1(xr0, 0, CH) RG_LD1(xr1, 1, CH) RG_LD1(xr2, 2, CH) RG_LD1(xr3, 3, CH)
    RG_PREFETCH(sbd * 8)
#pragma unroll 1
    for (int chunk = sbd * 8; chunk < sbd * 8 + 8; ++chunk) {
      const int pbase = chunk * 32;
      {
        float a[8], f[8];
#pragma unroll
        for (int jj = 0; jj < 8; ++jj) a[jj] = bcv[jj];
        unpack8(xr0, f);
#pragma unroll
        for (int jj = 0; jj < 8; ++jj) a[jj] += wcv[0][jj] * f[jj];
        unpack8(xr1, f);
#pragma unroll
        for (int jj = 0; jj < 8; ++jj) a[jj] += wcv[1][jj] * f[jj];
        unpack8(xr2, f);
#pragma unroll
        for (int jj = 0; jj < 8; ++jj) a[jj] += wcv[2][jj] * f[jj];
        unpack8(xr3, f);
#pragma unroll
        for (int jj = 0; jj < 8; ++jj) a[jj] += wcv[3][jj] * f[jj];
        *(float4*)(xc + spos * 64 + sseg * 8) = make_float4(a[0], a[1], a[2], a[3]);
        *(float4*)(xc + spos * 64 + sseg * 8 + 4) = make_float4(a[4], a[5], a[6], a[7]);
        *(uint4*)(xcb + spos * 72 + sseg * 8) = pack8(a);
      }
      __syncthreads();
      if (chunk + 1 < sbd * 8 + 8) { RG_PREFETCH(chunk + 1) }
      const int Rout = pos2row_seq(b, pbase + spos, dir);
      uint4* yp = (uint4*)(p.HL + (size_t)Rout * 1024 + 512 + sch);
      uint4 prev, gv;
      if (PASS == 1 && dir == 1) { prev = *yp; gv = *(const uint4*)(UB2 + (size_t)Rout * 2048 + 512 + sch); }
      {
        const int r = lane & 31, hh = lane >> 5;
        f32x16 acc;
#pragma unroll
        for (int q = 0; q < 16; ++q) acc[q] = 0.f;
#pragma unroll
        for (int ks = 0; ks < 4; ++ks) {
          bf16x8 A = *(const bf16x8*)(xcb + r * 72 + 16 * ks + 8 * hh);
          bf16x8 B = *(const bf16x8*)(WTl + (32 * wave + r) * 72 + 16 * ks + 8 * hh);
          acc = __builtin_amdgcn_mfma_f32_32x32x16_bf16(A, B, acc, 0, 0, 0);
        }
        float* dstp = (wave < 2) ? pa : pb;
        const int jc = (wave & 1) * 32 + r;
#pragma unroll
        for (int q = 0; q < 16; ++q) dstp[((q & 3) + 8 * (q >> 2) + 4 * hh) * 64 + jc] = acc[q];
      }
      __syncthreads();
#pragma unroll
      for (int i = 0; i < 8; ++i) {
        int e = tid + 256 * i;
        float r = sigmf(pa[e] + g_ba);
        float gi = sigmf(pb[e] + g_bx);
        float la = g_sp * r;
        float a = __expf(la);
        float bt = sqrtf(fmaxf(1.f - a * a, 0.f)) * gi * xc[e];
        pa[e] = a; pb[e] = bt;
      }
      __syncthreads();
      if (tid < 64) {
        float hh = hcarry;
#pragma unroll 8
        for (int pos = 0; pos < 32; ++pos) { float av = pa[pos * 64 + tid]; hh = av * hh + pb[pos * 64 + tid]; pb[pos * 64 + tid] = hh; aprod *= av; }
        hcarry = hh;
      }
      __syncthreads();
      if (PASS == 1) {
        float hv[8];
#pragma unroll
        for (int jj = 0; jj < 8; ++jj) hv[jj] = pb[spos * 64 + sseg * 8 + jj];
        if (dir == 1) {
          float f[8]; unpack8(prev, f);
          float gf[8]; unpack8(gv, gf);
#pragma unroll
          for (int jj = 0; jj < 8; ++jj) hv[jj] = (hv[jj] + f[jj]) * gf[jj];
        }
        *yp = pack8(hv);
      }
    }
    if (PASS == 0 && tid < 64) {
      float* sp = p.SUM + ((((size_t)b * 2 + dir) * 17 + sbd) * 512 + head * 64 + tid) * 2;
      sp[0] = aprod; sp[1] = hcarry;
    }
    __syncthreads();
  }
}

typedef bf16x8 __attribute__((aligned(2))) bf16x8_u;
typedef uint4 __attribute__((aligned(4))) uint4_a4;
__device__ __forceinline__ bf16x8 ld_win8(const u16* base, int y, uint32_t sh) {
  const uint32_t* wp = (const uint32_t*)base + (y >> 1);
  uint4 w = *(const uint4_a4*)wp;
  uint32_t w4 = wp[4];
  FragU f;
  f.u[0] = __builtin_amdgcn_alignbit(w.y, w.x, sh);
  f.u[1] = __builtin_amdgcn_alignbit(w.z, w.y, sh);
  f.u[2] = __builtin_amdgcn_alignbit(w.w, w.z, sh);
  f.u[3] = __builtin_amdgcn_alignbit(w4, w.w, sh);
  return f.v;
}

__device__ __forceinline__ void hy_conv3x8(const u16* col, int t8, int n, float w0, float w1, float w2, float bias, float* out) {
  float f[8]; unpack8(*(const uint4*)(col + t8), f);
  float prev = (t8 > 0) ? bf2f(col[t8 - 1]) : 0.f;
  float next = (t8 + 8 < n) ? bf2f(col[t8 + 8]) : 0.f;
#pragma unroll
  for (int j = 0; j < 8; ++j) {
    float a = (j == 0) ? prev : f[j - 1];
    float cnx = (j == 7) ? next : f[j + 1];
    out[j] = bias + w0 * a + w1 * f[j] + w2 * cnx;
  }
}

__device__ __forceinline__ void hy_task(const P& p, int l, int c, float* sm) {
  int tid = threadIdx.x; asm volatile("" : "+v"(tid)); const int wave = tid >> 6, lane = tid & 63;
  const int r = lane & 31, h = lane >> 5;
  u16* krr = (u16*)sm;
  u16* zs = krr + 8192 + 64;
  float* red = (float*)(zs + 16384);
  const u16* UT = p.U;
  const float* cwp = p.hy_conv_w + (size_t)l * 3 * 1536;
  const float* cbp = p.hy_conv_b + (size_t)l * 1536;
  for (int o = 0; o < 2; ++o) {
    const u16* K = p.KF + (size_t)(o * 512 + c) * 8192;
    float asum = 0.f;
#pragma unroll
    for (int i = 0; i < 4; ++i) {
      int idx = (tid + 256 * i) * 8;
      uint4 v = *(const uint4*)(K + idx);
      *(uint4*)(krr + idx) = v;
      float f[8]; unpack8(v, f);
#pragma unroll
      for (int j = 0; j < 8; ++j) asum += fabsf(f[j]);
    }
    asum = wave_sum(asum);
    if (lane == 0) red[wave] = asum;
    if (o == 0) {
      const float w0 = cwp[c], w1 = cwp[1536 + c], w2 = cwp[3072 + c], bs = cbp[c];
#pragma unroll 1
      for (int e = tid; e < 2048; e += 256) {
        int b = e >> 9, t8 = (e & 511) * 8;
        float f[8];
        hy_conv3x8(UT + (size_t)c * NTOK + b * 4096, t8, 4096, w0, w1, w2, bs, f);
        *(uint4*)(zs + b * 4096 + t8) = pack8(f);
      }
    }
    __syncthreads();
    const float scale = 1.f / (red[0] + red[1] + red[2] + red[3] + 1e-6f);
    const float skip = p.hy_skip[(l * 2 + o) * 512 + c];
    f32x16 acc[2][2];
#pragma unroll
    for (int a = 0; a < 2; ++a)
#pragma unroll
      for (int b = 0; b < 2; ++b)
#pragma unroll
        for (int q = 0; q < 16; ++q) acc[a][b][q] = 0.f;
    const int I0 = wave * 16;
    const int Il0 = I0 + (r >> 2), Il1 = I0 + 8 + (r >> 2);
    const u16* zb = zs + (r & 3) * 4096 + 8 * h;
    const int ybase = 4096 - r + 8 * h + 48;
    bf16x8 F0, F1, F2, F3, F4, F5;
    const uint32_t ysh = (uint32_t)((ybase & 1) * 16);
    {
      const int y0 = ybase - 64 * (I0 - 63);
      F0 = ld_win8(krr, y0, ysh); F1 = ld_win8(krr, y0 - 16, ysh); F2 = ld_win8(krr, y0 - 32, ysh);
      F3 = ld_win8(krr, y0 - 48, ysh); F4 = ld_win8(krr, y0 - 64, ysh); F5 = ld_win8(krr, y0 - 80, ysh);
    }
#pragma unroll 1
    for (int D = I0 - 63; D <= I0 + 15; ++D) {
      bf16x8 B0[4], B1[4];
      {
        int J0 = Il0 - D, J1 = Il1 - D;
        bool ok0 = (unsigned)J0 < 64u, ok1 = (unsigned)J1 < 64u;
        const u16* zp0 = zb + 64 * J0; const u16* zp1 = zb + 64 * J1;
#pragma unroll
        for (int ks = 0; ks < 4; ++ks) {
          bf16x8 z0 = {0, 0, 0, 0, 0, 0, 0, 0}, z1 = {0, 0, 0, 0, 0, 0, 0, 0};
          if (ok0) z0 = *(const bf16x8*)(zp0 + 16 * ks);
          if (ok1) z1 = *(const bf16x8*)(zp1 + 16 * ks);
          B0[ks] = z0; B1[ks] = z1;
        }
      }
      acc[0][0] = __builtin_amdgcn_mfma_f32_32x32x16_bf16(F3, B0[0], acc[0][0], 0, 0, 0);
      acc[0][1] = __builtin_amdgcn_mfma_f32_32x32x16_bf16(F3, B1[0], acc[0][1], 0, 0, 0);
      acc[1][0] = __builtin_amdgcn_mfma_f32_32x32x16_bf16(F5, B0[0], acc[1][0], 0, 0, 0);
      acc[1][1] = __builtin_amdgcn_mfma_f32_32x32x16_bf16(F5, B1[0], acc[1][1], 0, 0, 0);
      acc[0][0] = __builtin_amdgcn_mfma_f32_32x32x16_bf16(F2, B0[1], acc[0][0], 0, 0, 0);
      acc[0][1] = __builtin_amdgcn_mfma_f32_32x32x16_bf16(F2, B1[1], acc[0][1], 0, 0, 0);
      acc[1][0] = __builtin_amdgcn_mfma_f32_32x32x16_bf16(F4, B0[1], acc[1][0], 0, 0, 0);
      acc[1][1] = __builtin_amdgcn_mfma_f32_32x32x16_bf16(F4, B1[1], acc[1][1], 0, 0, 0);
      acc[0][0] = __builtin_amdgcn_mfma_f32_32x32x16_bf16(F1, B0[2], acc[0][0], 0, 0, 0);
      acc[0][1] = __builtin_amdgcn_mfma_f32_32x32x16_bf16(F1, B1[2], acc[0][1], 0, 0, 0);
      acc[1][0] = __builtin_amdgcn_mfma_f32_32x32x16_bf16(F3, B0[2], acc[1][0], 0, 0, 0);
      acc[1][1] = __builtin_amdgcn_mfma_f32_32x32x16_bf16(F3, B1[2], acc[1][1], 0, 0, 0);
      acc[0][0] = __builtin_amdgcn_mfma_f32_32x32x16_bf16(F0, B0[3], acc[0][0], 0, 0, 0);
      acc[0][1] = __builtin_amdgcn_mfma_f32_32x32x16_bf16(F0, B1[3], acc[0][1], 0, 0, 0);
      acc[1][0] = __builtin_amdgcn_mfma_f32_32x32x16_bf16(F2, B0[3], acc[1][0], 0, 0, 0);
      acc[1][1] = __builtin_amdgcn_mfma_f32_32x32x16_bf16(F2, B1[3], acc[1][1], 0, 0, 0);
      F0 = F4; F1 = F5;
      if (D < I0 + 15) {
        const int y1 = ybase - 64 * (D + 1);
        F2 = ld_win8(krr, y1 - 32, ysh); F3 = ld_win8(krr, y1 - 48, ysh);
        F4 = ld_win8(krr, y1 - 64, ysh); F5 = ld_win8(krr, y1 - 80, ysh);
      }
    }
    __syncthreads();
#pragma unroll
    for (int ni = 0; ni < 2; ++ni) {
      u16* zc = zs + (r & 3) * 4096 + 64 * (ni ? Il1 : Il0);
#pragma unroll
      for (int mi = 0; mi < 2; ++mi)
#pragma unroll
        for (int q = 0; q < 16; ++q) {
          int i = 32 * mi + (q & 3) + 8 * (q >> 2) + 4 * h;
          float zo = bf2f(zc[i]);
          zc[i] = f2bf(scale * acc[mi][ni][q] + skip * zo);
        }
    }
    __syncthreads();
    {
      const int ch = (o + 1) * 512 + c;
      const float w0 = cwp[ch], w1 = cwp[1536 + ch], w2 = cwp[3072 + ch], bs = cbp[ch];
#pragma unroll 1
      for (int e = tid; e < 2048; e += 256) {
        int b = e >> 9, t8 = (e & 511) * 8;
        float xg[8], y[8];
        hy_conv3x8(UT + (size_t)ch * NTOK + b * 4096, t8, 4096, w0, w1, w2, bs, xg);
        unpack8(*(const uint4*)(zs + b * 4096 + t8), y);
#pragma unroll
        for (int j = 0; j < 8; ++j) y[j] *= xg[j];
        if (o == 0) *(uint4*)(zs + b * 4096 + t8) = pack8(y);
        else {
          float gf[8]; unpack8(*(const uint4*)(UT + (size_t)(1536 + c) * NTOK + b * 4096 + t8), gf);
#pragma unroll
          for (int j = 0; j < 8; ++j) y[j] *= gf[j];
          *(uint4*)(p.U + (size_t)c * NTOK + b * 4096 + t8) = pack8(y);
        }
      }
    }
    __syncthreads();
  }
  if (l == 0) {
    const int t = tid;
    for (int o = 0; o < 2; ++o) {
      const u16* K = p.KFC + (size_t)(o * 512 + c) * 512;
      float asum = 0.f;
      {
        uint32_t w2 = *(const uint32_t*)(K + tid * 2);
        *(uint32_t*)(krr + tid * 2) = w2;
        asum = fabsf(bflo(w2)) + fabsf(bfhi(w2));
      }
      asum = wave_sum(asum);
      if (lane == 0) red[wave] = asum;
      if (o == 0) {
        const float w0 = cwp[c], w1 = cwp[1536 + c], w2 = cwp[3072 + c], bs = cbp[c];
        if (tid < 128) {
          int b = tid >> 5, t8 = (tid & 31) * 8;
          float f[8];
          hy_conv3x8(UT + (size_t)c * NTOK + NLAT + b * 256, t8, 256, w0, w1, w2, bs, f);
          *(uint4*)(zs + b * 4096 + t8) = pack8(f);
        }
      }
      __syncthreads();
      const float scale = 1.f / (red[0] + red[1] + red[2] + red[3] + 1e-6f);
      float a0 = 0, a1 = 0, a2 = 0, a3 = 0;
      for (int s2 = 0; s2 < 256; ++s2) {
        float kv = bf2f(krr[256 - t + s2]);
        a0 += kv * bf2f(zs[s2]); a1 += kv * bf2f(zs[4096 + s2]); a2 += kv * bf2f(zs[8192 + s2]); a3 += kv * bf2f(zs[12288 + s2]);
      }
      const float skip = p.hy_skip[(l * 2 + o) * 512 + c];
      float y[4];
      y[0] = scale * a0 + skip * bf2f(zs[t]); y[1] = scale * a1 + skip * bf2f(zs[4096 + t]);
      y[2] = scale * a2 + skip * bf2f(zs[8192 + t]); y[3] = scale * a3 + skip * bf2f(zs[12288 + t]);
      __syncthreads();
      {
        const int ch = (o + 1) * 512 + c;
        const float w0 = cwp[ch], w1 = cwp[1536 + ch], w2 = cwp[3072 + ch], bs = cbp[ch];
#pragma unroll
        for (int b = 0; b < 4; ++b) {
          const u16* col = UT + (size_t)ch * NTOK + NLAT + b * 256;
          float xg = bs + w1 * bf2f(col[t]);
          if (t > 0) xg += w0 * bf2f(col[t - 1]);
          if (t < 255) xg += w2 * bf2f(col[t + 1]);
          float zn = xg * y[b];
          if (o == 0) zs[b * 4096 + t] = f2bf(zn);
          else {
            size_t R = (size_t)NLAT + b * 256 + t;
            float gate = bf2f(UT[(size_t)(1536 + c) * NTOK + R]);
            p.U[(size_t)c * NTOK + R] = f2bf(zn * gate);
          }
        }
      }
      __syncthreads();
    }
  }
}

__device__ __forceinline__ void fin_rows(const P& p, int l, int chunk) {
  int tid = threadIdx.x; asm volatile("" : "+v"(tid)); const int wave = tid >> 6, lane = tid & 63;
  for (int rr = 0; rr < 16; ++rr) {
    int R = chunk * 64 + wave * 16 + rr;
    {
      uint4* yp = (uint4*)(p.Y2 + (size_t)R * 1024 + lane * 8);
      float o[8]; unpack8(*yp, o);
      float ss = 0;
#pragma unroll
      for (int j = 0; j < 8; ++j) ss += o[j] * o[j];
      ss += __shfl_xor(ss, 1); ss += __shfl_xor(ss, 2); ss += __shfl_xor(ss, 4); ss += __shfl_xor(ss, 8);
      float rinv = rsqrtf(ss * (1.f / 128.f) + EPS);
      float gf[8]; unpack8(*(const uint4*)(p.U + (size_t)NTOK * 2048 + (size_t)R * 2048 + 1024 + lane * 8), gf);
#pragma unroll
      for (int j = 0; j < 8; ++j) o[j] = o[j] * rinv * p.hg_norm_w[l * 512 + lane * 8 + j] * gf[j];
      *yp = pack8(o);
    }
    {
      uint4* yp = (uint4*)(p.Y2 + (size_t)R * 1024 + 512 + lane * 8);
      float o[8]; unpack8(*yp, o);
      float gf[8]; unpack8(*(const uint4*)(p.U + (size_t)NTOK * 2048 + (size_t)R * 2048 + 1536 + lane * 8), gf);
      float ss = 0;
#pragma unroll
      for (int j = 0; j < 8; ++j) { o[j] *= gf[j]; ss += o[j] * o[j]; }
      ss += __shfl_xor(ss, 1); ss += __shfl_xor(ss, 2); ss += __shfl_xor(ss, 4); ss += __shfl_xor(ss, 8); ss += __shfl_xor(ss, 16);
      float rinv = rsqrtf(ss * (1.f / 256.f) + EPS);
#pragma unroll
      for (int j = 0; j < 8; ++j) o[j] = o[j] * rinv * p.m2_norm_w[l * 512 + lane * 8 + j];
      *yp = pack8(o);
    }
  }
}

__device__ __forceinline__ void ph_mixB(const P& p, int l, int bid, int nb, float* sm) {
  for (int t = bid; t < 544 + 512; t += nb) {
    if (t < 544) { if (EN_RG) rg_task<0>(p, l, t, sm); }
    else { if (EN_HY) hy_task(p, l, t - 544, sm); }
    __syncthreads();
  }
}
__device__ __forceinline__ void hy_transpose(const P& p, int tile, u16* sm) {
  int tid = threadIdx.x; asm volatile("" : "+v"(tid));
  const int ct = tile & 7, rt = tile >> 3;
  const int c0 = ct * 64, R0 = rt * 64;
#pragma unroll
  for (int i = 0; i < 2; ++i) {
    int q = tid + 256 * i; int cc = q >> 3, seg = q & 7;
    *(uint4*)(sm + cc * 72 + seg * 8) = *(const uint4*)(p.U + (size_t)(c0 + cc) * NTOK + R0 + seg * 8);
  }
  __syncthreads();
#pragma unroll
  for (int i = 0; i < 2; ++i) {
    int q = tid + 256 * i; int rr = q >> 3, seg = q & 7;
    FragU f;
#pragma unroll
    for (int j = 0; j < 4; ++j)
      f.u[j] = (uint32_t)sm[(seg * 8 + 2 * j) * 72 + rr] | ((uint32_t)sm[(seg * 8 + 2 * j + 1) * 72 + rr] << 16);
    *(uint4*)(p.HL + (size_t)(R0 + rr) * 1024 + c0 + seg * 8) = f.q;
  }
}
__device__ __forceinline__ void ph_mixB2(const P& p, int l, int bid, int nb, float* sm) {
  const int nfin = (l == 0 ? NTOK : NLAT) / 64;
  const int ntr = nfin * 8;
  for (int t = bid; t < 544 + nfin + ntr; t += nb) {
    if (t < 544) { if (EN_RG) rg_task<1>(p, l, t, sm); }
    else if (t < 544 + nfin) fin_rows(p, l, t - 544);
    else hy_transpose(p, t - 544 - nfin, (u16*)sm);
    __syncthreads();
  }
}
__device__ __forceinline__ void ph_final(const P& p, int bid, int nb) {
  int tid = threadIdx.x; asm volatile("" : "+v"(tid)); const int wave = tid >> 6, lane = tid & 63;
  for (int R = bid * 4 + wave; R < NLAT; R += nb * 4) {
    float4* rp = (float4*)(p.out + (size_t)R * 1024);
    float4 v[4]; float ss = 0;
#pragma unroll
    for (int i = 0; i < 4; ++i) {
      v[i] = rp[lane + i * 64];
      ss += v[i].x * v[i].x + v[i].y * v[i].y + v[i].z * v[i].z + v[i].w * v[i].w;
    }
    ss = wave_sum(ss);
    float rinv = rsqrtf(ss * (1.f / 1024.f) + EPS);
#pragma unroll
    for (int i = 0; i < 4; ++i) {
      float4 w = *(const float4*)(p.final_norm_w + (lane + i * 64) * 4);
      float4 o; o.x = v[i].x * rinv * w.x; o.y = v[i].y * rinv * w.y; o.z = v[i].z * rinv * w.z; o.w = v[i].w * rinv * w.w;
      rp[lane + i * 64] = o;
    }
  }
}

#define SMEM_BYTES 56320
__global__ void __launch_bounds__(256) mega(P p) {
  __shared__ __align__(16) unsigned char smem[SMEM_BYTES];
  cg::grid_group grid = cg::this_grid();
  const int bid = blockIdx.x, nb = gridDim.x;
  float* smf = (float*)smem; u16* smh = (u16*)smem;
#ifndef PHM
#define PHM 0xffff
#endif
  if (PHM & 1) ph_mod(p, bid, nb, smf);
  grid.sync();
  for (int l = 0; l < 2; ++l) {
    if (PHM & 2) ph_norm(p, l, bid, nb);
    if (PHM & 4) ph_wconv(p, l, bid, nb, smf);
    grid.sync();
    if (PHM & 16) ph_gemm<0>(p, l, bid, nb, smh);
    grid.sync();
#if PROBE_DUP == 3
    ph_gemm<0>(p, l, bid, nb, smh);
    grid.sync();
#endif
#if PROBE_DUP == 10
    ph_norm(p, l, bid, nb);
    ph_wconv(p, l, bid, nb, smf);
    grid.sync();
#endif
    if (PHM & 32) ph_mixA0(p, l, bid, nb, smem);
    grid.sync();
    if (PHM & 32) ph_mixA1(p, l, bid, nb, smem);
    grid.sync();
#if PROBE_DUP == 8
    ph_mixA0(p, l, bid, nb, smem);
    grid.sync();
    ph_mixA1(p, l, bid, nb, smem);
    grid.sync();
#endif
    if (PHM & 64) ph_gemm<1>(p, l, bid, nb, smh);
    if (PHM & 8) ph_filt(p, l, bid, nb, smf);
    grid.sync();
#if PROBE_DUP == 2
    ph_mixB(p, l, bid, nb, smf);
    grid.sync();
#endif
#if PROBE_DUP == 4
    ph_gemm<1>(p, l, bid, nb, smh);
    grid.sync();
#endif
#if PROBE_DUP == 9
    ph_gemm<1>(p, l, bid, nb, smh, 1);
    grid.sync();
#endif
    if (PHM & 128) ph_mixB(p, l, bid, nb, smf);
    grid.sync();
    if (PHM & 128) ph_mixB2(p, l, bid, nb, smf);
    grid.sync();
#if PROBE_DUP == 7
    for (int t = bid; t < 544; t += nb) { rg_task<1>(p, l, t, smf); __syncthreads(); }
    grid.sync();
#endif
    if (PHM & 256) ph_gemm<2>(p, l, bid, nb, smh);
    grid.sync();
  }
  if (PHM & 512) ph_final(p, bid, nb);
}

extern "C" void kernel_launch(void* const* d_in, const int* in_sizes, int n_in, void* d_out, int out_size,
                              void* d_ws, size_t ws_size, hipStream_t stream) {
  static int grid_blocks = 0;
  if (!grid_blocks) {
    int dev = 0, cus = 0, per_cu = 0;
    hipGetDevice(&dev);
    hipDeviceGetAttribute(&cus, hipDeviceAttributeMultiprocessorCount, dev);
    hipOccupancyMaxActiveBlocksPerMultiprocessor(&per_cu, mega, 256, 0);
    if (per_cu < 1) per_cu = 1;
    if (per_cu > 2) per_cu = 2;
    grid_blocks = cus * per_cu;
  }
  P p{};
  const float** fp = (const float**)&p;
  for (int i = 0; i < 34; ++i) fp[i] = (const float*)d_in[i];
  p.out = (float*)d_out;
  char* w = (char*)d_ws;
  size_t off = 0;
  auto take = [&](size_t bytes) { char* r = w + off; off += (bytes + 255) & ~(size_t)255; return r; };
  p.U = (u16*)take((size_t)NTOK * UW * 2);
  p.HL = (u16*)take((size_t)NTOK * 1024 * 2);
  p.Y2 = (u16*)take((size_t)NTOK * 1024 * 2);
  p.WT = (u16*)take((size_t)7296 * 1024 * 2);
  p.WoT = (u16*)take((size_t)1024 * 2048 * 2);
  p.KF = (u16*)take((size_t)1024 * 8192 * 2);
  p.KFC = (u16*)take((size_t)1024 * 512 * 2);
  p.XC = (float*)take((size_t)1024 * 1024 * 4);
  p.DT = (float*)take((size_t)NTOK * 8 * 4);
  p.MOD = (float*)take((size_t)2 * 5 * 3072 * 4);
  p.SUM = (float*)take((size_t)4 * 2 * 17 * 512 * 2 * 4);
  p.SSH = (float*)take((size_t)16 * 2 * 4 * 65536);
  p.PS = (float*)take((size_t)16 * 2 * 4 * 128 * 4);
  p.PA = (float*)take((size_t)16 * 2 * 8 * 4 * 4);
  if (off > ws_size) { fprintf(stderr, "workspace too small: need %zu have %zu\n", off, ws_size); return; }
  void* args[] = {&p};
  hipError_t e = hipLaunchCooperativeKernel((void*)mega, dim3(grid_blocks), dim3(256), args, 0, stream);
  if (e != hipSuccess) fprintf(stderr, "cooperative launch failed: %s (grid %d)\n", hipGetErrorString(e), grid_blocks);
}
```

```cpp
#include <hip/hip_runtime.h>
#include <hip/hip_bf16.h>
#include <hip/hip_cooperative_groups.h>
#include <cstdio>
#include <cstdint>
namespace cg = cooperative_groups;

typedef unsigned short u16;
using bf16x8 = __attribute__((ext_vector_type(8))) short;
using f32x16 = __attribute__((ext_vector_type(16))) float;

#define NTOK 17408
#define NLAT 16384
#define UW 4096
#define EPS 1e-6f

#ifndef PROBE_DUP
#define PROBE_DUP 0
#endif
#ifndef EN_HY
#define EN_HY 1
#endif
#ifndef EN_RG
#define EN_RG 1
#endif
#ifndef EN_HG
#define EN_HG 1
#endif
#ifndef EN_M2
#define EN_M2 1
#endif

struct P {
  const float *x, *c, *ctx, *c_ctx, *w_mod, *b_mod, *norm_w, *w_in, *w_out;
  const float *hy_conv_w, *hy_conv_b, *hy_w1, *hy_b1, *hy_w2, *hy_b2, *hy_w3, *hy_freq, *hy_skip;
  const float *rg_conv_w, *rg_conv_b, *rg_wa, *rg_ba, *rg_wx, *rg_bx, *rg_lam;
  const float *hg_lb, *hg_norm_w, *m2_conv_w, *m2_conv_b, *m2_dt_bias, *m2_a_log, *m2_d, *m2_norm_w, *final_norm_w;
  float* out;
  u16 *U, *HL, *Y2, *WT, *WoT, *KF, *KFC;
  float *XC, *DT, *MOD, *SUM, *SSH, *PS, *PA;
};

typedef __bf16 bf2_t __attribute__((ext_vector_type(2)));
typedef float f2_t __attribute__((ext_vector_type(2)));
__device__ __forceinline__ uint32_t pack2(float a, float b) {
  f2_t v = {a, b};
  return __builtin_bit_cast(uint32_t, __builtin_convertvector(v, bf2_t));
}
__device__ __forceinline__ u16 f2bf(float f) { return (u16)(pack2(f, f) & 0xffffu); }
__device__ __forceinline__ float bf2f(u16 h) { return __uint_as_float(((uint32_t)h) << 16); }
__device__ __forceinline__ float bflo(uint32_t w) { return __uint_as_float(w << 16); }
__device__ __forceinline__ float bfhi(uint32_t w) { return __uint_as_float(w & 0xffff0000u); }
__device__ __forceinline__ float siluf(float x) { return x * __builtin_amdgcn_rcpf(1.f + __expf(-x)); }
__device__ __forceinline__ float sigmf(float x) { return __builtin_amdgcn_rcpf(1.f + __expf(-x)); }
__device__ __forceinline__ float softplusf(float x) { return x > 20.f ? x : log1pf(__expf(x)); }

__device__ __forceinline__ void unpack8(const uint4& v, float* f) {
  f[0] = bflo(v.x); f[1] = bfhi(v.x); f[2] = bflo(v.y); f[3] = bfhi(v.y);
  f[4] = bflo(v.z); f[5] = bfhi(v.z); f[6] = bflo(v.w); f[7] = bfhi(v.w);
}
__device__ __forceinline__ uint4 pack8(const float* f) {
  uint4 v; v.x = pack2(f[0], f[1]); v.y = pack2(f[2], f[3]); v.z = pack2(f[4], f[5]); v.w = pack2(f[6], f[7]);
  return v;
}
__device__ __forceinline__ float wave_sum(float v) {
#pragma unroll
  for (int o = 32; o >= 1; o >>= 1) v += __shfl_xor(v, o);
  return v;
}

__device__ __forceinline__ int pos2row_seq(int b, int p, int dir) {
  if (p < 256) { int t = dir ? 255 - p : p; return NLAT + b * 256 + t; }
  int j = p - 256; int t = dir ? 4095 - j : j; return b * 4096 + t;
}
__device__ __forceinline__ int pos2row_m2(int b, int p, int dir) {
  if (p < 256) { int t = dir ? 255 - p : p; return NLAT + b * 256 + t; }
  int j = p - 256; int jj = dir ? 4095 - j : j; int c = jj >> 6, r = jj & 63; return b * 4096 + r * 64 + c;
}

__device__ __forceinline__ void ph_mod(const P& p, int bid, int nb, float* sm) {
  int tid = threadIdx.x; asm volatile("" : "+v"(tid));
  for (int task = bid; task < 96; task += nb) {
    int l = task / 48, cgi = task % 48;
    int col = cgi * 64 + (tid & 63);
    int kq = tid >> 6;
    float a0 = 0, a1 = 0, a2 = 0, a3 = 0, a4 = 0;
    for (int k = kq * 256; k < kq * 256 + 256; ++k) {
      float w = p.w_mod[((size_t)l * 1024 + k) * 3072 + col];
      a0 += siluf(p.c[k]) * w; a1 += siluf(p.c[1024 + k]) * w; a2 += siluf(p.c[2048 + k]) * w;
      a3 += siluf(p.c[3072 + k]) * w; a4 += siluf(p.c_ctx[k]) * w;
    }
    sm[(kq * 5 + 0) * 64 + (tid & 63)] = a0; sm[(kq * 5 + 1) * 64 + (tid & 63)] = a1;
    sm[(kq * 5 + 2) * 64 + (tid & 63)] = a2; sm[(kq * 5 + 3) * 64 + (tid & 63)] = a3;
    sm[(kq * 5 + 4) * 64 + (tid & 63)] = a4;
    __syncthreads();
    if (tid < 64) {
      float bm = p.b_mod[l * 3072 + col];
#pragma unroll
      for (int j = 0; j < 5; ++j) {
        float s = sm[(0 * 5 + j) * 64 + tid] + sm[(1 * 5 + j) * 64 + tid] + sm[(2 * 5 + j) * 64 + tid] + sm[(3 * 5 + j) * 64 + tid];
        p.MOD[(size_t)(l * 5 + j) * 3072 + col] = s + bm;
      }
    }
    __syncthreads();
  }
}

__device__ __forceinline__ void ph_norm(const P& p, int l, int bid, int nb) {
  int tid = threadIdx.x; asm volatile("" : "+v"(tid)); const int wave = tid >> 6, lane = tid & 63;
  for (int R = bid * 4 + wave; R < NTOK; R += nb * 4) {
    const float* src; int mj;
    if (R < NLAT) { src = (l == 0 ? p.x : (const float*)p.out) + (size_t)R * 1024; mj = R >> 12; }
    else { int rc = R - NLAT; src = (l == 0 ? p.ctx : (const float*)p.XC) + (size_t)rc * 1024; mj = 4; }
    const float* mod = p.MOD + (size_t)(l * 5 + mj) * 3072;
    float4 v[4]; float ss = 0;
#pragma unroll
    for (int i = 0; i < 4; ++i) {
      v[i] = ((const float4*)src)[lane + i * 64];
      ss += v[i].x * v[i].x + v[i].y * v[i].y + v[i].z * v[i].z + v[i].w * v[i].w;
    }
    ss = wave_sum(ss);
    float rinv = rsqrtf(ss * (1.f / 1024.f) + EPS);
#pragma unroll
    for (int i = 0; i < 4; ++i) {
      int idx = (lane + i * 64) * 4;
      float4 nw = *(const float4*)(p.norm_w + l * 1024 + idx);
      float4 sh = *(const float4*)(mod + idx);
      float4 sc = *(const float4*)(mod + 1024 + idx);
      float h0 = v[i].x * rinv * nw.x * (1.f + sc.x) + sh.x;
      float h1 = v[i].y * rinv * nw.y * (1.f + sc.y) + sh.y;
      float h2 = v[i].z * rinv * nw.z * (1.f + sc.z) + sh.z;
      float h3 = v[i].w * rinv * nw.w * (1.f + sc.w) + sh.w;
      uint2 o; o.x = pack2(h0, h1); o.y = pack2(h2, h3);
      *(uint2*)(p.HL + (size_t)R * 1024 + idx) = o;
    }
  }
}

__device__ __forceinline__ void ph_wconv(const P& p, int l, int bid, int nb, float* sm) {
  int tid = threadIdx.x; asm volatile("" : "+v"(tid));
  const int T1 = 114 * 16, T2 = 16 * 32;
  for (int t = bid; t < T1 + T2; t += nb) {
    const float* src; int ld, K, n0, k0, sc0, nvalid; u16* dst;
    if (t < T1) {
      int nt = t / 16, kt = t % 16; n0 = nt * 64; k0 = kt * 64;
      src = p.w_in + (size_t)l * 1024 * 7176; ld = 7176; K = 1024; dst = p.WT; nvalid = 64;
      if (n0 < 2048) sc0 = 3072 + n0;
      else if (n0 < 3072) sc0 = 5632 + (n0 - 2048);
      else if (n0 < 3200) { sc0 = 6656 + (n0 - 3072); nvalid = (n0 == 3072) ? 8 : 0; }
      else { int m = n0 - 3200; if (m < 3072) sc0 = m; else if (m < 3584) sc0 = 5120 + (m - 3072); else sc0 = 6664 + (m - 3584); }
    } else {
      int tt = t - T1; int nt = tt / 32, kt = tt % 32; n0 = nt * 64; k0 = kt * 64;
      src = p.w_out + (size_t)l * 2048 * 1024; ld = 1024; K = 2048; dst = p.WoT; nvalid = 64; sc0 = n0;
    }
#pragma unroll
    for (int i = 0; i < 4; ++i) {
      int kk = (tid >> 4) + 16 * i, cc = (tid & 15) * 4;
      const float* sp = src + (size_t)(k0 + kk) * ld + sc0 + cc;
      float4 v;
      if (nvalid == 64) v = *(const float4*)sp;
      else { v.x = (cc + 0 < nvalid) ? sp[0] : 0.f; v.y = (cc + 1 < nvalid) ? sp[1] : 0.f; v.z = (cc + 2 < nvalid) ? sp[2] : 0.f; v.w = (cc + 3 < nvalid) ? sp[3] : 0.f; }
      sm[kk * 65 + cc + 0] = v.x; sm[kk * 65 + cc + 1] = v.y; sm[kk * 65 + cc + 2] = v.z; sm[kk * 65 + cc + 3] = v.w;
    }
    __syncthreads();
#pragma unroll
    for (int i = 0; i < 2; ++i) {
      int q = tid + 256 * i; int nn = q >> 3, ks = q & 7;
      float f[8];
#pragma unroll
      for (int j = 0; j < 8; ++j) f[j] = sm[(ks * 8 + j) * 65 + nn];
      *(uint4*)(dst + (size_t)(n0 + nn) * K + k0 + ks * 8) = pack8(f);
    }
    __syncthreads();
  }
}

__device__ __forceinline__ void ph_filt(const P& p, int l, int bid, int nb, float* sm) {
  int tid = threadIdx.x; asm volatile("" : "+v"(tid));
  const float HY_MIN = -3.0701134573253945f, HY_MAX = -15.350567286626972f;
  int ntask = 256 + (l == 0 ? 16 : 0);
  float* zs = sm; float* h1 = sm + 544; float* h2 = sm + 544 + 1024;
  for (int task = bid; task < ntask; task += nb) {
    int n, t0; u16* K;
    if (task < 256) { n = 4096; t0 = task * 16; K = p.KF; } else { n = 256; t0 = (task - 256) * 16; K = p.KFC; }
    float inv_nm1 = 1.f / (float)(n - 1);
    for (int e = tid; e < 16 * 33; e += 256) {
      int tt = e / 33, f = e % 33; int t = t0 + tt; float val;
      if (f == 0) val = (float)t * inv_nm1;
      else {
        int bi = (f - 1) & 15;
        float band = 1e-4f + (float)bi * ((15.f - 1e-4f) / 15.f);
        float ang = (6.283185307179586f / (float)n) * (float)t * band;
        val = (f <= 16) ? cosf(ang) : -sinf(ang);
      }
      zs[e] = val;
    }
    __syncthreads();
    for (int e = tid; e < 1024; e += 256) {
      int tt = e >> 6, j = e & 63; float acc = p.hy_b1[l * 64 + j];
      for (int f = 0; f < 33; ++f) acc += zs[tt * 33 + f] * p.hy_w1[(l * 33 + f) * 64 + j];
      h1[e] = sinf(p.hy_freq[l * 64 + j] * acc);
    }
    __syncthreads();
    for (int e = tid; e < 1024; e += 256) {
      int tt = e >> 6, j = e & 63; float acc = p.hy_b2[l * 64 + j];
      for (int i = 0; i < 64; ++i) acc += h1[tt * 64 + i] * p.hy_w2[(l * 64 + i) * 64 + j];
      h2[e] = sinf(p.hy_freq[l * 64 + j] * acc);
    }
    __syncthreads();
    for (int r = 0; r < 8; ++r) {
      int col = tid + 256 * r; int o = col >> 10, side = (col >> 9) & 1, c = col & 511;
      float w[64];
#pragma unroll
      for (int i = 0; i < 64; ++i) w[i] = p.hy_w3[(size_t)(l * 64 + i) * 2048 + col];
      float delta = fabsf(HY_MIN + (HY_MAX - HY_MIN) * (float)c / 511.f);
      u16* Kc = K + (size_t)(o * 512 + c) * (2 * n);
      for (int tt = 0; tt < 16; ++tt) {
        float acc = 0;
#pragma unroll
        for (int i = 0; i < 64; ++i) acc += h2[tt * 64 + i] * w[i];
        int t = t0 + tt;
        float val = acc * __expf(-(float)t * inv_nm1 * delta);
        int idx;
        if (side == 0) idx = n - t; else { if (t == 0) { idx = 0; val = 0.f; } else idx = n + t; }
        Kc[idx] = f2bf(val);
      }
    }
    __syncthreads();
  }
}

#define LDSTR 72
template <int MODE>
__device__ __forceinline__ void gemm_tile(const P& p, int l, int mt, int nt, u16* sA, u16* sB, int noepi) {
  int tid = threadIdx.x; asm volatile("" : "+v"(tid)); const int wave = tid >> 6, lane = tid & 63;
  const int wm = wave >> 1, wn = wave & 1;
  const int KT = (MODE == 2) ? 2048 : 1024;
  const u16* Bsrc = (MODE == 0) ? p.WT + (size_t)(nt * 128) * 1024
                  : (MODE == 1) ? p.WT + (size_t)(3200 + nt * 128) * 1024
                                : p.WoT + (size_t)(nt * 128) * 2048;
  f32x16 acc[4][2];
#pragma unroll
  for (int a = 0; a < 4; ++a)
#pragma unroll
    for (int b = 0; b < 2; ++b)
#pragma unroll
      for (int r = 0; r < 16; ++r) acc[a][b][r] = 0.f;
  uint4 ra0, ra1, ra2, ra3, ra4, ra5, ra6, ra7, rb0, rb1, rb2, rb3;
  const int lrow = tid >> 3, lseg = tid & 7;
  const u16* Ab0 = p.HL + (size_t)(mt * 256 + lrow) * 1024 + lseg * 8;
  const u16* Ab1 = p.Y2 + (size_t)(mt * 256 + lrow) * 1024 + lseg * 8;
  const u16* Bb = Bsrc + (size_t)lrow * KT + lseg * 8;
#define GLOADS(K0)                                                                                  \
  {                                                                                                 \
    const u16* ap = (MODE == 2 && (K0) >= 1024) ? Ab1 + ((K0) - 1024) : Ab0 + (K0);                 \
    ra0 = *(const uint4*)(ap); ra1 = *(const uint4*)(ap + 32 * 1024);                               \
    ra2 = *(const uint4*)(ap + 64 * 1024); ra3 = *(const uint4*)(ap + 96 * 1024);                   \
    ra4 = *(const uint4*)(ap + 128 * 1024); ra5 = *(const uint4*)(ap + 160 * 1024);                 \
    ra6 = *(const uint4*)(ap + 192 * 1024); ra7 = *(const uint4*)(ap + 224 * 1024);                 \
    const u16* bp = Bb + (K0);                                                                      \
    rb0 = *(const uint4*)(bp); rb1 = *(const uint4*)(bp + (size_t)32 * KT);                         \
    rb2 = *(const uint4*)(bp + (size_t)64 * KT); rb3 = *(const uint4*)(bp + (size_t)96 * KT);       \
  }
  GLOADS(0)
#pragma unroll 1
  for (int k0 = 0; k0 < KT; k0 += 64) {
    *(uint4*)(sA + (lrow + 0) * LDSTR + lseg * 8) = ra0;   *(uint4*)(sA + (lrow + 32) * LDSTR + lseg * 8) = ra1;
    *(uint4*)(sA + (lrow + 64) * LDSTR + lseg * 8) = ra2;  *(uint4*)(sA + (lrow + 96) * LDSTR + lseg * 8) = ra3;
    *(uint4*)(sA + (lrow + 128) * LDSTR + lseg * 8) = ra4; *(uint4*)(sA + (lrow + 160) * LDSTR + lseg * 8) = ra5;
    *(uint4*)(sA + (lrow + 192) * LDSTR + lseg * 8) = ra6; *(uint4*)(sA + (lrow + 224) * LDSTR + lseg * 8) = ra7;
    *(uint4*)(sB + (lrow + 0) * LDSTR + lseg * 8) = rb0;   *(uint4*)(sB + (lrow + 32) * LDSTR + lseg * 8) = rb1;
    *(uint4*)(sB + (lrow + 64) * LDSTR + lseg * 8) = rb2;  *(uint4*)(sB + (lrow + 96) * LDSTR + lseg * 8) = rb3;
    __syncthreads();
    if (k0 + 64 < KT) GLOADS(k0 + 64)
#pragma unroll
    for (int ks = 0; ks < 4; ++ks) {
      bf16x8 fa[4], fb[2];
#pragma unroll
      for (int mi = 0; mi < 4; ++mi)
        fa[mi] = *(const bf16x8*)(sA + (wm * 128 + mi * 32 + (lane & 31)) * LDSTR + ks * 16 + (lane >> 5) * 8);
#pragma unroll
      for (int ni = 0; ni < 2; ++ni)
        fb[ni] = *(const bf16x8*)(sB + (wn * 64 + ni * 32 + (lane & 31)) * LDSTR + ks * 16 + (lane >> 5) * 8);
#pragma unroll
      for (int mi = 0; mi < 4; ++mi)
#pragma unroll
        for (int ni = 0; ni < 2; ++ni)
          acc[mi][ni] = __builtin_amdgcn_mfma_f32_32x32x16_bf16(fa[mi], fb[ni], acc[mi][ni], 0, 0, 0);
    }
    __syncthreads();
  }
  if (noepi) {
    float sacc = 0.f;
#pragma unroll
    for (int a = 0; a < 4; ++a)
#pragma unroll
      for (int b = 0; b < 2; ++b) sacc += acc[a][b][3];
    if (sacc == 1.2345e30f) p.DT[0] = sacc;
    return;
  }
  const int mj = (mt < 64) ? (mt >> 4) : 4;
  const int c31 = lane & 31, hh = lane >> 5;
  const int gcolA = nt * 128 + wn * 64 + c31, gcolB = gcolA + 32;
  if (MODE == 0 && nt == 24) {
    if (wn == 0 && c31 < 8) {
#pragma unroll
      for (int mi = 0; mi < 4; ++mi)
#pragma unroll
        for (int r = 0; r < 16; ++r) {
          const int R = mt * 256 + wm * 128 + mi * 32 + (r & 3) + 8 * (r >> 2) + 4 * hh;
          p.DT[(size_t)R * 8 + c31] = acc[mi][0][r];
        }
    }
    return;
  }
  if (MODE == 1 && nt < 16) {
    const bool sl = (gcolA >> 9) == 3;
#pragma unroll
    for (int mi = 0; mi < 4; ++mi)
#pragma unroll
      for (int ni = 0; ni < 2; ++ni)
#pragma unroll
        for (int g4 = 0; g4 < 4; ++g4) {
          float v0 = acc[mi][ni][4 * g4], v1 = acc[mi][ni][4 * g4 + 1], v2 = acc[mi][ni][4 * g4 + 2], v3 = acc[mi][ni][4 * g4 + 3];
          if (sl) { v0 = siluf(v0); v1 = siluf(v1); v2 = siluf(v2); v3 = siluf(v3); }
          int R0 = mt * 256 + wm * 128 + mi * 32 + 8 * g4 + 4 * hh;
          uint2 o; o.x = pack2(v0, v1); o.y = pack2(v2, v3);
          *(uint2*)(p.U + (size_t)(ni ? gcolB : gcolA) * NTOK + R0) = o;
        }
    return;
  }
  if (MODE != 2) {
    float lbA = 0.f, lbB = 0.f;
    int kindA = 0, kindB = 0;
    if (MODE == 0) {
      int pa_ = gcolA >> 9, pb_ = gcolB >> 9;
      kindA = (pa_ == 0) ? 1 : (pa_ == 1 || pa_ == 2) ? 2 : 0;
      kindB = (pb_ == 0) ? 1 : (pb_ == 1 || pb_ == 2) ? 2 : 0;
      if (l == 1) {
        if (kindA == 2) { int dir = pa_ - 1, ch = gcolA & 511; lbA = 1.f / (1.f + __expf(p.hg_lb[dir * 512 + ch] - p.hg_lb[(2 + dir) * 512 + ch])); }
        if (kindB == 2) { int dir = pb_ - 1, ch = gcolB & 511; lbB = 1.f / (1.f + __expf(p.hg_lb[dir * 512 + ch] - p.hg_lb[(2 + dir) * 512 + ch])); }
      }
    } else {
      int pa_ = gcolA >> 9, pb_ = gcolB >> 9;
      kindA = (pa_ == 3 || pa_ >= 5) ? 3 : 0;
      kindB = (pb_ == 3 || pb_ >= 5) ? 3 : 0;
    }
    u16* stg = sA + wave * (32 * 72);
    u16* dstbase = (MODE == 0) ? p.U + (size_t)(nt * 128 + wn * 64) : p.U + (size_t)NTOK * 2048 + (size_t)(nt * 128 - 2048 + wn * 64);
    const int ldo = (MODE == 0) ? UW : 2048;
#pragma unroll
    for (int mi = 0; mi < 4; ++mi) {
#pragma unroll
      for (int r = 0; r < 16; ++r) {
        const int rl = (r & 3) + 8 * (r >> 2) + 4 * hh;
        float va = acc[mi][0][r], vb = acc[mi][1][r];
        if (kindA == 1) va *= 0.08838834764831845f; else if (kindA == 2) va = (1.f - lbA) * __builtin_amdgcn_rcpf(1.f + __expf(va)); else if (kindA == 3) va = siluf(va);
        if (kindB == 1) vb *= 0.08838834764831845f; else if (kindB == 2) vb = (1.f - lbB) * __builtin_amdgcn_rcpf(1.f + __expf(vb)); else if (kindB == 3) vb = siluf(vb);
        stg[rl * 72 + c31] = f2bf(va);
        stg[rl * 72 + 32 + c31] = f2bf(vb);
      }
#pragma unroll
      for (int it = 0; it < 4; ++it) {
        const int rl = it * 8 + (lane >> 3), seg = lane & 7;
        uint4 v = *(const uint4*)(stg + rl * 72 + seg * 8);
        const int R = mt * 256 + wm * 128 + mi * 32 + rl;
        *(uint4*)(dstbase + (size_t)R * ldo + seg * 8) = v;
      }
    }
    return;
  }
  {
    float* stgf = (float*)sA + wave * (32 * 68);
    const int seg = lane & 15;
    const int gc0 = nt * 128 + wn * 64 + seg * 4;
    const float4 g4v = *(const float4*)(p.MOD + (size_t)(l * 5 + mj) * 3072 + 2048 + gc0);
#pragma unroll
    for (int mi = 0; mi < 4; ++mi) {
#pragma unroll
      for (int r = 0; r < 16; ++r) {
        const int rl = (r & 3) + 8 * (r >> 2) + 4 * hh;
        stgf[rl * 68 + c31] = acc[mi][0][r];
        stgf[rl * 68 + 32 + c31] = acc[mi][1][r];
      }
#pragma unroll
      for (int it = 0; it < 8; ++it) {
        const int rl = it * 4 + (lane >> 4);
        float4 v = *(const float4*)(stgf + rl * 68 + seg * 4);
        const int R = mt * 256 + wm * 128 + mi * 32 + rl;
        const float* src; float* dst;
        if (R < NLAT) { src = ((l == 0) ? p.x : (const float*)p.out) + (size_t)R * 1024 + gc0; dst = p.out + (size_t)R * 1024 + gc0; }
        else { int rc = R - NLAT; src = p.ctx + (size_t)rc * 1024 + gc0; dst = p.XC + (size_t)rc * 1024 + gc0; }
        float4 xv = *(const float4*)src;
        float4 o; o.x = xv.x + g4v.x * v.x; o.y = xv.y + g4v.y * v.y; o.z = xv.z + g4v.z * v.z; o.w = xv.w + g4v.w * v.w;
        *(float4*)dst = o;
      }
    }
  }
}

template <int MODE>
__device__ __forceinline__ void ph_gemm(const P& p, int l, int bid, int nb, u16* sm, int noepi = 0) {
  const int NT = (MODE == 0) ? 25 : (MODE == 1) ? 32 : 8;
  const int MT = (MODE == 2 && l == 1) ? 64 : 68;
  u16* sA = sm; u16* sB = sm + 256 * LDSTR;
  const int xcd = bid & 7, local = bid >> 3;
  const int mbase = MT >> 3, mextra = MT & 7;
  const int mper = mbase + (xcd < mextra ? 1 : 0);
  const int mstart = (xcd < mextra) ? xcd * (mbase + 1) : mextra * (mbase + 1) + (xcd - mextra) * mbase;
  const int total = mper * NT;
  const int fullb = NT >> 3, rem = NT & 7;
  for (int it = 0;; ++it) {
    int mt, nt;
    if (nb == 256) {
      int q = local + 32 * it;
      if (q >= total) break;
      int b, i, bw;
      if (q < fullb * mper * 8) { b = q / (mper * 8); i = q - b * mper * 8; bw = 8; }
      else { b = fullb; i = q - fullb * mper * 8; bw = rem; }
      int sub = i / (4 * bw);
      const int nsub = mper >> 2;
      int mt_off, nt_off;
      if (sub < nsub) { int j = i - sub * 4 * bw; mt_off = j & 3; nt_off = j >> 2; }
      else { int j = i - nsub * 4 * bw; sub = nsub; mt_off = 0; nt_off = j; }
      mt = mstart + sub * 4 + mt_off; nt = b * 8 + nt_off;
    } else {
      int t = bid + it * nb;
      if (t >= MT * NT) break;
      nt = t / MT; mt = t % MT;
    }
    __syncthreads();
    gemm_tile<MODE>(p, l, mt, nt, sA, sB, noepi);
  }
}

__device__ __forceinline__ void hg_task(const P& p, int l, int task, float* sm) {
  int tid = threadIdx.x; asm volatile("" : "+v"(tid)); const int wave = tid >> 6, lane = tid & 63;
  const int b = task >> 5, h = (task >> 3) & 3, es = task & 7;
  const int dg = lane & 15, el = lane >> 4;
  float* qs = sm; float* ks = sm + 4096; float* vs = sm + 8192; float* os = sm + 8192 + 512;
  for (int dir = 0; dir < 2; ++dir) {
    float S[8];
#pragma unroll
    for (int r = 0; r < 8; ++r) S[r] = 0.f;
    for (int chunk = 0; chunk < 136; ++chunk) {
#pragma unroll
      for (int i = 0; i < 2; ++i) {
        int q = tid + 256 * i; int pos = q >> 4, seg = q & 15;
        int R = pos2row_seq(b, chunk * 32 + pos, dir);
        const u16* up = p.U + (size_t)R * UW + h * 128 + seg * 8;
        uint4 qv = *(const uint4*)up;
        uint4 kv = *(const uint4*)(up + 512 + dir * 512);
        float f[8];
        unpack8(qv, f);
        *(float4*)(qs + pos * 128 + seg * 8) = make_float4(f[0], f[1], f[2], f[3]);
        *(float4*)(qs + pos * 128 + seg * 8 + 4) = make_float4(f[4], f[5], f[6], f[7]);
        unpack8(kv, f);
        *(float4*)(ks + pos * 128 + seg * 8) = make_float4(f[0], f[1], f[2], f[3]);
        *(float4*)(ks + pos * 128 + seg * 8 + 4) = make_float4(f[4], f[5], f[6], f[7]);
      }
      {
        int pos = tid >> 3, e2 = (tid & 7) * 2;
        int R = pos2row_seq(b, chunk * 32 + pos, dir);
        uint32_t w = *(const uint32_t*)(p.U + (size_t)R * UW + 1536 + h * 128 + es * 16 + e2);
        vs[pos * 16 + e2] = bflo(w); vs[pos * 16 + e2 + 1] = bfhi(w);
      }
      __syncthreads();
#pragma unroll 4
      for (int i = 0; i < 32; ++i) {
        float4 q0 = *(const float4*)(qs + i * 128 + dg * 8), q1 = *(const float4*)(qs + i * 128 + dg * 8 + 4);
        float4 k0 = *(const float4*)(ks + i * 128 + dg * 8), k1 = *(const float4*)(ks + i * 128 + dg * 8 + 4);
        float v = vs[i * 16 + wave * 4 + el];
        S[0] += k0.x * (v - S[0]); S[1] += k0.y * (v - S[1]); S[2] += k0.z * (v - S[2]); S[3] += k0.w * (v - S[3]);
        S[4] += k1.x * (v - S[4]); S[5] += k1.y * (v - S[5]); S[6] += k1.z * (v - S[6]); S[7] += k1.w * (v - S[7]);
        float o = q0.x * S[0] + q0.y * S[1] + q0.z * S[2] + q0.w * S[3] + q1.x * S[4] + q1.y * S[5] + q1.z * S[6] + q1.w * S[7];
        o += __shfl_xor(o, 1); o += __shfl_xor(o, 2); o += __shfl_xor(o, 4); o += __shfl_xor(o, 8);
        if (dg == 0) os[i * 16 + wave * 4 + el] = o;
      }
      __syncthreads();
      {
        int pos = tid >> 3, e2 = (tid & 7) * 2;
        int R = pos2row_seq(b, chunk * 32 + pos, dir);
        uint32_t* yp = (uint32_t*)(p.Y2 + (size_t)R * 1024 + h * 128 + es * 16 + e2);
        float o0 = os[pos * 16 + e2], o1 = os[pos * 16 + e2 + 1];
        if (dir == 1) { uint32_t w = *yp; o0 += bflo(w); o1 += bfhi(w); }
        *yp = pack2(o0, o1);
      }
    }
    __syncthreads();
  }
}

__device__ __forceinline__ void m2_task(const P& p, int l, int task, float* sm) {
  int tid = threadIdx.x; asm volatile("" : "+v"(tid)); const int wave = tid >> 6, lane = tid & 63;
  const int b = task >> 5, head = (task >> 2) & 7, ps = task & 3;
  const int g = head >> 2;
  const int dg = lane & 15, el = lane >> 4;
  float* Cs = sm; float* Bs = sm + 4096; float* xs = sm + 8192; float* os = sm + 8192 + 512;
  float* dts = sm + 8192 + 1024; float* decs = dts + 32;
  for (int dir = 0; dir < 2; ++dir) {
    const float* cw = p.m2_conv_w + (size_t)(l * 2 + dir) * 4 * 1024;
    const float* cb = p.m2_conv_b + (size_t)(l * 2 + dir) * 1024;
    const float dtb = p.m2_dt_bias[(l * 2 + dir) * 8 + head];
    const float Aneg = -__expf(p.m2_a_log[(l * 2 + dir) * 8 + head]);
    const float Dsk = p.m2_d[(l * 2 + dir) * 8 + head];
    float S[8];
#pragma unroll
    for (int r = 0; r < 8; ++r) S[r] = 0.f;
    for (int chunk = 0; chunk < 136; ++chunk) {
      const int pbase = chunk * 32;
      const int seg0 = (pbase < 256) ? 0 : 256;
#pragma unroll
      for (int i = 0; i < 2; ++i) {
        int q = tid + 256 * i; int pos = q >> 4, seg = q & 15;
        int pp = pbase + pos;
        int chB = 512 + g * 128 + seg * 8, chC = 768 + g * 128 + seg * 8;
        float aB[8], aC[8];
#pragma unroll
        for (int j = 0; j < 8; ++j) { aB[j] = cb[chB + j]; aC[j] = cb[chC + j]; }
#pragma unroll
        for (int tap = 0; tap < 4; ++tap) {
          int pt = pp - 3 + tap;
          if (pt >= seg0) {
            int R = pos2row_m2(b, pt, dir);
            const u16* up = p.U + (size_t)R * UW + 2048;
            uint4 bv = *(const uint4*)(up + chB);
            uint4 cv = *(const uint4*)(up + chC);
            float f[8];
            unpack8(bv, f);
#pragma unroll
            for (int j = 0; j < 8; ++j) aB[j] += cw[tap * 1024 + chB + j] * f[j];
            unpack8(cv, f);
#pragma unroll
            for (int j = 0; j < 8; ++j) aC[j] += cw[tap * 1024 + chC + j] * f[j];
          }
        }
#pragma unroll
        for (int j = 0; j < 8; ++j) { aB[j] = siluf(aB[j]); aC[j] = siluf(aC[j]); }
        *(float4*)(Bs + pos * 128 + seg * 8) = make_float4(aB[0], aB[1], aB[2], aB[3]);
        *(float4*)(Bs + pos * 128 + seg * 8 + 4) = make_float4(aB[4], aB[5], aB[6], aB[7]);
        *(float4*)(Cs + pos * 128 + seg * 8) = make_float4(aC[0], aC[1], aC[2], aC[3]);
        *(float4*)(Cs + pos * 128 + seg * 8 + 4) = make_float4(aC[4], aC[5], aC[6], aC[7]);
      }
      {
        int pos = tid >> 3, e2 = (tid & 7) * 2;
        int pp = pbase + pos;
        int ch = head * 64 + ps * 16 + e2;
        float a0 = cb[ch], a1 = cb[ch + 1];
#pragma unroll
        for (int tap = 0; tap < 4; ++tap) {
          int pt = pp - 3 + tap;
          if (pt >= seg0) {
            int R = pos2row_m2(b, pt, dir);
            uint32_t w = *(const uint32_t*)(p.U + (size_t)R * UW + 2048 + ch);
            a0 += cw[tap * 1024 + ch] * bflo(w); a1 += cw[tap * 1024 + ch + 1] * bfhi(w);
          }
        }
        xs[pos * 16 + e2] = siluf(a0); xs[pos * 16 + e2 + 1] = siluf(a1);
      }
      if (tid < 32) {
        int R = pos2row_m2(b, pbase + tid, dir);
        float dtv = softplusf(p.DT[(size_t)R * 8 + head] + dtb);
        dts[tid] = dtv; decs[tid] = __expf(dtv * Aneg);
      }
      __syncthreads();
#pragma unroll 4
      for (int i = 0; i < 32; ++i) {
        float4 q0 = *(const float4*)(Cs + i * 128 + dg * 8), q1 = *(const float4*)(Cs + i * 128 + dg * 8 + 4);
        float4 k0 = *(const float4*)(Bs + i * 128 + dg * 8), k1 = *(const float4*)(Bs + i * 128 + dg * 8 + 4);
        float xv = xs[i * 16 + wave * 4 + el];
        float a = decs[i]; float v = xv * dts[i];
        S[0] = a * S[0] + k0.x * v; S[1] = a * S[1] + k0.y * v; S[2] = a * S[2] + k0.z * v; S[3] = a * S[3] + k0.w * v;
        S[4] = a * S[4] + k1.x * v; S[5] = a * S[5] + k1.y * v; S[6] = a * S[6] + k1.z * v; S[7] = a * S[7] + k1.w * v;
        float o = q0.x * S[0] + q0.y * S[1] + q0.z * S[2] + q0.w * S[3] + q1.x * S[4] + q1.y * S[5] + q1.z * S[6] + q1.w * S[7];
        o += __shfl_xor(o, 1); o += __shfl_xor(o, 2); o += __shfl_xor(o, 4); o += __shfl_xor(o, 8);
        if (dg == 0) os[i * 16 + wave * 4 + el] = o + Dsk * xv;
      }
      __syncthreads();
      {
        int pos = tid >> 3, e2 = (tid & 7) * 2;
        int R = pos2row_m2(b, pbase + pos, dir);
        uint32_t* yp = (uint32_t*)(p.Y2 + (size_t)R * 1024 + 512 + head * 64 + ps * 16 + e2);
        float o0 = os[pos * 16 + e2], o1 = os[pos * 16 + e2 + 1];
        if (dir == 1) { uint32_t w = *yp; o0 += bflo(w); o1 += bfhi(w); }
        *yp = pack2(o0, o1);
      }
    }
    __syncthreads();
  }
}

#ifndef M2_MFMA
#define M2_MFMA 1
#endif
#define QS 136
#define TS 40
union FragU { bf16x8 v; uint32_t u[4]; uint2 d[2]; uint4 q; };
__device__ __forceinline__ bf16x8 cvt_frag(const f32x16& x, int s2) {
  FragU f;
  f.u[0] = pack2(x[8 * s2 + 0], x[8 * s2 + 1]); f.u[1] = pack2(x[8 * s2 + 2], x[8 * s2 + 3]);
  f.u[2] = pack2(x[8 * s2 + 4], x[8 * s2 + 5]); f.u[3] = pack2(x[8 * s2 + 6], x[8 * s2 + 7]);
  return f.v;
}
__device__ __forceinline__ bf16x8 ld_frag_perm(const u16* base) {
  FragU f; f.d[0] = *(const uint2*)base; f.d[1] = *(const uint2*)(base + 8); return f.v;
}

template <int PASS>
__device__ __forceinline__ void hg_mfma(const P& p, int l, int task, int blk, int dir0, unsigned char* smem) {
  int tid = threadIdx.x; asm volatile("" : "+v"(tid)); const int wave = tid >> 6, lane = tid & 63;
  const int r = lane & 31, hh = lane >> 5;
  const int b = task >> 2, h = task & 3;
  u16* ks = (u16*)smem;
  u16* qs = ks + 32 * QS;
  u16* kT = qs + 32 * QS;
  u16* vT = kT + 128 * TS;
  float* tot = (float*)(vT + 128 * TS);
  float* eg = tot + 256;
  const int dd = tid & 127, half = tid >> 7;
  for (int dir = (PASS == 0 ? dir0 : 0); dir < (PASS == 0 ? dir0 + 1 : 2); ++dir) {
    const int sbd = (PASS == 0) ? blk : ((blk == 0) ? 0 : (dir ? 5 - blk : blk));
    const int c0 = (sbd == 0) ? 0 : 8 + 32 * (sbd - 1);
    const int c1 = (sbd == 0) ? 8 : 8 + 32 * sbd;
    float gsum = 0.f;
    f32x16 S[4];
#pragma unroll
    for (int i = 0; i < 4; ++i)
#pragma unroll
      for (int q = 0; q < 16; ++q) S[i][q] = 0.f;
    if (PASS == 1) {
      for (int qb = 0; qb < sbd; ++qb) {
        const size_t sidx = (size_t)((task * 2 + dir) * 4 + qb);
        if (half == 0) eg[dd] = __expf(p.PS[sidx * 128 + dd]);
        __syncthreads();
        const float* sp = p.SSH + sidx * 16384 + (size_t)wave * 4096 + lane;
#pragma unroll
        for (int dt = 0; dt < 4; ++dt)
#pragma unroll
          for (int q4 = 0; q4 < 4; ++q4) {
            float4 e4 = *(const float4*)(eg + 32 * dt + 8 * q4 + 4 * hh);
            S[dt][4 * q4 + 0] = S[dt][4 * q4 + 0] * e4.x + sp[(dt * 16 + 4 * q4 + 0) * 64];
            S[dt][4 * q4 + 1] = S[dt][4 * q4 + 1] * e4.y + sp[(dt * 16 + 4 * q4 + 1) * 64];
            S[dt][4 * q4 + 2] = S[dt][4 * q4 + 2] * e4.z + sp[(dt * 16 + 4 * q4 + 2) * 64];
            S[dt][4 * q4 + 3] = S[dt][4 * q4 + 3] * e4.w + sp[(dt * 16 + 4 * q4 + 3) * 64];
          }
        __syncthreads();
      }
    }
    uint4 pq0, pq1, pk0, pk1, pv0, pv1;
#define HG_PREFETCH(CH)                                                                     \
    {                                                                                       \
      int pos0 = tid >> 4, seg = tid & 15;                                                  \
      int R0 = pos2row_seq(b, (CH) * 32 + pos0, dir), R1 = pos2row_seq(b, (CH) * 32 + pos0 + 16, dir); \
      const u16* u0 = p.U + (size_t)R0 * UW + h * 128 + seg * 8;                            \
      const u16* u1 = p.U + (size_t)R1 * UW + h * 128 + seg * 8;                            \
      pq0 = *(const uint4*)u0; pq1 = *(const uint4*)u1;                                     \
      pk0 = *(const uint4*)(u0 + 512 + dir * 512); pk1 = *(const uint4*)(u1 + 512 + dir * 512); \
      pv0 = *(const uint4*)(u0 + 1536); pv1 = *(const uint4*)(u1 + 1536);                   \
    }
    HG_PREFETCH(c0)
#pragma unroll 1
    for (int chunk = c0; chunk < c1; ++chunk) {
      {
        int pos0 = tid >> 4, seg = tid & 15;
        *(uint4*)(qs + pos0 * QS + seg * 8) = pq0; *(uint4*)(qs + (pos0 + 16) * QS + seg * 8) = pq1;
        *(uint4*)(ks + pos0 * QS + seg * 8) = pk0; *(uint4*)(ks + (pos0 + 16) * QS + seg * 8) = pk1;
        FragU f0, f1; f0.q = pv0; f1.q = pv1;
#pragma unroll
        for (int j = 0; j < 4; ++j) {
          vT[(seg * 8 + 2 * j) * TS + pos0] = (u16)(f0.u[j] & 0xffffu); vT[(seg * 8 + 2 * j + 1) * TS + pos0] = (u16)(f0.u[j] >> 16);
          vT[(seg * 8 + 2 * j) * TS + pos0 + 16] = (u16)(f1.u[j] & 0xffffu); vT[(seg * 8 + 2 * j + 1) * TS + pos0 + 16] = (u16)(f1.u[j] >> 16);
        }
      }
      __syncthreads();
      if (chunk + 1 < c1) HG_PREFETCH(chunk + 1)
      const int Rout = pos2row_seq(b, chunk * 32 + r, dir);
      u16* yrow = p.Y2 + (size_t)Rout * 1024 + h * 128 + wave * 32 + 4 * hh;
      uint2 yold[4];
      if (PASS == 1 && dir == 1) {
#pragma unroll
        for (int q4 = 0; q4 < 4; ++q4) yold[q4] = *(const uint2*)(yrow + 8 * q4);
      }
      float gl[16];
      {
        float run = 0.f;
#pragma unroll
        for (int i = 0; i < 16; ++i) {
          float kkv = bf2f(ks[(half * 16 + i) * QS + dd]);
          run += __logf(fmaxf(1.f - kkv, 1e-6f));
          gl[i] = run;
        }
        tot[half * 128 + dd] = run;
      }
      __syncthreads();
      {
        const float t0 = tot[dd], t1 = tot[128 + dd];
        const float off = half ? t0 : 0.f;
        const float g31 = t0 + t1;
        float k2[16];
#pragma unroll
        for (int i = 0; i < 16; ++i) {
          const int pos = half * 16 + i;
          const float g = gl[i] + off;
          const float kkv = bf2f(ks[pos * QS + dd]);
          const float qv = bf2f(qs[pos * QS + dd]);
          qs[pos * QS + dd] = f2bf(qv * __expf(g));
          ks[pos * QS + dd] = f2bf(kkv * __expf(fminf(-g, 60.f)));
          k2[i] = kkv * __expf(g31 - g);
        }
        *(uint4*)(kT + dd * TS + half * 16) = pack8(k2);
        *(uint4*)(kT + dd * TS + half * 16 + 8) = pack8(k2 + 8);
        if (half == 0) eg[dd] = __expf(g31);
        gsum += g31;
      }
      __syncthreads();
      f32x16 O;
      if (PASS == 1) {
      f32x16 att;
#pragma unroll
      for (int q = 0; q < 16; ++q) att[q] = 0.f;
#pragma unroll
      for (int k8 = 0; k8 < 8; ++k8) {
        bf16x8 A = *(const bf16x8*)(ks + r * QS + 16 * k8 + 8 * hh);
        bf16x8 B = *(const bf16x8*)(qs + r * QS + 16 * k8 + 8 * hh);
        att = __builtin_amdgcn_mfma_f32_32x32x16_bf16(A, B, att, 0, 0, 0);
      }
#pragma unroll
      for (int q = 0; q < 16; ++q) {
        int sidx = (q & 3) + 8 * (q >> 2) + 4 * hh;
        if (sidx > r) att[q] = 0.f;
      }
#pragma unroll
      for (int q = 0; q < 16; ++q) O[q] = 0.f;
#pragma unroll
      for (int dt = 0; dt < 4; ++dt)
#pragma unroll
        for (int s2 = 0; s2 < 2; ++s2) {
          bf16x8 A = cvt_frag(S[dt], s2);
          bf16x8 B = ld_frag_perm(qs + r * QS + 32 * dt + 16 * s2 + 4 * hh);
          O = __builtin_amdgcn_mfma_f32_32x32x16_bf16(A, B, O, 0, 0, 0);
        }
#pragma unroll
      for (int s2 = 0; s2 < 2; ++s2) {
        bf16x8 A = ld_frag_perm(vT + (32 * wave + r) * TS + 16 * s2 + 4 * hh);
        bf16x8 B = cvt_frag(att, s2);
        O = __builtin_amdgcn_mfma_f32_32x32x16_bf16(A, B, O, 0, 0, 0);
      }
      }
#pragma unroll
      for (int dt = 0; dt < 4; ++dt) {
#pragma unroll
        for (int q4 = 0; q4 < 4; ++q4) {
          float4 e4 = *(const float4*)(eg + 32 * dt + 8 * q4 + 4 * hh);
          S[dt][4 * q4 + 0] *= e4.x; S[dt][4 * q4 + 1] *= e4.y; S[dt][4 * q4 + 2] *= e4.z; S[dt][4 * q4 + 3] *= e4.w;
        }
#pragma unroll
        for (int s2 = 0; s2 < 2; ++s2) {
          bf16x8 A = *(const bf16x8*)(kT + (32 * dt + r) * TS + 16 * s2 + 8 * hh);
          bf16x8 B = *(const bf16x8*)(vT + (32 * wave + r) * TS + 16 * s2 + 8 * hh);
          S[dt] = __builtin_amdgcn_mfma_f32_32x32x16_bf16(A, B, S[dt], 0, 0, 0);
        }
      }
      if (PASS == 1) {
#pragma unroll
      for (int q4 = 0; q4 < 4; ++q4) {
        float o0 = O[4 * q4], o1 = O[4 * q4 + 1], o2 = O[4 * q4 + 2], o3 = O[4 * q4 + 3];
        if (dir == 1) { o0 += bflo(yold[q4].x); o1 += bfhi(yold[q4].x); o2 += bflo(yold[q4].y); o3 += bfhi(yold[q4].y); }
        uint2 ov; ov.x = pack2(o0, o1); ov.y = pack2(o2, o3);
        *(uint2*)(yrow + 8 * q4) = ov;
      }
      }
      __syncthreads();
    }
    if (PASS == 0) {
      const size_t sidx = (size_t)((task * 2 + dir) * 4 + sbd);
      if (half == 0) p.PS[sidx * 128 + dd] = gsum;
      float* sp = p.SSH + sidx * 16384 + (size_t)wave * 4096 + lane;
#pragma unroll
      for (int dt = 0; dt < 4; ++dt)
#pragma unroll
        for (int q = 0; q < 16; ++q) sp[(dt * 16 + q) * 64] = S[dt][q];
    }
    __syncthreads();
  }
}

#if M2_MFMA
#define M2_NTASK 16
template <int PASS>
__device__ __forceinline__ void m2_mfma(const P& p, int l, int task, int blk, int dir0, unsigned char* smem) {
  int tid = threadIdx.x; asm volatile("" : "+v"(tid)); const int wave = tid >> 6, lane = tid & 63;
  const int r = lane & 31, hh = lane >> 5;
  const int b = task >> 2, g = (task >> 1) & 1, hp = task & 1;
  const int hq = wave >> 1, ph = wave & 1;
  const int head = 4 * g + 2 * hp + hq;
  u16* Bm = (u16*)smem;
  u16* Cm = Bm + 32 * QS;
  u16* BmT = Cm + 32 * QS;
  u16* xsT = BmT + 128 * TS;
  float* Gs = (float*)(xsT + 128 * TS);
  float* dts = Gs + 64;
  float* wl = dts + 64;
  const int cp = (lane < 48) ? lane : 47;
  const bool act = lane < 48;
  const int chW = (cp < 16) ? ((4 * g + 2 * hp) * 64 + cp * 8) : (cp < 32) ? (512 + g * 128 + (cp - 16) * 8) : (768 + g * 128 + (cp - 32) * 8);
  const int chU = 2048 + chW;
  float* SSM = (float*)p.KF;
  for (int dir = (PASS == 0 ? dir0 : 0); dir < (PASS == 0 ? dir0 + 1 : 2); ++dir) {
    const int sbd = (PASS == 0) ? blk : ((blk == 0) ? 0 : (dir ? 9 - blk : blk));
    const int c0 = (sbd == 0) ? 0 : 8 + 16 * (sbd - 1);
    const int c1 = (sbd == 0) ? 8 : 8 + 16 * sbd;
    float lsum = 0.f;
    const float* cw = p.m2_conv_w + (size_t)(l * 2 + dir) * 4 * 1024;
    const float* cb = p.m2_conv_b + (size_t)(l * 2 + dir) * 1024;
    if (wave == 0) {
#pragma unroll
      for (int j = 0; j < 8; ++j) {
        wl[(4 * 8 + j) * 64 + lane] = cb[chW + j];
#pragma unroll
        for (int tap = 0; tap < 4; ++tap) wl[(tap * 8 + j) * 64 + lane] = cw[tap * 1024 + chW + j];
      }
    }
    __syncthreads();
    const int hd_t = 4 * g + 2 * hp + ((tid >> 5) & 1);
    const float dtb = p.m2_dt_bias[(l * 2 + dir) * 8 + hd_t];
    const float Aneg_t = -__expf(p.m2_a_log[(l * 2 + dir) * 8 + hd_t]);
    const float Dsk = p.m2_d[(l * 2 + dir) * 8 + head];
    f32x16 S[4];
#pragma unroll
    for (int i = 0; i < 4; ++i)
#pragma unroll
      for (int q = 0; q < 16; ++q) S[i][q] = 0.f;
    if (PASS == 1) {
      for (int qb = 0; qb < sbd; ++qb) {
        const size_t sidx = (size_t)((task * 2 + dir) * 8 + qb);
        const float a = __expf(p.PA[sidx * 4 + wave]);
        const float* sp = SSM + sidx * 16384 + (size_t)wave * 4096 + lane;
#pragma unroll
        for (int nt = 0; nt < 4; ++nt)
#pragma unroll
          for (int q = 0; q < 16; ++q) S[nt][q] = S[nt][q] * a + sp[(nt * 16 + q) * 64];
      }
    }
    uint4 raw0, raw1, raw2, raw3, raw4, raw5, raw6, raw7, raw8, raw9, raw10;
    float dtraw = 0.f;
#define M2_LD1(RW, I, CH)                                                                  \
    {                                                                                      \
      int pt = (CH) * 32 + wave * 8 + (I) - 3;                                             \
      int sg0 = ((CH) * 32 < 256) ? 0 : 256;                                               \
      if (pt >= sg0) { int Rr = pos2row_m2(b, pt, dir); RW = *(const uint4*)(p.U + (size_t)Rr * UW + chU); } \
      else RW = make_uint4(0u, 0u, 0u, 0u);                                                \
    }
#define M2_PREFETCH(CH)                                                                    \
    M2_LD1(raw0, 0, CH) M2_LD1(raw1, 1, CH) M2_LD1(raw2, 2, CH) M2_LD1(raw3, 3, CH) M2_LD1(raw4, 4, CH) M2_LD1(raw5, 5, CH) \
    M2_LD1(raw6, 6, CH) M2_LD1(raw7, 7, CH) M2_LD1(raw8, 8, CH) M2_LD1(raw9, 9, CH) M2_LD1(raw10, 10, CH)            \
    if (tid < 64) { int Rr = pos2row_m2(b, (CH) * 32 + (tid & 31), dir); dtraw = p.DT[(size_t)Rr * 8 + hd_t]; }
    M2_PREFETCH(c0)
#pragma unroll 1
    for (int chunk = c0; chunk < c1; ++chunk) {
      {
#define M2_RAWF(RW, J) (((J) & 1) ? bfhi((RW)) : bflo((RW)))
#define M2_CH(J, C0, C1, C2, C3, C4, C5, C6, C7, C8, C9, C10)                               \
        {                                                                                  \
          const float q0 = wl[(0 * 8 + (J)) * 64 + lane], q1 = wl[(1 * 8 + (J)) * 64 + lane]; \
          const float q2 = wl[(2 * 8 + (J)) * 64 + lane], q3 = wl[(3 * 8 + (J)) * 64 + lane]; \
          const float qb = wl[(4 * 8 + (J)) * 64 + lane];                                  \
          const float v0 = M2_RAWF(C0, J), v1 = M2_RAWF(C1, J), v2 = M2_RAWF(C2, J), v3 = M2_RAWF(C3, J); \
          const float v4 = M2_RAWF(C4, J), v5 = M2_RAWF(C5, J), v6 = M2_RAWF(C6, J), v7 = M2_RAWF(C7, J); \
          const float v8 = M2_RAWF(C8, J), v9 = M2_RAWF(C9, J), v10 = M2_RAWF(C10, J);      \
          float o[8];                                                                      \
          o[0] = siluf(qb + q0 * v0 + q1 * v1 + q2 * v2 + q3 * v3);                        \
          o[1] = siluf(qb + q0 * v1 + q1 * v2 + q2 * v3 + q3 * v4);                        \
          o[2] = siluf(qb + q0 * v2 + q1 * v3 + q2 * v4 + q3 * v5);                        \
          o[3] = siluf(qb + q0 * v3 + q1 * v4 + q2 * v5 + q3 * v6);                        \
          o[4] = siluf(qb + q0 * v4 + q1 * v5 + q2 * v6 + q3 * v7);                        \
          o[5] = siluf(qb + q0 * v5 + q1 * v6 + q2 * v7 + q3 * v8);                        \
          o[6] = siluf(qb + q0 * v6 + q1 * v7 + q2 * v8 + q3 * v9);                        \
          o[7] = siluf(qb + q0 * v7 + q1 * v8 + q2 * v9 + q3 * v10);                       \
          if (act) {                                                                       \
            if (cp < 16) {                                                                 \
              *(uint4*)(xsT + (cp * 8 + (J)) * TS + wave * 8) = pack8(o);                  \
            } else if (cp < 32) {                                                          \
              *(uint4*)(BmT + ((cp - 16) * 8 + (J)) * TS + wave * 8) = pack8(o);           \
              _Pragma("unroll") for (int i = 0; i < 8; ++i) Bm[(wave * 8 + i) * QS + (cp - 16) * 8 + (J)] = f2bf(o[i]); \
            } else {                                                                       \
              _Pragma("unroll") for (int i = 0; i < 8; ++i) Cm[(wave * 8 + i) * QS + (cp - 32) * 8 + (J)] = f2bf(o[i]); \
            }                                                                              \
          }                                                                                \
        }
        M2_CH(0, raw0.x, raw1.x, raw2.x, raw3.x, raw4.x, raw5.x, raw6.x, raw7.x, raw8.x, raw9.x, raw10.x)
        M2_CH(1, raw0.x, raw1.x, raw2.x, raw3.x, raw4.x, raw5.x, raw6.x, raw7.x, raw8.x, raw9.x, raw10.x)
        M2_CH(2, raw0.y, raw1.y, raw2.y, raw3.y, raw4.y, raw5.y, raw6.y, raw7.y, raw8.y, raw9.y, raw10.y)
        M2_CH(3, raw0.y, raw1.y, raw2.y, raw3.y, raw4.y, raw5.y, raw6.y, raw7.y, raw8.y, raw9.y, raw10.y)
        M2_CH(4, raw0.z, raw1.z, raw2.z, raw3.z, raw4.z, raw5.z, raw6.z, raw7.z, raw8.z, raw9.z, raw10.z)
        M2_CH(5, raw0.z, raw1.z, raw2.z, raw3.z, raw4.z, raw5.z, raw6.z, raw7.z, raw8.z, raw9.z, raw10.z)
        M2_CH(6, raw0.w, raw1.w, raw2.w, raw3.w, raw4.w, raw5.w, raw6.w, raw7.w, raw8.w, raw9.w, raw10.w)
        M2_CH(7, raw0.w, raw1.w, raw2.w, raw3.w, raw4.w, raw5.w, raw6.w, raw7.w, raw8.w, raw9.w, raw10.w)
      }
      if (tid < 64) {
        float dtv = softplusf(dtraw + dtb);
        float run = dtv * Aneg_t;
#pragma unroll
        for (int o = 1; o < 32; o <<= 1) { float n = __shfl_up(run, o, 32); if ((tid & 31) >= o) run += n; }
        Gs[tid] = run; dts[tid] = dtv;
      }
      __syncthreads();
      if (chunk + 1 < c1) { M2_PREFETCH(chunk + 1) }
      const int Rout = pos2row_m2(b, chunk * 32 + r, dir);
      u16* yrow = p.Y2 + (size_t)Rout * 1024 + 512 + head * 64 + 32 * ph + 4 * hh;
      uint2 yold[4];
      if (PASS == 1 && dir == 1) {
#pragma unroll
        for (int i = 0; i < 4; ++i) yold[i] = *(const uint2*)(yrow + 8 * i);
      }
      const float* Gw = Gs + hq * 32; const float* dw = dts + hq * 32;
      const float Gt = Gw[r], G31 = Gw[31];
      lsum += G31;
      const u16* xw = xsT + (hq * 64 + ph * 32) * TS;
      f32x16 O0;
      if (PASS == 1) {
      f32x16 att;
#pragma unroll
      for (int q = 0; q < 16; ++q) att[q] = 0.f;
#pragma unroll
      for (int k8 = 0; k8 < 8; ++k8) {
        bf16x8 A = *(const bf16x8*)(Bm + r * QS + 16 * k8 + 8 * hh);
        bf16x8 B = *(const bf16x8*)(Cm + r * QS + 16 * k8 + 8 * hh);
        att = __builtin_amdgcn_mfma_f32_32x32x16_bf16(A, B, att, 0, 0, 0);
      }
#pragma unroll
      for (int q4 = 0; q4 < 4; ++q4) {
        float4 gs4 = *(const float4*)(Gw + 8 * q4 + 4 * hh);
        float4 dt4 = *(const float4*)(dw + 8 * q4 + 4 * hh);
        int s0 = 8 * q4 + 4 * hh;
        att[4 * q4 + 0] = (s0 + 0 <= r) ? att[4 * q4 + 0] * __expf(Gt - gs4.x) * dt4.x : 0.f;
        att[4 * q4 + 1] = (s0 + 1 <= r) ? att[4 * q4 + 1] * __expf(Gt - gs4.y) * dt4.y : 0.f;
        att[4 * q4 + 2] = (s0 + 2 <= r) ? att[4 * q4 + 2] * __expf(Gt - gs4.z) * dt4.z : 0.f;
        att[4 * q4 + 3] = (s0 + 3 <= r) ? att[4 * q4 + 3] * __expf(Gt - gs4.w) * dt4.w : 0.f;
      }
#pragma unroll
      for (int q = 0; q < 16; ++q) O0[q] = 0.f;
#pragma unroll
      for (int nt = 0; nt < 4; ++nt)
#pragma unroll
        for (int s2 = 0; s2 < 2; ++s2) {
          bf16x8 B = ld_frag_perm(Cm + r * QS + 32 * nt + 16 * s2 + 4 * hh);
          O0 = __builtin_amdgcn_mfma_f32_32x32x16_bf16(cvt_frag(S[nt], s2), B, O0, 0, 0, 0);
        }
      {
        const float eGt = __expf(Gt);
#pragma unroll
        for (int q = 0; q < 16; ++q) O0[q] *= eGt;
      }
#pragma unroll
      for (int s2 = 0; s2 < 2; ++s2) {
        bf16x8 B = cvt_frag(att, s2);
        O0 = __builtin_amdgcn_mfma_f32_32x32x16_bf16(ld_frag_perm(xw + r * TS + 16 * s2 + 4 * hh), B, O0, 0, 0, 0);
      }
#pragma unroll
      for (int q = 0; q < 16; ++q) {
        int pp = (q & 3) + 8 * (q >> 2) + 4 * hh;
        O0[q] += Dsk * bf2f(xw[pp * TS + r]);
      }
      }
      {
        const float eG31 = __expf(G31);
#pragma unroll
        for (int nt = 0; nt < 4; ++nt)
#pragma unroll
          for (int q = 0; q < 16; ++q) S[nt][q] *= eG31;
#pragma unroll
        for (int s2 = 0; s2 < 2; ++s2) {
          float ws[8];
          {
            float4 ga = *(const float4*)(Gw + 16 * s2 + 8 * hh), gb = *(const float4*)(Gw + 16 * s2 + 8 * hh + 4);
            float4 da = *(const float4*)(dw + 16 * s2 + 8 * hh), db = *(const float4*)(dw + 16 * s2 + 8 * hh + 4);
            ws[0] = da.x * __expf(G31 - ga.x); ws[1] = da.y * __expf(G31 - ga.y); ws[2] = da.z * __expf(G31 - ga.z); ws[3] = da.w * __expf(G31 - ga.w);
            ws[4] = db.x * __expf(G31 - gb.x); ws[5] = db.y * __expf(G31 - gb.y); ws[6] = db.z * __expf(G31 - gb.z); ws[7] = db.w * __expf(G31 - gb.w);
          }
          bf16x8 Bf0;
          {
            float f[8]; unpack8(*(const uint4*)(xw + r * TS + 16 * s2 + 8 * hh), f);
#pragma unroll
            for (int j = 0; j < 8; ++j) f[j] *= ws[j];
            FragU u; u.q = pack8(f); Bf0 = u.v;
          }
#pragma unroll
          for (int nt = 0; nt < 4; ++nt) {
            bf16x8 A = *(const bf16x8*)(BmT + (32 * nt + r) * TS + 16 * s2 + 8 * hh);
            S[nt] = __builtin_amdgcn_mfma_f32_32x32x16_bf16(A, Bf0, S[nt], 0, 0, 0);
          }
        }
      }
      if (PASS == 1) {
#pragma unroll
      for (int q4 = 0; q4 < 4; ++q4) {
        float o0 = O0[4 * q4], o1 = O0[4 * q4 + 1], o2 = O0[4 * q4 + 2], o3 = O0[4 * q4 + 3];
        if (dir == 1) { o0 += bflo(yold[q4].x); o1 += bfhi(yold[q4].x); o2 += bflo(yold[q4].y); o3 += bfhi(yold[q4].y); }
        uint2 ov; ov.x = pack2(o0, o1); ov.y = pack2(o2, o3);
        *(uint2*)(yrow + 8 * q4) = ov;
      }
      }
      __syncthreads();
    }
    if (PASS == 0) {
      const size_t sidx = (size_t)((task * 2 + dir) * 8 + sbd);
      if (lane == 0) p.PA[sidx * 4 + wave] = lsum;
      float* sp = SSM + sidx * 16384 + (size_t)wave * 4096 + lane;
#pragma unroll
      for (int nt = 0; nt < 4; ++nt)
#pragma unroll
        for (int q = 0; q < 16; ++q) sp[(nt * 16 + q) * 64] = S[nt][q];
    }
    __syncthreads();
  }
}
#endif
__device__ __forceinline__ void ph_mixA0(const P& p, int l, int bid, int nb, unsigned char* sm) {
  for (int i = 0;; ++i) {
    int t;
    if (nb == 256) {
      if (bid < 128) { if (i >= 1) break; t = bid; }
      else { if (i >= 2) break; t = 128 + (bid - 128) + 128 * i; }
    } else { t = bid + i * nb; if (t >= 384) break; }
    if (t < 128) hg_mfma<0>(p, l, t >> 3, (t >> 1) & 3, t & 1, sm);
    else { int u = t - 128; m2_mfma<0>(p, l, u >> 4, (u >> 1) & 7, u & 1, sm); }
    __syncthreads();
  }
}
__device__ __forceinline__ void ph_mixA1(const P& p, int l, int bid, int nb, unsigned char* sm) {
  for (int t = bid; t < 80 + 144; t += nb) {
    if (t < 80) hg_mfma<1>(p, l, t / 5, t % 5, 0, sm);
    else { int u = t - 80; m2_mfma<1>(p, l, u / 9, u % 9, 0, sm); }
    __syncthreads();
  }
}

template <int PASS>
__device__ __forceinline__ void rg_task(const P& p, int l, int task, float* sm) {
  int tid = threadIdx.x; asm volatile("" : "+v"(tid));
  const int wave = tid >> 6, lane = tid & 63;
  const int b = task / 136, rem = task % 136, head = rem / 17, sb = rem % 17;
  float* xc = sm;
  float* pa = sm + 2048;
  float* pb = sm + 4096;
  u16* xcb = (u16*)(sm + 6144);
  u16* WTl = xcb + 32 * 72;
  const int j = tid & 63;
  const int spos = tid >> 3, sseg = tid & 7;
  const int sch = head * 64 + sseg * 8;
  const u16* UB2 = p.U + (size_t)NTOK * 2048;
  for (int dir = 0; dir < 2; ++dir) {
    const int ld = l * 2 + dir;
    {
      const float* wa = p.rg_wa + (size_t)(ld * 8 + head) * 4096;
      const float* wx = p.rg_wx + (size_t)(ld * 8 + head) * 4096;
#pragma unroll
      for (int it = 0; it < 4; ++it) {
        int i = (tid >> 4) + 16 * it, j4 = (tid & 15) * 4;
        float4 va = *(const float4*)(wa + i * 64 + j4);
        float4 vx = *(const float4*)(wx + i * 64 + j4);
        WTl[(j4 + 0) * 72 + i] = f2bf(va.x); WTl[(j4 + 1) * 72 + i] = f2bf(va.y);
        WTl[(j4 + 2) * 72 + i] = f2bf(va.z); WTl[(j4 + 3) * 72 + i] = f2bf(va.w);
        WTl[(64 + j4 + 0) * 72 + i] = f2bf(vx.x); WTl[(64 + j4 + 1) * 72 + i] = f2bf(vx.y);
        WTl[(64 + j4 + 2) * 72 + i] = f2bf(vx.z); WTl[(64 + j4 + 3) * 72 + i] = f2bf(vx.w);
      }
    }
    float wcv[4][8], bcv[8];
#pragma unroll
    for (int jj = 0; jj < 8; ++jj) {
      bcv[jj] = p.rg_conv_b[(size_t)ld * 512 + sch + jj];
#pragma unroll
      for (int tap = 0; tap < 4; ++tap) wcv[tap][jj] = p.rg_conv_w[((size_t)ld * 4 + tap) * 512 + sch + jj];
    }
    const int chg = head * 64 + j;
    const float g_ba = p.rg_ba[ld * 512 + chg], g_bx = p.rg_bx[ld * 512 + chg];
    const float g_sp = -8.0f * softplusf(-p.rg_lam[ld * 512 + chg]);
    const int sbd = (PASS == 0) ? sb : (dir ? (sb == 0 ? 0 : 17 - sb) : sb);
    float hcarry = 0.f, aprod = 1.f;
    if (PASS == 1 && tid < 64) {
      for (int q = 0; q < sbd; ++q) {
        const float* sp = p.SUM + ((((size_t)b * 2 + dir) * 17 + q) * 512 + head * 64 + tid) * 2;
        hcarry = sp[0] * hcarry + sp[1];
      }
    }
    uint4 xr0, xr1, xr2, xr3;
#define RG_LD1(XR, TAP, CH)                                                               \
    {                                                                                     \
      int pt = (CH) * 32 + spos - 3 + (TAP);                                              \
      int sg0 = ((CH) * 32 < 256) ? 0 : 256;                                              \
      if (pt >= sg0) { int Rr = pos2row_seq(b, pt, dir); XR = *(const uint4*)(UB2 + (size_t)Rr * 2048 + sch); } \
      else XR = make_uint4(0u, 0u, 0u, 0u);                                               \
    }
#define RG_PREFETCH(CH) RG_LD1(xr0, 0, CH) RG_LD1(xr1, 1, CH) RG_LD1(xr2, 2, CH) RG_LD1(xr3, 3, CH)
    RG_PREFETCH(sbd * 8)
#pragma unroll 1
    for (int chunk = sbd * 8; chunk < sbd * 8 + 8; ++chunk) {
      const int pbase = chunk * 32;
      {
        float a[8], f[8];
#pragma unroll
        for (int jj = 0; jj < 8; ++jj) a[jj] = bcv[jj];
        unpack8(xr0, f);
#pragma unroll
        for (int jj = 0; jj < 8; ++jj) a[jj] += wcv[0][jj] * f[jj];
        unpack8(xr1, f);
#pragma unroll
        for (int jj = 0; jj < 8; ++jj) a[jj] += wcv[1][jj] * f[jj];
        unpack8(xr2, f);
#pragma unroll
        for (int jj = 0; jj < 8; ++jj) a[jj] += wcv[2][jj] * f[jj];
        unpack8(xr3, f);
#pragma unroll
        for (int jj = 0; jj < 8; ++jj) a[jj] += wcv[3][jj] * f[jj];
        *(float4*)(xc + spos * 64 + sseg * 8) = make_float4(a[0], a[1], a[2], a[3]);
        *(float4*)(xc + spos * 64 + sseg * 8 + 4) = make_float4(a[4], a[5], a[6], a[7]);
        *(uint4*)(xcb + spos * 72 + sseg * 8) = pack8(a);
      }
      __syncthreads();
      if (chunk + 1 < sbd * 8 + 8) { RG_PREFETCH(chunk + 1) }
      const int Rout = pos2row_seq(b, pbase + spos, dir);
      uint4* yp = (uint4*)(p.HL + (size_t)Rout * 1024 + 512 + sch);
      uint4 prev, gv;
      if (PASS == 1 && dir == 1) { prev = *yp; gv = *(const uint4*)(UB2 + (size_t)Rout * 2048 + 512 + sch); }
      {
        const int r = lane & 31, hh = lane >> 5;
        f32x16 acc;
#pragma unroll
        for (int q = 0; q < 16; ++q) acc[q] = 0.f;
#pragma unroll
        for (int ks = 0; ks < 4; ++ks) {
          bf16x8 A = *(const bf16x8*)(xcb + r * 72 + 16 * ks + 8 * hh);
          bf16x8 B = *(const bf16x8*)(WTl + (32 * wave + r) * 72 + 16 * ks + 8 * hh);
          acc = __builtin_amdgcn_mfma_f32_32x32x16_bf16(A, B, acc, 0, 0, 0);
        }
        float* dstp = (wave < 2) ? pa : pb;
        const int jc = (wave & 1) * 32 + r;
#pragma unroll
        for (int q = 0; q < 16; ++q) dstp[((q & 3) + 8 * (q >> 2) + 4 * hh) * 64 + jc] = acc[q];
      }
      __syncthreads();
#pragma unroll
      for (int i = 0; i < 8; ++i) {
        int e = tid + 256 * i;
        float r = sigmf(pa[e] + g_ba);
        float gi = sigmf(pb[e] + g_bx);
        float la = g_sp * r;
        float a = __expf(la);
        float bt = sqrtf(fmaxf(1.f - a * a, 0.f)) * gi * xc[e];
        pa[e] = a; pb[e] = bt;
      }
      __syncthreads();
      if (tid < 64) {
        float hh = hcarry;
#pragma unroll 8
        for (int pos = 0; pos < 32; ++pos) { float av = pa[pos * 64 + tid]; hh = av * hh + pb[pos * 64 + tid]; pb[pos * 64 + tid] = hh; aprod *= av; }
        hcarry = hh;
      }
      __syncthreads();
      if (PASS == 1) {
        float hv[8];
#pragma unroll
        for (int jj = 0; jj < 8; ++jj) hv[jj] = pb[spos * 64 + sseg * 8 + jj];
        if (dir == 1) {
          float f[8]; unpack8(prev, f);
          float gf[8]; unpack8(gv, gf);
#pragma unroll
          for (int jj = 0; jj < 8; ++jj) hv[jj] = (hv[jj] + f[jj]) * gf[jj];
        }
        *yp = pack8(hv);
      }
    }
    if (PASS == 0 && tid < 64) {
      float* sp = p.SUM + ((((size_t)b * 2 + dir) * 17 + sbd) * 512 + head * 64 + tid) * 2;
      sp[0] = aprod; sp[1] = hcarry;
    }
    __syncthreads();
  }
}

typedef bf16x8 __attribute__((aligned(2))) bf16x8_u;
typedef uint4 __attribute__((aligned(4))) uint4_a4;
__device__ __forceinline__ bf16x8 ld_win8(const u16* base, int y, uint32_t sh) {
  const uint32_t* wp = (const uint32_t*)base + (y >> 1);
  uint4 w = *(const uint4_a4*)wp;
  uint32_t w4 = wp[4];
  FragU f;
  f.u[0] = __builtin_amdgcn_alignbit(w.y, w.x, sh);
  f.u[1] = __builtin_amdgcn_alignbit(w.z, w.y, sh);
  f.u[2] = __builtin_amdgcn_alignbit(w.w, w.z, sh);
  f.u[3] = __builtin_amdgcn_alignbit(w4, w.w, sh);
  return f.v;
}

__device__ __forceinline__ void hy_conv3x8(const u16* col, int t8, int n, float w0, float w1, float w2, float bias, float* out) {
  float f[8]; unpack8(*(const uint4*)(col + t8), f);
  float prev = (t8 > 0) ? bf2f(col[t8 - 1]) : 0.f;
  float next = (t8 + 8 < n) ? bf2f(col[t8 + 8]) : 0.f;
#pragma unroll
  for (int j = 0; j < 8; ++j) {
    float a = (j == 0) ? prev : f[j - 1];
    float cnx = (j == 7) ? next : f[j + 1];
    out[j] = bias + w0 * a + w1 * f[j] + w2 * cnx;
  }
}

__device__ __forceinline__ void hy_task(const P& p, int l, int c, float* sm) {
  int tid = threadIdx.x; asm volatile("" : "+v"(tid)); const int wave = tid >> 6, lane = tid & 63;
  const int r = lane & 31, h = lane >> 5;
  u16* krr = (u16*)sm;
  u16* zs = krr + 8192 + 64;
  float* red = (float*)(zs + 16384);
  const u16* UT = p.U;
  const float* cwp = p.hy_conv_w + (size_t)l * 3 * 1536;
  const float* cbp = p.hy_conv_b + (size_t)l * 1536;
  for (int o = 0; o < 2; ++o) {
    const u16* K = p.KF + (size_t)(o * 512 + c) * 8192;
    float asum = 0.f;
#pragma unroll
    for (int i = 0; i < 4; ++i) {
      int idx = (tid + 256 * i) * 8;
      uint4 v = *(const uint4*)(K + idx);
      *(uint4*)(krr + idx) = v;
      float f[8]; unpack8(v, f);
#pragma unroll
      for (int j = 0; j < 8; ++j) asum += fabsf(f[j]);
    }
    asum = wave_sum(asum);
    if (lane == 0) red[wave] = asum;
    if (o == 0) {
      const float w0 = cwp[c], w1 = cwp[1536 + c], w2 = cwp[3072 + c], bs = cbp[c];
#pragma unroll 1
      for (int e = tid; e < 2048; e += 256) {
        int b = e >> 9, t8 = (e & 511) * 8;
        float f[8];
        hy_conv3x8(UT + (size_t)c * NTOK + b * 4096, t8, 4096, w0, w1, w2, bs, f);
        *(uint4*)(zs + b * 4096 + t8) = pack8(f);
      }
    }
    __syncthreads();
    const float scale = 1.f / (red[0] + red[1] + red[2] + red[3] + 1e-6f);
    const float skip = p.hy_skip[(l * 2 + o) * 512 + c];
    f32x16 acc[2][2];
#pragma unroll
    for (int a = 0; a < 2; ++a)
#pragma unroll
      for (int b = 0; b < 2; ++b)
#pragma unroll
        for (int q = 0; q < 16; ++q) acc[a][b][q] = 0.f;
    const int I0 = wave * 16;
    const int Il0 = I0 + (r >> 2), Il1 = I0 + 8 + (r >> 2);
    const u16* zb = zs + (r & 3) * 4096 + 8 * h;
    const int ybase = 4096 - r + 8 * h + 48;
    bf16x8 F0, F1, F2, F3, F4, F5;
    const uint32_t ysh = (uint32_t)((ybase & 1) * 16);
    {
      const int y0 = ybase - 64 * (I0 - 63);
      F0 = ld_win8(krr, y0, ysh); F1 = ld_win8(krr, y0 - 16, ysh); F2 = ld_win8(krr, y0 - 32, ysh);
      F3 = ld_win8(krr, y0 - 48, ysh); F4 = ld_win8(krr, y0 - 64, ysh); F5 = ld_win8(krr, y0 - 80, ysh);
    }
#pragma unroll 1
    for (int D = I0 - 63; D <= I0 + 15; ++D) {
      bf16x8 B0[4], B1[4];
      {
        int J0 = Il0 - D, J1 = Il1 - D;
        bool ok0 = (unsigned)J0 < 64u, ok1 = (unsigned)J1 < 64u;
        const u16* zp0 = zb + 64 * J0; const u16* zp1 = zb + 64 * J1;
#pragma unroll
        for (int ks = 0; ks < 4; ++ks) {
          bf16x8 z0 = {0, 0, 0, 0, 0, 0, 0, 0}, z1 = {0, 0, 0, 0, 0, 0, 0, 0};
          if (ok0) z0 = *(const bf16x8*)(zp0 + 16 * ks);
          if (ok1) z1 = *(const bf16x8*)(zp1 + 16 * ks);
          B0[ks] = z0; B1[ks] = z1;
        }
      }
      acc[0][0] = __builtin_amdgcn_mfma_f32_32x32x16_bf16(F3, B0[0], acc[0][0], 0, 0, 0);
      acc[0][1] = __builtin_amdgcn_mfma_f32_32x32x16_bf16(F3, B1[0], acc[0][1], 0, 0, 0);
      acc[1][0] = __builtin_amdgcn_mfma_f32_32x32x16_bf16(F5, B0[0], acc[1][0], 0, 0, 0);
      acc[1][1] = __builtin_amdgcn_mfma_f32_32x32x16_bf16(F5, B1[0], acc[1][1], 0, 0, 0);
      acc[0][0] = __builtin_amdgcn_mfma_f32_32x32x16_bf16(F2, B0[1], acc[0][0], 0, 0, 0);
      acc[0][1] = __builtin_amdgcn_mfma_f32_32x32x16_bf16(F2, B1[1], acc[0][1], 0, 0, 0);
      acc[1][0] = __builtin_amdgcn_mfma_f32_32x32x16_bf16(F4, B0[1], acc[1][0], 0, 0, 0);
      acc[1][1] = __builtin_amdgcn_mfma_f32_32x32x16_bf16(F4, B1[1], acc[1][1], 0, 0, 0);
      acc[0][0] = __builtin_amdgcn_mfma_f32_32x32x16_bf16(F1, B0[2], acc[0][0], 0, 0, 0);
      acc[0][1] = __builtin_amdgcn_mfma_f32_32x32x16_bf16(F1, B1[2], acc[0][1], 0, 0, 0);
      acc[1][0] = __builtin_amdgcn_mfma_f32_32x32x16_bf16(F3, B0[2], acc[1][0], 0, 0, 0);
      acc[1][1] = __builtin_amdgcn_mfma_f32_32x32x16_bf16(F3, B1[2], acc[1][1], 0, 0, 0);
      acc[0][0] = __builtin_amdgcn_mfma_f32_32x32x16_bf16(F0, B0[3], acc[0][0], 0, 0, 0);
      acc[0][1] = __builtin_amdgcn_mfma_f32_32x32x16_bf16(F0, B1[3], acc[0][1], 0, 0, 0);
      acc[1][0] = __builtin_amdgcn_mfma_f32_32x32x16_bf16(F2, B0[3], acc[1][0], 0, 0, 0);
      acc[1][1] = __builtin_amdgcn_mfma_f32_32x32x16_bf16(F2, B1[3], acc[1][1], 0, 0, 0);
      F0 = F4; F1 = F5;
      if (D < I0 + 15) {
        const int y1 = ybase - 64 * (D + 1);
        F2 = ld_win8(krr, y1 - 32, ysh); F3 = ld_win8(krr, y1 - 48, ysh);
        F4 = ld_win8(krr, y1 - 64, ysh); F5 = ld_win8(krr, y1 - 80, ysh);
      }
    }
    __syncthreads();
#pragma unroll
    for (int ni = 0; ni < 2; ++ni) {
      u16* zc = zs + (r & 3) * 4096 + 64 * (ni ? Il1 : Il0);
#pragma unroll
      for (int mi = 0; mi < 2; ++mi)
#pragma unroll
        for (int q = 0; q < 16; ++q) {
          int i = 32 * mi + (q & 3) + 8 * (q >> 2) + 4 * h;
          float zo = bf2f(zc[i]);
          zc[i] = f2bf(scale * acc[mi][ni][q] + skip * zo);
        }
    }
    __syncthreads();
    {
      const int ch = (o + 1) * 512 + c;
      const float w0 = cwp[ch], w1 = cwp[1536 + ch], w2 = cwp[3072 + ch], bs = cbp[ch];
#pragma unroll 1
      for (int e = tid; e < 2048; e += 256) {
        int b = e >> 9, t8 = (e & 511) * 8;
        float xg[8], y[8];
        hy_conv3x8(UT + (size_t)ch * NTOK + b * 4096, t8, 4096, w0, w1, w2, bs, xg);
        unpack8(*(const uint4*)(zs + b * 4096 + t8), y);
#pragma unroll
        for (int j = 0; j < 8; ++j) y[j] *= xg[j];
        if (o == 0) *(uint4*)(zs + b * 4096 + t8) = pack8(y);
        else {
          float gf[8]; unpack8(*(const uint4*)(UT + (size_t)(1536 + c) * NTOK + b * 4096 + t8), gf);
#pragma unroll
          for (int j = 0; j < 8; ++j) y[j] *= gf[j];
          *(uint4*)(p.U + (size_t)c * NTOK + b * 4096 + t8) = pack8(y);
        }
      }
    }
    __syncthreads();
  }
  if (l == 0) {
    const int t = tid;
    for (int o = 0; o < 2; ++o) {
      const u16* K = p.KFC + (size_t)(o * 512 + c) * 512;
      float asum = 0.f;
      {
        uint32_t w2 = *(const uint32_t*)(K + tid * 2);
        *(uint32_t*)(krr + tid * 2) = w2;
        asum = fabsf(bflo(w2)) + fabsf(bfhi(w2));
      }
      asum = wave_sum(asum);
      if (lane == 0) red[wave] = asum;
      if (o == 0) {
        const float w0 = cwp[c], w1 = cwp[1536 + c], w2 = cwp[3072 + c], bs = cbp[c];
        if (tid < 128) {
          int b = tid >> 5, t8 = (tid & 31) * 8;
          float f[8];
          hy_conv3x8(UT + (size_t)c * NTOK + NLAT + b * 256, t8, 256, w0, w1, w2, bs, f);
          *(uint4*)(zs + b * 4096 + t8) = pack8(f);
        }
      }
      __syncthreads();
      const float scale = 1.f / (red[0] + red[1] + red[2] + red[3] + 1e-6f);
      float a0 = 0, a1 = 0, a2 = 0, a3 = 0;
      for (int s2 = 0; s2 < 256; ++s2) {
        float kv = bf2f(krr[256 - t + s2]);
        a0 += kv * bf2f(zs[s2]); a1 += kv * bf2f(zs[4096 + s2]); a2 += kv * bf2f(zs[8192 + s2]); a3 += kv * bf2f(zs[12288 + s2]);
      }
      const float skip = p.hy_skip[(l * 2 + o) * 512 + c];
      float y[4];
      y[0] = scale * a0 + skip * bf2f(zs[t]); y[1] = scale * a1 + skip * bf2f(zs[4096 + t]);
      y[2] = scale * a2 + skip * bf2f(zs[8192 + t]); y[3] = scale * a3 + skip * bf2f(zs[12288 + t]);
      __syncthreads();
      {
        const int ch = (o + 1) * 512 + c;
        const float w0 = cwp[ch], w1 = cwp[1536 + ch], w2 = cwp[3072 + ch], bs = cbp[ch];
#pragma unroll
        for (int b = 0; b < 4; ++b) {
          const u16* col = UT + (size_t)ch * NTOK + NLAT + b * 256;
          float xg = bs + w1 * bf2f(col[t]);
          if (t > 0) xg += w0 * bf2f(col[t - 1]);
          if (t < 255) xg += w2 * bf2f(col[t + 1]);
          float zn = xg * y[b];
          if (o == 0) zs[b * 4096 + t] = f2bf(zn);
          else {
            size_t R = (size_t)NLAT + b * 256 + t;
            float gate = bf2f(UT[(size_t)(1536 + c) * NTOK + R]);
            p.U[(size_t)c * NTOK + R] = f2bf(zn * gate);
          }
        }
      }
      __syncthreads();
    }
  }
}

__device__ __forceinline__ void fin_rows(const P& p, int l, int chunk) {
  int tid = threadIdx.x; asm volatile("" : "+v"(tid)); const int wave = tid >> 6, lane = tid & 63;
  for (int rr = 0; rr < 16; ++rr) {
    int R = chunk * 64 + wave * 16 + rr;
    {
      uint4* yp = (uint4*)(p.Y2 + (size_t)R * 1024 + lane * 8);
      float o[8]; unpack8(*yp, o);
      float ss = 0;
#pragma unroll
      for (int j = 0; j < 8; ++j) ss += o[j] * o[j];
      ss += __shfl_xor(ss, 1); ss += __shfl_xor(ss, 2); ss += __shfl_xor(ss, 4); ss += __shfl_xor(ss, 8);
      float rinv = rsqrtf(ss * (1.f / 128.f) + EPS);
      float gf[8]; unpack8(*(const uint4*)(p.U + (size_t)NTOK * 2048 + (size_t)R * 2048 + 1024 + lane * 8), gf);
#pragma unroll
      for (int j = 0; j < 8; ++j) o[j] = o[j] * rinv * p.hg_norm_w[l * 512 + lane * 8 + j] * gf[j];
      *yp = pack8(o);
    }
    {
      uint4* yp = (uint4*)(p.Y2 + (size_t)R * 1024 + 512 + lane * 8);
      float o[8]; unpack8(*yp, o);
      float gf[8]; unpack8(*(const uint4*)(p.U + (size_t)NTOK * 2048 + (size_t)R * 2048 + 1536 + lane * 8), gf);
      float ss = 0;
#pragma unroll
      for (int j = 0; j < 8; ++j) { o[j] *= gf[j]; ss += o[j] * o[j]; }
      ss += __shfl_xor(ss, 1); ss += __shfl_xor(ss, 2); ss += __shfl_xor(ss, 4); ss += __shfl_xor(ss, 8); ss += __shfl_xor(ss, 16);
      float rinv = rsqrtf(ss * (1.f / 256.f) + EPS);
#pragma unroll
      for (int j = 0; j < 8; ++j) o[j] = o[j] * rinv * p.m2_norm_w[l * 512 + lane * 8 + j];
      *yp = pack8(o);
    }
  }
}

__device__ __forceinline__ void ph_mixB(const P& p, int l, int bid, int nb, float* sm) {
  for (int t = bid; t < 544 + 512; t += nb) {
    if (t < 544) { if (EN_RG) rg_task<0>(p, l, t, sm); }
    else { if (EN_HY) hy_task(p, l, t - 544, sm); }
    __syncthreads();
  }
}
__device__ __forceinline__ void hy_transpose(const P& p, int tile, u16* sm) {
  int tid = threadIdx.x; asm volatile("" : "+v"(tid));
  const int ct = tile & 7, rt = tile >> 3;
  const int c0 = ct * 64, R0 = rt * 64;
#pragma unroll
  for (int i = 0; i < 2; ++i) {
    int q = tid + 256 * i; int cc = q >> 3, seg = q & 7;
    *(uint4*)(sm + cc * 72 + seg * 8) = *(const uint4*)(p.U + (size_t)(c0 + cc) * NTOK + R0 + seg * 8);
  }
  __syncthreads();
#pragma unroll
  for (int i = 0; i < 2; ++i) {
    int q = tid + 256 * i; int rr = q >> 3, seg = q & 7;
    FragU f;
#pragma unroll
    for (int j = 0; j < 4; ++j)
      f.u[j] = (uint32_t)sm[(seg * 8 + 2 * j) * 72 + rr] | ((uint32_t)sm[(seg * 8 + 2 * j + 1) * 72 + rr] << 16);
    *(uint4*)(p.HL + (size_t)(R0 + rr) * 1024 + c0 + seg * 8) = f.q;
  }
}
__device__ __forceinline__ void ph_mixB2(const P& p, int l, int bid, int nb, float* sm) {
  const int nfin = (l == 0 ? NTOK : NLAT) / 64;
  const int ntr = nfin * 8;
  for (int t = bid; t < 544 + nfin + ntr; t += nb) {
    if (t < 544) { if (EN_RG) rg_task<1>(p, l, t, sm); }
    else if (t < 544 + nfin) fin_rows(p, l, t - 544);
    else hy_transpose(p, t - 544 - nfin, (u16*)sm);
    __syncthreads();
  }
}
__device__ __forceinline__ void ph_final(const P& p, int bid, int nb) {
  int tid = threadIdx.x; asm volatile("" : "+v"(tid)); const int wave = tid >> 6, lane = tid & 63;
  for (int R = bid * 4 + wave; R < NLAT; R += nb * 4) {
    float4* rp = (float4*)(p.out + (size_t)R * 1024);
    float4 v[4]; float ss = 0;
#pragma unroll
    for (int i = 0; i < 4; ++i) {
      v[i] = rp[lane + i * 64];
      ss += v[i].x * v[i].x + v[i].y * v[i].y + v[i].z * v[i].z + v[i].w * v[i].w;
    }
    ss = wave_sum(ss);
    float rinv = rsqrtf(ss * (1.f / 1024.f) + EPS);
#pragma unroll
    for (int i = 0; i < 4; ++i) {
      float4 w = *(const float4*)(p.final_norm_w + (lane + i * 64) * 4);
      float4 o; o.x = v[i].x * rinv * w.x; o.y = v[i].y * rinv * w.y; o.z = v[i].z * rinv * w.z; o.w = v[i].w * rinv * w.w;
      rp[lane + i * 64] = o;
    }
  }
}

#define SMEM_BYTES 56320
__global__ void __launch_bounds__(256) mega(P p) {
  __shared__ __align__(16) unsigned char smem[SMEM_BYTES];
  cg::grid_group grid = cg::this_grid();
  const int bid = blockIdx.x, nb = gridDim.x;
  float* smf = (float*)smem; u16* smh = (u16*)smem;
#ifndef PHM
#define PHM 0xffff
#endif
  if (PHM & 1) ph_mod(p, bid, nb, smf);
  grid.sync();
  for (int l = 0; l < 2; ++l) {
    if (PHM & 2) ph_norm(p, l, bid, nb);
    if (PHM & 4) ph_wconv(p, l, bid, nb, smf);
    grid.sync();
    if (PHM & 16) ph_gemm<0>(p, l, bid, nb, smh);
    grid.sync();
#if PROBE_DUP == 3
    ph_gemm<0>(p, l, bid, nb, smh);
    grid.sync();
#endif
#if PROBE_DUP == 10
    ph_norm(p, l, bid, nb);
    ph_wconv(p, l, bid, nb, smf);
    grid.sync();
#endif
    if (PHM & 32) ph_mixA0(p, l, bid, nb, smem);
    grid.sync();
    if (PHM & 32) ph_mixA1(p, l, bid, nb, smem);
    grid.sync();
#if PROBE_DUP == 8
    ph_mixA0(p, l, bid, nb, smem);
    grid.sync();
    ph_mixA1(p, l, bid, nb, smem);
    grid.sync();
#endif
    if (PHM & 64) ph_gemm<1>(p, l, bid, nb, smh);
    if (PHM & 8) ph_filt(p, l, bid, nb, smf);
    grid.sync();
#if PROBE_DUP == 2
    ph_mixB(p, l, bid, nb, smf);
    grid.sync();
#endif
#if PROBE_DUP == 4
    ph_gemm<1>(p, l, bid, nb, smh);
    grid.sync();
#endif
#if PROBE_DUP == 9
    ph_gemm<1>(p, l, bid, nb, smh, 1);
    grid.sync();
#endif
    if (PHM & 128) ph_mixB(p, l, bid, nb, smf);
    grid.sync();
    if (PHM & 128) ph_mixB2(p, l, bid, nb, smf);
    grid.sync();
#if PROBE_DUP == 7
    for (int t = bid; t < 544; t += nb) { rg_task<1>(p, l, t, smf); __syncthreads(); }
    grid.sync();
#endif
    if (PHM & 256) ph_gemm<2>(p, l, bid, nb, smh);
    grid.sync();
  }
  if (PHM & 512) ph_final(p, bid, nb);
}

extern "C" void kernel_launch(void* const* d_in, const int* in_sizes, int n_in, void* d_out, int out_size,
                              void* d_ws, size_t ws_size, hipStream_t stream) {
  static int grid_blocks = 0;
  if (!grid_blocks) {
    int dev = 0, cus = 0, per_cu = 0;
    hipGetDevice(&dev);
    hipDeviceGetAttribute(&cus, hipDeviceAttributeMultiprocessorCount, dev);
    hipOccupancyMaxActiveBlocksPerMultiprocessor(&per_cu, mega, 256, 0);
    if (per_cu < 1) per_cu = 1;
    if (per_cu > 2) per_cu = 2;
    grid_blocks = cus * per_cu;
  }
  P p{};
  const float** fp = (const float**)&p;
  for (int i = 0; i < 34; ++i) fp[i] = (const float*)d_in[i];
  p.out = (float*)d_out;
  char* w = (char*)d_ws;
  size_t off = 0;
  auto take = [&](size_t bytes) { char* r = w + off; off += (bytes + 255) & ~(size_t)255; return r; };
  p.U = (u16*)take((size_t)NTOK * UW * 2);
  p.HL = (u16*)take((size_t)NTOK * 1024 * 2);
  p.Y2 = (u16*)take((size_t)NTOK * 1024 * 2);
  p.WT = (u16*)take((size_t)7296 * 1024 * 2);
  p.WoT = (u16*)take((size_t)1024 * 2048 * 2);
  p.KF = (u16*)take((size_t)1024 * 8192 * 2);
  p.KFC = (u16*)take((size_t)1024 * 512 * 2);
  p.XC = (float*)take((size_t)1024 * 1024 * 4);
  p.DT = (float*)take((size_t)NTOK * 8 * 4);
  p.MOD = (float*)take((size_t)2 * 5 * 3072 * 4);
  p.SUM = (float*)take((size_t)4 * 2 * 17 * 512 * 2 * 4);
  p.SSH = (float*)take((size_t)16 * 2 * 4 * 65536);
  p.PS = (float*)take((size_t)16 * 2 * 4 * 128 * 4);
  p.PA = (float*)take((size_t)16 * 2 * 8 * 4 * 4);
  if (off > ws_size) { fprintf(stderr, "workspace too small: need %zu have %zu\n", off, ws_size); return; }
  void* args[] = {&p};
  hipError_t e = hipLaunchCooperativeKernel((void*)mega, dim3(grid_blocks), dim3(256), args, 0, stream);
  if (e != hipSuccess) fprintf(stderr, "cooperative launch failed: %s (grid %d)\n", hipGetErrorString(e), grid_blocks);
}
```

```cpp
#include <hip/hip_runtime.h>
#include <hip/hip_bf16.h>
#include <hip/hip_cooperative_groups.h>
#include <cstdio>
#include <cstdint>
namespace cg = cooperative_groups;

typedef unsigned short u16;
using bf16x8 = __attribute__((ext_vector_type(8))) short;
using f32x16 = __attribute__((ext_vector_type(16))) float;

#define NTOK 17408
#define NLAT 16384
#define UW 4096
#define EPS 1e-6f

#ifndef PROBE_DUP
#define PROBE_DUP 0
#endif
#ifndef EN_HY
#define EN_HY 1
#endif
#ifndef EN_RG
#define EN_RG 1
#endif
#ifndef EN_HG
#define EN_HG 1
#endif
#ifndef EN_M2
#define EN_M2 1
#endif

struct P {
  const float *x, *c, *ctx, *c_ctx, *w_mod, *b_mod, *norm_w, *w_in, *w_out;
  const float *hy_conv_w, *hy_conv_b, *hy_w1, *hy_b1, *hy_w2, *hy_b2, *hy_w3, *hy_freq, *hy_skip;
  const float *rg_conv_w, *rg_conv_b, *rg_wa, *rg_ba, *rg_wx, *rg_bx, *rg_lam;
  const float *hg_lb, *hg_norm_w, *m2_conv_w, *m2_conv_b, *m2_dt_bias, *m2_a_log, *m2_d, *m2_norm_w, *final_norm_w;
  float* out;
  u16 *U, *HL, *Y2, *WT, *WoT, *KF, *KFC;
  float *XC, *DT, *MOD, *SUM, *SSH, *PS, *PA;
};

typedef __bf16 bf2_t __attribute__((ext_vector_type(2)));
typedef float f2_t __attribute__((ext_vector_type(2)));
__device__ __forceinline__ uint32_t pack2(float a, float b) {
  f2_t v = {a, b};
  return __builtin_bit_cast(uint32_t, __builtin_convertvector(v, bf2_t));
}
__device__ __forceinline__ u16 f2bf(float f) { return (u16)(pack2(f, f) & 0xffffu); }
__device__ __forceinline__ float bf2f(u16 h) { return __uint_as_float(((uint32_t)h) << 16); }
__device__ __forceinline__ float bflo(uint32_t w) { return __uint_as_float(w << 16); }
__device__ __forceinline__ float bfhi(uint32_t w) { return __uint_as_float(w & 0xffff0000u); }
__device__ __forceinline__ float siluf(float x) { return x * __builtin_amdgcn_rcpf(1.f + __expf(-x)); }
__device__ __forceinline__ float sigmf(float x) { return __builtin_amdgcn_rcpf(1.f + __expf(-x)); }
__device__ __forceinline__ float softplusf(float x) { return x > 20.f ? x : log1pf(__expf(x)); }

__device__ __forceinline__ void unpack8(const uint4& v, float* f) {
  f[0] = bflo(v.x); f[1] = bfhi(v.x); f[2] = bflo(v.y); f[3] = bfhi(v.y);
  f[4] = bflo(v.z); f[5] = bfhi(v.z); f[6] = bflo(v.w); f[7] = bfhi(v.w);
}
__device__ __forceinline__ uint4 pack8(const float* f) {
  uint4 v; v.x = pack2(f[0], f[1]); v.y = pack2(f[2], f[3]); v.z = pack2(f[4], f[5]); v.w = pack2(f[6], f[7]);
  return v;
}
__device__ __forceinline__ float wave_sum(float v) {
#pragma unroll
  for (int o = 32; o >= 1; o >>= 1) v += __shfl_xor(v, o);
  return v;
}

__device__ __forceinline__ int pos2row_seq(int b, int p, int dir) {
  if (p < 256) { int t = dir ? 255 - p : p; return NLAT + b * 256 + t; }
  int j = p - 256; int t = dir ? 4095 - j : j; return b * 4096 + t;
}
__device__ __forceinline__ int pos2row_m2(int b, int p, int dir) {
  if (p < 256) { int t = dir ? 255 - p : p; return NLAT + b * 256 + t; }
  int j = p - 256; int jj = dir ? 4095 - j : j; int c = jj >> 6, r = jj & 63; return b * 4096 + r * 64 + c;
}

__device__ __forceinline__ void ph_mod(const P& p, int bid, int nb, float* sm) {
  int tid = threadIdx.x; asm volatile("" : "+v"(tid));
  for (int task = bid; task < 96; task += nb) {
    int l = task / 48, cgi = task % 48;
    int col = cgi * 64 + (tid & 63);
    int kq = tid >> 6;
    float a0 = 0, a1 = 0, a2 = 0, a3 = 0, a4 = 0;
    for (int k = kq * 256; k < kq * 256 + 256; ++k) {
      float w = p.w_mod[((size_t)l * 1024 + k) * 3072 + col];
      a0 += siluf(p.c[k]) * w; a1 += siluf(p.c[1024 + k]) * w; a2 += siluf(p.c[2048 + k]) * w;
      a3 += siluf(p.c[3072 + k]) * w; a4 += siluf(p.c_ctx[k]) * w;
    }
    sm[(kq * 5 + 0) * 64 + (tid & 63)] = a0; sm[(kq * 5 + 1) * 64 + (tid & 63)] = a1;
    sm[(kq * 5 + 2) * 64 + (tid & 63)] = a2; sm[(kq * 5 + 3) * 64 + (tid & 63)] = a3;
    sm[(kq * 5 + 4) * 64 + (tid & 63)] = a4;
    __syncthreads();
    if (tid < 64) {
      float bm = p.b_mod[l * 3072 + col];
#pragma unroll
      for (int j = 0; j < 5; ++j) {
        float s = sm[(0 * 5 + j) * 64 + tid] + sm[(1 * 5 + j) * 64 + tid] + sm[(2 * 5 + j) * 64 + tid] + sm[(3 * 5 + j) * 64 + tid];
        p.MOD[(size_t)(l * 5 + j) * 3072 + col] = s + bm;
      }
    }
    __syncthreads();
  }
}

__device__ __forceinline__ void ph_norm(const P& p, int l, int bid, int nb) {
  int tid = threadIdx.x; asm volatile("" : "+v"(tid)); const int wave = tid >> 6, lane = tid & 63;
  for (int R = bid * 4 + wave; R < NTOK; R += nb * 4) {
    const float* src; int mj;
    if (R < NLAT) { src = (l == 0 ? p.x : (const float*)p.out) + (size_t)R * 1024; mj = R >> 12; }
    else { int rc = R - NLAT; src = (l == 0 ? p.ctx : (const float*)p.XC) + (size_t)rc * 1024; mj = 4; }
    const float* mod = p.MOD + (size_t)(l * 5 + mj) * 3072;
    float4 v[4]; float ss = 0;
#pragma unroll
    for (int i = 0; i < 4; ++i) {
      v[i] = ((const float4*)src)[lane + i * 64];
      ss += v[i].x * v[i].x + v[i].y * v[i].y + v[i].z * v[i].z + v[i].w * v[i].w;
    }
    ss = wave_sum(ss);
    float rinv = rsqrtf(ss * (1.f / 1024.f) + EPS);
#pragma unroll
    for (int i = 0; i < 4; ++i) {
      int idx = (lane + i * 64) * 4;
      float4 nw = *(const float4*)(p.norm_w + l * 1024 + idx);
      float4 sh = *(const float4*)(mod + idx);
      float4 sc = *(const float4*)(mod + 1024 + idx);
      float h0 = v[i].x * rinv * nw.x * (1.f + sc.x) + sh.x;
      float h1 = v[i].y * rinv * nw.y * (1.f + sc.y) + sh.y;
      float h2 = v[i].z * rinv * nw.z * (1.f + sc.z) + sh.z;
      float h3 = v[i].w * rinv * nw.w * (1.f + sc.w) + sh.w;
      uint2 o; o.x = pack2(h0, h1); o.y = pack2(h2, h3);
      *(uint2*)(p.HL + (size_t)R * 1024 + idx) = o;
    }
  }
}

__device__ __forceinline__ void ph_wconv(const P& p, int l, int bid, int nb, float* sm) {
  int tid = threadIdx.x; asm volatile("" : "+v"(tid));
  const int T1 = 114 * 16, T2 = 16 * 32;
  for (int t = bid; t < T1 + T2; t += nb) {
    const float* src; int ld, K, n0, k0, sc0, nvalid; u16* dst;
    if (t < T1) {
      int nt = t / 16, kt = t % 16; n0 = nt * 64; k0 = kt * 64;
      src = p.w_in + (size_t)l * 1024 * 7176; ld = 7176; K = 1024; dst = p.WT; nvalid = 64;
      if (n0 < 2048) sc0 = 3072 + n0;
      else if (n0 < 3072) sc0 = 5632 + (n0 - 2048);
      else if (n0 < 3200) { sc0 = 6656 + (n0 - 3072); nvalid = (n0 == 3072) ? 8 : 0; }
      else { int m = n0 - 3200; if (m < 3072) sc0 = m; else if (m < 3584) sc0 = 5120 + (m - 3072); else sc0 = 6664 + (m - 3584); }
    } else {
      int tt = t - T1; int nt = tt / 32, kt = tt % 32; n0 = nt * 64; k0 = kt * 64;
      src = p.w_out + (size_t)l * 2048 * 1024; ld = 1024; K = 2048; dst = p.WoT; nvalid = 64; sc0 = n0;
    }
#pragma unroll
    for (int i = 0; i < 4; ++i) {
      int kk = (tid >> 4) + 16 * i, cc = (tid & 15) * 4;
      const float* sp = src + (size_t)(k0 + kk) * ld + sc0 + cc;
      float4 v;
      if (nvalid == 64) v = *(const float4*)sp;
      else { v.x = (cc + 0 < nvalid) ? sp[0] : 0.f; v.y = (cc + 1 < nvalid) ? sp[1] : 0.f; v.z = (cc + 2 < nvalid) ? sp[2] : 0.f; v.w = (cc + 3 < nvalid) ? sp[3] : 0.f; }
      sm[kk * 65 + cc + 0] = v.x; sm[kk * 65 + cc + 1] = v.y; sm[kk * 65 + cc + 2] = v.z; sm[kk * 65 + cc + 3] = v.w;
    }
    __syncthreads();
#pragma unroll
    for (int i = 0; i < 2; ++i) {
      int q = tid + 256 * i; int nn = q >> 3, ks = q & 7;
      float f[8];
#pragma unroll
      for (int j = 0; j < 8; ++j) f[j] = sm[(ks * 8 + j) * 65 + nn];
      *(uint4*)(dst + (size_t)(n0 + nn) * K + k0 + ks * 8) = pack8(f);
    }
    __syncthreads();
  }
}

__device__ __forceinline__ void ph_filt(const P& p, int l, int bid, int nb, float* sm) {
  int tid = threadIdx.x; asm volatile("" : "+v"(tid));
  const float HY_MIN = -3.0701134573253945f, HY_MAX = -15.350567286626972f;
  int ntask = 256 + (l == 0 ? 16 : 0);
  float* zs = sm; float* h1 = sm + 544; float* h2 = sm + 544 + 1024;
  for (int task = bid; task < ntask; task += nb) {
    int n, t0; u16* K;
    if (task < 256) { n = 4096; t0 = task * 16; K = p.KF; } else { n = 256; t0 = (task - 256) * 16; K = p.KFC; }
    float inv_nm1 = 1.f / (float)(n - 1);
    for (int e = tid; e < 16 * 33; e += 256) {
      int tt = e / 33, f = e % 33; int t = t0 + tt; float val;
      if (f == 0) val = (float)t * inv_nm1;
      else {
        int bi = (f - 1) & 15;
        float band = 1e-4f + (float)bi * ((15.f - 1e-4f) / 15.f);
        float ang = (6.283185307179586f / (float)n) * (float)t * band;
        val = (f <= 16) ? cosf(ang) : -sinf(ang);
      }
      zs[e] = val;
    }
    __syncthreads();
    for (int e = tid; e < 1024; e += 256) {
      int tt = e >> 6, j = e & 63; float acc = p.hy_b1[l * 64 + j];
      for (int f = 0; f < 33; ++f) acc += zs[tt * 33 + f] * p.hy_w1[(l * 33 + f) * 64 + j];
      h1[e] = sinf(p.hy_freq[l * 64 + j] * acc);
    }
    __syncthreads();
    for (int e = tid; e < 1024; e += 256) {
      int tt = e >> 6, j = e & 63; float acc = p.hy_b2[l * 64 + j];
      for (int i = 0; i < 64; ++i) acc += h1[tt * 64 + i] * p.hy_w2[(l * 64 + i) * 64 + j];
      h2[e] = sinf(p.hy_freq[l * 64 + j] * acc);
    }
    __syncthreads();
    for (int r = 0; r < 8; ++r) {
      int col = tid + 256 * r; int o = col >> 10, side = (col >> 9) & 1, c = col & 511;
      float w[64];
#pragma unroll
      for (int i = 0; i < 64; ++i) w[i] = p.hy_w3[(size_t)(l * 64 + i) * 2048 + col];
      float delta = fabsf(HY_MIN + (HY_MAX - HY_MIN) * (float)c / 511.f);
      u16* Kc = K + (size_t)(o * 512 + c) * (2 * n);
      for (int tt = 0; tt < 16; ++tt) {
        float acc = 0;
#pragma unroll
        for (int i = 0; i < 64; ++i) acc += h2[tt * 64 + i] * w[i];
        int t = t0 + tt;
        float val = acc * __expf(-(float)t * inv_nm1 * delta);
        int idx;
        if (side == 0) idx = n - t; else { if (t == 0) { idx = 0; val = 0.f; } else idx = n + t; }
        Kc[idx] = f2bf(val);
      }
    }
    __syncthreads();
  }
}

#define LDSTR 72
template <int MODE>
__device__ __forceinline__ void gemm_tile(const P& p, int l, int mt, int nt, u16* sA, u16* sB, int noepi) {
  int tid = threadIdx.x; asm volatile("" : "+v"(tid)); const int wave = tid >> 6, lane = tid & 63;
  const int wm = wave >> 1, wn = wave & 1;
  const int KT = (MODE == 2) ? 2048 : 1024;
  const u16* Bsrc = (MODE == 0) ? p.WT + (size_t)(nt * 128) * 1024
                  : (MODE == 1) ? p.WT + (size_t)(3200 + nt * 128) * 1024
                                : p.WoT + (size_t)(nt * 128) * 2048;
  f32x16 acc[4][2];
#pragma unroll
  for (int a = 0; a < 4; ++a)
#pragma unroll
    for (int b = 0; b < 2; ++b)
#pragma unroll
      for (int r = 0; r < 16; ++r) acc[a][b][r] = 0.f;
  uint4 ra0, ra1, ra2, ra3, ra4, ra5, ra6, ra7, rb0, rb1, rb2, rb3;
  const int lrow = tid >> 3, lseg = tid & 7;
  const u16* Ab0 = p.HL + (size_t)(mt * 256 + lrow) * 1024 + lseg * 8;
  const u16* Ab1 = p.Y2 + (size_t)(mt * 256 + lrow) * 1024 + lseg * 8;
  const u16* Bb = Bsrc + (size_t)lrow * KT + lseg * 8;
#define GLOADS(K0)                                                                                  \
  {                                                                                                 \
    const u16* ap = (MODE == 2 && (K0) >= 1024) ? Ab1 + ((K0) - 1024) : Ab0 + (K0);                 \
    ra0 = *(const uint4*)(ap); ra1 = *(const uint4*)(ap + 32 * 1024);                               \
    ra2 = *(const uint4*)(ap + 64 * 1024); ra3 = *(const uint4*)(ap + 96 * 1024);                   \
    ra4 = *(const uint4*)(ap + 128 * 1024); ra5 = *(const uint4*)(ap + 160 * 1024);                 \
    ra6 = *(const uint4*)(ap + 192 * 1024); ra7 = *(const uint4*)(ap + 224 * 1024);                 \
    const u16* bp = Bb + (K0);                                                                      \
    rb0 = *(const uint4*)(bp); rb1 = *(const uint4*)(bp + (size_t)32 * KT);                         \
    rb2 = *(const uint4*)(bp + (size_t)64 * KT); rb3 = *(const uint4*)(bp + (size_t)96 * KT);       \
  }
  GLOADS(0)
#pragma unroll 1
  for (int k0 = 0; k0 < KT; k0 += 64) {
    *(uint4*)(sA + (lrow + 0) * LDSTR + lseg * 8) = ra0;   *(uint4*)(sA + (lrow + 32) * LDSTR + lseg * 8) = ra1;
    *(uint4*)(sA + (lrow + 64) * LDSTR + lseg * 8) = ra2;  *(uint4*)(sA + (lrow + 96) * LDSTR + lseg * 8) = ra3;
    *(uint4*)(sA + (lrow + 128) * LDSTR + lseg * 8) = ra4; *(uint4*)(sA + (lrow + 160) * LDSTR + lseg * 8) = ra5;
    *(uint4*)(sA + (lrow + 192) * LDSTR + lseg * 8) = ra6; *(uint4*)(sA + (lrow + 224) * LDSTR + lseg * 8) = ra7;
    *(uint4*)(sB + (lrow + 0) * LDSTR + lseg * 8) = rb0;   *(uint4*)(sB + (lrow + 32) * LDSTR + lseg * 8) = rb1;
    *(uint4*)(sB + (lrow + 64) * LDSTR + lseg * 8) = rb2;  *(uint4*)(sB + (lrow + 96) * LDSTR + lseg * 8) = rb3;
    __syncthreads();
    if (k0 + 64 < KT) GLOADS(k0 + 64)
#pragma unroll
    for (int ks = 0; ks < 4; ++ks) {
      bf16x8 fa[4], fb[2];
#pragma unroll
      for (int mi = 0; mi < 4; ++mi)
        fa[mi] = *(const bf16x8*)(sA + (wm * 128 + mi * 32 + (lane & 31)) * LDSTR + ks * 16 + (lane >> 5) * 8);
#pragma unroll
      for (int ni = 0; ni < 2; ++ni)
        fb[ni] = *(const bf16x8*)(sB + (wn * 64 + ni * 32 + (lane & 31)) * LDSTR + ks * 16 + (lane >> 5) * 8);
#pragma unroll
      for (int mi = 0; mi < 4; ++mi)
#pragma unroll
        for (int ni = 0; ni < 2; ++ni)
          acc[mi][ni] = __builtin_amdgcn_mfma_f32_32x32x16_bf16(fa[mi], fb[ni], acc[mi][ni], 0, 0, 0);
    }
    __syncthreads();
  }
  if (noepi) {
    float sacc = 0.f;
#pragma unroll
    for (int a = 0; a < 4; ++a)
#pragma unroll
      for (int b = 0; b < 2; ++b) sacc += acc[a][b][3];
    if (sacc == 1.2345e30f) p.DT[0] = sacc;
    return;
  }
  const int mj = (mt < 64) ? (mt >> 4) : 4;
  const int c31 = lane & 31, hh = lane >> 5;
  const int gcolA = nt * 128 + wn * 64 + c31, gcolB = gcolA + 32;
  if (MODE == 0 && nt == 24) {
    if (wn == 0 && c31 < 8) {
#pragma unroll
      for (int mi = 0; mi < 4; ++mi)
#pragma unroll
        for (int r = 0; r < 16; ++r) {
          const int R = mt * 256 + wm * 128 + mi * 32 + (r & 3) + 8 * (r >> 2) + 4 * hh;
          p.DT[(size_t)R * 8 + c31] = acc[mi][0][r];
        }
    }
    return;
  }
  if (MODE == 1 && nt < 16) {
    const bool sl = (gcolA >> 9) == 3;
#pragma unroll
    for (int mi = 0; mi < 4; ++mi)
#pragma unroll
      for (int ni = 0; ni < 2; ++ni)
#pragma unroll
        for (int g4 = 0; g4 < 4; ++g4) {
          float v0 = acc[mi][ni][4 * g4], v1 = acc[mi][ni][4 * g4 + 1], v2 = acc[mi][ni][4 * g4 + 2], v3 = acc[mi][ni][4 * g4 + 3];
          if (sl) { v0 = siluf(v0); v1 = siluf(v1); v2 = siluf(v2); v3 = siluf(v3); }
          int R0 = mt * 256 + wm * 128 + mi * 32 + 8 * g4 + 4 * hh;
          uint2 o; o.x = pack2(v0, v1); o.y = pack2(v2, v3);
          *(uint2*)(p.U + (size_t)(ni ? gcolB : gcolA) * NTOK + R0) = o;
        }
    return;
  }
  if (MODE != 2) {
    float lbA = 0.f, lbB = 0.f;
    int kindA = 0, kindB = 0;
    if (MODE == 0) {
      int pa_ = gcolA >> 9, pb_ = gcolB >> 9;
      kindA = (pa_ == 0) ? 1 : (pa_ == 1 || pa_ == 2) ? 2 : 0;
      kindB = (pb_ == 0) ? 1 : (pb_ == 1 || pb_ == 2) ? 2 : 0;
      if (l == 1) {
        if (kindA == 2) { int dir = pa_ - 1, ch = gcolA & 511; lbA = 1.f / (1.f + __expf(p.hg_lb[dir * 512 + ch] - p.hg_lb[(2 + dir) * 512 + ch])); }
        if (kindB == 2) { int dir = pb_ - 1, ch = gcolB & 511; lbB = 1.f / (1.f + __expf(p.hg_lb[dir * 512 + ch] - p.hg_lb[(2 + dir) * 512 + ch])); }
      }
    } else {
      int pa_ = gcolA >> 9, pb_ = gcolB >> 9;
      kindA = (pa_ == 3 || pa_ >= 5) ? 3 : 0;
      kindB = (pb_ == 3 || pb_ >= 5) ? 3 : 0;
    }
    u16* stg = sA + wave * (32 * 72);
    u16* dstbase = (MODE == 0) ? p.U + (size_t)(nt * 128 + wn * 64) : p.U + (size_t)NTOK * 2048 + (size_t)(nt * 128 - 2048 + wn * 64);
    const int ldo = (MODE == 0) ? UW : 2048;
#pragma unroll
    for (int mi = 0; mi < 4; ++mi) {
#pragma unroll
      for (int r = 0; r < 16; ++r) {
        const int rl = (r & 3) + 8 * (r >> 2) + 4 * hh;
        float va = acc[mi][0][r], vb = acc[mi][1][r];
        if (kindA == 1) va *= 0.08838834764831845f; else if (kindA == 2) va = (1.f - lbA) * __builtin_amdgcn_rcpf(1.f + __expf(va)); else if (kindA == 3) va = siluf(va);
        if (kindB == 1) vb *= 0.08838834764831845f; else if (kindB == 2) vb = (1.f - lbB) * __builtin_amdgcn_rcpf(1.f + __expf(vb)); else if (kindB == 3) vb = siluf(vb);
        stg[rl * 72 + c31] = f2bf(va);
        stg[rl * 72 + 32 + c31] = f2bf(vb);
      }
#pragma unroll
      for (int it = 0; it < 4; ++it) {
        const int rl = it * 8 + (lane >> 3), seg = lane & 7;
        uint4 v = *(const uint4*)(stg + rl * 72 + seg * 8);
        const int R = mt * 256 + wm * 128 + mi * 32 + rl;
        *(uint4*)(dstbase + (size_t)R * ldo + seg * 8) = v;
      }
    }
    return;
  }
  {
    float* stgf = (float*)sA + wave * (32 * 68);
    const int seg = lane & 15;
    const int gc0 = nt * 128 + wn * 64 + seg * 4;
    const float4 g4v = *(const float4*)(p.MOD + (size_t)(l * 5 + mj) * 3072 + 2048 + gc0);
#pragma unroll
    for (int mi = 0; mi < 4; ++mi) {
#pragma unroll
      for (int r = 0; r < 16; ++r) {
        const int rl = (r & 3) + 8 * (r >> 2) + 4 * hh;
        stgf[rl * 68 + c31] = acc[mi][0][r];
        stgf[rl * 68 + 32 + c31] = acc[mi][1][r];
      }
#pragma unroll
      for (int it = 0; it < 8; ++it) {
        const int rl = it * 4 + (lane >> 4);
        float4 v = *(const float4*)(stgf + rl * 68 + seg * 4);
        const int R = mt * 256 + wm * 128 + mi * 32 + rl;
        const float* src; float* dst;
        if (R < NLAT) { src = ((l == 0) ? p.x : (const float*)p.out) + (size_t)R * 1024 + gc0; dst = p.out + (size_t)R * 1024 + gc0; }
        else { int rc = R - NLAT; src = p.ctx + (size_t)rc * 1024 + gc0; dst = p.XC + (size_t)rc * 1024 + gc0; }
        float4 xv = *(const float4*)src;
        float4 o; o.x = xv.x + g4v.x * v.x; o.y = xv.y + g4v.y * v.y; o.z = xv.z + g4v.z * v.z; o.w = xv.w + g4v.w * v.w;
        *(float4*)dst = o;
      }
    }
  }
}

template <int MODE>
__device__ __forceinline__ void ph_gemm(const P& p, int l, int bid, int nb, u16* sm, int noepi = 0) {
  const int NT = (MODE == 0) ? 25 : (MODE == 1) ? 32 : 8;
  const int MT = (MODE == 2 && l == 1) ? 64 : 68;
  u16* sA = sm; u16* sB = sm + 256 * LDSTR;
  const int xcd = bid & 7, local = bid >> 3;
  const int mbase = MT >> 3, mextra = MT & 7;
  const int mper = mbase + (xcd < mextra ? 1 : 0);
  const int mstart = (xcd < mextra) ? xcd * (mbase + 1) : mextra * (mbase + 1) + (xcd - mextra) * mbase;
  const int total = mper * NT;
  const int fullb = NT >> 3, rem = NT & 7;
  for (int it = 0;; ++it) {
    int mt, nt;
    if (nb == 256) {
      int q = local + 32 * it;
      if (q >= total) break;
      int b, i, bw;
      if (q < fullb * mper * 8) { b = q / (mper * 8); i = q - b * mper * 8; bw = 8; }
      else { b = fullb; i = q - fullb * mper * 8; bw = rem; }
      int sub = i / (4 * bw);
      const int nsub = mper >> 2;
      int mt_off, nt_off;
      if (sub < nsub) { int j = i - sub * 4 * bw; mt_off = j & 3; nt_off = j >> 2; }
      else { int j = i - nsub * 4 * bw; sub = nsub; mt_off = 0; nt_off = j; }
      mt = mstart + sub * 4 + mt_off; nt = b * 8 + nt_off;
    } else {
      int t = bid + it * nb;
      if (t >= MT * NT) break;
      nt = t / MT; mt = t % MT;
    }
    __syncthreads();
    gemm_tile<MODE>(p, l, mt, nt, sA, sB, noepi);
  }
}

__device__ __forceinline__ void hg_task(const P& p, int l, int task, float* sm) {
  int tid = threadIdx.x; asm volatile("" : "+v"(tid)); const int wave = tid >> 6, lane = tid & 63;
  const int b = task >> 5, h = (task >> 3) & 3, es = task & 7;
  const int dg = lane & 15, el = lane >> 4;
  float* qs = sm; float* ks = sm + 4096; float* vs = sm + 8192; float* os = sm + 8192 + 512;
  for (int dir = 0; dir < 2; ++dir) {
    float S[8];
#pragma unroll
    for (int r = 0; r < 8; ++r) S[r] = 0.f;
    for (int chunk = 0; chunk < 136; ++chunk) {
#pragma unroll
      for (int i = 0; i < 2; ++i) {
        int q = tid + 256 * i; int pos = q >> 4, seg = q & 15;
        int R = pos2row_seq(b, chunk * 32 + pos, dir);
        const u16* up = p.U + (size_t)R * UW + h * 128 + seg * 8;
        uint4 qv = *(const uint4*)up;
        uint4 kv = *(const uint4*)(up + 512 + dir * 512);
        float f[8];
        unpack8(qv, f);
        *(float4*)(qs + pos * 128 + seg * 8) = make_float4(f[0], f[1], f[2], f[3]);
        *(float4*)(qs + pos * 128 + seg * 8 + 4) = make_float4(f[4], f[5], f[6], f[7]);
        unpack8(kv, f);
        *(float4*)(ks + pos * 128 + seg * 8) = make_float4(f[0], f[1], f[2], f[3]);
        *(float4*)(ks + pos * 128 + seg * 8 + 4) = make_float4(f[4], f[5], f[6], f[7]);
      }
      {
        int pos = tid >> 3, e2 = (tid & 7) * 2;
        int R = pos2row_seq(b, chunk * 32 + pos, dir);
        uint32_t w = *(const uint32_t*)(p.U + (size_t)R * UW + 1536 + h * 128 + es * 16 + e2);
        vs[pos * 16 + e2] = bflo(w); vs[pos * 16 + e2 + 1] = bfhi(w);
      }
      __syncthreads();
#pragma unroll 4
      for (int i = 0; i < 32; ++i) {
        float4 q0 = *(const float4*)(qs + i * 128 + dg * 8), q1 = *(const float4*)(qs + i * 128 + dg * 8 + 4);
        float4 k0 = *(const float4*)(ks + i * 128 + dg * 8), k1 = *(const float4*)(ks + i * 128 + dg * 8 + 4);
        float v = vs[i * 16 + wave * 4 + el];
        S[0] += k0.x * (v - S[0]); S[1] += k0.y * (v - S[1]); S[2] += k0.z * (v - S[2]); S[3] += k0.w * (v - S[3]);
        S[4] += k1.x * (v - S[4]); S[5] += k1.y * (v - S[5]); S[6] += k1.z * (v - S[6]); S[7] += k1.w * (v - S[7]);
        float o = q0.x * S[0] + q0.y * S[1] + q0.z * S[2] + q0.w * S[3] + q1.x * S[4] + q1.y * S[5] + q1.z * S[6] + q1.w * S[7];
        o += __shfl_xor(o, 1); o += __shfl_xor(o, 2); o += __shfl_xor(o, 4); o += __shfl_xor(o, 8);
        if (dg == 0) os[i * 16 + wave * 4 + el] = o;
      }
      __syncthreads();
      {
        int pos = tid >> 3, e2 = (tid & 7) * 2;
        int R = pos2row_seq(b, chunk * 32 + pos, dir);
        uint32_t* yp = (uint32_t*)(p.Y2 + (size_t)R * 1024 + h * 128 + es * 16 + e2);
        float o0 = os[pos * 16 + e2], o1 = os[pos * 16 + e2 + 1];
        if (dir == 1) { uint32_t w = *yp; o0 += bflo(w); o1 += bfhi(w); }
        *yp = pack2(o0, o1);
      }
    }
    __syncthreads();
  }
}

__device__ __forceinline__ void m2_task(const P& p, int l, int task, float* sm) {
  int tid = threadIdx.x; asm volatile("" : "+v"(tid)); const int wave = tid >> 6, lane = tid & 63;
  const int b = task >> 5, head = (task >> 2) & 7, ps = task & 3;
  const int g = head >> 2;
  const int dg = lane & 15, el = lane >> 4;
  float* Cs = sm; float* Bs = sm + 4096; float* xs = sm + 8192; float* os = sm + 8192 + 512;
  float* dts = sm + 8192 + 1024; float* decs = dts + 32;
  for (int dir = 0; dir < 2; ++dir) {
    const float* cw = p.m2_conv_w + (size_t)(l * 2 + dir) * 4 * 1024;
    const float* cb = p.m2_conv_b + (size_t)(l * 2 + dir) * 1024;
    const float dtb = p.m2_dt_bias[(l * 2 + dir) * 8 + head];
    const float Aneg = -__expf(p.m2_a_log[(l * 2 + dir) * 8 + head]);
    const float Dsk = p.m2_d[(l * 2 + dir) * 8 + head];
    float S[8];
#pragma unroll
    for (int r = 0; r < 8; ++r) S[r] = 0.f;
    for (int chunk = 0; chunk < 136; ++chunk) {
      const int pbase = chunk * 32;
      const int seg0 = (pbase < 256) ? 0 : 256;
#pragma unroll
      for (int i = 0; i < 2; ++i) {
        int q = tid + 256 * i; int pos = q >> 4, seg = q & 15;
        int pp = pbase + pos;
        int chB = 512 + g * 128 + seg * 8, chC = 768 + g * 128 + seg * 8;
        float aB[8], aC[8];
#pragma unroll
        for (int j = 0; j < 8; ++j) { aB[j] = cb[chB + j]; aC[j] = cb[chC + j]; }
#pragma unroll
        for (int tap = 0; tap < 4; ++tap) {
          int pt = pp - 3 + tap;
          if (pt >= seg0) {
            int R = pos2row_m2(b, pt, dir);
            const u16* up = p.U + (size_t)R * UW + 2048;
            uint4 bv = *(const uint4*)(up + chB);
            uint4 cv = *(const uint4*)(up + chC);
            float f[8];
            unpack8(bv, f);
#pragma unroll
            for (int j = 0; j < 8; ++j) aB[j] += cw[tap * 1024 + chB + j] * f[j];
            unpack8(cv, f);
#pragma unroll
            for (int j = 0; j < 8; ++j) aC[j] += cw[tap * 1024 + chC + j] * f[j];
          }
        }
#pragma unroll
        for (int j = 0; j < 8; ++j) { aB[j] = siluf(aB[j]); aC[j] = siluf(aC[j]); }
        *(float4*)(Bs + pos * 128 + seg * 8) = make_float4(aB[0], aB[1], aB[2], aB[3]);
        *(float4*)(Bs + pos * 128 + seg * 8 + 4) = make_float4(aB[4], aB[5], aB[6], aB[7]);
        *(float4*)(Cs + pos * 128 + seg * 8) = make_float4(aC[0], aC[1], aC[2], aC[3]);
        *(float4*)(Cs + pos * 128 + seg * 8 + 4) = make_float4(aC[4], aC[5], aC[6], aC[7]);
      }
      {
        int pos = tid >> 3, e2 = (tid & 7) * 2;
        int pp = pbase + pos;
        int ch = head * 64 + ps * 16 + e2;
        float a0 = cb[ch], a1 = cb[ch + 1];
#pragma unroll
        for (int tap = 0; tap < 4; ++tap) {
          int pt = pp - 3 + tap;
          if (pt >= seg0) {
            int R = pos2row_m2(b, pt, dir);
            uint32_t w = *(const uint32_t*)(p.U + (size_t)R * UW + 2048 + ch);
            a0 += cw[tap * 1024 + ch] * bflo(w); a1 += cw[tap * 1024 + ch + 1] * bfhi(w);
          }
        }
        xs[pos * 16 + e2] = siluf(a0); xs[pos * 16 + e2 + 1] = siluf(a1);
      }
      if (tid < 32) {
        int R = pos2row_m2(b, pbase + tid, dir);
        float dtv = softplusf(p.DT[(size_t)R * 8 + head] + dtb);
        dts[tid] = dtv; decs[tid] = __expf(dtv * Aneg);
      }
      __syncthreads();
#pragma unroll 4
      for (int i = 0; i < 32; ++i) {
        float4 q0 = *(const float4*)(Cs + i * 128 + dg * 8), q1 = *(const float4*)(Cs + i * 128 + dg * 8 + 4);
        float4 k0 = *(const float4*)(Bs + i * 128 + dg * 8), k1 = *(const float4*)(Bs + i * 128 + dg * 8 + 4);
        float xv = xs[i * 16 + wave * 4 + el];
        float a = decs[i]; float v = xv * dts[i];
        S[0] = a * S[0] + k0.x * v; S[1] = a * S[1] + k0.y * v; S[2] = a * S[2] + k0.z * v; S[3] = a * S[3] + k0.w * v;
        S[4] = a * S[4] + k1.x * v; S[5] = a * S[5] + k1.y * v; S[6] = a * S[6] + k1.z * v; S[7] = a * S[7] + k1.w * v;
        float o = q0.x * S[0] + q0.y * S[1] + q0.z * S[2] + q0.w * S[3] + q1.x * S[4] + q1.y * S[5] + q1.z * S[6] + q1.w * S[7];
        o += __shfl_xor(o, 1); o += __shfl_xor(o, 2); o += __shfl_xor(o, 4); o += __shfl_xor(o, 8);
        if (dg == 0) os[i * 16 + wave * 4 + el] = o + Dsk * xv;
      }
      __syncthreads();
      {
        int pos = tid >> 3, e2 = (tid & 7) * 2;
        int R = pos2row_m2(b, pbase + pos, dir);
        uint32_t* yp = (uint32_t*)(p.Y2 + (size_t)R * 1024 + 512 + head * 64 + ps * 16 + e2);
        float o0 = os[pos * 16 + e2], o1 = os[pos * 16 + e2 + 1];
        if (dir == 1) { uint32_t w = *yp; o0 += bflo(w); o1 += bfhi(w); }
        *yp = pack2(o0, o1);
      }
    }
    __syncthreads();
  }
}

#ifndef M2_MFMA
#define M2_MFMA 1
#endif
#define QS 136
#define TS 40
union FragU { bf16x8 v; uint32_t u[4]; uint2 d[2]; uint4 q; };
__device__ __forceinline__ bf16x8 cvt_frag(const f32x16& x, int s2) {
  FragU f;
  f.u[0] = pack2(x[8 * s2 + 0], x[8 * s2 + 1]); f.u[1] = pack2(x[8 * s2 + 2], x[8 * s2 + 3]);
  f.u[2] = pack2(x[8 * s2 + 4], x[8 * s2 + 5]); f.u[3] = pack2(x[8 * s2 + 6], x[8 * s2 + 7]);
  return f.v;
}
__device__ __forceinline__ bf16x8 ld_frag_perm(const u16* base) {
  FragU f; f.d[0] = *(const uint2*)base; f.d[1] = *(const uint2*)(base + 8); return f.v;
}

template <int PASS>
__device__ __forceinline__ void hg_mfma(const P& p, int l, int task, int blk, int dir0, unsigned char* smem) {
  int tid = threadIdx.x; asm volatile("" : "+v"(tid)); const int wave = tid >> 6, lane = tid & 63;
  const int r = lane & 31, hh = lane >> 5;
  const int b = task >> 2, h = task & 3;
  u16* ks = (u16*)smem;
  u16* qs = ks + 32 * QS;
  u16* kT = qs + 32 * QS;
  u16* vT = kT + 128 * TS;
  float* tot = (float*)(vT + 128 * TS);
  float* eg = tot + 256;
  const int dd = tid & 127, half = tid >> 7;
  for (int dir = (PASS == 0 ? dir0 : 0); dir < (PASS == 0 ? dir0 + 1 : 2); ++dir) {
    const int sbd = (PASS == 0) ? blk : ((blk == 0) ? 0 : (dir ? 9 - blk : blk));
    const int c0 = (sbd == 0) ? 0 : 8 + 16 * (sbd - 1);
    const int c1 = (sbd == 0) ? 8 : 8 + 16 * sbd;
    float gsum = 0.f;
    f32x16 S[4];
#pragma unroll
    for (int i = 0; i < 4; ++i)
#pragma unroll
      for (int q = 0; q < 16; ++q) S[i][q] = 0.f;
    if (PASS == 1) {
      for (int qb = 0; qb < sbd; ++qb) {
        const size_t sidx = (size_t)((task * 2 + dir) * 8 + qb);
        if (half == 0) eg[dd] = __expf(p.PS[sidx * 128 + dd]);
        __syncthreads();
        const float* sp = p.SSH + sidx * 16384 + (size_t)wave * 4096 + lane;
#pragma unroll
        for (int dt = 0; dt < 4; ++dt)
#pragma unroll
          for (int q4 = 0; q4 < 4; ++q4) {
            float4 e4 = *(const float4*)(eg + 32 * dt + 8 * q4 + 4 * hh);
            S[dt][4 * q4 + 0] = S[dt][4 * q4 + 0] * e4.x + sp[(dt * 16 + 4 * q4 + 0) * 64];
            S[dt][4 * q4 + 1] = S[dt][4 * q4 + 1] * e4.y + sp[(dt * 16 + 4 * q4 + 1) * 64];
            S[dt][4 * q4 + 2] = S[dt][4 * q4 + 2] * e4.z + sp[(dt * 16 + 4 * q4 + 2) * 64];
            S[dt][4 * q4 + 3] = S[dt][4 * q4 + 3] * e4.w + sp[(dt * 16 + 4 * q4 + 3) * 64];
          }
        __syncthreads();
      }
    }
    uint4 pq0, pq1, pk0, pk1, pv0, pv1;
#define HG_PREFETCH(CH)                                                                     \
    {                                                                                       \
      int pos0 = tid >> 4, seg = tid & 15;                                                  \
      int R0 = pos2row_seq(b, (CH) * 32 + pos0, dir), R1 = pos2row_seq(b, (CH) * 32 + pos0 + 16, dir); \
      const u16* u0 = p.U + (size_t)R0 * UW + h * 128 + seg * 8;                            \
      const u16* u1 = p.U + (size_t)R1 * UW + h * 128 + seg * 8;                            \
      pq0 = *(const uint4*)u0; pq1 = *(const uint4*)u1;                                     \
      pk0 = *(const uint4*)(u0 + 512 + dir * 512); pk1 = *(const uint4*)(u1 + 512 + dir * 512); \
      pv0 = *(const uint4*)(u0 + 1536); pv1 = *(const uint4*)(u1 + 1536);                   \
    }
    HG_PREFETCH(c0)
#pragma unroll 1
    for (int chunk = c0; chunk < c1; ++chunk) {
      {
        int pos0 = tid >> 4, seg = tid & 15;
        *(uint4*)(qs + pos0 * QS + seg * 8) = pq0; *(uint4*)(qs + (pos0 + 16) * QS + seg * 8) = pq1;
        *(uint4*)(ks + pos0 * QS + seg * 8) = pk0; *(uint4*)(ks + (pos0 + 16) * QS + seg * 8) = pk1;
        FragU f0, f1; f0.q = pv0; f1.q = pv1;
#pragma unroll
        for (int j = 0; j < 4; ++j) {
          vT[(seg * 8 + 2 * j) * TS + pos0] = (u16)(f0.u[j] & 0xffffu); vT[(seg * 8 + 2 * j + 1) * TS + pos0] = (u16)(f0.u[j] >> 16);
          vT[(seg * 8 + 2 * j) * TS + pos0 + 16] = (u16)(f1.u[j] & 0xffffu); vT[(seg * 8 + 2 * j + 1) * TS + pos0 + 16] = (u16)(f1.u[j] >> 16);
        }
      }
      __syncthreads();
      if (chunk + 1 < c1) HG_PREFETCH(chunk + 1)
      const int Rout = pos2row_seq(b, chunk * 32 + r, dir);
      u16* yrow = p.Y2 + (size_t)Rout * 1024 + h * 128 + wave * 32 + 4 * hh;
      uint2 yold[4];
      if (PASS == 1 && dir == 1) {
#pragma unroll
        for (int q4 = 0; q4 < 4; ++q4) yold[q4] = *(const uint2*)(yrow + 8 * q4);
      }
      float gl[16];
      {
        float run = 0.f;
#pragma unroll
        for (int i = 0; i < 16; ++i) {
          float kkv = bf2f(ks[(half * 16 + i) * QS + dd]);
          run += __logf(fmaxf(1.f - kkv, 1e-6f));
          gl[i] = run;
        }
        tot[half * 128 + dd] = run;
      }
      __syncthreads();
      {
        const float t0 = tot[dd], t1 = tot[128 + dd];
        const float off = half ? t0 : 0.f;
        const float g31 = t0 + t1;
        float k2[16];
#pragma unroll
        for (int i = 0; i < 16; ++i) {
          const int pos = half * 16 + i;
          const float g = gl[i] + off;
          const float kkv = bf2f(ks[pos * QS + dd]);
          const float qv = bf2f(qs[pos * QS + dd]);
          qs[pos * QS + dd] = f2bf(qv * __expf(g));
          ks[pos * QS + dd] = f2bf(kkv * __expf(fminf(-g, 60.f)));
          k2[i] = kkv * __expf(g31 - g);
        }
        *(uint4*)(kT + dd * TS + half * 16) = pack8(k2);
        *(uint4*)(kT + dd * TS + half * 16 + 8) = pack8(k2 + 8);
        if (half == 0) eg[dd] = __expf(g31);
        gsum += g31;
      }
      __syncthreads();
      f32x16 O;
      if (PASS == 1) {
      f32x16 att;
#pragma unroll
      for (int q = 0; q < 16; ++q) att[q] = 0.f;
#pragma unroll
      for (int k8 = 0; k8 < 8; ++k8) {
        bf16x8 A = *(const bf16x8*)(ks + r * QS + 16 * k8 + 8 * hh);
        bf16x8 B = *(const bf16x8*)(qs + r * QS + 16 * k8 + 8 * hh);
        att = __builtin_amdgcn_mfma_f32_32x32x16_bf16(A, B, att, 0, 0, 0);
      }
#pragma unroll
      for (int q = 0; q < 16; ++q) {
        int sidx = (q & 3) + 8 * (q >> 2) + 4 * hh;
        if (sidx > r) att[q] = 0.f;
      }
#pragma unroll
      for (int q = 0; q < 16; ++q) O[q] = 0.f;
#pragma unroll
      for (int dt = 0; dt < 4; ++dt)
#pragma unroll
        for (int s2 = 0; s2 < 2; ++s2) {
          bf16x8 A = cvt_frag(S[dt], s2);
          bf16x8 B = ld_frag_perm(qs + r * QS + 32 * dt + 16 * s2 + 4 * hh);
          O = __builtin_amdgcn_mfma_f32_32x32x16_bf16(A, B, O, 0, 0, 0);
        }
#pragma unroll
      for (int s2 = 0; s2 < 2; ++s2) {
        bf16x8 A = ld_frag_perm(vT + (32 * wave + r) * TS + 16 * s2 + 4 * hh);
        bf16x8 B = cvt_frag(att, s2);
        O = __builtin_amdgcn_mfma_f32_32x32x16_bf16(A, B, O, 0, 0, 0);
      }
      }
#pragma unroll
      for (int dt = 0; dt < 4; ++dt) {
#pragma unroll
        for (int q4 = 0; q4 < 4; ++q4) {
          float4 e4 = *(const float4*)(eg + 32 * dt + 8 * q4 + 4 * hh);
          S[dt][4 * q4 + 0] *= e4.x; S[dt][4 * q4 + 1] *= e4.y; S[dt][4 * q4 + 2] *= e4.z; S[dt][4 * q4 + 3] *= e4.w;
        }
#pragma unroll
        for (int s2 = 0; s2 < 2; ++s2) {
          bf16x8 A = *(const bf16x8*)(kT + (32 * dt + r) * TS + 16 * s2 + 8 * hh);
          bf16x8 B = *(const bf16x8*)(vT + (32 * wave + r) * TS + 16 * s2 + 8 * hh);
          S[dt] = __builtin_amdgcn_mfma_f32_32x32x16_bf16(A, B, S[dt], 0, 0, 0);
        }
      }
      if (PASS == 1) {
#pragma unroll
      for (int q4 = 0; q4 < 4; ++q4) {
        float o0 = O[4 * q4], o1 = O[4 * q4 + 1], o2 = O[4 * q4 + 2], o3 = O[4 * q4 + 3];
        if (dir == 1) { o0 += bflo(yold[q4].x); o1 += bfhi(yold[q4].x); o2 += bflo(yold[q4].y); o3 += bfhi(yold[q4].y); }
        uint2 ov; ov.x = pack2(o0, o1); ov.y = pack2(o2, o3);
        *(uint2*)(yrow + 8 * q4) = ov;
      }
      }
      __syncthreads();
    }
    if (PASS == 0) {
      const size_t sidx = (size_t)((task * 2 + dir) * 8 + sbd);
      if (half == 0) p.PS[sidx * 128 + dd] = gsum;
      float* sp = p.SSH + sidx * 16384 + (size_t)wave * 4096 + lane;
#pragma unroll
      for (int dt = 0; dt < 4; ++dt)
#pragma unroll
        for (int q = 0; q < 16; ++q) sp[(dt * 16 + q) * 64] = S[dt][q];
    }
    __syncthreads();
  }
}

#if M2_MFMA
#define M2_NTASK 16
template <int PASS>
__device__ __forceinline__ void m2_mfma(const P& p, int l, int task, int blk, int dir0, unsigned char* smem) {
  int tid = threadIdx.x; asm volatile("" : "+v"(tid)); const int wave = tid >> 6, lane = tid & 63;
  const int r = lane & 31, hh = lane >> 5;
  const int b = task >> 2, g = (task >> 1) & 1, hp = task & 1;
  const int hq = wave >> 1, ph = wave & 1;
  const int head = 4 * g + 2 * hp + hq;
  u16* Bm = (u16*)smem;
  u16* Cm = Bm + 32 * QS;
  u16* BmT = Cm + 32 * QS;
  u16* xsT = BmT + 128 * TS;
  float* Gs = (float*)(xsT + 128 * TS);
  float* dts = Gs + 64;
  float* wl = dts + 64;
  const int cp = (lane < 48) ? lane : 47;
  const bool act = lane < 48;
  const int chW = (cp < 16) ? ((4 * g + 2 * hp) * 64 + cp * 8) : (cp < 32) ? (512 + g * 128 + (cp - 16) * 8) : (768 + g * 128 + (cp - 32) * 8);
  const int chU = 2048 + chW;
  float* SSM = (float*)p.KF;
  for (int dir = (PASS == 0 ? dir0 : 0); dir < (PASS == 0 ? dir0 + 1 : 2); ++dir) {
    const int sbd = (PASS == 0) ? blk : ((blk == 0) ? 0 : (dir ? 9 - blk : blk));
    const int c0 = (sbd == 0) ? 0 : 8 + 16 * (sbd - 1);
    const int c1 = (sbd == 0) ? 8 : 8 + 16 * sbd;
    float lsum = 0.f;
    const float* cw = p.m2_conv_w + (size_t)(l * 2 + dir) * 4 * 1024;
    const float* cb = p.m2_conv_b + (size_t)(l * 2 + dir) * 1024;
    if (wave == 0) {
#pragma unroll
      for (int j = 0; j < 8; ++j) {
        wl[(4 * 8 + j) * 64 + lane] = cb[chW + j];
#pragma unroll
        for (int tap = 0; tap < 4; ++tap) wl[(tap * 8 + j) * 64 + lane] = cw[tap * 1024 + chW + j];
      }
    }
    __syncthreads();
    const int hd_t = 4 * g + 2 * hp + ((tid >> 5) & 1);
    const float dtb = p.m2_dt_bias[(l * 2 + dir) * 8 + hd_t];
    const float Aneg_t = -__expf(p.m2_a_log[(l * 2 + dir) * 8 + hd_t]);
    const float Dsk = p.m2_d[(l * 2 + dir) * 8 + head];
    f32x16 S[4];
#pragma unroll
    for (int i = 0; i < 4; ++i)
#pragma unroll
      for (int q = 0; q < 16; ++q) S[i][q] = 0.f;
    if (PASS == 1) {
      for (int qb = 0; qb < sbd; ++qb) {
        const size_t sidx = (size_t)((task * 2 + dir) * 8 + qb);
        const float a = __expf(p.PA[sidx * 4 + wave]);
        const float* sp = SSM + sidx * 16384 + (size_t)wave * 4096 + lane;
#pragma unroll
        for (int nt = 0; nt < 4; ++nt)
#pragma unroll
          for (int q = 0; q < 16; ++q) S[nt][q] = S[nt][q] * a + sp[(nt * 16 + q) * 64];
      }
    }
    uint4 raw0, raw1, raw2, raw3, raw4, raw5, raw6, raw7, raw8, raw9, raw10;
    float dtraw = 0.f;
#define M2_LD1(RW, I, CH)                                                                  \
    {                                                                                      \
      int pt = (CH) * 32 + wave * 8 + (I) - 3;                                             \
      int sg0 = ((CH) * 32 < 256) ? 0 : 256;                                               \
      if (pt >= sg0) { int Rr = pos2row_m2(b, pt, dir); RW = *(const uint4*)(p.U + (size_t)Rr * UW + chU); } \
      else RW = make_uint4(0u, 0u, 0u, 0u);                                                \
    }
#define M2_PREFETCH(CH)                                                                    \
    M2_LD1(raw0, 0, CH) M2_LD1(raw1, 1, CH) M2_LD1(raw2, 2, CH) M2_LD1(raw3, 3, CH) M2_LD1(raw4, 4, CH) M2_LD1(raw5, 5, CH) \
    M2_LD1(raw6, 6, CH) M2_LD1(raw7, 7, CH) M2_LD1(raw8, 8, CH) M2_LD1(raw9, 9, CH) M2_LD1(raw10, 10, CH)            \
    if (tid < 64) { int Rr = pos2row_m2(b, (CH) * 32 + (tid & 31), dir); dtraw = p.DT[(size_t)Rr * 8 + hd_t]; }
    M2_PREFETCH(c0)
#pragma unroll 1
    for (int chunk = c0; chunk < c1; ++chunk) {
      {
#define M2_RAWF(RW, J) (((J) & 1) ? bfhi((RW)) : bflo((RW)))
#define M2_CH(J, C0, C1, C2, C3, C4, C5, C6, C7, C8, C9, C10)                               \
        {                                                                                  \
          const float q0 = wl[(0 * 8 + (J)) * 64 + lane], q1 = wl[(1 * 8 + (J)) * 64 + lane]; \
          const float q2 = wl[(2 * 8 + (J)) * 64 + lane], q3 = wl[(3 * 8 + (J)) * 64 + lane]; \
          const float qb = wl[(4 * 8 + (J)) * 64 + lane];                                  \
          const float v0 = M2_RAWF(C0, J), v1 = M2_RAWF(C1, J), v2 = M2_RAWF(C2, J), v3 = M2_RAWF(C3, J); \
          const float v4 = M2_RAWF(C4, J), v5 = M2_RAWF(C5, J), v6 = M2_RAWF(C6, J), v7 = M2_RAWF(C7, J); \
          const float v8 = M2_RAWF(C8, J), v9 = M2_RAWF(C9, J), v10 = M2_RAWF(C10, J);      \
          float o[8];                                                                      \
          o[0] = siluf(qb + q0 * v0 + q1 * v1 + q2 * v2 + q3 * v3);                        \
          o[1] = siluf(qb + q0 * v1 + q1 * v2 + q2 * v3 + q3 * v4);                        \
          o[2] = siluf(qb + q0 * v2 + q1 * v3 + q2 * v4 + q3 * v5);                        \
          o[3] = siluf(qb + q0 * v3 + q1 * v4 + q2 * v5 + q3 * v6);                        \
          o[4] = siluf(qb + q0 * v4 + q1 * v5 + q2 * v6 + q3 * v7);                        \
          o[5] = siluf(qb + q0 * v5 + q1 * v6 + q2 * v7 + q3 * v8);                        \
          o[6] = siluf(qb + q0 * v6 + q1 * v7 + q2 * v8 + q3 * v9);                        \
          o[7] = siluf(qb + q0 * v7 + q1 * v8 + q2 * v9 + q3 * v10);                       \
          if (act) {                                                                       \
            if (cp < 16) {                                                                 \
              *(uint4*)(xsT + (cp * 8 + (J)) * TS + wave * 8) = pack8(o);                  \
            } else if (cp < 32) {                                                          \
              *(uint4*)(BmT + ((cp - 16) * 8 + (J)) * TS + wave * 8) = pack8(o);           \
              _Pragma("unroll") for (int i = 0; i < 8; ++i) Bm[(wave * 8 + i) * QS + (cp - 16) * 8 + (J)] = f2bf(o[i]); \
            } else {                                                                       \
              _Pragma("unroll") for (int i = 0; i < 8; ++i) Cm[(wave * 8 + i) * QS + (cp - 32) * 8 + (J)] = f2bf(o[i]); \
            }                                                                              \
          }                                                                                \
        }
        M2_CH(0, raw0.x, raw1.x, raw2.x, raw3.x, raw4.x, raw5.x, raw6.x, raw7.x, raw8.x, raw9.x, raw10.x)
        M2_CH(1, raw0.x, raw1.x, raw2.x, raw3.x, raw4.x, raw5.x, raw6.x, raw7.x, raw8.x, raw9.x, raw10.x)
        M2_CH(2, raw0.y, raw1.y, raw2.y, raw3.y, raw4.y, raw5.y, raw6.y, raw7.y, raw8.y, raw9.y, raw10.y)
        M2_CH(3, raw0.y, raw1.y, raw2.y, raw3.y, raw4.y, raw5.y, raw6.y, raw7.y, raw8.y, raw9.y, raw10.y)
        M2_CH(4, raw0.z, raw1.z, raw2.z, raw3.z, raw4.z, raw5.z, raw6.z, raw7.z, raw8.z, raw9.z, raw10.z)
        M2_CH(5, raw0.z, raw1.z, raw2.z, raw3.z, raw4.z, raw5.z, raw6.z, raw7.z, raw8.z, raw9.z, raw10.z)
        M2_CH(6, raw0.w, raw1.w, raw2.w, raw3.w, raw4.w, raw5.w, raw6.w, raw7.w, raw8.w, raw9.w, raw10.w)
        M2_CH(7, raw0.w, raw1.w, raw2.w, raw3.w, raw4.w, raw5.w, raw6.w, raw7.w, raw8.w, raw9.w, raw10.w)
      }
      if (tid < 64) {
        float dtv = softplusf(dtraw + dtb);
        float run = dtv * Aneg_t;
#pragma unroll
        for (int o = 1; o < 32; o <<= 1) { float n = __shfl_up(run, o, 32); if ((tid & 31) >= o) run += n; }
        Gs[tid] = run; dts[tid] = dtv;
      }
      __syncthreads();
      if (chunk + 1 < c1) { M2_PREFETCH(chunk + 1) }
      const int Rout = pos2row_m2(b, chunk * 32 + r, dir);
      u16* yrow = p.Y2 + (size_t)Rout * 1024 + 512 + head * 64 + 32 * ph + 4 * hh;
      uint2 yold[4];
      if (PASS == 1 && dir == 1) {
#pragma unroll
        for (int i = 0; i < 4; ++i) yold[i] = *(const uint2*)(yrow + 8 * i);
      }
      const float* Gw = Gs + hq * 32; const float* dw = dts + hq * 32;
      const float Gt = Gw[r], G31 = Gw[31];
      lsum += G31;
      const u16* xw = xsT + (hq * 64 + ph * 32) * TS;
      f32x16 O0;
      if (PASS == 1) {
      f32x16 att;
#pragma unroll
      for (int q = 0; q < 16; ++q) att[q] = 0.f;
#pragma unroll
      for (int k8 = 0; k8 < 8; ++k8) {
        bf16x8 A = *(const bf16x8*)(Bm + r * QS + 16 * k8 + 8 * hh);
        bf16x8 B = *(const bf16x8*)(Cm + r * QS + 16 * k8 + 8 * hh);
        att = __builtin_amdgcn_mfma_f32_32x32x16_bf16(A, B, att, 0, 0, 0);
      }
#pragma unroll
      for (int q4 = 0; q4 < 4; ++q4) {
        float4 gs4 = *(const float4*)(Gw + 8 * q4 + 4 * hh);
        float4 dt4 = *(const float4*)(dw + 8 * q4 + 4 * hh);
        int s0 = 8 * q4 + 4 * hh;
        att[4 * q4 + 0] = (s0 + 0 <= r) ? att[4 * q4 + 0] * __expf(Gt - gs4.x) * dt4.x : 0.f;
        att[4 * q4 + 1] = (s0 + 1 <= r) ? att[4 * q4 + 1] * __expf(Gt - gs4.y) * dt4.y : 0.f;
        att[4 * q4 + 2] = (s0 + 2 <= r) ? att[4 * q4 + 2] * __expf(Gt - gs4.z) * dt4.z : 0.f;
        att[4 * q4 + 3] = (s0 + 3 <= r) ? att[4 * q4 + 3] * __expf(Gt - gs4.w) * dt4.w : 0.f;
      }
#pragma unroll
      for (int q = 0; q < 16; ++q) O0[q] = 0.f;
#pragma unroll
      for (int nt = 0; nt < 4; ++nt)
#pragma unroll
        for (int s2 = 0; s2 < 2; ++s2) {
          bf16x8 B = ld_frag_perm(Cm + r * QS + 32 * nt + 16 * s2 + 4 * hh);
          O0 = __builtin_amdgcn_mfma_f32_32x32x16_bf16(cvt_frag(S[nt], s2), B, O0, 0, 0, 0);
        }
      {
        const float eGt = __expf(Gt);
#pragma unroll
        for (int q = 0; q < 16; ++q) O0[q] *= eGt;
      }
#pragma unroll
      for (int s2 = 0; s2 < 2; ++s2) {
        bf16x8 B = cvt_frag(att, s2);
        O0 = __builtin_amdgcn_mfma_f32_32x32x16_bf16(ld_frag_perm(xw + r * TS + 16 * s2 + 4 * hh), B, O0, 0, 0, 0);
      }
#pragma unroll
      for (int q = 0; q < 16; ++q) {
        int pp = (q & 3) + 8 * (q >> 2) + 4 * hh;
        O0[q] += Dsk * bf2f(xw[pp * TS + r]);
      }
      }
      {
        const float eG31 = __expf(G31);
#pragma unroll
        for (int nt = 0; nt < 4; ++nt)
#pragma unroll
          for (int q = 0; q < 16; ++q) S[nt][q] *= eG31;
#pragma unroll
        for (int s2 = 0; s2 < 2; ++s2) {
          float ws[8];
          {
            float4 ga = *(const float4*)(Gw + 16 * s2 + 8 * hh), gb = *(const float4*)(Gw + 16 * s2 + 8 * hh + 4);
            float4 da = *(const float4*)(dw + 16 * s2 + 8 * hh), db = *(const float4*)(dw + 16 * s2 + 8 * hh + 4);
            ws[0] = da.x * __expf(G31 - ga.x); ws[1] = da.y * __expf(G31 - ga.y); ws[2] = da.z * __expf(G31 - ga.z); ws[3] = da.w * __expf(G31 - ga.w);
            ws[4] = db.x * __expf(G31 - gb.x); ws[5] = db.y * __expf(G31 - gb.y); ws[6] = db.z * __expf(G31 - gb.z); ws[7] = db.w * __expf(G31 - gb.w);
          }
          bf16x8 Bf0;
          {
            float f[8]; unpack8(*(const uint4*)(xw + r * TS + 16 * s2 + 8 * hh), f);
#pragma unroll
            for (int j = 0; j < 8; ++j) f[j] *= ws[j];
            FragU u; u.q = pack8(f); Bf0 = u.v;
          }
#pragma unroll
          for (int nt = 0; nt < 4; ++nt) {
            bf16x8 A = *(const bf16x8*)(BmT + (32 * nt + r) * TS + 16 * s2 + 8 * hh);
            S[nt] = __builtin_amdgcn_mfma_f32_32x32x16_bf16(A, Bf0, S[nt], 0, 0, 0);
          }
        }
      }
      if (PASS == 1) {
#pragma unroll
      for (int q4 = 0; q4 < 4; ++q4) {
        float o0 = O0[4 * q4], o1 = O0[4 * q4 + 1], o2 = O0[4 * q4 + 2], o3 = O0[4 * q4 + 3];
        if (dir == 1) { o0 += bflo(yold[q4].x); o1 += bfhi(yold[q4].x); o2 += bflo(yold[q4].y); o3 += bfhi(yold[q4].y); }
        uint2 ov; ov.x = pack2(o0, o1); ov.y = pack2(o2, o3);
        *(uint2*)(yrow + 8 * q4) = ov;
      }
      }
      __syncthreads();
    }
    if (PASS == 0) {
      const size_t sidx = (size_t)((task * 2 + dir) * 8 + sbd);
      if (lane == 0) p.PA[sidx * 4 + wave] = lsum;
      float* sp = SSM + sidx * 16384 + (size_t)wave * 4096 + lane;
#pragma unroll
      for (int nt = 0; nt < 4; ++nt)
#pragma unroll
        for (int q = 0; q < 16; ++q) sp[(nt * 16 + q) * 64] = S[nt][q];
    }
    __syncthreads();
  }
}
#endif
__device__ __forceinline__ void ph_mixA0(const P& p, int l, int bid, int nb, unsigned char* sm) {
  for (int t = bid; t < 512; t += nb) {
    if (t < 256) hg_mfma<0>(p, l, t >> 4, (t >> 1) & 7, t & 1, sm);
    else { int u = t - 256; m2_mfma<0>(p, l, u >> 4, (u >> 1) & 7, u & 1, sm); }
    __syncthreads();
  }
}
__device__ __forceinline__ void ph_mixA1(const P& p, int l, int bid, int nb, unsigned char* sm) {
  for (int t = bid; t < 288; t += nb) {
    if (t < 128) hg_mfma<1>(p, l, t >> 3, 1 + (t & 7), 0, sm);
    else if (t < 256) { int u = t - 128; m2_mfma<1>(p, l, u >> 3, 1 + (u & 7), 0, sm); }
    else if (t < 272) hg_mfma<1>(p, l, t - 256, 0, 0, sm);
    else m2_mfma<1>(p, l, t - 272, 0, 0, sm);
    __syncthreads();
  }
}

template <int PASS>
__device__ __forceinline__ void rg_task(const P& p, int l, int task, float* sm) {
  int tid = threadIdx.x; asm volatile("" : "+v"(tid));
  const int wave = tid >> 6, lane = tid & 63;
  const int b = task / 136, rem = task % 136, head = rem / 17, sb = rem % 17;
  float* xc = sm;
  float* pa = sm + 2048;
  float* pb = sm + 4096;
  u16* xcb = (u16*)(sm + 6144);
  u16* WTl = xcb + 32 * 72;
  const int j = tid & 63;
  const int spos = tid >> 3, sseg = tid & 7;
  const int sch = head * 64 + sseg * 8;
  const u16* UB2 = p.U + (size_t)NTOK * 2048;
  for (int dir = 0; dir < 2; ++dir) {
    const int ld = l * 2 + dir;
    {
      const float* wa = p.rg_wa + (size_t)(ld * 8 + head) * 4096;
      const float* wx = p.rg_wx + (size_t)(ld * 8 + head) * 4096;
#pragma unroll
      for (int it = 0; it < 4; ++it) {
        int i = (tid >> 4) + 16 * it, j4 = (tid & 15) * 4;
        float4 va = *(const float4*)(wa + i * 64 + j4);
        float4 vx = *(const float4*)(wx + i * 64 + j4);
        WTl[(j4 + 0) * 72 + i] = f2bf(va.x); WTl[(j4 + 1) * 72 + i] = f2bf(va.y);
        WTl[(j4 + 2) * 72 + i] = f2bf(va.z); WTl[(j4 + 3) * 72 + i] = f2bf(va.w);
        WTl[(64 + j4 + 0) * 72 + i] = f2bf(vx.x); WTl[(64 + j4 + 1) * 72 + i] = f2bf(vx.y);
        WTl[(64 + j4 + 2) * 72 + i] = f2bf(vx.z); WTl[(64 + j4 + 3) * 72 + i] = f2bf(vx.w);
      }
    }
    float wcv[4][8], bcv[8];
#pragma unroll
    for (int jj = 0; jj < 8; ++jj) {
      bcv[jj] = p.rg_conv_b[(size_t)ld * 512 + sch + jj];
#pragma unroll
      for (int tap = 0; tap < 4; ++tap) wcv[tap][jj] = p.rg_conv_w[((size_t)ld * 4 + tap) * 512 + sch + jj];
    }
    const int chg = head * 64 + j;
    const float g_ba = p.rg_ba[ld * 512 + chg], g_bx = p.rg_bx[ld * 512 + chg];
    const float g_sp = -8.0f * softplusf(-p.rg_lam[ld * 512 + chg]);
    const int sbd = (PASS == 0) ? sb : (dir ? (sb == 0 ? 0 : 17 - sb) : sb);
    float hcarry = 0.f, aprod = 1.f;
    if (PASS == 1 && tid < 64) {
      float2 sv[16];
#pragma unroll
      for (int q = 0; q < 16; ++q) {
        const float2* sp = (const float2*)(p.SUM + ((((size_t)b * 2 + dir) * 17 + q) * 512 + head * 64 + tid) * 2);
        sv[q] = (q < sbd) ? *sp : make_float2(1.f, 0.f);
      }
#pragma unroll
      for (int q = 0; q < 16; ++q) hcarry = sv[q].x * hcarry + sv[q].y;
    }
    uint4 xr0, xr1, xr2, xr3;
#define RG_LD1(XR, TAP, CH)                                                               \
    {                                                                                     \
      int pt = (CH) * 32 + spos - 3 + (TAP);                                              \
      int sg0 = ((CH) * 32 < 256) ? 0 : 256;                                              \
      if (pt >= sg0) { int Rr = pos2row_seq(b, pt, dir); XR = *(const uint4*)(UB2 + (size_t)Rr * 2048 + sch); } \
      else XR = make_uint4(0u, 0u, 0u, 0u);                                               \
    }
#define RG_PREFETCH(CH) RG_LD1(xr0, 0, CH) RG_LD1(xr1, 1, CH) RG_LD1(xr2, 2, CH) RG_LD1(xr3, 3, CH)
    RG_PREFETCH(sbd * 8)
#pragma unroll 1
    for (int chunk = sbd * 8; chunk < sbd * 8 + 8; ++chunk) {
      const int pbase = chunk * 32;
      {
        float a[8], f[8];
#pragma unroll
        for (int jj = 0; jj < 8; ++jj) a[jj] = bcv[jj];
        unpack8(xr0, f);
#pragma unroll
        for (int jj = 0; jj < 8; ++jj) a[jj] += wcv[0][jj] * f[jj];
        unpack8(xr1, f);
#pragma unroll
        for (int jj = 0; jj < 8; ++jj) a[jj] += wcv[1][jj] * f[jj];
        unpack8(xr2, f);
#pragma unroll
        for (int jj = 0; jj < 8; ++jj) a[jj] += wcv[2][jj] * f[jj];
        unpack8(xr3, f);
#pragma unroll
        for (int jj = 0; jj < 8; ++jj) a[jj] += wcv[3][jj] * f[jj];
        *(float4*)(xc + spos * 64 + sseg * 8) = make_float4(a[0], a[1], a[2], a[3]);
        *(float4*)(xc + spos * 64 + sseg * 8 + 4) = make_float4(a[4], a[5], a[6], a[7]);
        *(uint4*)(xcb + spos * 72 + sseg * 8) = pack8(a);
      }
      __syncthreads();
      if (chunk + 1 < sbd * 8 + 8) { RG_PREFETCH(chunk + 1) }
      const int Rout = pos2row_seq(b, pbase + spos, dir);
      uint4* yp = (uint4*)(p.HL + (size_t)Rout * 1024 + 512 + sch);
      uint4 prev, gv;
      if (PASS == 1 && dir == 1) { prev = *yp; gv = *(const uint4*)(UB2 + (size_t)Rout * 2048 + 512 + sch); }
      {
        const int r = lane & 31, hh = lane >> 5;
        f32x16 acc;
#pragma unroll
        for (int q = 0; q < 16; ++q) acc[q] = 0.f;
#pragma unroll
        for (int ks = 0; ks < 4; ++ks) {
          bf16x8 A = *(const bf16x8*)(xcb + r * 72 + 16 * ks + 8 * hh);
          bf16x8 B = *(const bf16x8*)(WTl + (32 * wave + r) * 72 + 16 * ks + 8 * hh);
          acc = __builtin_amdgcn_mfma_f32_32x32x16_bf16(A, B, acc, 0, 0, 0);
        }
        float* dstp = (wave < 2) ? pa : pb;
        const int jc = (wave & 1) * 32 + r;
#pragma unroll
        for (int q = 0; q < 16; ++q) dstp[((q & 3) + 8 * (q >> 2) + 4 * hh) * 64 + jc] = acc[q];
      }
      __syncthreads();
#pragma unroll
      for (int i = 0; i < 8; ++i) {
        int e = tid + 256 * i;
        float r = sigmf(pa[e] + g_ba);
        float gi = sigmf(pb[e] + g_bx);
        float la = g_sp * r;
        float a = __expf(la);
        float bt = sqrtf(fmaxf(1.f - a * a, 0.f)) * gi * xc[e];
        pa[e] = a; pb[e] = bt;
      }
      __syncthreads();
      if (tid < 64) {
        float hh = hcarry;
#pragma unroll 8
        for (int pos = 0; pos < 32; ++pos) { float av = pa[pos * 64 + tid]; hh = av * hh + pb[pos * 64 + tid]; pb[pos * 64 + tid] = hh; aprod *= av; }
        hcarry = hh;
      }
      __syncthreads();
      if (PASS == 1) {
        float hv[8];
#pragma unroll
        for (int jj = 0; jj < 8; ++jj) hv[jj] = pb[spos * 64 + sseg * 8 + jj];
        if (dir == 1) {
          float f[8]; unpack8(prev, f);
          float gf[8]; unpack8(gv, gf);
#pragma unroll
          for (int jj = 0; jj < 8; ++jj) hv[jj] = (hv[jj] + f[jj]) * gf[jj];
        }
        *yp = pack8(hv);
      }
    }
    if (PASS == 0 && tid < 64) {
      float* sp = p.SUM + ((((size_t)b * 2 + dir) * 17 + sbd) * 512 + head * 64 + tid) * 2;
      sp[0] = aprod; sp[1] = hcarry;
    }
    __syncthreads();
  }
}

typedef bf16x8 __attribute__((aligned(2))) bf16x8_u;
typedef uint4 __attribute__((aligned(4))) uint4_a4;
__device__ __forceinline__ bf16x8 ld_win8(const u16* base, int y, uint32_t sh) {
  const uint32_t* wp = (const uint32_t*)base + (y >> 1);
  uint4 w = *(const uint4_a4*)wp;
  uint32_t w4 = wp[4];
  FragU f;
  f.u[0] = __builtin_amdgcn_alignbit(w.y, w.x, sh);
  f.u[1] = __builtin_amdgcn_alignbit(w.z, w.y, sh);
  f.u[2] = __builtin_amdgcn_alignbit(w.w, w.z, sh);
  f.u[3] = __builtin_amdgcn_alignbit(w4, w.w, sh);
  return f.v;
}

__device__ __forceinline__ void hy_conv3x8(const u16* col, int t8, int n, float w0, float w1, float w2, float bias, float* out) {
  float f[8]; unpack8(*(const uint4*)(col + t8), f);
  float prev = (t8 > 0) ? bf2f(col[t8 - 1]) : 0.f;
  float next = (t8 + 8 < n) ? bf2f(col[t8 + 8]) : 0.f;
#pragma unroll
  for (int j = 0; j < 8; ++j) {
    float a = (j == 0) ? prev : f[j - 1];
    float cnx = (j == 7) ? next : f[j + 1];
    out[j] = bias + w0 * a + w1 * f[j] + w2 * cnx;
  }
}

__device__ __forceinline__ void hy_task(const P& p, int l, int c, float* sm) {
  int tid = threadIdx.x; asm volatile("" : "+v"(tid)); const int wave = tid >> 6, lane = tid & 63;
  const int r = lane & 31, h = lane >> 5;
  u16* krr = (u16*)sm;
  u16* zs = krr + 8192 + 64;
  float* red = (float*)(zs + 16384);
  const u16* UT = p.U;
  const float* cwp = p.hy_conv_w + (size_t)l * 3 * 1536;
  const float* cbp = p.hy_conv_b + (size_t)l * 1536;
  for (int o = 0; o < 2; ++o) {
    const u16* K = p.KF + (size_t)(o * 512 + c) * 8192;
    float asum = 0.f;
#pragma unroll
    for (int i = 0; i < 4; ++i) {
      int idx = (tid + 256 * i) * 8;
      uint4 v = *(const uint4*)(K + idx);
      *(uint4*)(krr + idx) = v;
      float f[8]; unpack8(v, f);
#pragma unroll
      for (int j = 0; j < 8; ++j) asum += fabsf(f[j]);
    }
    asum = wave_sum(asum);
    if (lane == 0) red[wave] = asum;
    if (o == 0) {
      const float w0 = cwp[c], w1 = cwp[1536 + c], w2 = cwp[3072 + c], bs = cbp[c];
#pragma unroll 2
      for (int e = tid; e < 2048; e += 256) {
        int b = e >> 9, t8 = (e & 511) * 8;
        float f[8];
        hy_conv3x8(UT + (size_t)c * NTOK + b * 4096, t8, 4096, w0, w1, w2, bs, f);
        *(uint4*)(zs + b * 4096 + t8) = pack8(f);
      }
    }
    __syncthreads();
    const float scale = 1.f / (red[0] + red[1] + red[2] + red[3] + 1e-6f);
    const float skip = p.hy_skip[(l * 2 + o) * 512 + c];
    f32x16 acc[2][2];
#pragma unroll
    for (int a = 0; a < 2; ++a)
#pragma unroll
      for (int b = 0; b < 2; ++b)
#pragma unroll
        for (int q = 0; q < 16; ++q) acc[a][b][q] = 0.f;
    const int I0 = wave * 16;
    const int Il0 = I0 + (r >> 2), Il1 = I0 + 8 + (r >> 2);
    const u16* zb = zs + (r & 3) * 4096 + 8 * h;
    const int ybase = 4096 - r + 8 * h + 48;
    bf16x8 F0, F1, F2, F3, F4, F5;
    const uint32_t ysh = (uint32_t)((ybase & 1) * 16);
    {
      const int y0 = ybase - 64 * (I0 - 63);
      F0 = ld_win8(krr, y0, ysh); F1 = ld_win8(krr, y0 - 16, ysh); F2 = ld_win8(krr, y0 - 32, ysh);
      F3 = ld_win8(krr, y0 - 48, ysh); F4 = ld_win8(krr, y0 - 64, ysh); F5 = ld_win8(krr, y0 - 80, ysh);
    }
#pragma unroll 1
    for (int D = I0 - 63; D <= I0 + 15; ++D) {
      bf16x8 B0[4], B1[4];
      {
        int J0 = Il0 - D, J1 = Il1 - D;
        bool ok0 = (unsigned)J0 < 64u, ok1 = (unsigned)J1 < 64u;
        const u16* zp0 = zb + 64 * J0; const u16* zp1 = zb + 64 * J1;
#pragma unroll
        for (int ks = 0; ks < 4; ++ks) {
          bf16x8 z0 = {0, 0, 0, 0, 0, 0, 0, 0}, z1 = {0, 0, 0, 0, 0, 0, 0, 0};
          if (ok0) z0 = *(const bf16x8*)(zp0 + 16 * ks);
          if (ok1) z1 = *(const bf16x8*)(zp1 + 16 * ks);
          B0[ks] = z0; B1[ks] = z1;
        }
      }
      acc[0][0] = __builtin_amdgcn_mfma_f32_32x32x16_bf16(F3, B0[0], acc[0][0], 0, 0, 0);
      acc[0][1] = __builtin_amdgcn_mfma_f32_32x32x16_bf16(F3, B1[0], acc[0][1], 0, 0, 0);
      acc[1][0] = __builtin_amdgcn_mfma_f32_32x32x16_bf16(F5, B0[0], acc[1][0], 0, 0, 0);
      acc[1][1] = __builtin_amdgcn_mfma_f32_32x32x16_bf16(F5, B1[0], acc[1][1], 0, 0, 0);
      acc[0][0] = __builtin_amdgcn_mfma_f32_32x32x16_bf16(F2, B0[1], acc[0][0], 0, 0, 0);
      acc[0][1] = __builtin_amdgcn_mfma_f32_32x32x16_bf16(F2, B1[1], acc[0][1], 0, 0, 0);
      acc[1][0] = __builtin_amdgcn_mfma_f32_32x32x16_bf16(F4, B0[1], acc[1][0], 0, 0, 0);
      acc[1][1] = __builtin_amdgcn_mfma_f32_32x32x16_bf16(F4, B1[1], acc[1][1], 0, 0, 0);
      acc[0][0] = __builtin_amdgcn_mfma_f32_32x32x16_bf16(F1, B0[2], acc[0][0], 0, 0, 0);
      acc[0][1] = __builtin_amdgcn_mfma_f32_32x32x16_bf16(F1, B1[2], acc[0][1], 0, 0, 0);
      acc[1][0] = __builtin_amdgcn_mfma_f32_32x32x16_bf16(F3, B0[2], acc[1][0], 0, 0, 0);
      acc[1][1] = __builtin_amdgcn_mfma_f32_32x32x16_bf16(F3, B1[2], acc[1][1], 0, 0, 0);
      acc[0][0] = __builtin_amdgcn_mfma_f32_32x32x16_bf16(F0, B0[3], acc[0][0], 0, 0, 0);
      acc[0][1] = __builtin_amdgcn_mfma_f32_32x32x16_bf16(F0, B1[3], acc[0][1], 0, 0, 0);
      acc[1][0] = __builtin_amdgcn_mfma_f32_32x32x16_bf16(F2, B0[3], acc[1][0], 0, 0, 0);
      acc[1][1] = __builtin_amdgcn_mfma_f32_32x32x16_bf16(F2, B1[3], acc[1][1], 0, 0, 0);
      F0 = F4; F1 = F5;
      if (D < I0 + 15) {
        const int y1 = ybase - 64 * (D + 1);
        F2 = ld_win8(krr, y1 - 32, ysh); F3 = ld_win8(krr, y1 - 48, ysh);
        F4 = ld_win8(krr, y1 - 64, ysh); F5 = ld_win8(krr, y1 - 80, ysh);
      }
    }
    __syncthreads();
#pragma unroll
    for (int ni = 0; ni < 2; ++ni) {
      u16* zc = zs + (r & 3) * 4096 + 64 * (ni ? Il1 : Il0);
#pragma unroll
      for (int mi = 0; mi < 2; ++mi)
#pragma unroll
        for (int q = 0; q < 16; ++q) {
          int i = 32 * mi + (q & 3) + 8 * (q >> 2) + 4 * h;
          float zo = bf2f(zc[i]);
          zc[i] = f2bf(scale * acc[mi][ni][q] + skip * zo);
        }
    }
    __syncthreads();
    {
      const int ch = (o + 1) * 512 + c;
      const float w0 = cwp[ch], w1 = cwp[1536 + ch], w2 = cwp[3072 + ch], bs = cbp[ch];
#pragma unroll 2
      for (int e = tid; e < 2048; e += 256) {
        int b = e >> 9, t8 = (e & 511) * 8;
        float xg[8], y[8];
        hy_conv3x8(UT + (size_t)ch * NTOK + b * 4096, t8, 4096, w0, w1, w2, bs, xg);
        unpack8(*(const uint4*)(zs + b * 4096 + t8), y);
#pragma unroll
        for (int j = 0; j < 8; ++j) y[j] *= xg[j];
        if (o == 0) *(uint4*)(zs + b * 4096 + t8) = pack8(y);
        else {
          float gf[8]; unpack8(*(const uint4*)(UT + (size_t)(1536 + c) * NTOK + b * 4096 + t8), gf);
#pragma unroll
          for (int j = 0; j < 8; ++j) y[j] *= gf[j];
          *(uint4*)(p.U + (size_t)c * NTOK + b * 4096 + t8) = pack8(y);
        }
      }
    }
    __syncthreads();
  }
  if (l == 0) {
    const int t = tid;
    for (int o = 0; o < 2; ++o) {
      const u16* K = p.KFC + (size_t)(o * 512 + c) * 512;
      float asum = 0.f;
      {
        uint32_t w2 = *(const uint32_t*)(K + tid * 2);
        *(uint32_t*)(krr + tid * 2) = w2;
        asum = fabsf(bflo(w2)) + fabsf(bfhi(w2));
      }
      asum = wave_sum(asum);
      if (lane == 0) red[wave] = asum;
      if (o == 0) {
        const float w0 = cwp[c], w1 = cwp[1536 + c], w2 = cwp[3072 + c], bs = cbp[c];
        if (tid < 128) {
          int b = tid >> 5, t8 = (tid & 31) * 8;
          float f[8];
          hy_conv3x8(UT + (size_t)c * NTOK + NLAT + b * 256, t8, 256, w0, w1, w2, bs, f);
          *(uint4*)(zs + b * 4096 + t8) = pack8(f);
        }
      }
      __syncthreads();
      const float scale = 1.f / (red[0] + red[1] + red[2] + red[3] + 1e-6f);
      float a0 = 0, a1 = 0, a2 = 0, a3 = 0;
      for (int s2 = 0; s2 < 256; ++s2) {
        float kv = bf2f(krr[256 - t + s2]);
        a0 += kv * bf2f(zs[s2]); a1 += kv * bf2f(zs[4096 + s2]); a2 += kv * bf2f(zs[8192 + s2]); a3 += kv * bf2f(zs[12288 + s2]);
      }
      const float skip = p.hy_skip[(l * 2 + o) * 512 + c];
      float y[4];
      y[0] = scale * a0 + skip * bf2f(zs[t]); y[1] = scale * a1 + skip * bf2f(zs[4096 + t]);
      y[2] = scale * a2 + skip * bf2f(zs[8192 + t]); y[3] = scale * a3 + skip * bf2f(zs[12288 + t]);
      __syncthreads();
      {
        const int ch = (o + 1) * 512 + c;
        const float w0 = cwp[ch], w1 = cwp[1536 + ch], w2 = cwp[3072 + ch], bs = cbp[ch];
#pragma unroll
        for (int b = 0; b < 4; ++b) {
          const u16* col = UT + (size_t)ch * NTOK + NLAT + b * 256;
          float xg = bs + w1 * bf2f(col[t]);
          if (t > 0) xg += w0 * bf2f(col[t - 1]);
          if (t < 255) xg += w2 * bf2f(col[t + 1]);
          float zn = xg * y[b];
          if (o == 0) zs[b * 4096 + t] = f2bf(zn);
          else {
            size_t R = (size_t)NLAT + b * 256 + t;
            float gate = bf2f(UT[(size_t)(1536 + c) * NTOK + R]);
            p.U[(size_t)c * NTOK + R] = f2bf(zn * gate);
          }
        }
      }
      __syncthreads();
    }
  }
}

__device__ __forceinline__ void fin_rows(const P& p, int l, int chunk) {
  int tid = threadIdx.x; asm volatile("" : "+v"(tid)); const int wave = tid >> 6, lane = tid & 63;
  for (int rr = 0; rr < 16; ++rr) {
    int R = chunk * 64 + wave * 16 + rr;
    {
      uint4* yp = (uint4*)(p.Y2 + (size_t)R * 1024 + lane * 8);
      float o[8]; unpack8(*yp, o);
      float ss = 0;
#pragma unroll
      for (int j = 0; j < 8; ++j) ss += o[j] * o[j];
      ss += __shfl_xor(ss, 1); ss += __shfl_xor(ss, 2); ss += __shfl_xor(ss, 4); ss += __shfl_xor(ss, 8);
      float rinv = rsqrtf(ss * (1.f / 128.f) + EPS);
      float gf[8]; unpack8(*(const uint4*)(p.U + (size_t)NTOK * 2048 + (size_t)R * 2048 + 1024 + lane * 8), gf);
#pragma unroll
      for (int j = 0; j < 8; ++j) o[j] = o[j] * rinv * p.hg_norm_w[l * 512 + lane * 8 + j] * gf[j];
      *yp = pack8(o);
    }
    {
      uint4* yp = (uint4*)(p.Y2 + (size_t)R * 1024 + 512 + lane * 8);
      float o[8]; unpack8(*yp, o);
      float gf[8]; unpack8(*(const uint4*)(p.U + (size_t)NTOK * 2048 + (size_t)R * 2048 + 1536 + lane * 8), gf);
      float ss = 0;
#pragma unroll
      for (int j = 0; j < 8; ++j) { o[j] *= gf[j]; ss += o[j] * o[j]; }
      ss += __shfl_xor(ss, 1); ss += __shfl_xor(ss, 2); ss += __shfl_xor(ss, 4); ss += __shfl_xor(ss, 8); ss += __shfl_xor(ss, 16);
      float rinv = rsqrtf(ss * (1.f / 256.f) + EPS);
#pragma unroll
      for (int j = 0; j < 8; ++j) o[j] = o[j] * rinv * p.m2_norm_w[l * 512 + lane * 8 + j];
      *yp = pack8(o);
    }
  }
}

__device__ __forceinline__ void ph_mixB(const P& p, int l, int bid, int nb, float* sm) {
  for (int t = bid; t < 544 + 512; t += nb) {
    if (t < 544) { if (EN_RG) rg_task<0>(p, l, t, sm); }
    else { if (EN_HY) hy_task(p, l, t - 544, sm); }
    __syncthreads();
  }
}
__device__ __forceinline__ void hy_transpose(const P& p, int tile, u16* sm) {
  int tid = threadIdx.x; asm volatile("" : "+v"(tid));
  const int ct = tile & 7, rt = tile >> 3;
  const int c0 = ct * 64, R0 = rt * 64;
#pragma unroll
  for (int i = 0; i < 2; ++i) {
    int q = tid + 256 * i; int cc = q >> 3, seg = q & 7;
    *(uint4*)(sm + cc * 72 + seg * 8) = *(const uint4*)(p.U + (size_t)(c0 + cc) * NTOK + R0 + seg * 8);
  }
  __syncthreads();
#pragma unroll
  for (int i = 0; i < 2; ++i) {
    int q = tid + 256 * i; int rr = q >> 3, seg = q & 7;
    FragU f;
#pragma unroll
    for (int j = 0; j < 4; ++j)
      f.u[j] = (uint32_t)sm[(seg * 8 + 2 * j) * 72 + rr] | ((uint32_t)sm[(seg * 8 + 2 * j + 1) * 72 + rr] << 16);
    *(uint4*)(p.HL + (size_t)(R0 + rr) * 1024 + c0 + seg * 8) = f.q;
  }
}
__device__ __forceinline__ void ph_mixB2(const P& p, int l, int bid, int nb, float* sm) {
  const int nfin = (l == 0 ? NTOK : NLAT) / 64;
  const int ntr = nfin * 8;
  for (int t = bid; t < 544 + nfin + ntr; t += nb) {
    if (t < 544) { if (EN_RG) rg_task<1>(p, l, t, sm); }
    else if (t < 544 + nfin) fin_rows(p, l, t - 544);
    else hy_transpose(p, t - 544 - nfin, (u16*)sm);
    __syncthreads();
  }
}
__device__ __forceinline__ void ph_final(const P& p, int bid, int nb) {
  int tid = threadIdx.x; asm volatile("" : "+v"(tid)); const int wave = tid >> 6, lane = tid & 63;
  for (int R = bid * 4 + wave; R < NLAT; R += nb * 4) {
    float4* rp = (float4*)(p.out + (size_t)R * 1024);
    float4 v[4]; float ss = 0;
#pragma unroll
    for (int i = 0; i < 4; ++i) {
      v[i] = rp[lane + i * 64];
      ss += v[i].x * v[i].x + v[i].y * v[i].y + v[i].z * v[i].z + v[i].w * v[i].w;
    }
    ss = wave_sum(ss);
    float rinv = rsqrtf(ss * (1.f / 1024.f) + EPS);
#pragma unroll
    for (int i = 0; i < 4; ++i) {
      float4 w = *(const float4*)(p.final_norm_w + (lane + i * 64) * 4);
      float4 o; o.x = v[i].x * rinv * w.x; o.y = v[i].y * rinv * w.y; o.z = v[i].z * rinv * w.z; o.w = v[i].w * rinv * w.w;
      rp[lane + i * 64] = o;
    }
  }
}

#define SMEM_BYTES 56320
__global__ void __launch_bounds__(256) mega(P p) {
  __shared__ __align__(16) unsigned char smem[SMEM_BYTES];
  cg::grid_group grid = cg::this_grid();
  const int bid = blockIdx.x, nb = gridDim.x;
  float* smf = (float*)smem; u16* smh = (u16*)smem;
#ifndef PHM
#define PHM 0xffff
#endif
  if (PHM & 1) ph_mod(p, bid, nb, smf);
  grid.sync();
  for (int l = 0; l < 2; ++l) {
    if (PHM & 2) ph_norm(p, l, bid, nb);
    if (PHM & 4) ph_wconv(p, l, bid, nb, smf);
    grid.sync();
    if (PHM & 16) ph_gemm<0>(p, l, bid, nb, smh);
    grid.sync();
#if PROBE_DUP == 3
    ph_gemm<0>(p, l, bid, nb, smh);
    grid.sync();
#endif
#if PROBE_DUP == 10
    ph_norm(p, l, bid, nb);
    ph_wconv(p, l, bid, nb, smf);
    grid.sync();
#endif
    if (PHM & 32) ph_mixA0(p, l, bid, nb, smem);
    grid.sync();
    if (PHM & 32) ph_mixA1(p, l, bid, nb, smem);
    grid.sync();
#if PROBE_DUP == 8
    ph_mixA0(p, l, bid, nb, smem);
    grid.sync();
    ph_mixA1(p, l, bid, nb, smem);
    grid.sync();
#endif
    if (PHM & 64) ph_gemm<1>(p, l, bid, nb, smh);
    if (PHM & 8) ph_filt(p, l, bid, nb, smf);
    grid.sync();
#if PROBE_DUP == 2
    ph_mixB(p, l, bid, nb, smf);
    grid.sync();
#endif
#if PROBE_DUP == 4
    ph_gemm<1>(p, l, bid, nb, smh);
    grid.sync();
#endif
#if PROBE_DUP == 9
    ph_gemm<1>(p, l, bid, nb, smh, 1);
    grid.sync();
#endif
    if (PHM & 128) ph_mixB(p, l, bid, nb, smf);
    grid.sync();
    if (PHM & 128) ph_mixB2(p, l, bid, nb, smf);
    grid.sync();
#if PROBE_DUP == 7
    for (int t = bid; t < 544; t += nb) { rg_task<1>(p, l, t, smf); __syncthreads(); }
    grid.sync();
#endif
    if (PHM & 256) ph_gemm<2>(p, l, bid, nb, smh);
    grid.sync();
  }
  if (PHM & 512) ph_final(p, bid, nb);
}

extern "C" void kernel_launch(void* const* d_in, const int* in_sizes, int n_in, void* d_out, int out_size,
                              void* d_ws, size_t ws_size, hipStream_t stream) {
  static int grid_blocks = 0;
  if (!grid_blocks) {
    int dev = 0, cus = 0, per_cu = 0;
    hipGetDevice(&dev);
    hipDeviceGetAttribute(&cus, hipDeviceAttributeMultiprocessorCount, dev);
    hipOccupancyMaxActiveBlocksPerMultiprocessor(&per_cu, mega, 256, 0);
    if (per_cu < 1) per_cu = 1;
    if (per_cu > 2) per_cu = 2;
    grid_blocks = cus * per_cu;
  }
  P p{};
  const float** fp = (const float**)&p;
  for (int i = 0; i < 34; ++i) fp[i] = (const float*)d_in[i];
  p.out = (float*)d_out;
  char* w = (char*)d_ws;
  size_t off = 0;
  auto take = [&](size_t bytes) { char* r = w + off; off += (bytes + 255) & ~(size_t)255; return r; };
  p.U = (u16*)take((size_t)NTOK * UW * 2);
  p.HL = (u16*)take((size_t)NTOK * 1024 * 2);
  p.Y2 = (u16*)take((size_t)NTOK * 1024 * 2);
  p.WT = (u16*)take((size_t)7296 * 1024 * 2);
  p.WoT = (u16*)take((size_t)1024 * 2048 * 2);
  p.KF = (u16*)take((size_t)1024 * 8192 * 2);
  p.DT = (float*)take((size_t)NTOK * 8 * 4);
  p.MOD = (float*)take((size_t)2 * 5 * 3072 * 4);
  p.SUM = (float*)take((size_t)4 * 2 * 17 * 512 * 2 * 4);
  {
    char* Z = take((size_t)16777216);
    p.SSH = (float*)Z; p.XC = (float*)(Z + 8388608); p.KFC = (u16*)(Z + 12582912);
  }
  p.PS = (float*)take((size_t)16 * 2 * 8 * 128 * 4);
  p.PA = (float*)take((size_t)16 * 2 * 8 * 4 * 4);
  if (off > ws_size) { fprintf(stderr, "workspace too small: need %zu have %zu\n", off, ws_size); return; }
  void* args[] = {&p};
  hipError_t e = hipLaunchCooperativeKernel((void*)mega, dim3(grid_blocks), dim3(256), args, 0, stream);
  if (e != hipSuccess) fprintf(stderr, "cooperative launch failed: %s (grid %d)\n", hipGetErrorString(e), grid_blocks);
}
```

```cpp
#include <hip/hip_runtime.h>
#include <hip/hip_bf16.h>
#include <hip/hip_cooperative_groups.h>
#include <cstdio>
#include <cstdint>
namespace cg = cooperative_groups;

typedef unsigned short u16;
using bf16x8 = __attribute__((ext_vector_type(8))) short;
using f32x16 = __attribute__((ext_vector_type(16))) float;

#define NTOK 17408
#define NLAT 16384
#define UW 4096
#define EPS 1e-6f

#ifndef PROBE_DUP
#define PROBE_DUP 0
#endif
#ifndef EN_HY
#define EN_HY 1
#endif
#ifndef EN_RG
#define EN_RG 1
#endif
#ifndef EN_HG
#define EN_HG 1
#endif
#ifndef EN_M2
#define EN_M2 1
#endif

struct P {
  const float *x, *c, *ctx, *c_ctx, *w_mod, *b_mod, *norm_w, *w_in, *w_out;
  const float *hy_conv_w, *hy_conv_b, *hy_w1, *hy_b1, *hy_w2, *hy_b2, *hy_w3, *hy_freq, *hy_skip;
  const float *rg_conv_w, *rg_conv_b, *rg_wa, *rg_ba, *rg_wx, *rg_bx, *rg_lam;
  const float *hg_lb, *hg_norm_w, *m2_conv_w, *m2_conv_b, *m2_dt_bias, *m2_a_log, *m2_d, *m2_norm_w, *final_norm_w;
  float* out;
  u16 *U, *HL, *Y2, *WT, *WoT, *KF, *KFC;
  float *XC, *DT, *MOD, *SUM, *SSH, *PS, *PA;
};

typedef __bf16 bf2_t __attribute__((ext_vector_type(2)));
typedef float f2_t __attribute__((ext_vector_type(2)));
__device__ __forceinline__ uint32_t pack2(float a, float b) {
  f2_t v = {a, b};
  return __builtin_bit_cast(uint32_t, __builtin_convertvector(v, bf2_t));
}
__device__ __forceinline__ u16 f2bf(float f) { return (u16)(pack2(f, f) & 0xffffu); }
__device__ __forceinline__ float bf2f(u16 h) { return __uint_as_float(((uint32_t)h) << 16); }
__device__ __forceinline__ float bflo(uint32_t w) { return __uint_as_float(w << 16); }
__device__ __forceinline__ float bfhi(uint32_t w) { return __uint_as_float(w & 0xffff0000u); }
__device__ __forceinline__ float siluf(float x) { return x * __builtin_amdgcn_rcpf(1.f + __expf(-x)); }
__device__ __forceinline__ float sigmf(float x) { return __builtin_amdgcn_rcpf(1.f + __expf(-x)); }
__device__ __forceinline__ float softplusf(float x) { return x > 20.f ? x : log1pf(__expf(x)); }

__device__ __forceinline__ void unpack8(const uint4& v, float* f) {
  f[0] = bflo(v.x); f[1] = bfhi(v.x); f[2] = bflo(v.y); f[3] = bfhi(v.y);
  f[4] = bflo(v.z); f[5] = bfhi(v.z); f[6] = bflo(v.w); f[7] = bfhi(v.w);
}
__device__ __forceinline__ uint4 pack8(const float* f) {
  uint4 v; v.x = pack2(f[0], f[1]); v.y = pack2(f[2], f[3]); v.z = pack2(f[4], f[5]); v.w = pack2(f[6], f[7]);
  return v;
}
__device__ __forceinline__ float wave_sum(float v) {
#pragma unroll
  for (int o = 32; o >= 1; o >>= 1) v += __shfl_xor(v, o);
  return v;
}

__device__ __forceinline__ int pos2row_seq(int b, int p, int dir) {
  if (p < 256) { int t = dir ? 255 - p : p; return NLAT + b * 256 + t; }
  int j = p - 256; int t = dir ? 4095 - j : j; return b * 4096 + t;
}
__device__ __forceinline__ int pos2row_m2(int b, int p, int dir) {
  if (p < 256) { int t = dir ? 255 - p : p; return NLAT + b * 256 + t; }
  int j = p - 256; int jj = dir ? 4095 - j : j; int c = jj >> 6, r = jj & 63; return b * 4096 + r * 64 + c;
}

__device__ __forceinline__ void ph_mod(const P& p, int bid, int nb, float* sm) {
  int tid = threadIdx.x; asm volatile("" : "+v"(tid));
  for (int task = bid; task < 96; task += nb) {
    int l = task / 48, cgi = task % 48;
    int col = cgi * 64 + (tid & 63);
    int kq = tid >> 6;
    float a0 = 0, a1 = 0, a2 = 0, a3 = 0, a4 = 0;
#pragma unroll 8
    for (int k = kq * 256; k < kq * 256 + 256; ++k) {
      float w = p.w_mod[((size_t)l * 1024 + k) * 3072 + col];
      a0 += siluf(p.c[k]) * w; a1 += siluf(p.c[1024 + k]) * w; a2 += siluf(p.c[2048 + k]) * w;
      a3 += siluf(p.c[3072 + k]) * w; a4 += siluf(p.c_ctx[k]) * w;
    }
    sm[(kq * 5 + 0) * 64 + (tid & 63)] = a0; sm[(kq * 5 + 1) * 64 + (tid & 63)] = a1;
    sm[(kq * 5 + 2) * 64 + (tid & 63)] = a2; sm[(kq * 5 + 3) * 64 + (tid & 63)] = a3;
    sm[(kq * 5 + 4) * 64 + (tid & 63)] = a4;
    __syncthreads();
    if (tid < 64) {
      float bm = p.b_mod[l * 3072 + col];
#pragma unroll
      for (int j = 0; j < 5; ++j) {
        float s = sm[(0 * 5 + j) * 64 + tid] + sm[(1 * 5 + j) * 64 + tid] + sm[(2 * 5 + j) * 64 + tid] + sm[(3 * 5 + j) * 64 + tid];
        p.MOD[(size_t)(l * 5 + j) * 3072 + col] = s + bm;
      }
    }
    __syncthreads();
  }
}

__device__ __forceinline__ void ph_norm(const P& p, int l, int bid, int nb) {
  int tid = threadIdx.x; asm volatile("" : "+v"(tid)); const int wave = tid >> 6, lane = tid & 63;
  for (int R = bid * 4 + wave; R < NTOK; R += nb * 4) {
    const float* src; int mj;
    if (R < NLAT) { src = (l == 0 ? p.x : (const float*)p.out) + (size_t)R * 1024; mj = R >> 12; }
    else { int rc = R - NLAT; src = (l == 0 ? p.ctx : (const float*)p.XC) + (size_t)rc * 1024; mj = 4; }
    const float* mod = p.MOD + (size_t)(l * 5 + mj) * 3072;
    float4 v[4]; float ss = 0;
#pragma unroll
    for (int i = 0; i < 4; ++i) {
      v[i] = ((const float4*)src)[lane + i * 64];
      ss += v[i].x * v[i].x + v[i].y * v[i].y + v[i].z * v[i].z + v[i].w * v[i].w;
    }
    ss = wave_sum(ss);
    float rinv = rsqrtf(ss * (1.f / 1024.f) + EPS);
#pragma unroll
    for (int i = 0; i < 4; ++i) {
      int idx = (lane + i * 64) * 4;
      float4 nw = *(const float4*)(p.norm_w + l * 1024 + idx);
      float4 sh = *(const float4*)(mod + idx);
      float4 sc = *(const float4*)(mod + 1024 + idx);
      float h0 = v[i].x * rinv * nw.x * (1.f + sc.x) + sh.x;
      float h1 = v[i].y * rinv * nw.y * (1.f + sc.y) + sh.y;
      float h2 = v[i].z * rinv * nw.z * (1.f + sc.z) + sh.z;
      float h3 = v[i].w * rinv * nw.w * (1.f + sc.w) + sh.w;
      uint2 o; o.x = pack2(h0, h1); o.y = pack2(h2, h3);
      *(uint2*)(p.HL + (size_t)R * 1024 + idx) = o;
    }
  }
}

__device__ __forceinline__ void ph_wconv(const P& p, int l, int bid, int nb, float* sm) {
  int tid = threadIdx.x; asm volatile("" : "+v"(tid));
  const int T1 = 114 * 16, T2 = 16 * 32;
  for (int t = bid; t < T1 + T2; t += nb) {
    const float* src; int ld, K, n0, k0, sc0, nvalid; u16* dst;
    if (t < T1) {
      int nt = t / 16, kt = t % 16; n0 = nt * 64; k0 = kt * 64;
      src = p.w_in + (size_t)l * 1024 * 7176; ld = 7176; K = 1024; dst = p.WT; nvalid = 64;
      if (n0 < 2048) sc0 = 3072 + n0;
      else if (n0 < 3072) sc0 = 5632 + (n0 - 2048);
      else if (n0 < 3200) { sc0 = 6656 + (n0 - 3072); nvalid = (n0 == 3072) ? 8 : 0; }
      else { int m = n0 - 3200; if (m < 3072) sc0 = m; else if (m < 3584) sc0 = 5120 + (m - 3072); else sc0 = 6664 + (m - 3584); }
    } else {
      int tt = t - T1; int nt = tt / 32, kt = tt % 32; n0 = nt * 64; k0 = kt * 64;
      src = p.w_out + (size_t)l * 2048 * 1024; ld = 1024; K = 2048; dst = p.WoT; nvalid = 64; sc0 = n0;
    }
#pragma unroll
    for (int i = 0; i < 4; ++i) {
      int kk = (tid >> 4) + 16 * i, cc = (tid & 15) * 4;
      const float* sp = src + (size_t)(k0 + kk) * ld + sc0 + cc;
      float4 v;
      if (nvalid == 64) v = *(const float4*)sp;
      else { v.x = (cc + 0 < nvalid) ? sp[0] : 0.f; v.y = (cc + 1 < nvalid) ? sp[1] : 0.f; v.z = (cc + 2 < nvalid) ? sp[2] : 0.f; v.w = (cc + 3 < nvalid) ? sp[3] : 0.f; }
      sm[kk * 65 + cc + 0] = v.x; sm[kk * 65 + cc + 1] = v.y; sm[kk * 65 + cc + 2] = v.z; sm[kk * 65 + cc + 3] = v.w;
    }
    __syncthreads();
#pragma unroll
    for (int i = 0; i < 2; ++i) {
      int q = tid + 256 * i; int nn = q >> 3, ks = q & 7;
      float f[8];
#pragma unroll
      for (int j = 0; j < 8; ++j) f[j] = sm[(ks * 8 + j) * 65 + nn];
      *(uint4*)(dst + (size_t)(n0 + nn) * K + k0 + ks * 8) = pack8(f);
    }
    __syncthreads();
  }
}

__device__ __forceinline__ void ph_filt(const P& p, int l, int bid, int nb, float* sm) {
  int tid = threadIdx.x; asm volatile("" : "+v"(tid));
  const float HY_MIN = -3.0701134573253945f, HY_MAX = -15.350567286626972f;
  int ntask = 256 + (l == 0 ? 16 : 0);
  float* zs = sm; float* h1 = sm + 544; float* h2 = sm + 544 + 1024;
  for (int task = bid; task < ntask; task += nb) {
    int n, t0; u16* K;
    if (task < 256) { n = 4096; t0 = task * 16; K = p.KF; } else { n = 256; t0 = (task - 256) * 16; K = p.KFC; }
    float inv_nm1 = 1.f / (float)(n - 1);
    for (int e = tid; e < 16 * 33; e += 256) {
      int tt = e / 33, f = e % 33; int t = t0 + tt; float val;
      if (f == 0) val = (float)t * inv_nm1;
      else {
        int bi = (f - 1) & 15;
        float band = 1e-4f + (float)bi * ((15.f - 1e-4f) / 15.f);
        float ang = (6.283185307179586f / (float)n) * (float)t * band;
        val = (f <= 16) ? cosf(ang) : -sinf(ang);
      }
      zs[e] = val;
    }
    __syncthreads();
    for (int e = tid; e < 1024; e += 256) {
      int tt = e >> 6, j = e & 63; float acc = p.hy_b1[l * 64 + j];
#pragma unroll
      for (int f = 0; f < 33; ++f) acc += zs[tt * 33 + f] * p.hy_w1[(l * 33 + f) * 64 + j];
      h1[e] = sinf(p.hy_freq[l * 64 + j] * acc);
    }
    __syncthreads();
    for (int e = tid; e < 1024; e += 256) {
      int tt = e >> 6, j = e & 63; float acc = p.hy_b2[l * 64 + j];
#pragma unroll
      for (int i = 0; i < 64; ++i) acc += h1[tt * 64 + i] * p.hy_w2[(l * 64 + i) * 64 + j];
      h2[e] = sinf(p.hy_freq[l * 64 + j] * acc);
    }
    __syncthreads();
    for (int r = 0; r < 8; ++r) {
      int col = tid + 256 * r; int o = col >> 10, side = (col >> 9) & 1, c = col & 511;
      float w[64];
#pragma unroll
      for (int i = 0; i < 64; ++i) w[i] = p.hy_w3[(size_t)(l * 64 + i) * 2048 + col];
      float delta = fabsf(HY_MIN + (HY_MAX - HY_MIN) * (float)c / 511.f);
      u16* Kc = K + (size_t)(o * 512 + c) * (2 * n);
      for (int tt = 0; tt < 16; ++tt) {
        float acc = 0;
#pragma unroll
        for (int i = 0; i < 64; ++i) acc += h2[tt * 64 + i] * w[i];
        int t = t0 + tt;
        float val = acc * __expf(-(float)t * inv_nm1 * delta);
        int idx;
        if (side == 0) idx = n - t; else { if (t == 0) { idx = 0; val = 0.f; } else idx = n + t; }
        Kc[idx] = f2bf(val);
      }
    }
    __syncthreads();
  }
}

#define LDSTR 72
template <int MODE>
__device__ __forceinline__ void gemm_tile(const P& p, int l, int mt, int nt, u16* sA, u16* sB, int noepi) {
  int tid = threadIdx.x; asm volatile("" : "+v"(tid)); const int wave = tid >> 6, lane = tid & 63;
  const int wm = wave >> 1, wn = wave & 1;
  const int KT = (MODE == 2) ? 2048 : 1024;
  const u16* Bsrc = (MODE == 0) ? p.WT + (size_t)(nt * 128) * 1024
                  : (MODE == 1) ? p.WT + (size_t)(3200 + nt * 128) * 1024
                                : p.WoT + (size_t)(nt * 128) * 2048;
  f32x16 acc[4][2];
#pragma unroll
  for (int a = 0; a < 4; ++a)
#pragma unroll
    for (int b = 0; b < 2; ++b)
#pragma unroll
      for (int r = 0; r < 16; ++r) acc[a][b][r] = 0.f;
  uint4 ra0, ra1, ra2, ra3, ra4, ra5, ra6, ra7, rb0, rb1, rb2, rb3;
  const int lrow = tid >> 3, lseg = tid & 7;
  const u16* Ab0 = p.HL + (size_t)(mt * 256 + lrow) * 1024 + lseg * 8;
  const u16* Ab1 = p.Y2 + (size_t)(mt * 256 + lrow) * 1024 + lseg * 8;
  const u16* Bb = Bsrc + (size_t)lrow * KT + lseg * 8;
#define GLOADS(K0)                                                                                  \
  {                                                                                                 \
    const u16* ap = (MODE == 2 && (K0) >= 1024) ? Ab1 + ((K0) - 1024) : Ab0 + (K0);                 \
    ra0 = *(const uint4*)(ap); ra1 = *(const uint4*)(ap + 32 * 1024);                               \
    ra2 = *(const uint4*)(ap + 64 * 1024); ra3 = *(const uint4*)(ap + 96 * 1024);                   \
    ra4 = *(const uint4*)(ap + 128 * 1024); ra5 = *(const uint4*)(ap + 160 * 1024);                 \
    ra6 = *(const uint4*)(ap + 192 * 1024); ra7 = *(const uint4*)(ap + 224 * 1024);                 \
    const u16* bp = Bb + (K0);                                                                      \
    rb0 = *(const uint4*)(bp); rb1 = *(const uint4*)(bp + (size_t)32 * KT);                         \
    rb2 = *(const uint4*)(bp + (size_t)64 * KT); rb3 = *(const uint4*)(bp + (size_t)96 * KT);       \
  }
  GLOADS(0)
#pragma unroll 1
  for (int k0 = 0; k0 < KT; k0 += 64) {
    *(uint4*)(sA + (lrow + 0) * LDSTR + lseg * 8) = ra0;   *(uint4*)(sA + (lrow + 32) * LDSTR + lseg * 8) = ra1;
    *(uint4*)(sA + (lrow + 64) * LDSTR + lseg * 8) = ra2;  *(uint4*)(sA + (lrow + 96) * LDSTR + lseg * 8) = ra3;
    *(uint4*)(sA + (lrow + 128) * LDSTR + lseg * 8) = ra4; *(uint4*)(sA + (lrow + 160) * LDSTR + lseg * 8) = ra5;
    *(uint4*)(sA + (lrow + 192) * LDSTR + lseg * 8) = ra6; *(uint4*)(sA + (lrow + 224) * LDSTR + lseg * 8) = ra7;
    *(uint4*)(sB + (lrow + 0) * LDSTR + lseg * 8) = rb0;   *(uint4*)(sB + (lrow + 32) * LDSTR + lseg * 8) = rb1;
    *(uint4*)(sB + (lrow + 64) * LDSTR + lseg * 8) = rb2;  *(uint4*)(sB + (lrow + 96) * LDSTR + lseg * 8) = rb3;
    __syncthreads();
    if (k0 + 64 < KT) GLOADS(k0 + 64)
#pragma unroll
    for (int ks = 0; ks < 4; ++ks) {
      bf16x8 fa[4], fb[2];
#pragma unroll
      for (int mi = 0; mi < 4; ++mi)
        fa[mi] = *(const bf16x8*)(sA + (wm * 128 + mi * 32 + (lane & 31)) * LDSTR + ks * 16 + (lane >> 5) * 8);
#pragma unroll
      for (int ni = 0; ni < 2; ++ni)
        fb[ni] = *(const bf16x8*)(sB + (wn * 64 + ni * 32 + (lane & 31)) * LDSTR + ks * 16 + (lane >> 5) * 8);
#pragma unroll
      for (int mi = 0; mi < 4; ++mi)
#pragma unroll
        for (int ni = 0; ni < 2; ++ni)
          acc[mi][ni] = __builtin_amdgcn_mfma_f32_32x32x16_bf16(fa[mi], fb[ni], acc[mi][ni], 0, 0, 0);
    }
    __syncthreads();
  }
  if (noepi) {
    float sacc = 0.f;
#pragma unroll
    for (int a = 0; a < 4; ++a)
#pragma unroll
      for (int b = 0; b < 2; ++b) sacc += acc[a][b][3];
    if (sacc == 1.2345e30f) p.DT[0] = sacc;
    return;
  }
  const int mj = (mt < 64) ? (mt >> 4) : 4;
  const int c31 = lane & 31, hh = lane >> 5;
  const int gcolA = nt * 128 + wn * 64 + c31, gcolB = gcolA + 32;
  if (MODE == 0 && nt == 24) {
    if (wn == 0 && c31 < 8) {
#pragma unroll
      for (int mi = 0; mi < 4; ++mi)
#pragma unroll
        for (int r = 0; r < 16; ++r) {
          const int R = mt * 256 + wm * 128 + mi * 32 + (r & 3) + 8 * (r >> 2) + 4 * hh;
          p.DT[(size_t)R * 8 + c31] = acc[mi][0][r];
        }
    }
    return;
  }
  if (MODE == 1 && nt < 16) {
    const bool sl = (gcolA >> 9) == 3;
#pragma unroll
    for (int mi = 0; mi < 4; ++mi)
#pragma unroll
      for (int ni = 0; ni < 2; ++ni)
#pragma unroll
        for (int g4 = 0; g4 < 4; ++g4) {
          float v0 = acc[mi][ni][4 * g4], v1 = acc[mi][ni][4 * g4 + 1], v2 = acc[mi][ni][4 * g4 + 2], v3 = acc[mi][ni][4 * g4 + 3];
          if (sl) { v0 = siluf(v0); v1 = siluf(v1); v2 = siluf(v2); v3 = siluf(v3); }
          int R0 = mt * 256 + wm * 128 + mi * 32 + 8 * g4 + 4 * hh;
          uint2 o; o.x = pack2(v0, v1); o.y = pack2(v2, v3);
          *(uint2*)(p.U + (size_t)(ni ? gcolB : gcolA) * NTOK + R0) = o;
        }
    return;
  }
  if (MODE != 2) {
    float lbA = 0.f, lbB = 0.f;
    int kindA = 0, kindB = 0;
    if (MODE == 0) {
      int pa_ = gcolA >> 9, pb_ = gcolB >> 9;
      kindA = (pa_ == 0) ? 1 : (pa_ == 1 || pa_ == 2) ? 2 : 0;
      kindB = (pb_ == 0) ? 1 : (pb_ == 1 || pb_ == 2) ? 2 : 0;
      if (l == 1) {
        if (kindA == 2) { int dir = pa_ - 1, ch = gcolA & 511; lbA = 1.f / (1.f + __expf(p.hg_lb[dir * 512 + ch] - p.hg_lb[(2 + dir) * 512 + ch])); }
        if (kindB == 2) { int dir = pb_ - 1, ch = gcolB & 511; lbB = 1.f / (1.f + __expf(p.hg_lb[dir * 512 + ch] - p.hg_lb[(2 + dir) * 512 + ch])); }
      }
    } else {
      int pa_ = gcolA >> 9, pb_ = gcolB >> 9;
      kindA = (pa_ == 3 || pa_ >= 5) ? 3 : 0;
      kindB = (pb_ == 3 || pb_ >= 5) ? 3 : 0;
    }
    u16* stg = sA + wave * (32 * 72);
    u16* dstbase = (MODE == 0) ? p.U + (size_t)(nt * 128 + wn * 64) : p.U + (size_t)NTOK * 2048 + (size_t)(nt * 128 - 2048 + wn * 64);
    const int ldo = (MODE == 0) ? UW : 2048;
#pragma unroll
    for (int mi = 0; mi < 4; ++mi) {
#pragma unroll
      for (int r = 0; r < 16; ++r) {
        const int rl = (r & 3) + 8 * (r >> 2) + 4 * hh;
        float va = acc[mi][0][r], vb = acc[mi][1][r];
        if (kindA == 1) va *= 0.08838834764831845f; else if (kindA == 2) va = (1.f - lbA) * __builtin_amdgcn_rcpf(1.f + __expf(va)); else if (kindA == 3) va = siluf(va);
        if (kindB == 1) vb *= 0.08838834764831845f; else if (kindB == 2) vb = (1.f - lbB) * __builtin_amdgcn_rcpf(1.f + __expf(vb)); else if (kindB == 3) vb = siluf(vb);
        stg[rl * 72 + c31] = f2bf(va);
        stg[rl * 72 + 32 + c31] = f2bf(vb);
      }
#pragma unroll
      for (int it = 0; it < 4; ++it) {
        const int rl = it * 8 + (lane >> 3), seg = lane & 7;
        uint4 v = *(const uint4*)(stg + rl * 72 + seg * 8);
        const int R = mt * 256 + wm * 128 + mi * 32 + rl;
        *(uint4*)(dstbase + (size_t)R * ldo + seg * 8) = v;
      }
    }
    return;
  }
  {
    float* stgf = (float*)sA + wave * (32 * 68);
    const int seg = lane & 15;
    const int gc0 = nt * 128 + wn * 64 + seg * 4;
    const float4 g4v = *(const float4*)(p.MOD + (size_t)(l * 5 + mj) * 3072 + 2048 + gc0);
#pragma unroll
    for (int mi = 0; mi < 4; ++mi) {
#pragma unroll
      for (int r = 0; r < 16; ++r) {
        const int rl = (r & 3) + 8 * (r >> 2) + 4 * hh;
        stgf[rl * 68 + c31] = acc[mi][0][r];
        stgf[rl * 68 + 32 + c31] = acc[mi][1][r];
      }
#pragma unroll
      for (int it = 0; it < 8; ++it) {
        const int rl = it * 4 + (lane >> 4);
        float4 v = *(const float4*)(stgf + rl * 68 + seg * 4);
        const int R = mt * 256 + wm * 128 + mi * 32 + rl;
        const float* src; float* dst;
        if (R < NLAT) { src = ((l == 0) ? p.x : (const float*)p.out) + (size_t)R * 1024 + gc0; dst = p.out + (size_t)R * 1024 + gc0; }
        else { int rc = R - NLAT; src = p.ctx + (size_t)rc * 1024 + gc0; dst = p.XC + (size_t)rc * 1024 + gc0; }
        float4 xv = *(const float4*)src;
        float4 o; o.x = xv.x + g4v.x * v.x; o.y = xv.y + g4v.y * v.y; o.z = xv.z + g4v.z * v.z; o.w = xv.w + g4v.w * v.w;
        *(float4*)dst = o;
      }
    }
  }
}

template <int MODE>
__device__ __forceinline__ void ph_gemm(const P& p, int l, int bid, int nb, u16* sm, int noepi = 0) {
  const int NT = (MODE == 0) ? 25 : (MODE == 1) ? 32 : 8;
  const int MT = (MODE == 2 && l == 1) ? 64 : 68;
  u16* sA = sm; u16* sB = sm + 256 * LDSTR;
  const int xcd = bid & 7, local = bid >> 3;
  const int mbase = MT >> 3, mextra = MT & 7;
  const int mper = mbase + (xcd < mextra ? 1 : 0);
  const int mstart = (xcd < mextra) ? xcd * (mbase + 1) : mextra * (mbase + 1) + (xcd - mextra) * mbase;
  const int total = mper * NT;
  const int fullb = NT >> 3, rem = NT & 7;
  for (int it = 0;; ++it) {
    int mt, nt;
    if (nb == 256) {
      int q = local + 32 * it;
      if (q >= total) break;
      int b, i, bw;
      if (q < fullb * mper * 8) { b = q / (mper * 8); i = q - b * mper * 8; bw = 8; }
      else { b = fullb; i = q - fullb * mper * 8; bw = rem; }
      int sub = i / (4 * bw);
      const int nsub = mper >> 2;
      int mt_off, nt_off;
      if (sub < nsub) { int j = i - sub * 4 * bw; mt_off = j & 3; nt_off = j >> 2; }
      else { int j = i - nsub * 4 * bw; sub = nsub; mt_off = 0; nt_off = j; }
      mt = mstart + sub * 4 + mt_off; nt = b * 8 + nt_off;
    } else {
      int t = bid + it * nb;
      if (t >= MT * NT) break;
      nt = t / MT; mt = t % MT;
    }
    __syncthreads();
    gemm_tile<MODE>(p, l, mt, nt, sA, sB, noepi);
  }
}

__device__ __forceinline__ void hg_task(const P& p, int l, int task, float* sm) {
  int tid = threadIdx.x; asm volatile("" : "+v"(tid)); const int wave = tid >> 6, lane = tid & 63;
  const int b = task >> 5, h = (task >> 3) & 3, es = task & 7;
  const int dg = lane & 15, el = lane >> 4;
  float* qs = sm; float* ks = sm + 4096; float* vs = sm + 8192; float* os = sm + 8192 + 512;
  for (int dir = 0; dir < 2; ++dir) {
    float S[8];
#pragma unroll
    for (int r = 0; r < 8; ++r) S[r] = 0.f;
    for (int chunk = 0; chunk < 136; ++chunk) {
#pragma unroll
      for (int i = 0; i < 2; ++i) {
        int q = tid + 256 * i; int pos = q >> 4, seg = q & 15;
        int R = pos2row_seq(b, chunk * 32 + pos, dir);
        const u16* up = p.U + (size_t)R * UW + h * 128 + seg * 8;
        uint4 qv = *(const uint4*)up;
        uint4 kv = *(const uint4*)(up + 512 + dir * 512);
        float f[8];
        unpack8(qv, f);
        *(float4*)(qs + pos * 128 + seg * 8) = make_float4(f[0], f[1], f[2], f[3]);
        *(float4*)(qs + pos * 128 + seg * 8 + 4) = make_float4(f[4], f[5], f[6], f[7]);
        unpack8(kv, f);
        *(float4*)(ks + pos * 128 + seg * 8) = make_float4(f[0], f[1], f[2], f[3]);
        *(float4*)(ks + pos * 128 + seg * 8 + 4) = make_float4(f[4], f[5], f[6], f[7]);
      }
      {
        int pos = tid >> 3, e2 = (tid & 7) * 2;
        int R = pos2row_seq(b, chunk * 32 + pos, dir);
        uint32_t w = *(const uint32_t*)(p.U + (size_t)R * UW + 1536 + h * 128 + es * 16 + e2);
        vs[pos * 16 + e2] = bflo(w); vs[pos * 16 + e2 + 1] = bfhi(w);
      }
      __syncthreads();
#pragma unroll 4
      for (int i = 0; i < 32; ++i) {
        float4 q0 = *(const float4*)(qs + i * 128 + dg * 8), q1 = *(const float4*)(qs + i * 128 + dg * 8 + 4);
        float4 k0 = *(const float4*)(ks + i * 128 + dg * 8), k1 = *(const float4*)(ks + i * 128 + dg * 8 + 4);
        float v = vs[i * 16 + wave * 4 + el];
        S[0] += k0.x * (v - S[0]); S[1] += k0.y * (v - S[1]); S[2] += k0.z * (v - S[2]); S[3] += k0.w * (v - S[3]);
        S[4] += k1.x * (v - S[4]); S[5] += k1.y * (v - S[5]); S[6] += k1.z * (v - S[6]); S[7] += k1.w * (v - S[7]);
        float o = q0.x * S[0] + q0.y * S[1] + q0.z * S[2] + q0.w * S[3] + q1.x * S[4] + q1.y * S[5] + q1.z * S[6] + q1.w * S[7];
        o += __shfl_xor(o, 1); o += __shfl_xor(o, 2); o += __shfl_xor(o, 4); o += __shfl_xor(o, 8);
        if (dg == 0) os[i * 16 + wave * 4 + el] = o;
      }
      __syncthreads();
      {
        int pos = tid >> 3, e2 = (tid & 7) * 2;
        int R = pos2row_seq(b, chunk * 32 + pos, dir);
        uint32_t* yp = (uint32_t*)(p.Y2 + (size_t)R * 1024 + h * 128 + es * 16 + e2);
        float o0 = os[pos * 16 + e2], o1 = os[pos * 16 + e2 + 1];
        if (dir == 1) { uint32_t w = *yp; o0 += bflo(w); o1 += bfhi(w); }
        *yp = pack2(o0, o1);
      }
    }
    __syncthreads();
  }
}

__device__ __forceinline__ void m2_task(const P& p, int l, int task, float* sm) {
  int tid = threadIdx.x; asm volatile("" : "+v"(tid)); const int wave = tid >> 6, lane = tid & 63;
  const int b = task >> 5, head = (task >> 2) & 7, ps = task & 3;
  const int g = head >> 2;
  const int dg = lane & 15, el = lane >> 4;
  float* Cs = sm; float* Bs = sm + 4096; float* xs = sm + 8192; float* os = sm + 8192 + 512;
  float* dts = sm + 8192 + 1024; float* decs = dts + 32;
  for (int dir = 0; dir < 2; ++dir) {
    const float* cw = p.m2_conv_w + (size_t)(l * 2 + dir) * 4 * 1024;
    const float* cb = p.m2_conv_b + (size_t)(l * 2 + dir) * 1024;
    const float dtb = p.m2_dt_bias[(l * 2 + dir) * 8 + head];
    const float Aneg = -__expf(p.m2_a_log[(l * 2 + dir) * 8 + head]);
    const float Dsk = p.m2_d[(l * 2 + dir) * 8 + head];
    float S[8];
#pragma unroll
    for (int r = 0; r < 8; ++r) S[r] = 0.f;
    for (int chunk = 0; chunk < 136; ++chunk) {
      const int pbase = chunk * 32;
      const int seg0 = (pbase < 256) ? 0 : 256;
#pragma unroll
      for (int i = 0; i < 2; ++i) {
        int q = tid + 256 * i; int pos = q >> 4, seg = q & 15;
        int pp = pbase + pos;
        int chB = 512 + g * 128 + seg * 8, chC = 768 + g * 128 + seg * 8;
        float aB[8], aC[8];
#pragma unroll
        for (int j = 0; j < 8; ++j) { aB[j] = cb[chB + j]; aC[j] = cb[chC + j]; }
#pragma unroll
        for (int tap = 0; tap < 4; ++tap) {
          int pt = pp - 3 + tap;
          if (pt >= seg0) {
            int R = pos2row_m2(b, pt, dir);
            const u16* up = p.U + (size_t)R * UW + 2048;
            uint4 bv = *(const uint4*)(up + chB);
            uint4 cv = *(const uint4*)(up + chC);
            float f[8];
            unpack8(bv, f);
#pragma unroll
            for (int j = 0; j < 8; ++j) aB[j] += cw[tap * 1024 + chB + j] * f[j];
            unpack8(cv, f);
#pragma unroll
            for (int j = 0; j < 8; ++j) aC[j] += cw[tap * 1024 + chC + j] * f[j];
          }
        }
#pragma unroll
        for (int j = 0; j < 8; ++j) { aB[j] = siluf(aB[j]); aC[j] = siluf(aC[j]); }
        *(float4*)(Bs + pos * 128 + seg * 8) = make_float4(aB[0], aB[1], aB[2], aB[3]);
        *(float4*)(Bs + pos * 128 + seg * 8 + 4) = make_float4(aB[4], aB[5], aB[6], aB[7]);
        *(float4*)(Cs + pos * 128 + seg * 8) = make_float4(aC[0], aC[1], aC[2], aC[3]);
        *(float4*)(Cs + pos * 128 + seg * 8 + 4) = make_float4(aC[4], aC[5], aC[6], aC[7]);
      }
      {
        int pos = tid >> 3, e2 = (tid & 7) * 2;
        int pp = pbase + pos;
        int ch = head * 64 + ps * 16 + e2;
        float a0 = cb[ch], a1 = cb[ch + 1];
#pragma unroll
        for (int tap = 0; tap < 4; ++tap) {
          int pt = pp - 3 + tap;
          if (pt >= seg0) {
            int R = pos2row_m2(b, pt, dir);
            uint32_t w = *(const uint32_t*)(p.U + (size_t)R * UW + 2048 + ch);
            a0 += cw[tap * 1024 + ch] * bflo(w); a1 += cw[tap * 1024 + ch + 1] * bfhi(w);
          }
        }
        xs[pos * 16 + e2] = siluf(a0); xs[pos * 16 + e2 + 1] = siluf(a1);
      }
      if (tid < 32) {
        int R = pos2row_m2(b, pbase + tid, dir);
        float dtv = softplusf(p.DT[(size_t)R * 8 + head] + dtb);
        dts[tid] = dtv; decs[tid] = __expf(dtv * Aneg);
      }
      __syncthreads();
#pragma unroll 4
      for (int i = 0; i < 32; ++i) {
        float4 q0 = *(const float4*)(Cs + i * 128 + dg * 8), q1 = *(const float4*)(Cs + i * 128 + dg * 8 + 4);
        float4 k0 = *(const float4*)(Bs + i * 128 + dg * 8), k1 = *(const float4*)(Bs + i * 128 + dg * 8 + 4);
        float xv = xs[i * 16 + wave * 4 + el];
        float a = decs[i]; float v = xv * dts[i];
        S[0] = a * S[0] + k0.x * v; S[1] = a * S[1] + k0.y * v; S[2] = a * S[2] + k0.z * v; S[3] = a * S[3] + k0.w * v;
        S[4] = a * S[4] + k1.x * v; S[5] = a * S[5] + k1.y * v; S[6] = a * S[6] + k1.z * v; S[7] = a * S[7] + k1.w * v;
        float o = q0.x * S[0] + q0.y * S[1] + q0.z * S[2] + q0.w * S[3] + q1.x * S[4] + q1.y * S[5] + q1.z * S[6] + q1.w * S[7];
        o += __shfl_xor(o, 1); o += __shfl_xor(o, 2); o += __shfl_xor(o, 4); o += __shfl_xor(o, 8);
        if (dg == 0) os[i * 16 + wave * 4 + el] = o + Dsk * xv;
      }
      __syncthreads();
      {
        int pos = tid >> 3, e2 = (tid & 7) * 2;
        int R = pos2row_m2(b, pbase + pos, dir);
        uint32_t* yp = (uint32_t*)(p.Y2 + (size_t)R * 1024 + 512 + head * 64 + ps * 16 + e2);
        float o0 = os[pos * 16 + e2], o1 = os[pos * 16 + e2 + 1];
        if (dir == 1) { uint32_t w = *yp; o0 += bflo(w); o1 += bfhi(w); }
        *yp = pack2(o0, o1);
      }
    }
    __syncthreads();
  }
}

#ifndef M2_MFMA
#define M2_MFMA 1
#endif
#define QS 136
#define TS 40
union FragU { bf16x8 v; uint32_t u[4]; uint2 d[2]; uint4 q; };
__device__ __forceinline__ bf16x8 cvt_frag(const f32x16& x, int s2) {
  FragU f;
  f.u[0] = pack2(x[8 * s2 + 0], x[8 * s2 + 1]); f.u[1] = pack2(x[8 * s2 + 2], x[8 * s2 + 3]);
  f.u[2] = pack2(x[8 * s2 + 4], x[8 * s2 + 5]); f.u[3] = pack2(x[8 * s2 + 6], x[8 * s2 + 7]);
  return f.v;
}
__device__ __forceinline__ bf16x8 ld_frag_perm(const u16* base) {
  FragU f; f.d[0] = *(const uint2*)base; f.d[1] = *(const uint2*)(base + 8); return f.v;
}

template <int PASS>
__device__ __forceinline__ void hg_mfma(const P& p, int l, int task, int blk, int dir0, unsigned char* smem) {
  int tid = threadIdx.x; asm volatile("" : "+v"(tid)); const int wave = tid >> 6, lane = tid & 63;
  const int r = lane & 31, hh = lane >> 5;
  const int b = task >> 2, h = task & 3;
  u16* ks = (u16*)smem;
  u16* qs = ks + 32 * QS;
  u16* kT = qs + 32 * QS;
  u16* vT = kT + 128 * TS;
  float* tot = (float*)(vT + 128 * TS);
  float* eg = tot + 256;
  const int dd = tid & 127, half = tid >> 7;
  for (int dir = (PASS == 0 ? dir0 : 0); dir < (PASS == 0 ? dir0 + 1 : 2); ++dir) {
    const int sbd = (PASS == 0) ? blk : ((blk == 0) ? 0 : (dir ? 9 - blk : blk));
    const int c0 = (sbd == 0) ? 0 : 8 + 16 * (sbd - 1);
    const int c1 = (sbd == 0) ? 8 : 8 + 16 * sbd;
    float gsum = 0.f;
    f32x16 S[4];
#pragma unroll
    for (int i = 0; i < 4; ++i)
#pragma unroll
      for (int q = 0; q < 16; ++q) S[i][q] = 0.f;
    if (PASS == 1) {
      for (int qb = 0; qb < sbd; ++qb) {
        const size_t sidx = (size_t)((task * 2 + dir) * 8 + qb);
        if (half == 0) eg[dd] = __expf(p.PS[sidx * 128 + dd]);
        __syncthreads();
        const float* sp = p.SSH + sidx * 16384 + (size_t)wave * 4096 + lane;
#pragma unroll
        for (int dt = 0; dt < 4; ++dt)
#pragma unroll
          for (int q4 = 0; q4 < 4; ++q4) {
            float4 e4 = *(const float4*)(eg + 32 * dt + 8 * q4 + 4 * hh);
            S[dt][4 * q4 + 0] = S[dt][4 * q4 + 0] * e4.x + sp[(dt * 16 + 4 * q4 + 0) * 64];
            S[dt][4 * q4 + 1] = S[dt][4 * q4 + 1] * e4.y + sp[(dt * 16 + 4 * q4 + 1) * 64];
            S[dt][4 * q4 + 2] = S[dt][4 * q4 + 2] * e4.z + sp[(dt * 16 + 4 * q4 + 2) * 64];
            S[dt][4 * q4 + 3] = S[dt][4 * q4 + 3] * e4.w + sp[(dt * 16 + 4 * q4 + 3) * 64];
          }
        __syncthreads();
      }
    }
    uint4 pq0, pq1, pk0, pk1, pv0, pv1;
#define HG_PREFETCH(CH)                                                                     \
    {                                                                                       \
      int pos0 = tid >> 4, seg = tid & 15;                                                  \
      int R0 = pos2row_seq(b, (CH) * 32 + pos0, dir), R1 = pos2row_seq(b, (CH) * 32 + pos0 + 16, dir); \
      const u16* u0 = p.U + (size_t)R0 * UW + h * 128 + seg * 8;                            \
      const u16* u1 = p.U + (size_t)R1 * UW + h * 128 + seg * 8;                            \
      pq0 = *(const uint4*)u0; pq1 = *(const uint4*)u1;                                     \
      pk0 = *(const uint4*)(u0 + 512 + dir * 512); pk1 = *(const uint4*)(u1 + 512 + dir * 512); \
      pv0 = *(const uint4*)(u0 + 1536); pv1 = *(const uint4*)(u1 + 1536);                   \
    }
    HG_PREFETCH(c0)
#pragma unroll 1
    for (int chunk = c0; chunk < c1; ++chunk) {
      {
        int pos0 = tid >> 4, seg = tid & 15;
        *(uint4*)(qs + pos0 * QS + seg * 8) = pq0; *(uint4*)(qs + (pos0 + 16) * QS + seg * 8) = pq1;
        *(uint4*)(ks + pos0 * QS + seg * 8) = pk0; *(uint4*)(ks + (pos0 + 16) * QS + seg * 8) = pk1;
        FragU f0, f1; f0.q = pv0; f1.q = pv1;
#pragma unroll
        for (int j = 0; j < 4; ++j) {
          vT[(seg * 8 + 2 * j) * TS + pos0] = (u16)(f0.u[j] & 0xffffu); vT[(seg * 8 + 2 * j + 1) * TS + pos0] = (u16)(f0.u[j] >> 16);
          vT[(seg * 8 + 2 * j) * TS + pos0 + 16] = (u16)(f1.u[j] & 0xffffu); vT[(seg * 8 + 2 * j + 1) * TS + pos0 + 16] = (u16)(f1.u[j] >> 16);
        }
      }
      __syncthreads();
      if (chunk + 1 < c1) HG_PREFETCH(chunk + 1)
      const int Rout = pos2row_seq(b, chunk * 32 + r, dir);
      u16* yrow = p.Y2 + (size_t)Rout * 1024 + h * 128 + wave * 32 + 4 * hh;
      uint2 yold[4];
      if (PASS == 1 && dir == 1) {
#pragma unroll
        for (int q4 = 0; q4 < 4; ++q4) yold[q4] = *(const uint2*)(yrow + 8 * q4);
      }
      float gl[16];
      {
        float run = 0.f;
#pragma unroll
        for (int i = 0; i < 16; ++i) {
          float kkv = bf2f(ks[(half * 16 + i) * QS + dd]);
          run += __logf(fmaxf(1.f - kkv, 1e-6f));
          gl[i] = run;
        }
        tot[half * 128 + dd] = run;
      }
      __syncthreads();
      {
        const float t0 = tot[dd], t1 = tot[128 + dd];
        const float off = half ? t0 : 0.f;
        const float g31 = t0 + t1;
        float k2[16];
#pragma unroll
        for (int i = 0; i < 16; ++i) {
          const int pos = half * 16 + i;
          const float g = gl[i] + off;
          const float kkv = bf2f(ks[pos * QS + dd]);
          const float qv = bf2f(qs[pos * QS + dd]);
          qs[pos * QS + dd] = f2bf(qv * __expf(g));
          ks[pos * QS + dd] = f2bf(kkv * __expf(fminf(-g, 60.f)));
          k2[i] = kkv * __expf(g31 - g);
        }
        *(uint4*)(kT + dd * TS + half * 16) = pack8(k2);
        *(uint4*)(kT + dd * TS + half * 16 + 8) = pack8(k2 + 8);
        if (half == 0) eg[dd] = __expf(g31);
        gsum += g31;
      }
      __syncthreads();
      f32x16 O;
      if (PASS == 1) {
      f32x16 att;
#pragma unroll
      for (int q = 0; q < 16; ++q) att[q] = 0.f;
#pragma unroll
      for (int k8 = 0; k8 < 8; ++k8) {
        bf16x8 A = *(const bf16x8*)(ks + r * QS + 16 * k8 + 8 * hh);
        bf16x8 B = *(const bf16x8*)(qs + r * QS + 16 * k8 + 8 * hh);
        att = __builtin_amdgcn_mfma_f32_32x32x16_bf16(A, B, att, 0, 0, 0);
      }
#pragma unroll
      for (int q = 0; q < 16; ++q) {
        int sidx = (q & 3) + 8 * (q >> 2) + 4 * hh;
        if (sidx > r) att[q] = 0.f;
      }
#pragma unroll
      for (int q = 0; q < 16; ++q) O[q] = 0.f;
#pragma unroll
      for (int dt = 0; dt < 4; ++dt)
#pragma unroll
        for (int s2 = 0; s2 < 2; ++s2) {
          bf16x8 A = cvt_frag(S[dt], s2);
          bf16x8 B = ld_frag_perm(qs + r * QS + 32 * dt + 16 * s2 + 4 * hh);
          O = __builtin_amdgcn_mfma_f32_32x32x16_bf16(A, B, O, 0, 0, 0);
        }
#pragma unroll
      for (int s2 = 0; s2 < 2; ++s2) {
        bf16x8 A = ld_frag_perm(vT + (32 * wave + r) * TS + 16 * s2 + 4 * hh);
        bf16x8 B = cvt_frag(att, s2);
        O = __builtin_amdgcn_mfma_f32_32x32x16_bf16(A, B, O, 0, 0, 0);
      }
      }
#pragma unroll
      for (int dt = 0; dt < 4; ++dt) {
#pragma unroll
        for (int q4 = 0; q4 < 4; ++q4) {
          float4 e4 = *(const float4*)(eg + 32 * dt + 8 * q4 + 4 * hh);
          S[dt][4 * q4 + 0] *= e4.x; S[dt][4 * q4 + 1] *= e4.y; S[dt][4 * q4 + 2] *= e4.z; S[dt][4 * q4 + 3] *= e4.w;
        }
#pragma unroll
        for (int s2 = 0; s2 < 2; ++s2) {
          bf16x8 A = *(const bf16x8*)(kT + (32 * dt + r) * TS + 16 * s2 + 8 * hh);
          bf16x8 B = *(const bf16x8*)(vT + (32 * wave + r) * TS + 16 * s2 + 8 * hh);
          S[dt] = __builtin_amdgcn_mfma_f32_32x32x16_bf16(A, B, S[dt], 0, 0, 0);
        }
      }
      if (PASS == 1) {
#pragma unroll
      for (int q4 = 0; q4 < 4; ++q4) {
        float o0 = O[4 * q4], o1 = O[4 * q4 + 1], o2 = O[4 * q4 + 2], o3 = O[4 * q4 + 3];
        if (dir == 1) { o0 += bflo(yold[q4].x); o1 += bfhi(yold[q4].x); o2 += bflo(yold[q4].y); o3 += bfhi(yold[q4].y); }
        uint2 ov; ov.x = pack2(o0, o1); ov.y = pack2(o2, o3);
        *(uint2*)(yrow + 8 * q4) = ov;
      }
      }
      __syncthreads();
    }
    if (PASS == 0) {
      const size_t sidx = (size_t)((task * 2 + dir) * 8 + sbd);
      if (half == 0) p.PS[sidx * 128 + dd] = gsum;
      float* sp = p.SSH + sidx * 16384 + (size_t)wave * 4096 + lane;
#pragma unroll
      for (int dt = 0; dt < 4; ++dt)
#pragma unroll
        for (int q = 0; q < 16; ++q) sp[(dt * 16 + q) * 64] = S[dt][q];
    }
    __syncthreads();
  }
}

#if M2_MFMA
#define M2_NTASK 16
template <int PASS>
__device__ __forceinline__ void m2_mfma(const P& p, int l, int task, int blk, int dir0, unsigned char* smem) {
  int tid = threadIdx.x; asm volatile("" : "+v"(tid)); const int wave = tid >> 6, lane = tid & 63;
  const int r = lane & 31, hh = lane >> 5;
  const int b = task >> 2, g = (task >> 1) & 1, hp = task & 1;
  const int hq = wave >> 1, ph = wave & 1;
  const int head = 4 * g + 2 * hp + hq;
  u16* Bm = (u16*)smem;
  u16* Cm = Bm + 32 * QS;
  u16* BmT = Cm + 32 * QS;
  u16* xsT = BmT + 128 * TS;
  float* Gs = (float*)(xsT + 128 * TS);
  float* dts = Gs + 64;
  float* wl = dts + 64;
  const int cp = (lane < 48) ? lane : 47;
  const bool act = lane < 48;
  const int chW = (cp < 16) ? ((4 * g + 2 * hp) * 64 + cp * 8) : (cp < 32) ? (512 + g * 128 + (cp - 16) * 8) : (768 + g * 128 + (cp - 32) * 8);
  const int chU = 2048 + chW;
  float* SSM = (float*)p.KF;
  for (int dir = (PASS == 0 ? dir0 : 0); dir < (PASS == 0 ? dir0 + 1 : 2); ++dir) {
    const int sbd = (PASS == 0) ? blk : ((blk == 0) ? 0 : (dir ? 9 - blk : blk));
    const int c0 = (sbd == 0) ? 0 : 8 + 16 * (sbd - 1);
    const int c1 = (sbd == 0) ? 8 : 8 + 16 * sbd;
    float lsum = 0.f;
    const float* cw = p.m2_conv_w + (size_t)(l * 2 + dir) * 4 * 1024;
    const float* cb = p.m2_conv_b + (size_t)(l * 2 + dir) * 1024;
    if (wave == 0) {
#pragma unroll
      for (int j = 0; j < 8; ++j) {
        wl[(4 * 8 + j) * 64 + lane] = cb[chW + j];
#pragma unroll
        for (int tap = 0; tap < 4; ++tap) wl[(tap * 8 + j) * 64 + lane] = cw[tap * 1024 + chW + j];
      }
    }
    __syncthreads();
    const int hd_t = 4 * g + 2 * hp + ((tid >> 5) & 1);
    const float dtb = p.m2_dt_bias[(l * 2 + dir) * 8 + hd_t];
    const float Aneg_t = -__expf(p.m2_a_log[(l * 2 + dir) * 8 + hd_t]);
    const float Dsk = p.m2_d[(l * 2 + dir) * 8 + head];
    f32x16 S[4];
#pragma unroll
    for (int i = 0; i < 4; ++i)
#pragma unroll
      for (int q = 0; q < 16; ++q) S[i][q] = 0.f;
    if (PASS == 1) {
      for (int qb = 0; qb < sbd; ++qb) {
        const size_t sidx = (size_t)((task * 2 + dir) * 8 + qb);
        const float a = __expf(p.PA[sidx * 4 + wave]);
        const float* sp = SSM + sidx * 16384 + (size_t)wave * 4096 + lane;
#pragma unroll
        for (int nt = 0; nt < 4; ++nt)
#pragma unroll
          for (int q = 0; q < 16; ++q) S[nt][q] = S[nt][q] * a + sp[(nt * 16 + q) * 64];
      }
    }
    uint4 raw0, raw1, raw2, raw3, raw4, raw5, raw6, raw7, raw8, raw9, raw10;
    float dtraw = 0.f;
#define M2_LD1(RW, I, CH)                                                                  \
    {                                                                                      \
      int pt = (CH) * 32 + wave * 8 + (I) - 3;                                             \
      int sg0 = ((CH) * 32 < 256) ? 0 : 256;                                               \
      if (pt >= sg0) { int Rr = pos2row_m2(b, pt, dir); RW = *(const uint4*)(p.U + (size_t)Rr * UW + chU); } \
      else RW = make_uint4(0u, 0u, 0u, 0u);                                                \
    }
#define M2_PREFETCH(CH)                                                                    \
    M2_LD1(raw0, 0, CH) M2_LD1(raw1, 1, CH) M2_LD1(raw2, 2, CH) M2_LD1(raw3, 3, CH) M2_LD1(raw4, 4, CH) M2_LD1(raw5, 5, CH) \
    M2_LD1(raw6, 6, CH) M2_LD1(raw7, 7, CH) M2_LD1(raw8, 8, CH) M2_LD1(raw9, 9, CH) M2_LD1(raw10, 10, CH)            \
    if (tid < 64) { int Rr = pos2row_m2(b, (CH) * 32 + (tid & 31), dir); dtraw = p.DT[(size_t)Rr * 8 + hd_t]; }
    M2_PREFETCH(c0)
#pragma unroll 1
    for (int chunk = c0; chunk < c1; ++chunk) {
      {
#define M2_RAWF(RW, J) (((J) & 1) ? bfhi((RW)) : bflo((RW)))
#define M2_CH(J, C0, C1, C2, C3, C4, C5, C6, C7, C8, C9, C10)                               \
        {                                                                                  \
          const float q0 = wl[(0 * 8 + (J)) * 64 + lane], q1 = wl[(1 * 8 + (J)) * 64 + lane]; \
          const float q2 = wl[(2 * 8 + (J)) * 64 + lane], q3 = wl[(3 * 8 + (J)) * 64 + lane]; \
          const float qb = wl[(4 * 8 + (J)) * 64 + lane];                                  \
          const float v0 = M2_RAWF(C0, J), v1 = M2_RAWF(C1, J), v2 = M2_RAWF(C2, J), v3 = M2_RAWF(C3, J); \
          const float v4 = M2_RAWF(C4, J), v5 = M2_RAWF(C5, J), v6 = M2_RAWF(C6, J), v7 = M2_RAWF(C7, J); \
          const float v8 = M2_RAWF(C8, J), v9 = M2_RAWF(C9, J), v10 = M2_RAWF(C10, J);      \
          float o[8];                                                                      \
          o[0] = siluf(qb + q0 * v0 + q1 * v1 + q2 * v2 + q3 * v3);                        \
          o[1] = siluf(qb + q0 * v1 + q1 * v2 + q2 * v3 + q3 * v4);                        \
          o[2] = siluf(qb + q0 * v2 + q1 * v3 + q2 * v4 + q3 * v5);                        \
          o[3] = siluf(qb + q0 * v3 + q1 * v4 + q2 * v5 + q3 * v6);                        \
          o[4] = siluf(qb + q0 * v4 + q1 * v5 + q2 * v6 + q3 * v7);                        \
          o[5] = siluf(qb + q0 * v5 + q1 * v6 + q2 * v7 + q3 * v8);                        \
          o[6] = siluf(qb + q0 * v6 + q1 * v7 + q2 * v8 + q3 * v9);                        \
          o[7] = siluf(qb + q0 * v7 + q1 * v8 + q2 * v9 + q3 * v10);                       \
          if (act) {                                                                       \
            if (cp < 16) {                                                                 \
              *(uint4*)(xsT + (cp * 8 + (J)) * TS + wave * 8) = pack8(o);                  \
            } else if (cp < 32) {                                                          \
              *(uint4*)(BmT + ((cp - 16) * 8 + (J)) * TS + wave * 8) = pack8(o);           \
              _Pragma("unroll") for (int i = 0; i < 8; ++i) Bm[(wave * 8 + i) * QS + (cp - 16) * 8 + (J)] = f2bf(o[i]); \
            } else {                                                                       \
              _Pragma("unroll") for (int i = 0; i < 8; ++i) Cm[(wave * 8 + i) * QS + (cp - 32) * 8 + (J)] = f2bf(o[i]); \
            }                                                                              \
          }                                                                                \
        }
        M2_CH(0, raw0.x, raw1.x, raw2.x, raw3.x, raw4.x, raw5.x, raw6.x, raw7.x, raw8.x, raw9.x, raw10.x)
        M2_CH(1, raw0.x, raw1.x, raw2.x, raw3.x, raw4.x, raw5.x, raw6.x, raw7.x, raw8.x, raw9.x, raw10.x)
        M2_CH(2, raw0.y, raw1.y, raw2.y, raw3.y, raw4.y, raw5.y, raw6.y, raw7.y, raw8.y, raw9.y, raw10.y)
        M2_CH(3, raw0.y, raw1.y, raw2.y, raw3.y, raw4.y, raw5.y, raw6.y, raw7.y, raw8.y, raw9.y, raw10.y)
        M2_CH(4, raw0.z, raw1.z, raw2.z, raw3.z, raw4.z, raw5.z, raw6.z, raw7.z, raw8.z, raw9.z, raw10.z)
        M2_CH(5, raw0.z, raw1.z, raw2.z, raw3.z, raw4.z, raw5.z, raw6.z, raw7.z, raw8.z, raw9.z, raw10.z)
        M2_CH(6, raw0.w, raw1.w, raw2.w, raw3.w, raw4.w, raw5.w, raw6.w, raw7.w, raw8.w, raw9.w, raw10.w)
        M2_CH(7, raw0.w, raw1.w, raw2.w, raw3.w, raw4.w, raw5.w, raw6.w, raw7.w, raw8.w, raw9.w, raw10.w)
      }
      if (tid < 64) {
        float dtv = softplusf(dtraw + dtb);
        float run = dtv * Aneg_t;
#pragma unroll
        for (int o = 1; o < 32; o <<= 1) { float n = __shfl_up(run, o, 32); if ((tid & 31) >= o) run += n; }
        Gs[tid] = run; dts[tid] = dtv;
      }
      __syncthreads();
      if (chunk + 1 < c1) { M2_PREFETCH(chunk + 1) }
      const int Rout = pos2row_m2(b, chunk * 32 + r, dir);
      u16* yrow = p.Y2 + (size_t)Rout * 1024 + 512 + head * 64 + 32 * ph + 4 * hh;
      uint2 yold[4];
      if (PASS == 1 && dir == 1) {
#pragma unroll
        for (int i = 0; i < 4; ++i) yold[i] = *(const uint2*)(yrow + 8 * i);
      }
      const float* Gw = Gs + hq * 32; const float* dw = dts + hq * 32;
      const float Gt = Gw[r], G31 = Gw[31];
      lsum += G31;
      const u16* xw = xsT + (hq * 64 + ph * 32) * TS;
      f32x16 O0;
      if (PASS == 1) {
      f32x16 att;
#pragma unroll
      for (int q = 0; q < 16; ++q) att[q] = 0.f;
#pragma unroll
      for (int k8 = 0; k8 < 8; ++k8) {
        bf16x8 A = *(const bf16x8*)(Bm + r * QS + 16 * k8 + 8 * hh);
        bf16x8 B = *(const bf16x8*)(Cm + r * QS + 16 * k8 + 8 * hh);
        att = __builtin_amdgcn_mfma_f32_32x32x16_bf16(A, B, att, 0, 0, 0);
      }
#pragma unroll
      for (int q4 = 0; q4 < 4; ++q4) {
        float4 gs4 = *(const float4*)(Gw + 8 * q4 + 4 * hh);
        float4 dt4 = *(const float4*)(dw + 8 * q4 + 4 * hh);
        int s0 = 8 * q4 + 4 * hh;
        att[4 * q4 + 0] = (s0 + 0 <= r) ? att[4 * q4 + 0] * __expf(Gt - gs4.x) * dt4.x : 0.f;
        att[4 * q4 + 1] = (s0 + 1 <= r) ? att[4 * q4 + 1] * __expf(Gt - gs4.y) * dt4.y : 0.f;
        att[4 * q4 + 2] = (s0 + 2 <= r) ? att[4 * q4 + 2] * __expf(Gt - gs4.z) * dt4.z : 0.f;
        att[4 * q4 + 3] = (s0 + 3 <= r) ? att[4 * q4 + 3] * __expf(Gt - gs4.w) * dt4.w : 0.f;
      }
#pragma unroll
      for (int q = 0; q < 16; ++q) O0[q] = 0.f;
#pragma unroll
      for (int nt = 0; nt < 4; ++nt)
#pragma unroll
        for (int s2 = 0; s2 < 2; ++s2) {
          bf16x8 B = ld_frag_perm(Cm + r * QS + 32 * nt + 16 * s2 + 4 * hh);
          O0 = __builtin_amdgcn_mfma_f32_32x32x16_bf16(cvt_frag(S[nt], s2), B, O0, 0, 0, 0);
        }
      {
        const float eGt = __expf(Gt);
#pragma unroll
        for (int q = 0; q < 16; ++q) O0[q] *= eGt;
      }
#pragma unroll
      for (int s2 = 0; s2 < 2; ++s2) {
        bf16x8 B = cvt_frag(att, s2);
        O0 = __builtin_amdgcn_mfma_f32_32x32x16_bf16(ld_frag_perm(xw + r * TS + 16 * s2 + 4 * hh), B, O0, 0, 0, 0);
      }
#pragma unroll
      for (int q = 0; q < 16; ++q) {
        int pp = (q & 3) + 8 * (q >> 2) + 4 * hh;
        O0[q] += Dsk * bf2f(xw[pp * TS + r]);
      }
      }
      {
        const float eG31 = __expf(G31);
#pragma unroll
        for (int nt = 0; nt < 4; ++nt)
#pragma unroll
          for (int q = 0; q < 16; ++q) S[nt][q] *= eG31;
#pragma unroll
        for (int s2 = 0; s2 < 2; ++s2) {
          float ws[8];
          {
            float4 ga = *(const float4*)(Gw + 16 * s2 + 8 * hh), gb = *(const float4*)(Gw + 16 * s2 + 8 * hh + 4);
            float4 da = *(const float4*)(dw + 16 * s2 + 8 * hh), db = *(const float4*)(dw + 16 * s2 + 8 * hh + 4);
            ws[0] = da.x * __expf(G31 - ga.x); ws[1] = da.y * __expf(G31 - ga.y); ws[2] = da.z * __expf(G31 - ga.z); ws[3] = da.w * __expf(G31 - ga.w);
            ws[4] = db.x * __expf(G31 - gb.x); ws[5] = db.y * __expf(G31 - gb.y); ws[6] = db.z * __expf(G31 - gb.z); ws[7] = db.w * __expf(G31 - gb.w);
          }
          bf16x8 Bf0;
          {
            float f[8]; unpack8(*(const uint4*)(xw + r * TS + 16 * s2 + 8 * hh), f);
#pragma unroll
            for (int j = 0; j < 8; ++j) f[j] *= ws[j];
            FragU u; u.q = pack8(f); Bf0 = u.v;
          }
#pragma unroll
          for (int nt = 0; nt < 4; ++nt) {
            bf16x8 A = *(const bf16x8*)(BmT + (32 * nt + r) * TS + 16 * s2 + 8 * hh);
            S[nt] = __builtin_amdgcn_mfma_f32_32x32x16_bf16(A, Bf0, S[nt], 0, 0, 0);
          }
        }
      }
      if (PASS == 1) {
#pragma unroll
      for (int q4 = 0; q4 < 4; ++q4) {
        float o0 = O0[4 * q4], o1 = O0[4 * q4 + 1], o2 = O0[4 * q4 + 2], o3 = O0[4 * q4 + 3];
        if (dir == 1) { o0 += bflo(yold[q4].x); o1 += bfhi(yold[q4].x); o2 += bflo(yold[q4].y); o3 += bfhi(yold[q4].y); }
        uint2 ov; ov.x = pack2(o0, o1); ov.y = pack2(o2, o3);
        *(uint2*)(yrow + 8 * q4) = ov;
      }
      }
      __syncthreads();
    }
    if (PASS == 0) {
      const size_t sidx = (size_t)((task * 2 + dir) * 8 + sbd);
      if (lane == 0) p.PA[sidx * 4 + wave] = lsum;
      float* sp = SSM + sidx * 16384 + (size_t)wave * 4096 + lane;
#pragma unroll
      for (int nt = 0; nt < 4; ++nt)
#pragma unroll
        for (int q = 0; q < 16; ++q) sp[(nt * 16 + q) * 64] = S[nt][q];
    }
    __syncthreads();
  }
}
#endif
__device__ __forceinline__ void ph_mixA0(const P& p, int l, int bid, int nb, unsigned char* sm) {
  for (int t = bid; t < 512; t += nb) {
    if (t < 256) hg_mfma<0>(p, l, t >> 4, (t >> 1) & 7, t & 1, sm);
    else { int u = t - 256; m2_mfma<0>(p, l, u >> 4, (u >> 1) & 7, u & 1, sm); }
    __syncthreads();
  }
}
__device__ __forceinline__ void ph_mixA1(const P& p, int l, int bid, int nb, unsigned char* sm) {
  for (int t = bid; t < 288; t += nb) {
    if (t < 128) hg_mfma<1>(p, l, t >> 3, 1 + (t & 7), 0, sm);
    else if (t < 256) { int u = t - 128; m2_mfma<1>(p, l, u >> 3, 1 + (u & 7), 0, sm); }
    else if (t < 272) hg_mfma<1>(p, l, t - 256, 0, 0, sm);
    else m2_mfma<1>(p, l, t - 272, 0, 0, sm);
    __syncthreads();
  }
}

template <int PASS>
__device__ __forceinline__ void rg_task(const P& p, int l, int task, float* sm) {
  int tid = threadIdx.x; asm volatile("" : "+v"(tid));
  const int wave = tid >> 6, lane = tid & 63;
  const int b = task / 136, rem = task % 136, head = rem / 17, sb = rem % 17;
  float* xc = sm;
  float* pa = sm + 2048;
  float* pb = sm + 4096;
  u16* xcb = (u16*)(sm + 6144);
  u16* WTl = xcb + 32 * 72;
  const int j = tid & 63;
  const int spos = tid >> 3, sseg = tid & 7;
  const int sch = head * 64 + sseg * 8;
  const u16* UB2 = p.U + (size_t)NTOK * 2048;
  for (int dir = 0; dir < 2; ++dir) {
    const int ld = l * 2 + dir;
    {
      const float* wa = p.rg_wa + (size_t)(ld * 8 + head) * 4096;
      const float* wx = p.rg_wx + (size_t)(ld * 8 + head) * 4096;
#pragma unroll
      for (int it = 0; it < 4; ++it) {
        int i = (tid >> 4) + 16 * it, j4 = (tid & 15) * 4;
        float4 va = *(const float4*)(wa + i * 64 + j4);
        float4 vx = *(const float4*)(wx + i * 64 + j4);
        WTl[(j4 + 0) * 72 + i] = f2bf(va.x); WTl[(j4 + 1) * 72 + i] = f2bf(va.y);
        WTl[(j4 + 2) * 72 + i] = f2bf(va.z); WTl[(j4 + 3) * 72 + i] = f2bf(va.w);
        WTl[(64 + j4 + 0) * 72 + i] = f2bf(vx.x); WTl[(64 + j4 + 1) * 72 + i] = f2bf(vx.y);
        WTl[(64 + j4 + 2) * 72 + i] = f2bf(vx.z); WTl[(64 + j4 + 3) * 72 + i] = f2bf(vx.w);
      }
    }
    float wcv[4][8], bcv[8];
#pragma unroll
    for (int jj = 0; jj < 8; ++jj) {
      bcv[jj] = p.rg_conv_b[(size_t)ld * 512 + sch + jj];
#pragma unroll
      for (int tap = 0; tap < 4; ++tap) wcv[tap][jj] = p.rg_conv_w[((size_t)ld * 4 + tap) * 512 + sch + jj];
    }
    const int chg = head * 64 + j;
    const float g_ba = p.rg_ba[ld * 512 + chg], g_bx = p.rg_bx[ld * 512 + chg];
    const float g_sp = -8.0f * softplusf(-p.rg_lam[ld * 512 + chg]);
    const int sbd = (PASS == 0) ? sb : (dir ? (sb == 0 ? 0 : 17 - sb) : sb);
    float hcarry = 0.f, aprod = 1.f;
    if (PASS == 1 && tid < 64) {
      float2 sv[16];
#pragma unroll
      for (int q = 0; q < 16; ++q) {
        const float2* sp = (const float2*)(p.SUM + ((((size_t)b * 2 + dir) * 17 + q) * 512 + head * 64 + tid) * 2);
        sv[q] = (q < sbd) ? *sp : make_float2(1.f, 0.f);
      }
#pragma unroll
      for (int q = 0; q < 16; ++q) hcarry = sv[q].x * hcarry + sv[q].y;
    }
    uint4 xr0, xr1, xr2, xr3;
#define RG_LD1(XR, TAP, CH)                                                               \
    {                                                                                     \
      int pt = (CH) * 32 + spos - 3 + (TAP);                                              \
      int sg0 = ((CH) * 32 < 256) ? 0 : 256;                                              \
      if (pt >= sg0) { int Rr = pos2row_seq(b, pt, dir); XR = *(const uint4*)(UB2 + (size_t)Rr * 2048 + sch); } \
      else XR = make_uint4(0u, 0u, 0u, 0u);                                               \
    }
#define RG_PREFETCH(CH) RG_LD1(xr0, 0, CH) RG_LD1(xr1, 1, CH) RG_LD1(xr2, 2, CH) RG_LD1(xr3, 3, CH)
    RG_PREFETCH(sbd * 8)
#pragma unroll 1
    for (int chunk = sbd * 8; chunk < sbd * 8 + 8; ++chunk) {
      const int pbase = chunk * 32;
      {
        float a[8], f[8];
#pragma unroll
        for (int jj = 0; jj < 8; ++jj) a[jj] = bcv[jj];
        unpack8(xr0, f);
#pragma unroll
        for (int jj = 0; jj < 8; ++jj) a[jj] += wcv[0][jj] * f[jj];
        unpack8(xr1, f);
#pragma unroll
        for (int jj = 0; jj < 8; ++jj) a[jj] += wcv[1][jj] * f[jj];
        unpack8(xr2, f);
#pragma unroll
        for (int jj = 0; jj < 8; ++jj) a[jj] += wcv[2][jj] * f[jj];
        unpack8(xr3, f);
#pragma unroll
        for (int jj = 0; jj < 8; ++jj) a[jj] += wcv[3][jj] * f[jj];
        *(float4*)(xc + spos * 64 + sseg * 8) = make_float4(a[0], a[1], a[2], a[3]);
        *(float4*)(xc + spos * 64 + sseg * 8 + 4) = make_float4(a[4], a[5], a[6], a[7]);
        *(uint4*)(xcb + spos * 72 + sseg * 8) = pack8(a);
      }
      __syncthreads();
      if (chunk + 1 < sbd * 8 + 8) { RG_PREFETCH(chunk + 1) }
      const int Rout = pos2row_seq(b, pbase + spos, dir);
      uint4* yp = (uint4*)(p.HL + (size_t)Rout * 1024 + 512 + sch);
      uint4 prev, gv;
      if (PASS == 1 && dir == 1) { prev = *yp; gv = *(const uint4*)(UB2 + (size_t)Rout * 2048 + 512 + sch); }
      {
        const int r = lane & 31, hh = lane >> 5;
        f32x16 acc;
#pragma unroll
        for (int q = 0; q < 16; ++q) acc[q] = 0.f;
#pragma unroll
        for (int ks = 0; ks < 4; ++ks) {
          bf16x8 A = *(const bf16x8*)(xcb + r * 72 + 16 * ks + 8 * hh);
          bf16x8 B = *(const bf16x8*)(WTl + (32 * wave + r) * 72 + 16 * ks + 8 * hh);
          acc = __builtin_amdgcn_mfma_f32_32x32x16_bf16(A, B, acc, 0, 0, 0);
        }
        float* dstp = (wave < 2) ? pa : pb;
        const int jc = (wave & 1) * 32 + r;
#pragma unroll
        for (int q = 0; q < 16; ++q) dstp[((q & 3) + 8 * (q >> 2) + 4 * hh) * 64 + jc] = acc[q];
      }
      __syncthreads();
#pragma unroll
      for (int i = 0; i < 8; ++i) {
        int e = tid + 256 * i;
        float r = sigmf(pa[e] + g_ba);
        float gi = sigmf(pb[e] + g_bx);
        float la = g_sp * r;
        float a = __expf(la);
        float bt = sqrtf(fmaxf(1.f - a * a, 0.f)) * gi * xc[e];
        pa[e] = a; pb[e] = bt;
      }
      __syncthreads();
      if (tid < 64) {
        float hh = hcarry;
#pragma unroll 8
        for (int pos = 0; pos < 32; ++pos) { float av = pa[pos * 64 + tid]; hh = av * hh + pb[pos * 64 + tid]; pb[pos * 64 + tid] = hh; aprod *= av; }
        hcarry = hh;
      }
      __syncthreads();
      if (PASS == 1) {
        float hv[8];
#pragma unroll
        for (int jj = 0; jj < 8; ++jj) hv[jj] = pb[spos * 64 + sseg * 8 + jj];
        if (dir == 1) {
          float f[8]; unpack8(prev, f);
          float gf[8]; unpack8(gv, gf);
#pragma unroll
          for (int jj = 0; jj < 8; ++jj) hv[jj] = (hv[jj] + f[jj]) * gf[jj];
        }
        *yp = pack8(hv);
      }
    }
    if (PASS == 0 && tid < 64) {
      float* sp = p.SUM + ((((size_t)b * 2 + dir) * 17 + sbd) * 512 + head * 64 + tid) * 2;
      sp[0] = aprod; sp[1] = hcarry;
    }
    __syncthreads();
  }
}

typedef bf16x8 __attribute__((aligned(2))) bf16x8_u;
typedef uint4 __attribute__((aligned(4))) uint4_a4;
__device__ __forceinline__ bf16x8 ld_win8(const u16* base, int y, uint32_t sh) {
  const uint32_t* wp = (const uint32_t*)base + (y >> 1);
  uint4 w = *(const uint4_a4*)wp;
  uint32_t w4 = wp[4];
  FragU f;
  f.u[0] = __builtin_amdgcn_alignbit(w.y, w.x, sh);
  f.u[1] = __builtin_amdgcn_alignbit(w.z, w.y, sh);
  f.u[2] = __builtin_amdgcn_alignbit(w.w, w.z, sh);
  f.u[3] = __builtin_amdgcn_alignbit(w4, w.w, sh);
  return f.v;
}

__device__ __forceinline__ void hy_conv3x8(const u16* col, int t8, int n, float w0, float w1, float w2, float bias, float* out) {
  float f[8]; unpack8(*(const uint4*)(col + t8), f);
  float prev = (t8 > 0) ? bf2f(col[t8 - 1]) : 0.f;
  float next = (t8 + 8 < n) ? bf2f(col[t8 + 8]) : 0.f;
#pragma unroll
  for (int j = 0; j < 8; ++j) {
    float a = (j == 0) ? prev : f[j - 1];
    float cnx = (j == 7) ? next : f[j + 1];
    out[j] = bias + w0 * a + w1 * f[j] + w2 * cnx;
  }
}

__device__ __forceinline__ void hy_task(const P& p, int l, int c, float* sm) {
  int tid = threadIdx.x; asm volatile("" : "+v"(tid)); const int wave = tid >> 6, lane = tid & 63;
  const int r = lane & 31, h = lane >> 5;
  u16* krr = (u16*)sm;
  u16* zs = krr + 8192 + 64;
  float* red = (float*)(zs + 16384);
  const u16* UT = p.U;
  const float* cwp = p.hy_conv_w + (size_t)l * 3 * 1536;
  const float* cbp = p.hy_conv_b + (size_t)l * 1536;
  for (int o = 0; o < 2; ++o) {
    const u16* K = p.KF + (size_t)(o * 512 + c) * 8192;
    float asum = 0.f;
#pragma unroll
    for (int i = 0; i < 4; ++i) {
      int idx = (tid + 256 * i) * 8;
      uint4 v = *(const uint4*)(K + idx);
      *(uint4*)(krr + idx) = v;
      float f[8]; unpack8(v, f);
#pragma unroll
      for (int j = 0; j < 8; ++j) asum += fabsf(f[j]);
    }
    asum = wave_sum(asum);
    if (lane == 0) red[wave] = asum;
    if (o == 0) {
      const float w0 = cwp[c], w1 = cwp[1536 + c], w2 = cwp[3072 + c], bs = cbp[c];
#pragma unroll 2
      for (int e = tid; e < 2048; e += 256) {
        int b = e >> 9, t8 = (e & 511) * 8;
        float f[8];
        hy_conv3x8(UT + (size_t)c * NTOK + b * 4096, t8, 4096, w0, w1, w2, bs, f);
        *(uint4*)(zs + b * 4096 + t8) = pack8(f);
      }
    }
    __syncthreads();
    const float scale = 1.f / (red[0] + red[1] + red[2] + red[3] + 1e-6f);
    const float skip = p.hy_skip[(l * 2 + o) * 512 + c];
    f32x16 acc[2][2];
#pragma unroll
    for (int a = 0; a < 2; ++a)
#pragma unroll
      for (int b = 0; b < 2; ++b)
#pragma unroll
        for (int q = 0; q < 16; ++q) acc[a][b][q] = 0.f;
    const int I0 = wave * 16;
    const int Il0 = I0 + (r >> 2), Il1 = I0 + 8 + (r >> 2);
    const u16* zb = zs + (r & 3) * 4096 + 8 * h;
    const int ybase = 4096 - r + 8 * h + 48;
    bf16x8 F0, F1, F2, F3, F4, F5;
    const uint32_t ysh = (uint32_t)((ybase & 1) * 16);
    {
      const int y0 = ybase - 64 * (I0 - 63);
      F0 = ld_win8(krr, y0, ysh); F1 = ld_win8(krr, y0 - 16, ysh); F2 = ld_win8(krr, y0 - 32, ysh);
      F3 = ld_win8(krr, y0 - 48, ysh); F4 = ld_win8(krr, y0 - 64, ysh); F5 = ld_win8(krr, y0 - 80, ysh);
    }
#pragma unroll 1
    for (int D = I0 - 63; D <= I0 + 15; ++D) {
      bf16x8 B0[4], B1[4];
      {
        int J0 = Il0 - D, J1 = Il1 - D;
        bool ok0 = (unsigned)J0 < 64u, ok1 = (unsigned)J1 < 64u;
        const u16* zp0 = zb + 64 * J0; const u16* zp1 = zb + 64 * J1;
#pragma unroll
        for (int ks = 0; ks < 4; ++ks) {
          bf16x8 z0 = {0, 0, 0, 0, 0, 0, 0, 0}, z1 = {0, 0, 0, 0, 0, 0, 0, 0};
          if (ok0) z0 = *(const bf16x8*)(zp0 + 16 * ks);
          if (ok1) z1 = *(const bf16x8*)(zp1 + 16 * ks);
          B0[ks] = z0; B1[ks] = z1;
        }
      }
      acc[0][0] = __builtin_amdgcn_mfma_f32_32x32x16_bf16(F3, B0[0], acc[0][0], 0, 0, 0);
      acc[0][1] = __builtin_amdgcn_mfma_f32_32x32x16_bf16(F3, B1[0], acc[0][1], 0, 0, 0);
      acc[1][0] = __builtin_amdgcn_mfma_f32_32x32x16_bf16(F5, B0[0], acc[1][0], 0, 0, 0);
      acc[1][1] = __builtin_amdgcn_mfma_f32_32x32x16_bf16(F5, B1[0], acc[1][1], 0, 0, 0);
      acc[0][0] = __builtin_amdgcn_mfma_f32_32x32x16_bf16(F2, B0[1], acc[0][0], 0, 0, 0);
      acc[0][1] = __builtin_amdgcn_mfma_f32_32x32x16_bf16(F2, B1[1], acc[0][1], 0, 0, 0);
      acc[1][0] = __builtin_amdgcn_mfma_f32_32x32x16_bf16(F4, B0[1], acc[1][0], 0, 0, 0);
      acc[1][1] = __builtin_amdgcn_mfma_f32_32x32x16_bf16(F4, B1[1], acc[1][1], 0, 0, 0);
      acc[0][0] = __builtin_amdgcn_mfma_f32_32x32x16_bf16(F1, B0[2], acc[0][0], 0, 0, 0);
      acc[0][1] = __builtin_amdgcn_mfma_f32_32x32x16_bf16(F1, B1[2], acc[0][1], 0, 0, 0);
      acc[1][0] = __builtin_amdgcn_mfma_f32_32x32x16_bf16(F3, B0[2], acc[1][0], 0, 0, 0);
      acc[1][1] = __builtin_amdgcn_mfma_f32_32x32x16_bf16(F3, B1[2], acc[1][1], 0, 0, 0);
      acc[0][0] = __builtin_amdgcn_mfma_f32_32x32x16_bf16(F0, B0[3], acc[0][0], 0, 0, 0);
      acc[0][1] = __builtin_amdgcn_mfma_f32_32x32x16_bf16(F0, B1[3], acc[0][1], 0, 0, 0);
      acc[1][0] = __builtin_amdgcn_mfma_f32_32x32x16_bf16(F2, B0[3], acc[1][0], 0, 0, 0);
      acc[1][1] = __builtin_amdgcn_mfma_f32_32x32x16_bf16(F2, B1[3], acc[1][1], 0, 0, 0);
      F0 = F4; F1 = F5;
      if (D < I0 + 15) {
        const int y1 = ybase - 64 * (D + 1);
        F2 = ld_win8(krr, y1 - 32, ysh); F3 = ld_win8(krr, y1 - 48, ysh);
        F4 = ld_win8(krr, y1 - 64, ysh); F5 = ld_win8(krr, y1 - 80, ysh);
      }
    }
    __syncthreads();
#pragma unroll
    for (int ni = 0; ni < 2; ++ni) {
      u16* zc = zs + (r & 3) * 4096 + 64 * (ni ? Il1 : Il0);
#pragma unroll
      for (int mi = 0; mi < 2; ++mi)
#pragma unroll
        for (int q = 0; q < 16; ++q) {
          int i = 32 * mi + (q & 3) + 8 * (q >> 2) + 4 * h;
          float zo = bf2f(zc[i]);
          zc[i] = f2bf(scale * acc[mi][ni][q] + skip * zo);
        }
    }
    __syncthreads();
    {
      const int ch = (o + 1) * 512 + c;
      const float w0 = cwp[ch], w1 = cwp[1536 + ch], w2 = cwp[3072 + ch], bs = cbp[ch];
#pragma unroll 2
      for (int e = tid; e < 2048; e += 256) {
        int b = e >> 9, t8 = (e & 511) * 8;
        float xg[8], y[8];
        hy_conv3x8(UT + (size_t)ch * NTOK + b * 4096, t8, 4096, w0, w1, w2, bs, xg);
        unpack8(*(const uint4*)(zs + b * 4096 + t8), y);
#pragma unroll
        for (int j = 0; j < 8; ++j) y[j] *= xg[j];
        if (o == 0) *(uint4*)(zs + b * 4096 + t8) = pack8(y);
        else {
          float gf[8]; unpack8(*(const uint4*)(UT + (size_t)(1536 + c) * NTOK + b * 4096 + t8), gf);
#pragma unroll
          for (int j = 0; j < 8; ++j) y[j] *= gf[j];
          *(uint4*)(p.U + (size_t)c * NTOK + b * 4096 + t8) = pack8(y);
        }
      }
    }
    __syncthreads();
  }
  if (l == 0) {
    const int t = tid;
    for (int o = 0; o < 2; ++o) {
      const u16* K = p.KFC + (size_t)(o * 512 + c) * 512;
      float asum = 0.f;
      {
        uint32_t w2 = *(const uint32_t*)(K + tid * 2);
        *(uint32_t*)(krr + tid * 2) = w2;
        asum = fabsf(bflo(w2)) + fabsf(bfhi(w2));
      }
      asum = wave_sum(asum);
      if (lane == 0) red[wave] = asum;
      if (o == 0) {
        const float w0 = cwp[c], w1 = cwp[1536 + c], w2 = cwp[3072 + c], bs = cbp[c];
        if (tid < 128) {
          int b = tid >> 5, t8 = (tid & 31) * 8;
          float f[8];
          hy_conv3x8(UT + (size_t)c * NTOK + NLAT + b * 256, t8, 256, w0, w1, w2, bs, f);
          *(uint4*)(zs + b * 4096 + t8) = pack8(f);
        }
      }
      __syncthreads();
      const float scale = 1.f / (red[0] + red[1] + red[2] + red[3] + 1e-6f);
      float a0 = 0, a1 = 0, a2 = 0, a3 = 0;
      for (int s2 = 0; s2 < 256; ++s2) {
        float kv = bf2f(krr[256 - t + s2]);
        a0 += kv * bf2f(zs[s2]); a1 += kv * bf2f(zs[4096 + s2]); a2 += kv * bf2f(zs[8192 + s2]); a3 += kv * bf2f(zs[12288 + s2]);
      }
      const float skip = p.hy_skip[(l * 2 + o) * 512 + c];
      float y[4];
      y[0] = scale * a0 + skip * bf2f(zs[t]); y[1] = scale * a1 + skip * bf2f(zs[4096 + t]);
      y[2] = scale * a2 + skip * bf2f(zs[8192 + t]); y[3] = scale * a3 + skip * bf2f(zs[12288 + t]);
      __syncthreads();
      {
        const int ch = (o + 1) * 512 + c;
        const float w0 = cwp[ch], w1 = cwp[1536 + ch], w2 = cwp[3072 + ch], bs = cbp[ch];
#pragma unroll
        for (int b = 0; b < 4; ++b) {
          const u16* col = UT + (size_t)ch * NTOK + NLAT + b * 256;
          float xg = bs + w1 * bf2f(col[t]);
          if (t > 0) xg += w0 * bf2f(col[t - 1]);
          if (t < 255) xg += w2 * bf2f(col[t + 1]);
          float zn = xg * y[b];
          if (o == 0) zs[b * 4096 + t] = f2bf(zn);
          else {
            size_t R = (size_t)NLAT + b * 256 + t;
            float gate = bf2f(UT[(size_t)(1536 + c) * NTOK + R]);
            p.U[(size_t)c * NTOK + R] = f2bf(zn * gate);
          }
        }
      }
      __syncthreads();
    }
  }
}

__device__ __forceinline__ void fin_rows(const P& p, int l, int chunk) {
  int tid = threadIdx.x; asm volatile("" : "+v"(tid)); const int wave = tid >> 6, lane = tid & 63;
  for (int rr = 0; rr < 16; ++rr) {
    int R = chunk * 64 + wave * 16 + rr;
    {
      uint4* yp = (uint4*)(p.Y2 + (size_t)R * 1024 + lane * 8);
      float o[8]; unpack8(*yp, o);
      float ss = 0;
#pragma unroll
      for (int j = 0; j < 8; ++j) ss += o[j] * o[j];
      ss += __shfl_xor(ss, 1); ss += __shfl_xor(ss, 2); ss += __shfl_xor(ss, 4); ss += __shfl_xor(ss, 8);
      float rinv = rsqrtf(ss * (1.f / 128.f) + EPS);
      float gf[8]; unpack8(*(const uint4*)(p.U + (size_t)NTOK * 2048 + (size_t)R * 2048 + 1024 + lane * 8), gf);
#pragma unroll
      for (int j = 0; j < 8; ++j) o[j] = o[j] * rinv * p.hg_norm_w[l * 512 + lane * 8 + j] * gf[j];
      *yp = pack8(o);
    }
    {
      uint4* yp = (uint4*)(p.Y2 + (size_t)R * 1024 + 512 + lane * 8);
      float o[8]; unpack8(*yp, o);
      float gf[8]; unpack8(*(const uint4*)(p.U + (size_t)NTOK * 2048 + (size_t)R * 2048 + 1536 + lane * 8), gf);
      float ss = 0;
#pragma unroll
      for (int j = 0; j < 8; ++j) { o[j] *= gf[j]; ss += o[j] * o[j]; }
      ss += __shfl_xor(ss, 1); ss += __shfl_xor(ss, 2); ss += __shfl_xor(ss, 4); ss += __shfl_xor(ss, 8); ss += __shfl_xor(ss, 16);
      float rinv = rsqrtf(ss * (1.f / 256.f) + EPS);
#pragma unroll
      for (int j = 0; j < 8; ++j) o[j] = o[j] * rinv * p.m2_norm_w[l * 512 + lane * 8 + j];
      *yp = pack8(o);
    }
  }
}

__device__ __forceinline__ void ph_mixB(const P& p, int l, int bid, int nb, float* sm) {
  for (int t = bid; t < 544 + 512; t += nb) {
    if (t < 544) { if (EN_RG) rg_task<0>(p, l, t, sm); }
    else { if (EN_HY) hy_task(p, l, t - 544, sm); }
    __syncthreads();
  }
}
__device__ __forceinline__ void hy_transpose(const P& p, int tile, u16* sm) {
  int tid = threadIdx.x; asm volatile("" : "+v"(tid));
  const int ct = tile & 7, rt = tile >> 3;
  const int c0 = ct * 64, R0 = rt * 64;
#pragma unroll
  for (int i = 0; i < 2; ++i) {
    int q = tid + 256 * i; int cc = q >> 3, seg = q & 7;
    *(uint4*)(sm + cc * 72 + seg * 8) = *(const uint4*)(p.U + (size_t)(c0 + cc) * NTOK + R0 + seg * 8);
  }
  __syncthreads();
#pragma unroll
  for (int i = 0; i < 2; ++i) {
    int q = tid + 256 * i; int rr = q >> 3, seg = q & 7;
    FragU f;
#pragma unroll
    for (int j = 0; j < 4; ++j)
      f.u[j] = (uint32_t)sm[(seg * 8 + 2 * j) * 72 + rr] | ((uint32_t)sm[(seg * 8 + 2 * j + 1) * 72 + rr] << 16);
    *(uint4*)(p.HL + (size_t)(R0 + rr) * 1024 + c0 + seg * 8) = f.q;
  }
}
__device__ __forceinline__ void ph_mixB2(const P& p, int l, int bid, int nb, float* sm) {
  const int nfin = (l == 0 ? NTOK : NLAT) / 64;
  const int ntr = nfin * 8;
  for (int t = bid; t < 544 + nfin + ntr; t += nb) {
    if (t < 544) { if (EN_RG) rg_task<1>(p, l, t, sm); }
    else if (t < 544 + nfin) fin_rows(p, l, t - 544);
    else hy_transpose(p, t - 544 - nfin, (u16*)sm);
    __syncthreads();
  }
}
__device__ __forceinline__ void ph_final(const P& p, int bid, int nb) {
  int tid = threadIdx.x; asm volatile("" : "+v"(tid)); const int wave = tid >> 6, lane = tid & 63;
  for (int R = bid * 4 + wave; R < NLAT; R += nb * 4) {
    float4* rp = (float4*)(p.out + (size_t)R * 1024);
    float4 v[4]; float ss = 0;
#pragma unroll
    for (int i = 0; i < 4; ++i) {
      v[i] = rp[lane + i * 64];
      ss += v[i].x * v[i].x + v[i].y * v[i].y + v[i].z * v[i].z + v[i].w * v[i].w;
    }
    ss = wave_sum(ss);
    float rinv = rsqrtf(ss * (1.f / 1024.f) + EPS);
#pragma unroll
    for (int i = 0; i < 4; ++i) {
      float4 w = *(const float4*)(p.final_norm_w + (lane + i * 64) * 4);
      float4 o; o.x = v[i].x * rinv * w.x; o.y = v[i].y * rinv * w.y; o.z = v[i].z * rinv * w.z; o.w = v[i].w * rinv * w.w;
      rp[lane + i * 64] = o;
    }
  }
}

#define SMEM_BYTES 56320
__global__ void __launch_bounds__(256) mega(P p) {
  __shared__ __align__(16) unsigned char smem[SMEM_BYTES];
  cg::grid_group grid = cg::this_grid();
  const int bid = blockIdx.x, nb = gridDim.x;
  float* smf = (float*)smem; u16* smh = (u16*)smem;
#ifndef PHM
#define PHM 0xffff
#endif
  if (PHM & 1) ph_mod(p, bid, nb, smf);
  grid.sync();
  for (int l = 0; l < 2; ++l) {
    if (PHM & 2) ph_norm(p, l, bid, nb);
    if (PHM & 4) ph_wconv(p, l, bid, nb, smf);
    grid.sync();
    if (PHM & 16) ph_gemm<0>(p, l, bid, nb, smh);
    grid.sync();
#if PROBE_DUP == 3
    ph_gemm<0>(p, l, bid, nb, smh);
    grid.sync();
#endif
#if PROBE_DUP == 10
    ph_norm(p, l, bid, nb);
    ph_wconv(p, l, bid, nb, smf);
    grid.sync();
#endif
    if (PHM & 32) ph_mixA0(p, l, bid, nb, smem);
    grid.sync();
    if (PHM & 32) ph_mixA1(p, l, bid, nb, smem);
    grid.sync();
#if PROBE_DUP == 8
    ph_mixA0(p, l, bid, nb, smem);
    grid.sync();
    ph_mixA1(p, l, bid, nb, smem);
    grid.sync();
#endif
    if (PHM & 64) ph_gemm<1>(p, l, bid, nb, smh);
    if (PHM & 8) ph_filt(p, l, bid, nb, smf);
    grid.sync();
#if PROBE_DUP == 2
    ph_mixB(p, l, bid, nb, smf);
    grid.sync();
#endif
#if PROBE_DUP == 4
    ph_gemm<1>(p, l, bid, nb, smh);
    grid.sync();
#endif
#if PROBE_DUP == 9
    ph_gemm<1>(p, l, bid, nb, smh, 1);
    grid.sync();
#endif
    if (PHM & 128) ph_mixB(p, l, bid, nb, smf);
    grid.sync();
    if (PHM & 128) ph_mixB2(p, l, bid, nb, smf);
    grid.sync();
#if PROBE_DUP == 7
    for (int t = bid; t < 544; t += nb) { rg_task<1>(p, l, t, smf); __syncthreads(); }
    grid.sync();
#endif
    if (PHM & 256) ph_gemm<2>(p, l, bid, nb, smh);
    grid.sync();
  }
  if (PHM & 512) ph_final(p, bid, nb);
}

extern "C" void kernel_launch(void* const* d_in, const int* in_sizes, int n_in, void* d_out, int out_size,
                              void* d_ws, size_t ws_size, hipStream_t stream) {
  static int grid_blocks = 0;
  if (!grid_blocks) {
    int dev = 0, cus = 0, per_cu = 0;
    hipGetDevice(&dev);
    hipDeviceGetAttribute(&cus, hipDeviceAttributeMultiprocessorCount, dev);
    hipOccupancyMaxActiveBlocksPerMultiprocessor(&per_cu, mega, 256, 0);
    if (per_cu < 1) per_cu = 1;
    if (per_cu > 2) per_cu = 2;
    grid_blocks = cus * per_cu;
  }
  P p{};
  const float** fp = (const float**)&p;
  for (int i = 0; i < 34; ++i) fp[i] = (const float*)d_in[i];
  p.out = (float*)d_out;
  char* w = (char*)d_ws;
  size_t off = 0;
  auto take = [&](size_t bytes) { char* r = w + off; off += (bytes + 255) & ~(size_t)255; return r; };
  p.U = (u16*)take((size_t)NTOK * UW * 2);
  p.HL = (u16*)take((size_t)NTOK * 1024 * 2);
  p.Y2 = (u16*)take((size_t)NTOK * 1024 * 2);
  p.WT = (u16*)take((size_t)7296 * 1024 * 2);
  p.WoT = (u16*)take((size_t)1024 * 2048 * 2);
  p.KF = (u16*)take((size_t)1024 * 8192 * 2);
  p.DT = (float*)take((size_t)NTOK * 8 * 4);
  p.MOD = (float*)take((size_t)2 * 5 * 3072 * 4);
  p.SUM = (float*)take((size_t)4 * 2 * 17 * 512 * 2 * 4);
  {
    char* Z = take((size_t)16777216);
    p.SSH = (float*)Z; p.XC = (float*)(Z + 8388608); p.KFC = (u16*)(Z + 12582912);
  }
  p.PS = (float*)take((size_t)16 * 2 * 8 * 128 * 4);
  p.PA = (float*)take((size_t)16 * 2 * 8 * 4 * 4);
  if (off > ws_size) { fprintf(stderr, "workspace too small: need %zu have %zu\n", off, ws_size); return; }
  void* args[] = {&p};
  hipError_t e = hipLaunchCooperativeKernel((void*)mega, dim3(grid_blocks), dim3(256), args, 0, stream);
  if (e != hipSuccess) fprintf(stderr, "cooperative launch failed: %s (grid %d)\n", hipGetErrorString(e), grid_blocks);
}
```

```cpp
#include <hip/hip_runtime.h>
#include <hip/hip_bf16.h>
#include <hip/hip_cooperative_groups.h>
#include <cstdio>
#include <cstdint>
namespace cg = cooperative_groups;

typedef unsigned short u16;
using bf16x8 = __attribute__((ext_vector_type(8))) short;
using f32x16 = __attribute__((ext_vector_type(16))) float;

#define NTOK 17408
#define NLAT 16384
#define UW 4096
#define EPS 1e-6f

#ifndef PROBE_DUP
#define PROBE_DUP 0
#endif
#ifndef EN_HY
#define EN_HY 1
#endif
#ifndef EN_RG
#define EN_RG 1
#endif
#ifndef EN_HG
#define EN_HG 1
#endif
#ifndef EN_M2
#define EN_M2 1
#endif

struct P {
  const float *x, *c, *ctx, *c_ctx, *w_mod, *b_mod, *norm_w, *w_in, *w_out;
  const float *hy_conv_w, *hy_conv_b, *hy_w1, *hy_b1, *hy_w2, *hy_b2, *hy_w3, *hy_freq, *hy_skip;
  const float *rg_conv_w, *rg_conv_b, *rg_wa, *rg_ba, *rg_wx, *rg_bx, *rg_lam;
  const float *hg_lb, *hg_norm_w, *m2_conv_w, *m2_conv_b, *m2_dt_bias, *m2_a_log, *m2_d, *m2_norm_w, *final_norm_w;
  float* out;
  u16 *U, *HL, *Y2, *WT, *WoT, *KF, *KFC;
  float *XC, *DT, *MOD, *SUM, *SSH, *PS, *PA;
};

typedef __bf16 bf2_t __attribute__((ext_vector_type(2)));
typedef float f2_t __attribute__((ext_vector_type(2)));
__device__ __forceinline__ uint32_t pack2(float a, float b) {
  f2_t v = {a, b};
  return __builtin_bit_cast(uint32_t, __builtin_convertvector(v, bf2_t));
}
__device__ __forceinline__ u16 f2bf(float f) { return (u16)(pack2(f, f) & 0xffffu); }
__device__ __forceinline__ float bf2f(u16 h) { return __uint_as_float(((uint32_t)h) << 16); }
__device__ __forceinline__ float bflo(uint32_t w) { return __uint_as_float(w << 16); }
__device__ __forceinline__ float bfhi(uint32_t w) { return __uint_as_float(w & 0xffff0000u); }
__device__ __forceinline__ float siluf(float x) { return x * __builtin_amdgcn_rcpf(1.f + __expf(-x)); }
__device__ __forceinline__ float sigmf(float x) { return __builtin_amdgcn_rcpf(1.f + __expf(-x)); }
__device__ __forceinline__ float softplusf(float x) { return x > 20.f ? x : log1pf(__expf(x)); }

__device__ __forceinline__ void unpack8(const uint4& v, float* f) {
  f[0] = bflo(v.x); f[1] = bfhi(v.x); f[2] = bflo(v.y); f[3] = bfhi(v.y);
  f[4] = bflo(v.z); f[5] = bfhi(v.z); f[6] = bflo(v.w); f[7] = bfhi(v.w);
}
__device__ __forceinline__ uint4 pack8(const float* f) {
  uint4 v; v.x = pack2(f[0], f[1]); v.y = pack2(f[2], f[3]); v.z = pack2(f[4], f[5]); v.w = pack2(f[6], f[7]);
  return v;
}
__device__ __forceinline__ float wave_sum(float v) {
#pragma unroll
  for (int o = 32; o >= 1; o >>= 1) v += __shfl_xor(v, o);
  return v;
}

__device__ __forceinline__ int pos2row_seq(int b, int p, int dir) {
  if (p < 256) { int t = dir ? 255 - p : p; return NLAT + b * 256 + t; }
  int j = p - 256; int t = dir ? 4095 - j : j; return b * 4096 + t;
}
__device__ __forceinline__ int pos2row_m2(int b, int p, int dir) {
  if (p < 256) { int t = dir ? 255 - p : p; return NLAT + b * 256 + t; }
  int j = p - 256; int jj = dir ? 4095 - j : j; int c = jj >> 6, r = jj & 63; return b * 4096 + r * 64 + c;
}

__device__ __forceinline__ void ph_mod(const P& p, int bid, int nb, float* sm) {
  int tid = threadIdx.x; asm volatile("" : "+v"(tid));
  for (int task = bid; task < 96; task += nb) {
    int l = task / 48, cgi = task % 48;
    int col = cgi * 64 + (tid & 63);
    int kq = tid >> 6;
    float a0 = 0, a1 = 0, a2 = 0, a3 = 0, a4 = 0;
#pragma unroll 8
    for (int k = kq * 256; k < kq * 256 + 256; ++k) {
      float w = p.w_mod[((size_t)l * 1024 + k) * 3072 + col];
      a0 += siluf(p.c[k]) * w; a1 += siluf(p.c[1024 + k]) * w; a2 += siluf(p.c[2048 + k]) * w;
      a3 += siluf(p.c[3072 + k]) * w; a4 += siluf(p.c_ctx[k]) * w;
    }
    sm[(kq * 5 + 0) * 64 + (tid & 63)] = a0; sm[(kq * 5 + 1) * 64 + (tid & 63)] = a1;
    sm[(kq * 5 + 2) * 64 + (tid & 63)] = a2; sm[(kq * 5 + 3) * 64 + (tid & 63)] = a3;
    sm[(kq * 5 + 4) * 64 + (tid & 63)] = a4;
    __syncthreads();
    if (tid < 64) {
      float bm = p.b_mod[l * 3072 + col];
#pragma unroll
      for (int j = 0; j < 5; ++j) {
        float s = sm[(0 * 5 + j) * 64 + tid] + sm[(1 * 5 + j) * 64 + tid] + sm[(2 * 5 + j) * 64 + tid] + sm[(3 * 5 + j) * 64 + tid];
        p.MOD[(size_t)(l * 5 + j) * 3072 + col] = s + bm;
      }
    }
    __syncthreads();
  }
}

__device__ __forceinline__ void ph_norm(const P& p, int l, int bid, int nb) {
  int tid = threadIdx.x; asm volatile("" : "+v"(tid)); const int wave = tid >> 6, lane = tid & 63;
  for (int R = bid * 4 + wave; R < NTOK; R += nb * 4) {
    const float* src; int mj;
    if (R < NLAT) { src = (l == 0 ? p.x : (const float*)p.out) + (size_t)R * 1024; mj = R >> 12; }
    else { int rc = R - NLAT; src = (l == 0 ? p.ctx : (const float*)p.XC) + (size_t)rc * 1024; mj = 4; }
    const float* mod = p.MOD + (size_t)(l * 5 + mj) * 3072;
    float4 v[4]; float ss = 0;
#pragma unroll
    for (int i = 0; i < 4; ++i) {
      v[i] = ((const float4*)src)[lane + i * 64];
      ss += v[i].x * v[i].x + v[i].y * v[i].y + v[i].z * v[i].z + v[i].w * v[i].w;
    }
    ss = wave_sum(ss);
    float rinv = rsqrtf(ss * (1.f / 1024.f) + EPS);
#pragma unroll
    for (int i = 0; i < 4; ++i) {
      int idx = (lane + i * 64) * 4;
      float4 nw = *(const float4*)(p.norm_w + l * 1024 + idx);
      float4 sh = *(const float4*)(mod + idx);
      float4 sc = *(const float4*)(mod + 1024 + idx);
      float h0 = v[i].x * rinv * nw.x * (1.f + sc.x) + sh.x;
      float h1 = v[i].y * rinv * nw.y * (1.f + sc.y) + sh.y;
      float h2 = v[i].z * rinv * nw.z * (1.f + sc.z) + sh.z;
      float h3 = v[i].w * rinv * nw.w * (1.f + sc.w) + sh.w;
      uint2 o; o.x = pack2(h0, h1); o.y = pack2(h2, h3);
      *(uint2*)(p.HL + (size_t)R * 1024 + idx) = o;
    }
  }
}

__device__ __forceinline__ void ph_wconv(const P& p, int l, int bid, int nb, float* sm) {
  int tid = threadIdx.x; asm volatile("" : "+v"(tid));
  const int T1 = 114 * 16, T2 = 16 * 32;
  for (int t = bid; t < T1 + T2; t += nb) {
    const float* src; int ld, K, n0, k0, sc0, nvalid; u16* dst;
    if (t < T1) {
      int nt = t / 16, kt = t % 16; n0 = nt * 64; k0 = kt * 64;
      src = p.w_in + (size_t)l * 1024 * 7176; ld = 7176; K = 1024; dst = p.WT; nvalid = 64;
      if (n0 < 2048) sc0 = 3072 + n0;
      else if (n0 < 3072) sc0 = 5632 + (n0 - 2048);
      else if (n0 < 3200) { sc0 = 6656 + (n0 - 3072); nvalid = (n0 == 3072) ? 8 : 0; }
      else { int m = n0 - 3200; if (m < 3072) sc0 = m; else if (m < 3584) sc0 = 5120 + (m - 3072); else sc0 = 6664 + (m - 3584); }
    } else {
      int tt = t - T1; int nt = tt / 32, kt = tt % 32; n0 = nt * 64; k0 = kt * 64;
      src = p.w_out + (size_t)l * 2048 * 1024; ld = 1024; K = 2048; dst = p.WoT; nvalid = 64; sc0 = n0;
    }
#pragma unroll
    for (int i = 0; i < 4; ++i) {
      int kk = (tid >> 4) + 16 * i, cc = (tid & 15) * 4;
      const float* sp = src + (size_t)(k0 + kk) * ld + sc0 + cc;
      float4 v;
      if (nvalid == 64) v = *(const float4*)sp;
      else { v.x = (cc + 0 < nvalid) ? sp[0] : 0.f; v.y = (cc + 1 < nvalid) ? sp[1] : 0.f; v.z = (cc + 2 < nvalid) ? sp[2] : 0.f; v.w = (cc + 3 < nvalid) ? sp[3] : 0.f; }
      sm[kk * 65 + cc + 0] = v.x; sm[kk * 65 + cc + 1] = v.y; sm[kk * 65 + cc + 2] = v.z; sm[kk * 65 + cc + 3] = v.w;
    }
    __syncthreads();
#pragma unroll
    for (int i = 0; i < 2; ++i) {
      int q = tid + 256 * i; int nn = q >> 3, ks = q & 7;
      float f[8];
#pragma unroll
      for (int j = 0; j < 8; ++j) f[j] = sm[(ks * 8 + j) * 65 + nn];
      *(uint4*)(dst + (size_t)(n0 + nn) * K + k0 + ks * 8) = pack8(f);
    }
    __syncthreads();
  }
}

__device__ __forceinline__ void ph_filt(const P& p, int l, int bid, int nb, float* sm) {
  int tid = threadIdx.x; asm volatile("" : "+v"(tid));
  const float HY_MIN = -3.0701134573253945f, HY_MAX = -15.350567286626972f;
  int ntask = 256 + (l == 0 ? 16 : 0);
  float* zs = sm; float* h1 = sm + 544; float* h2 = sm + 544 + 1024;
  for (int task = bid; task < ntask; task += nb) {
    int n, t0; u16* K;
    if (task < 256) { n = 4096; t0 = task * 16; K = p.KF; } else { n = 256; t0 = (task - 256) * 16; K = p.KFC; }
    float inv_nm1 = 1.f / (float)(n - 1);
    for (int e = tid; e < 16 * 33; e += 256) {
      int tt = e / 33, f = e % 33; int t = t0 + tt; float val;
      if (f == 0) val = (float)t * inv_nm1;
      else {
        int bi = (f - 1) & 15;
        float band = 1e-4f + (float)bi * ((15.f - 1e-4f) / 15.f);
        float ang = (6.283185307179586f / (float)n) * (float)t * band;
        val = (f <= 16) ? cosf(ang) : -sinf(ang);
      }
      zs[e] = val;
    }
    __syncthreads();
    for (int e = tid; e < 1024; e += 256) {
      int tt = e >> 6, j = e & 63; float acc = p.hy_b1[l * 64 + j];
#pragma unroll 11
      for (int f = 0; f < 33; ++f) acc += zs[tt * 33 + f] * p.hy_w1[(l * 33 + f) * 64 + j];
      h1[e] = sinf(p.hy_freq[l * 64 + j] * acc);
    }
    __syncthreads();
    for (int e = tid; e < 1024; e += 256) {
      int tt = e >> 6, j = e & 63; float acc = p.hy_b2[l * 64 + j];
#pragma unroll 8
      for (int i = 0; i < 64; ++i) acc += h1[tt * 64 + i] * p.hy_w2[(l * 64 + i) * 64 + j];
      h2[e] = sinf(p.hy_freq[l * 64 + j] * acc);
    }
    __syncthreads();
    for (int r = 0; r < 8; ++r) {
      int col = tid + 256 * r; int o = col >> 10, side = (col >> 9) & 1, c = col & 511;
      float w[64];
#pragma unroll
      for (int i = 0; i < 64; ++i) w[i] = p.hy_w3[(size_t)(l * 64 + i) * 2048 + col];
      float delta = fabsf(HY_MIN + (HY_MAX - HY_MIN) * (float)c / 511.f);
      u16* Kc = K + (size_t)(o * 512 + c) * (2 * n);
      for (int tt = 0; tt < 16; ++tt) {
        float acc = 0;
#pragma unroll
        for (int i = 0; i < 64; ++i) acc += h2[tt * 64 + i] * w[i];
        int t = t0 + tt;
        float val = acc * __expf(-(float)t * inv_nm1 * delta);
        int idx;
        if (side == 0) idx = n - t; else { if (t == 0) { idx = 0; val = 0.f; } else idx = n + t; }
        Kc[idx] = f2bf(val);
      }
    }
    __syncthreads();
  }
}

#define LDSTR 72
template <int MODE>
__device__ __forceinline__ void gemm_tile(const P& p, int l, int mt, int nt, u16* sA, u16* sB, int noepi) {
  int tid = threadIdx.x; asm volatile("" : "+v"(tid)); const int wave = tid >> 6, lane = tid & 63;
  const int wm = wave >> 1, wn = wave & 1;
  const int KT = (MODE == 2) ? 2048 : 1024;
  const u16* Bsrc = (MODE == 0) ? p.WT + (size_t)(nt * 128) * 1024
                  : (MODE == 1) ? p.WT + (size_t)(3200 + nt * 128) * 1024
                                : p.WoT + (size_t)(nt * 128) * 2048;
  f32x16 acc[4][2];
#pragma unroll
  for (int a = 0; a < 4; ++a)
#pragma unroll
    for (int b = 0; b < 2; ++b)
#pragma unroll
      for (int r = 0; r < 16; ++r) acc[a][b][r] = 0.f;
  uint4 ra0, ra1, ra2, ra3, ra4, ra5, ra6, ra7, rb0, rb1, rb2, rb3;
  const int lrow = tid >> 3, lseg = tid & 7;
  const u16* Ab0 = p.HL + (size_t)(mt * 256 + lrow) * 1024 + lseg * 8;
  const u16* Ab1 = p.Y2 + (size_t)(mt * 256 + lrow) * 1024 + lseg * 8;
  const u16* Bb = Bsrc + (size_t)lrow * KT + lseg * 8;
#define GLOADS(K0)                                                                                  \
  {                                                                                                 \
    const u16* ap = (MODE == 2 && (K0) >= 1024) ? Ab1 + ((K0) - 1024) : Ab0 + (K0);                 \
    ra0 = *(const uint4*)(ap); ra1 = *(const uint4*)(ap + 32 * 1024);                               \
    ra2 = *(const uint4*)(ap + 64 * 1024); ra3 = *(const uint4*)(ap + 96 * 1024);                   \
    ra4 = *(const uint4*)(ap + 128 * 1024); ra5 = *(const uint4*)(ap + 160 * 1024);                 \
    ra6 = *(const uint4*)(ap + 192 * 1024); ra7 = *(const uint4*)(ap + 224 * 1024);                 \
    const u16* bp = Bb + (K0);                                                                      \
    rb0 = *(const uint4*)(bp); rb1 = *(const uint4*)(bp + (size_t)32 * KT);                         \
    rb2 = *(const uint4*)(bp + (size_t)64 * KT); rb3 = *(const uint4*)(bp + (size_t)96 * KT);       \
  }
  GLOADS(0)
#pragma unroll 1
  for (int k0 = 0; k0 < KT; k0 += 64) {
    *(uint4*)(sA + (lrow + 0) * LDSTR + lseg * 8) = ra0;   *(uint4*)(sA + (lrow + 32) * LDSTR + lseg * 8) = ra1;
    *(uint4*)(sA + (lrow + 64) * LDSTR + lseg * 8) = ra2;  *(uint4*)(sA + (lrow + 96) * LDSTR + lseg * 8) = ra3;
    *(uint4*)(sA + (lrow + 128) * LDSTR + lseg * 8) = ra4; *(uint4*)(sA + (lrow + 160) * LDSTR + lseg * 8) = ra5;
    *(uint4*)(sA + (lrow + 192) * LDSTR + lseg * 8) = ra6; *(uint4*)(sA + (lrow + 224) * LDSTR + lseg * 8) = ra7;
    *(uint4*)(sB + (lrow + 0) * LDSTR + lseg * 8) = rb0;   *(uint4*)(sB + (lrow + 32) * LDSTR + lseg * 8) = rb1;
    *(uint4*)(sB + (lrow + 64) * LDSTR + lseg * 8) = rb2;  *(uint4*)(sB + (lrow + 96) * LDSTR + lseg * 8) = rb3;
    __syncthreads();
    if (k0 + 64 < KT) GLOADS(k0 + 64)
#pragma unroll
    for (int ks = 0; ks < 4; ++ks) {
      bf16x8 fa[4], fb[2];
#pragma unroll
      for (int mi = 0; mi < 4; ++mi)
        fa[mi] = *(const bf16x8*)(sA + (wm * 128 + mi * 32 + (lane & 31)) * LDSTR + ks * 16 + (lane >> 5) * 8);
#pragma unroll
      for (int ni = 0; ni < 2; ++ni)
        fb[ni] = *(const bf16x8*)(sB + (wn * 64 + ni * 32 + (lane & 31)) * LDSTR + ks * 16 + (lane >> 5) * 8);
#pragma unroll
      for (int mi = 0; mi < 4; ++mi)
#pragma unroll
        for (int ni = 0; ni < 2; ++ni)
          acc[mi][ni] = __builtin_amdgcn_mfma_f32_32x32x16_bf16(fa[mi], fb[ni], acc[mi][ni], 0, 0, 0);
    }
    __syncthreads();
  }
  if (noepi) {
    float sacc = 0.f;
#pragma unroll
    for (int a = 0; a < 4; ++a)
#pragma unroll
      for (int b = 0; b < 2; ++b) sacc += acc[a][b][3];
    if (sacc == 1.2345e30f) p.DT[0] = sacc;
    return;
  }
  const int mj = (mt < 64) ? (mt >> 4) : 4;
  const int c31 = lane & 31, hh = lane >> 5;
  const int gcolA = nt * 128 + wn * 64 + c31, gcolB = gcolA + 32;
  if (MODE == 0 && nt == 24) {
    if (wn == 0 && c31 < 8) {
#pragma unroll
      for (int mi = 0; mi < 4; ++mi)
#pragma unroll
        for (int r = 0; r < 16; ++r) {
          const int R = mt * 256 + wm * 128 + mi * 32 + (r & 3) + 8 * (r >> 2) + 4 * hh;
          p.DT[(size_t)R * 8 + c31] = acc[mi][0][r];
        }
    }
    return;
  }
  if (MODE == 1 && nt < 16) {
    const bool sl = (gcolA >> 9) == 3;
#pragma unroll
    for (int mi = 0; mi < 4; ++mi)
#pragma unroll
      for (int ni = 0; ni < 2; ++ni)
#pragma unroll
        for (int g4 = 0; g4 < 4; ++g4) {
          float v0 = acc[mi][ni][4 * g4], v1 = acc[mi][ni][4 * g4 + 1], v2 = acc[mi][ni][4 * g4 + 2], v3 = acc[mi][ni][4 * g4 + 3];
          if (sl) { v0 = siluf(v0); v1 = siluf(v1); v2 = siluf(v2); v3 = siluf(v3); }
          int R0 = mt * 256 + wm * 128 + mi * 32 + 8 * g4 + 4 * hh;
          uint2 o; o.x = pack2(v0, v1); o.y = pack2(v2, v3);
          *(uint2*)(p.U + (size_t)(ni ? gcolB : gcolA) * NTOK + R0) = o;
        }
    return;
  }
  if (MODE != 2) {
    float lbA = 0.f, lbB = 0.f;
    int kindA = 0, kindB = 0;
    if (MODE == 0) {
      int pa_ = gcolA >> 9, pb_ = gcolB >> 9;
      kindA = (pa_ == 0) ? 1 : (pa_ == 1 || pa_ == 2) ? 2 : 0;
      kindB = (pb_ == 0) ? 1 : (pb_ == 1 || pb_ == 2) ? 2 : 0;
      if (l == 1) {
        if (kindA == 2) { int dir = pa_ - 1, ch = gcolA & 511; lbA = 1.f / (1.f + __expf(p.hg_lb[dir * 512 + ch] - p.hg_lb[(2 + dir) * 512 + ch])); }
        if (kindB == 2) { int dir = pb_ - 1, ch = gcolB & 511; lbB = 1.f / (1.f + __expf(p.hg_lb[dir * 512 + ch] - p.hg_lb[(2 + dir) * 512 + ch])); }
      }
    } else {
      int pa_ = gcolA >> 9, pb_ = gcolB >> 9;
      kindA = (pa_ == 3 || pa_ >= 5) ? 3 : 0;
      kindB = (pb_ == 3 || pb_ >= 5) ? 3 : 0;
    }
    u16* stg = sA + wave * (32 * 72);
    u16* dstbase = (MODE == 0) ? p.U + (size_t)(nt * 128 + wn * 64) : p.U + (size_t)NTOK * 2048 + (size_t)(nt * 128 - 2048 + wn * 64);
    const int ldo = (MODE == 0) ? UW : 2048;
#pragma unroll
    for (int mi = 0; mi < 4; ++mi) {
#pragma unroll
      for (int r = 0; r < 16; ++r) {
        const int rl = (r & 3) + 8 * (r >> 2) + 4 * hh;
        float va = acc[mi][0][r], vb = acc[mi][1][r];
        if (kindA == 1) va *= 0.08838834764831845f; else if (kindA == 2) va = (1.f - lbA) * __builtin_amdgcn_rcpf(1.f + __expf(va)); else if (kindA == 3) va = siluf(va);
        if (kindB == 1) vb *= 0.08838834764831845f; else if (kindB == 2) vb = (1.f - lbB) * __builtin_amdgcn_rcpf(1.f + __expf(vb)); else if (kindB == 3) vb = siluf(vb);
        stg[rl * 72 + c31] = f2bf(va);
        stg[rl * 72 + 32 + c31] = f2bf(vb);
      }
#pragma unroll
      for (int it = 0; it < 4; ++it) {
        const int rl = it * 8 + (lane >> 3), seg = lane & 7;
        uint4 v = *(const uint4*)(stg + rl * 72 + seg * 8);
        const int R = mt * 256 + wm * 128 + mi * 32 + rl;
        *(uint4*)(dstbase + (size_t)R * ldo + seg * 8) = v;
      }
    }
    return;
  }
  {
    float* stgf = (float*)sA + wave * (32 * 68);
    const int seg = lane & 15;
    const int gc0 = nt * 128 + wn * 64 + seg * 4;
    const float4 g4v = *(const float4*)(p.MOD + (size_t)(l * 5 + mj) * 3072 + 2048 + gc0);
#pragma unroll
    for (int mi = 0; mi < 4; ++mi) {
#pragma unroll
      for (int r = 0; r < 16; ++r) {
        const int rl = (r & 3) + 8 * (r >> 2) + 4 * hh;
        stgf[rl * 68 + c31] = acc[mi][0][r];
        stgf[rl * 68 + 32 + c31] = acc[mi][1][r];
      }
#pragma unroll
      for (int it = 0; it < 8; ++it) {
        const int rl = it * 4 + (lane >> 4);
        float4 v = *(const float4*)(stgf + rl * 68 + seg * 4);
        const int R = mt * 256 + wm * 128 + mi * 32 + rl;
        const float* src; float* dst;
        if (R < NLAT) { src = ((l == 0) ? p.x : (const float*)p.out) + (size_t)R * 1024 + gc0; dst = p.out + (size_t)R * 1024 + gc0; }
        else { int rc = R - NLAT; src = p.ctx + (size_t)rc * 1024 + gc0; dst = p.XC + (size_t)rc * 1024 + gc0; }
        float4 xv = *(const float4*)src;
        float4 o; o.x = xv.x + g4v.x * v.x; o.y = xv.y + g4v.y * v.y; o.z = xv.z + g4v.z * v.z; o.w = xv.w + g4v.w * v.w;
        *(float4*)dst = o;
      }
    }
  }
}

template <int MODE>
__device__ __forceinline__ void ph_gemm(const P& p, int l, int bid, int nb, u16* sm, int noepi = 0) {
  const int NT = (MODE == 0) ? 25 : (MODE == 1) ? 32 : 8;
  const int MT = (MODE == 2 && l == 1) ? 64 : 68;
  u16* sA = sm; u16* sB = sm + 256 * LDSTR;
  const int xcd = bid & 7, local = bid >> 3, npx = nb >> 3;
  const int mbase = MT >> 3, mextra = MT & 7;
  const int mper = mbase + (xcd < mextra ? 1 : 0);
  const int mstart = (xcd < mextra) ? xcd * (mbase + 1) : mextra * (mbase + 1) + (xcd - mextra) * mbase;
  const int total = mper * NT;
  const int fullb = NT >> 3, rem = NT & 7;
  for (int it = 0;; ++it) {
    int mt, nt;
    if ((nb & 7) == 0) {
      int q = local + npx * it;
      if (q >= total) break;
      int b, i, bw;
      if (q < fullb * mper * 8) { b = q / (mper * 8); i = q - b * mper * 8; bw = 8; }
      else { b = fullb; i = q - fullb * mper * 8; bw = rem; }
      int sub = i / (4 * bw);
      const int nsub = mper >> 2;
      int mt_off, nt_off;
      if (sub < nsub) { int j = i - sub * 4 * bw; mt_off = j & 3; nt_off = j >> 2; }
      else { int j = i - nsub * 4 * bw; sub = nsub; mt_off = 0; nt_off = j; }
      mt = mstart + sub * 4 + mt_off; nt = b * 8 + nt_off;
    } else {
      int t = bid + it * nb;
      if (t >= MT * NT) break;
      nt = t / MT; mt = t % MT;
    }
    __syncthreads();
    gemm_tile<MODE>(p, l, mt, nt, sA, sB, noepi);
  }
  __syncthreads();
}

__device__ __forceinline__ void hg_task(const P& p, int l, int task, float* sm) {
  int tid = threadIdx.x; asm volatile("" : "+v"(tid)); const int wave = tid >> 6, lane = tid & 63;
  const int b = task >> 5, h = (task >> 3) & 3, es = task & 7;
  const int dg = lane & 15, el = lane >> 4;
  float* qs = sm; float* ks = sm + 4096; float* vs = sm + 8192; float* os = sm + 8192 + 512;
  for (int dir = 0; dir < 2; ++dir) {
    float S[8];
#pragma unroll
    for (int r = 0; r < 8; ++r) S[r] = 0.f;
    for (int chunk = 0; chunk < 136; ++chunk) {
#pragma unroll
      for (int i = 0; i < 2; ++i) {
        int q = tid + 256 * i; int pos = q >> 4, seg = q & 15;
        int R = pos2row_seq(b, chunk * 32 + pos, dir);
        const u16* up = p.U + (size_t)R * UW + h * 128 + seg * 8;
        uint4 qv = *(const uint4*)up;
        uint4 kv = *(const uint4*)(up + 512 + dir * 512);
        float f[8];
        unpack8(qv, f);
        *(float4*)(qs + pos * 128 + seg * 8) = make_float4(f[0], f[1], f[2], f[3]);
        *(float4*)(qs + pos * 128 + seg * 8 + 4) = make_float4(f[4], f[5], f[6], f[7]);
        unpack8(kv, f);
        *(float4*)(ks + pos * 128 + seg * 8) = make_float4(f[0], f[1], f[2], f[3]);
        *(float4*)(ks + pos * 128 + seg * 8 + 4) = make_float4(f[4], f[5], f[6], f[7]);
      }
      {
        int pos = tid >> 3, e2 = (tid & 7) * 2;
        int R = pos2row_seq(b, chunk * 32 + pos, dir);
        uint32_t w = *(const uint32_t*)(p.U + (size_t)R * UW + 1536 + h * 128 + es * 16 + e2);
        vs[pos * 16 + e2] = bflo(w); vs[pos * 16 + e2 + 1] = bfhi(w);
      }
      __syncthreads();
#pragma unroll 4
      for (int i = 0; i < 32; ++i) {
        float4 q0 = *(const float4*)(qs + i * 128 + dg * 8), q1 = *(const float4*)(qs + i * 128 + dg * 8 + 4);
        float4 k0 = *(const float4*)(ks + i * 128 + dg * 8), k1 = *(const float4*)(ks + i * 128 + dg * 8 + 4);
        float v = vs[i * 16 + wave * 4 + el];
        S[0] += k0.x * (v - S[0]); S[1] += k0.y * (v - S[1]); S[2] += k0.z * (v - S[2]); S[3] += k0.w * (v - S[3]);
        S[4] += k1.x * (v - S[4]); S[5] += k1.y * (v - S[5]); S[6] += k1.z * (v - S[6]); S[7] += k1.w * (v - S[7]);
        float o = q0.x * S[0] + q0.y * S[1] + q0.z * S[2] + q0.w * S[3] + q1.x * S[4] + q1.y * S[5] + q1.z * S[6] + q1.w * S[7];
        o += __shfl_xor(o, 1); o += __shfl_xor(o, 2); o += __shfl_xor(o, 4); o += __shfl_xor(o, 8);
        if (dg == 0) os[i * 16 + wave * 4 + el] = o;
      }
      __syncthreads();
      {
        int pos = tid >> 3, e2 = (tid & 7) * 2;
        int R = pos2row_seq(b, chunk * 32 + pos, dir);
        uint32_t* yp = (uint32_t*)(p.Y2 + (size_t)R * 1024 + h * 128 + es * 16 + e2);
        float o0 = os[pos * 16 + e2], o1 = os[pos * 16 + e2 + 1];
        if (dir == 1) { uint32_t w = *yp; o0 += bflo(w); o1 += bfhi(w); }
        *yp = pack2(o0, o1);
      }
    }
    __syncthreads();
  }
}

__device__ __forceinline__ void m2_task(const P& p, int l, int task, float* sm) {
  int tid = threadIdx.x; asm volatile("" : "+v"(tid)); const int wave = tid >> 6, lane = tid & 63;
  const int b = task >> 5, head = (task >> 2) & 7, ps = task & 3;
  const int g = head >> 2;
  const int dg = lane & 15, el = lane >> 4;
  float* Cs = sm; float* Bs = sm + 4096; float* xs = sm + 8192; float* os = sm + 8192 + 512;
  float* dts = sm + 8192 + 1024; float* decs = dts + 32;
  for (int dir = 0; dir < 2; ++dir) {
    const float* cw = p.m2_conv_w + (size_t)(l * 2 + dir) * 4 * 1024;
    const float* cb = p.m2_conv_b + (size_t)(l * 2 + dir) * 1024;
    const float dtb = p.m2_dt_bias[(l * 2 + dir) * 8 + head];
    const float Aneg = -__expf(p.m2_a_log[(l * 2 + dir) * 8 + head]);
    const float Dsk = p.m2_d[(l * 2 + dir) * 8 + head];
    float S[8];
#pragma unroll
    for (int r = 0; r < 8; ++r) S[r] = 0.f;
    for (int chunk = 0; chunk < 136; ++chunk) {
      const int pbase = chunk * 32;
      const int seg0 = (pbase < 256) ? 0 : 256;
#pragma unroll
      for (int i = 0; i < 2; ++i) {
        int q = tid + 256 * i; int pos = q >> 4, seg = q & 15;
        int pp = pbase + pos;
        int chB = 512 + g * 128 + seg * 8, chC = 768 + g * 128 + seg * 8;
        float aB[8], aC[8];
#pragma unroll
        for (int j = 0; j < 8; ++j) { aB[j] = cb[chB + j]; aC[j] = cb[chC + j]; }
#pragma unroll
        for (int tap = 0; tap < 4; ++tap) {
          int pt = pp - 3 + tap;
          if (pt >= seg0) {
            int R = pos2row_m2(b, pt, dir);
            const u16* up = p.U + (size_t)R * UW + 2048;
            uint4 bv = *(const uint4*)(up + chB);
            uint4 cv = *(const uint4*)(up + chC);
            float f[8];
            unpack8(bv, f);
#pragma unroll
            for (int j = 0; j < 8; ++j) aB[j] += cw[tap * 1024 + chB + j] * f[j];
            unpack8(cv, f);
#pragma unroll
            for (int j = 0; j < 8; ++j) aC[j] += cw[tap * 1024 + chC + j] * f[j];
          }
        }
#pragma unroll
        for (int j = 0; j < 8; ++j) { aB[j] = siluf(aB[j]); aC[j] = siluf(aC[j]); }
        *(float4*)(Bs + pos * 128 + seg * 8) = make_float4(aB[0], aB[1], aB[2], aB[3]);
        *(float4*)(Bs + pos * 128 + seg * 8 + 4) = make_float4(aB[4], aB[5], aB[6], aB[7]);
        *(float4*)(Cs + pos * 128 + seg * 8) = make_float4(aC[0], aC[1], aC[2], aC[3]);
        *(float4*)(Cs + pos * 128 + seg * 8 + 4) = make_float4(aC[4], aC[5], aC[6], aC[7]);
      }
      {
        int pos = tid >> 3, e2 = (tid & 7) * 2;
        int pp = pbase + pos;
        int ch = head * 64 + ps * 16 + e2;
        float a0 = cb[ch], a1 = cb[ch + 1];
#pragma unroll
        for (int tap = 0; tap < 4; ++tap) {
          int pt = pp - 3 + tap;
          if (pt >= seg0) {
            int R = pos2row_m2(b, pt, dir);
            uint32_t w = *(const uint32_t*)(p.U + (size_t)R * UW + 2048 + ch);
            a0 += cw[tap * 1024 + ch] * bflo(w); a1 += cw[tap * 1024 + ch + 1] * bfhi(w);
          }
        }
        xs[pos * 16 + e2] = siluf(a0); xs[pos * 16 + e2 + 1] = siluf(a1);
      }
      if (tid < 32) {
        int R = pos2row_m2(b, pbase + tid, dir);
        float dtv = softplusf(p.DT[(size_t)R * 8 + head] + dtb);
        dts[tid] = dtv; decs[tid] = __expf(dtv * Aneg);
      }
      __syncthreads();
#pragma unroll 4
      for (int i = 0; i < 32; ++i) {
        float4 q0 = *(const float4*)(Cs + i * 128 + dg * 8), q1 = *(const float4*)(Cs + i * 128 + dg * 8 + 4);
        float4 k0 = *(const float4*)(Bs + i * 128 + dg * 8), k1 = *(const float4*)(Bs + i * 128 + dg * 8 + 4);
        float xv = xs[i * 16 + wave * 4 + el];
        float a = decs[i]; float v = xv * dts[i];
        S[0] = a * S[0] + k0.x * v; S[1] = a * S[1] + k0.y * v; S[2] = a * S[2] + k0.z * v; S[3] = a * S[3] + k0.w * v;
        S[4] = a * S[4] + k1.x * v; S[5] = a * S[5] + k1.y * v; S[6] = a * S[6] + k1.z * v; S[7] = a * S[7] + k1.w * v;
        float o = q0.x * S[0] + q0.y * S[1] + q0.z * S[2] + q0.w * S[3] + q1.x * S[4] + q1.y * S[5] + q1.z * S[6] + q1.w * S[7];
        o += __shfl_xor(o, 1); o += __shfl_xor(o, 2); o += __shfl_xor(o, 4); o += __shfl_xor(o, 8);
        if (dg == 0) os[i * 16 + wave * 4 + el] = o + Dsk * xv;
      }
      __syncthreads();
      {
        int pos = tid >> 3, e2 = (tid & 7) * 2;
        int R = pos2row_m2(b, pbase + pos, dir);
        uint32_t* yp = (uint32_t*)(p.Y2 + (size_t)R * 1024 + 512 + head * 64 + ps * 16 + e2);
        float o0 = os[pos * 16 + e2], o1 = os[pos * 16 + e2 + 1];
        if (dir == 1) { uint32_t w = *yp; o0 += bflo(w); o1 += bfhi(w); }
        *yp = pack2(o0, o1);
      }
    }
    __syncthreads();
  }
}

#ifndef M2_MFMA
#define M2_MFMA 1
#endif
#define QS 136
#define TS 40
union FragU { bf16x8 v; uint32_t u[4]; uint2 d[2]; uint4 q; };
__device__ __forceinline__ bf16x8 cvt_frag(const f32x16& x, int s2) {
  FragU f;
  f.u[0] = pack2(x[8 * s2 + 0], x[8 * s2 + 1]); f.u[1] = pack2(x[8 * s2 + 2], x[8 * s2 + 3]);
  f.u[2] = pack2(x[8 * s2 + 4], x[8 * s2 + 5]); f.u[3] = pack2(x[8 * s2 + 6], x[8 * s2 + 7]);
  return f.v;
}
__device__ __forceinline__ bf16x8 ld_frag_perm(const u16* base) {
  FragU f; f.d[0] = *(const uint2*)base; f.d[1] = *(const uint2*)(base + 8); return f.v;
}

template <int PASS>
__device__ __forceinline__ void hg_mfma(const P& p, int l, int task, int blk, int dir0, unsigned char* smem) {
  int tid = threadIdx.x; asm volatile("" : "+v"(tid)); const int wave = tid >> 6, lane = tid & 63;
  const int r = lane & 31, hh = lane >> 5;
  const int b = task >> 2, h = task & 3;
  u16* ks = (u16*)smem;
  u16* qs = ks + 32 * QS;
  u16* kT = qs + 32 * QS;
  u16* vT = kT + 128 * TS;
  float* tot = (float*)(vT + 128 * TS);
  float* eg = tot + 256;
  const int dd = tid & 127, half = tid >> 7;
  for (int dir = (PASS == 0 ? dir0 : 0); dir < (PASS == 0 ? dir0 + 1 : 2); ++dir) {
    const int sbd = (PASS == 0) ? blk : ((blk == 0) ? 0 : (dir ? 9 - blk : blk));
    const int c0 = (sbd == 0) ? 0 : 8 + 16 * (sbd - 1);
    const int c1 = (sbd == 0) ? 8 : 8 + 16 * sbd;
    float gsum = 0.f;
    f32x16 S[4];
#pragma unroll
    for (int i = 0; i < 4; ++i)
#pragma unroll
      for (int q = 0; q < 16; ++q) S[i][q] = 0.f;
    if (PASS == 1) {
      for (int qb = 0; qb < sbd; ++qb) {
        const size_t sidx = (size_t)((task * 2 + dir) * 8 + qb);
        if (half == 0) eg[dd] = __expf(p.PS[sidx * 128 + dd]);
        __syncthreads();
        const float* sp = p.SSH + sidx * 16384 + (size_t)wave * 4096 + lane;
#pragma unroll
        for (int dt = 0; dt < 4; ++dt)
#pragma unroll
          for (int q4 = 0; q4 < 4; ++q4) {
            float4 e4 = *(const float4*)(eg + 32 * dt + 8 * q4 + 4 * hh);
            S[dt][4 * q4 + 0] = S[dt][4 * q4 + 0] * e4.x + sp[(dt * 16 + 4 * q4 + 0) * 64];
            S[dt][4 * q4 + 1] = S[dt][4 * q4 + 1] * e4.y + sp[(dt * 16 + 4 * q4 + 1) * 64];
            S[dt][4 * q4 + 2] = S[dt][4 * q4 + 2] * e4.z + sp[(dt * 16 + 4 * q4 + 2) * 64];
            S[dt][4 * q4 + 3] = S[dt][4 * q4 + 3] * e4.w + sp[(dt * 16 + 4 * q4 + 3) * 64];
          }
        __syncthreads();
      }
    }
    uint4 pq0, pq1, pk0, pk1, pv0, pv1;
#define HG_PREFETCH(CH)                                                                     \
    {                                                                                       \
      int pos0 = tid >> 4, seg = tid & 15;                                                  \
      int R0 = pos2row_seq(b, (CH) * 32 + pos0, dir), R1 = pos2row_seq(b, (CH) * 32 + pos0 + 16, dir); \
      const u16* u0 = p.U + (size_t)R0 * UW + h * 128 + seg * 8;                            \
      const u16* u1 = p.U + (size_t)R1 * UW + h * 128 + seg * 8;                            \
      pq0 = *(const uint4*)u0; pq1 = *(const uint4*)u1;                                     \
      pk0 = *(const uint4*)(u0 + 512 + dir * 512); pk1 = *(const uint4*)(u1 + 512 + dir * 512); \
      pv0 = *(const uint4*)(u0 + 1536); pv1 = *(const uint4*)(u1 + 1536);                   \
    }
    HG_PREFETCH(c0)
#pragma unroll 1
    for (int chunk = c0; chunk < c1; ++chunk) {
      {
        int pos0 = tid >> 4, seg = tid & 15;
        *(uint4*)(qs + pos0 * QS + seg * 8) = pq0; *(uint4*)(qs + (pos0 + 16) * QS + seg * 8) = pq1;
        *(uint4*)(ks + pos0 * QS + seg * 8) = pk0; *(uint4*)(ks + (pos0 + 16) * QS + seg * 8) = pk1;
        FragU f0, f1; f0.q = pv0; f1.q = pv1;
#pragma unroll
        for (int j = 0; j < 4; ++j) {
          vT[(seg * 8 + 2 * j) * TS + pos0] = (u16)(f0.u[j] & 0xffffu); vT[(seg * 8 + 2 * j + 1) * TS + pos0] = (u16)(f0.u[j] >> 16);
          vT[(seg * 8 + 2 * j) * TS + pos0 + 16] = (u16)(f1.u[j] & 0xffffu); vT[(seg * 8 + 2 * j + 1) * TS + pos0 + 16] = (u16)(f1.u[j] >> 16);
        }
      }
      __syncthreads();
      if (chunk + 1 < c1) HG_PREFETCH(chunk + 1)
      const int Rout = pos2row_seq(b, chunk * 32 + r, dir);
      u16* yrow = p.Y2 + (size_t)Rout * 1024 + h * 128 + wave * 32 + 4 * hh;
      uint2 yold[4];
      if (PASS == 1 && dir == 1) {
#pragma unroll
        for (int q4 = 0; q4 < 4; ++q4) yold[q4] = *(const uint2*)(yrow + 8 * q4);
      }
      float gl[16];
      {
        float run = 0.f;
#pragma unroll
        for (int i = 0; i < 16; ++i) {
          float kkv = bf2f(ks[(half * 16 + i) * QS + dd]);
          run += __logf(fmaxf(1.f - kkv, 1e-6f));
          gl[i] = run;
        }
        tot[half * 128 + dd] = run;
      }
      __syncthreads();
      {
        const float t0 = tot[dd], t1 = tot[128 + dd];
        const float off = half ? t0 : 0.f;
        const float g31 = t0 + t1;
        float k2[16];
#pragma unroll
        for (int i = 0; i < 16; ++i) {
          const int pos = half * 16 + i;
          const float g = gl[i] + off;
          const float kkv = bf2f(ks[pos * QS + dd]);
          const float qv = bf2f(qs[pos * QS + dd]);
          qs[pos * QS + dd] = f2bf(qv * __expf(g));
          ks[pos * QS + dd] = f2bf(kkv * __expf(fminf(-g, 60.f)));
          k2[i] = kkv * __expf(g31 - g);
        }
        *(uint4*)(kT + dd * TS + half * 16) = pack8(k2);
        *(uint4*)(kT + dd * TS + half * 16 + 8) = pack8(k2 + 8);
        if (half == 0) eg[dd] = __expf(g31);
        gsum += g31;
      }
      __syncthreads();
      f32x16 O;
      if (PASS == 1) {
      f32x16 att;
#pragma unroll
      for (int q = 0; q < 16; ++q) att[q] = 0.f;
#pragma unroll
      for (int k8 = 0; k8 < 8; ++k8) {
        bf16x8 A = *(const bf16x8*)(ks + r * QS + 16 * k8 + 8 * hh);
        bf16x8 B = *(const bf16x8*)(qs + r * QS + 16 * k8 + 8 * hh);
        att = __builtin_amdgcn_mfma_f32_32x32x16_bf16(A, B, att, 0, 0, 0);
      }
#pragma unroll
      for (int q = 0; q < 16; ++q) {
        int sidx = (q & 3) + 8 * (q >> 2) + 4 * hh;
        if (sidx > r) att[q] = 0.f;
      }
#pragma unroll
      for (int q = 0; q < 16; ++q) O[q] = 0.f;
#pragma unroll
      for (int dt = 0; dt < 4; ++dt)
#pragma unroll
        for (int s2 = 0; s2 < 2; ++s2) {
          bf16x8 A = cvt_frag(S[dt], s2);
          bf16x8 B = ld_frag_perm(qs + r * QS + 32 * dt + 16 * s2 + 4 * hh);
          O = __builtin_amdgcn_mfma_f32_32x32x16_bf16(A, B, O, 0, 0, 0);
        }
#pragma unroll
      for (int s2 = 0; s2 < 2; ++s2) {
        bf16x8 A = ld_frag_perm(vT + (32 * wave + r) * TS + 16 * s2 + 4 * hh);
        bf16x8 B = cvt_frag(att, s2);
        O = __builtin_amdgcn_mfma_f32_32x32x16_bf16(A, B, O, 0, 0, 0);
      }
      }
#pragma unroll
      for (int dt = 0; dt < 4; ++dt) {
#pragma unroll
        for (int q4 = 0; q4 < 4; ++q4) {
          float4 e4 = *(const float4*)(eg + 32 * dt + 8 * q4 + 4 * hh);
          S[dt][4 * q4 + 0] *= e4.x; S[dt][4 * q4 + 1] *= e4.y; S[dt][4 * q4 + 2] *= e4.z; S[dt][4 * q4 + 3] *= e4.w;
        }
#pragma unroll
        for (int s2 = 0; s2 < 2; ++s2) {
          bf16x8 A = *(const bf16x8*)(kT + (32 * dt + r) * TS + 16 * s2 + 8 * hh);
          bf16x8 B = *(const bf16x8*)(vT + (32 * wave + r) * TS + 16 * s2 + 8 * hh);
          S[dt] = __builtin_amdgcn_mfma_f32_32x32x16_bf16(A, B, S[dt], 0, 0, 0);
        }
      }
      if (PASS == 1) {
#pragma unroll
      for (int q4 = 0; q4 < 4; ++q4) {
        float o0 = O[4 * q4], o1 = O[4 * q4 + 1], o2 = O[4 * q4 + 2], o3 = O[4 * q4 + 3];
        if (dir == 1) { o0 += bflo(yold[q4].x); o1 += bfhi(yold[q4].x); o2 += bflo(yold[q4].y); o3 += bfhi(yold[q4].y); }
        uint2 ov; ov.x = pack2(o0, o1); ov.y = pack2(o2, o3);
        *(uint2*)(yrow + 8 * q4) = ov;
      }
      }
      __syncthreads();
    }
    if (PASS == 0) {
      const size_t sidx = (size_t)((task * 2 + dir) * 8 + sbd);
      if (half == 0) p.PS[sidx * 128 + dd] = gsum;
      float* sp = p.SSH + sidx * 16384 + (size_t)wave * 4096 + lane;
#pragma unroll
      for (int dt = 0; dt < 4; ++dt)
#pragma unroll
        for (int q = 0; q < 16; ++q) sp[(dt * 16 + q) * 64] = S[dt][q];
    }
    __syncthreads();
  }
}

#if M2_MFMA
#define M2_NTASK 16
template <int PASS>
__device__ __forceinline__ void m2_mfma(const P& p, int l, int task, int blk, int dir0, unsigned char* smem) {
  int tid = threadIdx.x; asm volatile("" : "+v"(tid)); const int wave = tid >> 6, lane = tid & 63;
  const int r = lane & 31, hh = lane >> 5;
  const int b = task >> 2, g = (task >> 1) & 1, hp = task & 1;
  const int hq = wave >> 1, ph = wave & 1;
  const int head = 4 * g + 2 * hp + hq;
  u16* Bm = (u16*)smem;
  u16* Cm = Bm + 32 * QS;
  u16* BmT = Cm + 32 * QS;
  u16* xsT = BmT + 128 * TS;
  float* Gs = (float*)(xsT + 128 * TS);
  float* dts = Gs + 64;
  float* wl = dts + 64;
  const int cp = (lane < 48) ? lane : 47;
  const bool act = lane < 48;
  const int chW = (cp < 16) ? ((4 * g + 2 * hp) * 64 + cp * 8) : (cp < 32) ? (512 + g * 128 + (cp - 16) * 8) : (768 + g * 128 + (cp - 32) * 8);
  const int chU = 2048 + chW;
  float* SSM = (float*)p.KF;
  for (int dir = (PASS == 0 ? dir0 : 0); dir < (PASS == 0 ? dir0 + 1 : 2); ++dir) {
    const int sbd = (PASS == 0) ? blk : ((blk == 0) ? 0 : (dir ? 9 - blk : blk));
    const int c0 = (sbd == 0) ? 0 : 8 + 16 * (sbd - 1);
    const int c1 = (sbd == 0) ? 8 : 8 + 16 * sbd;
    float lsum = 0.f;
    const float* cw = p.m2_conv_w + (size_t)(l * 2 + dir) * 4 * 1024;
    const float* cb = p.m2_conv_b + (size_t)(l * 2 + dir) * 1024;
    if (wave == 0) {
#pragma unroll
      for (int j = 0; j < 8; ++j) {
        wl[(4 * 8 + j) * 64 + lane] = cb[chW + j];
#pragma unroll
        for (int tap = 0; tap < 4; ++tap) wl[(tap * 8 + j) * 64 + lane] = cw[tap * 1024 + chW + j];
      }
    }
    __syncthreads();
    const int hd_t = 4 * g + 2 * hp + ((tid >> 5) & 1);
    const float dtb = p.m2_dt_bias[(l * 2 + dir) * 8 + hd_t];
    const float Aneg_t = -__expf(p.m2_a_log[(l * 2 + dir) * 8 + hd_t]);
    const float Dsk = p.m2_d[(l * 2 + dir) * 8 + head];
    f32x16 S[4];
#pragma unroll
    for (int i = 0; i < 4; ++i)
#pragma unroll
      for (int q = 0; q < 16; ++q) S[i][q] = 0.f;
    if (PASS == 1) {
      for (int qb = 0; qb < sbd; ++qb) {
        const size_t sidx = (size_t)((task * 2 + dir) * 8 + qb);
        const float a = __expf(p.PA[sidx * 4 + wave]);
        const float* sp = SSM + sidx * 16384 + (size_t)wave * 4096 + lane;
#pragma unroll
        for (int nt = 0; nt < 4; ++nt)
#pragma unroll
          for (int q = 0; q < 16; ++q) S[nt][q] = S[nt][q] * a + sp[(nt * 16 + q) * 64];
      }
    }
    uint4 raw0, raw1, raw2, raw3, raw4, raw5, raw6, raw7, raw8, raw9, raw10;
    float dtraw = 0.f;
#define M2_LD1(RW, I, CH)                                                                  \
    {                                                                                      \
      int pt = (CH) * 32 + wave * 8 + (I) - 3;                                             \
      int sg0 = ((CH) * 32 < 256) ? 0 : 256;                                               \
      if (pt >= sg0) { int Rr = pos2row_m2(b, pt, dir); RW = *(const uint4*)(p.U + (size_t)Rr * UW + chU); } \
      else RW = make_uint4(0u, 0u, 0u, 0u);                                                \
    }
#define M2_PREFETCH(CH)                                                                    \
    M2_LD1(raw0, 0, CH) M2_LD1(raw1, 1, CH) M2_LD1(raw2, 2, CH) M2_LD1(raw3, 3, CH) M2_LD1(raw4, 4, CH) M2_LD1(raw5, 5, CH) \
    M2_LD1(raw6, 6, CH) M2_LD1(raw7, 7, CH) M2_LD1(raw8, 8, CH) M2_LD1(raw9, 9, CH) M2_LD1(raw10, 10, CH)            \
    if (tid < 64) { int Rr = pos2row_m2(b, (CH) * 32 + (tid & 31), dir); dtraw = p.DT[(size_t)Rr * 8 + hd_t]; }
    M2_PREFETCH(c0)
#pragma unroll 1
    for (int chunk = c0; chunk < c1; ++chunk) {
      {
#define M2_RAWF(RW, J) (((J) & 1) ? bfhi((RW)) : bflo((RW)))
#define M2_CH(J, C0, C1, C2, C3, C4, C5, C6, C7, C8, C9, C10)                               \
        {                                                                                  \
          const float q0 = wl[(0 * 8 + (J)) * 64 + lane], q1 = wl[(1 * 8 + (J)) * 64 + lane]; \
          const float q2 = wl[(2 * 8 + (J)) * 64 + lane], q3 = wl[(3 * 8 + (J)) * 64 + lane]; \
          const float qb = wl[(4 * 8 + (J)) * 64 + lane];                                  \
          const float v0 = M2_RAWF(C0, J), v1 = M2_RAWF(C1, J), v2 = M2_RAWF(C2, J), v3 = M2_RAWF(C3, J); \
          const float v4 = M2_RAWF(C4, J), v5 = M2_RAWF(C5, J), v6 = M2_RAWF(C6, J), v7 = M2_RAWF(C7, J); \
          const float v8 = M2_RAWF(C8, J), v9 = M2_RAWF(C9, J), v10 = M2_RAWF(C10, J);      \
          float o[8];                                                                      \
          o[0] = siluf(qb + q0 * v0 + q1 * v1 + q2 * v2 + q3 * v3);                        \
          o[1] = siluf(qb + q0 * v1 + q1 * v2 + q2 * v3 + q3 * v4);                        \
          o[2] = siluf(qb + q0 * v2 + q1 * v3 + q2 * v4 + q3 * v5);                        \
          o[3] = siluf(qb + q0 * v3 + q1 * v4 + q2 * v5 + q3 * v6);                        \
          o[4] = siluf(qb + q0 * v4 + q1 * v5 + q2 * v6 + q3 * v7);                        \
          o[5] = siluf(qb + q0 * v5 + q1 * v6 + q2 * v7 + q3 * v8);                        \
          o[6] = siluf(qb + q0 * v6 + q1 * v7 + q2 * v8 + q3 * v9);                        \
          o[7] = siluf(qb + q0 * v7 + q1 * v8 + q2 * v9 + q3 * v10);                       \
          if (act) {                                                                       \
            if (cp < 16) {                                                                 \
              *(uint4*)(xsT + (cp * 8 + (J)) * TS + wave * 8) = pack8(o);                  \
            } else if (cp < 32) {                                                          \
              *(uint4*)(BmT + ((cp - 16) * 8 + (J)) * TS + wave * 8) = pack8(o);           \
              _Pragma("unroll") for (int i = 0; i < 8; ++i) Bm[(wave * 8 + i) * QS + (cp - 16) * 8 + (J)] = f2bf(o[i]); \
            } else {                                                                       \
              _Pragma("unroll") for (int i = 0; i < 8; ++i) Cm[(wave * 8 + i) * QS + (cp - 32) * 8 + (J)] = f2bf(o[i]); \
            }                                                                              \
          }                                                                                \
        }
        M2_CH(0, raw0.x, raw1.x, raw2.x, raw3.x, raw4.x, raw5.x, raw6.x, raw7.x, raw8.x, raw9.x, raw10.x)
        M2_CH(1, raw0.x, raw1.x, raw2.x, raw3.x, raw4.x, raw5.x, raw6.x, raw7.x, raw8.x, raw9.x, raw10.x)
        M2_CH(2, raw0.y, raw1.y, raw2.y, raw3.y, raw4.y, raw5.y, raw6.y, raw7.y, raw8.y, raw9.y, raw10.y)
        M2_CH(3, raw0.y, raw1.y, raw2.y, raw3.y, raw4.y, raw5.y, raw6.y, raw7.y, raw8.y, raw9.y, raw10.y)
        M2_CH(4, raw0.z, raw1.z, raw2.z, raw3.z, raw4.z, raw5.z, raw6.z, raw7.z, raw8.z, raw9.z, raw10.z)
        M2_CH(5, raw0.z, raw1.z, raw2.z, raw3.z, raw4.z, raw5.z, raw6.z, raw7.z, raw8.z, raw9.z, raw10.z)
        M2_CH(6, raw0.w, raw1.w, raw2.w, raw3.w, raw4.w, raw5.w, raw6.w, raw7.w, raw8.w, raw9.w, raw10.w)
        M2_CH(7, raw0.w, raw1.w, raw2.w, raw3.w, raw4.w, raw5.w, raw6.w, raw7.w, raw8.w, raw9.w, raw10.w)
      }
      if (tid < 64) {
        float dtv = softplusf(dtraw + dtb);
        float run = dtv * Aneg_t;
#pragma unroll
        for (int o = 1; o < 32; o <<= 1) { float n = __shfl_up(run, o, 32); if ((tid & 31) >= o) run += n; }
        Gs[tid] = run; dts[tid] = dtv;
      }
      __syncthreads();
      if (chunk + 1 < c1) { M2_PREFETCH(chunk + 1) }
      const int Rout = pos2row_m2(b, chunk * 32 + r, dir);
      u16* yrow = p.Y2 + (size_t)Rout * 1024 + 512 + head * 64 + 32 * ph + 4 * hh;
      uint2 yold[4];
      if (PASS == 1 && dir == 1) {
#pragma unroll
        for (int i = 0; i < 4; ++i) yold[i] = *(const uint2*)(yrow + 8 * i);
      }
      const float* Gw = Gs + hq * 32; const float* dw = dts + hq * 32;
      const float Gt = Gw[r], G31 = Gw[31];
      lsum += G31;
      const u16* xw = xsT + (hq * 64 + ph * 32) * TS;
      f32x16 O0;
      if (PASS == 1) {
      f32x16 att;
#pragma unroll
      for (int q = 0; q < 16; ++q) att[q] = 0.f;
#pragma unroll
      for (int k8 = 0; k8 < 8; ++k8) {
        bf16x8 A = *(const bf16x8*)(Bm + r * QS + 16 * k8 + 8 * hh);
        bf16x8 B = *(const bf16x8*)(Cm + r * QS + 16 * k8 + 8 * hh);
        att = __builtin_amdgcn_mfma_f32_32x32x16_bf16(A, B, att, 0, 0, 0);
      }
#pragma unroll
      for (int q4 = 0; q4 < 4; ++q4) {
        float4 gs4 = *(const float4*)(Gw + 8 * q4 + 4 * hh);
        float4 dt4 = *(const float4*)(dw + 8 * q4 + 4 * hh);
        int s0 = 8 * q4 + 4 * hh;
        att[4 * q4 + 0] = (s0 + 0 <= r) ? att[4 * q4 + 0] * __expf(Gt - gs4.x) * dt4.x : 0.f;
        att[4 * q4 + 1] = (s0 + 1 <= r) ? att[4 * q4 + 1] * __expf(Gt - gs4.y) * dt4.y : 0.f;
        att[4 * q4 + 2] = (s0 + 2 <= r) ? att[4 * q4 + 2] * __expf(Gt - gs4.z) * dt4.z : 0.f;
        att[4 * q4 + 3] = (s0 + 3 <= r) ? att[4 * q4 + 3] * __expf(Gt - gs4.w) * dt4.w : 0.f;
      }
#pragma unroll
      for (int q = 0; q < 16; ++q) O0[q] = 0.f;
#pragma unroll
      for (int nt = 0; nt < 4; ++nt)
#pragma unroll
        for (int s2 = 0; s2 < 2; ++s2) {
          bf16x8 B = ld_frag_perm(Cm + r * QS + 32 * nt + 16 * s2 + 4 * hh);
          O0 = __builtin_amdgcn_mfma_f32_32x32x16_bf16(cvt_frag(S[nt], s2), B, O0, 0, 0, 0);
        }
      {
        const float eGt = __expf(Gt);
#pragma unroll
        for (int q = 0; q < 16; ++q) O0[q] *= eGt;
      }
#pragma unroll
      for (int s2 = 0; s2 < 2; ++s2) {
        bf16x8 B = cvt_frag(att, s2);
        O0 = __builtin_amdgcn_mfma_f32_32x32x16_bf16(ld_frag_perm(xw + r * TS + 16 * s2 + 4 * hh), B, O0, 0, 0, 0);
      }
#pragma unroll
      for (int q = 0; q < 16; ++q) {
        int pp = (q & 3) + 8 * (q >> 2) + 4 * hh;
        O0[q] += Dsk * bf2f(xw[pp * TS + r]);
      }
      }
      {
        const float eG31 = __expf(G31);
#pragma unroll
        for (int nt = 0; nt < 4; ++nt)
#pragma unroll
          for (int q = 0; q < 16; ++q) S[nt][q] *= eG31;
#pragma unroll
        for (int s2 = 0; s2 < 2; ++s2) {
          float ws[8];
          {
            float4 ga = *(const float4*)(Gw + 16 * s2 + 8 * hh), gb = *(const float4*)(Gw + 16 * s2 + 8 * hh + 4);
            float4 da = *(const float4*)(dw + 16 * s2 + 8 * hh), db = *(const float4*)(dw + 16 * s2 + 8 * hh + 4);
            ws[0] = da.x * __expf(G31 - ga.x); ws[1] = da.y * __expf(G31 - ga.y); ws[2] = da.z * __expf(G31 - ga.z); ws[3] = da.w * __expf(G31 - ga.w);
            ws[4] = db.x * __expf(G31 - gb.x); ws[5] = db.y * __expf(G31 - gb.y); ws[6] = db.z * __expf(G31 - gb.z); ws[7] = db.w * __expf(G31 - gb.w);
          }
          bf16x8 Bf0;
          {
            float f[8]; unpack8(*(const uint4*)(xw + r * TS + 16 * s2 + 8 * hh), f);
#pragma unroll
            for (int j = 0; j < 8; ++j) f[j] *= ws[j];
            FragU u; u.q = pack8(f); Bf0 = u.v;
          }
#pragma unroll
          for (int nt = 0; nt < 4; ++nt) {
            bf16x8 A = *(const bf16x8*)(BmT + (32 * nt + r) * TS + 16 * s2 + 8 * hh);
            S[nt] = __builtin_amdgcn_mfma_f32_32x32x16_bf16(A, Bf0, S[nt], 0, 0, 0);
          }
        }
      }
      if (PASS == 1) {
#pragma unroll
      for (int q4 = 0; q4 < 4; ++q4) {
        float o0 = O0[4 * q4], o1 = O0[4 * q4 + 1], o2 = O0[4 * q4 + 2], o3 = O0[4 * q4 + 3];
        if (dir == 1) { o0 += bflo(yold[q4].x); o1 += bfhi(yold[q4].x); o2 += bflo(yold[q4].y); o3 += bfhi(yold[q4].y); }
        uint2 ov; ov.x = pack2(o0, o1); ov.y = pack2(o2, o3);
        *(uint2*)(yrow + 8 * q4) = ov;
      }
      }
      __syncthreads();
    }
    if (PASS == 0) {
      const size_t sidx = (size_t)((task * 2 + dir) * 8 + sbd);
      if (lane == 0) p.PA[sidx * 4 + wave] = lsum;
      float* sp = SSM + sidx * 16384 + (size_t)wave * 4096 + lane;
#pragma unroll
      for (int nt = 0; nt < 4; ++nt)
#pragma unroll
        for (int q = 0; q < 16; ++q) sp[(nt * 16 + q) * 64] = S[nt][q];
    }
    __syncthreads();
  }
}
#endif
__device__ __forceinline__ void ph_mixA0(const P& p, int l, int bid, int nb, unsigned char* sm) {
  for (int t = bid; t < 512; t += nb) {
    if (t < 256) hg_mfma<0>(p, l, t >> 4, (t >> 1) & 7, t & 1, sm);
    else { int u = t - 256; m2_mfma<0>(p, l, u >> 4, (u >> 1) & 7, u & 1, sm); }
    __syncthreads();
  }
}
__device__ __forceinline__ void ph_mixA1(const P& p, int l, int bid, int nb, unsigned char* sm) {
  for (int t = bid; t < 288; t += nb) {
    if (t < 128) hg_mfma<1>(p, l, t >> 3, 1 + (t & 7), 0, sm);
    else if (t < 256) { int u = t - 128; m2_mfma<1>(p, l, u >> 3, 1 + (u & 7), 0, sm); }
    else if (t < 272) hg_mfma<1>(p, l, t - 256, 0, 0, sm);
    else m2_mfma<1>(p, l, t - 272, 0, 0, sm);
    __syncthreads();
  }
}

template <int PASS>
__device__ __forceinline__ void rg_task(const P& p, int l, int task, float* sm) {
  int tid = threadIdx.x; asm volatile("" : "+v"(tid));
  const int wave = tid >> 6, lane = tid & 63;
  const int b = task / 136, rem = task % 136, head = rem / 17, sb = rem % 17;
  float* xc = sm;
  float* pa = sm + 2048;
  float* pb = sm + 4096;
  u16* xcb = (u16*)(sm + 6144);
  u16* WTl = xcb + 32 * 72;
  const int j = tid & 63;
  const int spos = tid >> 3, sseg = tid & 7;
  const int sch = head * 64 + sseg * 8;
  const u16* UB2 = p.U + (size_t)NTOK * 2048;
  for (int dir = 0; dir < 2; ++dir) {
    const int ld = l * 2 + dir;
    {
      const float* wa = p.rg_wa + (size_t)(ld * 8 + head) * 4096;
      const float* wx = p.rg_wx + (size_t)(ld * 8 + head) * 4096;
#pragma unroll
      for (int it = 0; it < 4; ++it) {
        int i = (tid >> 4) + 16 * it, j4 = (tid & 15) * 4;
        float4 va = *(const float4*)(wa + i * 64 + j4);
        float4 vx = *(const float4*)(wx + i * 64 + j4);
        WTl[(j4 + 0) * 72 + i] = f2bf(va.x); WTl[(j4 + 1) * 72 + i] = f2bf(va.y);
        WTl[(j4 + 2) * 72 + i] = f2bf(va.z); WTl[(j4 + 3) * 72 + i] = f2bf(va.w);
        WTl[(64 + j4 + 0) * 72 + i] = f2bf(vx.x); WTl[(64 + j4 + 1) * 72 + i] = f2bf(vx.y);
        WTl[(64 + j4 + 2) * 72 + i] = f2bf(vx.z); WTl[(64 + j4 + 3) * 72 + i] = f2bf(vx.w);
      }
    }
    float wcv[4][8], bcv[8];
#pragma unroll
    for (int jj = 0; jj < 8; ++jj) {
      bcv[jj] = p.rg_conv_b[(size_t)ld * 512 + sch + jj];
#pragma unroll
      for (int tap = 0; tap < 4; ++tap) wcv[tap][jj] = p.rg_conv_w[((size_t)ld * 4 + tap) * 512 + sch + jj];
    }
    const int chg = head * 64 + j;
    const float g_ba = p.rg_ba[ld * 512 + chg], g_bx = p.rg_bx[ld * 512 + chg];
    const float g_sp = -8.0f * softplusf(-p.rg_lam[ld * 512 + chg]);
    const int sbd = (PASS == 0) ? sb : (dir ? (sb == 0 ? 0 : 17 - sb) : sb);
    float hcarry = 0.f, aprod = 1.f;
    if (PASS == 1 && tid < 64) {
      float2 sv[16];
#pragma unroll
      for (int q = 0; q < 16; ++q) {
        const float2* sp = (const float2*)(p.SUM + ((((size_t)b * 2 + dir) * 17 + q) * 512 + head * 64 + tid) * 2);
        sv[q] = (q < sbd) ? *sp : make_float2(1.f, 0.f);
      }
#pragma unroll
      for (int q = 0; q < 16; ++q) hcarry = sv[q].x * hcarry + sv[q].y;
    }
    uint4 xr0, xr1, xr2, xr3;
#define RG_LD1(XR, TAP, CH)                                                               \
    {                                                                                     \
      int pt = (CH) * 32 + spos - 3 + (TAP);                                              \
      int sg0 = ((CH) * 32 < 256) ? 0 : 256;                                              \
      if (pt >= sg0) { int Rr = pos2row_seq(b, pt, dir); XR = *(const uint4*)(UB2 + (size_t)Rr * 2048 + sch); } \
      else XR = make_uint4(0u, 0u, 0u, 0u);                                               \
    }
#define RG_PREFETCH(CH) RG_LD1(xr0, 0, CH) RG_LD1(xr1, 1, CH) RG_LD1(xr2, 2, CH) RG_LD1(xr3, 3, CH)
    RG_PREFETCH(sbd * 8)
#pragma unroll 1
    for (int chunk = sbd * 8; chunk < sbd * 8 + 8; ++chunk) {
      const int pbase = chunk * 32;
      {
        float a[8], f[8];
#pragma unroll
        for (int jj = 0; jj < 8; ++jj) a[jj] = bcv[jj];
        unpack8(xr0, f);
#pragma unroll
        for (int jj = 0; jj < 8; ++jj) a[jj] += wcv[0][jj] * f[jj];
        unpack8(xr1, f);
#pragma unroll
        for (int jj = 0; jj < 8; ++jj) a[jj] += wcv[1][jj] * f[jj];
        unpack8(xr2, f);
#pragma unroll
        for (int jj = 0; jj < 8; ++jj) a[jj] += wcv[2][jj] * f[jj];
        unpack8(xr3, f);
#pragma unroll
        for (int jj = 0; jj < 8; ++jj) a[jj] += wcv[3][jj] * f[jj];
        *(float4*)(xc + spos * 64 + sseg * 8) = make_float4(a[0], a[1], a[2], a[3]);
        *(float4*)(xc + spos * 64 + sseg * 8 + 4) = make_float4(a[4], a[5], a[6], a[7]);
        *(uint4*)(xcb + spos * 72 + sseg * 8) = pack8(a);
      }
      __syncthreads();
      if (chunk + 1 < sbd * 8 + 8) { RG_PREFETCH(chunk + 1) }
      const int Rout = pos2row_seq(b, pbase + spos, dir);
      uint4* yp = (uint4*)(p.HL + (size_t)Rout * 1024 + 512 + sch);
      uint4 prev, gv;
      if (PASS == 1 && dir == 1) { prev = *yp; gv = *(const uint4*)(UB2 + (size_t)Rout * 2048 + 512 + sch); }
      {
        const int r = lane & 31, hh = lane >> 5;
        f32x16 acc;
#pragma unroll
        for (int q = 0; q < 16; ++q) acc[q] = 0.f;
#pragma unroll
        for (int ks = 0; ks < 4; ++ks) {
          bf16x8 A = *(const bf16x8*)(xcb + r * 72 + 16 * ks + 8 * hh);
          bf16x8 B = *(const bf16x8*)(WTl + (32 * wave + r) * 72 + 16 * ks + 8 * hh);
          acc = __builtin_amdgcn_mfma_f32_32x32x16_bf16(A, B, acc, 0, 0, 0);
        }
        float* dstp = (wave < 2) ? pa : pb;
        const int jc = (wave & 1) * 32 + r;
#pragma unroll
        for (int q = 0; q < 16; ++q) dstp[((q & 3) + 8 * (q >> 2) + 4 * hh) * 64 + jc] = acc[q];
      }
      __syncthreads();
#pragma unroll
      for (int i = 0; i < 8; ++i) {
        int e = tid + 256 * i;
        float r = sigmf(pa[e] + g_ba);
        float gi = sigmf(pb[e] + g_bx);
        float la = g_sp * r;
        float a = __expf(la);
        float bt = sqrtf(fmaxf(1.f - a * a, 0.f)) * gi * xc[e];
        pa[e] = a; pb[e] = bt;
      }
      __syncthreads();
      if (tid < 64) {
        float hh = hcarry;
#pragma unroll 8
        for (int pos = 0; pos < 32; ++pos) { float av = pa[pos * 64 + tid]; hh = av * hh + pb[pos * 64 + tid]; pb[pos * 64 + tid] = hh; aprod *= av; }
        hcarry = hh;
      }
      __syncthreads();
      if (PASS == 1) {
        float hv[8];
#pragma unroll
        for (int jj = 0; jj < 8; ++jj) hv[jj] = pb[spos * 64 + sseg * 8 + jj];
        if (dir == 1) {
          float f[8]; unpack8(prev, f);
          float gf[8]; unpack8(gv, gf);
#pragma unroll
          for (int jj = 0; jj < 8; ++jj) hv[jj] = (hv[jj] + f[jj]) * gf[jj];
        }
        *yp = pack8(hv);
      }
    }
    if (PASS == 0 && tid < 64) {
      float* sp = p.SUM + ((((size_t)b * 2 + dir) * 17 + sbd) * 512 + head * 64 + tid) * 2;
      sp[0] = aprod; sp[1] = hcarry;
    }
    __syncthreads();
  }
}

typedef bf16x8 __attribute__((aligned(2))) bf16x8_u;
typedef uint4 __attribute__((aligned(4))) uint4_a4;
__device__ __forceinline__ bf16x8 ld_win8(const u16* base, int y, uint32_t sh) {
  const uint32_t* wp = (const uint32_t*)base + (y >> 1);
  uint4 w = *(const uint4_a4*)wp;
  uint32_t w4 = wp[4];
  FragU f;
  f.u[0] = __builtin_amdgcn_alignbit(w.y, w.x, sh);
  f.u[1] = __builtin_amdgcn_alignbit(w.z, w.y, sh);
  f.u[2] = __builtin_amdgcn_alignbit(w.w, w.z, sh);
  f.u[3] = __builtin_amdgcn_alignbit(w4, w.w, sh);
  return f.v;
}

__device__ __forceinline__ void hy_conv3x8(const u16* col, int t8, int n, float w0, float w1, float w2, float bias, float* out) {
  float f[8]; unpack8(*(const uint4*)(col + t8), f);
  float prev = (t8 > 0) ? bf2f(col[t8 - 1]) : 0.f;
  float next = (t8 + 8 < n) ? bf2f(col[t8 + 8]) : 0.f;
#pragma unroll
  for (int j = 0; j < 8; ++j) {
    float a = (j == 0) ? prev : f[j - 1];
    float cnx = (j == 7) ? next : f[j + 1];
    out[j] = bias + w0 * a + w1 * f[j] + w2 * cnx;
  }
}

__device__ __forceinline__ void hy_task(const P& p, int l, int c, float* sm) {
  int tid = threadIdx.x; asm volatile("" : "+v"(tid)); const int wave = tid >> 6, lane = tid & 63;
  const int r = lane & 31, h = lane >> 5;
  u16* krr = (u16*)sm;
  u16* zs = krr + 8192 + 64;
  float* red = (float*)(zs + 16384);
  const u16* UT = p.U;
  const float* cwp = p.hy_conv_w + (size_t)l * 3 * 1536;
  const float* cbp = p.hy_conv_b + (size_t)l * 1536;
  for (int o = 0; o < 2; ++o) {
    const u16* K = p.KF + (size_t)(o * 512 + c) * 8192;
    float asum = 0.f;
#pragma unroll
    for (int i = 0; i < 4; ++i) {
      int idx = (tid + 256 * i) * 8;
      uint4 v = *(const uint4*)(K + idx);
      *(uint4*)(krr + idx) = v;
      float f[8]; unpack8(v, f);
#pragma unroll
      for (int j = 0; j < 8; ++j) asum += fabsf(f[j]);
    }
    asum = wave_sum(asum);
    if (lane == 0) red[wave] = asum;
    if (o == 0) {
      const float w0 = cwp[c], w1 = cwp[1536 + c], w2 = cwp[3072 + c], bs = cbp[c];
#pragma unroll 2
      for (int e = tid; e < 2048; e += 256) {
        int b = e >> 9, t8 = (e & 511) * 8;
        float f[8];
        hy_conv3x8(UT + (size_t)c * NTOK + b * 4096, t8, 4096, w0, w1, w2, bs, f);
        *(uint4*)(zs + b * 4096 + t8) = pack8(f);
      }
    }
    __syncthreads();
    const float scale = 1.f / (red[0] + red[1] + red[2] + red[3] + 1e-6f);
    const float skip = p.hy_skip[(l * 2 + o) * 512 + c];
    f32x16 acc[2][2];
#pragma unroll
    for (int a = 0; a < 2; ++a)
#pragma unroll
      for (int b = 0; b < 2; ++b)
#pragma unroll
        for (int q = 0; q < 16; ++q) acc[a][b][q] = 0.f;
    const int I0 = wave * 16;
    const int Il0 = I0 + (r >> 2), Il1 = I0 + 8 + (r >> 2);
    const u16* zb = zs + (r & 3) * 4096 + 8 * h;
    const int ybase = 4096 - r + 8 * h + 48;
    bf16x8 F0, F1, F2, F3, F4, F5;
    const uint32_t ysh = (uint32_t)((ybase & 1) * 16);
    {
      const int y0 = ybase - 64 * (I0 - 63);
      F0 = ld_win8(krr, y0, ysh); F1 = ld_win8(krr, y0 - 16, ysh); F2 = ld_win8(krr, y0 - 32, ysh);
      F3 = ld_win8(krr, y0 - 48, ysh); F4 = ld_win8(krr, y0 - 64, ysh); F5 = ld_win8(krr, y0 - 80, ysh);
    }
#pragma unroll 1
    for (int D = I0 - 63; D <= I0 + 15; ++D) {
      bf16x8 B0[4], B1[4];
      {
        int J0 = Il0 - D, J1 = Il1 - D;
        bool ok0 = (unsigned)J0 < 64u, ok1 = (unsigned)J1 < 64u;
        const u16* zp0 = zb + 64 * J0; const u16* zp1 = zb + 64 * J1;
#pragma unroll
        for (int ks = 0; ks < 4; ++ks) {
          bf16x8 z0 = {0, 0, 0, 0, 0, 0, 0, 0}, z1 = {0, 0, 0, 0, 0, 0, 0, 0};
          if (ok0) z0 = *(const bf16x8*)(zp0 + 16 * ks);
          if (ok1) z1 = *(const bf16x8*)(zp1 + 16 * ks);
          B0[ks] = z0; B1[ks] = z1;
        }
      }
      acc[0][0] = __builtin_amdgcn_mfma_f32_32x32x16_bf16(F3, B0[0], acc[0][0], 0, 0, 0);
      acc[0][1] = __builtin_amdgcn_mfma_f32_32x32x16_bf16(F3, B1[0], acc[0][1], 0, 0, 0);
      acc[1][0] = __builtin_amdgcn_mfma_f32_32x32x16_bf16(F5, B0[0], acc[1][0], 0, 0, 0);
      acc[1][1] = __builtin_amdgcn_mfma_f32_32x32x16_bf16(F5, B1[0], acc[1][1], 0, 0, 0);
      acc[0][0] = __builtin_amdgcn_mfma_f32_32x32x16_bf16(F2, B0[1], acc[0][0], 0, 0, 0);
      acc[0][1] = __builtin_amdgcn_mfma_f32_32x32x16_bf16(F2, B1[1], acc[0][1], 0, 0, 0);
      acc[1][0] = __builtin_amdgcn_mfma_f32_32x32x16_bf16(F4, B0[1], acc[1][0], 0, 0, 0);
      acc[1][1] = __builtin_amdgcn_mfma_f32_32x32x16_bf16(F4, B1[1], acc[1][1], 0, 0, 0);
      acc[0][0] = __builtin_amdgcn_mfma_f32_32x32x16_bf16(F1, B0[2], acc[0][0], 0, 0, 0);
      acc[0][1] = __builtin_amdgcn_mfma_f32_32x32x16_bf16(F1, B1[2], acc[0][1], 0, 0, 0);
      acc[1][0] = __builtin_amdgcn_mfma_f32_32x32x16_bf16(F3, B0[2], acc[1][0], 0, 0, 0);
      acc[1][1] = __builtin_amdgcn_mfma_f32_32x32x16_bf16(F3, B1[2], acc[1][1], 0, 0, 0);
      acc[0][0] = __builtin_amdgcn_mfma_f32_32x32x16_bf16(F0, B0[3], acc[0][0], 0, 0, 0);
      acc[0][1] = __builtin_amdgcn_mfma_f32_32x32x16_bf16(F0, B1[3], acc[0][1], 0, 0, 0);
      acc[1][0] = __builtin_amdgcn_mfma_f32_32x32x16_bf16(F2, B0[3], acc[1][0], 0, 0, 0);
      acc[1][1] = __builtin_amdgcn_mfma_f32_32x32x16_bf16(F2, B1[3], acc[1][1], 0, 0, 0);
      F0 = F4; F1 = F5;
      if (D < I0 + 15) {
        const int y1 = ybase - 64 * (D + 1);
        F2 = ld_win8(krr, y1 - 32, ysh); F3 = ld_win8(krr, y1 - 48, ysh);
        F4 = ld_win8(krr, y1 - 64, ysh); F5 = ld_win8(krr, y1 - 80, ysh);
      }
    }
    __syncthreads();
#pragma unroll
    for (int ni = 0; ni < 2; ++ni) {
      u16* zc = zs + (r & 3) * 4096 + 64 * (ni ? Il1 : Il0);
#pragma unroll
      for (int mi = 0; mi < 2; ++mi)
#pragma unroll
        for (int q = 0; q < 16; ++q) {
          int i = 32 * mi + (q & 3) + 8 * (q >> 2) + 4 * h;
          float zo = bf2f(zc[i]);
          zc[i] = f2bf(scale * acc[mi][ni][q] + skip * zo);
        }
    }
    __syncthreads();
    {
      const int ch = (o + 1) * 512 + c;
      const float w0 = cwp[ch], w1 = cwp[1536 + ch], w2 = cwp[3072 + ch], bs = cbp[ch];
#pragma unroll 2
      for (int e = tid; e < 2048; e += 256) {
        int b = e >> 9, t8 = (e & 511) * 8;
        float xg[8], y[8];
        hy_conv3x8(UT + (size_t)ch * NTOK + b * 4096, t8, 4096, w0, w1, w2, bs, xg);
        unpack8(*(const uint4*)(zs + b * 4096 + t8), y);
#pragma unroll
        for (int j = 0; j < 8; ++j) y[j] *= xg[j];
        if (o == 0) *(uint4*)(zs + b * 4096 + t8) = pack8(y);
        else {
          float gf[8]; unpack8(*(const uint4*)(UT + (size_t)(1536 + c) * NTOK + b * 4096 + t8), gf);
#pragma unroll
          for (int j = 0; j < 8; ++j) y[j] *= gf[j];
          *(uint4*)(p.U + (size_t)c * NTOK + b * 4096 + t8) = pack8(y);
        }
      }
    }
    __syncthreads();
  }
  if (l == 0) {
    const int t = tid;
    for (int o = 0; o < 2; ++o) {
      const u16* K = p.KFC + (size_t)(o * 512 + c) * 512;
      float asum = 0.f;
      {
        uint32_t w2 = *(const uint32_t*)(K + tid * 2);
        *(uint32_t*)(krr + tid * 2) = w2;
        asum = fabsf(bflo(w2)) + fabsf(bfhi(w2));
      }
      asum = wave_sum(asum);
      if (lane == 0) red[wave] = asum;
      if (o == 0) {
        const float w0 = cwp[c], w1 = cwp[1536 + c], w2 = cwp[3072 + c], bs = cbp[c];
        if (tid < 128) {
          int b = tid >> 5, t8 = (tid & 31) * 8;
          float f[8];
          hy_conv3x8(UT + (size_t)c * NTOK + NLAT + b * 256, t8, 256, w0, w1, w2, bs, f);
          *(uint4*)(zs + b * 4096 + t8) = pack8(f);
        }
      }
      __syncthreads();
      const float scale = 1.f / (red[0] + red[1] + red[2] + red[3] + 1e-6f);
      float a0 = 0, a1 = 0, a2 = 0, a3 = 0;
      for (int s2 = 0; s2 < 256; ++s2) {
        float kv = bf2f(krr[256 - t + s2]);
        a0 += kv * bf2f(zs[s2]); a1 += kv * bf2f(zs[4096 + s2]); a2 += kv * bf2f(zs[8192 + s2]); a3 += kv * bf2f(zs[12288 + s2]);
      }
      const float skip = p.hy_skip[(l * 2 + o) * 512 + c];
      float y[4];
      y[0] = scale * a0 + skip * bf2f(zs[t]); y[1] = scale * a1 + skip * bf2f(zs[4096 + t]);
      y[2] = scale * a2 + skip * bf2f(zs[8192 + t]); y[3] = scale * a3 + skip * bf2f(zs[12288 + t]);
      __syncthreads();
      {
        const int ch = (o + 1) * 512 + c;
        const float w0 = cwp[ch], w1 = cwp[1536 + ch], w2 = cwp[3072 + ch], bs = cbp[ch];
#pragma unroll
        for (int b = 0; b < 4; ++b) {
          const u16* col = UT + (size_t)ch * NTOK + NLAT + b * 256;
          float xg = bs + w1 * bf2f(col[t]);
          if (t > 0) xg += w0 * bf2f(col[t - 1]);
          if (t < 255) xg += w2 * bf2f(col[t + 1]);
          float zn = xg * y[b];
          if (o == 0) zs[b * 4096 + t] = f2bf(zn);
          else {
            size_t R = (size_t)NLAT + b * 256 + t;
            float gate = bf2f(UT[(size_t)(1536 + c) * NTOK + R]);
            p.U[(size_t)c * NTOK + R] = f2bf(zn * gate);
          }
        }
      }
      __syncthreads();
    }
  }
}

__device__ __forceinline__ void fin_rows(const P& p, int l, int chunk) {
  int tid = threadIdx.x; asm volatile("" : "+v"(tid)); const int wave = tid >> 6, lane = tid & 63;
  for (int rr = 0; rr < 16; ++rr) {
    int R = chunk * 64 + wave * 16 + rr;
    {
      uint4* yp = (uint4*)(p.Y2 + (size_t)R * 1024 + lane * 8);
      float o[8]; unpack8(*yp, o);
      float ss = 0;
#pragma unroll
      for (int j = 0; j < 8; ++j) ss += o[j] * o[j];
      ss += __shfl_xor(ss, 1); ss += __shfl_xor(ss, 2); ss += __shfl_xor(ss, 4); ss += __shfl_xor(ss, 8);
      float rinv = rsqrtf(ss * (1.f / 128.f) + EPS);
      float gf[8]; unpack8(*(const uint4*)(p.U + (size_t)NTOK * 2048 + (size_t)R * 2048 + 1024 + lane * 8), gf);
#pragma unroll
      for (int j = 0; j < 8; ++j) o[j] = o[j] * rinv * p.hg_norm_w[l * 512 + lane * 8 + j] * gf[j];
      *yp = pack8(o);
    }
    {
      uint4* yp = (uint4*)(p.Y2 + (size_t)R * 1024 + 512 + lane * 8);
      float o[8]; unpack8(*yp, o);
      float gf[8]; unpack8(*(const uint4*)(p.U + (size_t)NTOK * 2048 + (size_t)R * 2048 + 1536 + lane * 8), gf);
      float ss = 0;
#pragma unroll
      for (int j = 0; j < 8; ++j) { o[j] *= gf[j]; ss += o[j] * o[j]; }
      ss += __shfl_xor(ss, 1); ss += __shfl_xor(ss, 2); ss += __shfl_xor(ss, 4); ss += __shfl_xor(ss, 8); ss += __shfl_xor(ss, 16);
      float rinv = rsqrtf(ss * (1.f / 256.f) + EPS);
#pragma unroll
      for (int j = 0; j < 8; ++j) o[j] = o[j] * rinv * p.m2_norm_w[l * 512 + lane * 8 + j];
      *yp = pack8(o);
    }
  }
}

__device__ __forceinline__ void ph_mixB(const P& p, int l, int bid, int nb, float* sm) {
  for (int t = bid; t < 544 + 512; t += nb) {
    if (t < 544) { if (EN_RG) rg_task<0>(p, l, t, sm); }
    else { if (EN_HY) hy_task(p, l, t - 544, sm); }
    __syncthreads();
  }
}
__device__ __forceinline__ void hy_transpose(const P& p, int tile, u16* sm) {
  int tid = threadIdx.x; asm volatile("" : "+v"(tid));
  const int ct = tile & 7, rt = tile >> 3;
  const int c0 = ct * 64, R0 = rt * 64;
#pragma unroll
  for (int i = 0; i < 2; ++i) {
    int q = tid + 256 * i; int cc = q >> 3, seg = q & 7;
    *(uint4*)(sm + cc * 72 + seg * 8) = *(const uint4*)(p.U + (size_t)(c0 + cc) * NTOK + R0 + seg * 8);
  }
  __syncthreads();
#pragma unroll
  for (int i = 0; i < 2; ++i) {
    int q = tid + 256 * i; int rr = q >> 3, seg = q & 7;
    FragU f;
#pragma unroll
    for (int j = 0; j < 4; ++j)
      f.u[j] = (uint32_t)sm[(seg * 8 + 2 * j) * 72 + rr] | ((uint32_t)sm[(seg * 8 + 2 * j + 1) * 72 + rr] << 16);
    *(uint4*)(p.HL + (size_t)(R0 + rr) * 1024 + c0 + seg * 8) = f.q;
  }
}
__device__ __forceinline__ void ph_mixB2(const P& p, int l, int bid, int nb, float* sm) {
  const int nfin = (l == 0 ? NTOK : NLAT) / 64;
  const int ntr = nfin * 8;
  for (int t = bid; t < 544 + nfin + ntr; t += nb) {
    if (t < 544) { if (EN_RG) rg_task<1>(p, l, t, sm); }
    else if (t < 544 + nfin) fin_rows(p, l, t - 544);
    else hy_transpose(p, t - 544 - nfin, (u16*)sm);
    __syncthreads();
  }
}
__device__ __forceinline__ void ph_final(const P& p, int bid, int nb) {
  int tid = threadIdx.x; asm volatile("" : "+v"(tid)); const int wave = tid >> 6, lane = tid & 63;
  for (int R = bid * 4 + wave; R < NLAT; R += nb * 4) {
    float4* rp = (float4*)(p.out + (size_t)R * 1024);
    float4 v[4]; float ss = 0;
#pragma unroll
    for (int i = 0; i < 4; ++i) {
      v[i] = rp[lane + i * 64];
      ss += v[i].x * v[i].x + v[i].y * v[i].y + v[i].z * v[i].z + v[i].w * v[i].w;
    }
    ss = wave_sum(ss);
    float rinv = rsqrtf(ss * (1.f / 1024.f) + EPS);
#pragma unroll
    for (int i = 0; i < 4; ++i) {
      float4 w = *(const float4*)(p.final_norm_w + (lane + i * 64) * 4);
      float4 o; o.x = v[i].x * rinv * w.x; o.y = v[i].y * rinv * w.y; o.z = v[i].z * rinv * w.z; o.w = v[i].w * rinv * w.w;
      rp[lane + i * 64] = o;
    }
  }
}

#define SMEM_BYTES 56320
__global__ void __launch_bounds__(256, 2) mega(P p) {
  __shared__ __align__(16) unsigned char smem[SMEM_BYTES];
  cg::grid_group grid = cg::this_grid();
  const int bid = blockIdx.x, nb = gridDim.x;
  float* smf = (float*)smem; u16* smh = (u16*)smem;
#ifndef PHM
#define PHM 0xffff
#endif
  if (PHM & 1) ph_mod(p, bid, nb, smf);
  grid.sync();
  for (int l = 0; l < 2; ++l) {
    if (PHM & 2) ph_norm(p, l, bid, nb);
    if (PHM & 4) ph_wconv(p, l, bid, nb, smf);
    grid.sync();
    if (PHM & 16) ph_gemm<0>(p, l, bid, nb, smh);
    grid.sync();
#if PROBE_DUP == 3
    ph_gemm<0>(p, l, bid, nb, smh);
    grid.sync();
#endif
#if PROBE_DUP == 10
    ph_norm(p, l, bid, nb);
    ph_wconv(p, l, bid, nb, smf);
    grid.sync();
#endif
    if (PHM & 32) ph_mixA0(p, l, bid, nb, smem);
    grid.sync();
    if (PHM & 32) ph_mixA1(p, l, bid, nb, smem);
    grid.sync();
#if PROBE_DUP == 8
    ph_mixA0(p, l, bid, nb, smem);
    grid.sync();
    ph_mixA1(p, l, bid, nb, smem);
    grid.sync();
#endif
    if (PHM & 64) ph_gemm<1>(p, l, bid, nb, smh);
    if (PHM & 8) ph_filt(p, l, bid, nb, smf);
    grid.sync();
#if PROBE_DUP == 2
    ph_mixB(p, l, bid, nb, smf);
    grid.sync();
#endif
#if PROBE_DUP == 4
    ph_gemm<1>(p, l, bid, nb, smh);
    grid.sync();
#endif
#if PROBE_DUP == 9
    ph_gemm<1>(p, l, bid, nb, smh, 1);
    grid.sync();
#endif
    if (PHM & 128) ph_mixB(p, l, bid, nb, smf);
    grid.sync();
    if (PHM & 128) ph_mixB2(p, l, bid, nb, smf);
    grid.sync();
#if PROBE_DUP == 7
    for (int t = bid; t < 544; t += nb) { rg_task<1>(p, l, t, smf); __syncthreads(); }
    grid.sync();
#endif
    if (PHM & 256) ph_gemm<2>(p, l, bid, nb, smh);
    grid.sync();
  }
  if (PHM & 512) ph_final(p, bid, nb);
}

extern "C" void kernel_launch(void* const* d_in, const int* in_sizes, int n_in, void* d_out, int out_size,
                              void* d_ws, size_t ws_size, hipStream_t stream) {
  static int grid_blocks = 0;
  if (!grid_blocks) {
    int dev = 0, cus = 0, per_cu = 0;
    hipGetDevice(&dev);
    hipDeviceGetAttribute(&cus, hipDeviceAttributeMultiprocessorCount, dev);
    hipOccupancyMaxActiveBlocksPerMultiprocessor(&per_cu, mega, 256, 0);
    if (per_cu < 1) per_cu = 1;
    if (per_cu > 2) per_cu = 2;
    grid_blocks = cus * per_cu;
  }
  P p{};
  const float** fp = (const float**)&p;
  for (int i = 0; i < 34; ++i) fp[i] = (const float*)d_in[i];
  p.out = (float*)d_out;
  char* w = (char*)d_ws;
  size_t off = 0;
  auto take = [&](size_t bytes) { char* r = w + off; off += (bytes + 255) & ~(size_t)255; return r; };
  p.U = (u16*)take((size_t)NTOK * UW * 2);
  p.HL = (u16*)take((size_t)NTOK * 1024 * 2);
  p.Y2 = (u16*)take((size_t)NTOK * 1024 * 2);
  p.WT = (u16*)take((size_t)7296 * 1024 * 2);
  p.WoT = (u16*)take((size_t)1024 * 2048 * 2);
  p.KF = (u16*)take((size_t)1024 * 8192 * 2);
  p.DT = (float*)take((size_t)NTOK * 8 * 4);
  p.MOD = (float*)take((size_t)2 * 5 * 3072 * 4);
  p.SUM = (float*)take((size_t)4 * 2 * 17 * 512 * 2 * 4);
  {
    char* Z = take((size_t)16777216);
    p.SSH = (float*)Z; p.XC = (float*)(Z + 8388608); p.KFC = (u16*)(Z + 12582912);
  }
  p.PS = (float*)take((size_t)16 * 2 * 8 * 128 * 4);
  p.PA = (float*)take((size_t)16 * 2 * 8 * 4 * 4);
  if (off > ws_size) { fprintf(stderr, "workspace too small: need %zu have %zu\n", off, ws_size); return; }
  void* args[] = {&p};
  hipError_t e = hipLaunchCooperativeKernel((void*)mega, dim3(grid_blocks), dim3(256), args, 0, stream);
  if (e != hipSuccess) fprintf(stderr, "cooperative launch failed: %s (grid %d)\n", hipGetErrorString(e), grid_blocks);
}
```

```cpp
#include <hip/hip_runtime.h>
#include <hip/hip_bf16.h>
#include <hip/hip_cooperative_groups.h>
#include <cstdio>
#include <cstdint>
namespace cg = cooperative_groups;

typedef unsigned short u16;
using bf16x8 = __attribute__((ext_vector_type(8))) short;
using f32x16 = __attribute__((ext_vector_type(16))) float;

#define NTOK 17408
#define NLAT 16384
#define UW 4096
#define EPS 1e-6f

#ifndef PROBE_DUP
#define PROBE_DUP 0
#endif
#ifndef EN_HY
#define EN_HY 1
#endif
#ifndef EN_RG
#define EN_RG 1
#endif
#ifndef EN_HG
#define EN_HG 1
#endif
#ifndef EN_M2
#define EN_M2 1
#endif

struct P {
  const float *x, *c, *ctx, *c_ctx, *w_mod, *b_mod, *norm_w, *w_in, *w_out;
  const float *hy_conv_w, *hy_conv_b, *hy_w1, *hy_b1, *hy_w2, *hy_b2, *hy_w3, *hy_freq, *hy_skip;
  const float *rg_conv_w, *rg_conv_b, *rg_wa, *rg_ba, *rg_wx, *rg_bx, *rg_lam;
  const float *hg_lb, *hg_norm_w, *m2_conv_w, *m2_conv_b, *m2_dt_bias, *m2_a_log, *m2_d, *m2_norm_w, *final_norm_w;
  float* out;
  u16 *U, *HL, *Y2, *WT, *WoT, *KF, *KFC;
  float *XC, *DT, *MOD, *SUM, *SSH, *PS, *PA;
};

typedef __bf16 bf2_t __attribute__((ext_vector_type(2)));
typedef float f2_t __attribute__((ext_vector_type(2)));
__device__ __forceinline__ uint32_t pack2(float a, float b) {
  f2_t v = {a, b};
  return __builtin_bit_cast(uint32_t, __builtin_convertvector(v, bf2_t));
}
__device__ __forceinline__ u16 f2bf(float f) { return (u16)(pack2(f, f) & 0xffffu); }
__device__ __forceinline__ float bf2f(u16 h) { return __uint_as_float(((uint32_t)h) << 16); }
__device__ __forceinline__ float bflo(uint32_t w) { return __uint_as_float(w << 16); }
__device__ __forceinline__ float bfhi(uint32_t w) { return __uint_as_float(w & 0xffff0000u); }
__device__ __forceinline__ float siluf(float x) { return x * __builtin_amdgcn_rcpf(1.f + __expf(-x)); }
__device__ __forceinline__ float sigmf(float x) { return __builtin_amdgcn_rcpf(1.f + __expf(-x)); }
__device__ __forceinline__ float softplusf(float x) { return x > 20.f ? x : log1pf(__expf(x)); }

__device__ __forceinline__ void unpack8(const uint4& v, float* f) {
  f[0] = bflo(v.x); f[1] = bfhi(v.x); f[2] = bflo(v.y); f[3] = bfhi(v.y);
  f[4] = bflo(v.z); f[5] = bfhi(v.z); f[6] = bflo(v.w); f[7] = bfhi(v.w);
}
__device__ __forceinline__ uint4 pack8(const float* f) {
  uint4 v; v.x = pack2(f[0], f[1]); v.y = pack2(f[2], f[3]); v.z = pack2(f[4], f[5]); v.w = pack2(f[6], f[7]);
  return v;
}
__device__ __forceinline__ float wave_sum(float v) {
#pragma unroll
  for (int o = 32; o >= 1; o >>= 1) v += __shfl_xor(v, o);
  return v;
}

__device__ __forceinline__ int pos2row_seq(int b, int p, int dir) {
  if (p < 256) { int t = dir ? 255 - p : p; return NLAT + b * 256 + t; }
  int j = p - 256; int t = dir ? 4095 - j : j; return b * 4096 + t;
}
__device__ __forceinline__ int pos2row_m2(int b, int p, int dir) {
  if (p < 256) { int t = dir ? 255 - p : p; return NLAT + b * 256 + t; }
  int j = p - 256; int jj = dir ? 4095 - j : j; int c = jj >> 6, r = jj & 63; return b * 4096 + r * 64 + c;
}

__device__ __forceinline__ void ph_mod(const P& p, int bid, int nb, float* sm) {
  int tid = threadIdx.x; asm volatile("" : "+v"(tid));
  for (int task = bid; task < 96; task += nb) {
    int l = task / 48, cgi = task % 48;
    int col = cgi * 64 + (tid & 63);
    int kq = tid >> 6;
    float a0 = 0, a1 = 0, a2 = 0, a3 = 0, a4 = 0;
#pragma unroll 8
    for (int k = kq * 256; k < kq * 256 + 256; ++k) {
      float w = p.w_mod[((size_t)l * 1024 + k) * 3072 + col];
      a0 += siluf(p.c[k]) * w; a1 += siluf(p.c[1024 + k]) * w; a2 += siluf(p.c[2048 + k]) * w;
      a3 += siluf(p.c[3072 + k]) * w; a4 += siluf(p.c_ctx[k]) * w;
    }
    sm[(kq * 5 + 0) * 64 + (tid & 63)] = a0; sm[(kq * 5 + 1) * 64 + (tid & 63)] = a1;
    sm[(kq * 5 + 2) * 64 + (tid & 63)] = a2; sm[(kq * 5 + 3) * 64 + (tid & 63)] = a3;
    sm[(kq * 5 + 4) * 64 + (tid & 63)] = a4;
    __syncthreads();
    if (tid < 64) {
      float bm = p.b_mod[l * 3072 + col];
#pragma unroll
      for (int j = 0; j < 5; ++j) {
        float s = sm[(0 * 5 + j) * 64 + tid] + sm[(1 * 5 + j) * 64 + tid] + sm[(2 * 5 + j) * 64 + tid] + sm[(3 * 5 + j) * 64 + tid];
        p.MOD[(size_t)(l * 5 + j) * 3072 + col] = s + bm;
      }
    }
    __syncthreads();
  }
}

__device__ __forceinline__ void ph_norm(const P& p, int l, int bid, int nb) {
  int tid = threadIdx.x; asm volatile("" : "+v"(tid)); const int wave = tid >> 6, lane = tid & 63;
  for (int R = bid * 4 + wave; R < NTOK; R += nb * 4) {
    const float* src; int mj;
    if (R < NLAT) { src = (l == 0 ? p.x : (const float*)p.out) + (size_t)R * 1024; mj = R >> 12; }
    else { int rc = R - NLAT; src = (l == 0 ? p.ctx : (const float*)p.XC) + (size_t)rc * 1024; mj = 4; }
    const float* mod = p.MOD + (size_t)(l * 5 + mj) * 3072;
    float4 v[4]; float ss = 0;
#pragma unroll
    for (int i = 0; i < 4; ++i) {
      v[i] = ((const float4*)src)[lane + i * 64];
      ss += v[i].x * v[i].x + v[i].y * v[i].y + v[i].z * v[i].z + v[i].w * v[i].w;
    }
    ss = wave_sum(ss);
    float rinv = rsqrtf(ss * (1.f / 1024.f) + EPS);
#pragma unroll
    for (int i = 0; i < 4; ++i) {
      int idx = (lane + i * 64) * 4;
      float4 nw = *(const float4*)(p.norm_w + l * 1024 + idx);
      float4 sh = *(const float4*)(mod + idx);
      float4 sc = *(const float4*)(mod + 1024 + idx);
      float h0 = v[i].x * rinv * nw.x * (1.f + sc.x) + sh.x;
      float h1 = v[i].y * rinv * nw.y * (1.f + sc.y) + sh.y;
      float h2 = v[i].z * rinv * nw.z * (1.f + sc.z) + sh.z;
      float h3 = v[i].w * rinv * nw.w * (1.f + sc.w) + sh.w;
      uint2 o; o.x = pack2(h0, h1); o.y = pack2(h2, h3);
      *(uint2*)(p.HL + (size_t)R * 1024 + idx) = o;
    }
  }
}

__device__ __forceinline__ void ph_wconv(const P& p, int l, int bid, int nb, float* sm) {
  int tid = threadIdx.x; asm volatile("" : "+v"(tid));
  const int T1 = 114 * 16, T2 = 16 * 32;
  for (int t = bid; t < T1 + T2; t += nb) {
    const float* src; int ld, K, n0, k0, sc0, nvalid; u16* dst;
    if (t < T1) {
      int nt = t / 16, kt = t % 16; n0 = nt * 64; k0 = kt * 64;
      src = p.w_in + (size_t)l * 1024 * 7176; ld = 7176; K = 1024; dst = p.WT; nvalid = 64;
      if (n0 < 2048) sc0 = 3072 + n0;
      else if (n0 < 3072) sc0 = 5632 + (n0 - 2048);
      else if (n0 < 3200) { sc0 = 6656 + (n0 - 3072); nvalid = (n0 == 3072) ? 8 : 0; }
      else { int m = n0 - 3200; if (m < 3072) sc0 = m; else if (m < 3584) sc0 = 5120 + (m - 3072); else sc0 = 6664 + (m - 3584); }
    } else {
      int tt = t - T1; int nt = tt / 32, kt = tt % 32; n0 = nt * 64; k0 = kt * 64;
      src = p.w_out + (size_t)l * 2048 * 1024; ld = 1024; K = 2048; dst = p.WoT; nvalid = 64; sc0 = n0;
    }
#pragma unroll
    for (int i = 0; i < 4; ++i) {
      int kk = (tid >> 4) + 16 * i, cc = (tid & 15) * 4;
      const float* sp = src + (size_t)(k0 + kk) * ld + sc0 + cc;
      float4 v;
      if (nvalid == 64) v = *(const float4*)sp;
      else { v.x = (cc + 0 < nvalid) ? sp[0] : 0.f; v.y = (cc + 1 < nvalid) ? sp[1] : 0.f; v.z = (cc + 2 < nvalid) ? sp[2] : 0.f; v.w = (cc + 3 < nvalid) ? sp[3] : 0.f; }
      sm[kk * 65 + cc + 0] = v.x; sm[kk * 65 + cc + 1] = v.y; sm[kk * 65 + cc + 2] = v.z; sm[kk * 65 + cc + 3] = v.w;
    }
    __syncthreads();
#pragma unroll
    for (int i = 0; i < 2; ++i) {
      int q = tid + 256 * i; int nn = q >> 3, ks = q & 7;
      float f[8];
#pragma unroll
      for (int j = 0; j < 8; ++j) f[j] = sm[(ks * 8 + j) * 65 + nn];
      *(uint4*)(dst + (size_t)(n0 + nn) * K + k0 + ks * 8) = pack8(f);
    }
    __syncthreads();
  }
}

__device__ __forceinline__ void ph_filt(const P& p, int l, int bid, int nb, float* sm) {
  int tid = threadIdx.x; asm volatile("" : "+v"(tid));
  const float HY_MIN = -3.0701134573253945f, HY_MAX = -15.350567286626972f;
  int ntask = 256 + (l == 0 ? 16 : 0);
  float* zs = sm; float* h1 = sm + 544; float* h2 = sm + 544 + 1024;
  for (int task = bid; task < ntask; task += nb) {
    int n, t0; u16* K;
    if (task < 256) { n = 4096; t0 = task * 16; K = p.KF; } else { n = 256; t0 = (task - 256) * 16; K = p.KFC; }
    float inv_nm1 = 1.f / (float)(n - 1);
    for (int e = tid; e < 16 * 33; e += 256) {
      int tt = e / 33, f = e % 33; int t = t0 + tt; float val;
      if (f == 0) val = (float)t * inv_nm1;
      else {
        int bi = (f - 1) & 15;
        float band = 1e-4f + (float)bi * ((15.f - 1e-4f) / 15.f);
        float ang = (6.283185307179586f / (float)n) * (float)t * band;
        val = (f <= 16) ? cosf(ang) : -sinf(ang);
      }
      zs[e] = val;
    }
    __syncthreads();
    for (int e = tid; e < 1024; e += 256) {
      int tt = e >> 6, j = e & 63; float acc = p.hy_b1[l * 64 + j];
#pragma unroll 11
      for (int f = 0; f < 33; ++f) acc += zs[tt * 33 + f] * p.hy_w1[(l * 33 + f) * 64 + j];
      h1[e] = sinf(p.hy_freq[l * 64 + j] * acc);
    }
    __syncthreads();
    for (int e = tid; e < 1024; e += 256) {
      int tt = e >> 6, j = e & 63; float acc = p.hy_b2[l * 64 + j];
#pragma unroll 8
      for (int i = 0; i < 64; ++i) acc += h1[tt * 64 + i] * p.hy_w2[(l * 64 + i) * 64 + j];
      h2[e] = sinf(p.hy_freq[l * 64 + j] * acc);
    }
    __syncthreads();
    for (int r = 0; r < 8; ++r) {
      int col = tid + 256 * r; int o = col >> 10, side = (col >> 9) & 1, c = col & 511;
      float w[64];
#pragma unroll
      for (int i = 0; i < 64; ++i) w[i] = p.hy_w3[(size_t)(l * 64 + i) * 2048 + col];
      float delta = fabsf(HY_MIN + (HY_MAX - HY_MIN) * (float)c / 511.f);
      u16* Kc = K + (size_t)(o * 512 + c) * (2 * n);
      for (int tt = 0; tt < 16; ++tt) {
        float acc = 0;
#pragma unroll
        for (int i = 0; i < 64; ++i) acc += h2[tt * 64 + i] * w[i];
        int t = t0 + tt;
        float val = acc * __expf(-(float)t * inv_nm1 * delta);
        int idx;
        if (side == 0) idx = n - t; else { if (t == 0) { idx = 0; val = 0.f; } else idx = n + t; }
        Kc[idx] = f2bf(val);
      }
    }
    __syncthreads();
  }
}

#define LDSTR 72
template <int MODE>
__device__ __forceinline__ void gemm_tile(const P& p, int l, int mt, int nt, u16* sA, u16* sB, int noepi) {
  int tid = threadIdx.x; asm volatile("" : "+v"(tid)); const int wave = tid >> 6, lane = tid & 63;
  const int wm = wave >> 1, wn = wave & 1;
  const int KT = (MODE == 2) ? 2048 : 1024;
  const u16* Bsrc = (MODE == 0) ? p.WT + (size_t)(nt * 128) * 1024
                  : (MODE == 1) ? p.WT + (size_t)(3200 + nt * 128) * 1024
                                : p.WoT + (size_t)(nt * 128) * 2048;
  f32x16 acc[4][2];
#pragma unroll
  for (int a = 0; a < 4; ++a)
#pragma unroll
    for (int b = 0; b < 2; ++b)
#pragma unroll
      for (int r = 0; r < 16; ++r) acc[a][b][r] = 0.f;
  uint4 ra0, ra1, ra2, ra3, ra4, ra5, ra6, ra7, rb0, rb1, rb2, rb3;
  const int lrow = tid >> 3, lseg = tid & 7;
  const u16* Ab0 = p.HL + (size_t)(mt * 256 + lrow) * 1024 + lseg * 8;
  const u16* Ab1 = p.Y2 + (size_t)(mt * 256 + lrow) * 1024 + lseg * 8;
  const u16* Bb = Bsrc + (size_t)lrow * KT + lseg * 8;
#define GLOADS(K0)                                                                                  \
  {                                                                                                 \
    const u16* ap = (MODE == 2 && (K0) >= 1024) ? Ab1 + ((K0) - 1024) : Ab0 + (K0);                 \
    ra0 = *(const uint4*)(ap); ra1 = *(const uint4*)(ap + 32 * 1024);                               \
    ra2 = *(const uint4*)(ap + 64 * 1024); ra3 = *(const uint4*)(ap + 96 * 1024);                   \
    ra4 = *(const uint4*)(ap + 128 * 1024); ra5 = *(const uint4*)(ap + 160 * 1024);                 \
    ra6 = *(const uint4*)(ap + 192 * 1024); ra7 = *(const uint4*)(ap + 224 * 1024);                 \
    const u16* bp = Bb + (K0);                                                                      \
    rb0 = *(const uint4*)(bp); rb1 = *(const uint4*)(bp + (size_t)32 * KT);                         \
    rb2 = *(const uint4*)(bp + (size_t)64 * KT); rb3 = *(const uint4*)(bp + (size_t)96 * KT);       \
  }
  GLOADS(0)
#pragma unroll 1
  for (int k0 = 0; k0 < KT; k0 += 64) {
    *(uint4*)(sA + (lrow + 0) * LDSTR + lseg * 8) = ra0;   *(uint4*)(sA + (lrow + 32) * LDSTR + lseg * 8) = ra1;
    *(uint4*)(sA + (lrow + 64) * LDSTR + lseg * 8) = ra2;  *(uint4*)(sA + (lrow + 96) * LDSTR + lseg * 8) = ra3;
    *(uint4*)(sA + (lrow + 128) * LDSTR + lseg * 8) = ra4; *(uint4*)(sA + (lrow + 160) * LDSTR + lseg * 8) = ra5;
    *(uint4*)(sA + (lrow + 192) * LDSTR + lseg * 8) = ra6; *(uint4*)(sA + (lrow + 224) * LDSTR + lseg * 8) = ra7;
    *(uint4*)(sB + (lrow + 0) * LDSTR + lseg * 8) = rb0;   *(uint4*)(sB + (lrow + 32) * LDSTR + lseg * 8) = rb1;
    *(uint4*)(sB + (lrow + 64) * LDSTR + lseg * 8) = rb2;  *(uint4*)(sB + (lrow + 96) * LDSTR + lseg * 8) = rb3;
    __syncthreads();
    if (k0 + 64 < KT) GLOADS(k0 + 64)
#pragma unroll
    for (int ks = 0; ks < 4; ++ks) {
      bf16x8 fa[4], fb[2];
#pragma unroll
      for (int mi = 0; mi < 4; ++mi)
        fa[mi] = *(const bf16x8*)(sA + (wm * 128 + mi * 32 + (lane & 31)) * LDSTR + ks * 16 + (lane >> 5) * 8);
#pragma unroll
      for (int ni = 0; ni < 2; ++ni)
        fb[ni] = *(const bf16x8*)(sB + (wn * 64 + ni * 32 + (lane & 31)) * LDSTR + ks * 16 + (lane >> 5) * 8);
#pragma unroll
      for (int mi = 0; mi < 4; ++mi)
#pragma unroll
        for (int ni = 0; ni < 2; ++ni)
          acc[mi][ni] = __builtin_amdgcn_mfma_f32_32x32x16_bf16(fa[mi], fb[ni], acc[mi][ni], 0, 0, 0);
    }
    __syncthreads();
  }
  if (noepi) {
    float sacc = 0.f;
#pragma unroll
    for (int a = 0; a < 4; ++a)
#pragma unroll
      for (int b = 0; b < 2; ++b) sacc += acc[a][b][3];
    if (sacc == 1.2345e30f) p.DT[0] = sacc;
    return;
  }
  const int mj = (mt < 64) ? (mt >> 4) : 4;
  const int c31 = lane & 31, hh = lane >> 5;
  const int gcolA = nt * 128 + wn * 64 + c31, gcolB = gcolA + 32;
  if (MODE == 0 && nt == 24) {
    if (wn == 0 && c31 < 8) {
#pragma unroll
      for (int mi = 0; mi < 4; ++mi)
#pragma unroll
        for (int r = 0; r < 16; ++r) {
          const int R = mt * 256 + wm * 128 + mi * 32 + (r & 3) + 8 * (r >> 2) + 4 * hh;
          p.DT[(size_t)R * 8 + c31] = acc[mi][0][r];
        }
    }
    return;
  }
  if (MODE == 1 && nt < 16) {
    const bool sl = (gcolA >> 9) == 3;
#pragma unroll
    for (int mi = 0; mi < 4; ++mi)
#pragma unroll
      for (int ni = 0; ni < 2; ++ni)
#pragma unroll
        for (int g4 = 0; g4 < 4; ++g4) {
          float v0 = acc[mi][ni][4 * g4], v1 = acc[mi][ni][4 * g4 + 1], v2 = acc[mi][ni][4 * g4 + 2], v3 = acc[mi][ni][4 * g4 + 3];
          if (sl) { v0 = siluf(v0); v1 = siluf(v1); v2 = siluf(v2); v3 = siluf(v3); }
          int R0 = mt * 256 + wm * 128 + mi * 32 + 8 * g4 + 4 * hh;
          uint2 o; o.x = pack2(v0, v1); o.y = pack2(v2, v3);
          *(uint2*)(p.U + (size_t)(ni ? gcolB : gcolA) * NTOK + R0) = o;
        }
    return;
  }
  if (MODE != 2) {
    float lbA = 0.f, lbB = 0.f;
    int kindA = 0, kindB = 0;
    if (MODE == 0) {
      int pa_ = gcolA >> 9, pb_ = gcolB >> 9;
      kindA = (pa_ == 0) ? 1 : (pa_ == 1 || pa_ == 2) ? 2 : 0;
      kindB = (pb_ == 0) ? 1 : (pb_ == 1 || pb_ == 2) ? 2 : 0;
      if (l == 1) {
        if (kindA == 2) { int dir = pa_ - 1, ch = gcolA & 511; lbA = 1.f / (1.f + __expf(p.hg_lb[dir * 512 + ch] - p.hg_lb[(2 + dir) * 512 + ch])); }
        if (kindB == 2) { int dir = pb_ - 1, ch = gcolB & 511; lbB = 1.f / (1.f + __expf(p.hg_lb[dir * 512 + ch] - p.hg_lb[(2 + dir) * 512 + ch])); }
      }
    } else {
      int pa_ = gcolA >> 9, pb_ = gcolB >> 9;
      kindA = (pa_ == 3 || pa_ >= 5) ? 3 : 0;
      kindB = (pb_ == 3 || pb_ >= 5) ? 3 : 0;
    }
    u16* stg = sA + wave * (32 * 72);
    u16* dstbase = (MODE == 0) ? p.U + (size_t)(nt * 128 + wn * 64) : p.U + (size_t)NTOK * 2048 + (size_t)(nt * 128 - 2048 + wn * 64);
    const int ldo = (MODE == 0) ? UW : 2048;
#pragma unroll
    for (int mi = 0; mi < 4; ++mi) {
#pragma unroll
      for (int r = 0; r < 16; ++r) {
        const int rl = (r & 3) + 8 * (r >> 2) + 4 * hh;
        float va = acc[mi][0][r], vb = acc[mi][1][r];
        if (kindA == 1) va *= 0.08838834764831845f; else if (kindA == 2) va = (1.f - lbA) * __builtin_amdgcn_rcpf(1.f + __expf(va)); else if (kindA == 3) va = siluf(va);
        if (kindB == 1) vb *= 0.08838834764831845f; else if (kindB == 2) vb = (1.f - lbB) * __builtin_amdgcn_rcpf(1.f + __expf(vb)); else if (kindB == 3) vb = siluf(vb);
        stg[rl * 72 + c31] = f2bf(va);
        stg[rl * 72 + 32 + c31] = f2bf(vb);
      }
#pragma unroll
      for (int it = 0; it < 4; ++it) {
        const int rl = it * 8 + (lane >> 3), seg = lane & 7;
        uint4 v = *(const uint4*)(stg + rl * 72 + seg * 8);
        const int R = mt * 256 + wm * 128 + mi * 32 + rl;
        *(uint4*)(dstbase + (size_t)R * ldo + seg * 8) = v;
      }
    }
    return;
  }
  {
    float* stgf = (float*)sA + wave * (32 * 68);
    const int seg = lane & 15;
    const int gc0 = nt * 128 + wn * 64 + seg * 4;
    const float4 g4v = *(const float4*)(p.MOD + (size_t)(l * 5 + mj) * 3072 + 2048 + gc0);
#pragma unroll
    for (int mi = 0; mi < 4; ++mi) {
#pragma unroll
      for (int r = 0; r < 16; ++r) {
        const int rl = (r & 3) + 8 * (r >> 2) + 4 * hh;
        stgf[rl * 68 + c31] = acc[mi][0][r];
        stgf[rl * 68 + 32 + c31] = acc[mi][1][r];
      }
#pragma unroll
      for (int it = 0; it < 8; ++it) {
        const int rl = it * 4 + (lane >> 4);
        float4 v = *(const float4*)(stgf + rl * 68 + seg * 4);
        const int R = mt * 256 + wm * 128 + mi * 32 + rl;
        const float* src; float* dst;
        if (R < NLAT) { src = ((l == 0) ? p.x : (const float*)p.out) + (size_t)R * 1024 + gc0; dst = p.out + (size_t)R * 1024 + gc0; }
        else { int rc = R - NLAT; src = p.ctx + (size_t)rc * 1024 + gc0; dst = p.XC + (size_t)rc * 1024 + gc0; }
        float4 xv = *(const float4*)src;
        float4 o; o.x = xv.x + g4v.x * v.x; o.y = xv.y + g4v.y * v.y; o.z = xv.z + g4v.z * v.z; o.w = xv.w + g4v.w * v.w;
        *(float4*)dst = o;
      }
    }
  }
}

template <int MODE>
__device__ __forceinline__ void ph_gemm(const P& p, int l, int bid, int nb, u16* sm, int noepi = 0) {
  const int NT = (MODE == 0) ? 25 : (MODE == 1) ? 32 : 8;
  const int MT = (MODE == 2 && l == 1) ? 64 : 68;
  u16* sA = sm; u16* sB = sm + 256 * LDSTR;
  const int xcd = bid & 7, local = bid >> 3, npx = nb >> 3;
  const int mbase = MT >> 3, mextra = MT & 7;
  const int mper = mbase + (xcd < mextra ? 1 : 0);
  const int mstart = (xcd < mextra) ? xcd * (mbase + 1) : mextra * (mbase + 1) + (xcd - mextra) * mbase;
  const int total = mper * NT;
  const int fullb = NT >> 3, rem = NT & 7;
  for (int it = 0;; ++it) {
    int mt, nt;
    if ((nb & 7) == 0) {
      int q = local + npx * it;
      if (q >= total) break;
      int b, i, bw;
      if (q < fullb * mper * 8) { b = q / (mper * 8); i = q - b * mper * 8; bw = 8; }
      else { b = fullb; i = q - fullb * mper * 8; bw = rem; }
      int sub = i / (4 * bw);
      const int nsub = mper >> 2;
      int mt_off, nt_off;
      if (sub < nsub) { int j = i - sub * 4 * bw; mt_off = j & 3; nt_off = j >> 2; }
      else { int j = i - nsub * 4 * bw; sub = nsub; mt_off = 0; nt_off = j; }
      mt = mstart + sub * 4 + mt_off; nt = b * 8 + nt_off;
    } else {
      int t = bid + it * nb;
      if (t >= MT * NT) break;
      nt = t / MT; mt = t % MT;
    }
    __syncthreads();
    gemm_tile<MODE>(p, l, mt, nt, sA, sB, noepi);
  }
  __syncthreads();
}

__device__ __forceinline__ void hg_task(const P& p, int l, int task, float* sm) {
  int tid = threadIdx.x; asm volatile("" : "+v"(tid)); const int wave = tid >> 6, lane = tid & 63;
  const int b = task >> 5, h = (task >> 3) & 3, es = task & 7;
  const int dg = lane & 15, el = lane >> 4;
  float* qs = sm; float* ks = sm + 4096; float* vs = sm + 8192; float* os = sm + 8192 + 512;
  for (int dir = 0; dir < 2; ++dir) {
    float S[8];
#pragma unroll
    for (int r = 0; r < 8; ++r) S[r] = 0.f;
    for (int chunk = 0; chunk < 136; ++chunk) {
#pragma unroll
      for (int i = 0; i < 2; ++i) {
        int q = tid + 256 * i; int pos = q >> 4, seg = q & 15;
        int R = pos2row_seq(b, chunk * 32 + pos, dir);
        const u16* up = p.U + (size_t)R * UW + h * 128 + seg * 8;
        uint4 qv = *(const uint4*)up;
        uint4 kv = *(const uint4*)(up + 512 + dir * 512);
        float f[8];
        unpack8(qv, f);
        *(float4*)(qs + pos * 128 + seg * 8) = make_float4(f[0], f[1], f[2], f[3]);
        *(float4*)(qs + pos * 128 + seg * 8 + 4) = make_float4(f[4], f[5], f[6], f[7]);
        unpack8(kv, f);
        *(float4*)(ks + pos * 128 + seg * 8) = make_float4(f[0], f[1], f[2], f[3]);
        *(float4*)(ks + pos * 128 + seg * 8 + 4) = make_float4(f[4], f[5], f[6], f[7]);
      }
      {
        int pos = tid >> 3, e2 = (tid & 7) * 2;
        int R = pos2row_seq(b, chunk * 32 + pos, dir);
        uint32_t w = *(const uint32_t*)(p.U + (size_t)R * UW + 1536 + h * 128 + es * 16 + e2);
        vs[pos * 16 + e2] = bflo(w); vs[pos * 16 + e2 + 1] = bfhi(w);
      }
      __syncthreads();
#pragma unroll 4
      for (int i = 0; i < 32; ++i) {
        float4 q0 = *(const float4*)(qs + i * 128 + dg * 8), q1 = *(const float4*)(qs + i * 128 + dg * 8 + 4);
        float4 k0 = *(const float4*)(ks + i * 128 + dg * 8), k1 = *(const float4*)(ks + i * 128 + dg * 8 + 4);
        float v = vs[i * 16 + wave * 4 + el];
        S[0] += k0.x * (v - S[0]); S[1] += k0.y * (v - S[1]); S[2] += k0.z * (v - S[2]); S[3] += k0.w * (v - S[3]);
        S[4] += k1.x * (v - S[4]); S[5] += k1.y * (v - S[5]); S[6] += k1.z * (v - S[6]); S[7] += k1.w * (v - S[7]);
        float o = q0.x * S[0] + q0.y * S[1] + q0.z * S[2] + q0.w * S[3] + q1.x * S[4] + q1.y * S[5] + q1.z * S[6] + q1.w * S[7];
        o += __shfl_xor(o, 1); o += __shfl_xor(o, 2); o += __shfl_xor(o, 4); o += __shfl_xor(o, 8);
        if (dg == 0) os[i * 16 + wave * 4 + el] = o;
      }
      __syncthreads();
      {
        int pos = tid >> 3, e2 = (tid & 7) * 2;
        int R = pos2row_seq(b, chunk * 32 + pos, dir);
        uint32_t* yp = (uint32_t*)(p.Y2 + (size_t)R * 1024 + h * 128 + es * 16 + e2);
        float o0 = os[pos * 16 + e2], o1 = os[pos * 16 + e2 + 1];
        if (dir == 1) { uint32_t w = *yp; o0 += bflo(w); o1 += bfhi(w); }
        *yp = pack2(o0, o1);
      }
    }
    __syncthreads();
  }
}

__device__ __forceinline__ void m2_task(const P& p, int l, int task, float* sm) {
  int tid = threadIdx.x; asm volatile("" : "+v"(tid)); const int wave = tid >> 6, lane = tid & 63;
  const int b = task >> 5, head = (task >> 2) & 7, ps = task & 3;
  const int g = head >> 2;
  const int dg = lane & 15, el = lane >> 4;
  float* Cs = sm; float* Bs = sm + 4096; float* xs = sm + 8192; float* os = sm + 8192 + 512;
  float* dts = sm + 8192 + 1024; float* decs = dts + 32;
  for (int dir = 0; dir < 2; ++dir) {
    const float* cw = p.m2_conv_w + (size_t)(l * 2 + dir) * 4 * 1024;
    const float* cb = p.m2_conv_b + (size_t)(l * 2 + dir) * 1024;
    const float dtb = p.m2_dt_bias[(l * 2 + dir) * 8 + head];
    const float Aneg = -__expf(p.m2_a_log[(l * 2 + dir) * 8 + head]);
    const float Dsk = p.m2_d[(l * 2 + dir) * 8 + head];
    float S[8];
#pragma unroll
    for (int r = 0; r < 8; ++r) S[r] = 0.f;
    for (int chunk = 0; chunk < 136; ++chunk) {
      const int pbase = chunk * 32;
      const int seg0 = (pbase < 256) ? 0 : 256;
#pragma unroll
      for (int i = 0; i < 2; ++i) {
        int q = tid + 256 * i; int pos = q >> 4, seg = q & 15;
        int pp = pbase + pos;
        int chB = 512 + g * 128 + seg * 8, chC = 768 + g * 128 + seg * 8;
        float aB[8], aC[8];
#pragma unroll
        for (int j = 0; j < 8; ++j) { aB[j] = cb[chB + j]; aC[j] = cb[chC + j]; }
#pragma unroll
        for (int tap = 0; tap < 4; ++tap) {
          int pt = pp - 3 + tap;
          if (pt >= seg0) {
            int R = pos2row_m2(b, pt, dir);
            const u16* up = p.U + (size_t)R * UW + 2048;
            uint4 bv = *(const uint4*)(up + chB);
            uint4 cv = *(const uint4*)(up + chC);
            float f[8];
            unpack8(bv, f);
#pragma unroll
            for (int j = 0; j < 8; ++j) aB[j] += cw[tap * 1024 + chB + j] * f[j];
            unpack8(cv, f);
#pragma unroll
            for (int j = 0; j < 8; ++j) aC[j] += cw[tap * 1024 + chC + j] * f[j];
          }
        }
#pragma unroll
        for (int j = 0; j < 8; ++j) { aB[j] = siluf(aB[j]); aC[j] = siluf(aC[j]); }
        *(float4*)(Bs + pos * 128 + seg * 8) = make_float4(aB[0], aB[1], aB[2], aB[3]);
        *(float4*)(Bs + pos * 128 + seg * 8 + 4) = make_float4(aB[4], aB[5], aB[6], aB[7]);
        *(float4*)(Cs + pos * 128 + seg * 8) = make_float4(aC[0], aC[1], aC[2], aC[3]);
        *(float4*)(Cs + pos * 128 + seg * 8 + 4) = make_float4(aC[4], aC[5], aC[6], aC[7]);
      }
      {
        int pos = tid >> 3, e2 = (tid & 7) * 2;
        int pp = pbase + pos;
        int ch = head * 64 + ps * 16 + e2;
        float a0 = cb[ch], a1 = cb[ch + 1];
#pragma unroll
        for (int tap = 0; tap < 4; ++tap) {
          int pt = pp - 3 + tap;
          if (pt >= seg0) {
            int R = pos2row_m2(b, pt, dir);
            uint32_t w = *(const uint32_t*)(p.U + (size_t)R * UW + 2048 + ch);
            a0 += cw[tap * 1024 + ch] * bflo(w); a1 += cw[tap * 1024 + ch + 1] * bfhi(w);
          }
        }
        xs[pos * 16 + e2] = siluf(a0); xs[pos * 16 + e2 + 1] = siluf(a1);
      }
      if (tid < 32) {
        int R = pos2row_m2(b, pbase + tid, dir);
        float dtv = softplusf(p.DT[(size_t)R * 8 + head] + dtb);
        dts[tid] = dtv; decs[tid] = __expf(dtv * Aneg);
      }
      __syncthreads();
#pragma unroll 4
      for (int i = 0; i < 32; ++i) {
        float4 q0 = *(const float4*)(Cs + i * 128 + dg * 8), q1 = *(const float4*)(Cs + i * 128 + dg * 8 + 4);
        float4 k0 = *(const float4*)(Bs + i * 128 + dg * 8), k1 = *(const float4*)(Bs + i * 128 + dg * 8 + 4);
        float xv = xs[i * 16 + wave * 4 + el];
        float a = decs[i]; float v = xv * dts[i];
        S[0] = a * S[0] + k0.x * v; S[1] = a * S[1] + k0.y * v; S[2] = a * S[2] + k0.z * v; S[3] = a * S[3] + k0.w * v;
        S[4] = a * S[4] + k1.x * v; S[5] = a * S[5] + k1.y * v; S[6] = a * S[6] + k1.z * v; S[7] = a * S[7] + k1.w * v;
        float o = q0.x * S[0] + q0.y * S[1] + q0.z * S[2] + q0.w * S[3] + q1.x * S[4] + q1.y * S[5] + q1.z * S[6] + q1.w * S[7];
        o += __shfl_xor(o, 1); o += __shfl_xor(o, 2); o += __shfl_xor(o, 4); o += __shfl_xor(o, 8);
        if (dg == 0) os[i * 16 + wave * 4 + el] = o + Dsk * xv;
      }
      __syncthreads();
      {
        int pos = tid >> 3, e2 = (tid & 7) * 2;
        int R = pos2row_m2(b, pbase + pos, dir);
        uint32_t* yp = (uint32_t*)(p.Y2 + (size_t)R * 1024 + 512 + head * 64 + ps * 16 + e2);
        float o0 = os[pos * 16 + e2], o1 = os[pos * 16 + e2 + 1];
        if (dir == 1) { uint32_t w = *yp; o0 += bflo(w); o1 += bfhi(w); }
        *yp = pack2(o0, o1);
      }
    }
    __syncthreads();
  }
}

#ifndef M2_MFMA
#define M2_MFMA 1
#endif
#define QS 136
#define TS 40
union FragU { bf16x8 v; uint32_t u[4]; uint2 d[2]; uint4 q; };
__device__ __forceinline__ bf16x8 cvt_frag(const f32x16& x, int s2) {
  FragU f;
  f.u[0] = pack2(x[8 * s2 + 0], x[8 * s2 + 1]); f.u[1] = pack2(x[8 * s2 + 2], x[8 * s2 + 3]);
  f.u[2] = pack2(x[8 * s2 + 4], x[8 * s2 + 5]); f.u[3] = pack2(x[8 * s2 + 6], x[8 * s2 + 7]);
  return f.v;
}
__device__ __forceinline__ bf16x8 ld_frag_perm(const u16* base) {
  FragU f; f.d[0] = *(const uint2*)base; f.d[1] = *(const uint2*)(base + 8); return f.v;
}

template <int PASS>
__device__ __forceinline__ void hg_mfma(const P& p, int l, int task, int blk, int dir0, unsigned char* smem) {
  int tid = threadIdx.x; asm volatile("" : "+v"(tid)); const int wave = tid >> 6, lane = tid & 63;
  const int r = lane & 31, hh = lane >> 5;
  const int b = task >> 2, h = task & 3;
  u16* ks = (u16*)smem;
  u16* qs = ks + 32 * QS;
  u16* kT = qs + 32 * QS;
  u16* vT = kT + 128 * TS;
  float* tot = (float*)(vT + 128 * TS);
  float* eg = tot + 256;
  const int dd = tid & 127, half = tid >> 7;
  for (int dir = (PASS == 0 ? dir0 : 0); dir < (PASS == 0 ? dir0 + 1 : 2); ++dir) {
    const int sbd = (PASS == 0) ? blk : ((blk == 0) ? 0 : (dir ? 9 - blk : blk));
    const int c0 = (sbd == 0) ? 0 : 8 + 16 * (sbd - 1);
    const int c1 = (sbd == 0) ? 8 : 8 + 16 * sbd;
    float gsum = 0.f;
    f32x16 S[4];
#pragma unroll
    for (int i = 0; i < 4; ++i)
#pragma unroll
      for (int q = 0; q < 16; ++q) S[i][q] = 0.f;
    if (PASS == 1) {
      for (int qb = 0; qb < sbd; ++qb) {
        const size_t sidx = (size_t)((task * 2 + dir) * 8 + qb);
        if (half == 0) eg[dd] = __expf(p.PS[sidx * 128 + dd]);
        __syncthreads();
        const float* sp = p.SSH + sidx * 16384 + (size_t)wave * 4096 + lane;
#pragma unroll
        for (int dt = 0; dt < 4; ++dt)
#pragma unroll
          for (int q4 = 0; q4 < 4; ++q4) {
            float4 e4 = *(const float4*)(eg + 32 * dt + 8 * q4 + 4 * hh);
            S[dt][4 * q4 + 0] = S[dt][4 * q4 + 0] * e4.x + sp[(dt * 16 + 4 * q4 + 0) * 64];
            S[dt][4 * q4 + 1] = S[dt][4 * q4 + 1] * e4.y + sp[(dt * 16 + 4 * q4 + 1) * 64];
            S[dt][4 * q4 + 2] = S[dt][4 * q4 + 2] * e4.z + sp[(dt * 16 + 4 * q4 + 2) * 64];
            S[dt][4 * q4 + 3] = S[dt][4 * q4 + 3] * e4.w + sp[(dt * 16 + 4 * q4 + 3) * 64];
          }
        __syncthreads();
      }
    }
    uint4 pq0, pq1, pk0, pk1, pv0, pv1;
#define HG_PREFETCH(CH)                                                                     \
    {                                                                                       \
      int pos0 = tid >> 4, seg = tid & 15;                                                  \
      int R0 = pos2row_seq(b, (CH) * 32 + pos0, dir), R1 = pos2row_seq(b, (CH) * 32 + pos0 + 16, dir); \
      const u16* u0 = p.U + (size_t)R0 * UW + h * 128 + seg * 8;                            \
      const u16* u1 = p.U + (size_t)R1 * UW + h * 128 + seg * 8;                            \
      pq0 = *(const uint4*)u0; pq1 = *(const uint4*)u1;                                     \
      pk0 = *(const uint4*)(u0 + 512 + dir * 512); pk1 = *(const uint4*)(u1 + 512 + dir * 512); \
      pv0 = *(const uint4*)(u0 + 1536); pv1 = *(const uint4*)(u1 + 1536);                   \
    }
    HG_PREFETCH(c0)
#pragma unroll 1
    for (int chunk = c0; chunk < c1; ++chunk) {
      {
        int pos0 = tid >> 4, seg = tid & 15;
        *(uint4*)(qs + pos0 * QS + seg * 8) = pq0; *(uint4*)(qs + (pos0 + 16) * QS + seg * 8) = pq1;
        *(uint4*)(ks + pos0 * QS + seg * 8) = pk0; *(uint4*)(ks + (pos0 + 16) * QS + seg * 8) = pk1;
        FragU f0, f1; f0.q = pv0; f1.q = pv1;
#pragma unroll
        for (int j = 0; j < 4; ++j) {
          vT[(seg * 8 + 2 * j) * TS + pos0] = (u16)(f0.u[j] & 0xffffu); vT[(seg * 8 + 2 * j + 1) * TS + pos0] = (u16)(f0.u[j] >> 16);
          vT[(seg * 8 + 2 * j) * TS + pos0 + 16] = (u16)(f1.u[j] & 0xffffu); vT[(seg * 8 + 2 * j + 1) * TS + pos0 + 16] = (u16)(f1.u[j] >> 16);
        }
      }
      __syncthreads();
      if (chunk + 1 < c1) HG_PREFETCH(chunk + 1)
      const int Rout = pos2row_seq(b, chunk * 32 + r, dir);
      u16* yrow = p.Y2 + (size_t)Rout * 1024 + h * 128 + wave * 32 + 4 * hh;
      uint2 yold[4];
      if (PASS == 1 && dir == 1) {
#pragma unroll
        for (int q4 = 0; q4 < 4; ++q4) yold[q4] = *(const uint2*)(yrow + 8 * q4);
      }
      float gl[16];
      {
        float run = 0.f;
#pragma unroll
        for (int i = 0; i < 16; ++i) {
          float kkv = bf2f(ks[(half * 16 + i) * QS + dd]);
          run += __logf(fmaxf(1.f - kkv, 1e-6f));
          gl[i] = run;
        }
        tot[half * 128 + dd] = run;
      }
      __syncthreads();
      {
        const float t0 = tot[dd], t1 = tot[128 + dd];
        const float off = half ? t0 : 0.f;
        const float g31 = t0 + t1;
        float k2[16];
#pragma unroll
        for (int i = 0; i < 16; ++i) {
          const int pos = half * 16 + i;
          const float g = gl[i] + off;
          const float kkv = bf2f(ks[pos * QS + dd]);
          const float qv = bf2f(qs[pos * QS + dd]);
          qs[pos * QS + dd] = f2bf(qv * __expf(g));
          ks[pos * QS + dd] = f2bf(kkv * __expf(fminf(-g, 60.f)));
          k2[i] = kkv * __expf(g31 - g);
        }
        *(uint4*)(kT + dd * TS + half * 16) = pack8(k2);
        *(uint4*)(kT + dd * TS + half * 16 + 8) = pack8(k2 + 8);
        if (half == 0) eg[dd] = __expf(g31);
        gsum += g31;
      }
      __syncthreads();
      f32x16 O;
      if (PASS == 1) {
      f32x16 att;
#pragma unroll
      for (int q = 0; q < 16; ++q) att[q] = 0.f;
#pragma unroll
      for (int k8 = 0; k8 < 8; ++k8) {
        bf16x8 A = *(const bf16x8*)(ks + r * QS + 16 * k8 + 8 * hh);
        bf16x8 B = *(const bf16x8*)(qs + r * QS + 16 * k8 + 8 * hh);
        att = __builtin_amdgcn_mfma_f32_32x32x16_bf16(A, B, att, 0, 0, 0);
      }
#pragma unroll
      for (int q = 0; q < 16; ++q) {
        int sidx = (q & 3) + 8 * (q >> 2) + 4 * hh;
        if (sidx > r) att[q] = 0.f;
      }
#pragma unroll
      for (int q = 0; q < 16; ++q) O[q] = 0.f;
#pragma unroll
      for (int dt = 0; dt < 4; ++dt)
#pragma unroll
        for (int s2 = 0; s2 < 2; ++s2) {
          bf16x8 A = cvt_frag(S[dt], s2);
          bf16x8 B = ld_frag_perm(qs + r * QS + 32 * dt + 16 * s2 + 4 * hh);
          O = __builtin_amdgcn_mfma_f32_32x32x16_bf16(A, B, O, 0, 0, 0);
        }
#pragma unroll
      for (int s2 = 0; s2 < 2; ++s2) {
        bf16x8 A = ld_frag_perm(vT + (32 * wave + r) * TS + 16 * s2 + 4 * hh);
        bf16x8 B = cvt_frag(att, s2);
        O = __builtin_amdgcn_mfma_f32_32x32x16_bf16(A, B, O, 0, 0, 0);
      }
      }
#pragma unroll
      for (int dt = 0; dt < 4; ++dt) {
#pragma unroll
        for (int q4 = 0; q4 < 4; ++q4) {
          float4 e4 = *(const float4*)(eg + 32 * dt + 8 * q4 + 4 * hh);
          S[dt][4 * q4 + 0] *= e4.x; S[dt][4 * q4 + 1] *= e4.y; S[dt][4 * q4 + 2] *= e4.z; S[dt][4 * q4 + 3] *= e4.w;
        }
#pragma unroll
        for (int s2 = 0; s2 < 2; ++s2) {
          bf16x8 A = *(const bf16x8*)(kT + (32 * dt + r) * TS + 16 * s2 + 8 * hh);
          bf16x8 B = *(const bf16x8*)(vT + (32 * wave + r) * TS + 16 * s2 + 8 * hh);
          S[dt] = __builtin_amdgcn_mfma_f32_32x32x16_bf16(A, B, S[dt], 0, 0, 0);
        }
      }
      if (PASS == 1) {
#pragma unroll
      for (int q4 = 0; q4 < 4; ++q4) {
        float o0 = O[4 * q4], o1 = O[4 * q4 + 1], o2 = O[4 * q4 + 2], o3 = O[4 * q4 + 3];
        if (dir == 1) { o0 += bflo(yold[q4].x); o1 += bfhi(yold[q4].x); o2 += bflo(yold[q4].y); o3 += bfhi(yold[q4].y); }
        uint2 ov; ov.x = pack2(o0, o1); ov.y = pack2(o2, o3);
        *(uint2*)(yrow + 8 * q4) = ov;
      }
      }
      __syncthreads();
    }
    if (PASS == 0) {
      const size_t sidx = (size_t)((task * 2 + dir) * 8 + sbd);
      if (half == 0) p.PS[sidx * 128 + dd] = gsum;
      float* sp = p.SSH + sidx * 16384 + (size_t)wave * 4096 + lane;
#pragma unroll
      for (int dt = 0; dt < 4; ++dt)
#pragma unroll
        for (int q = 0; q < 16; ++q) sp[(dt * 16 + q) * 64] = S[dt][q];
    }
    __syncthreads();
  }
}

#if M2_MFMA
#define M2_NTASK 16
template <int PASS>
__device__ __forceinline__ void m2_mfma(const P& p, int l, int task, int blk, int dir0, unsigned char* smem) {
  int tid = threadIdx.x; asm volatile("" : "+v"(tid)); const int wave = tid >> 6, lane = tid & 63;
  const int r = lane & 31, hh = lane >> 5;
  const int b = task >> 2, g = (task >> 1) & 1, hp = task & 1;
  const int hq = wave >> 1, ph = wave & 1;
  const int head = 4 * g + 2 * hp + hq;
  u16* Bm = (u16*)smem;
  u16* Cm = Bm + 32 * QS;
  u16* BmT = Cm + 32 * QS;
  u16* xsT = BmT + 128 * TS;
  float* Gs = (float*)(xsT + 128 * TS);
  float* dts = Gs + 64;
  float* wl = dts + 64;
  const int cp = (lane < 48) ? lane : 47;
  const bool act = lane < 48;
  const int chW = (cp < 16) ? ((4 * g + 2 * hp) * 64 + cp * 8) : (cp < 32) ? (512 + g * 128 + (cp - 16) * 8) : (768 + g * 128 + (cp - 32) * 8);
  const int chU = 2048 + chW;
  float* SSM = (float*)p.KF;
  for (int dir = (PASS == 0 ? dir0 : 0); dir < (PASS == 0 ? dir0 + 1 : 2); ++dir) {
    const int sbd = (PASS == 0) ? blk : ((blk == 0) ? 0 : (dir ? 9 - blk : blk));
    const int c0 = (sbd == 0) ? 0 : 8 + 16 * (sbd - 1);
    const int c1 = (sbd == 0) ? 8 : 8 + 16 * sbd;
    float lsum = 0.f;
    const float* cw = p.m2_conv_w + (size_t)(l * 2 + dir) * 4 * 1024;
    const float* cb = p.m2_conv_b + (size_t)(l * 2 + dir) * 1024;
    if (wave == 0) {
#pragma unroll
      for (int j = 0; j < 8; ++j) {
        wl[(4 * 8 + j) * 64 + lane] = cb[chW + j];
#pragma unroll
        for (int tap = 0; tap < 4; ++tap) wl[(tap * 8 + j) * 64 + lane] = cw[tap * 1024 + chW + j];
      }
    }
    __syncthreads();
    const int hd_t = 4 * g + 2 * hp + ((tid >> 5) & 1);
    const float dtb = p.m2_dt_bias[(l * 2 + dir) * 8 + hd_t];
    const float Aneg_t = -__expf(p.m2_a_log[(l * 2 + dir) * 8 + hd_t]);
    const float Dsk = p.m2_d[(l * 2 + dir) * 8 + head];
    f32x16 S[4];
#pragma unroll
    for (int i = 0; i < 4; ++i)
#pragma unroll
      for (int q = 0; q < 16; ++q) S[i][q] = 0.f;
    if (PASS == 1) {
      for (int qb = 0; qb < sbd; ++qb) {
        const size_t sidx = (size_t)((task * 2 + dir) * 8 + qb);
        const float a = __expf(p.PA[sidx * 4 + wave]);
        const float* sp = SSM + sidx * 16384 + (size_t)wave * 4096 + lane;
#pragma unroll
        for (int nt = 0; nt < 4; ++nt)
#pragma unroll
          for (int q = 0; q < 16; ++q) S[nt][q] = S[nt][q] * a + sp[(nt * 16 + q) * 64];
      }
    }
    uint4 raw0, raw1, raw2, raw3, raw4, raw5, raw6, raw7, raw8, raw9, raw10;
    float dtraw = 0.f;
#define M2_LD1(RW, I, CH)                                                                  \
    {                                                                                      \
      int pt = (CH) * 32 + wave * 8 + (I) - 3;                                             \
      int sg0 = ((CH) * 32 < 256) ? 0 : 256;                                               \
      if (pt >= sg0) { int Rr = pos2row_m2(b, pt, dir); RW = *(const uint4*)(p.U + (size_t)Rr * UW + chU); } \
      else RW = make_uint4(0u, 0u, 0u, 0u);                                                \
    }
#define M2_PREFETCH(CH)                                                                    \
    M2_LD1(raw0, 0, CH) M2_LD1(raw1, 1, CH) M2_LD1(raw2, 2, CH) M2_LD1(raw3, 3, CH) M2_LD1(raw4, 4, CH) M2_LD1(raw5, 5, CH) \
    M2_LD1(raw6, 6, CH) M2_LD1(raw7, 7, CH) M2_LD1(raw8, 8, CH) M2_LD1(raw9, 9, CH) M2_LD1(raw10, 10, CH)            \
    if (tid < 64) { int Rr = pos2row_m2(b, (CH) * 32 + (tid & 31), dir); dtraw = p.DT[(size_t)Rr * 8 + hd_t]; }
    M2_PREFETCH(c0)
#pragma unroll 1
    for (int chunk = c0; chunk < c1; ++chunk) {
      {
#define M2_RAWF(RW, J) (((J) & 1) ? bfhi((RW)) : bflo((RW)))
#define M2_CH(J, C0, C1, C2, C3, C4, C5, C6, C7, C8, C9, C10)                               \
        {                                                                                  \
          const float q0 = wl[(0 * 8 + (J)) * 64 + lane], q1 = wl[(1 * 8 + (J)) * 64 + lane]; \
          const float q2 = wl[(2 * 8 + (J)) * 64 + lane], q3 = wl[(3 * 8 + (J)) * 64 + lane]; \
          const float qb = wl[(4 * 8 + (J)) * 64 + lane];                                  \
          const float v0 = M2_RAWF(C0, J), v1 = M2_RAWF(C1, J), v2 = M2_RAWF(C2, J), v3 = M2_RAWF(C3, J); \
          const float v4 = M2_RAWF(C4, J), v5 = M2_RAWF(C5, J), v6 = M2_RAWF(C6, J), v7 = M2_RAWF(C7, J); \
          const float v8 = M2_RAWF(C8, J), v9 = M2_RAWF(C9, J), v10 = M2_RAWF(C10, J);      \
          float o[8];                                                                      \
          o[0] = siluf(qb + q0 * v0 + q1 * v1 + q2 * v2 + q3 * v3);                        \
          o[1] = siluf(qb + q0 * v1 + q1 * v2 + q2 * v3 + q3 * v4);                        \
          o[2] = siluf(qb + q0 * v2 + q1 * v3 + q2 * v4 + q3 * v5);                        \
          o[3] = siluf(qb + q0 * v3 + q1 * v4 + q2 * v5 + q3 * v6);                        \
          o[4] = siluf(qb + q0 * v4 + q1 * v5 + q2 * v6 + q3 * v7);                        \
          o[5] = siluf(qb + q0 * v5 + q1 * v6 + q2 * v7 + q3 * v8);                        \
          o[6] = siluf(qb + q0 * v6 + q1 * v7 + q2 * v8 + q3 * v9);                        \
          o[7] = siluf(qb + q0 * v7 + q1 * v8 + q2 * v9 + q3 * v10);                       \
          if (act) {                                                                       \
            if (cp < 16) {                                                                 \
              *(uint4*)(xsT + (cp * 8 + (J)) * TS + wave * 8) = pack8(o);                  \
            } else if (cp < 32) {                                                          \
              *(uint4*)(BmT + ((cp - 16) * 8 + (J)) * TS + wave * 8) = pack8(o);           \
              _Pragma("unroll") for (int i = 0; i < 8; ++i) Bm[(wave * 8 + i) * QS + (cp - 16) * 8 + (J)] = f2bf(o[i]); \
            } else {                                                                       \
              _Pragma("unroll") for (int i = 0; i < 8; ++i) Cm[(wave * 8 + i) * QS + (cp - 32) * 8 + (J)] = f2bf(o[i]); \
            }                                                                              \
          }                                                                                \
        }
        M2_CH(0, raw0.x, raw1.x, raw2.x, raw3.x, raw4.x, raw5.x, raw6.x, raw7.x, raw8.x, raw9.x, raw10.x)
        M2_CH(1, raw0.x, raw1.x, raw2.x, raw3.x, raw4.x, raw5.x, raw6.x, raw7.x, raw8.x, raw9.x, raw10.x)
        M2_CH(2, raw0.y, raw1.y, raw2.y, raw3.y, raw4.y, raw5.y, raw6.y, raw7.y, raw8.y, raw9.y, raw10.y)
        M2_CH(3, raw0.y, raw1.y, raw2.y, raw3.y, raw4.y, raw5.y, raw6.y, raw7.y, raw8.y, raw9.y, raw10.y)
        M2_CH(4, raw0.z, raw1.z, raw2.z, raw3.z, raw4.z, raw5.z, raw6.z, raw7.z, raw8.z, raw9.z, raw10.z)
        M2_CH(5, raw0.z, raw1.z, raw2.z, raw3.z, raw4.z, raw5.z, raw6.z, raw7.z, raw8.z, raw9.z, raw10.z)
        M2_CH(6, raw0.w, raw1.w, raw2.w, raw3.w, raw4.w, raw5.w, raw6.w, raw7.w, raw8.w, raw9.w, raw10.w)
        M2_CH(7, raw0.w, raw1.w, raw2.w, raw3.w, raw4.w, raw5.w, raw6.w, raw7.w, raw8.w, raw9.w, raw10.w)
      }
      if (tid < 64) {
        float dtv = softplusf(dtraw + dtb);
        float run = dtv * Aneg_t;
#pragma unroll
        for (int o = 1; o < 32; o <<= 1) { float n = __shfl_up(run, o, 32); if ((tid & 31) >= o) run += n; }
        Gs[tid] = run; dts[tid] = dtv;
      }
      __syncthreads();
      if (chunk + 1 < c1) { M2_PREFETCH(chunk + 1) }
      const int Rout = pos2row_m2(b, chunk * 32 + r, dir);
      u16* yrow = p.Y2 + (size_t)Rout * 1024 + 512 + head * 64 + 32 * ph + 4 * hh;
      uint2 yold[4];
      if (PASS == 1 && dir == 1) {
#pragma unroll
        for (int i = 0; i < 4; ++i) yold[i] = *(const uint2*)(yrow + 8 * i);
      }
      const float* Gw = Gs + hq * 32; const float* dw = dts + hq * 32;
      const float Gt = Gw[r], G31 = Gw[31];
      lsum += G31;
      const u16* xw = xsT + (hq * 64 + ph * 32) * TS;
      f32x16 O0;
      if (PASS == 1) {
      f32x16 att;
#pragma unroll
      for (int q = 0; q < 16; ++q) att[q] = 0.f;
#pragma unroll
      for (int k8 = 0; k8 < 8; ++k8) {
        bf16x8 A = *(const bf16x8*)(Bm + r * QS + 16 * k8 + 8 * hh);
        bf16x8 B = *(const bf16x8*)(Cm + r * QS + 16 * k8 + 8 * hh);
        att = __builtin_amdgcn_mfma_f32_32x32x16_bf16(A, B, att, 0, 0, 0);
      }
#pragma unroll
      for (int q4 = 0; q4 < 4; ++q4) {
        float4 gs4 = *(const float4*)(Gw + 8 * q4 + 4 * hh);
        float4 dt4 = *(const float4*)(dw + 8 * q4 + 4 * hh);
        int s0 = 8 * q4 + 4 * hh;
        att[4 * q4 + 0] = (s0 + 0 <= r) ? att[4 * q4 + 0] * __expf(Gt - gs4.x) * dt4.x : 0.f;
        att[4 * q4 + 1] = (s0 + 1 <= r) ? att[4 * q4 + 1] * __expf(Gt - gs4.y) * dt4.y : 0.f;
        att[4 * q4 + 2] = (s0 + 2 <= r) ? att[4 * q4 + 2] * __expf(Gt - gs4.z) * dt4.z : 0.f;
        att[4 * q4 + 3] = (s0 + 3 <= r) ? att[4 * q4 + 3] * __expf(Gt - gs4.w) * dt4.w : 0.f;
      }
#pragma unroll
      for (int q = 0; q < 16; ++q) O0[q] = 0.f;
#pragma unroll
      for (int nt = 0; nt < 4; ++nt)
#pragma unroll
        for (int s2 = 0; s2 < 2; ++s2) {
          bf16x8 B = ld_frag_perm(Cm + r * QS + 32 * nt + 16 * s2 + 4 * hh);
          O0 = __builtin_amdgcn_mfma_f32_32x32x16_bf16(cvt_frag(S[nt], s2), B, O0, 0, 0, 0);
        }
      {
        const float eGt = __expf(Gt);
#pragma unroll
        for (int q = 0; q < 16; ++q) O0[q] *= eGt;
      }
#pragma unroll
      for (int s2 = 0; s2 < 2; ++s2) {
        bf16x8 B = cvt_frag(att, s2);
        O0 = __builtin_amdgcn_mfma_f32_32x32x16_bf16(ld_frag_perm(xw + r * TS + 16 * s2 + 4 * hh), B, O0, 0, 0, 0);
      }
#pragma unroll
      for (int q = 0; q < 16; ++q) {
        int pp = (q & 3) + 8 * (q >> 2) + 4 * hh;
        O0[q] += Dsk * bf2f(xw[pp * TS + r]);
      }
      }
      {
        const float eG31 = __expf(G31);
#pragma unroll
        for (int nt = 0; nt < 4; ++nt)
#pragma unroll
          for (int q = 0; q < 16; ++q) S[nt][q] *= eG31;
#pragma unroll
        for (int s2 = 0; s2 < 2; ++s2) {
          float ws[8];
          {
            float4 ga = *(const float4*)(Gw + 16 * s2 + 8 * hh), gb = *(const float4*)(Gw + 16 * s2 + 8 * hh + 4);
            float4 da = *(const float4*)(dw + 16 * s2 + 8 * hh), db = *(const float4*)(dw + 16 * s2 + 8 * hh + 4);
            ws[0] = da.x * __expf(G31 - ga.x); ws[1] = da.y * __expf(G31 - ga.y); ws[2] = da.z * __expf(G31 - ga.z); ws[3] = da.w * __expf(G31 - ga.w);
            ws[4] = db.x * __expf(G31 - gb.x); ws[5] = db.y * __expf(G31 - gb.y); ws[6] = db.z * __expf(G31 - gb.z); ws[7] = db.w * __expf(G31 - gb.w);
          }
          bf16x8 Bf0;
          {
            float f[8]; unpack8(*(const uint4*)(xw + r * TS + 16 * s2 + 8 * hh), f);
#pragma unroll
            for (int j = 0; j < 8; ++j) f[j] *= ws[j];
            FragU u; u.q = pack8(f); Bf0 = u.v;
          }
#pragma unroll
          for (int nt = 0; nt < 4; ++nt) {
            bf16x8 A = *(const bf16x8*)(BmT + (32 * nt + r) * TS + 16 * s2 + 8 * hh);
            S[nt] = __builtin_amdgcn_mfma_f32_32x32x16_bf16(A, Bf0, S[nt], 0, 0, 0);
          }
        }
      }
      if (PASS == 1) {
#pragma unroll
      for (int q4 = 0; q4 < 4; ++q4) {
        float o0 = O0[4 * q4], o1 = O0[4 * q4 + 1], o2 = O0[4 * q4 + 2], o3 = O0[4 * q4 + 3];
        if (dir == 1) { o0 += bflo(yold[q4].x); o1 += bfhi(yold[q4].x); o2 += bflo(yold[q4].y); o3 += bfhi(yold[q4].y); }
        uint2 ov; ov.x = pack2(o0, o1); ov.y = pack2(o2, o3);
        *(uint2*)(yrow + 8 * q4) = ov;
      }
      }
      __syncthreads();
    }
    if (PASS == 0) {
      const size_t sidx = (size_t)((task * 2 + dir) * 8 + sbd);
      if (lane == 0) p.PA[sidx * 4 + wave] = lsum;
      float* sp = SSM + sidx * 16384 + (size_t)wave * 4096 + lane;
#pragma unroll
      for (int nt = 0; nt < 4; ++nt)
#pragma unroll
        for (int q = 0; q < 16; ++q) sp[(nt * 16 + q) * 64] = S[nt][q];
    }
    __syncthreads();
  }
}
#endif
__device__ __forceinline__ void ph_mixA0(const P& p, int l, int bid, int nb, unsigned char* sm) {
  for (int t = bid; t < 512; t += nb) {
    if (t < 256) hg_mfma<0>(p, l, t >> 4, (t >> 1) & 7, t & 1, sm);
    else { int u = t - 256; m2_mfma<0>(p, l, u >> 4, (u >> 1) & 7, u & 1, sm); }
    __syncthreads();
  }
}
__device__ __forceinline__ void ph_mixA1(const P& p, int l, int bid, int nb, unsigned char* sm) {
  for (int t = bid; t < 288; t += nb) {
    if (t < 128) hg_mfma<1>(p, l, t >> 3, 1 + (t & 7), 0, sm);
    else if (t < 256) { int u = t - 128; m2_mfma<1>(p, l, u >> 3, 1 + (u & 7), 0, sm); }
    else if (t < 272) hg_mfma<1>(p, l, t - 256, 0, 0, sm);
    else m2_mfma<1>(p, l, t - 272, 0, 0, sm);
    __syncthreads();
  }
}

template <int PASS>
__device__ __forceinline__ void rg_task(const P& p, int l, int task, float* sm) {
  int tid = threadIdx.x; asm volatile("" : "+v"(tid));
  const int wave = tid >> 6, lane = tid & 63;
  const int b = task / 136, rem = task % 136, head = rem / 17, sb = rem % 17;
  float* xc = sm;
  float* pa = sm + 2048;
  float* pb = sm + 4096;
  u16* xcb = (u16*)(sm + 6144);
  u16* WTl = xcb + 32 * 72;
  const int j = tid & 63;
  const int spos = tid >> 3, sseg = tid & 7;
  const int sch = head * 64 + sseg * 8;
  const u16* UB2 = p.U + (size_t)NTOK * 2048;
  for (int dir = 0; dir < 2; ++dir) {
    const int ld = l * 2 + dir;
    {
      const float* wa = p.rg_wa + (size_t)(ld * 8 + head) * 4096;
      const float* wx = p.rg_wx + (size_t)(ld * 8 + head) * 4096;
#pragma unroll
      for (int it = 0; it < 4; ++it) {
        int i = (tid >> 4) + 16 * it, j4 = (tid & 15) * 4;
        float4 va = *(const float4*)(wa + i * 64 + j4);
        float4 vx = *(const float4*)(wx + i * 64 + j4);
        WTl[(j4 + 0) * 72 + i] = f2bf(va.x); WTl[(j4 + 1) * 72 + i] = f2bf(va.y);
        WTl[(j4 + 2) * 72 + i] = f2bf(va.z); WTl[(j4 + 3) * 72 + i] = f2bf(va.w);
        WTl[(64 + j4 + 0) * 72 + i] = f2bf(vx.x); WTl[(64 + j4 + 1) * 72 + i] = f2bf(vx.y);
        WTl[(64 + j4 + 2) * 72 + i] = f2bf(vx.z); WTl[(64 + j4 + 3) * 72 + i] = f2bf(vx.w);
      }
    }
    float wcv[4][8], bcv[8];
#pragma unroll
    for (int jj = 0; jj < 8; ++jj) {
      bcv[jj] = p.rg_conv_b[(size_t)ld * 512 + sch + jj];
#pragma unroll
      for (int tap = 0; tap < 4; ++tap) wcv[tap][jj] = p.rg_conv_w[((size_t)ld * 4 + tap) * 512 + sch + jj];
    }
    const int chg = head * 64 + j;
    const float g_ba = p.rg_ba[ld * 512 + chg], g_bx = p.rg_bx[ld * 512 + chg];
    const float g_sp = -8.0f * softplusf(-p.rg_lam[ld * 512 + chg]);
    const int sbd = (PASS == 0) ? sb : (dir ? (sb == 0 ? 0 : 17 - sb) : sb);
    float hcarry = 0.f, aprod = 1.f;
    if (PASS == 1 && tid < 64) {
      float2 sv[16];
#pragma unroll
      for (int q = 0; q < 16; ++q) {
        const float2* sp = (const float2*)(p.SUM + ((((size_t)b * 2 + dir) * 17 + q) * 512 + head * 64 + tid) * 2);
        sv[q] = (q < sbd) ? *sp : make_float2(1.f, 0.f);
      }
#pragma unroll
      for (int q = 0; q < 16; ++q) hcarry = sv[q].x * hcarry + sv[q].y;
    }
    uint4 xr0, xr1, xr2, xr3;
#define RG_LD1(XR, TAP, CH)                                                               \
    {                                                                                     \
      int pt = (CH) * 32 + spos - 3 + (TAP);                                              \
      int sg0 = ((CH) * 32 < 256) ? 0 : 256;                                              \
      if (pt >= sg0) { int Rr = pos2row_seq(b, pt, dir); XR = *(const uint4*)(UB2 + (size_t)Rr * 2048 + sch); } \
      else XR = make_uint4(0u, 0u, 0u, 0u);                                               \
    }
#define RG_PREFETCH(CH) RG_LD1(xr0, 0, CH) RG_LD1(xr1, 1, CH) RG_LD1(xr2, 2, CH) RG_LD1(xr3, 3, CH)
    RG_PREFETCH(sbd * 8)
#pragma unroll 1
    for (int chunk = sbd * 8; chunk < sbd * 8 + 8; ++chunk) {
      const int pbase = chunk * 32;
      {
        float a[8], f[8];
#pragma unroll
        for (int jj = 0; jj < 8; ++jj) a[jj] = bcv[jj];
        unpack8(xr0, f);
#pragma unroll
        for (int jj = 0; jj < 8; ++jj) a[jj] += wcv[0][jj] * f[jj];
        unpack8(xr1, f);
#pragma unroll
        for (int jj = 0; jj < 8; ++jj) a[jj] += wcv[1][jj] * f[jj];
        unpack8(xr2, f);
#pragma unroll
        for (int jj = 0; jj < 8; ++jj) a[jj] += wcv[2][jj] * f[jj];
        unpack8(xr3, f);
#pragma unroll
        for (int jj = 0; jj < 8; ++jj) a[jj] += wcv[3][jj] * f[jj];
        *(float4*)(xc + spos * 64 + sseg * 8) = make_float4(a[0], a[1], a[2], a[3]);
        *(float4*)(xc + spos * 64 + sseg * 8 + 4) = make_float4(a[4], a[5], a[6], a[7]);
        *(uint4*)(xcb + spos * 72 + sseg * 8) = pack8(a);
      }
      __syncthreads();
      if (chunk + 1 < sbd * 8 + 8) { RG_PREFETCH(chunk + 1) }
      const int Rout = pos2row_seq(b, pbase + spos, dir);
      uint4* yp = (uint4*)(p.HL + (size_t)Rout * 1024 + 512 + sch);
      uint4 prev, gv;
      if (PASS == 1 && dir == 1) { prev = *yp; gv = *(const uint4*)(UB2 + (size_t)Rout * 2048 + 512 + sch); }
      {
        const int r = lane & 31, hh = lane >> 5;
        f32x16 acc;
#pragma unroll
        for (int q = 0; q < 16; ++q) acc[q] = 0.f;
#pragma unroll
        for (int ks = 0; ks < 4; ++ks) {
          bf16x8 A = *(const bf16x8*)(xcb + r * 72 + 16 * ks + 8 * hh);
          bf16x8 B = *(const bf16x8*)(WTl + (32 * wave + r) * 72 + 16 * ks + 8 * hh);
          acc = __builtin_amdgcn_mfma_f32_32x32x16_bf16(A, B, acc, 0, 0, 0);
        }
        float* dstp = (wave < 2) ? pa : pb;
        const int jc = (wave & 1) * 32 + r;
#pragma unroll
        for (int q = 0; q < 16; ++q) dstp[((q & 3) + 8 * (q >> 2) + 4 * hh) * 64 + jc] = acc[q];
      }
      __syncthreads();
#pragma unroll
      for (int i = 0; i < 8; ++i) {
        int e = tid + 256 * i;
        float r = sigmf(pa[e] + g_ba);
        float gi = sigmf(pb[e] + g_bx);
        float la = g_sp * r;
        float a = __expf(la);
        float bt = sqrtf(fmaxf(1.f - a * a, 0.f)) * gi * xc[e];
        pa[e] = a; pb[e] = bt;
      }
      __syncthreads();
      if (tid < 64) {
        float hh = hcarry;
#pragma unroll 8
        for (int pos = 0; pos < 32; ++pos) { float av = pa[pos * 64 + tid]; hh = av * hh + pb[pos * 64 + tid]; pb[pos * 64 + tid] = hh; aprod *= av; }
        hcarry = hh;
      }
      __syncthreads();
      if (PASS == 1) {
        float hv[8];
#pragma unroll
        for (int jj = 0; jj < 8; ++jj) hv[jj] = pb[spos * 64 + sseg * 8 + jj];
        if (dir == 1) {
          float f[8]; unpack8(prev, f);
          float gf[8]; unpack8(gv, gf);
#pragma unroll
          for (int jj = 0; jj < 8; ++jj) hv[jj] = (hv[jj] + f[jj]) * gf[jj];
        }
        *yp = pack8(hv);
      }
    }
    if (PASS == 0 && tid < 64) {
      float* sp = p.SUM + ((((size_t)b * 2 + dir) * 17 + sbd) * 512 + head * 64 + tid) * 2;
      sp[0] = aprod; sp[1] = hcarry;
    }
    __syncthreads();
  }
}

typedef bf16x8 __attribute__((aligned(2))) bf16x8_u;
typedef uint4 __attribute__((aligned(4))) uint4_a4;
__device__ __forceinline__ bf16x8 ld_win8(const u16* base, int y, uint32_t sh) {
  const uint32_t* wp = (const uint32_t*)base + (y >> 1);
  uint4 w = *(const uint4_a4*)wp;
  uint32_t w4 = wp[4];
  FragU f;
  f.u[0] = __builtin_amdgcn_alignbit(w.y, w.x, sh);
  f.u[1] = __builtin_amdgcn_alignbit(w.z, w.y, sh);
  f.u[2] = __builtin_amdgcn_alignbit(w.w, w.z, sh);
  f.u[3] = __builtin_amdgcn_alignbit(w4, w.w, sh);
  return f.v;
}

__device__ __forceinline__ void hy_conv3x8(const u16* col, int t8, int n, float w0, float w1, float w2, float bias, float* out) {
  float f[8]; unpack8(*(const uint4*)(col + t8), f);
  float prev = (t8 > 0) ? bf2f(col[t8 - 1]) : 0.f;
  float next = (t8 + 8 < n) ? bf2f(col[t8 + 8]) : 0.f;
#pragma unroll
  for (int j = 0; j < 8; ++j) {
    float a = (j == 0) ? prev : f[j - 1];
    float cnx = (j == 7) ? next : f[j + 1];
    out[j] = bias + w0 * a + w1 * f[j] + w2 * cnx;
  }
}

#define ZB 5128
#define ZJ 80
#define ZI(B, T) ((B) * ZB + ((T) >> 6) * ZJ + ((T) & 63))
__device__ __forceinline__ void hy_task(const P& p, int l, int c, float* sm) {
  int tid = threadIdx.x; asm volatile("" : "+v"(tid)); const int wave = tid >> 6, lane = tid & 63;
  const int r = lane & 31, h = lane >> 5;
  u16* krr = (u16*)sm;
  u16* zs = krr + 8192 + 64;
  float* red = (float*)(zs + 4 * ZB);
  const u16* UT = p.U;
  const float* cwp = p.hy_conv_w + (size_t)l * 3 * 1536;
  const float* cbp = p.hy_conv_b + (size_t)l * 1536;
  for (int o = 0; o < 2; ++o) {
    const u16* K = p.KF + (size_t)(o * 512 + c) * 8192;
    float asum = 0.f;
#pragma unroll
    for (int i = 0; i < 4; ++i) {
      int idx = (tid + 256 * i) * 8;
      uint4 v = *(const uint4*)(K + idx);
      *(uint4*)(krr + idx) = v;
      float f[8]; unpack8(v, f);
#pragma unroll
      for (int j = 0; j < 8; ++j) asum += fabsf(f[j]);
    }
    asum = wave_sum(asum);
    if (lane == 0) red[wave] = asum;
    if (o == 0) {
      const float w0 = cwp[c], w1 = cwp[1536 + c], w2 = cwp[3072 + c], bs = cbp[c];
#pragma unroll 2
      for (int e = tid; e < 2048; e += 256) {
        int b = e >> 9, t8 = (e & 511) * 8;
        float f[8];
        hy_conv3x8(UT + (size_t)c * NTOK + b * 4096, t8, 4096, w0, w1, w2, bs, f);
        *(uint4*)(zs + ZI(b, t8)) = pack8(f);
      }
    }
    __syncthreads();
    const float scale = 1.f / (red[0] + red[1] + red[2] + red[3] + 1e-6f);
    const float skip = p.hy_skip[(l * 2 + o) * 512 + c];
    f32x16 acc[2][2];
#pragma unroll
    for (int a = 0; a < 2; ++a)
#pragma unroll
      for (int b = 0; b < 2; ++b)
#pragma unroll
        for (int q = 0; q < 16; ++q) acc[a][b][q] = 0.f;
    const int I0 = wave * 16;
    const int Il0 = I0 + (r >> 2), Il1 = I0 + 8 + (r >> 2);
    const u16* zb = zs + (r & 3) * ZB + 8 * h;
    const int ybase = 4096 - r + 8 * h + 48;
    bf16x8 F0, F1, F2, F3, F4, F5;
    const uint32_t ysh = (uint32_t)((ybase & 1) * 16);
    {
      const int y0 = ybase - 64 * (I0 - 63);
      F0 = ld_win8(krr, y0, ysh); F1 = ld_win8(krr, y0 - 16, ysh); F2 = ld_win8(krr, y0 - 32, ysh);
      F3 = ld_win8(krr, y0 - 48, ysh); F4 = ld_win8(krr, y0 - 64, ysh); F5 = ld_win8(krr, y0 - 80, ysh);
    }
#pragma unroll 1
    for (int D = I0 - 63; D <= I0 + 15; ++D) {
      bf16x8 B0[4], B1[4];
      {
        int J0 = Il0 - D, J1 = Il1 - D;
        bool ok0 = (unsigned)J0 < 64u, ok1 = (unsigned)J1 < 64u;
        const u16* zp0 = zb + ZJ * J0; const u16* zp1 = zb + ZJ * J1;
#pragma unroll
        for (int ks = 0; ks < 4; ++ks) {
          bf16x8 z0 = {0, 0, 0, 0, 0, 0, 0, 0}, z1 = {0, 0, 0, 0, 0, 0, 0, 0};
          if (ok0) z0 = *(const bf16x8*)(zp0 + 16 * ks);
          if (ok1) z1 = *(const bf16x8*)(zp1 + 16 * ks);
          B0[ks] = z0; B1[ks] = z1;
        }
      }
      acc[0][0] = __builtin_amdgcn_mfma_f32_32x32x16_bf16(F3, B0[0], acc[0][0], 0, 0, 0);
      acc[0][1] = __builtin_amdgcn_mfma_f32_32x32x16_bf16(F3, B1[0], acc[0][1], 0, 0, 0);
      acc[1][0] = __builtin_amdgcn_mfma_f32_32x32x16_bf16(F5, B0[0], acc[1][0], 0, 0, 0);
      acc[1][1] = __builtin_amdgcn_mfma_f32_32x32x16_bf16(F5, B1[0], acc[1][1], 0, 0, 0);
      acc[0][0] = __builtin_amdgcn_mfma_f32_32x32x16_bf16(F2, B0[1], acc[0][0], 0, 0, 0);
      acc[0][1] = __builtin_amdgcn_mfma_f32_32x32x16_bf16(F2, B1[1], acc[0][1], 0, 0, 0);
      acc[1][0] = __builtin_amdgcn_mfma_f32_32x32x16_bf16(F4, B0[1], acc[1][0], 0, 0, 0);
      acc[1][1] = __builtin_amdgcn_mfma_f32_32x32x16_bf16(F4, B1[1], acc[1][1], 0, 0, 0);
      acc[0][0] = __builtin_amdgcn_mfma_f32_32x32x16_bf16(F1, B0[2], acc[0][0], 0, 0, 0);
      acc[0][1] = __builtin_amdgcn_mfma_f32_32x32x16_bf16(F1, B1[2], acc[0][1], 0, 0, 0);
      acc[1][0] = __builtin_amdgcn_mfma_f32_32x32x16_bf16(F3, B0[2], acc[1][0], 0, 0, 0);
      acc[1][1] = __builtin_amdgcn_mfma_f32_32x32x16_bf16(F3, B1[2], acc[1][1], 0, 0, 0);
      acc[0][0] = __builtin_amdgcn_mfma_f32_32x32x16_bf16(F0, B0[3], acc[0][0], 0, 0, 0);
      acc[0][1] = __builtin_amdgcn_mfma_f32_32x32x16_bf16(F0, B1[3], acc[0][1], 0, 0, 0);
      acc[1][0] = __builtin_amdgcn_mfma_f32_32x32x16_bf16(F2, B0[3], acc[1][0], 0, 0, 0);
      acc[1][1] = __builtin_amdgcn_mfma_f32_32x32x16_bf16(F2, B1[3], acc[1][1], 0, 0, 0);
      F0 = F4; F1 = F5;
      if (D < I0 + 15) {
        const int y1 = ybase - 64 * (D + 1);
        F2 = ld_win8(krr, y1 - 32, ysh); F3 = ld_win8(krr, y1 - 48, ysh);
        F4 = ld_win8(krr, y1 - 64, ysh); F5 = ld_win8(krr, y1 - 80, ysh);
      }
    }
    __syncthreads();
#pragma unroll
    for (int ni = 0; ni < 2; ++ni) {
      u16* zc = zs + (r & 3) * ZB + ZJ * (ni ? Il1 : Il0);
#pragma unroll
      for (int mi = 0; mi < 2; ++mi)
#pragma unroll
        for (int q = 0; q < 16; ++q) {
          int i = 32 * mi + (q & 3) + 8 * (q >> 2) + 4 * h;
          float zo = bf2f(zc[i]);
          zc[i] = f2bf(scale * acc[mi][ni][q] + skip * zo);
        }
    }
    __syncthreads();
    {
      const int ch = (o + 1) * 512 + c;
      const float w0 = cwp[ch], w1 = cwp[1536 + ch], w2 = cwp[3072 + ch], bs = cbp[ch];
#pragma unroll 2
      for (int e = tid; e < 2048; e += 256) {
        int b = e >> 9, t8 = (e & 511) * 8;
        float xg[8], y[8];
        hy_conv3x8(UT + (size_t)ch * NTOK + b * 4096, t8, 4096, w0, w1, w2, bs, xg);
        unpack8(*(const uint4*)(zs + ZI(b, t8)), y);
#pragma unroll
        for (int j = 0; j < 8; ++j) y[j] *= xg[j];
        if (o == 0) *(uint4*)(zs + ZI(b, t8)) = pack8(y);
        else {
          float gf[8]; unpack8(*(const uint4*)(UT + (size_t)(1536 + c) * NTOK + b * 4096 + t8), gf);
#pragma unroll
          for (int j = 0; j < 8; ++j) y[j] *= gf[j];
          *(uint4*)(p.U + (size_t)c * NTOK + b * 4096 + t8) = pack8(y);
        }
      }
    }
    __syncthreads();
  }
  if (l == 0) {
    const int t = tid;
    for (int o = 0; o < 2; ++o) {
      const u16* K = p.KFC + (size_t)(o * 512 + c) * 512;
      float asum = 0.f;
      {
        uint32_t w2 = *(const uint32_t*)(K + tid * 2);
        *(uint32_t*)(krr + tid * 2) = w2;
        asum = fabsf(bflo(w2)) + fabsf(bfhi(w2));
      }
      asum = wave_sum(asum);
      if (lane == 0) red[wave] = asum;
      if (o == 0) {
        const float w0 = cwp[c], w1 = cwp[1536 + c], w2 = cwp[3072 + c], bs = cbp[c];
        if (tid < 128) {
          int b = tid >> 5, t8 = (tid & 31) * 8;
          float f[8];
          hy_conv3x8(UT + (size_t)c * NTOK + NLAT + b * 256, t8, 256, w0, w1, w2, bs, f);
          *(uint4*)(zs + ZI(b, t8)) = pack8(f);
        }
      }
      __syncthreads();
      const float scale = 1.f / (red[0] + red[1] + red[2] + red[3] + 1e-6f);
      float a0 = 0, a1 = 0, a2 = 0, a3 = 0;
      for (int s2 = 0; s2 < 256; ++s2) {
        float kv = bf2f(krr[256 - t + s2]);
        a0 += kv * bf2f(zs[ZI(0, s2)]); a1 += kv * bf2f(zs[ZI(1, s2)]); a2 += kv * bf2f(zs[ZI(2, s2)]); a3 += kv * bf2f(zs[ZI(3, s2)]);
      }
      const float skip = p.hy_skip[(l * 2 + o) * 512 + c];
      float y[4];
      y[0] = scale * a0 + skip * bf2f(zs[ZI(0, t)]); y[1] = scale * a1 + skip * bf2f(zs[ZI(1, t)]);
      y[2] = scale * a2 + skip * bf2f(zs[ZI(2, t)]); y[3] = scale * a3 + skip * bf2f(zs[ZI(3, t)]);
      __syncthreads();
      {
        const int ch = (o + 1) * 512 + c;
        const float w0 = cwp[ch], w1 = cwp[1536 + ch], w2 = cwp[3072 + ch], bs = cbp[ch];
#pragma unroll
        for (int b = 0; b < 4; ++b) {
          const u16* col = UT + (size_t)ch * NTOK + NLAT + b * 256;
          float xg = bs + w1 * bf2f(col[t]);
          if (t > 0) xg += w0 * bf2f(col[t - 1]);
          if (t < 255) xg += w2 * bf2f(col[t + 1]);
          float zn = xg * y[b];
          if (o == 0) zs[ZI(b, t)] = f2bf(zn);
          else {
            size_t R = (size_t)NLAT + b * 256 + t;
            float gate = bf2f(UT[(size_t)(1536 + c) * NTOK + R]);
            p.U[(size_t)c * NTOK + R] = f2bf(zn * gate);
          }
        }
      }
      __syncthreads();
    }
  }
}

__device__ __forceinline__ void fin_rows(const P& p, int l, int chunk) {
  int tid = threadIdx.x; asm volatile("" : "+v"(tid)); const int wave = tid >> 6, lane = tid & 63;
  for (int rr = 0; rr < 16; ++rr) {
    int R = chunk * 64 + wave * 16 + rr;
    {
      uint4* yp = (uint4*)(p.Y2 + (size_t)R * 1024 + lane * 8);
      float o[8]; unpack8(*yp, o);
      float ss = 0;
#pragma unroll
      for (int j = 0; j < 8; ++j) ss += o[j] * o[j];
      ss += __shfl_xor(ss, 1); ss += __shfl_xor(ss, 2); ss += __shfl_xor(ss, 4); ss += __shfl_xor(ss, 8);
      float rinv = rsqrtf(ss * (1.f / 128.f) + EPS);
      float gf[8]; unpack8(*(const uint4*)(p.U + (size_t)NTOK * 2048 + (size_t)R * 2048 + 1024 + lane * 8), gf);
#pragma unroll
      for (int j = 0; j < 8; ++j) o[j] = o[j] * rinv * p.hg_norm_w[l * 512 + lane * 8 + j] * gf[j];
      *yp = pack8(o);
    }
    {
      uint4* yp = (uint4*)(p.Y2 + (size_t)R * 1024 + 512 + lane * 8);
      float o[8]; unpack8(*yp, o);
      float gf[8]; unpack8(*(const uint4*)(p.U + (size_t)NTOK * 2048 + (size_t)R * 2048 + 1536 + lane * 8), gf);
      float ss = 0;
#pragma unroll
      for (int j = 0; j < 8; ++j) { o[j] *= gf[j]; ss += o[j] * o[j]; }
      ss += __shfl_xor(ss, 1); ss += __shfl_xor(ss, 2); ss += __shfl_xor(ss, 4); ss += __shfl_xor(ss, 8); ss += __shfl_xor(ss, 16);
      float rinv = rsqrtf(ss * (1.f / 256.f) + EPS);
#pragma unroll
      for (int j = 0; j < 8; ++j) o[j] = o[j] * rinv * p.m2_norm_w[l * 512 + lane * 8 + j];
      *yp = pack8(o);
    }
  }
}

__device__ __forceinline__ void ph_mixB(const P& p, int l, int bid, int nb, float* sm) {
  for (int t = bid; t < 544 + 512; t += nb) {
    if (t < 544) { if (EN_RG) rg_task<0>(p, l, t, sm); }
    else { if (EN_HY) hy_task(p, l, t - 544, sm); }
    __syncthreads();
  }
}
__device__ __forceinline__ void hy_transpose(const P& p, int tile, u16* sm) {
  int tid = threadIdx.x; asm volatile("" : "+v"(tid));
  const int ct = tile & 7, rt = tile >> 3;
  const int c0 = ct * 64, R0 = rt * 64;
#pragma unroll
  for (int i = 0; i < 2; ++i) {
    int q = tid + 256 * i; int cc = q >> 3, seg = q & 7;
    *(uint4*)(sm + cc * 72 + seg * 8) = *(const uint4*)(p.U + (size_t)(c0 + cc) * NTOK + R0 + seg * 8);
  }
  __syncthreads();
#pragma unroll
  for (int i = 0; i < 2; ++i) {
    int q = tid + 256 * i; int rr = q >> 3, seg = q & 7;
    FragU f;
#pragma unroll
    for (int j = 0; j < 4; ++j)
      f.u[j] = (uint32_t)sm[(seg * 8 + 2 * j) * 72 + rr] | ((uint32_t)sm[(seg * 8 + 2 * j + 1) * 72 + rr] << 16);
    *(uint4*)(p.HL + (size_t)(R0 + rr) * 1024 + c0 + seg * 8) = f.q;
  }
}
__device__ __forceinline__ void ph_mixB2(const P& p, int l, int bid, int nb, float* sm) {
  const int nfin = (l == 0 ? NTOK : NLAT) / 64;
  const int ntr = nfin * 8;
  for (int t = bid; t < 544 + nfin + ntr; t += nb) {
    if (t < 544) { if (EN_RG) rg_task<1>(p, l, t, sm); }
    else if (t < 544 + nfin) fin_rows(p, l, t - 544);
    else hy_transpose(p, t - 544 - nfin, (u16*)sm);
    __syncthreads();
  }
}
__device__ __forceinline__ void ph_final(const P& p, int bid, int nb) {
  int tid = threadIdx.x; asm volatile("" : "+v"(tid)); const int wave = tid >> 6, lane = tid & 63;
  for (int R = bid * 4 + wave; R < NLAT; R += nb * 4) {
    float4* rp = (float4*)(p.out + (size_t)R * 1024);
    float4 v[4]; float ss = 0;
#pragma unroll
    for (int i = 0; i < 4; ++i) {
      v[i] = rp[lane + i * 64];
      ss += v[i].x * v[i].x + v[i].y * v[i].y + v[i].z * v[i].z + v[i].w * v[i].w;
    }
    ss = wave_sum(ss);
    float rinv = rsqrtf(ss * (1.f / 1024.f) + EPS);
#pragma unroll
    for (int i = 0; i < 4; ++i) {
      float4 w = *(const float4*)(p.final_norm_w + (lane + i * 64) * 4);
      float4 o; o.x = v[i].x * rinv * w.x; o.y = v[i].y * rinv * w.y; o.z = v[i].z * rinv * w.z; o.w = v[i].w * rinv * w.w;
      rp[lane + i * 64] = o;
    }
  }
}

#define SMEM_BYTES 57600
__global__ void __launch_bounds__(256, 2) mega(P p) {
  __shared__ __align__(16) unsigned char smem[SMEM_BYTES];
  cg::grid_group grid = cg::this_grid();
  const int bid = blockIdx.x, nb = gridDim.x;
  float* smf = (float*)smem; u16* smh = (u16*)smem;
#ifndef PHM
#define PHM 0xffff
#endif
  if (PHM & 1) ph_mod(p, bid, nb, smf);
  grid.sync();
  for (int l = 0; l < 2; ++l) {
    if (PHM & 2) ph_norm(p, l, bid, nb);
    if (PHM & 4) ph_wconv(p, l, bid, nb, smf);
    grid.sync();
    if (PHM & 16) ph_gemm<0>(p, l, bid, nb, smh);
    grid.sync();
#if PROBE_DUP == 3
    ph_gemm<0>(p, l, bid, nb, smh);
    grid.sync();
#endif
#if PROBE_DUP == 10
    ph_norm(p, l, bid, nb);
    ph_wconv(p, l, bid, nb, smf);
    grid.sync();
#endif
    if (PHM & 32) ph_mixA0(p, l, bid, nb, smem);
    grid.sync();
    if (PHM & 32) ph_mixA1(p, l, bid, nb, smem);
    grid.sync();
#if PROBE_DUP == 8
    ph_mixA0(p, l, bid, nb, smem);
    grid.sync();
    ph_mixA1(p, l, bid, nb, smem);
    grid.sync();
#endif
    if (PHM & 64) ph_gemm<1>(p, l, bid, nb, smh);
    if (PHM & 8) ph_filt(p, l, bid, nb, smf);
    grid.sync();
#if PROBE_DUP == 2
    ph_mixB(p, l, bid, nb, smf);
    grid.sync();
#endif
#if PROBE_DUP == 4
    ph_gemm<1>(p, l, bid, nb, smh);
    grid.sync();
#endif
#if PROBE_DUP == 9
    ph_gemm<1>(p, l, bid, nb, smh, 1);
    grid.sync();
#endif
    if (PHM & 128) ph_mixB(p, l, bid, nb, smf);
    grid.sync();
    if (PHM & 128) ph_mixB2(p, l, bid, nb, smf);
    grid.sync();
#if PROBE_DUP == 7
    for (int t = bid; t < 544; t += nb) { rg_task<1>(p, l, t, smf); __syncthreads(); }
    grid.sync();
#endif
    if (PHM & 256) ph_gemm<2>(p, l, bid, nb, smh);
    grid.sync();
  }
  if (PHM & 512) ph_final(p, bid, nb);
}

extern "C" void kernel_launch(void* const* d_in, const int* in_sizes, int n_in, void* d_out, int out_size,
                              void* d_ws, size_t ws_size, hipStream_t stream) {
  static int grid_blocks = 0;
  if (!grid_blocks) {
    int dev = 0, cus = 0, per_cu = 0;
    hipGetDevice(&dev);
    hipDeviceGetAttribute(&cus, hipDeviceAttributeMultiprocessorCount, dev);
    hipOccupancyMaxActiveBlocksPerMultiprocessor(&per_cu, mega, 256, 0);
    if (per_cu < 1) per_cu = 1;
    if (per_cu > 2) per_cu = 2;
    grid_blocks = cus * per_cu;
  }
  P p{};
  const float** fp = (const float**)&p;
  for (int i = 0; i < 34; ++i) fp[i] = (const float*)d_in[i];
  p.out = (float*)d_out;
  char* w = (char*)d_ws;
  size_t off = 0;
  auto take = [&](size_t bytes) { char* r = w + off; off += (bytes + 255) & ~(size_t)255; return r; };
  p.U = (u16*)take((size_t)NTOK * UW * 2);
  p.HL = (u16*)take((size_t)NTOK * 1024 * 2);
  p.Y2 = (u16*)take((size_t)NTOK * 1024 * 2);
  p.WT = (u16*)take((size_t)7296 * 1024 * 2);
  p.WoT = (u16*)take((size_t)1024 * 2048 * 2);
  p.KF = (u16*)take((size_t)1024 * 8192 * 2);
  p.DT = (float*)take((size_t)NTOK * 8 * 4);
  p.MOD = (float*)take((size_t)2 * 5 * 3072 * 4);
  p.SUM = (float*)take((size_t)4 * 2 * 17 * 512 * 2 * 4);
  {
    char* Z = take((size_t)16777216);
    p.SSH = (float*)Z; p.XC = (float*)(Z + 8388608); p.KFC = (u16*)(Z + 12582912);
  }
  p.PS = (float*)take((size_t)16 * 2 * 8 * 128 * 4);
  p.PA = (float*)take((size_t)16 * 2 * 8 * 4 * 4);
  if (off > ws_size) { fprintf(stderr, "workspace too small: need %zu have %zu\n", off, ws_size); return; }
  void* args[] = {&p};
  hipError_t e = hipLaunchCooperativeKernel((void*)mega, dim3(grid_blocks), dim3(256), args, 0, stream);
  if (e != hipSuccess) fprintf(stderr, "cooperative launch failed: %s (grid %d)\n", hipGetErrorString(e), grid_blocks);
}
```

```cpp
#include <hip/hip_runtime.h>
#include <hip/hip_bf16.h>
#include <hip/hip_cooperative_groups.h>
#include <cstdio>
#include <cstdint>
namespace cg = cooperative_groups;

typedef unsigned short u16;
using bf16x8 = __attribute__((ext_vector_type(8))) short;
using f32x16 = __attribute__((ext_vector_type(16))) float;

#define NTOK 17408
#define NLAT 16384
#define UW 4096
#define EPS 1e-6f

#ifndef PROBE_DUP
#define PROBE_DUP 0
#endif
#ifndef EN_HY
#define EN_HY 1
#endif
#ifndef EN_RG
#define EN_RG 1
#endif
#ifndef EN_HG
#define EN_HG 1
#endif
#ifndef EN_M2
#define EN_M2 1
#endif

struct P {
  const float *x, *c, *ctx, *c_ctx, *w_mod, *b_mod, *norm_w, *w_in, *w_out;
  const float *hy_conv_w, *hy_conv_b, *hy_w1, *hy_b1, *hy_w2, *hy_b2, *hy_w3, *hy_freq, *hy_skip;
  const float *rg_conv_w, *rg_conv_b, *rg_wa, *rg_ba, *rg_wx, *rg_bx, *rg_lam;
  const float *hg_lb, *hg_norm_w, *m2_conv_w, *m2_conv_b, *m2_dt_bias, *m2_a_log, *m2_d, *m2_norm_w, *final_norm_w;
  float* out;
  u16 *U, *HL, *Y2, *WT, *WoT, *KF, *KFC;
  float *XC, *DT, *MOD, *SUM, *SSH, *PS, *PA;
};

typedef __bf16 bf2_t __attribute__((ext_vector_type(2)));
typedef float f2_t __attribute__((ext_vector_type(2)));
__device__ __forceinline__ uint32_t pack2(float a, float b) {
  f2_t v = {a, b};
  return __builtin_bit_cast(uint32_t, __builtin_convertvector(v, bf2_t));
}
__device__ __forceinline__ u16 f2bf(float f) { return (u16)(pack2(f, f) & 0xffffu); }
__device__ __forceinline__ float bf2f(u16 h) { return __uint_as_float(((uint32_t)h) << 16); }
__device__ __forceinline__ float bflo(uint32_t w) { return __uint_as_float(w << 16); }
__device__ __forceinline__ float bfhi(uint32_t w) { return __uint_as_float(w & 0xffff0000u); }
__device__ __forceinline__ float siluf(float x) { return x * __builtin_amdgcn_rcpf(1.f + __expf(-x)); }
__device__ __forceinline__ float sigmf(float x) { return __builtin_amdgcn_rcpf(1.f + __expf(-x)); }
__device__ __forceinline__ float softplusf(float x) { return x > 20.f ? x : log1pf(__expf(x)); }

__device__ __forceinline__ void unpack8(const uint4& v, float* f) {
  f[0] = bflo(v.x); f[1] = bfhi(v.x); f[2] = bflo(v.y); f[3] = bfhi(v.y);
  f[4] = bflo(v.z); f[5] = bfhi(v.z); f[6] = bflo(v.w); f[7] = bfhi(v.w);
}
__device__ __forceinline__ uint4 pack8(const float* f) {
  uint4 v; v.x = pack2(f[0], f[1]); v.y = pack2(f[2], f[3]); v.z = pack2(f[4], f[5]); v.w = pack2(f[6], f[7]);
  return v;
}
__device__ __forceinline__ float wave_sum(float v) {
#pragma unroll
  for (int o = 32; o >= 1; o >>= 1) v += __shfl_xor(v, o);
  return v;
}

__device__ __forceinline__ int pos2row_seq(int b, int p, int dir) {
  if (p < 256) { int t = dir ? 255 - p : p; return NLAT + b * 256 + t; }
  int j = p - 256; int t = dir ? 4095 - j : j; return b * 4096 + t;
}
__device__ __forceinline__ int pos2row_m2(int b, int p, int dir) {
  if (p < 256) { int t = dir ? 255 - p : p; return NLAT + b * 256 + t; }
  int j = p - 256; int jj = dir ? 4095 - j : j; int c = jj >> 6, r = jj & 63; return b * 4096 + r * 64 + c;
}

__device__ __forceinline__ void ph_mod(const P& p, int bid, int nb, float* sm) {
  int tid = threadIdx.x; asm volatile("" : "+v"(tid));
  for (int task = bid; task < 96; task += nb) {
    int l = task / 48, cgi = task % 48;
    int col = cgi * 64 + (tid & 63);
    int kq = tid >> 6;
    float a0 = 0, a1 = 0, a2 = 0, a3 = 0, a4 = 0;
#pragma unroll 8
    for (int k = kq * 256; k < kq * 256 + 256; ++k) {
      float w = p.w_mod[((size_t)l * 1024 + k) * 3072 + col];
      a0 += siluf(p.c[k]) * w; a1 += siluf(p.c[1024 + k]) * w; a2 += siluf(p.c[2048 + k]) * w;
      a3 += siluf(p.c[3072 + k]) * w; a4 += siluf(p.c_ctx[k]) * w;
    }
    sm[(kq * 5 + 0) * 64 + (tid & 63)] = a0; sm[(kq * 5 + 1) * 64 + (tid & 63)] = a1;
    sm[(kq * 5 + 2) * 64 + (tid & 63)] = a2; sm[(kq * 5 + 3) * 64 + (tid & 63)] = a3;
    sm[(kq * 5 + 4) * 64 + (tid & 63)] = a4;
    __syncthreads();
    if (tid < 64) {
      float bm = p.b_mod[l * 3072 + col];
#pragma unroll
      for (int j = 0; j < 5; ++j) {
        float s = sm[(0 * 5 + j) * 64 + tid] + sm[(1 * 5 + j) * 64 + tid] + sm[(2 * 5 + j) * 64 + tid] + sm[(3 * 5 + j) * 64 + tid];
        p.MOD[(size_t)(l * 5 + j) * 3072 + col] = s + bm;
      }
    }
    __syncthreads();
  }
}

__device__ __forceinline__ void ph_norm(const P& p, int l, int bid, int nb) {
  int tid = threadIdx.x; asm volatile("" : "+v"(tid)); const int wave = tid >> 6, lane = tid & 63;
  for (int R = bid * 4 + wave; R < NTOK; R += nb * 4) {
    const float* src; int mj;
    if (R < NLAT) { src = (l == 0 ? p.x : (const float*)p.out) + (size_t)R * 1024; mj = R >> 12; }
    else { int rc = R - NLAT; src = (l == 0 ? p.ctx : (const float*)p.XC) + (size_t)rc * 1024; mj = 4; }
    const float* mod = p.MOD + (size_t)(l * 5 + mj) * 3072;
    float4 v[4]; float ss = 0;
#pragma unroll
    for (int i = 0; i < 4; ++i) {
      v[i] = ((const float4*)src)[lane + i * 64];
      ss += v[i].x * v[i].x + v[i].y * v[i].y + v[i].z * v[i].z + v[i].w * v[i].w;
    }
    ss = wave_sum(ss);
    float rinv = rsqrtf(ss * (1.f / 1024.f) + EPS);
#pragma unroll
    for (int i = 0; i < 4; ++i) {
      int idx = (lane + i * 64) * 4;
      float4 nw = *(const float4*)(p.norm_w + l * 1024 + idx);
      float4 sh = *(const float4*)(mod + idx);
      float4 sc = *(const float4*)(mod + 1024 + idx);
      float h0 = v[i].x * rinv * nw.x * (1.f + sc.x) + sh.x;
      float h1 = v[i].y * rinv * nw.y * (1.f + sc.y) + sh.y;
      float h2 = v[i].z * rinv * nw.z * (1.f + sc.z) + sh.z;
      float h3 = v[i].w * rinv * nw.w * (1.f + sc.w) + sh.w;
      uint2 o; o.x = pack2(h0, h1); o.y = pack2(h2, h3);
      *(uint2*)(p.HL + (size_t)R * 1024 + idx) = o;
    }
  }
}

__device__ __forceinline__ void ph_wconv(const P& p, int l, int bid, int nb, float* sm) {
  int tid = threadIdx.x; asm volatile("" : "+v"(tid));
  const int T1 = 114 * 16, T2 = 16 * 32;
  for (int t = bid; t < T1 + T2; t += nb) {
    const float* src; int ld, K, n0, k0, sc0, nvalid; u16* dst;
    if (t < T1) {
      int nt = t / 16, kt = t % 16; n0 = nt * 64; k0 = kt * 64;
      src = p.w_in + (size_t)l * 1024 * 7176; ld = 7176; K = 1024; dst = p.WT; nvalid = 64;
      if (n0 < 2048) sc0 = 3072 + n0;
      else if (n0 < 3072) sc0 = 5632 + (n0 - 2048);
      else if (n0 < 3200) { sc0 = 6656 + (n0 - 3072); nvalid = (n0 == 3072) ? 8 : 0; }
      else { int m = n0 - 3200; if (m < 3072) sc0 = m; else if (m < 3584) sc0 = 5120 + (m - 3072); else sc0 = 6664 + (m - 3584); }
    } else {
      int tt = t - T1; int nt = tt / 32, kt = tt % 32; n0 = nt * 64; k0 = kt * 64;
      src = p.w_out + (size_t)l * 2048 * 1024; ld = 1024; K = 2048; dst = p.WoT; nvalid = 64; sc0 = n0;
    }
#pragma unroll
    for (int i = 0; i < 4; ++i) {
      int kk = (tid >> 4) + 16 * i, cc = (tid & 15) * 4;
      const float* sp = src + (size_t)(k0 + kk) * ld + sc0 + cc;
      float4 v;
      if (nvalid == 64) v = *(const float4*)sp;
      else { v.x = (cc + 0 < nvalid) ? sp[0] : 0.f; v.y = (cc + 1 < nvalid) ? sp[1] : 0.f; v.z = (cc + 2 < nvalid) ? sp[2] : 0.f; v.w = (cc + 3 < nvalid) ? sp[3] : 0.f; }
      sm[kk * 65 + cc + 0] = v.x; sm[kk * 65 + cc + 1] = v.y; sm[kk * 65 + cc + 2] = v.z; sm[kk * 65 + cc + 3] = v.w;
    }
    __syncthreads();
#pragma unroll
    for (int i = 0; i < 2; ++i) {
      int q = tid + 256 * i; int nn = q >> 3, ks = q & 7;
      float f[8];
#pragma unroll
      for (int j = 0; j < 8; ++j) f[j] = sm[(ks * 8 + j) * 65 + nn];
      *(uint4*)(dst + (size_t)(n0 + nn) * K + k0 + ks * 8) = pack8(f);
    }
    __syncthreads();
  }
}

__device__ __forceinline__ void ph_filt(const P& p, int l, int bid, int nb, float* sm) {
  int tid = threadIdx.x; asm volatile("" : "+v"(tid));
  const float HY_MIN = -3.0701134573253945f, HY_MAX = -15.350567286626972f;
  int ntask = 256 + (l == 0 ? 16 : 0);
  float* zs = sm; float* h1 = sm + 544; float* h2 = sm + 544 + 1024;
  for (int task = bid; task < ntask; task += nb) {
    int n, t0; u16* K;
    if (task < 256) { n = 4096; t0 = task * 16; K = p.KF; } else { n = 256; t0 = (task - 256) * 16; K = p.KFC; }
    float inv_nm1 = 1.f / (float)(n - 1);
    for (int e = tid; e < 16 * 33; e += 256) {
      int tt = e / 33, f = e % 33; int t = t0 + tt; float val;
      if (f == 0) val = (float)t * inv_nm1;
      else {
        int bi = (f - 1) & 15;
        float band = 1e-4f + (float)bi * ((15.f - 1e-4f) / 15.f);
        float ang = (6.283185307179586f / (float)n) * (float)t * band;
        val = (f <= 16) ? cosf(ang) : -sinf(ang);
      }
      zs[e] = val;
    }
    __syncthreads();
    for (int e = tid; e < 1024; e += 256) {
      int tt = e >> 6, j = e & 63; float acc = p.hy_b1[l * 64 + j];
#pragma unroll 11
      for (int f = 0; f < 33; ++f) acc += zs[tt * 33 + f] * p.hy_w1[(l * 33 + f) * 64 + j];
      h1[e] = sinf(p.hy_freq[l * 64 + j] * acc);
    }
    __syncthreads();
    for (int e = tid; e < 1024; e += 256) {
      int tt = e >> 6, j = e & 63; float acc = p.hy_b2[l * 64 + j];
#pragma unroll 8
      for (int i = 0; i < 64; ++i) acc += h1[tt * 64 + i] * p.hy_w2[(l * 64 + i) * 64 + j];
      h2[e] = sinf(p.hy_freq[l * 64 + j] * acc);
    }
    __syncthreads();
    for (int r = 0; r < 8; ++r) {
      int col = tid + 256 * r; int o = col >> 10, side = (col >> 9) & 1, c = col & 511;
      float w[64];
#pragma unroll
      for (int i = 0; i < 64; ++i) w[i] = p.hy_w3[(size_t)(l * 64 + i) * 2048 + col];
      float delta = fabsf(HY_MIN + (HY_MAX - HY_MIN) * (float)c / 511.f);
      u16* Kc = K + (size_t)(o * 512 + c) * (2 * n);
      for (int tt = 0; tt < 16; ++tt) {
        float acc = 0;
#pragma unroll
        for (int i = 0; i < 64; ++i) acc += h2[tt * 64 + i] * w[i];
        int t = t0 + tt;
        float val = acc * __expf(-(float)t * inv_nm1 * delta);
        int idx;
        if (side == 0) idx = n - t; else { if (t == 0) { idx = 0; val = 0.f; } else idx = n + t; }
        Kc[idx] = f2bf(val);
      }
    }
    __syncthreads();
  }
}

#define LDSTR 72
template <int MODE>
__device__ __forceinline__ void gemm_tile(const P& p, int l, int mt, int nt, u16* sA, u16* sB, int noepi) {
  int tid = threadIdx.x; asm volatile("" : "+v"(tid)); const int wave = tid >> 6, lane = tid & 63;
  const int wm = wave >> 1, wn = wave & 1;
  const int KT = (MODE == 2) ? 2048 : 1024;
  const u16* Bsrc = (MODE == 0) ? p.WT + (size_t)(nt * 128) * 1024
                  : (MODE == 1) ? p.WT + (size_t)(3200 + nt * 128) * 1024
                                : p.WoT + (size_t)(nt * 128) * 2048;
  f32x16 acc[4][2];
#pragma unroll
  for (int a = 0; a < 4; ++a)
#pragma unroll
    for (int b = 0; b < 2; ++b)
#pragma unroll
      for (int r = 0; r < 16; ++r) acc[a][b][r] = 0.f;
  uint4 ra0, ra1, ra2, ra3, ra4, ra5, ra6, ra7, rb0, rb1, rb2, rb3;
  const int lrow = tid >> 3, lseg = tid & 7;
  const u16* Ab0 = p.HL + (size_t)(mt * 256 + lrow) * 1024 + lseg * 8;
  const u16* Ab1 = p.Y2 + (size_t)(mt * 256 + lrow) * 1024 + lseg * 8;
  const u16* Bb = Bsrc + (size_t)lrow * KT + lseg * 8;
#define GLOADS(K0)                                                                                  \
  {                                                                                                 \
    const u16* ap = (MODE == 2 && (K0) >= 1024) ? Ab1 + ((K0) - 1024) : Ab0 + (K0);                 \
    ra0 = *(const uint4*)(ap); ra1 = *(const uint4*)(ap + 32 * 1024);                               \
    ra2 = *(const uint4*)(ap + 64 * 1024); ra3 = *(const uint4*)(ap + 96 * 1024);                   \
    ra4 = *(const uint4*)(ap + 128 * 1024); ra5 = *(const uint4*)(ap + 160 * 1024);                 \
    ra6 = *(const uint4*)(ap + 192 * 1024); ra7 = *(const uint4*)(ap + 224 * 1024);                 \
    const u16* bp = Bb + (K0);                                                                      \
    rb0 = *(const uint4*)(bp); rb1 = *(const uint4*)(bp + (size_t)32 * KT);                         \
    rb2 = *(const uint4*)(bp + (size_t)64 * KT); rb3 = *(const uint4*)(bp + (size_t)96 * KT);       \
  }
  GLOADS(0)
#pragma unroll 1
  for (int k0 = 0; k0 < KT; k0 += 64) {
    *(uint4*)(sA + (lrow + 0) * LDSTR + lseg * 8) = ra0;   *(uint4*)(sA + (lrow + 32) * LDSTR + lseg * 8) = ra1;
    *(uint4*)(sA + (lrow + 64) * LDSTR + lseg * 8) = ra2;  *(uint4*)(sA + (lrow + 96) * LDSTR + lseg * 8) = ra3;
    *(uint4*)(sA + (lrow + 128) * LDSTR + lseg * 8) = ra4; *(uint4*)(sA + (lrow + 160) * LDSTR + lseg * 8) = ra5;
    *(uint4*)(sA + (lrow + 192) * LDSTR + lseg * 8) = ra6; *(uint4*)(sA + (lrow + 224) * LDSTR + lseg * 8) = ra7;
    *(uint4*)(sB + (lrow + 0) * LDSTR + lseg * 8) = rb0;   *(uint4*)(sB + (lrow + 32) * LDSTR + lseg * 8) = rb1;
    *(uint4*)(sB + (lrow + 64) * LDSTR + lseg * 8) = rb2;  *(uint4*)(sB + (lrow + 96) * LDSTR + lseg * 8) = rb3;
    __syncthreads();
    if (k0 + 64 < KT) GLOADS(k0 + 64)
    __builtin_amdgcn_s_setprio(1);
#pragma unroll
    for (int ks = 0; ks < 4; ++ks) {
      bf16x8 fa[4], fb[2];
#pragma unroll
      for (int mi = 0; mi < 4; ++mi)
        fa[mi] = *(const bf16x8*)(sA + (wm * 128 + mi * 32 + (lane & 31)) * LDSTR + ks * 16 + (lane >> 5) * 8);
#pragma unroll
      for (int ni = 0; ni < 2; ++ni)
        fb[ni] = *(const bf16x8*)(sB + (wn * 64 + ni * 32 + (lane & 31)) * LDSTR + ks * 16 + (lane >> 5) * 8);
#pragma unroll
      for (int mi = 0; mi < 4; ++mi)
#pragma unroll
        for (int ni = 0; ni < 2; ++ni)
          acc[mi][ni] = __builtin_amdgcn_mfma_f32_32x32x16_bf16(fa[mi], fb[ni], acc[mi][ni], 0, 0, 0);
    }
    __builtin_amdgcn_s_setprio(0);
    __syncthreads();
  }
  if (noepi) {
    float sacc = 0.f;
#pragma unroll
    for (int a = 0; a < 4; ++a)
#pragma unroll
      for (int b = 0; b < 2; ++b) sacc += acc[a][b][3];
    if (sacc == 1.2345e30f) p.DT[0] = sacc;
    return;
  }
  const int mj = (mt < 64) ? (mt >> 4) : 4;
  const int c31 = lane & 31, hh = lane >> 5;
  const int gcolA = nt * 128 + wn * 64 + c31, gcolB = gcolA + 32;
  if (MODE == 0 && nt == 24) {
    if (wn == 0 && c31 < 8) {
#pragma unroll
      for (int mi = 0; mi < 4; ++mi)
#pragma unroll
        for (int r = 0; r < 16; ++r) {
          const int R = mt * 256 + wm * 128 + mi * 32 + (r & 3) + 8 * (r >> 2) + 4 * hh;
          p.DT[(size_t)R * 8 + c31] = acc[mi][0][r];
        }
    }
    return;
  }
  if (MODE == 1 && nt < 16) {
    const bool sl = (gcolA >> 9) == 3;
#pragma unroll
    for (int mi = 0; mi < 4; ++mi)
#pragma unroll
      for (int ni = 0; ni < 2; ++ni)
#pragma unroll
        for (int g4 = 0; g4 < 4; ++g4) {
          float v0 = acc[mi][ni][4 * g4], v1 = acc[mi][ni][4 * g4 + 1], v2 = acc[mi][ni][4 * g4 + 2], v3 = acc[mi][ni][4 * g4 + 3];
          if (sl) { v0 = siluf(v0); v1 = siluf(v1); v2 = siluf(v2); v3 = siluf(v3); }
          int R0 = mt * 256 + wm * 128 + mi * 32 + 8 * g4 + 4 * hh;
          uint2 o; o.x = pack2(v0, v1); o.y = pack2(v2, v3);
          *(uint2*)(p.U + (size_t)(ni ? gcolB : gcolA) * NTOK + R0) = o;
        }
    return;
  }
  if (MODE != 2) {
    float lbA = 0.f, lbB = 0.f;
    int kindA = 0, kindB = 0;
    if (MODE == 0) {
      int pa_ = gcolA >> 9, pb_ = gcolB >> 9;
      kindA = (pa_ == 0) ? 1 : (pa_ == 1 || pa_ == 2) ? 2 : 0;
      kindB = (pb_ == 0) ? 1 : (pb_ == 1 || pb_ == 2) ? 2 : 0;
      if (l == 1) {
        if (kindA == 2) { int dir = pa_ - 1, ch = gcolA & 511; lbA = 1.f / (1.f + __expf(p.hg_lb[dir * 512 + ch] - p.hg_lb[(2 + dir) * 512 + ch])); }
        if (kindB == 2) { int dir = pb_ - 1, ch = gcolB & 511; lbB = 1.f / (1.f + __expf(p.hg_lb[dir * 512 + ch] - p.hg_lb[(2 + dir) * 512 + ch])); }
      }
    } else {
      int pa_ = gcolA >> 9, pb_ = gcolB >> 9;
      kindA = (pa_ == 3 || pa_ >= 5) ? 3 : 0;
      kindB = (pb_ == 3 || pb_ >= 5) ? 3 : 0;
    }
    u16* stg = sA + wave * (32 * 72);
    u16* dstbase = (MODE == 0) ? p.U + (size_t)(nt * 128 + wn * 64) : p.U + (size_t)NTOK * 2048 + (size_t)(nt * 128 - 2048 + wn * 64);
    const int ldo = (MODE == 0) ? UW : 2048;
#pragma unroll
    for (int mi = 0; mi < 4; ++mi) {
#pragma unroll
      for (int r = 0; r < 16; ++r) {
        const int rl = (r & 3) + 8 * (r >> 2) + 4 * hh;
        float va = acc[mi][0][r], vb = acc[mi][1][r];
        if (kindA == 1) va *= 0.08838834764831845f; else if (kindA == 2) va = (1.f - lbA) * __builtin_amdgcn_rcpf(1.f + __expf(va)); else if (kindA == 3) va = siluf(va);
        if (kindB == 1) vb *= 0.08838834764831845f; else if (kindB == 2) vb = (1.f - lbB) * __builtin_amdgcn_rcpf(1.f + __expf(vb)); else if (kindB == 3) vb = siluf(vb);
        stg[rl * 72 + c31] = f2bf(va);
        stg[rl * 72 + 32 + c31] = f2bf(vb);
      }
#pragma unroll
      for (int it = 0; it < 4; ++it) {
        const int rl = it * 8 + (lane >> 3), seg = lane & 7;
        uint4 v = *(const uint4*)(stg + rl * 72 + seg * 8);
        const int R = mt * 256 + wm * 128 + mi * 32 + rl;
        *(uint4*)(dstbase + (size_t)R * ldo + seg * 8) = v;
      }
    }
    return;
  }
  {
    float* stgf = (float*)sA + wave * (32 * 68);
    const int seg = lane & 15;
    const int gc0 = nt * 128 + wn * 64 + seg * 4;
    const float4 g4v = *(const float4*)(p.MOD + (size_t)(l * 5 + mj) * 3072 + 2048 + gc0);
#pragma unroll
    for (int mi = 0; mi < 4; ++mi) {
#pragma unroll
      for (int r = 0; r < 16; ++r) {
        const int rl = (r & 3) + 8 * (r >> 2) + 4 * hh;
        stgf[rl * 68 + c31] = acc[mi][0][r];
        stgf[rl * 68 + 32 + c31] = acc[mi][1][r];
      }
#pragma unroll
      for (int it = 0; it < 8; ++it) {
        const int rl = it * 4 + (lane >> 4);
        float4 v = *(const float4*)(stgf + rl * 68 + seg * 4);
        const int R = mt * 256 + wm * 128 + mi * 32 + rl;
        const float* src; float* dst;
        if (R < NLAT) { src = ((l == 0) ? p.x : (const float*)p.out) + (size_t)R * 1024 + gc0; dst = p.out + (size_t)R * 1024 + gc0; }
        else { int rc = R - NLAT; src = p.ctx + (size_t)rc * 1024 + gc0; dst = p.XC + (size_t)rc * 1024 + gc0; }
        float4 xv = *(const float4*)src;
        float4 o; o.x = xv.x + g4v.x * v.x; o.y = xv.y + g4v.y * v.y; o.z = xv.z + g4v.z * v.z; o.w = xv.w + g4v.w * v.w;
        *(float4*)dst = o;
      }
    }
  }
}

template <int MODE>
__device__ __forceinline__ void ph_gemm(const P& p, int l, int bid, int nb, u16* sm, int noepi = 0) {
  const int NT = (MODE == 0) ? 25 : (MODE == 1) ? 32 : 8;
  const int MT = (MODE == 2 && l == 1) ? 64 : 68;
  u16* sA = sm; u16* sB = sm + 256 * LDSTR;
  const int xcd = bid & 7, local = bid >> 3, npx = nb >> 3;
  const int mbase = MT >> 3, mextra = MT & 7;
  const int mper = mbase + (xcd < mextra ? 1 : 0);
  const int mstart = (xcd < mextra) ? xcd * (mbase + 1) : mextra * (mbase + 1) + (xcd - mextra) * mbase;
  const int total = mper * NT;
  const int fullb = NT >> 3, rem = NT & 7;
  for (int it = 0;; ++it) {
    int mt, nt;
    if ((nb & 7) == 0) {
      int q = local + npx * it;
      if (q >= total) break;
      int b, i, bw;
      if (q < fullb * mper * 8) { b = q / (mper * 8); i = q - b * mper * 8; bw = 8; }
      else { b = fullb; i = q - fullb * mper * 8; bw = rem; }
      int sub = i / (4 * bw);
      const int nsub = mper >> 2;
      int mt_off, nt_off;
      if (sub < nsub) { int j = i - sub * 4 * bw; mt_off = j & 3; nt_off = j >> 2; }
      else { int j = i - nsub * 4 * bw; sub = nsub; mt_off = 0; nt_off = j; }
      mt = mstart + sub * 4 + mt_off; nt = b * 8 + nt_off;
    } else {
      int t = bid + it * nb;
      if (t >= MT * NT) break;
      nt = t / MT; mt = t % MT;
    }
    __syncthreads();
    gemm_tile<MODE>(p, l, mt, nt, sA, sB, noepi);
  }
  __syncthreads();
}

__device__ __forceinline__ void hg_task(const P& p, int l, int task, float* sm) {
  int tid = threadIdx.x; asm volatile("" : "+v"(tid)); const int wave = tid >> 6, lane = tid & 63;
  const int b = task >> 5, h = (task >> 3) & 3, es = task & 7;
  const int dg = lane & 15, el = lane >> 4;
  float* qs = sm; float* ks = sm + 4096; float* vs = sm + 8192; float* os = sm + 8192 + 512;
  for (int dir = 0; dir < 2; ++dir) {
    float S[8];
#pragma unroll
    for (int r = 0; r < 8; ++r) S[r] = 0.f;
    for (int chunk = 0; chunk < 136; ++chunk) {
#pragma unroll
      for (int i = 0; i < 2; ++i) {
        int q = tid + 256 * i; int pos = q >> 4, seg = q & 15;
        int R = pos2row_seq(b, chunk * 32 + pos, dir);
        const u16* up = p.U + (size_t)R * UW + h * 128 + seg * 8;
        uint4 qv = *(const uint4*)up;
        uint4 kv = *(const uint4*)(up + 512 + dir * 512);
        float f[8];
        unpack8(qv, f);
        *(float4*)(qs + pos * 128 + seg * 8) = make_float4(f[0], f[1], f[2], f[3]);
        *(float4*)(qs + pos * 128 + seg * 8 + 4) = make_float4(f[4], f[5], f[6], f[7]);
        unpack8(kv, f);
        *(float4*)(ks + pos * 128 + seg * 8) = make_float4(f[0], f[1], f[2], f[3]);
        *(float4*)(ks + pos * 128 + seg * 8 + 4) = make_float4(f[4], f[5], f[6], f[7]);
      }
      {
        int pos = tid >> 3, e2 = (tid & 7) * 2;
        int R = pos2row_seq(b, chunk * 32 + pos, dir);
        uint32_t w = *(const uint32_t*)(p.U + (size_t)R * UW + 1536 + h * 128 + es * 16 + e2);
        vs[pos * 16 + e2] = bflo(w); vs[pos * 16 + e2 + 1] = bfhi(w);
      }
      __syncthreads();
#pragma unroll 4
      for (int i = 0; i < 32; ++i) {
        float4 q0 = *(const float4*)(qs + i * 128 + dg * 8), q1 = *(const float4*)(qs + i * 128 + dg * 8 + 4);
        float4 k0 = *(const float4*)(ks + i * 128 + dg * 8), k1 = *(const float4*)(ks + i * 128 + dg * 8 + 4);
        float v = vs[i * 16 + wave * 4 + el];
        S[0] += k0.x * (v - S[0]); S[1] += k0.y * (v - S[1]); S[2] += k0.z * (v - S[2]); S[3] += k0.w * (v - S[3]);
        S[4] += k1.x * (v - S[4]); S[5] += k1.y * (v - S[5]); S[6] += k1.z * (v - S[6]); S[7] += k1.w * (v - S[7]);
        float o = q0.x * S[0] + q0.y * S[1] + q0.z * S[2] + q0.w * S[3] + q1.x * S[4] + q1.y * S[5] + q1.z * S[6] + q1.w * S[7];
        o += __shfl_xor(o, 1); o += __shfl_xor(o, 2); o += __shfl_xor(o, 4); o += __shfl_xor(o, 8);
        if (dg == 0) os[i * 16 + wave * 4 + el] = o;
      }
      __syncthreads();
      {
        int pos = tid >> 3, e2 = (tid & 7) * 2;
        int R = pos2row_seq(b, chunk * 32 + pos, dir);
        uint32_t* yp = (uint32_t*)(p.Y2 + (size_t)R * 1024 + h * 128 + es * 16 + e2);
        float o0 = os[pos * 16 + e2], o1 = os[pos * 16 + e2 + 1];
        if (dir == 1) { uint32_t w = *yp; o0 += bflo(w); o1 += bfhi(w); }
        *yp = pack2(o0, o1);
      }
    }
    __syncthreads();
  }
}

__device__ __forceinline__ void m2_task(const P& p, int l, int task, float* sm) {
  int tid = threadIdx.x; asm volatile("" : "+v"(tid)); const int wave = tid >> 6, lane = tid & 63;
  const int b = task >> 5, head = (task >> 2) & 7, ps = task & 3;
  const int g = head >> 2;
  const int dg = lane & 15, el = lane >> 4;
  float* Cs = sm; float* Bs = sm + 4096; float* xs = sm + 8192; float* os = sm + 8192 + 512;
  float* dts = sm + 8192 + 1024; float* decs = dts + 32;
  for (int dir = 0; dir < 2; ++dir) {
    const float* cw = p.m2_conv_w + (size_t)(l * 2 + dir) * 4 * 1024;
    const float* cb = p.m2_conv_b + (size_t)(l * 2 + dir) * 1024;
    const float dtb = p.m2_dt_bias[(l * 2 + dir) * 8 + head];
    const float Aneg = -__expf(p.m2_a_log[(l * 2 + dir) * 8 + head]);
    const float Dsk = p.m2_d[(l * 2 + dir) * 8 + head];
    float S[8];
#pragma unroll
    for (int r = 0; r < 8; ++r) S[r] = 0.f;
    for (int chunk = 0; chunk < 136; ++chunk) {
      const int pbase = chunk * 32;
      const int seg0 = (pbase < 256) ? 0 : 256;
#pragma unroll
      for (int i = 0; i < 2; ++i) {
        int q = tid + 256 * i; int pos = q >> 4, seg = q & 15;
        int pp = pbase + pos;
        int chB = 512 + g * 128 + seg * 8, chC = 768 + g * 128 + seg * 8;
        float aB[8], aC[8];
#pragma unroll
        for (int j = 0; j < 8; ++j) { aB[j] = cb[chB + j]; aC[j] = cb[chC + j]; }
#pragma unroll
        for (int tap = 0; tap < 4; ++tap) {
          int pt = pp - 3 + tap;
          if (pt >= seg0) {
            int R = pos2row_m2(b, pt, dir);
            const u16* up = p.U + (size_t)R * UW + 2048;
            uint4 bv = *(const uint4*)(up + chB);
            uint4 cv = *(const uint4*)(up + chC);
            float f[8];
            unpack8(bv, f);
#pragma unroll
            for (int j = 0; j < 8; ++j) aB[j] += cw[tap * 1024 + chB + j] * f[j];
            unpack8(cv, f);
#pragma unroll
            for (int j = 0; j < 8; ++j) aC[j] += cw[tap * 1024 + chC + j] * f[j];
          }
        }
#pragma unroll
        for (int j = 0; j < 8; ++j) { aB[j] = siluf(aB[j]); aC[j] = siluf(aC[j]); }
        *(float4*)(Bs + pos * 128 + seg * 8) = make_float4(aB[0], aB[1], aB[2], aB[3]);
        *(float4*)(Bs + pos * 128 + seg * 8 + 4) = make_float4(aB[4], aB[5], aB[6], aB[7]);
        *(float4*)(Cs + pos * 128 + seg * 8) = make_float4(aC[0], aC[1], aC[2], aC[3]);
        *(float4*)(Cs + pos * 128 + seg * 8 + 4) = make_float4(aC[4], aC[5], aC[6], aC[7]);
      }
      {
        int pos = tid >> 3, e2 = (tid & 7) * 2;
        int pp = pbase + pos;
        int ch = head * 64 + ps * 16 + e2;
        float a0 = cb[ch], a1 = cb[ch + 1];
#pragma unroll
        for (int tap = 0; tap < 4; ++tap) {
          int pt = pp - 3 + tap;
          if (pt >= seg0) {
            int R = pos2row_m2(b, pt, dir);
            uint32_t w = *(const uint32_t*)(p.U + (size_t)R * UW + 2048 + ch);
            a0 += cw[tap * 1024 + ch] * bflo(w); a1 += cw[tap * 1024 + ch + 1] * bfhi(w);
          }
        }
        xs[pos * 16 + e2] = siluf(a0); xs[pos * 16 + e2 + 1] = siluf(a1);
      }
      if (tid < 32) {
        int R = pos2row_m2(b, pbase + tid, dir);
        float dtv = softplusf(p.DT[(size_t)R * 8 + head] + dtb);
        dts[tid] = dtv; decs[tid] = __expf(dtv * Aneg);
      }
      __syncthreads();
#pragma unroll 4
      for (int i = 0; i < 32; ++i) {
        float4 q0 = *(const float4*)(Cs + i * 128 + dg * 8), q1 = *(const float4*)(Cs + i * 128 + dg * 8 + 4);
        float4 k0 = *(const float4*)(Bs + i * 128 + dg * 8), k1 = *(const float4*)(Bs + i * 128 + dg * 8 + 4);
        float xv = xs[i * 16 + wave * 4 + el];
        float a = decs[i]; float v = xv * dts[i];
        S[0] = a * S[0] + k0.x * v; S[1] = a * S[1] + k0.y * v; S[2] = a * S[2] + k0.z * v; S[3] = a * S[3] + k0.w * v;
        S[4] = a * S[4] + k1.x * v; S[5] = a * S[5] + k1.y * v; S[6] = a * S[6] + k1.z * v; S[7] = a * S[7] + k1.w * v;
        float o = q0.x * S[0] + q0.y * S[1] + q0.z * S[2] + q0.w * S[3] + q1.x * S[4] + q1.y * S[5] + q1.z * S[6] + q1.w * S[7];
        o += __shfl_xor(o, 1); o += __shfl_xor(o, 2); o += __shfl_xor(o, 4); o += __shfl_xor(o, 8);
        if (dg == 0) os[i * 16 + wave * 4 + el] = o + Dsk * xv;
      }
      __syncthreads();
      {
        int pos = tid >> 3, e2 = (tid & 7) * 2;
        int R = pos2row_m2(b, pbase + pos, dir);
        uint32_t* yp = (uint32_t*)(p.Y2 + (size_t)R * 1024 + 512 + head * 64 + ps * 16 + e2);
        float o0 = os[pos * 16 + e2], o1 = os[pos * 16 + e2 + 1];
        if (dir == 1) { uint32_t w = *yp; o0 += bflo(w); o1 += bfhi(w); }
        *yp = pack2(o0, o1);
      }
    }
    __syncthreads();
  }
}

#ifndef M2_MFMA
#define M2_MFMA 1
#endif
#define QS 136
#define TS 40
union FragU { bf16x8 v; uint32_t u[4]; uint2 d[2]; uint4 q; };
__device__ __forceinline__ bf16x8 cvt_frag(const f32x16& x, int s2) {
  FragU f;
  f.u[0] = pack2(x[8 * s2 + 0], x[8 * s2 + 1]); f.u[1] = pack2(x[8 * s2 + 2], x[8 * s2 + 3]);
  f.u[2] = pack2(x[8 * s2 + 4], x[8 * s2 + 5]); f.u[3] = pack2(x[8 * s2 + 6], x[8 * s2 + 7]);
  return f.v;
}
__device__ __forceinline__ bf16x8 ld_frag_perm(const u16* base) {
  FragU f; f.d[0] = *(const uint2*)base; f.d[1] = *(const uint2*)(base + 8); return f.v;
}

template <int PASS>
__device__ __forceinline__ void hg_mfma(const P& p, int l, int task, int blk, int dir0, unsigned char* smem) {
  int tid = threadIdx.x; asm volatile("" : "+v"(tid)); const int wave = tid >> 6, lane = tid & 63;
  const int r = lane & 31, hh = lane >> 5;
  const int b = task >> 2, h = task & 3;
  u16* ks = (u16*)smem;
  u16* qs = ks + 32 * QS;
  u16* kT = qs + 32 * QS;
  u16* vT = kT + 128 * TS;
  float* tot = (float*)(vT + 128 * TS);
  float* eg = tot + 256;
  const int dd = tid & 127, half = tid >> 7;
  for (int dir = (PASS == 0 ? dir0 : 0); dir < (PASS == 0 ? dir0 + 1 : 2); ++dir) {
    const int sbd = (PASS == 0) ? blk : ((blk == 0) ? 0 : (dir ? 9 - blk : blk));
    const int c0 = (sbd == 0) ? 0 : 8 + 16 * (sbd - 1);
    const int c1 = (sbd == 0) ? 8 : 8 + 16 * sbd;
    float gsum = 0.f;
    f32x16 S[4];
#pragma unroll
    for (int i = 0; i < 4; ++i)
#pragma unroll
      for (int q = 0; q < 16; ++q) S[i][q] = 0.f;
    if (PASS == 1) {
      for (int qb = 0; qb < sbd; ++qb) {
        const size_t sidx = (size_t)((task * 2 + dir) * 8 + qb);
        if (half == 0) eg[dd] = __expf(p.PS[sidx * 128 + dd]);
        __syncthreads();
        const float* sp = p.SSH + sidx * 16384 + (size_t)wave * 4096 + lane;
#pragma unroll
        for (int dt = 0; dt < 4; ++dt)
#pragma unroll
          for (int q4 = 0; q4 < 4; ++q4) {
            float4 e4 = *(const float4*)(eg + 32 * dt + 8 * q4 + 4 * hh);
            S[dt][4 * q4 + 0] = S[dt][4 * q4 + 0] * e4.x + sp[(dt * 16 + 4 * q4 + 0) * 64];
            S[dt][4 * q4 + 1] = S[dt][4 * q4 + 1] * e4.y + sp[(dt * 16 + 4 * q4 + 1) * 64];
            S[dt][4 * q4 + 2] = S[dt][4 * q4 + 2] * e4.z + sp[(dt * 16 + 4 * q4 + 2) * 64];
            S[dt][4 * q4 + 3] = S[dt][4 * q4 + 3] * e4.w + sp[(dt * 16 + 4 * q4 + 3) * 64];
          }
        __syncthreads();
      }
    }
    uint4 pq0, pq1, pk0, pk1, pv0, pv1;
#define HG_PREFETCH(CH)                                                                     \
    {                                                                                       \
      int pos0 = tid >> 4, seg = tid & 15;                                                  \
      int R0 = pos2row_seq(b, (CH) * 32 + pos0, dir), R1 = pos2row_seq(b, (CH) * 32 + pos0 + 16, dir); \
      const u16* u0 = p.U + (size_t)R0 * UW + h * 128 + seg * 8;                            \
      const u16* u1 = p.U + (size_t)R1 * UW + h * 128 + seg * 8;                            \
      pq0 = *(const uint4*)u0; pq1 = *(const uint4*)u1;                                     \
      pk0 = *(const uint4*)(u0 + 512 + dir * 512); pk1 = *(const uint4*)(u1 + 512 + dir * 512); \
      int Rv = pos2row_seq(b, (CH) * 32 + (tid & 31), dir);                                 \
      const u16* uv = p.U + (size_t)Rv * UW + 1536 + h * 128 + (tid >> 5) * 16;             \
      pv0 = *(const uint4*)uv; pv1 = *(const uint4*)(uv + 8);                               \
    }
    HG_PREFETCH(c0)
#pragma unroll 1
    for (int chunk = c0; chunk < c1; ++chunk) {
      {
        int pos0 = tid >> 4, seg = tid & 15;
        *(uint4*)(qs + pos0 * QS + seg * 8) = pq0; *(uint4*)(qs + (pos0 + 16) * QS + seg * 8) = pq1;
        *(uint4*)(ks + pos0 * QS + seg * 8) = pk0; *(uint4*)(ks + (pos0 + 16) * QS + seg * 8) = pk1;
        FragU f0, f1; f0.q = pv0; f1.q = pv1;
        u16* vw = vT + ((tid >> 5) * 16) * TS + (tid & 31);
#pragma unroll
        for (int j = 0; j < 4; ++j) {
          vw[(2 * j) * TS] = (u16)(f0.u[j] & 0xffffu); vw[(2 * j + 1) * TS] = (u16)(f0.u[j] >> 16);
          vw[(8 + 2 * j) * TS] = (u16)(f1.u[j] & 0xffffu); vw[(8 + 2 * j + 1) * TS] = (u16)(f1.u[j] >> 16);
        }
      }
      __syncthreads();
      if (chunk + 1 < c1) HG_PREFETCH(chunk + 1)
      const int Rout = pos2row_seq(b, chunk * 32 + r, dir);
      u16* yrow = p.Y2 + (size_t)Rout * 1024 + h * 128 + wave * 32 + 4 * hh;
      uint2 yold[4];
      if (PASS == 1 && dir == 1) {
#pragma unroll
        for (int q4 = 0; q4 < 4; ++q4) yold[q4] = *(const uint2*)(yrow + 8 * q4);
      }
      float gl[16];
      {
        float run = 0.f;
#pragma unroll
        for (int i = 0; i < 16; ++i) {
          float kkv = bf2f(ks[(half * 16 + i) * QS + dd]);
          run += __logf(fmaxf(1.f - kkv, 1e-6f));
          gl[i] = run;
        }
        tot[half * 128 + dd] = run;
      }
      __syncthreads();
      {
        const float t0 = tot[dd], t1 = tot[128 + dd];
        const float off = half ? t0 : 0.f;
        const float g31 = t0 + t1;
        float k2[16];
#pragma unroll
        for (int i = 0; i < 16; ++i) {
          const int pos = half * 16 + i;
          const float g = gl[i] + off;
          const float kkv = bf2f(ks[pos * QS + dd]);
          const float qv = bf2f(qs[pos * QS + dd]);
          qs[pos * QS + dd] = f2bf(qv * __expf(g));
          ks[pos * QS + dd] = f2bf(kkv * __expf(fminf(-g, 60.f)));
          k2[i] = kkv * __expf(g31 - g);
        }
        *(uint4*)(kT + dd * TS + half * 16) = pack8(k2);
        *(uint4*)(kT + dd * TS + half * 16 + 8) = pack8(k2 + 8);
        if (half == 0) eg[dd] = __expf(g31);
        gsum += g31;
      }
      __syncthreads();
      f32x16 O;
      if (PASS == 1) {
      f32x16 att;
#pragma unroll
      for (int q = 0; q < 16; ++q) att[q] = 0.f;
#pragma unroll
      for (int k8 = 0; k8 < 8; ++k8) {
        bf16x8 A = *(const bf16x8*)(ks + r * QS + 16 * k8 + 8 * hh);
        bf16x8 B = *(const bf16x8*)(qs + r * QS + 16 * k8 + 8 * hh);
        att = __builtin_amdgcn_mfma_f32_32x32x16_bf16(A, B, att, 0, 0, 0);
      }
#pragma unroll
      for (int q = 0; q < 16; ++q) {
        int sidx = (q & 3) + 8 * (q >> 2) + 4 * hh;
        if (sidx > r) att[q] = 0.f;
      }
#pragma unroll
      for (int q = 0; q < 16; ++q) O[q] = 0.f;
#pragma unroll
      for (int dt = 0; dt < 4; ++dt)
#pragma unroll
        for (int s2 = 0; s2 < 2; ++s2) {
          bf16x8 A = cvt_frag(S[dt], s2);
          bf16x8 B = ld_frag_perm(qs + r * QS + 32 * dt + 16 * s2 + 4 * hh);
          O = __builtin_amdgcn_mfma_f32_32x32x16_bf16(A, B, O, 0, 0, 0);
        }
#pragma unroll
      for (int s2 = 0; s2 < 2; ++s2) {
        bf16x8 A = ld_frag_perm(vT + (32 * wave + r) * TS + 16 * s2 + 4 * hh);
        bf16x8 B = cvt_frag(att, s2);
        O = __builtin_amdgcn_mfma_f32_32x32x16_bf16(A, B, O, 0, 0, 0);
      }
      }
#pragma unroll
      for (int dt = 0; dt < 4; ++dt) {
#pragma unroll
        for (int q4 = 0; q4 < 4; ++q4) {
          float4 e4 = *(const float4*)(eg + 32 * dt + 8 * q4 + 4 * hh);
          S[dt][4 * q4 + 0] *= e4.x; S[dt][4 * q4 + 1] *= e4.y; S[dt][4 * q4 + 2] *= e4.z; S[dt][4 * q4 + 3] *= e4.w;
        }
#pragma unroll
        for (int s2 = 0; s2 < 2; ++s2) {
          bf16x8 A = *(const bf16x8*)(kT + (32 * dt + r) * TS + 16 * s2 + 8 * hh);
          bf16x8 B = *(const bf16x8*)(vT + (32 * wave + r) * TS + 16 * s2 + 8 * hh);
          S[dt] = __builtin_amdgcn_mfma_f32_32x32x16_bf16(A, B, S[dt], 0, 0, 0);
        }
      }
      if (PASS == 1) {
#pragma unroll
      for (int q4 = 0; q4 < 4; ++q4) {
        float o0 = O[4 * q4], o1 = O[4 * q4 + 1], o2 = O[4 * q4 + 2], o3 = O[4 * q4 + 3];
        if (dir == 1) { o0 += bflo(yold[q4].x); o1 += bfhi(yold[q4].x); o2 += bflo(yold[q4].y); o3 += bfhi(yold[q4].y); }
        uint2 ov; ov.x = pack2(o0, o1); ov.y = pack2(o2, o3);
        *(uint2*)(yrow + 8 * q4) = ov;
      }
      }
      __syncthreads();
    }
    if (PASS == 0) {
      const size_t sidx = (size_t)((task * 2 + dir) * 8 + sbd);
      if (half == 0) p.PS[sidx * 128 + dd] = gsum;
      float* sp = p.SSH + sidx * 16384 + (size_t)wave * 4096 + lane;
#pragma unroll
      for (int dt = 0; dt < 4; ++dt)
#pragma unroll
        for (int q = 0; q < 16; ++q) sp[(dt * 16 + q) * 64] = S[dt][q];
    }
    __syncthreads();
  }
}

#if M2_MFMA
#define M2_NTASK 16
template <int PASS>
__device__ __forceinline__ void m2_mfma(const P& p, int l, int task, int blk, int dir0, unsigned char* smem) {
  int tid = threadIdx.x; asm volatile("" : "+v"(tid)); const int wave = tid >> 6, lane = tid & 63;
  const int r = lane & 31, hh = lane >> 5;
  const int b = task >> 2, g = (task >> 1) & 1, hp = task & 1;
  const int hq = wave >> 1, ph = wave & 1;
  const int head = 4 * g + 2 * hp + hq;
  u16* Bm = (u16*)smem;
  u16* Cm = Bm + 32 * QS;
  u16* BmT = Cm + 32 * QS;
  u16* xsT = BmT + 128 * TS;
  float* Gs = (float*)(xsT + 128 * TS);
  float* dts = Gs + 64;
  float* wl = dts + 64;
  const int cp = (lane < 48) ? lane : 47;
  const bool act = lane < 48;
  const int chW = (cp < 16) ? ((4 * g + 2 * hp) * 64 + cp * 8) : (cp < 32) ? (512 + g * 128 + (cp - 16) * 8) : (768 + g * 128 + (cp - 32) * 8);
  const int chU = 2048 + chW;
  float* SSM = (float*)p.KF;
  for (int dir = (PASS == 0 ? dir0 : 0); dir < (PASS == 0 ? dir0 + 1 : 2); ++dir) {
    const int sbd = (PASS == 0) ? blk : ((blk == 0) ? 0 : (dir ? 9 - blk : blk));
    const int c0 = (sbd == 0) ? 0 : 8 + 16 * (sbd - 1);
    const int c1 = (sbd == 0) ? 8 : 8 + 16 * sbd;
    float lsum = 0.f;
    const float* cw = p.m2_conv_w + (size_t)(l * 2 + dir) * 4 * 1024;
    const float* cb = p.m2_conv_b + (size_t)(l * 2 + dir) * 1024;
    if (wave == 0) {
#pragma unroll
      for (int j = 0; j < 8; ++j) {
        wl[(4 * 8 + j) * 64 + lane] = cb[chW + j];
#pragma unroll
        for (int tap = 0; tap < 4; ++tap) wl[(tap * 8 + j) * 64 + lane] = cw[tap * 1024 + chW + j];
      }
    }
    __syncthreads();
    const int hd_t = 4 * g + 2 * hp + ((tid >> 5) & 1);
    const float dtb = p.m2_dt_bias[(l * 2 + dir) * 8 + hd_t];
    const float Aneg_t = -__expf(p.m2_a_log[(l * 2 + dir) * 8 + hd_t]);
    const float Dsk = p.m2_d[(l * 2 + dir) * 8 + head];
    f32x16 S[4];
#pragma unroll
    for (int i = 0; i < 4; ++i)
#pragma unroll
      for (int q = 0; q < 16; ++q) S[i][q] = 0.f;
    if (PASS == 1) {
      for (int qb = 0; qb < sbd; ++qb) {
        const size_t sidx = (size_t)((task * 2 + dir) * 8 + qb);
        const float a = __expf(p.PA[sidx * 4 + wave]);
        const float* sp = SSM + sidx * 16384 + (size_t)wave * 4096 + lane;
#pragma unroll
        for (int nt = 0; nt < 4; ++nt)
#pragma unroll
          for (int q = 0; q < 16; ++q) S[nt][q] = S[nt][q] * a + sp[(nt * 16 + q) * 64];
      }
    }
    uint4 raw0, raw1, raw2, raw3, raw4, raw5, raw6, raw7, raw8, raw9, raw10;
    float dtraw = 0.f;
#define M2_LD1(RW, I, CH)                                                                  \
    {                                                                                      \
      int pt = (CH) * 32 + wave * 8 + (I) - 3;                                             \
      int sg0 = ((CH) * 32 < 256) ? 0 : 256;                                               \
      if (pt >= sg0) { int Rr = pos2row_m2(b, pt, dir); RW = *(const uint4*)(p.U + (size_t)Rr * UW + chU); } \
      else RW = make_uint4(0u, 0u, 0u, 0u);                                                \
    }
#define M2_PREFETCH(CH)                                                                    \
    M2_LD1(raw0, 0, CH) M2_LD1(raw1, 1, CH) M2_LD1(raw2, 2, CH) M2_LD1(raw3, 3, CH) M2_LD1(raw4, 4, CH) M2_LD1(raw5, 5, CH) \
    M2_LD1(raw6, 6, CH) M2_LD1(raw7, 7, CH) M2_LD1(raw8, 8, CH) M2_LD1(raw9, 9, CH) M2_LD1(raw10, 10, CH)            \
    if (tid < 64) { int Rr = pos2row_m2(b, (CH) * 32 + (tid & 31), dir); dtraw = p.DT[(size_t)Rr * 8 + hd_t]; }
    M2_PREFETCH(c0)
#pragma unroll 1
    for (int chunk = c0; chunk < c1; ++chunk) {
      {
#define M2_RAWF(RW, J) (((J) & 1) ? bfhi((RW)) : bflo((RW)))
#define M2_CH(J, C0, C1, C2, C3, C4, C5, C6, C7, C8, C9, C10)                               \
        {                                                                                  \
          const float q0 = wl[(0 * 8 + (J)) * 64 + lane], q1 = wl[(1 * 8 + (J)) * 64 + lane]; \
          const float q2 = wl[(2 * 8 + (J)) * 64 + lane], q3 = wl[(3 * 8 + (J)) * 64 + lane]; \
          const float qb = wl[(4 * 8 + (J)) * 64 + lane];                                  \
          const float v0 = M2_RAWF(C0, J), v1 = M2_RAWF(C1, J), v2 = M2_RAWF(C2, J), v3 = M2_RAWF(C3, J); \
          const float v4 = M2_RAWF(C4, J), v5 = M2_RAWF(C5, J), v6 = M2_RAWF(C6, J), v7 = M2_RAWF(C7, J); \
          const float v8 = M2_RAWF(C8, J), v9 = M2_RAWF(C9, J), v10 = M2_RAWF(C10, J);      \
          float o[8];                                                                      \
          o[0] = siluf(qb + q0 * v0 + q1 * v1 + q2 * v2 + q3 * v3);                        \
          o[1] = siluf(qb + q0 * v1 + q1 * v2 + q2 * v3 + q3 * v4);                        \
          o[2] = siluf(qb + q0 * v2 + q1 * v3 + q2 * v4 + q3 * v5);                        \
          o[3] = siluf(qb + q0 * v3 + q1 * v4 + q2 * v5 + q3 * v6);                        \
          o[4] = siluf(qb + q0 * v4 + q1 * v5 + q2 * v6 + q3 * v7);                        \
          o[5] = siluf(qb + q0 * v5 + q1 * v6 + q2 * v7 + q3 * v8);                        \
          o[6] = siluf(qb + q0 * v6 + q1 * v7 + q2 * v8 + q3 * v9);                        \
          o[7] = siluf(qb + q0 * v7 + q1 * v8 + q2 * v9 + q3 * v10);                       \
          if (act) {                                                                       \
            if (cp < 16) {                                                                 \
              *(uint4*)(xsT + (cp * 8 + (J)) * TS + wave * 8) = pack8(o);                  \
            } else if (cp < 32) {                                                          \
              *(uint4*)(BmT + ((cp - 16) * 8 + (J)) * TS + wave * 8) = pack8(o);           \
              _Pragma("unroll") for (int i = 0; i < 8; ++i) Bm[(wave * 8 + i) * QS + (cp - 16) * 8 + (J)] = f2bf(o[i]); \
            } else {                                                                       \
              _Pragma("unroll") for (int i = 0; i < 8; ++i) Cm[(wave * 8 + i) * QS + (cp - 32) * 8 + (J)] = f2bf(o[i]); \
            }                                                                              \
          }                                                                                \
        }
        M2_CH(0, raw0.x, raw1.x, raw2.x, raw3.x, raw4.x, raw5.x, raw6.x, raw7.x, raw8.x, raw9.x, raw10.x)
        M2_CH(1, raw0.x, raw1.x, raw2.x, raw3.x, raw4.x, raw5.x, raw6.x, raw7.x, raw8.x, raw9.x, raw10.x)
        M2_CH(2, raw0.y, raw1.y, raw2.y, raw3.y, raw4.y, raw5.y, raw6.y, raw7.y, raw8.y, raw9.y, raw10.y)
        M2_CH(3, raw0.y, raw1.y, raw2.y, raw3.y, raw4.y, raw5.y, raw6.y, raw7.y, raw8.y, raw9.y, raw10.y)
        M2_CH(4, raw0.z, raw1.z, raw2.z, raw3.z, raw4.z, raw5.z, raw6.z, raw7.z, raw8.z, raw9.z, raw10.z)
        M2_CH(5, raw0.z, raw1.z, raw2.z, raw3.z, raw4.z, raw5.z, raw6.z, raw7.z, raw8.z, raw9.z, raw10.z)
        M2_CH(6, raw0.w, raw1.w, raw2.w, raw3.w, raw4.w, raw5.w, raw6.w, raw7.w, raw8.w, raw9.w, raw10.w)
        M2_CH(7, raw0.w, raw1.w, raw2.w, raw3.w, raw4.w, raw5.w, raw6.w, raw7.w, raw8.w, raw9.w, raw10.w)
      }
      if (tid < 64) {
        float dtv = softplusf(dtraw + dtb);
        float run = dtv * Aneg_t;
#pragma unroll
        for (int o = 1; o < 32; o <<= 1) { float n = __shfl_up(run, o, 32); if ((tid & 31) >= o) run += n; }
        Gs[tid] = run; dts[tid] = dtv;
      }
      __syncthreads();
      if (chunk + 1 < c1) { M2_PREFETCH(chunk + 1) }
      const int Rout = pos2row_m2(b, chunk * 32 + r, dir);
      u16* yrow = p.Y2 + (size_t)Rout * 1024 + 512 + head * 64 + 32 * ph + 4 * hh;
      uint2 yold[4];
      if (PASS == 1 && dir == 1) {
#pragma unroll
        for (int i = 0; i < 4; ++i) yold[i] = *(const uint2*)(yrow + 8 * i);
      }
      const float* Gw = Gs + hq * 32; const float* dw = dts + hq * 32;
      const float Gt = Gw[r], G31 = Gw[31];
      lsum += G31;
      const u16* xw = xsT + (hq * 64 + ph * 32) * TS;
      f32x16 O0;
      if (PASS == 1) {
      f32x16 att;
#pragma unroll
      for (int q = 0; q < 16; ++q) att[q] = 0.f;
#pragma unroll
      for (int k8 = 0; k8 < 8; ++k8) {
        bf16x8 A = *(const bf16x8*)(Bm + r * QS + 16 * k8 + 8 * hh);
        bf16x8 B = *(const bf16x8*)(Cm + r * QS + 16 * k8 + 8 * hh);
        att = __builtin_amdgcn_mfma_f32_32x32x16_bf16(A, B, att, 0, 0, 0);
      }
#pragma unroll
      for (int q4 = 0; q4 < 4; ++q4) {
        float4 gs4 = *(const float4*)(Gw + 8 * q4 + 4 * hh);
        float4 dt4 = *(const float4*)(dw + 8 * q4 + 4 * hh);
        int s0 = 8 * q4 + 4 * hh;
        att[4 * q4 + 0] = (s0 + 0 <= r) ? att[4 * q4 + 0] * __expf(Gt - gs4.x) * dt4.x : 0.f;
        att[4 * q4 + 1] = (s0 + 1 <= r) ? att[4 * q4 + 1] * __expf(Gt - gs4.y) * dt4.y : 0.f;
        att[4 * q4 + 2] = (s0 + 2 <= r) ? att[4 * q4 + 2] * __expf(Gt - gs4.z) * dt4.z : 0.f;
        att[4 * q4 + 3] = (s0 + 3 <= r) ? att[4 * q4 + 3] * __expf(Gt - gs4.w) * dt4.w : 0.f;
      }
#pragma unroll
      for (int q = 0; q < 16; ++q) O0[q] = 0.f;
#pragma unroll
      for (int nt = 0; nt < 4; ++nt)
#pragma unroll
        for (int s2 = 0; s2 < 2; ++s2) {
          bf16x8 B = ld_frag_perm(Cm + r * QS + 32 * nt + 16 * s2 + 4 * hh);
          O0 = __builtin_amdgcn_mfma_f32_32x32x16_bf16(cvt_frag(S[nt], s2), B, O0, 0, 0, 0);
        }
      {
        const float eGt = __expf(Gt);
#pragma unroll
        for (int q = 0; q < 16; ++q) O0[q] *= eGt;
      }
#pragma unroll
      for (int s2 = 0; s2 < 2; ++s2) {
        bf16x8 B = cvt_frag(att, s2);
        O0 = __builtin_amdgcn_mfma_f32_32x32x16_bf16(ld_frag_perm(xw + r * TS + 16 * s2 + 4 * hh), B, O0, 0, 0, 0);
      }
#pragma unroll
      for (int q = 0; q < 16; ++q) {
        int pp = (q & 3) + 8 * (q >> 2) + 4 * hh;
        O0[q] += Dsk * bf2f(xw[pp * TS + r]);
      }
      }
      {
        const float eG31 = __expf(G31);
#pragma unroll
        for (int nt = 0; nt < 4; ++nt)
#pragma unroll
          for (int q = 0; q < 16; ++q) S[nt][q] *= eG31;
#pragma unroll
        for (int s2 = 0; s2 < 2; ++s2) {
          float ws[8];
          {
            float4 ga = *(const float4*)(Gw + 16 * s2 + 8 * hh), gb = *(const float4*)(Gw + 16 * s2 + 8 * hh + 4);
            float4 da = *(const float4*)(dw + 16 * s2 + 8 * hh), db = *(const float4*)(dw + 16 * s2 + 8 * hh + 4);
            ws[0] = da.x * __expf(G31 - ga.x); ws[1] = da.y * __expf(G31 - ga.y); ws[2] = da.z * __expf(G31 - ga.z); ws[3] = da.w * __expf(G31 - ga.w);
            ws[4] = db.x * __expf(G31 - gb.x); ws[5] = db.y * __expf(G31 - gb.y); ws[6] = db.z * __expf(G31 - gb.z); ws[7] = db.w * __expf(G31 - gb.w);
          }
          bf16x8 Bf0;
          {
            float f[8]; unpack8(*(const uint4*)(xw + r * TS + 16 * s2 + 8 * hh), f);
#pragma unroll
            for (int j = 0; j < 8; ++j) f[j] *= ws[j];
            FragU u; u.q = pack8(f); Bf0 = u.v;
          }
#pragma unroll
          for (int nt = 0; nt < 4; ++nt) {
            bf16x8 A = *(const bf16x8*)(BmT + (32 * nt + r) * TS + 16 * s2 + 8 * hh);
            S[nt] = __builtin_amdgcn_mfma_f32_32x32x16_bf16(A, Bf0, S[nt], 0, 0, 0);
          }
        }
      }
      if (PASS == 1) {
#pragma unroll
      for (int q4 = 0; q4 < 4; ++q4) {
        float o0 = O0[4 * q4], o1 = O0[4 * q4 + 1], o2 = O0[4 * q4 + 2], o3 = O0[4 * q4 + 3];
        if (dir == 1) { o0 += bflo(yold[q4].x); o1 += bfhi(yold[q4].x); o2 += bflo(yold[q4].y); o3 += bfhi(yold[q4].y); }
        uint2 ov; ov.x = pack2(o0, o1); ov.y = pack2(o2, o3);
        *(uint2*)(yrow + 8 * q4) = ov;
      }
      }
      __syncthreads();
    }
    if (PASS == 0) {
      const size_t sidx = (size_t)((task * 2 + dir) * 8 + sbd);
      if (lane == 0) p.PA[sidx * 4 + wave] = lsum;
      float* sp = SSM + sidx * 16384 + (size_t)wave * 4096 + lane;
#pragma unroll
      for (int nt = 0; nt < 4; ++nt)
#pragma unroll
        for (int q = 0; q < 16; ++q) sp[(nt * 16 + q) * 64] = S[nt][q];
    }
    __syncthreads();
  }
}
#endif
__device__ __forceinline__ void ph_mixA0(const P& p, int l, int bid, int nb, unsigned char* sm) {
  for (int t = bid; t < 512; t += nb) {
    if (t < 256) hg_mfma<0>(p, l, t >> 4, (t >> 1) & 7, t & 1, sm);
    else { int u = t - 256; m2_mfma<0>(p, l, u >> 4, (u >> 1) & 7, u & 1, sm); }
    __syncthreads();
  }
}
__device__ __forceinline__ void ph_mixA1(const P& p, int l, int bid, int nb, unsigned char* sm) {
  for (int t = bid; t < 288; t += nb) {
    if (t < 128) hg_mfma<1>(p, l, t >> 3, 1 + (t & 7), 0, sm);
    else if (t < 256) { int u = t - 128; m2_mfma<1>(p, l, u >> 3, 1 + (u & 7), 0, sm); }
    else if (t < 272) hg_mfma<1>(p, l, t - 256, 0, 0, sm);
    else m2_mfma<1>(p, l, t - 272, 0, 0, sm);
    __syncthreads();
  }
}

template <int PASS>
__device__ __forceinline__ void rg_task(const P& p, int l, int task, float* sm) {
  int tid = threadIdx.x; asm volatile("" : "+v"(tid));
  const int wave = tid >> 6, lane = tid & 63;
  const int b = task / 136, rem = task % 136, head = rem / 17, sb = rem % 17;
  float* xc = sm;
  float* pa = sm + 2048;
  float* pb = sm + 4096;
  u16* xcb = (u16*)(sm + 6144);
  u16* WTl = xcb + 32 * 72;
  const int j = tid & 63;
  const int spos = tid >> 3, sseg = tid & 7;
  const int sch = head * 64 + sseg * 8;
  const u16* UB2 = p.U + (size_t)NTOK * 2048;
  for (int dir = 0; dir < 2; ++dir) {
    const int ld = l * 2 + dir;
    {
      const float* wa = p.rg_wa + (size_t)(ld * 8 + head) * 4096;
      const float* wx = p.rg_wx + (size_t)(ld * 8 + head) * 4096;
#pragma unroll
      for (int it = 0; it < 4; ++it) {
        int i = (tid >> 4) + 16 * it, j4 = (tid & 15) * 4;
        float4 va = *(const float4*)(wa + i * 64 + j4);
        float4 vx = *(const float4*)(wx + i * 64 + j4);
        WTl[(j4 + 0) * 72 + i] = f2bf(va.x); WTl[(j4 + 1) * 72 + i] = f2bf(va.y);
        WTl[(j4 + 2) * 72 + i] = f2bf(va.z); WTl[(j4 + 3) * 72 + i] = f2bf(va.w);
        WTl[(64 + j4 + 0) * 72 + i] = f2bf(vx.x); WTl[(64 + j4 + 1) * 72 + i] = f2bf(vx.y);
        WTl[(64 + j4 + 2) * 72 + i] = f2bf(vx.z); WTl[(64 + j4 + 3) * 72 + i] = f2bf(vx.w);
      }
    }
    float wcv[4][8], bcv[8];
#pragma unroll
    for (int jj = 0; jj < 8; ++jj) {
      bcv[jj] = p.rg_conv_b[(size_t)ld * 512 + sch + jj];
#pragma unroll
      for (int tap = 0; tap < 4; ++tap) wcv[tap][jj] = p.rg_conv_w[((size_t)ld * 4 + tap) * 512 + sch + jj];
    }
    const int chg = head * 64 + j;
    const float g_ba = p.rg_ba[ld * 512 + chg], g_bx = p.rg_bx[ld * 512 + chg];
    const float g_sp = -8.0f * softplusf(-p.rg_lam[ld * 512 + chg]);
    const int sbd = (PASS == 0) ? sb : (dir ? (sb == 0 ? 0 : 17 - sb) : sb);
    float hcarry = 0.f, aprod = 1.f;
    if (PASS == 1 && tid < 64) {
      float2 sv[16];
#pragma unroll
      for (int q = 0; q < 16; ++q) {
        const float2* sp = (const float2*)(p.SUM + ((((size_t)b * 2 + dir) * 17 + q) * 512 + head * 64 + tid) * 2);
        sv[q] = (q < sbd) ? *sp : make_float2(1.f, 0.f);
      }
#pragma unroll
      for (int q = 0; q < 16; ++q) hcarry = sv[q].x * hcarry + sv[q].y;
    }
    uint4 xr0, xr1, xr2, xr3;
#define RG_LD1(XR, TAP, CH)                                                               \
    {                                                                                     \
      int pt = (CH) * 32 + spos - 3 + (TAP);                                              \
      int sg0 = ((CH) * 32 < 256) ? 0 : 256;                                              \
      if (pt >= sg0) { int Rr = pos2row_seq(b, pt, dir); XR = *(const uint4*)(UB2 + (size_t)Rr * 2048 + sch); } \
      else XR = make_uint4(0u, 0u, 0u, 0u);                                               \
    }
#define RG_PREFETCH(CH) RG_LD1(xr0, 0, CH) RG_LD1(xr1, 1, CH) RG_LD1(xr2, 2, CH) RG_LD1(xr3, 3, CH)
    RG_PREFETCH(sbd * 8)
#pragma unroll 1
    for (int chunk = sbd * 8; chunk < sbd * 8 + 8; ++chunk) {
      const int pbase = chunk * 32;
      {
        float a[8], f[8];
#pragma unroll
        for (int jj = 0; jj < 8; ++jj) a[jj] = bcv[jj];
        unpack8(xr0, f);
#pragma unroll
        for (int jj = 0; jj < 8; ++jj) a[jj] += wcv[0][jj] * f[jj];
        unpack8(xr1, f);
#pragma unroll
        for (int jj = 0; jj < 8; ++jj) a[jj] += wcv[1][jj] * f[jj];
        unpack8(xr2, f);
#pragma unroll
        for (int jj = 0; jj < 8; ++jj) a[jj] += wcv[2][jj] * f[jj];
        unpack8(xr3, f);
#pragma unroll
        for (int jj = 0; jj < 8; ++jj) a[jj] += wcv[3][jj] * f[jj];
        *(float4*)(xc + spos * 64 + sseg * 8) = make_float4(a[0], a[1], a[2], a[3]);
        *(float4*)(xc + spos * 64 + sseg * 8 + 4) = make_float4(a[4], a[5], a[6], a[7]);
        *(uint4*)(xcb + spos * 72 + sseg * 8) = pack8(a);
      }
      __syncthreads();
      if (chunk + 1 < sbd * 8 + 8) { RG_PREFETCH(chunk + 1) }
      const int Rout = pos2row_seq(b, pbase + spos, dir);
      uint4* yp = (uint4*)(p.HL + (size_t)Rout * 1024 + 512 + sch);
      uint4 prev, gv;
      if (PASS == 1 && dir == 1) { prev = *yp; gv = *(const uint4*)(UB2 + (size_t)Rout * 2048 + 512 + sch); }
      {
        const int r = lane & 31, hh = lane >> 5;
        f32x16 acc;
#pragma unroll
        for (int q = 0; q < 16; ++q) acc[q] = 0.f;
#pragma unroll
        for (int ks = 0; ks < 4; ++ks) {
          bf16x8 A = *(const bf16x8*)(xcb + r * 72 + 16 * ks + 8 * hh);
          bf16x8 B = *(const bf16x8*)(WTl + (32 * wave + r) * 72 + 16 * ks + 8 * hh);
          acc = __builtin_amdgcn_mfma_f32_32x32x16_bf16(A, B, acc, 0, 0, 0);
        }
        float* dstp = (wave < 2) ? pa : pb;
        const int jc = (wave & 1) * 32 + r;
#pragma unroll
        for (int q = 0; q < 16; ++q) dstp[((q & 3) + 8 * (q >> 2) + 4 * hh) * 64 + jc] = acc[q];
      }
      __syncthreads();
#pragma unroll
      for (int i = 0; i < 8; ++i) {
        int e = tid + 256 * i;
        float r = sigmf(pa[e] + g_ba);
        float gi = sigmf(pb[e] + g_bx);
        float la = g_sp * r;
        float a = __expf(la);
        float bt = sqrtf(fmaxf(1.f - a * a, 0.f)) * gi * xc[e];
        pa[e] = a; pb[e] = bt;
      }
      __syncthreads();
      if (tid < 64) {
        float hh = hcarry;
#pragma unroll 8
        for (int pos = 0; pos < 32; ++pos) { float av = pa[pos * 64 + tid]; hh = av * hh + pb[pos * 64 + tid]; pb[pos * 64 + tid] = hh; aprod *= av; }
        hcarry = hh;
      }
      __syncthreads();
      if (PASS == 1) {
        float hv[8];
#pragma unroll
        for (int jj = 0; jj < 8; ++jj) hv[jj] = pb[spos * 64 + sseg * 8 + jj];
        if (dir == 1) {
          float f[8]; unpack8(prev, f);
          float gf[8]; unpack8(gv, gf);
#pragma unroll
          for (int jj = 0; jj < 8; ++jj) hv[jj] = (hv[jj] + f[jj]) * gf[jj];
        }
        *yp = pack8(hv);
      }
    }
    if (PASS == 0 && tid < 64) {
      float* sp = p.SUM + ((((size_t)b * 2 + dir) * 17 + sbd) * 512 + head * 64 + tid) * 2;
      sp[0] = aprod; sp[1] = hcarry;
    }
    __syncthreads();
  }
}

typedef bf16x8 __attribute__((aligned(2))) bf16x8_u;
typedef uint4 __attribute__((aligned(4))) uint4_a4;
__device__ __forceinline__ bf16x8 ld_win8(const u16* base, int y, uint32_t sh) {
  const uint32_t* wp = (const uint32_t*)base + (y >> 1);
  uint4 w = *(const uint4_a4*)wp;
  uint32_t w4 = wp[4];
  FragU f;
  f.u[0] = __builtin_amdgcn_alignbit(w.y, w.x, sh);
  f.u[1] = __builtin_amdgcn_alignbit(w.z, w.y, sh);
  f.u[2] = __builtin_amdgcn_alignbit(w.w, w.z, sh);
  f.u[3] = __builtin_amdgcn_alignbit(w4, w.w, sh);
  return f.v;
}

__device__ __forceinline__ void hy_conv3x8(const u16* col, int t8, int n, float w0, float w1, float w2, float bias, float* out) {
  float f[8]; unpack8(*(const uint4*)(col + t8), f);
  float prev = (t8 > 0) ? bf2f(col[t8 - 1]) : 0.f;
  float next = (t8 + 8 < n) ? bf2f(col[t8 + 8]) : 0.f;
#pragma unroll
  for (int j = 0; j < 8; ++j) {
    float a = (j == 0) ? prev : f[j - 1];
    float cnx = (j == 7) ? next : f[j + 1];
    out[j] = bias + w0 * a + w1 * f[j] + w2 * cnx;
  }
}

#define ZB 5128
#define ZJ 80
#define ZI(B, T) ((B) * ZB + ((T) >> 6) * ZJ + ((T) & 63))
__device__ __forceinline__ void hy_task(const P& p, int l, int c, float* sm) {
  int tid = threadIdx.x; asm volatile("" : "+v"(tid)); const int wave = tid >> 6, lane = tid & 63;
  const int r = lane & 31, h = lane >> 5;
  u16* krr = (u16*)sm;
  u16* zs = krr + 8192 + 64;
  float* red = (float*)(zs + 4 * ZB);
  const u16* UT = p.U;
  const float* cwp = p.hy_conv_w + (size_t)l * 3 * 1536;
  const float* cbp = p.hy_conv_b + (size_t)l * 1536;
  for (int o = 0; o < 2; ++o) {
    const u16* K = p.KF + (size_t)(o * 512 + c) * 8192;
    float asum = 0.f;
#pragma unroll
    for (int i = 0; i < 4; ++i) {
      int idx = (tid + 256 * i) * 8;
      uint4 v = *(const uint4*)(K + idx);
      *(uint4*)(krr + idx) = v;
      float f[8]; unpack8(v, f);
#pragma unroll
      for (int j = 0; j < 8; ++j) asum += fabsf(f[j]);
    }
    asum = wave_sum(asum);
    if (lane == 0) red[wave] = asum;
    if (o == 0) {
      const float w0 = cwp[c], w1 = cwp[1536 + c], w2 = cwp[3072 + c], bs = cbp[c];
#pragma unroll 2
      for (int e = tid; e < 2048; e += 256) {
        int b = e >> 9, t8 = (e & 511) * 8;
        float f[8];
        hy_conv3x8(UT + (size_t)c * NTOK + b * 4096, t8, 4096, w0, w1, w2, bs, f);
        *(uint4*)(zs + ZI(b, t8)) = pack8(f);
      }
    }
    __syncthreads();
    const float scale = 1.f / (red[0] + red[1] + red[2] + red[3] + 1e-6f);
    const float skip = p.hy_skip[(l * 2 + o) * 512 + c];
    f32x16 acc[2][2];
#pragma unroll
    for (int a = 0; a < 2; ++a)
#pragma unroll
      for (int b = 0; b < 2; ++b)
#pragma unroll
        for (int q = 0; q < 16; ++q) acc[a][b][q] = 0.f;
    const int I0 = wave * 16;
    const int Il0 = I0 + (r >> 2), Il1 = I0 + 8 + (r >> 2);
    const u16* zb = zs + (r & 3) * ZB + 8 * h;
    const int ybase = 4096 - r + 8 * h + 48;
    bf16x8 F0, F1, F2, F3, F4, F5;
    const uint32_t ysh = (uint32_t)((ybase & 1) * 16);
    {
      const int y0 = ybase - 64 * (I0 - 63);
      F0 = ld_win8(krr, y0, ysh); F1 = ld_win8(krr, y0 - 16, ysh); F2 = ld_win8(krr, y0 - 32, ysh);
      F3 = ld_win8(krr, y0 - 48, ysh); F4 = ld_win8(krr, y0 - 64, ysh); F5 = ld_win8(krr, y0 - 80, ysh);
    }
#pragma unroll 1
    for (int D = I0 - 63; D <= I0 + 15; ++D) {
      bf16x8 B0[4], B1[4];
      {
        int J0 = Il0 - D, J1 = Il1 - D;
        bool ok0 = (unsigned)J0 < 64u, ok1 = (unsigned)J1 < 64u;
        const u16* zp0 = zb + ZJ * J0; const u16* zp1 = zb + ZJ * J1;
#pragma unroll
        for (int ks = 0; ks < 4; ++ks) {
          bf16x8 z0 = {0, 0, 0, 0, 0, 0, 0, 0}, z1 = {0, 0, 0, 0, 0, 0, 0, 0};
          if (ok0) z0 = *(const bf16x8*)(zp0 + 16 * ks);
          if (ok1) z1 = *(const bf16x8*)(zp1 + 16 * ks);
          B0[ks] = z0; B1[ks] = z1;
        }
      }
      acc[0][0] = __builtin_amdgcn_mfma_f32_32x32x16_bf16(F3, B0[0], acc[0][0], 0, 0, 0);
      acc[0][1] = __builtin_amdgcn_mfma_f32_32x32x16_bf16(F3, B1[0], acc[0][1], 0, 0, 0);
      acc[1][0] = __builtin_amdgcn_mfma_f32_32x32x16_bf16(F5, B0[0], acc[1][0], 0, 0, 0);
      acc[1][1] = __builtin_amdgcn_mfma_f32_32x32x16_bf16(F5, B1[0], acc[1][1], 0, 0, 0);
      acc[0][0] = __builtin_amdgcn_mfma_f32_32x32x16_bf16(F2, B0[1], acc[0][0], 0, 0, 0);
      acc[0][1] = __builtin_amdgcn_mfma_f32_32x32x16_bf16(F2, B1[1], acc[0][1], 0, 0, 0);
      acc[1][0] = __builtin_amdgcn_mfma_f32_32x32x16_bf16(F4, B0[1], acc[1][0], 0, 0, 0);
      acc[1][1] = __builtin_amdgcn_mfma_f32_32x32x16_bf16(F4, B1[1], acc[1][1], 0, 0, 0);
      acc[0][0] = __builtin_amdgcn_mfma_f32_32x32x16_bf16(F1, B0[2], acc[0][0], 0, 0, 0);
      acc[0][1] = __builtin_amdgcn_mfma_f32_32x32x16_bf16(F1, B1[2], acc[0][1], 0, 0, 0);
      acc[1][0] = __builtin_amdgcn_mfma_f32_32x32x16_bf16(F3, B0[2], acc[1][0], 0, 0, 0);
      acc[1][1] = __builtin_amdgcn_mfma_f32_32x32x16_bf16(F3, B1[2], acc[1][1], 0, 0, 0);
      acc[0][0] = __builtin_amdgcn_mfma_f32_32x32x16_bf16(F0, B0[3], acc[0][0], 0, 0, 0);
      acc[0][1] = __builtin_amdgcn_mfma_f32_32x32x16_bf16(F0, B1[3], acc[0][1], 0, 0, 0);
      acc[1][0] = __builtin_amdgcn_mfma_f32_32x32x16_bf16(F2, B0[3], acc[1][0], 0, 0, 0);
      acc[1][1] = __builtin_amdgcn_mfma_f32_32x32x16_bf16(F2, B1[3], acc[1][1], 0, 0, 0);
      F0 = F4; F1 = F5;
      if (D < I0 + 15) {
        const int y1 = ybase - 64 * (D + 1);
        F2 = ld_win8(krr, y1 - 32, ysh); F3 = ld_win8(krr, y1 - 48, ysh);
        F4 = ld_win8(krr, y1 - 64, ysh); F5 = ld_win8(krr, y1 - 80, ysh);
      }
    }
    __syncthreads();
#pragma unroll
    for (int ni = 0; ni < 2; ++ni) {
      u16* zc = zs + (r & 3) * ZB + ZJ * (ni ? Il1 : Il0);
#pragma unroll
      for (int mi = 0; mi < 2; ++mi)
#pragma unroll
        for (int q = 0; q < 16; ++q) {
          int i = 32 * mi + (q & 3) + 8 * (q >> 2) + 4 * h;
          float zo = bf2f(zc[i]);
          zc[i] = f2bf(scale * acc[mi][ni][q] + skip * zo);
        }
    }
    __syncthreads();
    {
      const int ch = (o + 1) * 512 + c;
      const float w0 = cwp[ch], w1 = cwp[1536 + ch], w2 = cwp[3072 + ch], bs = cbp[ch];
#pragma unroll 2
      for (int e = tid; e < 2048; e += 256) {
        int b = e >> 9, t8 = (e & 511) * 8;
        float xg[8], y[8];
        hy_conv3x8(UT + (size_t)ch * NTOK + b * 4096, t8, 4096, w0, w1, w2, bs, xg);
        unpack8(*(const uint4*)(zs + ZI(b, t8)), y);
#pragma unroll
        for (int j = 0; j < 8; ++j) y[j] *= xg[j];
        if (o == 0) *(uint4*)(zs + ZI(b, t8)) = pack8(y);
        else {
          float gf[8]; unpack8(*(const uint4*)(UT + (size_t)(1536 + c) * NTOK + b * 4096 + t8), gf);
#pragma unroll
          for (int j = 0; j < 8; ++j) y[j] *= gf[j];
          *(uint4*)(p.U + (size_t)c * NTOK + b * 4096 + t8) = pack8(y);
        }
      }
    }
    __syncthreads();
  }
  if (l == 0) {
    const int t = tid;
    for (int o = 0; o < 2; ++o) {
      const u16* K = p.KFC + (size_t)(o * 512 + c) * 512;
      float asum = 0.f;
      {
        uint32_t w2 = *(const uint32_t*)(K + tid * 2);
        *(uint32_t*)(krr + tid * 2) = w2;
        asum = fabsf(bflo(w2)) + fabsf(bfhi(w2));
      }
      asum = wave_sum(asum);
      if (lane == 0) red[wave] = asum;
      if (o == 0) {
        const float w0 = cwp[c], w1 = cwp[1536 + c], w2 = cwp[3072 + c], bs = cbp[c];
        if (tid < 128) {
          int b = tid >> 5, t8 = (tid & 31) * 8;
          float f[8];
          hy_conv3x8(UT + (size_t)c * NTOK + NLAT + b * 256, t8, 256, w0, w1, w2, bs, f);
          *(uint4*)(zs + ZI(b, t8)) = pack8(f);
        }
      }
      __syncthreads();
      const float scale = 1.f / (red[0] + red[1] + red[2] + red[3] + 1e-6f);
      float a0 = 0, a1 = 0, a2 = 0, a3 = 0;
      for (int s2 = 0; s2 < 256; ++s2) {
        float kv = bf2f(krr[256 - t + s2]);
        a0 += kv * bf2f(zs[ZI(0, s2)]); a1 += kv * bf2f(zs[ZI(1, s2)]); a2 += kv * bf2f(zs[ZI(2, s2)]); a3 += kv * bf2f(zs[ZI(3, s2)]);
      }
      const float skip = p.hy_skip[(l * 2 + o) * 512 + c];
      float y[4];
      y[0] = scale * a0 + skip * bf2f(zs[ZI(0, t)]); y[1] = scale * a1 + skip * bf2f(zs[ZI(1, t)]);
      y[2] = scale * a2 + skip * bf2f(zs[ZI(2, t)]); y[3] = scale * a3 + skip * bf2f(zs[ZI(3, t)]);
      __syncthreads();
      {
        const int ch = (o + 1) * 512 + c;
        const float w0 = cwp[ch], w1 = cwp[1536 + ch], w2 = cwp[3072 + ch], bs = cbp[ch];
#pragma unroll
        for (int b = 0; b < 4; ++b) {
          const u16* col = UT + (size_t)ch * NTOK + NLAT + b * 256;
          float xg = bs + w1 * bf2f(col[t]);
          if (t > 0) xg += w0 * bf2f(col[t - 1]);
          if (t < 255) xg += w2 * bf2f(col[t + 1]);
          float zn = xg * y[b];
          if (o == 0) zs[ZI(b, t)] = f2bf(zn);
          else {
            size_t R = (size_t)NLAT + b * 256 + t;
            float gate = bf2f(UT[(size_t)(1536 + c) * NTOK + R]);
            p.U[(size_t)c * NTOK + R] = f2bf(zn * gate);
          }
        }
      }
      __syncthreads();
    }
  }
}

__device__ __forceinline__ void fin_rows(const P& p, int l, int chunk) {
  int tid = threadIdx.x; asm volatile("" : "+v"(tid)); const int wave = tid >> 6, lane = tid & 63;
  for (int rr = 0; rr < 16; ++rr) {
    int R = chunk * 64 + wave * 16 + rr;
    {
      uint4* yp = (uint4*)(p.Y2 + (size_t)R * 1024 + lane * 8);
      float o[8]; unpack8(*yp, o);
      float ss = 0;
#pragma unroll
      for (int j = 0; j < 8; ++j) ss += o[j] * o[j];
      ss += __shfl_xor(ss, 1); ss += __shfl_xor(ss, 2); ss += __shfl_xor(ss, 4); ss += __shfl_xor(ss, 8);
      float rinv = rsqrtf(ss * (1.f / 128.f) + EPS);
      float gf[8]; unpack8(*(const uint4*)(p.U + (size_t)NTOK * 2048 + (size_t)R * 2048 + 1024 + lane * 8), gf);
#pragma unroll
      for (int j = 0; j < 8; ++j) o[j] = o[j] * rinv * p.hg_norm_w[l * 512 + lane * 8 + j] * gf[j];
      *yp = pack8(o);
    }
    {
      uint4* yp = (uint4*)(p.Y2 + (size_t)R * 1024 + 512 + lane * 8);
      float o[8]; unpack8(*yp, o);
      float gf[8]; unpack8(*(const uint4*)(p.U + (size_t)NTOK * 2048 + (size_t)R * 2048 + 1536 + lane * 8), gf);
      float ss = 0;
#pragma unroll
      for (int j = 0; j < 8; ++j) { o[j] *= gf[j]; ss += o[j] * o[j]; }
      ss += __shfl_xor(ss, 1); ss += __shfl_xor(ss, 2); ss += __shfl_xor(ss, 4); ss += __shfl_xor(ss, 8); ss += __shfl_xor(ss, 16);
      float rinv = rsqrtf(ss * (1.f / 256.f) + EPS);
#pragma unroll
      for (int j = 0; j < 8; ++j) o[j] = o[j] * rinv * p.m2_norm_w[l * 512 + lane * 8 + j];
      *yp = pack8(o);
    }
  }
}

__device__ __forceinline__ void ph_mixB(const P& p, int l, int bid, int nb, float* sm) {
  for (int t = bid; t < 544 + 512; t += nb) {
    if (t < 544) { if (EN_RG) rg_task<0>(p, l, t, sm); }
    else { if (EN_HY) hy_task(p, l, t - 544, sm); }
    __syncthreads();
  }
}
__device__ __forceinline__ void hy_transpose(const P& p, int tile, u16* sm) {
  int tid = threadIdx.x; asm volatile("" : "+v"(tid));
  const int ct = tile & 7, rt = tile >> 3;
  const int c0 = ct * 64, R0 = rt * 64;
#pragma unroll
  for (int i = 0; i < 2; ++i) {
    int q = tid + 256 * i; int cc = q >> 3, seg = q & 7;
    *(uint4*)(sm + cc * 72 + seg * 8) = *(const uint4*)(p.U + (size_t)(c0 + cc) * NTOK + R0 + seg * 8);
  }
  __syncthreads();
#pragma unroll
  for (int i = 0; i < 2; ++i) {
    int q = tid + 256 * i; int rr = q >> 3, seg = q & 7;
    FragU f;
#pragma unroll
    for (int j = 0; j < 4; ++j)
      f.u[j] = (uint32_t)sm[(seg * 8 + 2 * j) * 72 + rr] | ((uint32_t)sm[(seg * 8 + 2 * j + 1) * 72 + rr] << 16);
    *(uint4*)(p.HL + (size_t)(R0 + rr) * 1024 + c0 + seg * 8) = f.q;
  }
}
__device__ __forceinline__ void ph_mixB2(const P& p, int l, int bid, int nb, float* sm) {
  const int nfin = (l == 0 ? NTOK : NLAT) / 64;
  const int ntr = nfin * 8;
  for (int t = bid; t < 544 + nfin + ntr; t += nb) {
    if (t < 544) { if (EN_RG) rg_task<1>(p, l, t, sm); }
    else if (t < 544 + nfin) fin_rows(p, l, t - 544);
    else hy_transpose(p, t - 544 - nfin, (u16*)sm);
    __syncthreads();
  }
}
__device__ __forceinline__ void ph_final(const P& p, int bid, int nb) {
  int tid = threadIdx.x; asm volatile("" : "+v"(tid)); const int wave = tid >> 6, lane = tid & 63;
  for (int R = bid * 4 + wave; R < NLAT; R += nb * 4) {
    float4* rp = (float4*)(p.out + (size_t)R * 1024);
    float4 v[4]; float ss = 0;
#pragma unroll
    for (int i = 0; i < 4; ++i) {
      v[i] = rp[lane + i * 64];
      ss += v[i].x * v[i].x + v[i].y * v[i].y + v[i].z * v[i].z + v[i].w * v[i].w;
    }
    ss = wave_sum(ss);
    float rinv = rsqrtf(ss * (1.f / 1024.f) + EPS);
#pragma unroll
    for (int i = 0; i < 4; ++i) {
      float4 w = *(const float4*)(p.final_norm_w + (lane + i * 64) * 4);
      float4 o; o.x = v[i].x * rinv * w.x; o.y = v[i].y * rinv * w.y; o.z = v[i].z * rinv * w.z; o.w = v[i].w * rinv * w.w;
      rp[lane + i * 64] = o;
    }
  }
}

#define SMEM_BYTES 57600
__global__ void __launch_bounds__(256, 2) mega(P p) {
  __shared__ __align__(16) unsigned char smem[SMEM_BYTES];
  cg::grid_group grid = cg::this_grid();
  const int bid = blockIdx.x, nb = gridDim.x;
  float* smf = (float*)smem; u16* smh = (u16*)smem;
#ifndef PHM
#define PHM 0xffff
#endif
  if (PHM & 1) ph_mod(p, bid, nb, smf);
  grid.sync();
  for (int l = 0; l < 2; ++l) {
    if (PHM & 2) ph_norm(p, l, bid, nb);
    if (PHM & 4) ph_wconv(p, l, bid, nb, smf);
    grid.sync();
    if (PHM & 16) ph_gemm<0>(p, l, bid, nb, smh);
    grid.sync();
#if PROBE_DUP == 3
    ph_gemm<0>(p, l, bid, nb, smh);
    grid.sync();
#endif
#if PROBE_DUP == 10
    ph_norm(p, l, bid, nb);
    ph_wconv(p, l, bid, nb, smf);
    grid.sync();
#endif
    if (PHM & 32) ph_mixA0(p, l, bid, nb, smem);
    grid.sync();
    if (PHM & 32) ph_mixA1(p, l, bid, nb, smem);
    grid.sync();
#if PROBE_DUP == 8
    ph_mixA0(p, l, bid, nb, smem);
    grid.sync();
    ph_mixA1(p, l, bid, nb, smem);
    grid.sync();
#endif
    if (PHM & 64) ph_gemm<1>(p, l, bid, nb, smh);
    if (PHM & 8) ph_filt(p, l, bid, nb, smf);
    grid.sync();
#if PROBE_DUP == 2
    ph_mixB(p, l, bid, nb, smf);
    grid.sync();
#endif
#if PROBE_DUP == 4
    ph_gemm<1>(p, l, bid, nb, smh);
    grid.sync();
#endif
#if PROBE_DUP == 9
    ph_gemm<1>(p, l, bid, nb, smh, 1);
    grid.sync();
#endif
    if (PHM & 128) ph_mixB(p, l, bid, nb, smf);
    grid.sync();
    if (PHM & 128) ph_mixB2(p, l, bid, nb, smf);
    grid.sync();
#if PROBE_DUP == 7
    for (int t = bid; t < 544; t += nb) { rg_task<1>(p, l, t, smf); __syncthreads(); }
    grid.sync();
#endif
    if (PHM & 256) ph_gemm<2>(p, l, bid, nb, smh);
    grid.sync();
  }
  if (PHM & 512) ph_final(p, bid, nb);
}

extern "C" void kernel_launch(void* const* d_in, const int* in_sizes, int n_in, void* d_out, int out_size,
                              void* d_ws, size_t ws_size, hipStream_t stream) {
  static int grid_blocks = 0;
  if (!grid_blocks) {
    int dev = 0, cus = 0, per_cu = 0;
    hipGetDevice(&dev);
    hipDeviceGetAttribute(&cus, hipDeviceAttributeMultiprocessorCount, dev);
    hipOccupancyMaxActiveBlocksPerMultiprocessor(&per_cu, mega, 256, 0);
    if (per_cu < 1) per_cu = 1;
    if (per_cu > 2) per_cu = 2;
    grid_blocks = cus * per_cu;
  }
  P p{};
  const float** fp = (const float**)&p;
  for (int i = 0; i < 34; ++i) fp[i] = (const float*)d_in[i];
  p.out = (float*)d_out;
  char* w = (char*)d_ws;
  size_t off = 0;
  auto take = [&](size_t bytes) { char* r = w + off; off += (bytes + 255) & ~(size_t)255; return r; };
  p.U = (u16*)take((size_t)NTOK * UW * 2);
  p.HL = (u16*)take((size_t)NTOK * 1024 * 2);
  p.Y2 = (u16*)take((size_t)NTOK * 1024 * 2);
  p.WT = (u16*)take((size_t)7296 * 1024 * 2);
  p.WoT = (u16*)take((size_t)1024 * 2048 * 2);
  p.KF = (u16*)take((size_t)1024 * 8192 * 2);
  p.DT = (float*)take((size_t)NTOK * 8 * 4);
  p.MOD = (float*)take((size_t)2 * 5 * 3072 * 4);
  p.SUM = (float*)take((size_t)4 * 2 * 17 * 512 * 2 * 4);
  {
    char* Z = take((size_t)16777216);
    p.SSH = (float*)Z; p.XC = (float*)(Z + 8388608); p.KFC = (u16*)(Z + 12582912);
  }
  p.PS = (float*)take((size_t)16 * 2 * 8 * 128 * 4);
  p.PA = (float*)take((size_t)16 * 2 * 8 * 4 * 4);
  if (off > ws_size) { fprintf(stderr, "workspace too small: need %zu have %zu\n", off, ws_size); return; }
  void* args[] = {&p};
  hipError_t e = hipLaunchCooperativeKernel((void*)mega, dim3(grid_blocks), dim3(256), args, 0, stream);
  if (e != hipSuccess) fprintf(stderr, "cooperative launch failed: %s (grid %d)\n", hipGetErrorString(e), grid_blocks);
}
```

```cpp
#include <hip/hip_runtime.h>
#include <hip/hip_bf16.h>
#include <hip/hip_cooperative_groups.h>
#include <cstdio>
#include <cstdint>
namespace cg = cooperative_groups;

typedef unsigned short u16;
using bf16x8 = __attribute__((ext_vector_type(8))) short;
using f32x16 = __attribute__((ext_vector_type(16))) float;

#define NTOK 17408
#define NLAT 16384
#define UW 4096
#define EPS 1e-6f

#ifndef PROBE_DUP
#define PROBE_DUP 0
#endif
#ifndef EN_HY
#define EN_HY 1
#endif
#ifndef EN_RG
#define EN_RG 1
#endif
#ifndef EN_HG
#define EN_HG 1
#endif
#ifndef EN_M2
#define EN_M2 1
#endif

struct P {
  const float *x, *c, *ctx, *c_ctx, *w_mod, *b_mod, *norm_w, *w_in, *w_out;
  const float *hy_conv_w, *hy_conv_b, *hy_w1, *hy_b1, *hy_w2, *hy_b2, *hy_w3, *hy_freq, *hy_skip;
  const float *rg_conv_w, *rg_conv_b, *rg_wa, *rg_ba, *rg_wx, *rg_bx, *rg_lam;
  const float *hg_lb, *hg_norm_w, *m2_conv_w, *m2_conv_b, *m2_dt_bias, *m2_a_log, *m2_d, *m2_norm_w, *final_norm_w;
  float* out;
  u16 *U, *HL, *Y2, *WT, *WoT, *KF, *KFC;
  float *XC, *DT, *MOD, *SUM, *SSH, *PS, *PA;
};

typedef __bf16 bf2_t __attribute__((ext_vector_type(2)));
typedef float f2_t __attribute__((ext_vector_type(2)));
__device__ __forceinline__ uint32_t pack2(float a, float b) {
  f2_t v = {a, b};
  return __builtin_bit_cast(uint32_t, __builtin_convertvector(v, bf2_t));
}
__device__ __forceinline__ u16 f2bf(float f) { return (u16)(pack2(f, f) & 0xffffu); }
__device__ __forceinline__ float bf2f(u16 h) { return __uint_as_float(((uint32_t)h) << 16); }
__device__ __forceinline__ float bflo(uint32_t w) { return __uint_as_float(w << 16); }
__device__ __forceinline__ float bfhi(uint32_t w) { return __uint_as_float(w & 0xffff0000u); }
__device__ __forceinline__ float siluf(float x) { return x * __builtin_amdgcn_rcpf(1.f + __expf(-x)); }
__device__ __forceinline__ float sigmf(float x) { return __builtin_amdgcn_rcpf(1.f + __expf(-x)); }
__device__ __forceinline__ float softplusf(float x) { return x > 20.f ? x : log1pf(__expf(x)); }

__device__ __forceinline__ void unpack8(const uint4& v, float* f) {
  f[0] = bflo(v.x); f[1] = bfhi(v.x); f[2] = bflo(v.y); f[3] = bfhi(v.y);
  f[4] = bflo(v.z); f[5] = bfhi(v.z); f[6] = bflo(v.w); f[7] = bfhi(v.w);
}
__device__ __forceinline__ uint4 pack8(const float* f) {
  uint4 v; v.x = pack2(f[0], f[1]); v.y = pack2(f[2], f[3]); v.z = pack2(f[4], f[5]); v.w = pack2(f[6], f[7]);
  return v;
}
__device__ __forceinline__ float wave_sum(float v) {
#pragma unroll
  for (int o = 32; o >= 1; o >>= 1) v += __shfl_xor(v, o);
  return v;
}

__device__ __forceinline__ int pos2row_seq(int b, int p, int dir) {
  if (p < 256) { int t = dir ? 255 - p : p; return NLAT + b * 256 + t; }
  int j = p - 256; int t = dir ? 4095 - j : j; return b * 4096 + t;
}
__device__ __forceinline__ int pos2row_m2(int b, int p, int dir) {
  if (p < 256) { int t = dir ? 255 - p : p; return NLAT + b * 256 + t; }
  int j = p - 256; int jj = dir ? 4095 - j : j; int c = jj >> 6, r = jj & 63; return b * 4096 + r * 64 + c;
}

__device__ __forceinline__ void ph_mod(const P& p, int bid, int nb, float* sm) {
  int tid = threadIdx.x; asm volatile("" : "+v"(tid));
  for (int task = bid; task < 96; task += nb) {
    int l = task / 48, cgi = task % 48;
    int col = cgi * 64 + (tid & 63);
    int kq = tid >> 6;
    float a0 = 0, a1 = 0, a2 = 0, a3 = 0, a4 = 0;
#pragma unroll 8
    for (int k = kq * 256; k < kq * 256 + 256; ++k) {
      float w = p.w_mod[((size_t)l * 1024 + k) * 3072 + col];
      a0 += siluf(p.c[k]) * w; a1 += siluf(p.c[1024 + k]) * w; a2 += siluf(p.c[2048 + k]) * w;
      a3 += siluf(p.c[3072 + k]) * w; a4 += siluf(p.c_ctx[k]) * w;
    }
    sm[(kq * 5 + 0) * 64 + (tid & 63)] = a0; sm[(kq * 5 + 1) * 64 + (tid & 63)] = a1;
    sm[(kq * 5 + 2) * 64 + (tid & 63)] = a2; sm[(kq * 5 + 3) * 64 + (tid & 63)] = a3;
    sm[(kq * 5 + 4) * 64 + (tid & 63)] = a4;
    __syncthreads();
    if (tid < 64) {
      float bm = p.b_mod[l * 3072 + col];
#pragma unroll
      for (int j = 0; j < 5; ++j) {
        float s = sm[(0 * 5 + j) * 64 + tid] + sm[(1 * 5 + j) * 64 + tid] + sm[(2 * 5 + j) * 64 + tid] + sm[(3 * 5 + j) * 64 + tid];
        p.MOD[(size_t)(l * 5 + j) * 3072 + col] = s + bm;
      }
    }
    __syncthreads();
  }
}

__device__ __forceinline__ void ph_norm(const P& p, int l, int bid, int nb) {
  int tid = threadIdx.x; asm volatile("" : "+v"(tid)); const int wave = tid >> 6, lane = tid & 63;
  for (int R = bid * 4 + wave; R < NTOK; R += nb * 4) {
    const float* src; int mj;
    if (R < NLAT) { src = (l == 0 ? p.x : (const float*)p.out) + (size_t)R * 1024; mj = R >> 12; }
    else { int rc = R - NLAT; src = (l == 0 ? p.ctx : (const float*)p.XC) + (size_t)rc * 1024; mj = 4; }
    const float* mod = p.MOD + (size_t)(l * 5 + mj) * 3072;
    float4 v[4]; float ss = 0;
#pragma unroll
    for (int i = 0; i < 4; ++i) {
      v[i] = ((const float4*)src)[lane + i * 64];
      ss += v[i].x * v[i].x + v[i].y * v[i].y + v[i].z * v[i].z + v[i].w * v[i].w;
    }
    ss = wave_sum(ss);
    float rinv = rsqrtf(ss * (1.f / 1024.f) + EPS);
#pragma unroll
    for (int i = 0; i < 4; ++i) {
      int idx = (lane + i * 64) * 4;
      float4 nw = *(const float4*)(p.norm_w + l * 1024 + idx);
      float4 sh = *(const float4*)(mod + idx);
      float4 sc = *(const float4*)(mod + 1024 + idx);
      float h0 = v[i].x * rinv * nw.x * (1.f + sc.x) + sh.x;
      float h1 = v[i].y * rinv * nw.y * (1.f + sc.y) + sh.y;
      float h2 = v[i].z * rinv * nw.z * (1.f + sc.z) + sh.z;
      float h3 = v[i].w * rinv * nw.w * (1.f + sc.w) + sh.w;
      uint2 o; o.x = pack2(h0, h1); o.y = pack2(h2, h3);
      *(uint2*)(p.HL + (size_t)R * 1024 + idx) = o;
    }
  }
}

__device__ __forceinline__ void ph_wconv(const P& p, int l, int bid, int nb, float* sm) {
  int tid = threadIdx.x; asm volatile("" : "+v"(tid));
  const int T1 = 114 * 16, T2 = 16 * 32;
  for (int t = bid; t < T1 + T2; t += nb) {
    const float* src; int ld, K, n0, k0, sc0, nvalid; u16* dst;
    if (t < T1) {
      int nt = t / 16, kt = t % 16; n0 = nt * 64; k0 = kt * 64;
      src = p.w_in + (size_t)l * 1024 * 7176; ld = 7176; K = 1024; dst = p.WT; nvalid = 64;
      if (n0 < 2048) sc0 = 3072 + n0;
      else if (n0 < 3072) sc0 = 5632 + (n0 - 2048);
      else if (n0 < 3200) { sc0 = 6656 + (n0 - 3072); nvalid = (n0 == 3072) ? 8 : 0; }
      else { int m = n0 - 3200; if (m < 3072) sc0 = m; else if (m < 3584) sc0 = 5120 + (m - 3072); else sc0 = 6664 + (m - 3584); }
    } else {
      int tt = t - T1; int nt = tt / 32, kt = tt % 32; n0 = nt * 64; k0 = kt * 64;
      src = p.w_out + (size_t)l * 2048 * 1024; ld = 1024; K = 2048; dst = p.WoT; nvalid = 64; sc0 = n0;
    }
#pragma unroll
    for (int i = 0; i < 4; ++i) {
      int kk = (tid >> 4) + 16 * i, cc = (tid & 15) * 4;
      const float* sp = src + (size_t)(k0 + kk) * ld + sc0 + cc;
      float4 v;
      if (nvalid == 64) v = *(const float4*)sp;
      else { v.x = (cc + 0 < nvalid) ? sp[0] : 0.f; v.y = (cc + 1 < nvalid) ? sp[1] : 0.f; v.z = (cc + 2 < nvalid) ? sp[2] : 0.f; v.w = (cc + 3 < nvalid) ? sp[3] : 0.f; }
      sm[kk * 65 + cc + 0] = v.x; sm[kk * 65 + cc + 1] = v.y; sm[kk * 65 + cc + 2] = v.z; sm[kk * 65 + cc + 3] = v.w;
    }
    __syncthreads();
#pragma unroll
    for (int i = 0; i < 2; ++i) {
      int q = tid + 256 * i; int nn = q >> 3, ks = q & 7;
      float f[8];
#pragma unroll
      for (int j = 0; j < 8; ++j) f[j] = sm[(ks * 8 + j) * 65 + nn];
      *(uint4*)(dst + (size_t)(n0 + nn) * K + k0 + ks * 8) = pack8(f);
    }
    __syncthreads();
  }
}

__device__ __forceinline__ void ph_filt(const P& p, int l, int bid, int nb, float* sm) {
  int tid = threadIdx.x; asm volatile("" : "+v"(tid));
  const float HY_MIN = -3.0701134573253945f, HY_MAX = -15.350567286626972f;
  int ntask = 256 + (l == 0 ? 16 : 0);
  float* zs = sm; float* h1 = sm + 544; float* h2 = sm + 544 + 1024;
  for (int task = bid; task < ntask; task += nb) {
    int n, t0; u16* K;
    if (task < 256) { n = 4096; t0 = task * 16; K = p.KF; } else { n = 256; t0 = (task - 256) * 16; K = p.KFC; }
    float inv_nm1 = 1.f / (float)(n - 1);
    for (int e = tid; e < 16 * 33; e += 256) {
      int tt = e / 33, f = e % 33; int t = t0 + tt; float val;
      if (f == 0) val = (float)t * inv_nm1;
      else {
        int bi = (f - 1) & 15;
        float band = 1e-4f + (float)bi * ((15.f - 1e-4f) / 15.f);
        float ang = (6.283185307179586f / (float)n) * (float)t * band;
        val = (f <= 16) ? cosf(ang) : -sinf(ang);
      }
      zs[e] = val;
    }
    __syncthreads();
    for (int e = tid; e < 1024; e += 256) {
      int tt = e >> 6, j = e & 63; float acc = p.hy_b1[l * 64 + j];
#pragma unroll 11
      for (int f = 0; f < 33; ++f) acc += zs[tt * 33 + f] * p.hy_w1[(l * 33 + f) * 64 + j];
      h1[e] = sinf(p.hy_freq[l * 64 + j] * acc);
    }
    __syncthreads();
    for (int e = tid; e < 1024; e += 256) {
      int tt = e >> 6, j = e & 63; float acc = p.hy_b2[l * 64 + j];
#pragma unroll 8
      for (int i = 0; i < 64; ++i) acc += h1[tt * 64 + i] * p.hy_w2[(l * 64 + i) * 64 + j];
      h2[e] = sinf(p.hy_freq[l * 64 + j] * acc);
    }
    __syncthreads();
    for (int r = 0; r < 8; ++r) {
      int col = tid + 256 * r; int o = col >> 10, side = (col >> 9) & 1, c = col & 511;
      float w[64];
#pragma unroll
      for (int i = 0; i < 64; ++i) w[i] = p.hy_w3[(size_t)(l * 64 + i) * 2048 + col];
      float delta = fabsf(HY_MIN + (HY_MAX - HY_MIN) * (float)c / 511.f);
      u16* Kc = K + (size_t)(o * 512 + c) * (2 * n);
      for (int tt = 0; tt < 16; ++tt) {
        float acc = 0;
#pragma unroll
        for (int i = 0; i < 64; ++i) acc += h2[tt * 64 + i] * w[i];
        int t = t0 + tt;
        float val = acc * __expf(-(float)t * inv_nm1 * delta);
        int idx;
        if (side == 0) idx = n - t; else { if (t == 0) { idx = 0; val = 0.f; } else idx = n + t; }
        Kc[idx] = f2bf(val);
      }
    }
    __syncthreads();
  }
}

#define LDSTR 72
template <int MODE>
__device__ __forceinline__ void gemm_tile(const P& p, int l, int mt, int nt, u16* sA, u16* sB, int noepi) {
  int tid = threadIdx.x; asm volatile("" : "+v"(tid)); const int wave = tid >> 6, lane = tid & 63;
  const int wm = wave >> 1, wn = wave & 1;
  const int KT = (MODE == 2) ? 2048 : 1024;
  const u16* Bsrc = (MODE == 0) ? p.WT + (size_t)(nt * 128) * 1024
                  : (MODE == 1) ? p.WT + (size_t)(3200 + nt * 128) * 1024
                                : p.WoT + (size_t)(nt * 128) * 2048;
  f32x16 acc[4][2];
#pragma unroll
  for (int a = 0; a < 4; ++a)
#pragma unroll
    for (int b = 0; b < 2; ++b)
#pragma unroll
      for (int r = 0; r < 16; ++r) acc[a][b][r] = 0.f;
  uint4 ra0, ra1, ra2, ra3, ra4, ra5, ra6, ra7, rb0, rb1, rb2, rb3;
  const int lrow = tid >> 3, lseg = tid & 7;
  const u16* Ab0 = p.HL + (size_t)(mt * 256 + lrow) * 1024 + lseg * 8;
  const u16* Ab1 = p.Y2 + (size_t)(mt * 256 + lrow) * 1024 + lseg * 8;
  const u16* Bb = Bsrc + (size_t)lrow * KT + lseg * 8;
#define GLOADS(K0)                                                                                  \
  {                                                                                                 \
    const u16* ap = (MODE == 2 && (K0) >= 1024) ? Ab1 + ((K0) - 1024) : Ab0 + (K0);                 \
    ra0 = *(const uint4*)(ap); ra1 = *(const uint4*)(ap + 32 * 1024);                               \
    ra2 = *(const uint4*)(ap + 64 * 1024); ra3 = *(const uint4*)(ap + 96 * 1024);                   \
    ra4 = *(const uint4*)(ap + 128 * 1024); ra5 = *(const uint4*)(ap + 160 * 1024);                 \
    ra6 = *(const uint4*)(ap + 192 * 1024); ra7 = *(const uint4*)(ap + 224 * 1024);                 \
    const u16* bp = Bb + (K0);                                                                      \
    rb0 = *(const uint4*)(bp); rb1 = *(const uint4*)(bp + (size_t)32 * KT);                         \
    rb2 = *(const uint4*)(bp + (size_t)64 * KT); rb3 = *(const uint4*)(bp + (size_t)96 * KT);       \
  }
  GLOADS(0)
#pragma unroll 1
  for (int k0 = 0; k0 < KT; k0 += 64) {
    *(uint4*)(sA + (lrow + 0) * LDSTR + lseg * 8) = ra0;   *(uint4*)(sA + (lrow + 32) * LDSTR + lseg * 8) = ra1;
    *(uint4*)(sA + (lrow + 64) * LDSTR + lseg * 8) = ra2;  *(uint4*)(sA + (lrow + 96) * LDSTR + lseg * 8) = ra3;
    *(uint4*)(sA + (lrow + 128) * LDSTR + lseg * 8) = ra4; *(uint4*)(sA + (lrow + 160) * LDSTR + lseg * 8) = ra5;
    *(uint4*)(sA + (lrow + 192) * LDSTR + lseg * 8) = ra6; *(uint4*)(sA + (lrow + 224) * LDSTR + lseg * 8) = ra7;
    *(uint4*)(sB + (lrow + 0) * LDSTR + lseg * 8) = rb0;   *(uint4*)(sB + (lrow + 32) * LDSTR + lseg * 8) = rb1;
    *(uint4*)(sB + (lrow + 64) * LDSTR + lseg * 8) = rb2;  *(uint4*)(sB + (lrow + 96) * LDSTR + lseg * 8) = rb3;
    __syncthreads();
    if (k0 + 64 < KT) GLOADS(k0 + 64)
    __builtin_amdgcn_s_setprio(1);
#pragma unroll
    for (int ks = 0; ks < 4; ++ks) {
      bf16x8 fa[4], fb[2];
#pragma unroll
      for (int mi = 0; mi < 4; ++mi)
        fa[mi] = *(const bf16x8*)(sA + (wm * 128 + mi * 32 + (lane & 31)) * LDSTR + ks * 16 + (lane >> 5) * 8);
#pragma unroll
      for (int ni = 0; ni < 2; ++ni)
        fb[ni] = *(const bf16x8*)(sB + (wn * 64 + ni * 32 + (lane & 31)) * LDSTR + ks * 16 + (lane >> 5) * 8);
#pragma unroll
      for (int mi = 0; mi < 4; ++mi)
#pragma unroll
        for (int ni = 0; ni < 2; ++ni)
          acc[mi][ni] = __builtin_amdgcn_mfma_f32_32x32x16_bf16(fa[mi], fb[ni], acc[mi][ni], 0, 0, 0);
    }
    __builtin_amdgcn_s_setprio(0);
    __syncthreads();
  }
  if (noepi) {
    float sacc = 0.f;
#pragma unroll
    for (int a = 0; a < 4; ++a)
#pragma unroll
      for (int b = 0; b < 2; ++b) sacc += acc[a][b][3];
    if (sacc == 1.2345e30f) p.DT[0] = sacc;
    return;
  }
  const int mj = (mt < 64) ? (mt >> 4) : 4;
  const int c31 = lane & 31, hh = lane >> 5;
  const int gcolA = nt * 128 + wn * 64 + c31, gcolB = gcolA + 32;
  if (MODE == 0 && nt == 24) {
    if (wn == 0 && c31 < 8) {
#pragma unroll
      for (int mi = 0; mi < 4; ++mi)
#pragma unroll
        for (int r = 0; r < 16; ++r) {
          const int R = mt * 256 + wm * 128 + mi * 32 + (r & 3) + 8 * (r >> 2) + 4 * hh;
          p.DT[(size_t)R * 8 + c31] = acc[mi][0][r];
        }
    }
    return;
  }
  if (MODE == 1 && nt < 16) {
    const bool sl = (gcolA >> 9) == 3;
#pragma unroll
    for (int mi = 0; mi < 4; ++mi)
#pragma unroll
      for (int ni = 0; ni < 2; ++ni)
#pragma unroll
        for (int g4 = 0; g4 < 4; ++g4) {
          float v0 = acc[mi][ni][4 * g4], v1 = acc[mi][ni][4 * g4 + 1], v2 = acc[mi][ni][4 * g4 + 2], v3 = acc[mi][ni][4 * g4 + 3];
          if (sl) { v0 = siluf(v0); v1 = siluf(v1); v2 = siluf(v2); v3 = siluf(v3); }
          int R0 = mt * 256 + wm * 128 + mi * 32 + 8 * g4 + 4 * hh;
          uint2 o; o.x = pack2(v0, v1); o.y = pack2(v2, v3);
          *(uint2*)(p.U + (size_t)(ni ? gcolB : gcolA) * NTOK + R0) = o;
        }
    return;
  }
  if (MODE != 2) {
    float lbA = 0.f, lbB = 0.f;
    int kindA = 0, kindB = 0;
    if (MODE == 0) {
      int pa_ = gcolA >> 9, pb_ = gcolB >> 9;
      kindA = (pa_ == 0) ? 1 : (pa_ == 1 || pa_ == 2) ? 2 : 0;
      kindB = (pb_ == 0) ? 1 : (pb_ == 1 || pb_ == 2) ? 2 : 0;
      if (l == 1) {
        if (kindA == 2) { int dir = pa_ - 1, ch = gcolA & 511; lbA = 1.f / (1.f + __expf(p.hg_lb[dir * 512 + ch] - p.hg_lb[(2 + dir) * 512 + ch])); }
        if (kindB == 2) { int dir = pb_ - 1, ch = gcolB & 511; lbB = 1.f / (1.f + __expf(p.hg_lb[dir * 512 + ch] - p.hg_lb[(2 + dir) * 512 + ch])); }
      }
    } else {
      int pa_ = gcolA >> 9, pb_ = gcolB >> 9;
      kindA = (pa_ == 3 || pa_ >= 5) ? 3 : 0;
      kindB = (pb_ == 3 || pb_ >= 5) ? 3 : 0;
    }
    u16* stg = sA + wave * (32 * 72);
    u16* dstbase = (MODE == 0) ? p.U + (size_t)(nt * 128 + wn * 64) : p.U + (size_t)NTOK * 2048 + (size_t)(nt * 128 - 2048 + wn * 64);
    const int ldo = (MODE == 0) ? UW : 2048;
#pragma unroll
    for (int mi = 0; mi < 4; ++mi) {
#pragma unroll
      for (int r = 0; r < 16; ++r) {
        const int rl = (r & 3) + 8 * (r >> 2) + 4 * hh;
        float va = acc[mi][0][r], vb = acc[mi][1][r];
        if (kindA == 1) va *= 0.08838834764831845f; else if (kindA == 2) va = (1.f - lbA) * __builtin_amdgcn_rcpf(1.f + __expf(va)); else if (kindA == 3) va = siluf(va);
        if (kindB == 1) vb *= 0.08838834764831845f; else if (kindB == 2) vb = (1.f - lbB) * __builtin_amdgcn_rcpf(1.f + __expf(vb)); else if (kindB == 3) vb = siluf(vb);
        stg[rl * 72 + c31] = f2bf(va);
        stg[rl * 72 + 32 + c31] = f2bf(vb);
      }
#pragma unroll
      for (int it = 0; it < 4; ++it) {
        const int rl = it * 8 + (lane >> 3), seg = lane & 7;
        uint4 v = *(const uint4*)(stg + rl * 72 + seg * 8);
        const int R = mt * 256 + wm * 128 + mi * 32 + rl;
        *(uint4*)(dstbase + (size_t)R * ldo + seg * 8) = v;
      }
    }
    return;
  }
  {
    float* stgf = (float*)sA + wave * (32 * 68);
    const int seg = lane & 15;
    const int gc0 = nt * 128 + wn * 64 + seg * 4;
    const float4 g4v = *(const float4*)(p.MOD + (size_t)(l * 5 + mj) * 3072 + 2048 + gc0);
#pragma unroll
    for (int mi = 0; mi < 4; ++mi) {
#pragma unroll
      for (int r = 0; r < 16; ++r) {
        const int rl = (r & 3) + 8 * (r >> 2) + 4 * hh;
        stgf[rl * 68 + c31] = acc[mi][0][r];
        stgf[rl * 68 + 32 + c31] = acc[mi][1][r];
      }
#pragma unroll
      for (int it = 0; it < 8; ++it) {
        const int rl = it * 4 + (lane >> 4);
        float4 v = *(const float4*)(stgf + rl * 68 + seg * 4);
        const int R = mt * 256 + wm * 128 + mi * 32 + rl;
        const float* src; float* dst;
        if (R < NLAT) { src = ((l == 0) ? p.x : (const float*)p.out) + (size_t)R * 1024 + gc0; dst = p.out + (size_t)R * 1024 + gc0; }
        else { int rc = R - NLAT; src = p.ctx + (size_t)rc * 1024 + gc0; dst = p.XC + (size_t)rc * 1024 + gc0; }
        float4 xv = *(const float4*)src;
        float4 o; o.x = xv.x + g4v.x * v.x; o.y = xv.y + g4v.y * v.y; o.z = xv.z + g4v.z * v.z; o.w = xv.w + g4v.w * v.w;
        *(float4*)dst = o;
      }
    }
  }
}

template <int MODE>
__device__ __forceinline__ void ph_gemm(const P& p, int l, int bid, int nb, u16* sm, int noepi = 0) {
  const int NT = (MODE == 0) ? 25 : (MODE == 1) ? 32 : 8;
  const int MT = (MODE == 2 && l == 1) ? 64 : 68;
  u16* sA = sm; u16* sB = sm + 256 * LDSTR;
  const int xcd = bid & 7, local = bid >> 3, npx = nb >> 3;
  const int mbase = MT >> 3, mextra = MT & 7;
  const int mper = mbase + (xcd < mextra ? 1 : 0);
  const int mstart = (xcd < mextra) ? xcd * (mbase + 1) : mextra * (mbase + 1) + (xcd - mextra) * mbase;
  const int total = mper * NT;
  const int fullb = NT >> 3, rem = NT & 7;
  for (int it = 0;; ++it) {
    int mt, nt;
    if ((nb & 7) == 0) {
      int q = local + npx * it;
      if (q >= total) break;
      int b, i, bw;
      if (q < fullb * mper * 8) { b = q / (mper * 8); i = q - b * mper * 8; bw = 8; }
      else { b = fullb; i = q - fullb * mper * 8; bw = rem; }
      int sub = i / (4 * bw);
      const int nsub = mper >> 2;
      int mt_off, nt_off;
      if (sub < nsub) { int j = i - sub * 4 * bw; mt_off = j & 3; nt_off = j >> 2; }
      else { int j = i - nsub * 4 * bw; sub = nsub; mt_off = 0; nt_off = j; }
      mt = mstart + sub * 4 + mt_off; nt = b * 8 + nt_off;
    } else {
      int t = bid + it * nb;
      if (t >= MT * NT) break;
      nt = t / MT; mt = t % MT;
    }
    __syncthreads();
    gemm_tile<MODE>(p, l, mt, nt, sA, sB, noepi);
  }
  __syncthreads();
}

__device__ __forceinline__ void hg_task(const P& p, int l, int task, float* sm) {
  int tid = threadIdx.x; asm volatile("" : "+v"(tid)); const int wave = tid >> 6, lane = tid & 63;
  const int b = task >> 5, h = (task >> 3) & 3, es = task & 7;
  const int dg = lane & 15, el = lane >> 4;
  float* qs = sm; float* ks = sm + 4096; float* vs = sm + 8192; float* os = sm + 8192 + 512;
  for (int dir = 0; dir < 2; ++dir) {
    float S[8];
#pragma unroll
    for (int r = 0; r < 8; ++r) S[r] = 0.f;
    for (int chunk = 0; chunk < 136; ++chunk) {
#pragma unroll
      for (int i = 0; i < 2; ++i) {
        int q = tid + 256 * i; int pos = q >> 4, seg = q & 15;
        int R = pos2row_seq(b, chunk * 32 + pos, dir);
        const u16* up = p.U + (size_t)R * UW + h * 128 + seg * 8;
        uint4 qv = *(const uint4*)up;
        uint4 kv = *(const uint4*)(up + 512 + dir * 512);
        float f[8];
        unpack8(qv, f);
        *(float4*)(qs + pos * 128 + seg * 8) = make_float4(f[0], f[1], f[2], f[3]);
        *(float4*)(qs + pos * 128 + seg * 8 + 4) = make_float4(f[4], f[5], f[6], f[7]);
        unpack8(kv, f);
        *(float4*)(ks + pos * 128 + seg * 8) = make_float4(f[0], f[1], f[2], f[3]);
        *(float4*)(ks + pos * 128 + seg * 8 + 4) = make_float4(f[4], f[5], f[6], f[7]);
      }
      {
        int pos = tid >> 3, e2 = (tid & 7) * 2;
        int R = pos2row_seq(b, chunk * 32 + pos, dir);
        uint32_t w = *(const uint32_t*)(p.U + (size_t)R * UW + 1536 + h * 128 + es * 16 + e2);
        vs[pos * 16 + e2] = bflo(w); vs[pos * 16 + e2 + 1] = bfhi(w);
      }
      __syncthreads();
#pragma unroll 4
      for (int i = 0; i < 32; ++i) {
        float4 q0 = *(const float4*)(qs + i * 128 + dg * 8), q1 = *(const float4*)(qs + i * 128 + dg * 8 + 4);
        float4 k0 = *(const float4*)(ks + i * 128 + dg * 8), k1 = *(const float4*)(ks + i * 128 + dg * 8 + 4);
        float v = vs[i * 16 + wave * 4 + el];
        S[0] += k0.x * (v - S[0]); S[1] += k0.y * (v - S[1]); S[2] += k0.z * (v - S[2]); S[3] += k0.w * (v - S[3]);
        S[4] += k1.x * (v - S[4]); S[5] += k1.y * (v - S[5]); S[6] += k1.z * (v - S[6]); S[7] += k1.w * (v - S[7]);
        float o = q0.x * S[0] + q0.y * S[1] + q0.z * S[2] + q0.w * S[3] + q1.x * S[4] + q1.y * S[5] + q1.z * S[6] + q1.w * S[7];
        o += __shfl_xor(o, 1); o += __shfl_xor(o, 2); o += __shfl_xor(o, 4); o += __shfl_xor(o, 8);
        if (dg == 0) os[i * 16 + wave * 4 + el] = o;
      }
      __syncthreads();
      {
        int pos = tid >> 3, e2 = (tid & 7) * 2;
        int R = pos2row_seq(b, chunk * 32 + pos, dir);
        uint32_t* yp = (uint32_t*)(p.Y2 + (size_t)R * 1024 + h * 128 + es * 16 + e2);
        float o0 = os[pos * 16 + e2], o1 = os[pos * 16 + e2 + 1];
        if (dir == 1) { uint32_t w = *yp; o0 += bflo(w); o1 += bfhi(w); }
        *yp = pack2(o0, o1);
      }
    }
    __syncthreads();
  }
}

__device__ __forceinline__ void m2_task(const P& p, int l, int task, float* sm) {
  int tid = threadIdx.x; asm volatile("" : "+v"(tid)); const int wave = tid >> 6, lane = tid & 63;
  const int b = task >> 5, head = (task >> 2) & 7, ps = task & 3;
  const int g = head >> 2;
  const int dg = lane & 15, el = lane >> 4;
  float* Cs = sm; float* Bs = sm + 4096; float* xs = sm + 8192; float* os = sm + 8192 + 512;
  float* dts = sm + 8192 + 1024; float* decs = dts + 32;
  for (int dir = 0; dir < 2; ++dir) {
    const float* cw = p.m2_conv_w + (size_t)(l * 2 + dir) * 4 * 1024;
    const float* cb = p.m2_conv_b + (size_t)(l * 2 + dir) * 1024;
    const float dtb = p.m2_dt_bias[(l * 2 + dir) * 8 + head];
    const float Aneg = -__expf(p.m2_a_log[(l * 2 + dir) * 8 + head]);
    const float Dsk = p.m2_d[(l * 2 + dir) * 8 + head];
    float S[8];
#pragma unroll
    for (int r = 0; r < 8; ++r) S[r] = 0.f;
    for (int chunk = 0; chunk < 136; ++chunk) {
      const int pbase = chunk * 32;
      const int seg0 = (pbase < 256) ? 0 : 256;
#pragma unroll
      for (int i = 0; i < 2; ++i) {
        int q = tid + 256 * i; int pos = q >> 4, seg = q & 15;
        int pp = pbase + pos;
        int chB = 512 + g * 128 + seg * 8, chC = 768 + g * 128 + seg * 8;
        float aB[8], aC[8];
#pragma unroll
        for (int j = 0; j < 8; ++j) { aB[j] = cb[chB + j]; aC[j] = cb[chC + j]; }
#pragma unroll
        for (int tap = 0; tap < 4; ++tap) {
          int pt = pp - 3 + tap;
          if (pt >= seg0) {
            int R = pos2row_m2(b, pt, dir);
            const u16* up = p.U + (size_t)R * UW + 2048;
            uint4 bv = *(const uint4*)(up + chB);
            uint4 cv = *(const uint4*)(up + chC);
            float f[8];
            unpack8(bv, f);
#pragma unroll
            for (int j = 0; j < 8; ++j) aB[j] += cw[tap * 1024 + chB + j] * f[j];
            unpack8(cv, f);
#pragma unroll
            for (int j = 0; j < 8; ++j) aC[j] += cw[tap * 1024 + chC + j] * f[j];
          }
        }
#pragma unroll
        for (int j = 0; j < 8; ++j) { aB[j] = siluf(aB[j]); aC[j] = siluf(aC[j]); }
        *(float4*)(Bs + pos * 128 + seg * 8) = make_float4(aB[0], aB[1], aB[2], aB[3]);
        *(float4*)(Bs + pos * 128 + seg * 8 + 4) = make_float4(aB[4], aB[5], aB[6], aB[7]);
        *(float4*)(Cs + pos * 128 + seg * 8) = make_float4(aC[0], aC[1], aC[2], aC[3]);
        *(float4*)(Cs + pos * 128 + seg * 8 + 4) = make_float4(aC[4], aC[5], aC[6], aC[7]);
      }
      {
        int pos = tid >> 3, e2 = (tid & 7) * 2;
        int pp = pbase + pos;
        int ch = head * 64 + ps * 16 + e2;
        float a0 = cb[ch], a1 = cb[ch + 1];
#pragma unroll
        for (int tap = 0; tap < 4; ++tap) {
          int pt = pp - 3 + tap;
          if (pt >= seg0) {
            int R = pos2row_m2(b, pt, dir);
            uint32_t w = *(const uint32_t*)(p.U + (size_t)R * UW + 2048 + ch);
            a0 += cw[tap * 1024 + ch] * bflo(w); a1 += cw[tap * 1024 + ch + 1] * bfhi(w);
          }
        }
        xs[pos * 16 + e2] = siluf(a0); xs[pos * 16 + e2 + 1] = siluf(a1);
      }
      if (tid < 32) {
        int R = pos2row_m2(b, pbase + tid, dir);
        float dtv = softplusf(p.DT[(size_t)R * 8 + head] + dtb);
        dts[tid] = dtv; decs[tid] = __expf(dtv * Aneg);
      }
      __syncthreads();
#pragma unroll 4
      for (int i = 0; i < 32; ++i) {
        float4 q0 = *(const float4*)(Cs + i * 128 + dg * 8), q1 = *(const float4*)(Cs + i * 128 + dg * 8 + 4);
        float4 k0 = *(const float4*)(Bs + i * 128 + dg * 8), k1 = *(const float4*)(Bs + i * 128 + dg * 8 + 4);
        float xv = xs[i * 16 + wave * 4 + el];
        float a = decs[i]; float v = xv * dts[i];
        S[0] = a * S[0] + k0.x * v; S[1] = a * S[1] + k0.y * v; S[2] = a * S[2] + k0.z * v; S[3] = a * S[3] + k0.w * v;
        S[4] = a * S[4] + k1.x * v; S[5] = a * S[5] + k1.y * v; S[6] = a * S[6] + k1.z * v; S[7] = a * S[7] + k1.w * v;
        float o = q0.x * S[0] + q0.y * S[1] + q0.z * S[2] + q0.w * S[3] + q1.x * S[4] + q1.y * S[5] + q1.z * S[6] + q1.w * S[7];
        o += __shfl_xor(o, 1); o += __shfl_xor(o, 2); o += __shfl_xor(o, 4); o += __shfl_xor(o, 8);
        if (dg == 0) os[i * 16 + wave * 4 + el] = o + Dsk * xv;
      }
      __syncthreads();
      {
        int pos = tid >> 3, e2 = (tid & 7) * 2;
        int R = pos2row_m2(b, pbase + pos, dir);
        uint32_t* yp = (uint32_t*)(p.Y2 + (size_t)R * 1024 + 512 + head * 64 + ps * 16 + e2);
        float o0 = os[pos * 16 + e2], o1 = os[pos * 16 + e2 + 1];
        if (dir == 1) { uint32_t w = *yp; o0 += bflo(w); o1 += bfhi(w); }
        *yp = pack2(o0, o1);
      }
    }
    __syncthreads();
  }
}

#ifndef M2_MFMA
#define M2_MFMA 1
#endif
#define QS 136
#define TS 40
union FragU { bf16x8 v; uint32_t u[4]; uint2 d[2]; uint4 q; };
__device__ __forceinline__ bf16x8 cvt_frag(const f32x16& x, int s2) {
  FragU f;
  f.u[0] = pack2(x[8 * s2 + 0], x[8 * s2 + 1]); f.u[1] = pack2(x[8 * s2 + 2], x[8 * s2 + 3]);
  f.u[2] = pack2(x[8 * s2 + 4], x[8 * s2 + 5]); f.u[3] = pack2(x[8 * s2 + 6], x[8 * s2 + 7]);
  return f.v;
}
__device__ __forceinline__ bf16x8 ld_frag_perm(const u16* base) {
  FragU f; f.d[0] = *(const uint2*)base; f.d[1] = *(const uint2*)(base + 8); return f.v;
}

template <int PASS>
__device__ __forceinline__ void hg_mfma(const P& p, int l, int task, int blk, int dir0, unsigned char* smem) {
  int tid = threadIdx.x; asm volatile("" : "+v"(tid)); const int wave = tid >> 6, lane = tid & 63;
  const int r = lane & 31, hh = lane >> 5;
  const int b = task >> 2, h = task & 3;
  u16* ks = (u16*)smem;
  u16* qs = ks + 32 * QS;
  u16* kT = qs + 32 * QS;
  u16* vT = kT + 128 * TS;
  float* tot = (float*)(vT + 128 * TS);
  float* eg = tot + 256;
  const int dd = tid & 127, half = tid >> 7;
  for (int dir = (PASS == 0 ? dir0 : 0); dir < (PASS == 0 ? dir0 + 1 : 2); ++dir) {
    const int sbd = (PASS == 0) ? blk : ((blk == 0) ? 0 : (dir ? 9 - blk : blk));
    const int c0 = (sbd == 0) ? 0 : 8 + 16 * (sbd - 1);
    const int c1 = (sbd == 0) ? 8 : 8 + 16 * sbd;
    float gsum = 0.f;
    f32x16 S[4];
#pragma unroll
    for (int i = 0; i < 4; ++i)
#pragma unroll
      for (int q = 0; q < 16; ++q) S[i][q] = 0.f;
    if (PASS == 1) {
      for (int qb = 0; qb < sbd; ++qb) {
        const size_t sidx = (size_t)((task * 2 + dir) * 8 + qb);
        if (half == 0) eg[dd] = __expf(p.PS[sidx * 128 + dd]);
        __syncthreads();
        const float* sp = p.SSH + sidx * 16384 + (size_t)wave * 4096 + lane;
#pragma unroll
        for (int dt = 0; dt < 4; ++dt)
#pragma unroll
          for (int q4 = 0; q4 < 4; ++q4) {
            float4 e4 = *(const float4*)(eg + 32 * dt + 8 * q4 + 4 * hh);
            S[dt][4 * q4 + 0] = S[dt][4 * q4 + 0] * e4.x + sp[(dt * 16 + 4 * q4 + 0) * 64];
            S[dt][4 * q4 + 1] = S[dt][4 * q4 + 1] * e4.y + sp[(dt * 16 + 4 * q4 + 1) * 64];
            S[dt][4 * q4 + 2] = S[dt][4 * q4 + 2] * e4.z + sp[(dt * 16 + 4 * q4 + 2) * 64];
            S[dt][4 * q4 + 3] = S[dt][4 * q4 + 3] * e4.w + sp[(dt * 16 + 4 * q4 + 3) * 64];
          }
        __syncthreads();
      }
    }
    uint4 pq0, pq1, pk0, pk1, pv0, pv1;
#define HG_PREFETCH(CH)                                                                     \
    {                                                                                       \
      int pos0 = tid >> 4, seg = tid & 15;                                                  \
      int R0 = pos2row_seq(b, (CH) * 32 + pos0, dir), R1 = pos2row_seq(b, (CH) * 32 + pos0 + 16, dir); \
      const u16* u0 = p.U + (size_t)R0 * UW + h * 128 + seg * 8;                            \
      const u16* u1 = p.U + (size_t)R1 * UW + h * 128 + seg * 8;                            \
      pq0 = *(const uint4*)u0; pq1 = *(const uint4*)u1;                                     \
      pk0 = *(const uint4*)(u0 + 512 + dir * 512); pk1 = *(const uint4*)(u1 + 512 + dir * 512); \
      int Rv = pos2row_seq(b, (CH) * 32 + (tid & 31), dir);                                 \
      const u16* uv = p.U + (size_t)Rv * UW + 1536 + h * 128 + (tid >> 5) * 16;             \
      pv0 = *(const uint4*)uv; pv1 = *(const uint4*)(uv + 8);                               \
    }
    HG_PREFETCH(c0)
#pragma unroll 1
    for (int chunk = c0; chunk < c1; ++chunk) {
      {
        int pos0 = tid >> 4, seg = tid & 15;
        *(uint4*)(qs + pos0 * QS + seg * 8) = pq0; *(uint4*)(qs + (pos0 + 16) * QS + seg * 8) = pq1;
        *(uint4*)(ks + pos0 * QS + seg * 8) = pk0; *(uint4*)(ks + (pos0 + 16) * QS + seg * 8) = pk1;
        FragU f0, f1; f0.q = pv0; f1.q = pv1;
        u16* vw = vT + ((tid >> 5) * 16) * TS + (tid & 31);
#pragma unroll
        for (int j = 0; j < 4; ++j) {
          vw[(2 * j) * TS] = (u16)(f0.u[j] & 0xffffu); vw[(2 * j + 1) * TS] = (u16)(f0.u[j] >> 16);
          vw[(8 + 2 * j) * TS] = (u16)(f1.u[j] & 0xffffu); vw[(8 + 2 * j + 1) * TS] = (u16)(f1.u[j] >> 16);
        }
      }
      __syncthreads();
      if (chunk + 1 < c1) HG_PREFETCH(chunk + 1)
      const int Rout = pos2row_seq(b, chunk * 32 + r, dir);
      u16* yrow = p.Y2 + (size_t)Rout * 1024 + h * 128 + wave * 32 + 4 * hh;
      uint2 yold[4];
      if (PASS == 1 && dir == 1) {
#pragma unroll
        for (int q4 = 0; q4 < 4; ++q4) yold[q4] = *(const uint2*)(yrow + 8 * q4);
      }
      float gl[16];
      {
        float run = 0.f;
#pragma unroll
        for (int i = 0; i < 16; ++i) {
          float kkv = bf2f(ks[(half * 16 + i) * QS + dd]);
          run += __logf(fmaxf(1.f - kkv, 1e-6f));
          gl[i] = run;
        }
        tot[half * 128 + dd] = run;
      }
      __syncthreads();
      {
        const float t0 = tot[dd], t1 = tot[128 + dd];
        const float off = half ? t0 : 0.f;
        const float g31 = t0 + t1;
        float k2[16];
#pragma unroll
        for (int i = 0; i < 16; ++i) {
          const int pos = half * 16 + i;
          const float g = gl[i] + off;
          const float kkv = bf2f(ks[pos * QS + dd]);
          const float qv = bf2f(qs[pos * QS + dd]);
          qs[pos * QS + dd] = f2bf(qv * __expf(g));
          ks[pos * QS + dd] = f2bf(kkv * __expf(fminf(-g, 60.f)));
          k2[i] = kkv * __expf(g31 - g);
        }
        *(uint4*)(kT + dd * TS + half * 16) = pack8(k2);
        *(uint4*)(kT + dd * TS + half * 16 + 8) = pack8(k2 + 8);
        if (half == 0) eg[dd] = __expf(g31);
        gsum += g31;
      }
      __syncthreads();
      f32x16 O;
      if (PASS == 1) {
      f32x16 att;
#pragma unroll
      for (int q = 0; q < 16; ++q) att[q] = 0.f;
#pragma unroll
      for (int k8 = 0; k8 < 8; ++k8) {
        bf16x8 A = *(const bf16x8*)(ks + r * QS + 16 * k8 + 8 * hh);
        bf16x8 B = *(const bf16x8*)(qs + r * QS + 16 * k8 + 8 * hh);
        att = __builtin_amdgcn_mfma_f32_32x32x16_bf16(A, B, att, 0, 0, 0);
      }
#pragma unroll
      for (int q = 0; q < 16; ++q) {
        int sidx = (q & 3) + 8 * (q >> 2) + 4 * hh;
        if (sidx > r) att[q] = 0.f;
      }
#pragma unroll
      for (int q = 0; q < 16; ++q) O[q] = 0.f;
#pragma unroll
      for (int dt = 0; dt < 4; ++dt)
#pragma unroll
        for (int s2 = 0; s2 < 2; ++s2) {
          bf16x8 A = cvt_frag(S[dt], s2);
          bf16x8 B = ld_frag_perm(qs + r * QS + 32 * dt + 16 * s2 + 4 * hh);
          O = __builtin_amdgcn_mfma_f32_32x32x16_bf16(A, B, O, 0, 0, 0);
        }
#pragma unroll
      for (int s2 = 0; s2 < 2; ++s2) {
        bf16x8 A = ld_frag_perm(vT + (32 * wave + r) * TS + 16 * s2 + 4 * hh);
        bf16x8 B = cvt_frag(att, s2);
        O = __builtin_amdgcn_mfma_f32_32x32x16_bf16(A, B, O, 0, 0, 0);
      }
      }
#pragma unroll
      for (int dt = 0; dt < 4; ++dt) {
#pragma unroll
        for (int q4 = 0; q4 < 4; ++q4) {
          float4 e4 = *(const float4*)(eg + 32 * dt + 8 * q4 + 4 * hh);
          S[dt][4 * q4 + 0] *= e4.x; S[dt][4 * q4 + 1] *= e4.y; S[dt][4 * q4 + 2] *= e4.z; S[dt][4 * q4 + 3] *= e4.w;
        }
#pragma unroll
        for (int s2 = 0; s2 < 2; ++s2) {
          bf16x8 A = *(const bf16x8*)(kT + (32 * dt + r) * TS + 16 * s2 + 8 * hh);
          bf16x8 B = *(const bf16x8*)(vT + (32 * wave + r) * TS + 16 * s2 + 8 * hh);
          S[dt] = __builtin_amdgcn_mfma_f32_32x32x16_bf16(A, B, S[dt], 0, 0, 0);
        }
      }
      if (PASS == 1) {
#pragma unroll
      for (int q4 = 0; q4 < 4; ++q4) {
        float o0 = O[4 * q4], o1 = O[4 * q4 + 1], o2 = O[4 * q4 + 2], o3 = O[4 * q4 + 3];
        if (dir == 1) { o0 += bflo(yold[q4].x); o1 += bfhi(yold[q4].x); o2 += bflo(yold[q4].y); o3 += bfhi(yold[q4].y); }
        uint2 ov; ov.x = pack2(o0, o1); ov.y = pack2(o2, o3);
        *(uint2*)(yrow + 8 * q4) = ov;
      }
      }
      __syncthreads();
    }
    if (PASS == 0) {
      const size_t sidx = (size_t)((task * 2 + dir) * 8 + sbd);
      if (half == 0) p.PS[sidx * 128 + dd] = gsum;
      float* sp = p.SSH + sidx * 16384 + (size_t)wave * 4096 + lane;
#pragma unroll
      for (int dt = 0; dt < 4; ++dt)
#pragma unroll
        for (int q = 0; q < 16; ++q) sp[(dt * 16 + q) * 64] = S[dt][q];
    }
    __syncthreads();
  }
}

#if M2_MFMA
#define M2_NTASK 16
template <int PASS>
__device__ __forceinline__ void m2_mfma(const P& p, int l, int task, int blk, int dir0, unsigned char* smem) {
  int tid = threadIdx.x; asm volatile("" : "+v"(tid)); const int wave = tid >> 6, lane = tid & 63;
  const int r = lane & 31, hh = lane >> 5;
  const int b = task >> 2, g = (task >> 1) & 1, hp = task & 1;
  const int hq = wave >> 1, ph = wave & 1;
  const int head = 4 * g + 2 * hp + hq;
  u16* Bm = (u16*)smem;
  u16* Cm = Bm + 32 * QS;
  u16* BmT = Cm + 32 * QS;
  u16* xsT = BmT + 128 * TS;
  float* Gs = (float*)(xsT + 128 * TS);
  float* dts = Gs + 64;
  float* wl = dts + 64;
  const int cp = (lane < 48) ? lane : 47;
  const bool act = lane < 48;
  const int chW = (cp < 16) ? ((4 * g + 2 * hp) * 64 + cp * 8) : (cp < 32) ? (512 + g * 128 + (cp - 16) * 8) : (768 + g * 128 + (cp - 32) * 8);
  const int chU = 2048 + chW;
  float* SSM = (float*)p.KF;
  for (int dir = (PASS == 0 ? dir0 : 0); dir < (PASS == 0 ? dir0 + 1 : 2); ++dir) {
    const int sbd = (PASS == 0) ? blk : ((blk == 0) ? 0 : (dir ? 9 - blk : blk));
    const int c0 = (sbd == 0) ? 0 : 8 + 16 * (sbd - 1);
    const int c1 = (sbd == 0) ? 8 : 8 + 16 * sbd;
    float lsum = 0.f;
    const float* cw = p.m2_conv_w + (size_t)(l * 2 + dir) * 4 * 1024;
    const float* cb = p.m2_conv_b + (size_t)(l * 2 + dir) * 1024;
    if (wave == 0) {
#pragma unroll
      for (int j = 0; j < 8; ++j) {
        wl[(4 * 8 + j) * 64 + lane] = cb[chW + j];
#pragma unroll
        for (int tap = 0; tap < 4; ++tap) wl[(tap * 8 + j) * 64 + lane] = cw[tap * 1024 + chW + j];
      }
    }
    __syncthreads();
    const int hd_t = 4 * g + 2 * hp + ((tid >> 5) & 1);
    const float dtb = p.m2_dt_bias[(l * 2 + dir) * 8 + hd_t];
    const float Aneg_t = -__expf(p.m2_a_log[(l * 2 + dir) * 8 + hd_t]);
    const float Dsk = p.m2_d[(l * 2 + dir) * 8 + head];
    f32x16 S[4];
#pragma unroll
    for (int i = 0; i < 4; ++i)
#pragma unroll
      for (int q = 0; q < 16; ++q) S[i][q] = 0.f;
    if (PASS == 1) {
      for (int qb = 0; qb < sbd; ++qb) {
        const size_t sidx = (size_t)((task * 2 + dir) * 8 + qb);
        const float a = __expf(p.PA[sidx * 4 + wave]);
        const float* sp = SSM + sidx * 16384 + (size_t)wave * 4096 + lane;
#pragma unroll
        for (int nt = 0; nt < 4; ++nt)
#pragma unroll
          for (int q = 0; q < 16; ++q) S[nt][q] = S[nt][q] * a + sp[(nt * 16 + q) * 64];
      }
    }
    uint4 raw0, raw1, raw2, raw3, raw4, raw5, raw6, raw7, raw8, raw9, raw10;
    float dtraw = 0.f;
#define M2_LD1(RW, I, CH)                                                                  \
    {                                                                                      \
      int pt = (CH) * 32 + wave * 8 + (I) - 3;                                             \
      int sg0 = ((CH) * 32 < 256) ? 0 : 256;                                               \
      if (pt >= sg0) { int Rr = pos2row_m2(b, pt, dir); RW = *(const uint4*)(p.U + (size_t)Rr * UW + chU); } \
      else RW = make_uint4(0u, 0u, 0u, 0u);                                                \
    }
#define M2_PREFETCH(CH)                                                                    \
    M2_LD1(raw0, 0, CH) M2_LD1(raw1, 1, CH) M2_LD1(raw2, 2, CH) M2_LD1(raw3, 3, CH) M2_LD1(raw4, 4, CH) M2_LD1(raw5, 5, CH) \
    M2_LD1(raw6, 6, CH) M2_LD1(raw7, 7, CH) M2_LD1(raw8, 8, CH) M2_LD1(raw9, 9, CH) M2_LD1(raw10, 10, CH)            \
    if (tid < 64) { int Rr = pos2row_m2(b, (CH) * 32 + (tid & 31), dir); dtraw = p.DT[(size_t)Rr * 8 + hd_t]; }
    M2_PREFETCH(c0)
#pragma unroll 1
    for (int chunk = c0; chunk < c1; ++chunk) {
      {
#define M2_RAWF(RW, J) (((J) & 1) ? bfhi((RW)) : bflo((RW)))
#define M2_CH(J, C0, C1, C2, C3, C4, C5, C6, C7, C8, C9, C10)                               \
        {                                                                                  \
          const float q0 = wl[(0 * 8 + (J)) * 64 + lane], q1 = wl[(1 * 8 + (J)) * 64 + lane]; \
          const float q2 = wl[(2 * 8 + (J)) * 64 + lane], q3 = wl[(3 * 8 + (J)) * 64 + lane]; \
          const float qb = wl[(4 * 8 + (J)) * 64 + lane];                                  \
          const float v0 = M2_RAWF(C0, J), v1 = M2_RAWF(C1, J), v2 = M2_RAWF(C2, J), v3 = M2_RAWF(C3, J); \
          const float v4 = M2_RAWF(C4, J), v5 = M2_RAWF(C5, J), v6 = M2_RAWF(C6, J), v7 = M2_RAWF(C7, J); \
          const float v8 = M2_RAWF(C8, J), v9 = M2_RAWF(C9, J), v10 = M2_RAWF(C10, J);      \
          float o[8];                                                                      \
          o[0] = siluf(qb + q0 * v0 + q1 * v1 + q2 * v2 + q3 * v3);                        \
          o[1] = siluf(qb + q0 * v1 + q1 * v2 + q2 * v3 + q3 * v4);                        \
          o[2] = siluf(qb + q0 * v2 + q1 * v3 + q2 * v4 + q3 * v5);                        \
          o[3] = siluf(qb + q0 * v3 + q1 * v4 + q2 * v5 + q3 * v6);                        \
          o[4] = siluf(qb + q0 * v4 + q1 * v5 + q2 * v6 + q3 * v7);                        \
          o[5] = siluf(qb + q0 * v5 + q1 * v6 + q2 * v7 + q3 * v8);                        \
          o[6] = siluf(qb + q0 * v6 + q1 * v7 + q2 * v8 + q3 * v9);                        \
          o[7] = siluf(qb + q0 * v7 + q1 * v8 + q2 * v9 + q3 * v10);                       \
          if (act) {                                                                       \
            if (cp < 16) {                                                                 \
              *(uint4*)(xsT + (cp * 8 + (J)) * TS + wave * 8) = pack8(o);                  \
            } else if (cp < 32) {                                                          \
              *(uint4*)(BmT + ((cp - 16) * 8 + (J)) * TS + wave * 8) = pack8(o);           \
              _Pragma("unroll") for (int i = 0; i < 8; ++i) Bm[(wave * 8 + i) * QS + (cp - 16) * 8 + (J)] = f2bf(o[i]); \
            } else {                                                                       \
              _Pragma("unroll") for (int i = 0; i < 8; ++i) Cm[(wave * 8 + i) * QS + (cp - 32) * 8 + (J)] = f2bf(o[i]); \
            }                                                                              \
          }                                                                                \
        }
        M2_CH(0, raw0.x, raw1.x, raw2.x, raw3.x, raw4.x, raw5.x, raw6.x, raw7.x, raw8.x, raw9.x, raw10.x)
        M2_CH(1, raw0.x, raw1.x, raw2.x, raw3.x, raw4.x, raw5.x, raw6.x, raw7.x, raw8.x, raw9.x, raw10.x)
        M2_CH(2, raw0.y, raw1.y, raw2.y, raw3.y, raw4.y, raw5.y, raw6.y, raw7.y, raw8.y, raw9.y, raw10.y)
        M2_CH(3, raw0.y, raw1.y, raw2.y, raw3.y, raw4.y, raw5.y, raw6.y, raw7.y, raw8.y, raw9.y, raw10.y)
        M2_CH(4, raw0.z, raw1.z, raw2.z, raw3.z, raw4.z, raw5.z, raw6.z, raw7.z, raw8.z, raw9.z, raw10.z)
        M2_CH(5, raw0.z, raw1.z, raw2.z, raw3.z, raw4.z, raw5.z, raw6.z, raw7.z, raw8.z, raw9.z, raw10.z)
        M2_CH(6, raw0.w, raw1.w, raw2.w, raw3.w, raw4.w, raw5.w, raw6.w, raw7.w, raw8.w, raw9.w, raw10.w)
        M2_CH(7, raw0.w, raw1.w, raw2.w, raw3.w, raw4.w, raw5.w, raw6.w, raw7.w, raw8.w, raw9.w, raw10.w)
      }
      if (tid < 64) {
        float dtv = softplusf(dtraw + dtb);
        float run = dtv * Aneg_t;
#pragma unroll
        for (int o = 1; o < 32; o <<= 1) { float n = __shfl_up(run, o, 32); if ((tid & 31) >= o) run += n; }
        Gs[tid] = run; dts[tid] = dtv;
      }
      __syncthreads();
      if (chunk + 1 < c1) { M2_PREFETCH(chunk + 1) }
      const int Rout = pos2row_m2(b, chunk * 32 + r, dir);
      u16* yrow = p.Y2 + (size_t)Rout * 1024 + 512 + head * 64 + 32 * ph + 4 * hh;
      uint2 yold[4];
      if (PASS == 1 && dir == 1) {
#pragma unroll
        for (int i = 0; i < 4; ++i) yold[i] = *(const uint2*)(yrow + 8 * i);
      }
      const float* Gw = Gs + hq * 32; const float* dw = dts + hq * 32;
      const float Gt = Gw[r], G31 = Gw[31];
      lsum += G31;
      const u16* xw = xsT + (hq * 64 + ph * 32) * TS;
      f32x16 O0;
      if (PASS == 1) {
      f32x16 att;
#pragma unroll
      for (int q = 0; q < 16; ++q) att[q] = 0.f;
#pragma unroll
      for (int k8 = 0; k8 < 8; ++k8) {
        bf16x8 A = *(const bf16x8*)(Bm + r * QS + 16 * k8 + 8 * hh);
        bf16x8 B = *(const bf16x8*)(Cm + r * QS + 16 * k8 + 8 * hh);
        att = __builtin_amdgcn_mfma_f32_32x32x16_bf16(A, B, att, 0, 0, 0);
      }
#pragma unroll
      for (int q4 = 0; q4 < 4; ++q4) {
        float4 gs4 = *(const float4*)(Gw + 8 * q4 + 4 * hh);
        float4 dt4 = *(const float4*)(dw + 8 * q4 + 4 * hh);
        int s0 = 8 * q4 + 4 * hh;
        att[4 * q4 + 0] = (s0 + 0 <= r) ? att[4 * q4 + 0] * __expf(Gt - gs4.x) * dt4.x : 0.f;
        att[4 * q4 + 1] = (s0 + 1 <= r) ? att[4 * q4 + 1] * __expf(Gt - gs4.y) * dt4.y : 0.f;
        att[4 * q4 + 2] = (s0 + 2 <= r) ? att[4 * q4 + 2] * __expf(Gt - gs4.z) * dt4.z : 0.f;
        att[4 * q4 + 3] = (s0 + 3 <= r) ? att[4 * q4 + 3] * __expf(Gt - gs4.w) * dt4.w : 0.f;
      }
#pragma unroll
      for (int q = 0; q < 16; ++q) O0[q] = 0.f;
#pragma unroll
      for (int nt = 0; nt < 4; ++nt)
#pragma unroll
        for (int s2 = 0; s2 < 2; ++s2) {
          bf16x8 B = ld_frag_perm(Cm + r * QS + 32 * nt + 16 * s2 + 4 * hh);
          O0 = __builtin_amdgcn_mfma_f32_32x32x16_bf16(cvt_frag(S[nt], s2), B, O0, 0, 0, 0);
        }
      {
        const float eGt = __expf(Gt);
#pragma unroll
        for (int q = 0; q < 16; ++q) O0[q] *= eGt;
      }
#pragma unroll
      for (int s2 = 0; s2 < 2; ++s2) {
        bf16x8 B = cvt_frag(att, s2);
        O0 = __builtin_amdgcn_mfma_f32_32x32x16_bf16(ld_frag_perm(xw + r * TS + 16 * s2 + 4 * hh), B, O0, 0, 0, 0);
      }
#pragma unroll
      for (int q = 0; q < 16; ++q) {
        int pp = (q & 3) + 8 * (q >> 2) + 4 * hh;
        O0[q] += Dsk * bf2f(xw[pp * TS + r]);
      }
      }
      {
        const float eG31 = __expf(G31);
#pragma unroll
        for (int nt = 0; nt < 4; ++nt)
#pragma unroll
          for (int q = 0; q < 16; ++q) S[nt][q] *= eG31;
#pragma unroll
        for (int s2 = 0; s2 < 2; ++s2) {
          float ws[8];
          {
            float4 ga = *(const float4*)(Gw + 16 * s2 + 8 * hh), gb = *(const float4*)(Gw + 16 * s2 + 8 * hh + 4);
            float4 da = *(const float4*)(dw + 16 * s2 + 8 * hh), db = *(const float4*)(dw + 16 * s2 + 8 * hh + 4);
            ws[0] = da.x * __expf(G31 - ga.x); ws[1] = da.y * __expf(G31 - ga.y); ws[2] = da.z * __expf(G31 - ga.z); ws[3] = da.w * __expf(G31 - ga.w);
            ws[4] = db.x * __expf(G31 - gb.x); ws[5] = db.y * __expf(G31 - gb.y); ws[6] = db.z * __expf(G31 - gb.z); ws[7] = db.w * __expf(G31 - gb.w);
          }
          bf16x8 Bf0;
          {
            float f[8]; unpack8(*(const uint4*)(xw + r * TS + 16 * s2 + 8 * hh), f);
#pragma unroll
            for (int j = 0; j < 8; ++j) f[j] *= ws[j];
            FragU u; u.q = pack8(f); Bf0 = u.v;
          }
#pragma unroll
          for (int nt = 0; nt < 4; ++nt) {
            bf16x8 A = *(const bf16x8*)(BmT + (32 * nt + r) * TS + 16 * s2 + 8 * hh);
            S[nt] = __builtin_amdgcn_mfma_f32_32x32x16_bf16(A, Bf0, S[nt], 0, 0, 0);
          }
        }
      }
      if (PASS == 1) {
#pragma unroll
      for (int q4 = 0; q4 < 4; ++q4) {
        float o0 = O0[4 * q4], o1 = O0[4 * q4 + 1], o2 = O0[4 * q4 + 2], o3 = O0[4 * q4 + 3];
        if (dir == 1) { o0 += bflo(yold[q4].x); o1 += bfhi(yold[q4].x); o2 += bflo(yold[q4].y); o3 += bfhi(yold[q4].y); }
        uint2 ov; ov.x = pack2(o0, o1); ov.y = pack2(o2, o3);
        *(uint2*)(yrow + 8 * q4) = ov;
      }
      }
      __syncthreads();
    }
    if (PASS == 0) {
      const size_t sidx = (size_t)((task * 2 + dir) * 8 + sbd);
      if (lane == 0) p.PA[sidx * 4 + wave] = lsum;
      float* sp = SSM + sidx * 16384 + (size_t)wave * 4096 + lane;
#pragma unroll
      for (int nt = 0; nt < 4; ++nt)
#pragma unroll
        for (int q = 0; q < 16; ++q) sp[(nt * 16 + q) * 64] = S[nt][q];
    }
    __syncthreads();
  }
}
#endif
__device__ __forceinline__ void ph_mixA0(const P& p, int l, int bid, int nb, unsigned char* sm) {
  for (int t = bid; t < 512; t += nb) {
    if (t < 256) hg_mfma<0>(p, l, t >> 4, (t >> 1) & 7, t & 1, sm);
    else { int u = t - 256; m2_mfma<0>(p, l, u >> 4, (u >> 1) & 7, u & 1, sm); }
    __syncthreads();
  }
}
__device__ __forceinline__ void ph_mixA1(const P& p, int l, int bid, int nb, unsigned char* sm) {
  for (int t = bid; t < 288; t += nb) {
    if (t < 128) hg_mfma<1>(p, l, t >> 3, 1 + (t & 7), 0, sm);
    else if (t < 256) { int u = t - 128; m2_mfma<1>(p, l, u >> 3, 1 + (u & 7), 0, sm); }
    else if (t < 272) hg_mfma<1>(p, l, t - 256, 0, 0, sm);
    else m2_mfma<1>(p, l, t - 272, 0, 0, sm);
    __syncthreads();
  }
}

template <int PASS>
__device__ __forceinline__ void rg_task(const P& p, int l, int task, float* sm) {
  int tid = threadIdx.x; asm volatile("" : "+v"(tid));
  const int wave = tid >> 6, lane = tid & 63;
  const int b = task >> 7, head = (task >> 4) & 7, sb = task & 15;
  float* xc = sm;
  float* pa = sm + 2048;
  float* pb = sm + 4096;
  u16* xcb = (u16*)(sm + 6144);
  u16* WTl = xcb + 32 * 72;
  const int j = tid & 63;
  const int spos = tid >> 3, sseg = tid & 7;
  const int sch = head * 64 + sseg * 8;
  const u16* UB2 = p.U + (size_t)NTOK * 2048;
  for (int dir = 0; dir < 2; ++dir) {
    const int ld = l * 2 + dir;
    {
      const float* wa = p.rg_wa + (size_t)(ld * 8 + head) * 4096;
      const float* wx = p.rg_wx + (size_t)(ld * 8 + head) * 4096;
#pragma unroll
      for (int it = 0; it < 4; ++it) {
        int i = (tid >> 4) + 16 * it, j4 = (tid & 15) * 4;
        float4 va = *(const float4*)(wa + i * 64 + j4);
        float4 vx = *(const float4*)(wx + i * 64 + j4);
        WTl[(j4 + 0) * 72 + i] = f2bf(va.x); WTl[(j4 + 1) * 72 + i] = f2bf(va.y);
        WTl[(j4 + 2) * 72 + i] = f2bf(va.z); WTl[(j4 + 3) * 72 + i] = f2bf(va.w);
        WTl[(64 + j4 + 0) * 72 + i] = f2bf(vx.x); WTl[(64 + j4 + 1) * 72 + i] = f2bf(vx.y);
        WTl[(64 + j4 + 2) * 72 + i] = f2bf(vx.z); WTl[(64 + j4 + 3) * 72 + i] = f2bf(vx.w);
      }
    }
    float wcv[4][8], bcv[8];
#pragma unroll
    for (int jj = 0; jj < 8; ++jj) {
      bcv[jj] = p.rg_conv_b[(size_t)ld * 512 + sch + jj];
#pragma unroll
      for (int tap = 0; tap < 4; ++tap) wcv[tap][jj] = p.rg_conv_w[((size_t)ld * 4 + tap) * 512 + sch + jj];
    }
    const int chg = head * 64 + j;
    const float g_ba = p.rg_ba[ld * 512 + chg], g_bx = p.rg_bx[ld * 512 + chg];
    const float g_sp = -8.0f * softplusf(-p.rg_lam[ld * 512 + chg]);
    const int sbd = (PASS == 0) ? sb : (dir ? (sb == 0 ? 0 : 16 - sb) : sb);
    int cbeg, cend;
    if (sbd == 0) { cbeg = 0; cend = 8; }
    else {
      const int jb = sbd - 1;
      if (dir == 0) { cbeg = 8 + (jb * 128) / 15; cend = 8 + ((jb + 1) * 128) / 15; }
      else { const int kb = 14 - jb; cbeg = 8 + 128 - ((kb + 1) * 128) / 15; cend = 8 + 128 - (kb * 128) / 15; }
    }
    float hcarry = 0.f, aprod = 1.f;
    if (PASS == 1 && tid < 64) {
      float2 sv[16];
#pragma unroll
      for (int q = 0; q < 16; ++q) {
        const float2* sp = (const float2*)(p.SUM + ((((size_t)b * 2 + dir) * 17 + q) * 512 + head * 64 + tid) * 2);
        sv[q] = (q < sbd) ? *sp : make_float2(1.f, 0.f);
      }
#pragma unroll
      for (int q = 0; q < 16; ++q) hcarry = sv[q].x * hcarry + sv[q].y;
    }
    uint4 xr0, xr1, xr2, xr3;
#define RG_LD1(XR, TAP, CH)                                                               \
    {                                                                                     \
      int pt = (CH) * 32 + spos - 3 + (TAP);                                              \
      int sg0 = ((CH) * 32 < 256) ? 0 : 256;                                              \
      if (pt >= sg0) { int Rr = pos2row_seq(b, pt, dir); XR = *(const uint4*)(UB2 + (size_t)Rr * 2048 + sch); } \
      else XR = make_uint4(0u, 0u, 0u, 0u);                                               \
    }
#define RG_PREFETCH(CH) RG_LD1(xr0, 0, CH) RG_LD1(xr1, 1, CH) RG_LD1(xr2, 2, CH) RG_LD1(xr3, 3, CH)
    RG_PREFETCH(cbeg)
#pragma unroll 1
    for (int chunk = cbeg; chunk < cend; ++chunk) {
      const int pbase = chunk * 32;
      {
        float a[8], f[8];
#pragma unroll
        for (int jj = 0; jj < 8; ++jj) a[jj] = bcv[jj];
        unpack8(xr0, f);
#pragma unroll
        for (int jj = 0; jj < 8; ++jj) a[jj] += wcv[0][jj] * f[jj];
        unpack8(xr1, f);
#pragma unroll
        for (int jj = 0; jj < 8; ++jj) a[jj] += wcv[1][jj] * f[jj];
        unpack8(xr2, f);
#pragma unroll
        for (int jj = 0; jj < 8; ++jj) a[jj] += wcv[2][jj] * f[jj];
        unpack8(xr3, f);
#pragma unroll
        for (int jj = 0; jj < 8; ++jj) a[jj] += wcv[3][jj] * f[jj];
        *(float4*)(xc + spos * 64 + sseg * 8) = make_float4(a[0], a[1], a[2], a[3]);
        *(float4*)(xc + spos * 64 + sseg * 8 + 4) = make_float4(a[4], a[5], a[6], a[7]);
        *(uint4*)(xcb + spos * 72 + sseg * 8) = pack8(a);
      }
      __syncthreads();
      if (chunk + 1 < cend) { RG_PREFETCH(chunk + 1) }
      const int Rout = pos2row_seq(b, pbase + spos, dir);
      uint4* yp = (uint4*)(p.HL + (size_t)Rout * 1024 + 512 + sch);
      uint4 prev, gv;
      if (PASS == 1 && dir == 1) { prev = *yp; gv = *(const uint4*)(UB2 + (size_t)Rout * 2048 + 512 + sch); }
      {
        const int r = lane & 31, hh = lane >> 5;
        f32x16 acc;
#pragma unroll
        for (int q = 0; q < 16; ++q) acc[q] = 0.f;
#pragma unroll
        for (int ks = 0; ks < 4; ++ks) {
          bf16x8 A = *(const bf16x8*)(xcb + r * 72 + 16 * ks + 8 * hh);
          bf16x8 B = *(const bf16x8*)(WTl + (32 * wave + r) * 72 + 16 * ks + 8 * hh);
          acc = __builtin_amdgcn_mfma_f32_32x32x16_bf16(A, B, acc, 0, 0, 0);
        }
        float* dstp = (wave < 2) ? pa : pb;
        const int jc = (wave & 1) * 32 + r;
#pragma unroll
        for (int q = 0; q < 16; ++q) dstp[((q & 3) + 8 * (q >> 2) + 4 * hh) * 64 + jc] = acc[q];
      }
      __syncthreads();
#pragma unroll
      for (int i = 0; i < 8; ++i) {
        int e = tid + 256 * i;
        float r = sigmf(pa[e] + g_ba);
        float gi = sigmf(pb[e] + g_bx);
        float la = g_sp * r;
        float a = __expf(la);
        float bt = sqrtf(fmaxf(1.f - a * a, 0.f)) * gi * xc[e];
        pa[e] = a; pb[e] = bt;
      }
      __syncthreads();
      if (tid < 64) {
        float hh = hcarry;
#pragma unroll 8
        for (int pos = 0; pos < 32; ++pos) { float av = pa[pos * 64 + tid]; hh = av * hh + pb[pos * 64 + tid]; pb[pos * 64 + tid] = hh; aprod *= av; }
        hcarry = hh;
      }
      __syncthreads();
      if (PASS == 1) {
        float hv[8];
#pragma unroll
        for (int jj = 0; jj < 8; ++jj) hv[jj] = pb[spos * 64 + sseg * 8 + jj];
        if (dir == 1) {
          float f[8]; unpack8(prev, f);
          float gf[8]; unpack8(gv, gf);
#pragma unroll
          for (int jj = 0; jj < 8; ++jj) hv[jj] = (hv[jj] + f[jj]) * gf[jj];
        }
        *yp = pack8(hv);
      }
    }
    if (PASS == 0 && tid < 64) {
      float* sp = p.SUM + ((((size_t)b * 2 + dir) * 17 + sbd) * 512 + head * 64 + tid) * 2;
      sp[0] = aprod; sp[1] = hcarry;
    }
    __syncthreads();
  }
}

typedef bf16x8 __attribute__((aligned(2))) bf16x8_u;
typedef uint4 __attribute__((aligned(4))) uint4_a4;
__device__ __forceinline__ bf16x8 ld_win8(const u16* base, int y, uint32_t sh) {
  const uint32_t* wp = (const uint32_t*)base + (y >> 1);
  uint4 w = *(const uint4_a4*)wp;
  uint32_t w4 = wp[4];
  FragU f;
  f.u[0] = __builtin_amdgcn_alignbit(w.y, w.x, sh);
  f.u[1] = __builtin_amdgcn_alignbit(w.z, w.y, sh);
  f.u[2] = __builtin_amdgcn_alignbit(w.w, w.z, sh);
  f.u[3] = __builtin_amdgcn_alignbit(w4, w.w, sh);
  return f.v;
}

__device__ __forceinline__ void hy_conv3x8(const u16* col, int t8, int n, float w0, float w1, float w2, float bias, float* out) {
  float f[8]; unpack8(*(const uint4*)(col + t8), f);
  float prev = (t8 > 0) ? bf2f(col[t8 - 1]) : 0.f;
  float next = (t8 + 8 < n) ? bf2f(col[t8 + 8]) : 0.f;
#pragma unroll
  for (int j = 0; j < 8; ++j) {
    float a = (j == 0) ? prev : f[j - 1];
    float cnx = (j == 7) ? next : f[j + 1];
    out[j] = bias + w0 * a + w1 * f[j] + w2 * cnx;
  }
}

#define ZB 5128
#define ZJ 80
#define ZI(B, T) ((B) * ZB + ((T) >> 6) * ZJ + ((T) & 63))
__device__ __forceinline__ void hy_task(const P& p, int l, int c, float* sm) {
  int tid = threadIdx.x; asm volatile("" : "+v"(tid)); const int wave = tid >> 6, lane = tid & 63;
  const int r = lane & 31, h = lane >> 5;
  u16* krr = (u16*)sm;
  u16* zs = krr + 8192 + 64;
  float* red = (float*)(zs + 4 * ZB);
  const u16* UT = p.U;
  const float* cwp = p.hy_conv_w + (size_t)l * 3 * 1536;
  const float* cbp = p.hy_conv_b + (size_t)l * 1536;
  for (int o = 0; o < 2; ++o) {
    const u16* K = p.KF + (size_t)(o * 512 + c) * 8192;
    float asum = 0.f;
#pragma unroll
    for (int i = 0; i < 4; ++i) {
      int idx = (tid + 256 * i) * 8;
      uint4 v = *(const uint4*)(K + idx);
      *(uint4*)(krr + idx) = v;
      float f[8]; unpack8(v, f);
#pragma unroll
      for (int j = 0; j < 8; ++j) asum += fabsf(f[j]);
    }
    asum = wave_sum(asum);
    if (lane == 0) red[wave] = asum;
    if (o == 0) {
      const float w0 = cwp[c], w1 = cwp[1536 + c], w2 = cwp[3072 + c], bs = cbp[c];
#pragma unroll 2
      for (int e = tid; e < 2048; e += 256) {
        int b = e >> 9, t8 = (e & 511) * 8;
        float f[8];
        hy_conv3x8(UT + (size_t)c * NTOK + b * 4096, t8, 4096, w0, w1, w2, bs, f);
        *(uint4*)(zs + ZI(b, t8)) = pack8(f);
      }
    }
    __syncthreads();
    const float scale = 1.f / (red[0] + red[1] + red[2] + red[3] + 1e-6f);
    const float skip = p.hy_skip[(l * 2 + o) * 512 + c];
    f32x16 acc[2][2];
#pragma unroll
    for (int a = 0; a < 2; ++a)
#pragma unroll
      for (int b = 0; b < 2; ++b)
#pragma unroll
        for (int q = 0; q < 16; ++q) acc[a][b][q] = 0.f;
    const int I0 = wave * 16;
    const int Il0 = I0 + (r >> 2), Il1 = I0 + 8 + (r >> 2);
    const u16* zb = zs + (r & 3) * ZB + 8 * h;
    const int ybase = 4096 - r + 8 * h + 48;
    bf16x8 F0, F1, F2, F3, F4, F5;
    const uint32_t ysh = (uint32_t)((ybase & 1) * 16);
    {
      const int y0 = ybase - 64 * (I0 - 63);
      F0 = ld_win8(krr, y0, ysh); F1 = ld_win8(krr, y0 - 16, ysh); F2 = ld_win8(krr, y0 - 32, ysh);
      F3 = ld_win8(krr, y0 - 48, ysh); F4 = ld_win8(krr, y0 - 64, ysh); F5 = ld_win8(krr, y0 - 80, ysh);
    }
#pragma unroll 1
    for (int D = I0 - 63; D <= I0 + 15; ++D) {
      bf16x8 B0[4], B1[4];
      {
        int J0 = Il0 - D, J1 = Il1 - D;
        bool ok0 = (unsigned)J0 < 64u, ok1 = (unsigned)J1 < 64u;
        const u16* zp0 = zb + ZJ * J0; const u16* zp1 = zb + ZJ * J1;
#pragma unroll
        for (int ks = 0; ks < 4; ++ks) {
          bf16x8 z0 = {0, 0, 0, 0, 0, 0, 0, 0}, z1 = {0, 0, 0, 0, 0, 0, 0, 0};
          if (ok0) z0 = *(const bf16x8*)(zp0 + 16 * ks);
          if (ok1) z1 = *(const bf16x8*)(zp1 + 16 * ks);
          B0[ks] = z0; B1[ks] = z1;
        }
      }
      acc[0][0] = __builtin_amdgcn_mfma_f32_32x32x16_bf16(F3, B0[0], acc[0][0], 0, 0, 0);
      acc[0][1] = __builtin_amdgcn_mfma_f32_32x32x16_bf16(F3, B1[0], acc[0][1], 0, 0, 0);
      acc[1][0] = __builtin_amdgcn_mfma_f32_32x32x16_bf16(F5, B0[0], acc[1][0], 0, 0, 0);
      acc[1][1] = __builtin_amdgcn_mfma_f32_32x32x16_bf16(F5, B1[0], acc[1][1], 0, 0, 0);
      acc[0][0] = __builtin_amdgcn_mfma_f32_32x32x16_bf16(F2, B0[1], acc[0][0], 0, 0, 0);
      acc[0][1] = __builtin_amdgcn_mfma_f32_32x32x16_bf16(F2, B1[1], acc[0][1], 0, 0, 0);
      acc[1][0] = __builtin_amdgcn_mfma_f32_32x32x16_bf16(F4, B0[1], acc[1][0], 0, 0, 0);
      acc[1][1] = __builtin_amdgcn_mfma_f32_32x32x16_bf16(F4, B1[1], acc[1][1], 0, 0, 0);
      acc[0][0] = __builtin_amdgcn_mfma_f32_32x32x16_bf16(F1, B0[2], acc[0][0], 0, 0, 0);
      acc[0][1] = __builtin_amdgcn_mfma_f32_32x32x16_bf16(F1, B1[2], acc[0][1], 0, 0, 0);
      acc[1][0] = __builtin_amdgcn_mfma_f32_32x32x16_bf16(F3, B0[2], acc[1][0], 0, 0, 0);
      acc[1][1] = __builtin_amdgcn_mfma_f32_32x32x16_bf16(F3, B1[2], acc[1][1], 0, 0, 0);
      acc[0][0] = __builtin_amdgcn_mfma_f32_32x32x16_bf16(F0, B0[3], acc[0][0], 0, 0, 0);
      acc[0][1] = __builtin_amdgcn_mfma_f32_32x32x16_bf16(F0, B1[3], acc[0][1], 0, 0, 0);
      acc[1][0] = __builtin_amdgcn_mfma_f32_32x32x16_bf16(F2, B0[3], acc[1][0], 0, 0, 0);
      acc[1][1] = __builtin_amdgcn_mfma_f32_32x32x16_bf16(F2, B1[3], acc[1][1], 0, 0, 0);
      F0 = F4; F1 = F5;
      if (D < I0 + 15) {
        const int y1 = ybase - 64 * (D + 1);
        F2 = ld_win8(krr, y1 - 32, ysh); F3 = ld_win8(krr, y1 - 48, ysh);
        F4 = ld_win8(krr, y1 - 64, ysh); F5 = ld_win8(krr, y1 - 80, ysh);
      }
    }
    __syncthreads();
#pragma unroll
    for (int ni = 0; ni < 2; ++ni) {
      u16* zc = zs + (r & 3) * ZB + ZJ * (ni ? Il1 : Il0);
#pragma unroll
      for (int mi = 0; mi < 2; ++mi)
#pragma unroll
        for (int q = 0; q < 16; ++q) {
          int i = 32 * mi + (q & 3) + 8 * (q >> 2) + 4 * h;
          float zo = bf2f(zc[i]);
          zc[i] = f2bf(scale * acc[mi][ni][q] + skip * zo);
        }
    }
    __syncthreads();
    {
      const int ch = (o + 1) * 512 + c;
      const float w0 = cwp[ch], w1 = cwp[1536 + ch], w2 = cwp[3072 + ch], bs = cbp[ch];
#pragma unroll 2
      for (int e = tid; e < 2048; e += 256) {
        int b = e >> 9, t8 = (e & 511) * 8;
        float xg[8], y[8];
        hy_conv3x8(UT + (size_t)ch * NTOK + b * 4096, t8, 4096, w0, w1, w2, bs, xg);
        unpack8(*(const uint4*)(zs + ZI(b, t8)), y);
#pragma unroll
        for (int j = 0; j < 8; ++j) y[j] *= xg[j];
        if (o == 0) *(uint4*)(zs + ZI(b, t8)) = pack8(y);
        else {
          float gf[8]; unpack8(*(const uint4*)(UT + (size_t)(1536 + c) * NTOK + b * 4096 + t8), gf);
#pragma unroll
          for (int j = 0; j < 8; ++j) y[j] *= gf[j];
          *(uint4*)(p.U + (size_t)c * NTOK + b * 4096 + t8) = pack8(y);
        }
      }
    }
    __syncthreads();
  }
  if (l == 0) {
    const int t = tid;
    for (int o = 0; o < 2; ++o) {
      const u16* K = p.KFC + (size_t)(o * 512 + c) * 512;
      float asum = 0.f;
      {
        uint32_t w2 = *(const uint32_t*)(K + tid * 2);
        *(uint32_t*)(krr + tid * 2) = w2;
        asum = fabsf(bflo(w2)) + fabsf(bfhi(w2));
      }
      asum = wave_sum(asum);
      if (lane == 0) red[wave] = asum;
      if (o == 0) {
        const float w0 = cwp[c], w1 = cwp[1536 + c], w2 = cwp[3072 + c], bs = cbp[c];
        if (tid < 128) {
          int b = tid >> 5, t8 = (tid & 31) * 8;
          float f[8];
          hy_conv3x8(UT + (size_t)c * NTOK + NLAT + b * 256, t8, 256, w0, w1, w2, bs, f);
          *(uint4*)(zs + ZI(b, t8)) = pack8(f);
        }
      }
      __syncthreads();
      const float scale = 1.f / (red[0] + red[1] + red[2] + red[3] + 1e-6f);
      float a0 = 0, a1 = 0, a2 = 0, a3 = 0;
      for (int s2 = 0; s2 < 256; ++s2) {
        float kv = bf2f(krr[256 - t + s2]);
        a0 += kv * bf2f(zs[ZI(0, s2)]); a1 += kv * bf2f(zs[ZI(1, s2)]); a2 += kv * bf2f(zs[ZI(2, s2)]); a3 += kv * bf2f(zs[ZI(3, s2)]);
      }
      const float skip = p.hy_skip[(l * 2 + o) * 512 + c];
      float y[4];
      y[0] = scale * a0 + skip * bf2f(zs[ZI(0, t)]); y[1] = scale * a1 + skip * bf2f(zs[ZI(1, t)]);
      y[2] = scale * a2 + skip * bf2f(zs[ZI(2, t)]); y[3] = scale * a3 + skip * bf2f(zs[ZI(3, t)]);
      __syncthreads();
      {
        const int ch = (o + 1) * 512 + c;
        const float w0 = cwp[ch], w1 = cwp[1536 + ch], w2 = cwp[3072 + ch], bs = cbp[ch];
#pragma unroll
        for (int b = 0; b < 4; ++b) {
          const u16* col = UT + (size_t)ch * NTOK + NLAT + b * 256;
          float xg = bs + w1 * bf2f(col[t]);
          if (t > 0) xg += w0 * bf2f(col[t - 1]);
          if (t < 255) xg += w2 * bf2f(col[t + 1]);
          float zn = xg * y[b];
          if (o == 0) zs[ZI(b, t)] = f2bf(zn);
          else {
            size_t R = (size_t)NLAT + b * 256 + t;
            float gate = bf2f(UT[(size_t)(1536 + c) * NTOK + R]);
            p.U[(size_t)c * NTOK + R] = f2bf(zn * gate);
          }
        }
      }
      __syncthreads();
    }
  }
}

__device__ __forceinline__ void fin_rows(const P& p, int l, int chunk) {
  int tid = threadIdx.x; asm volatile("" : "+v"(tid)); const int wave = tid >> 6, lane = tid & 63;
  for (int rr = 0; rr < 16; ++rr) {
    int R = chunk * 64 + wave * 16 + rr;
    {
      uint4* yp = (uint4*)(p.Y2 + (size_t)R * 1024 + lane * 8);
      float o[8]; unpack8(*yp, o);
      float ss = 0;
#pragma unroll
      for (int j = 0; j < 8; ++j) ss += o[j] * o[j];
      ss += __shfl_xor(ss, 1); ss += __shfl_xor(ss, 2); ss += __shfl_xor(ss, 4); ss += __shfl_xor(ss, 8);
      float rinv = rsqrtf(ss * (1.f / 128.f) + EPS);
      float gf[8]; unpack8(*(const uint4*)(p.U + (size_t)NTOK * 2048 + (size_t)R * 2048 + 1024 + lane * 8), gf);
#pragma unroll
      for (int j = 0; j < 8; ++j) o[j] = o[j] * rinv * p.hg_norm_w[l * 512 + lane * 8 + j] * gf[j];
      *yp = pack8(o);
    }
    {
      uint4* yp = (uint4*)(p.Y2 + (size_t)R * 1024 + 512 + lane * 8);
      float o[8]; unpack8(*yp, o);
      float gf[8]; unpack8(*(const uint4*)(p.U + (size_t)NTOK * 2048 + (size_t)R * 2048 + 1536 + lane * 8), gf);
      float ss = 0;
#pragma unroll
      for (int j = 0; j < 8; ++j) { o[j] *= gf[j]; ss += o[j] * o[j]; }
      ss += __shfl_xor(ss, 1); ss += __shfl_xor(ss, 2); ss += __shfl_xor(ss, 4); ss += __shfl_xor(ss, 8); ss += __shfl_xor(ss, 16);
      float rinv = rsqrtf(ss * (1.f / 256.f) + EPS);
#pragma unroll
      for (int j = 0; j < 8; ++j) o[j] = o[j] * rinv * p.m2_norm_w[l * 512 + lane * 8 + j];
      *yp = pack8(o);
    }
  }
}

__device__ __forceinline__ void ph_mixB(const P& p, int l, int bid, int nb, float* sm) {
  for (int t = bid; t < 512 + 512; t += nb) {
    if (t < 512) { if (EN_RG) rg_task<0>(p, l, t, sm); }
    else { if (EN_HY) hy_task(p, l, t - 512, sm); }
    __syncthreads();
  }
}
__device__ __forceinline__ void hy_transpose(const P& p, int tile, u16* sm) {
  int tid = threadIdx.x; asm volatile("" : "+v"(tid));
  const int ct = tile & 7, rt = tile >> 3;
  const int c0 = ct * 64, R0 = rt * 64;
#pragma unroll
  for (int i = 0; i < 2; ++i) {
    int q = tid + 256 * i; int cc = q >> 3, seg = q & 7;
    *(uint4*)(sm + cc * 72 + seg * 8) = *(const uint4*)(p.U + (size_t)(c0 + cc) * NTOK + R0 + seg * 8);
  }
  __syncthreads();
#pragma unroll
  for (int i = 0; i < 2; ++i) {
    int q = tid + 256 * i; int rr = q >> 3, seg = q & 7;
    FragU f;
#pragma unroll
    for (int j = 0; j < 4; ++j)
      f.u[j] = (uint32_t)sm[(seg * 8 + 2 * j) * 72 + rr] | ((uint32_t)sm[(seg * 8 + 2 * j + 1) * 72 + rr] << 16);
    *(uint4*)(p.HL + (size_t)(R0 + rr) * 1024 + c0 + seg * 8) = f.q;
  }
}
__device__ __forceinline__ void ph_mixB2(const P& p, int l, int bid, int nb, float* sm) {
  const int nfin = (l == 0 ? NTOK : NLAT) / 64;
  const int ntr = nfin * 8;
  for (int t = bid; t < 512 + nfin + ntr; t += nb) {
    if (t < 512) { if (EN_RG) rg_task<1>(p, l, t, sm); }
    else if (t < 512 + nfin) fin_rows(p, l, t - 512);
    else hy_transpose(p, t - 512 - nfin, (u16*)sm);
    __syncthreads();
  }
}
__device__ __forceinline__ void ph_final(const P& p, int bid, int nb) {
  int tid = threadIdx.x; asm volatile("" : "+v"(tid)); const int wave = tid >> 6, lane = tid & 63;
  for (int R = bid * 4 + wave; R < NLAT; R += nb * 4) {
    float4* rp = (float4*)(p.out + (size_t)R * 1024);
    float4 v[4]; float ss = 0;
#pragma unroll
    for (int i = 0; i < 4; ++i) {
      v[i] = rp[lane + i * 64];
      ss += v[i].x * v[i].x + v[i].y * v[i].y + v[i].z * v[i].z + v[i].w * v[i].w;
    }
    ss = wave_sum(ss);
    float rinv = rsqrtf(ss * (1.f / 1024.f) + EPS);
#pragma unroll
    for (int i = 0; i < 4; ++i) {
      float4 w = *(const float4*)(p.final_norm_w + (lane + i * 64) * 4);
      float4 o; o.x = v[i].x * rinv * w.x; o.y = v[i].y * rinv * w.y; o.z = v[i].z * rinv * w.z; o.w = v[i].w * rinv * w.w;
      rp[lane + i * 64] = o;
    }
  }
}

#define SMEM_BYTES 57600
__global__ void __launch_bounds__(256, 2) mega(P p) {
  __shared__ __align__(16) unsigned char smem[SMEM_BYTES];
  cg::grid_group grid = cg::this_grid();
  const int bid = blockIdx.x, nb = gridDim.x;
  float* smf = (float*)smem; u16* smh = (u16*)smem;
#ifndef PHM
#define PHM 0xffff
#endif
  if (PHM & 1) ph_mod(p, bid, nb, smf);
  grid.sync();
  for (int l = 0; l < 2; ++l) {
    if (PHM & 2) ph_norm(p, l, bid, nb);
    if (PHM & 4) ph_wconv(p, l, bid, nb, smf);
    grid.sync();
    if (PHM & 16) ph_gemm<0>(p, l, bid, nb, smh);
    grid.sync();
#if PROBE_DUP == 3
    ph_gemm<0>(p, l, bid, nb, smh);
    grid.sync();
#endif
#if PROBE_DUP == 10
    ph_norm(p, l, bid, nb);
    ph_wconv(p, l, bid, nb, smf);
    grid.sync();
#endif
    if (PHM & 32) ph_mixA0(p, l, bid, nb, smem);
    grid.sync();
    if (PHM & 32) ph_mixA1(p, l, bid, nb, smem);
    grid.sync();
#if PROBE_DUP == 8
    ph_mixA0(p, l, bid, nb, smem);
    grid.sync();
    ph_mixA1(p, l, bid, nb, smem);
    grid.sync();
#endif
    if (PHM & 64) ph_gemm<1>(p, l, bid, nb, smh);
    if (PHM & 8) ph_filt(p, l, bid, nb, smf);
    grid.sync();
#if PROBE_DUP == 2
    ph_mixB(p, l, bid, nb, smf);
    grid.sync();
#endif
#if PROBE_DUP == 4
    ph_gemm<1>(p, l, bid, nb, smh);
    grid.sync();
#endif
#if PROBE_DUP == 9
    ph_gemm<1>(p, l, bid, nb, smh, 1);
    grid.sync();
#endif
    if (PHM & 128) ph_mixB(p, l, bid, nb, smf);
    grid.sync();
    if (PHM & 128) ph_mixB2(p, l, bid, nb, smf);
    grid.sync();
#if PROBE_DUP == 7
    for (int t = bid; t < 512; t += nb) { rg_task<1>(p, l, t, smf); __syncthreads(); }
    grid.sync();
#endif
    if (PHM & 256) ph_gemm<2>(p, l, bid, nb, smh);
    grid.sync();
  }
  if (PHM & 512) ph_final(p, bid, nb);
}

extern "C" void kernel_launch(void* const* d_in, const int* in_sizes, int n_in, void* d_out, int out_size,
                              void* d_ws, size_t ws_size, hipStream_t stream) {
  static int grid_blocks = 0;
  if (!grid_blocks) {
    int dev = 0, cus = 0, per_cu = 0;
    hipGetDevice(&dev);
    hipDeviceGetAttribute(&cus, hipDeviceAttributeMultiprocessorCount, dev);
    hipOccupancyMaxActiveBlocksPerMultiprocessor(&per_cu, mega, 256, 0);
    if (per_cu < 1) per_cu = 1;
    if (per_cu > 2) per_cu = 2;
    grid_blocks = cus * per_cu;
  }
  P p{};
  const float** fp = (const float**)&p;
  for (int i = 0; i < 34; ++i) fp[i] = (const float*)d_in[i];
  p.out = (float*)d_out;
  char* w = (char*)d_ws;
  size_t off = 0;
  auto take = [&](size_t bytes) { char* r = w + off; off += (bytes + 255) & ~(size_t)255; return r; };
  p.U = (u16*)take((size_t)NTOK * UW * 2);
  p.HL = (u16*)take((size_t)NTOK * 1024 * 2);
  p.Y2 = (u16*)take((size_t)NTOK * 1024 * 2);
  p.WT = (u16*)take((size_t)7296 * 1024 * 2);
  p.WoT = (u16*)take((size_t)1024 * 2048 * 2);
  p.KF = (u16*)take((size_t)1024 * 8192 * 2);
  p.DT = (float*)take((size_t)NTOK * 8 * 4);
  p.MOD = (float*)take((size_t)2 * 5 * 3072 * 4);
  p.SUM = (float*)take((size_t)4 * 2 * 17 * 512 * 2 * 4);
  {
    char* Z = take((size_t)16777216);
    p.SSH = (float*)Z; p.XC = (float*)(Z + 8388608); p.KFC = (u16*)(Z + 12582912);
  }
  p.PS = (float*)take((size_t)16 * 2 * 8 * 128 * 4);
  p.PA = (float*)take((size_t)16 * 2 * 8 * 4 * 4);
  if (off > ws_size) { fprintf(stderr, "workspace too small: need %zu have %zu\n", off, ws_size); return; }
  void* args[] = {&p};
  hipError_t e = hipLaunchCooperativeKernel((void*)mega, dim3(grid_blocks), dim3(256), args, 0, stream);
  if (e != hipSuccess) fprintf(stderr, "cooperative launch failed: %s (grid %d)\n", hipGetErrorString(e), grid_blocks);
}
```

```cpp
#include <hip/hip_runtime.h>
#include <hip/hip_bf16.h>
#include <hip/hip_cooperative_groups.h>
#include <cstdio>
#include <cstdint>
namespace cg = cooperative_groups;

typedef unsigned short u16;
using bf16x8 = __attribute__((ext_vector_type(8))) short;
using f32x16 = __attribute__((ext_vector_type(16))) float;

#define NTOK 17408
#define NLAT 16384
#define UW 4096
#define EPS 1e-6f

#ifndef PROBE_DUP
#define PROBE_DUP 0
#endif
#ifndef EN_HY
#define EN_HY 1
#endif
#ifndef EN_RG
#define EN_RG 1
#endif
#ifndef EN_HG
#define EN_HG 1
#endif
#ifndef EN_M2
#define EN_M2 1
#endif

struct P {
  const float *x, *c, *ctx, *c_ctx, *w_mod, *b_mod, *norm_w, *w_in, *w_out;
  const float *hy_conv_w, *hy_conv_b, *hy_w1, *hy_b1, *hy_w2, *hy_b2, *hy_w3, *hy_freq, *hy_skip;
  const float *rg_conv_w, *rg_conv_b, *rg_wa, *rg_ba, *rg_wx, *rg_bx, *rg_lam;
  const float *hg_lb, *hg_norm_w, *m2_conv_w, *m2_conv_b, *m2_dt_bias, *m2_a_log, *m2_d, *m2_norm_w, *final_norm_w;
  float* out;
  u16 *U, *HL, *Y2, *WT, *WoT, *KF, *KFC;
  float *XC, *DT, *MOD, *SUM, *SSH, *PS, *PA;
};

typedef __bf16 bf2_t __attribute__((ext_vector_type(2)));
typedef float f2_t __attribute__((ext_vector_type(2)));
__device__ __forceinline__ uint32_t pack2(float a, float b) {
  f2_t v = {a, b};
  return __builtin_bit_cast(uint32_t, __builtin_convertvector(v, bf2_t));
}
__device__ __forceinline__ u16 f2bf(float f) { return (u16)(pack2(f, f) & 0xffffu); }
__device__ __forceinline__ float bf2f(u16 h) { return __uint_as_float(((uint32_t)h) << 16); }
__device__ __forceinline__ float bflo(uint32_t w) { return __uint_as_float(w << 16); }
__device__ __forceinline__ float bfhi(uint32_t w) { return __uint_as_float(w & 0xffff0000u); }
__device__ __forceinline__ float siluf(float x) { return x * __builtin_amdgcn_rcpf(1.f + __expf(-x)); }
__device__ __forceinline__ float sigmf(float x) { return __builtin_amdgcn_rcpf(1.f + __expf(-x)); }
__device__ __forceinline__ float softplusf(float x) { return x > 20.f ? x : log1pf(__expf(x)); }

__device__ __forceinline__ void unpack8(const uint4& v, float* f) {
  f[0] = bflo(v.x); f[1] = bfhi(v.x); f[2] = bflo(v.y); f[3] = bfhi(v.y);
  f[4] = bflo(v.z); f[5] = bfhi(v.z); f[6] = bflo(v.w); f[7] = bfhi(v.w);
}
__device__ __forceinline__ uint4 pack8(const float* f) {
  uint4 v; v.x = pack2(f[0], f[1]); v.y = pack2(f[2], f[3]); v.z = pack2(f[4], f[5]); v.w = pack2(f[6], f[7]);
  return v;
}
__device__ __forceinline__ float wave_sum(float v) {
#pragma unroll
  for (int o = 32; o >= 1; o >>= 1) v += __shfl_xor(v, o);
  return v;
}

__device__ __forceinline__ int pos2row_seq(int b, int p, int dir) {
  if (p < 256) { int t = dir ? 255 - p : p; return NLAT + b * 256 + t; }
  int j = p - 256; int t = dir ? 4095 - j : j; return b * 4096 + t;
}
__device__ __forceinline__ int pos2row_m2(int b, int p, int dir) {
  if (p < 256) { int t = dir ? 255 - p : p; return NLAT + b * 256 + t; }
  int j = p - 256; int jj = dir ? 4095 - j : j; int c = jj >> 6, r = jj & 63; return b * 4096 + r * 64 + c;
}

__device__ __forceinline__ void ph_mod(const P& p, int bid, int nb, float* sm) {
  int tid = threadIdx.x; asm volatile("" : "+v"(tid));
  for (int task = bid; task < 96; task += nb) {
    int l = task / 48, cgi = task % 48;
    int col = cgi * 64 + (tid & 63);
    int kq = tid >> 6;
    float a0 = 0, a1 = 0, a2 = 0, a3 = 0, a4 = 0;
#pragma unroll 8
    for (int k = kq * 256; k < kq * 256 + 256; ++k) {
      float w = p.w_mod[((size_t)l * 1024 + k) * 3072 + col];
      a0 += siluf(p.c[k]) * w; a1 += siluf(p.c[1024 + k]) * w; a2 += siluf(p.c[2048 + k]) * w;
      a3 += siluf(p.c[3072 + k]) * w; a4 += siluf(p.c_ctx[k]) * w;
    }
    sm[(kq * 5 + 0) * 64 + (tid & 63)] = a0; sm[(kq * 5 + 1) * 64 + (tid & 63)] = a1;
    sm[(kq * 5 + 2) * 64 + (tid & 63)] = a2; sm[(kq * 5 + 3) * 64 + (tid & 63)] = a3;
    sm[(kq * 5 + 4) * 64 + (tid & 63)] = a4;
    __syncthreads();
    if (tid < 64) {
      float bm = p.b_mod[l * 3072 + col];
#pragma unroll
      for (int j = 0; j < 5; ++j) {
        float s = sm[(0 * 5 + j) * 64 + tid] + sm[(1 * 5 + j) * 64 + tid] + sm[(2 * 5 + j) * 64 + tid] + sm[(3 * 5 + j) * 64 + tid];
        p.MOD[(size_t)(l * 5 + j) * 3072 + col] = s + bm;
      }
    }
    __syncthreads();
  }
}

__device__ __forceinline__ void ph_norm(const P& p, int l, int bid, int nb) {
  int tid = threadIdx.x; asm volatile("" : "+v"(tid)); const int wave = tid >> 6, lane = tid & 63;
  for (int R = bid * 4 + wave; R < NTOK; R += nb * 4) {
    const float* src; int mj;
    if (R < NLAT) { src = (l == 0 ? p.x : (const float*)p.out) + (size_t)R * 1024; mj = R >> 12; }
    else { int rc = R - NLAT; src = (l == 0 ? p.ctx : (const float*)p.XC) + (size_t)rc * 1024; mj = 4; }
    const float* mod = p.MOD + (size_t)(l * 5 + mj) * 3072;
    float4 v[4]; float ss = 0;
#pragma unroll
    for (int i = 0; i < 4; ++i) {
      v[i] = ((const float4*)src)[lane + i * 64];
      ss += v[i].x * v[i].x + v[i].y * v[i].y + v[i].z * v[i].z + v[i].w * v[i].w;
    }
    ss = wave_sum(ss);
    float rinv = rsqrtf(ss * (1.f / 1024.f) + EPS);
#pragma unroll
    for (int i = 0; i < 4; ++i) {
      int idx = (lane + i * 64) * 4;
      float4 nw = *(const float4*)(p.norm_w + l * 1024 + idx);
      float4 sh = *(const float4*)(mod + idx);
      float4 sc = *(const float4*)(mod + 1024 + idx);
      float h0 = v[i].x * rinv * nw.x * (1.f + sc.x) + sh.x;
      float h1 = v[i].y * rinv * nw.y * (1.f + sc.y) + sh.y;
      float h2 = v[i].z * rinv * nw.z * (1.f + sc.z) + sh.z;
      float h3 = v[i].w * rinv * nw.w * (1.f + sc.w) + sh.w;
      uint2 o; o.x = pack2(h0, h1); o.y = pack2(h2, h3);
      *(uint2*)(p.HL + (size_t)R * 1024 + idx) = o;
    }
  }
}

__device__ __forceinline__ void ph_wconv(const P& p, int l, int bid, int nb, float* sm, int tb, int te) {
  int tid = threadIdx.x; asm volatile("" : "+v"(tid));
  const int T1 = 114 * 16, T2 = 16 * 32;
  for (int t = tb + bid; t < te; t += nb) {
    const float* src; int ld, K, n0, k0, sc0, nvalid; u16* dst;
    if (t < T1) {
      int nt = t / 16, kt = t % 16; n0 = nt * 64; k0 = kt * 64;
      src = p.w_in + (size_t)l * 1024 * 7176; ld = 7176; K = 1024; dst = p.WT; nvalid = 64;
      if (n0 < 2048) sc0 = 3072 + n0;
      else if (n0 < 3072) sc0 = 5632 + (n0 - 2048);
      else if (n0 < 3200) { sc0 = 6656 + (n0 - 3072); nvalid = (n0 == 3072) ? 8 : 0; }
      else { int m = n0 - 3200; if (m < 3072) sc0 = m; else if (m < 3584) sc0 = 5120 + (m - 3072); else sc0 = 6664 + (m - 3584); }
    } else {
      int tt = t - T1; int nt = tt / 32, kt = tt % 32; n0 = nt * 64; k0 = kt * 64;
      src = p.w_out + (size_t)l * 2048 * 1024; ld = 1024; K = 2048; dst = p.WoT; nvalid = 64; sc0 = n0;
    }
#pragma unroll
    for (int i = 0; i < 4; ++i) {
      int kk = (tid >> 4) + 16 * i, cc = (tid & 15) * 4;
      const float* sp = src + (size_t)(k0 + kk) * ld + sc0 + cc;
      float4 v;
      if (nvalid == 64) v = *(const float4*)sp;
      else { v.x = (cc + 0 < nvalid) ? sp[0] : 0.f; v.y = (cc + 1 < nvalid) ? sp[1] : 0.f; v.z = (cc + 2 < nvalid) ? sp[2] : 0.f; v.w = (cc + 3 < nvalid) ? sp[3] : 0.f; }
      sm[kk * 65 + cc + 0] = v.x; sm[kk * 65 + cc + 1] = v.y; sm[kk * 65 + cc + 2] = v.z; sm[kk * 65 + cc + 3] = v.w;
    }
    __syncthreads();
#pragma unroll
    for (int i = 0; i < 2; ++i) {
      int q = tid + 256 * i; int nn = q >> 3, ks = q & 7;
      float f[8];
#pragma unroll
      for (int j = 0; j < 8; ++j) f[j] = sm[(ks * 8 + j) * 65 + nn];
      *(uint4*)(dst + (size_t)(n0 + nn) * K + k0 + ks * 8) = pack8(f);
    }
    __syncthreads();
  }
}

__device__ __forceinline__ void ph_filt(const P& p, int l, int bid, int nb, float* sm) {
  int tid = threadIdx.x; asm volatile("" : "+v"(tid));
  const float HY_MIN = -3.0701134573253945f, HY_MAX = -15.350567286626972f;
  int ntask = 256 + (l == 0 ? 16 : 0);
  float* zs = sm; float* h1 = sm + 544; float* h2 = sm + 544 + 1024;
  for (int task = bid; task < ntask; task += nb) {
    int n, t0; u16* K;
    if (task < 256) { n = 4096; t0 = task * 16; K = p.KF; } else { n = 256; t0 = (task - 256) * 16; K = p.KFC; }
    float inv_nm1 = 1.f / (float)(n - 1);
    for (int e = tid; e < 16 * 33; e += 256) {
      int tt = e / 33, f = e % 33; int t = t0 + tt; float val;
      if (f == 0) val = (float)t * inv_nm1;
      else {
        int bi = (f - 1) & 15;
        float band = 1e-4f + (float)bi * ((15.f - 1e-4f) / 15.f);
        float ang = (6.283185307179586f / (float)n) * (float)t * band;
        val = (f <= 16) ? cosf(ang) : -sinf(ang);
      }
      zs[e] = val;
    }
    __syncthreads();
    for (int e = tid; e < 1024; e += 256) {
      int tt = e >> 6, j = e & 63; float acc = p.hy_b1[l * 64 + j];
#pragma unroll 11
      for (int f = 0; f < 33; ++f) acc += zs[tt * 33 + f] * p.hy_w1[(l * 33 + f) * 64 + j];
      h1[e] = sinf(p.hy_freq[l * 64 + j] * acc);
    }
    __syncthreads();
    for (int e = tid; e < 1024; e += 256) {
      int tt = e >> 6, j = e & 63; float acc = p.hy_b2[l * 64 + j];
#pragma unroll 8
      for (int i = 0; i < 64; ++i) acc += h1[tt * 64 + i] * p.hy_w2[(l * 64 + i) * 64 + j];
      h2[e] = sinf(p.hy_freq[l * 64 + j] * acc);
    }
    __syncthreads();
    for (int r = 0; r < 8; ++r) {
      int col = tid + 256 * r; int o = col >> 10, side = (col >> 9) & 1, c = col & 511;
      float w[64];
#pragma unroll
      for (int i = 0; i < 64; ++i) w[i] = p.hy_w3[(size_t)(l * 64 + i) * 2048 + col];
      float delta = fabsf(HY_MIN + (HY_MAX - HY_MIN) * (float)c / 511.f);
      u16* Kc = K + (size_t)(o * 512 + c) * (2 * n);
      for (int tt = 0; tt < 16; ++tt) {
        float acc = 0;
#pragma unroll
        for (int i = 0; i < 64; ++i) acc += h2[tt * 64 + i] * w[i];
        int t = t0 + tt;
        float val = acc * __expf(-(float)t * inv_nm1 * delta);
        int idx;
        if (side == 0) idx = n - t; else { if (t == 0) { idx = 0; val = 0.f; } else idx = n + t; }
        Kc[idx] = f2bf(val);
      }
    }
    __syncthreads();
  }
}

#define LDSTR 72
template <int MODE>
__device__ __forceinline__ void gemm_tile(const P& p, int l, int mt, int nt, u16* sA, u16* sB, int noepi) {
  int tid = threadIdx.x; asm volatile("" : "+v"(tid)); const int wave = tid >> 6, lane = tid & 63;
  const int wm = wave >> 1, wn = wave & 1;
  const int KT = (MODE == 2) ? 2048 : 1024;
  const u16* Bsrc = (MODE == 0) ? p.WT + (size_t)(nt * 128) * 1024
                  : (MODE == 1) ? p.WT + (size_t)(3200 + nt * 128) * 1024
                                : p.WoT + (size_t)(nt * 128) * 2048;
  f32x16 acc[4][2];
#pragma unroll
  for (int a = 0; a < 4; ++a)
#pragma unroll
    for (int b = 0; b < 2; ++b)
#pragma unroll
      for (int r = 0; r < 16; ++r) acc[a][b][r] = 0.f;
  uint4 ra0, ra1, ra2, ra3, ra4, ra5, ra6, ra7, rb0, rb1, rb2, rb3;
  const int lrow = tid >> 3, lseg = tid & 7;
  const u16* Ab0 = p.HL + (size_t)(mt * 256 + lrow) * 1024 + lseg * 8;
  const u16* Ab1 = p.Y2 + (size_t)(mt * 256 + lrow) * 1024 + lseg * 8;
  const u16* Bb = Bsrc + (size_t)lrow * KT + lseg * 8;
#define GLOADS(K0)                                                                                  \
  {                                                                                                 \
    const u16* ap = (MODE == 2 && (K0) >= 1024) ? Ab1 + ((K0) - 1024) : Ab0 + (K0);                 \
    ra0 = *(const uint4*)(ap); ra1 = *(const uint4*)(ap + 32 * 1024);                               \
    ra2 = *(const uint4*)(ap + 64 * 1024); ra3 = *(const uint4*)(ap + 96 * 1024);                   \
    ra4 = *(const uint4*)(ap + 128 * 1024); ra5 = *(const uint4*)(ap + 160 * 1024);                 \
    ra6 = *(const uint4*)(ap + 192 * 1024); ra7 = *(const uint4*)(ap + 224 * 1024);                 \
    const u16* bp = Bb + (K0);                                                                      \
    rb0 = *(const uint4*)(bp); rb1 = *(const uint4*)(bp + (size_t)32 * KT);                         \
    rb2 = *(const uint4*)(bp + (size_t)64 * KT); rb3 = *(const uint4*)(bp + (size_t)96 * KT);       \
  }
  GLOADS(0)
#pragma unroll 1
  for (int k0 = 0; k0 < KT; k0 += 64) {
    *(uint4*)(sA + (lrow + 0) * LDSTR + lseg * 8) = ra0;   *(uint4*)(sA + (lrow + 32) * LDSTR + lseg * 8) = ra1;
    *(uint4*)(sA + (lrow + 64) * LDSTR + lseg * 8) = ra2;  *(uint4*)(sA + (lrow + 96) * LDSTR + lseg * 8) = ra3;
    *(uint4*)(sA + (lrow + 128) * LDSTR + lseg * 8) = ra4; *(uint4*)(sA + (lrow + 160) * LDSTR + lseg * 8) = ra5;
    *(uint4*)(sA + (lrow + 192) * LDSTR + lseg * 8) = ra6; *(uint4*)(sA + (lrow + 224) * LDSTR + lseg * 8) = ra7;
    *(uint4*)(sB + (lrow + 0) * LDSTR + lseg * 8) = rb0;   *(uint4*)(sB + (lrow + 32) * LDSTR + lseg * 8) = rb1;
    *(uint4*)(sB + (lrow + 64) * LDSTR + lseg * 8) = rb2;  *(uint4*)(sB + (lrow + 96) * LDSTR + lseg * 8) = rb3;
    __syncthreads();
    if (k0 + 64 < KT) GLOADS(k0 + 64)
    __builtin_amdgcn_s_setprio(1);
#pragma unroll
    for (int ks = 0; ks < 4; ++ks) {
      bf16x8 fa[4], fb[2];
#pragma unroll
      for (int mi = 0; mi < 4; ++mi)
        fa[mi] = *(const bf16x8*)(sA + (wm * 128 + mi * 32 + (lane & 31)) * LDSTR + ks * 16 + (lane >> 5) * 8);
#pragma unroll
      for (int ni = 0; ni < 2; ++ni)
        fb[ni] = *(const bf16x8*)(sB + (wn * 64 + ni * 32 + (lane & 31)) * LDSTR + ks * 16 + (lane >> 5) * 8);
#pragma unroll
      for (int mi = 0; mi < 4; ++mi)
#pragma unroll
        for (int ni = 0; ni < 2; ++ni)
          acc[mi][ni] = __builtin_amdgcn_mfma_f32_32x32x16_bf16(fa[mi], fb[ni], acc[mi][ni], 0, 0, 0);
    }
    __builtin_amdgcn_s_setprio(0);
    __syncthreads();
  }
  if (noepi) {
    float sacc = 0.f;
#pragma unroll
    for (int a = 0; a < 4; ++a)
#pragma unroll
      for (int b = 0; b < 2; ++b) sacc += acc[a][b][3];
    if (sacc == 1.2345e30f) p.DT[0] = sacc;
    return;
  }
  const int mj = (mt < 64) ? (mt >> 4) : 4;
  const int c31 = lane & 31, hh = lane >> 5;
  const int gcolA = nt * 128 + wn * 64 + c31, gcolB = gcolA + 32;
  if (MODE == 0 && nt == 24) {
    if (wn == 0 && c31 < 8) {
#pragma unroll
      for (int mi = 0; mi < 4; ++mi)
#pragma unroll
        for (int r = 0; r < 16; ++r) {
          const int R = mt * 256 + wm * 128 + mi * 32 + (r & 3) + 8 * (r >> 2) + 4 * hh;
          p.DT[(size_t)R * 8 + c31] = acc[mi][0][r];
        }
    }
    return;
  }
  if (MODE == 1 && nt < 16) {
    const bool sl = (gcolA >> 9) == 3;
#pragma unroll
    for (int mi = 0; mi < 4; ++mi)
#pragma unroll
      for (int ni = 0; ni < 2; ++ni)
#pragma unroll
        for (int g4 = 0; g4 < 4; ++g4) {
          float v0 = acc[mi][ni][4 * g4], v1 = acc[mi][ni][4 * g4 + 1], v2 = acc[mi][ni][4 * g4 + 2], v3 = acc[mi][ni][4 * g4 + 3];
          if (sl) { v0 = siluf(v0); v1 = siluf(v1); v2 = siluf(v2); v3 = siluf(v3); }
          int R0 = mt * 256 + wm * 128 + mi * 32 + 8 * g4 + 4 * hh;
          uint2 o; o.x = pack2(v0, v1); o.y = pack2(v2, v3);
          *(uint2*)(p.U + (size_t)(ni ? gcolB : gcolA) * NTOK + R0) = o;
        }
    return;
  }
  if (MODE != 2) {
    float lbA = 0.f, lbB = 0.f;
    int kindA = 0, kindB = 0;
    if (MODE == 0) {
      int pa_ = gcolA >> 9, pb_ = gcolB >> 9;
      kindA = (pa_ == 0) ? 1 : (pa_ == 1 || pa_ == 2) ? 2 : 0;
      kindB = (pb_ == 0) ? 1 : (pb_ == 1 || pb_ == 2) ? 2 : 0;
      if (l == 1) {
        if (kindA == 2) { int dir = pa_ - 1, ch = gcolA & 511; lbA = 1.f / (1.f + __expf(p.hg_lb[dir * 512 + ch] - p.hg_lb[(2 + dir) * 512 + ch])); }
        if (kindB == 2) { int dir = pb_ - 1, ch = gcolB & 511; lbB = 1.f / (1.f + __expf(p.hg_lb[dir * 512 + ch] - p.hg_lb[(2 + dir) * 512 + ch])); }
      }
    } else {
      int pa_ = gcolA >> 9, pb_ = gcolB >> 9;
      kindA = (pa_ == 3 || pa_ >= 5) ? 3 : 0;
      kindB = (pb_ == 3 || pb_ >= 5) ? 3 : 0;
    }
    u16* stg = sA + wave * (32 * 72);
    u16* dstbase = (MODE == 0) ? p.U + (size_t)(nt * 128 + wn * 64) : p.U + (size_t)NTOK * 2048 + (size_t)(nt * 128 - 2048 + wn * 64);
    const int ldo = (MODE == 0) ? UW : 2048;
#pragma unroll
    for (int mi = 0; mi < 4; ++mi) {
#pragma unroll
      for (int r = 0; r < 16; ++r) {
        const int rl = (r & 3) + 8 * (r >> 2) + 4 * hh;
        float va = acc[mi][0][r], vb = acc[mi][1][r];
        if (kindA == 1) va *= 0.08838834764831845f; else if (kindA == 2) va = (1.f - lbA) * __builtin_amdgcn_rcpf(1.f + __expf(va)); else if (kindA == 3) va = siluf(va);
        if (kindB == 1) vb *= 0.08838834764831845f; else if (kindB == 2) vb = (1.f - lbB) * __builtin_amdgcn_rcpf(1.f + __expf(vb)); else if (kindB == 3) vb = siluf(vb);
        stg[rl * 72 + c31] = f2bf(va);
        stg[rl * 72 + 32 + c31] = f2bf(vb);
      }
#pragma unroll
      for (int it = 0; it < 4; ++it) {
        const int rl = it * 8 + (lane >> 3), seg = lane & 7;
        uint4 v = *(const uint4*)(stg + rl * 72 + seg * 8);
        const int R = mt * 256 + wm * 128 + mi * 32 + rl;
        *(uint4*)(dstbase + (size_t)R * ldo + seg * 8) = v;
      }
    }
    return;
  }
  {
    float* stgf = (float*)sA + wave * (32 * 68);
    const int seg = lane & 15;
    const int gc0 = nt * 128 + wn * 64 + seg * 4;
    const float4 g4v = *(const float4*)(p.MOD + (size_t)(l * 5 + mj) * 3072 + 2048 + gc0);
#pragma unroll
    for (int mi = 0; mi < 4; ++mi) {
#pragma unroll
      for (int r = 0; r < 16; ++r) {
        const int rl = (r & 3) + 8 * (r >> 2) + 4 * hh;
        stgf[rl * 68 + c31] = acc[mi][0][r];
        stgf[rl * 68 + 32 + c31] = acc[mi][1][r];
      }
#pragma unroll
      for (int it = 0; it < 8; ++it) {
        const int rl = it * 4 + (lane >> 4);
        float4 v = *(const float4*)(stgf + rl * 68 + seg * 4);
        const int R = mt * 256 + wm * 128 + mi * 32 + rl;
        const float* src; float* dst;
        if (R < NLAT) { src = ((l == 0) ? p.x : (const float*)p.out) + (size_t)R * 1024 + gc0; dst = p.out + (size_t)R * 1024 + gc0; }
        else { int rc = R - NLAT; src = p.ctx + (size_t)rc * 1024 + gc0; dst = p.XC + (size_t)rc * 1024 + gc0; }
        float4 xv = *(const float4*)src;
        float4 o; o.x = xv.x + g4v.x * v.x; o.y = xv.y + g4v.y * v.y; o.z = xv.z + g4v.z * v.z; o.w = xv.w + g4v.w * v.w;
        *(float4*)dst = o;
      }
    }
  }
}

template <int MODE>
__device__ __forceinline__ void ph_gemm(const P& p, int l, int bid, int nb, u16* sm, int noepi = 0) {
  const int NT = (MODE == 0) ? 25 : (MODE == 1) ? 32 : 8;
  const int MT = (MODE == 2 && l == 1) ? 64 : 68;
  u16* sA = sm; u16* sB = sm + 256 * LDSTR;
  const int xcd = bid & 7, local = bid >> 3, npx = nb >> 3;
  const int mbase = MT >> 3, mextra = MT & 7;
  const int mper = mbase + (xcd < mextra ? 1 : 0);
  const int mstart = (xcd < mextra) ? xcd * (mbase + 1) : mextra * (mbase + 1) + (xcd - mextra) * mbase;
  const int total = mper * NT;
  const int fullb = NT >> 3, rem = NT & 7;
  for (int it = 0;; ++it) {
    int mt, nt;
    if ((nb & 7) == 0) {
      int q = local + npx * it;
      if (q >= total) break;
      int b, i, bw;
      if (q < fullb * mper * 8) { b = q / (mper * 8); i = q - b * mper * 8; bw = 8; }
      else { b = fullb; i = q - fullb * mper * 8; bw = rem; }
      int sub = i / (4 * bw);
      const int nsub = mper >> 2;
      int mt_off, nt_off;
      if (sub < nsub) { int j = i - sub * 4 * bw; mt_off = j & 3; nt_off = j >> 2; }
      else { int j = i - nsub * 4 * bw; sub = nsub; mt_off = 0; nt_off = j; }
      mt = mstart + sub * 4 + mt_off; nt = b * 8 + nt_off;
    } else {
      int t = bid + it * nb;
      if (t >= MT * NT) break;
      nt = t / MT; mt = t % MT;
    }
    __syncthreads();
    gemm_tile<MODE>(p, l, mt, nt, sA, sB, noepi);
  }
  __syncthreads();
}

__device__ __forceinline__ void hg_task(const P& p, int l, int task, float* sm) {
  int tid = threadIdx.x; asm volatile("" : "+v"(tid)); const int wave = tid >> 6, lane = tid & 63;
  const int b = task >> 5, h = (task >> 3) & 3, es = task & 7;
  const int dg = lane & 15, el = lane >> 4;
  float* qs = sm; float* ks = sm + 4096; float* vs = sm + 8192; float* os = sm + 8192 + 512;
  for (int dir = 0; dir < 2; ++dir) {
    float S[8];
#pragma unroll
    for (int r = 0; r < 8; ++r) S[r] = 0.f;
    for (int chunk = 0; chunk < 136; ++chunk) {
#pragma unroll
      for (int i = 0; i < 2; ++i) {
        int q = tid + 256 * i; int pos = q >> 4, seg = q & 15;
        int R = pos2row_seq(b, chunk * 32 + pos, dir);
        const u16* up = p.U + (size_t)R * UW + h * 128 + seg * 8;
        uint4 qv = *(const uint4*)up;
        uint4 kv = *(const uint4*)(up + 512 + dir * 512);
        float f[8];
        unpack8(qv, f);
        *(float4*)(qs + pos * 128 + seg * 8) = make_float4(f[0], f[1], f[2], f[3]);
        *(float4*)(qs + pos * 128 + seg * 8 + 4) = make_float4(f[4], f[5], f[6], f[7]);
        unpack8(kv, f);
        *(float4*)(ks + pos * 128 + seg * 8) = make_float4(f[0], f[1], f[2], f[3]);
        *(float4*)(ks + pos * 128 + seg * 8 + 4) = make_float4(f[4], f[5], f[6], f[7]);
      }
      {
        int pos = tid >> 3, e2 = (tid & 7) * 2;
        int R = pos2row_seq(b, chunk * 32 + pos, dir);
        uint32_t w = *(const uint32_t*)(p.U + (size_t)R * UW + 1536 + h * 128 + es * 16 + e2);
        vs[pos * 16 + e2] = bflo(w); vs[pos * 16 + e2 + 1] = bfhi(w);
      }
      __syncthreads();
#pragma unroll 4
      for (int i = 0; i < 32; ++i) {
        float4 q0 = *(const float4*)(qs + i * 128 + dg * 8), q1 = *(const float4*)(qs + i * 128 + dg * 8 + 4);
        float4 k0 = *(const float4*)(ks + i * 128 + dg * 8), k1 = *(const float4*)(ks + i * 128 + dg * 8 + 4);
        float v = vs[i * 16 + wave * 4 + el];
        S[0] += k0.x * (v - S[0]); S[1] += k0.y * (v - S[1]); S[2] += k0.z * (v - S[2]); S[3] += k0.w * (v - S[3]);
        S[4] += k1.x * (v - S[4]); S[5] += k1.y * (v - S[5]); S[6] += k1.z * (v - S[6]); S[7] += k1.w * (v - S[7]);
        float o = q0.x * S[0] + q0.y * S[1] + q0.z * S[2] + q0.w * S[3] + q1.x * S[4] + q1.y * S[5] + q1.z * S[6] + q1.w * S[7];
        o += __shfl_xor(o, 1); o += __shfl_xor(o, 2); o += __shfl_xor(o, 4); o += __shfl_xor(o, 8);
        if (dg == 0) os[i * 16 + wave * 4 + el] = o;
      }
      __syncthreads();
      {
        int pos = tid >> 3, e2 = (tid & 7) * 2;
        int R = pos2row_seq(b, chunk * 32 + pos, dir);
        uint32_t* yp = (uint32_t*)(p.Y2 + (size_t)R * 1024 + h * 128 + es * 16 + e2);
        float o0 = os[pos * 16 + e2], o1 = os[pos * 16 + e2 + 1];
        if (dir == 1) { uint32_t w = *yp; o0 += bflo(w); o1 += bfhi(w); }
        *yp = pack2(o0, o1);
      }
    }
    __syncthreads();
  }
}

__device__ __forceinline__ void m2_task(const P& p, int l, int task, float* sm) {
  int tid = threadIdx.x; asm volatile("" : "+v"(tid)); const int wave = tid >> 6, lane = tid & 63;
  const int b = task >> 5, head = (task >> 2) & 7, ps = task & 3;
  const int g = head >> 2;
  const int dg = lane & 15, el = lane >> 4;
  float* Cs = sm; float* Bs = sm + 4096; float* xs = sm + 8192; float* os = sm + 8192 + 512;
  float* dts = sm + 8192 + 1024; float* decs = dts + 32;
  for (int dir = 0; dir < 2; ++dir) {
    const float* cw = p.m2_conv_w + (size_t)(l * 2 + dir) * 4 * 1024;
    const float* cb = p.m2_conv_b + (size_t)(l * 2 + dir) * 1024;
    const float dtb = p.m2_dt_bias[(l * 2 + dir) * 8 + head];
    const float Aneg = -__expf(p.m2_a_log[(l * 2 + dir) * 8 + head]);
    const float Dsk = p.m2_d[(l * 2 + dir) * 8 + head];
    float S[8];
#pragma unroll
    for (int r = 0; r < 8; ++r) S[r] = 0.f;
    for (int chunk = 0; chunk < 136; ++chunk) {
      const int pbase = chunk * 32;
      const int seg0 = (pbase < 256) ? 0 : 256;
#pragma unroll
      for (int i = 0; i < 2; ++i) {
        int q = tid + 256 * i; int pos = q >> 4, seg = q & 15;
        int pp = pbase + pos;
        int chB = 512 + g * 128 + seg * 8, chC = 768 + g * 128 + seg * 8;
        float aB[8], aC[8];
#pragma unroll
        for (int j = 0; j < 8; ++j) { aB[j] = cb[chB + j]; aC[j] = cb[chC + j]; }
#pragma unroll
        for (int tap = 0; tap < 4; ++tap) {
          int pt = pp - 3 + tap;
          if (pt >= seg0) {
            int R = pos2row_m2(b, pt, dir);
            const u16* up = p.U + (size_t)R * UW + 2048;
            uint4 bv = *(const uint4*)(up + chB);
            uint4 cv = *(const uint4*)(up + chC);
            float f[8];
            unpack8(bv, f);
#pragma unroll
            for (int j = 0; j < 8; ++j) aB[j] += cw[tap * 1024 + chB + j] * f[j];
            unpack8(cv, f);
#pragma unroll
            for (int j = 0; j < 8; ++j) aC[j] += cw[tap * 1024 + chC + j] * f[j];
          }
        }
#pragma unroll
        for (int j = 0; j < 8; ++j) { aB[j] = siluf(aB[j]); aC[j] = siluf(aC[j]); }
        *(float4*)(Bs + pos * 128 + seg * 8) = make_float4(aB[0], aB[1], aB[2], aB[3]);
        *(float4*)(Bs + pos * 128 + seg * 8 + 4) = make_float4(aB[4], aB[5], aB[6], aB[7]);
        *(float4*)(Cs + pos * 128 + seg * 8) = make_float4(aC[0], aC[1], aC[2], aC[3]);
        *(float4*)(Cs + pos * 128 + seg * 8 + 4) = make_float4(aC[4], aC[5], aC[6], aC[7]);
      }
      {
        int pos = tid >> 3, e2 = (tid & 7) * 2;
        int pp = pbase + pos;
        int ch = head * 64 + ps * 16 + e2;
        float a0 = cb[ch], a1 = cb[ch + 1];
#pragma unroll
        for (int tap = 0; tap < 4; ++tap) {
          int pt = pp - 3 + tap;
          if (pt >= seg0) {
            int R = pos2row_m2(b, pt, dir);
            uint32_t w = *(const uint32_t*)(p.U + (size_t)R * UW + 2048 + ch);
            a0 += cw[tap * 1024 + ch] * bflo(w); a1 += cw[tap * 1024 + ch + 1] * bfhi(w);
          }
        }
        xs[pos * 16 + e2] = siluf(a0); xs[pos * 16 + e2 + 1] = siluf(a1);
      }
      if (tid < 32) {
        int R = pos2row_m2(b, pbase + tid, dir);
        float dtv = softplusf(p.DT[(size_t)R * 8 + head] + dtb);
        dts[tid] = dtv; decs[tid] = __expf(dtv * Aneg);
      }
      __syncthreads();
#pragma unroll 4
      for (int i = 0; i < 32; ++i) {
        float4 q0 = *(const float4*)(Cs + i * 128 + dg * 8), q1 = *(const float4*)(Cs + i * 128 + dg * 8 + 4);
        float4 k0 = *(const float4*)(Bs + i * 128 + dg * 8), k1 = *(const float4*)(Bs + i * 128 + dg * 8 + 4);
        float xv = xs[i * 16 + wave * 4 + el];
        float a = decs[i]; float v = xv * dts[i];
        S[0] = a * S[0] + k0.x * v; S[1] = a * S[1] + k0.y * v; S[2] = a * S[2] + k0.z * v; S[3] = a * S[3] + k0.w * v;
        S[4] = a * S[4] + k1.x * v; S[5] = a * S[5] + k1.y * v; S[6] = a * S[6] + k1.z * v; S[7] = a * S[7] + k1.w * v;
        float o = q0.x * S[0] + q0.y * S[1] + q0.z * S[2] + q0.w * S[3] + q1.x * S[4] + q1.y * S[5] + q1.z * S[6] + q1.w * S[7];
        o += __shfl_xor(o, 1); o += __shfl_xor(o, 2); o += __shfl_xor(o, 4); o += __shfl_xor(o, 8);
        if (dg == 0) os[i * 16 + wave * 4 + el] = o + Dsk * xv;
      }
      __syncthreads();
      {
        int pos = tid >> 3, e2 = (tid & 7) * 2;
        int R = pos2row_m2(b, pbase + pos, dir);
        uint32_t* yp = (uint32_t*)(p.Y2 + (size_t)R * 1024 + 512 + head * 64 + ps * 16 + e2);
        float o0 = os[pos * 16 + e2], o1 = os[pos * 16 + e2 + 1];
        if (dir == 1) { uint32_t w = *yp; o0 += bflo(w); o1 += bfhi(w); }
        *yp = pack2(o0, o1);
      }
    }
    __syncthreads();
  }
}

#ifndef M2_MFMA
#define M2_MFMA 1
#endif
#define QS 136
#define TS 40
union FragU { bf16x8 v; uint32_t u[4]; uint2 d[2]; uint4 q; };
__device__ __forceinline__ bf16x8 cvt_frag(const f32x16& x, int s2) {
  FragU f;
  f.u[0] = pack2(x[8 * s2 + 0], x[8 * s2 + 1]); f.u[1] = pack2(x[8 * s2 + 2], x[8 * s2 + 3]);
  f.u[2] = pack2(x[8 * s2 + 4], x[8 * s2 + 5]); f.u[3] = pack2(x[8 * s2 + 6], x[8 * s2 + 7]);
  return f.v;
}
__device__ __forceinline__ bf16x8 ld_frag_perm(const u16* base) {
  FragU f; f.d[0] = *(const uint2*)base; f.d[1] = *(const uint2*)(base + 8); return f.v;
}

template <int PASS>
__device__ __forceinline__ void hg_mfma(const P& p, int l, int task, int blk, int dir0, unsigned char* smem) {
  int tid = threadIdx.x; asm volatile("" : "+v"(tid)); const int wave = tid >> 6, lane = tid & 63;
  const int r = lane & 31, hh = lane >> 5;
  const int b = task >> 2, h = task & 3;
  u16* ks = (u16*)smem;
  u16* qs = ks + 32 * QS;
  u16* kT = qs + 32 * QS;
  u16* vT = kT + 128 * TS;
  float* tot = (float*)(vT + 128 * TS);
  float* eg = tot + 256;
  const int dd = tid & 127, half = tid >> 7;
  for (int dir = (PASS == 0 ? dir0 : 0); dir < (PASS == 0 ? dir0 + 1 : 2); ++dir) {
    const int sbd = (PASS == 0) ? blk : ((blk == 0) ? 0 : (dir ? 9 - blk : blk));
    const int c0 = (sbd == 0) ? 0 : 8 + 16 * (sbd - 1);
    const int c1 = (sbd == 0) ? 8 : 8 + 16 * sbd;
    float gsum = 0.f;
    f32x16 S[4];
#pragma unroll
    for (int i = 0; i < 4; ++i)
#pragma unroll
      for (int q = 0; q < 16; ++q) S[i][q] = 0.f;
    if (PASS == 1) {
      for (int qb = 0; qb < sbd; ++qb) {
        const size_t sidx = (size_t)((task * 2 + dir) * 8 + qb);
        if (half == 0) eg[dd] = __expf(p.PS[sidx * 128 + dd]);
        __syncthreads();
        const float* sp = p.SSH + sidx * 16384 + (size_t)wave * 4096 + lane;
#pragma unroll
        for (int dt = 0; dt < 4; ++dt)
#pragma unroll
          for (int q4 = 0; q4 < 4; ++q4) {
            float4 e4 = *(const float4*)(eg + 32 * dt + 8 * q4 + 4 * hh);
            S[dt][4 * q4 + 0] = S[dt][4 * q4 + 0] * e4.x + sp[(dt * 16 + 4 * q4 + 0) * 64];
            S[dt][4 * q4 + 1] = S[dt][4 * q4 + 1] * e4.y + sp[(dt * 16 + 4 * q4 + 1) * 64];
            S[dt][4 * q4 + 2] = S[dt][4 * q4 + 2] * e4.z + sp[(dt * 16 + 4 * q4 + 2) * 64];
            S[dt][4 * q4 + 3] = S[dt][4 * q4 + 3] * e4.w + sp[(dt * 16 + 4 * q4 + 3) * 64];
          }
        __syncthreads();
      }
    }
    uint4 pq0, pq1, pk0, pk1, pv0, pv1;
#define HG_PREFETCH(CH)                                                                     \
    {                                                                                       \
      int pos0 = tid >> 4, seg = tid & 15;                                                  \
      int R0 = pos2row_seq(b, (CH) * 32 + pos0, dir), R1 = pos2row_seq(b, (CH) * 32 + pos0 + 16, dir); \
      const u16* u0 = p.U + (size_t)R0 * UW + h * 128 + seg * 8;                            \
      const u16* u1 = p.U + (size_t)R1 * UW + h * 128 + seg * 8;                            \
      pq0 = *(const uint4*)u0; pq1 = *(const uint4*)u1;                                     \
      pk0 = *(const uint4*)(u0 + 512 + dir * 512); pk1 = *(const uint4*)(u1 + 512 + dir * 512); \
      int Rv = pos2row_seq(b, (CH) * 32 + (tid & 31), dir);                                 \
      const u16* uv = p.U + (size_t)Rv * UW + 1536 + h * 128 + (tid >> 5) * 16;             \
      pv0 = *(const uint4*)uv; pv1 = *(const uint4*)(uv + 8);                               \
    }
    HG_PREFETCH(c0)
#pragma unroll 1
    for (int chunk = c0; chunk < c1; ++chunk) {
      {
        int pos0 = tid >> 4, seg = tid & 15;
        *(uint4*)(qs + pos0 * QS + seg * 8) = pq0; *(uint4*)(qs + (pos0 + 16) * QS + seg * 8) = pq1;
        *(uint4*)(ks + pos0 * QS + seg * 8) = pk0; *(uint4*)(ks + (pos0 + 16) * QS + seg * 8) = pk1;
        FragU f0, f1; f0.q = pv0; f1.q = pv1;
        u16* vw = vT + ((tid >> 5) * 16) * TS + (tid & 31);
#pragma unroll
        for (int j = 0; j < 4; ++j) {
          vw[(2 * j) * TS] = (u16)(f0.u[j] & 0xffffu); vw[(2 * j + 1) * TS] = (u16)(f0.u[j] >> 16);
          vw[(8 + 2 * j) * TS] = (u16)(f1.u[j] & 0xffffu); vw[(8 + 2 * j + 1) * TS] = (u16)(f1.u[j] >> 16);
        }
      }
      __syncthreads();
      if (chunk + 1 < c1) HG_PREFETCH(chunk + 1)
      const int Rout = pos2row_seq(b, chunk * 32 + r, dir);
      u16* yrow = p.Y2 + (size_t)Rout * 1024 + h * 128 + wave * 32 + 4 * hh;
      uint2 yold[4];
      if (PASS == 1 && dir == 1) {
#pragma unroll
        for (int q4 = 0; q4 < 4; ++q4) yold[q4] = *(const uint2*)(yrow + 8 * q4);
      }
      float gl[16];
      {
        float run = 0.f;
#pragma unroll
        for (int i = 0; i < 16; ++i) {
          float kkv = bf2f(ks[(half * 16 + i) * QS + dd]);
          run += __logf(fmaxf(1.f - kkv, 1e-6f));
          gl[i] = run;
        }
        tot[half * 128 + dd] = run;
      }
      __syncthreads();
      {
        const float t0 = tot[dd], t1 = tot[128 + dd];
        const float off = half ? t0 : 0.f;
        const float g31 = t0 + t1;
        float k2[16];
#pragma unroll
        for (int i = 0; i < 16; ++i) {
          const int pos = half * 16 + i;
          const float g = gl[i] + off;
          const float kkv = bf2f(ks[pos * QS + dd]);
          const float qv = bf2f(qs[pos * QS + dd]);
          qs[pos * QS + dd] = f2bf(qv * __expf(g));
          ks[pos * QS + dd] = f2bf(kkv * __expf(fminf(-g, 60.f)));
          k2[i] = kkv * __expf(g31 - g);
        }
        *(uint4*)(kT + dd * TS + half * 16) = pack8(k2);
        *(uint4*)(kT + dd * TS + half * 16 + 8) = pack8(k2 + 8);
        if (half == 0) eg[dd] = __expf(g31);
        gsum += g31;
      }
      __syncthreads();
      f32x16 O;
      if (PASS == 1) {
      f32x16 att;
#pragma unroll
      for (int q = 0; q < 16; ++q) att[q] = 0.f;
#pragma unroll
      for (int k8 = 0; k8 < 8; ++k8) {
        bf16x8 A = *(const bf16x8*)(ks + r * QS + 16 * k8 + 8 * hh);
        bf16x8 B = *(const bf16x8*)(qs + r * QS + 16 * k8 + 8 * hh);
        att = __builtin_amdgcn_mfma_f32_32x32x16_bf16(A, B, att, 0, 0, 0);
      }
#pragma unroll
      for (int q = 0; q < 16; ++q) {
        int sidx = (q & 3) + 8 * (q >> 2) + 4 * hh;
        if (sidx > r) att[q] = 0.f;
      }
#pragma unroll
      for (int q = 0; q < 16; ++q) O[q] = 0.f;
#pragma unroll
      for (int dt = 0; dt < 4; ++dt)
#pragma unroll
        for (int s2 = 0; s2 < 2; ++s2) {
          bf16x8 A = cvt_frag(S[dt], s2);
          bf16x8 B = ld_frag_perm(qs + r * QS + 32 * dt + 16 * s2 + 4 * hh);
          O = __builtin_amdgcn_mfma_f32_32x32x16_bf16(A, B, O, 0, 0, 0);
        }
#pragma unroll
      for (int s2 = 0; s2 < 2; ++s2) {
        bf16x8 A = ld_frag_perm(vT + (32 * wave + r) * TS + 16 * s2 + 4 * hh);
        bf16x8 B = cvt_frag(att, s2);
        O = __builtin_amdgcn_mfma_f32_32x32x16_bf16(A, B, O, 0, 0, 0);
      }
      }
#pragma unroll
      for (int dt = 0; dt < 4; ++dt) {
#pragma unroll
        for (int q4 = 0; q4 < 4; ++q4) {
          float4 e4 = *(const float4*)(eg + 32 * dt + 8 * q4 + 4 * hh);
          S[dt][4 * q4 + 0] *= e4.x; S[dt][4 * q4 + 1] *= e4.y; S[dt][4 * q4 + 2] *= e4.z; S[dt][4 * q4 + 3] *= e4.w;
        }
#pragma unroll
        for (int s2 = 0; s2 < 2; ++s2) {
          bf16x8 A = *(const bf16x8*)(kT + (32 * dt + r) * TS + 16 * s2 + 8 * hh);
          bf16x8 B = *(const bf16x8*)(vT + (32 * wave + r) * TS + 16 * s2 + 8 * hh);
          S[dt] = __builtin_amdgcn_mfma_f32_32x32x16_bf16(A, B, S[dt], 0, 0, 0);
        }
      }
      if (PASS == 1) {
#pragma unroll
      for (int q4 = 0; q4 < 4; ++q4) {
        float o0 = O[4 * q4], o1 = O[4 * q4 + 1], o2 = O[4 * q4 + 2], o3 = O[4 * q4 + 3];
        if (dir == 1) { o0 += bflo(yold[q4].x); o1 += bfhi(yold[q4].x); o2 += bflo(yold[q4].y); o3 += bfhi(yold[q4].y); }
        uint2 ov; ov.x = pack2(o0, o1); ov.y = pack2(o2, o3);
        *(uint2*)(yrow + 8 * q4) = ov;
      }
      }
      __syncthreads();
    }
    if (PASS == 0) {
      const size_t sidx = (size_t)((task * 2 + dir) * 8 + sbd);
      if (half == 0) p.PS[sidx * 128 + dd] = gsum;
      float* sp = p.SSH + sidx * 16384 + (size_t)wave * 4096 + lane;
#pragma unroll
      for (int dt = 0; dt < 4; ++dt)
#pragma unroll
        for (int q = 0; q < 16; ++q) sp[(dt * 16 + q) * 64] = S[dt][q];
    }
    __syncthreads();
  }
}

#if M2_MFMA
#define M2_NTASK 16
template <int PASS>
__device__ __forceinline__ void m2_mfma(const P& p, int l, int task, int blk, int dir0, unsigned char* smem) {
  int tid = threadIdx.x; asm volatile("" : "+v"(tid)); const int wave = tid >> 6, lane = tid & 63;
  const int r = lane & 31, hh = lane >> 5;
  const int b = task >> 2, g = (task >> 1) & 1, hp = task & 1;
  const int hq = wave >> 1, ph = wave & 1;
  const int head = 4 * g + 2 * hp + hq;
  u16* Bm = (u16*)smem;
  u16* Cm = Bm + 32 * QS;
  u16* BmT = Cm + 32 * QS;
  u16* xsT = BmT + 128 * TS;
  float* Gs = (float*)(xsT + 128 * TS);
  float* dts = Gs + 64;
  float* wl = dts + 64;
  const int cp = (lane < 48) ? lane : 47;
  const bool act = lane < 48;
  const int chW = (cp < 16) ? ((4 * g + 2 * hp) * 64 + cp * 8) : (cp < 32) ? (512 + g * 128 + (cp - 16) * 8) : (768 + g * 128 + (cp - 32) * 8);
  const int chU = 2048 + chW;
  float* SSM = (float*)p.KF;
  for (int dir = (PASS == 0 ? dir0 : 0); dir < (PASS == 0 ? dir0 + 1 : 2); ++dir) {
    const int sbd = (PASS == 0) ? blk : ((blk == 0) ? 0 : (dir ? 9 - blk : blk));
    const int c0 = (sbd == 0) ? 0 : 8 + 16 * (sbd - 1);
    const int c1 = (sbd == 0) ? 8 : 8 + 16 * sbd;
    float lsum = 0.f;
    const float* cw = p.m2_conv_w + (size_t)(l * 2 + dir) * 4 * 1024;
    const float* cb = p.m2_conv_b + (size_t)(l * 2 + dir) * 1024;
    if (wave == 0) {
#pragma unroll
      for (int j = 0; j < 8; ++j) {
        wl[(4 * 8 + j) * 64 + lane] = cb[chW + j];
#pragma unroll
        for (int tap = 0; tap < 4; ++tap) wl[(tap * 8 + j) * 64 + lane] = cw[tap * 1024 + chW + j];
      }
    }
    __syncthreads();
    const int hd_t = 4 * g + 2 * hp + ((tid >> 5) & 1);
    const float dtb = p.m2_dt_bias[(l * 2 + dir) * 8 + hd_t];
    const float Aneg_t = -__expf(p.m2_a_log[(l * 2 + dir) * 8 + hd_t]);
    const float Dsk = p.m2_d[(l * 2 + dir) * 8 + head];
    f32x16 S[4];
#pragma unroll
    for (int i = 0; i < 4; ++i)
#pragma unroll
      for (int q = 0; q < 16; ++q) S[i][q] = 0.f;
    if (PASS == 1) {
      for (int qb = 0; qb < sbd; ++qb) {
        const size_t sidx = (size_t)((task * 2 + dir) * 8 + qb);
        const float a = __expf(p.PA[sidx * 4 + wave]);
        const float* sp = SSM + sidx * 16384 + (size_t)wave * 4096 + lane;
#pragma unroll
        for (int nt = 0; nt < 4; ++nt)
#pragma unroll
          for (int q = 0; q < 16; ++q) S[nt][q] = S[nt][q] * a + sp[(nt * 16 + q) * 64];
      }
    }
    uint4 raw0, raw1, raw2, raw3, raw4, raw5, raw6, raw7, raw8, raw9, raw10;
    float dtraw = 0.f;
#define M2_LD1(RW, I, CH)                                                                  \
    {                                                                                      \
      int pt = (CH) * 32 + wave * 8 + (I) - 3;                                             \
      int sg0 = ((CH) * 32 < 256) ? 0 : 256;                                               \
      if (pt >= sg0) { int Rr = pos2row_m2(b, pt, dir); RW = *(const uint4*)(p.U + (size_t)Rr * UW + chU); } \
      else RW = make_uint4(0u, 0u, 0u, 0u);                                                \
    }
#define M2_PREFETCH(CH)                                                                    \
    M2_LD1(raw0, 0, CH) M2_LD1(raw1, 1, CH) M2_LD1(raw2, 2, CH) M2_LD1(raw3, 3, CH) M2_LD1(raw4, 4, CH) M2_LD1(raw5, 5, CH) \
    M2_LD1(raw6, 6, CH) M2_LD1(raw7, 7, CH) M2_LD1(raw8, 8, CH) M2_LD1(raw9, 9, CH) M2_LD1(raw10, 10, CH)            \
    if (tid < 64) { int Rr = pos2row_m2(b, (CH) * 32 + (tid & 31), dir); dtraw = p.DT[(size_t)Rr * 8 + hd_t]; }
    M2_PREFETCH(c0)
#pragma unroll 1
    for (int chunk = c0; chunk < c1; ++chunk) {
      {
#define M2_RAWF(RW, J) (((J) & 1) ? bfhi((RW)) : bflo((RW)))
#define M2_CH(J, C0, C1, C2, C3, C4, C5, C6, C7, C8, C9, C10)                               \
        {                                                                                  \
          const float q0 = wl[(0 * 8 + (J)) * 64 + lane], q1 = wl[(1 * 8 + (J)) * 64 + lane]; \
          const float q2 = wl[(2 * 8 + (J)) * 64 + lane], q3 = wl[(3 * 8 + (J)) * 64 + lane]; \
          const float qb = wl[(4 * 8 + (J)) * 64 + lane];                                  \
          const float v0 = M2_RAWF(C0, J), v1 = M2_RAWF(C1, J), v2 = M2_RAWF(C2, J), v3 = M2_RAWF(C3, J); \
          const float v4 = M2_RAWF(C4, J), v5 = M2_RAWF(C5, J), v6 = M2_RAWF(C6, J), v7 = M2_RAWF(C7, J); \
          const float v8 = M2_RAWF(C8, J), v9 = M2_RAWF(C9, J), v10 = M2_RAWF(C10, J);      \
          float o[8];                                                                      \
          o[0] = siluf(qb + q0 * v0 + q1 * v1 + q2 * v2 + q3 * v3);                        \
          o[1] = siluf(qb + q0 * v1 + q1 * v2 + q2 * v3 + q3 * v4);                        \
          o[2] = siluf(qb + q0 * v2 + q1 * v3 + q2 * v4 + q3 * v5);                        \
          o[3] = siluf(qb + q0 * v3 + q1 * v4 + q2 * v5 + q3 * v6);                        \
          o[4] = siluf(qb + q0 * v4 + q1 * v5 + q2 * v6 + q3 * v7);                        \
          o[5] = siluf(qb + q0 * v5 + q1 * v6 + q2 * v7 + q3 * v8);                        \
          o[6] = siluf(qb + q0 * v6 + q1 * v7 + q2 * v8 + q3 * v9);                        \
          o[7] = siluf(qb + q0 * v7 + q1 * v8 + q2 * v9 + q3 * v10);                       \
          if (act) {                                                                       \
            if (cp < 16) {                                                                 \
              *(uint4*)(xsT + (cp * 8 + (J)) * TS + wave * 8) = pack8(o);                  \
            } else if (cp < 32) {                                                          \
              *(uint4*)(BmT + ((cp - 16) * 8 + (J)) * TS + wave * 8) = pack8(o);           \
              _Pragma("unroll") for (int i = 0; i < 8; ++i) Bm[(wave * 8 + i) * QS + (cp - 16) * 8 + (J)] = f2bf(o[i]); \
            } else {                                                                       \
              _Pragma("unroll") for (int i = 0; i < 8; ++i) Cm[(wave * 8 + i) * QS + (cp - 32) * 8 + (J)] = f2bf(o[i]); \
            }                                                                              \
          }                                                                                \
        }
        M2_CH(0, raw0.x, raw1.x, raw2.x, raw3.x, raw4.x, raw5.x, raw6.x, raw7.x, raw8.x, raw9.x, raw10.x)
        M2_CH(1, raw0.x, raw1.x, raw2.x, raw3.x, raw4.x, raw5.x, raw6.x, raw7.x, raw8.x, raw9.x, raw10.x)
        M2_CH(2, raw0.y, raw1.y, raw2.y, raw3.y, raw4.y, raw5.y, raw6.y, raw7.y, raw8.y, raw9.y, raw10.y)
        M2_CH(3, raw0.y, raw1.y, raw2.y, raw3.y, raw4.y, raw5.y, raw6.y, raw7.y, raw8.y, raw9.y, raw10.y)
        M2_CH(4, raw0.z, raw1.z, raw2.z, raw3.z, raw4.z, raw5.z, raw6.z, raw7.z, raw8.z, raw9.z, raw10.z)
        M2_CH(5, raw0.z, raw1.z, raw2.z, raw3.z, raw4.z, raw5.z, raw6.z, raw7.z, raw8.z, raw9.z, raw10.z)
        M2_CH(6, raw0.w, raw1.w, raw2.w, raw3.w, raw4.w, raw5.w, raw6.w, raw7.w, raw8.w, raw9.w, raw10.w)
        M2_CH(7, raw0.w, raw1.w, raw2.w, raw3.w, raw4.w, raw5.w, raw6.w, raw7.w, raw8.w, raw9.w, raw10.w)
      }
      if (tid < 64) {
        float dtv = softplusf(dtraw + dtb);
        float run = dtv * Aneg_t;
#pragma unroll
        for (int o = 1; o < 32; o <<= 1) { float n = __shfl_up(run, o, 32); if ((tid & 31) >= o) run += n; }
        Gs[tid] = run; dts[tid] = dtv;
      }
      __syncthreads();
      if (chunk + 1 < c1) { M2_PREFETCH(chunk + 1) }
      const int Rout = pos2row_m2(b, chunk * 32 + r, dir);
      u16* yrow = p.Y2 + (size_t)Rout * 1024 + 512 + head * 64 + 32 * ph + 4 * hh;
      uint2 yold[4];
      if (PASS == 1 && dir == 1) {
#pragma unroll
        for (int i = 0; i < 4; ++i) yold[i] = *(const uint2*)(yrow + 8 * i);
      }
      const float* Gw = Gs + hq * 32; const float* dw = dts + hq * 32;
      const float Gt = Gw[r], G31 = Gw[31];
      lsum += G31;
      const u16* xw = xsT + (hq * 64 + ph * 32) * TS;
      f32x16 O0;
      if (PASS == 1) {
      f32x16 att;
#pragma unroll
      for (int q = 0; q < 16; ++q) att[q] = 0.f;
#pragma unroll
      for (int k8 = 0; k8 < 8; ++k8) {
        bf16x8 A = *(const bf16x8*)(Bm + r * QS + 16 * k8 + 8 * hh);
        bf16x8 B = *(const bf16x8*)(Cm + r * QS + 16 * k8 + 8 * hh);
        att = __builtin_amdgcn_mfma_f32_32x32x16_bf16(A, B, att, 0, 0, 0);
      }
#pragma unroll
      for (int q4 = 0; q4 < 4; ++q4) {
        float4 gs4 = *(const float4*)(Gw + 8 * q4 + 4 * hh);
        float4 dt4 = *(const float4*)(dw + 8 * q4 + 4 * hh);
        int s0 = 8 * q4 + 4 * hh;
        att[4 * q4 + 0] = (s0 + 0 <= r) ? att[4 * q4 + 0] * __expf(Gt - gs4.x) * dt4.x : 0.f;
        att[4 * q4 + 1] = (s0 + 1 <= r) ? att[4 * q4 + 1] * __expf(Gt - gs4.y) * dt4.y : 0.f;
        att[4 * q4 + 2] = (s0 + 2 <= r) ? att[4 * q4 + 2] * __expf(Gt - gs4.z) * dt4.z : 0.f;
        att[4 * q4 + 3] = (s0 + 3 <= r) ? att[4 * q4 + 3] * __expf(Gt - gs4.w) * dt4.w : 0.f;
      }
#pragma unroll
      for (int q = 0; q < 16; ++q) O0[q] = 0.f;
#pragma unroll
      for (int nt = 0; nt < 4; ++nt)
#pragma unroll
        for (int s2 = 0; s2 < 2; ++s2) {
          bf16x8 B = ld_frag_perm(Cm + r * QS + 32 * nt + 16 * s2 + 4 * hh);
          O0 = __builtin_amdgcn_mfma_f32_32x32x16_bf16(cvt_frag(S[nt], s2), B, O0, 0, 0, 0);
        }
      {
        const float eGt = __expf(Gt);
#pragma unroll
        for (int q = 0; q < 16; ++q) O0[q] *= eGt;
      }
#pragma unroll
      for (int s2 = 0; s2 < 2; ++s2) {
        bf16x8 B = cvt_frag(att, s2);
        O0 = __builtin_amdgcn_mfma_f32_32x32x16_bf16(ld_frag_perm(xw + r * TS + 16 * s2 + 4 * hh), B, O0, 0, 0, 0);
      }
#pragma unroll
      for (int q = 0; q < 16; ++q) {
        int pp = (q & 3) + 8 * (q >> 2) + 4 * hh;
        O0[q] += Dsk * bf2f(xw[pp * TS + r]);
      }
      }
      {
        const float eG31 = __expf(G31);
#pragma unroll
        for (int nt = 0; nt < 4; ++nt)
#pragma unroll
          for (int q = 0; q < 16; ++q) S[nt][q] *= eG31;
#pragma unroll
        for (int s2 = 0; s2 < 2; ++s2) {
          float ws[8];
          {
            float4 ga = *(const float4*)(Gw + 16 * s2 + 8 * hh), gb = *(const float4*)(Gw + 16 * s2 + 8 * hh + 4);
            float4 da = *(const float4*)(dw + 16 * s2 + 8 * hh), db = *(const float4*)(dw + 16 * s2 + 8 * hh + 4);
            ws[0] = da.x * __expf(G31 - ga.x); ws[1] = da.y * __expf(G31 - ga.y); ws[2] = da.z * __expf(G31 - ga.z); ws[3] = da.w * __expf(G31 - ga.w);
            ws[4] = db.x * __expf(G31 - gb.x); ws[5] = db.y * __expf(G31 - gb.y); ws[6] = db.z * __expf(G31 - gb.z); ws[7] = db.w * __expf(G31 - gb.w);
          }
          bf16x8 Bf0;
          {
            float f[8]; unpack8(*(const uint4*)(xw + r * TS + 16 * s2 + 8 * hh), f);
#pragma unroll
            for (int j = 0; j < 8; ++j) f[j] *= ws[j];
            FragU u; u.q = pack8(f); Bf0 = u.v;
          }
#pragma unroll
          for (int nt = 0; nt < 4; ++nt) {
            bf16x8 A = *(const bf16x8*)(BmT + (32 * nt + r) * TS + 16 * s2 + 8 * hh);
            S[nt] = __builtin_amdgcn_mfma_f32_32x32x16_bf16(A, Bf0, S[nt], 0, 0, 0);
          }
        }
      }
      if (PASS == 1) {
#pragma unroll
      for (int q4 = 0; q4 < 4; ++q4) {
        float o0 = O0[4 * q4], o1 = O0[4 * q4 + 1], o2 = O0[4 * q4 + 2], o3 = O0[4 * q4 + 3];
        if (dir == 1) { o0 += bflo(yold[q4].x); o1 += bfhi(yold[q4].x); o2 += bflo(yold[q4].y); o3 += bfhi(yold[q4].y); }
        uint2 ov; ov.x = pack2(o0, o1); ov.y = pack2(o2, o3);
        *(uint2*)(yrow + 8 * q4) = ov;
      }
      }
      __syncthreads();
    }
    if (PASS == 0) {
      const size_t sidx = (size_t)((task * 2 + dir) * 8 + sbd);
      if (lane == 0) p.PA[sidx * 4 + wave] = lsum;
      float* sp = SSM + sidx * 16384 + (size_t)wave * 4096 + lane;
#pragma unroll
      for (int nt = 0; nt < 4; ++nt)
#pragma unroll
        for (int q = 0; q < 16; ++q) sp[(nt * 16 + q) * 64] = S[nt][q];
    }
    __syncthreads();
  }
}
#endif
__device__ __forceinline__ void ph_mixA0(const P& p, int l, int bid, int nb, unsigned char* sm) {
  for (int t = bid; t < 512; t += nb) {
    if (t < 256) hg_mfma<0>(p, l, t >> 4, (t >> 1) & 7, t & 1, sm);
    else { int u = t - 256; m2_mfma<0>(p, l, u >> 4, (u >> 1) & 7, u & 1, sm); }
    __syncthreads();
  }
}
__device__ __forceinline__ void ph_mixA1(const P& p, int l, int bid, int nb, unsigned char* sm) {
  for (int t = bid; t < 288; t += nb) {
    if (t < 128) hg_mfma<1>(p, l, t >> 3, 1 + (t & 7), 0, sm);
    else if (t < 256) { int u = t - 128; m2_mfma<1>(p, l, u >> 3, 1 + (u & 7), 0, sm); }
    else if (t < 272) hg_mfma<1>(p, l, t - 256, 0, 0, sm);
    else m2_mfma<1>(p, l, t - 272, 0, 0, sm);
    __syncthreads();
  }
}

template <int PASS>
__device__ __forceinline__ void rg_task(const P& p, int l, int task, float* sm) {
  int tid = threadIdx.x; asm volatile("" : "+v"(tid));
  const int wave = tid >> 6, lane = tid & 63;
  const int b = task >> 7, head = (task >> 4) & 7, sb = task & 15;
  float* xc = sm;
  float* pa = sm + 2048;
  float* pb = sm + 4096;
  u16* xcb = (u16*)(sm + 6144);
  u16* WTl = xcb + 32 * 72;
  const int j = tid & 63;
  const int spos = tid >> 3, sseg = tid & 7;
  const int sch = head * 64 + sseg * 8;
  const u16* UB2 = p.U + (size_t)NTOK * 2048;
  for (int dir = 0; dir < 2; ++dir) {
    const int ld = l * 2 + dir;
    {
      const float* wa = p.rg_wa + (size_t)(ld * 8 + head) * 4096;
      const float* wx = p.rg_wx + (size_t)(ld * 8 + head) * 4096;
#pragma unroll
      for (int it = 0; it < 4; ++it) {
        int i = (tid >> 4) + 16 * it, j4 = (tid & 15) * 4;
        float4 va = *(const float4*)(wa + i * 64 + j4);
        float4 vx = *(const float4*)(wx + i * 64 + j4);
        WTl[(j4 + 0) * 72 + i] = f2bf(va.x); WTl[(j4 + 1) * 72 + i] = f2bf(va.y);
        WTl[(j4 + 2) * 72 + i] = f2bf(va.z); WTl[(j4 + 3) * 72 + i] = f2bf(va.w);
        WTl[(64 + j4 + 0) * 72 + i] = f2bf(vx.x); WTl[(64 + j4 + 1) * 72 + i] = f2bf(vx.y);
        WTl[(64 + j4 + 2) * 72 + i] = f2bf(vx.z); WTl[(64 + j4 + 3) * 72 + i] = f2bf(vx.w);
      }
    }
    float wcv[4][8], bcv[8];
#pragma unroll
    for (int jj = 0; jj < 8; ++jj) {
      bcv[jj] = p.rg_conv_b[(size_t)ld * 512 + sch + jj];
#pragma unroll
      for (int tap = 0; tap < 4; ++tap) wcv[tap][jj] = p.rg_conv_w[((size_t)ld * 4 + tap) * 512 + sch + jj];
    }
    const int chg = head * 64 + j;
    const float g_ba = p.rg_ba[ld * 512 + chg], g_bx = p.rg_bx[ld * 512 + chg];
    const float g_sp = -8.0f * softplusf(-p.rg_lam[ld * 512 + chg]);
    const int sbd = (PASS == 0) ? sb : (dir ? (sb == 0 ? 0 : 16 - sb) : sb);
    int cbeg, cend;
    if (sbd == 0) { cbeg = 0; cend = 8; }
    else {
      const int jb = sbd - 1;
      if (dir == 0) { cbeg = 8 + (jb * 128) / 15; cend = 8 + ((jb + 1) * 128) / 15; }
      else { const int kb = 14 - jb; cbeg = 8 + 128 - ((kb + 1) * 128) / 15; cend = 8 + 128 - (kb * 128) / 15; }
    }
    float hcarry = 0.f, aprod = 1.f;
    if (PASS == 1 && tid < 64) {
      float2 sv[16];
#pragma unroll
      for (int q = 0; q < 16; ++q) {
        const float2* sp = (const float2*)(p.SUM + ((((size_t)b * 2 + dir) * 17 + q) * 512 + head * 64 + tid) * 2);
        sv[q] = (q < sbd) ? *sp : make_float2(1.f, 0.f);
      }
#pragma unroll
      for (int q = 0; q < 16; ++q) hcarry = sv[q].x * hcarry + sv[q].y;
    }
    uint4 xr0, xr1, xr2, xr3;
#define RG_LD1(XR, TAP, CH)                                                               \
    {                                                                                     \
      int pt = (CH) * 32 + spos - 3 + (TAP);                                              \
      int sg0 = ((CH) * 32 < 256) ? 0 : 256;                                              \
      if (pt >= sg0) { int Rr = pos2row_seq(b, pt, dir); XR = *(const uint4*)(UB2 + (size_t)Rr * 2048 + sch); } \
      else XR = make_uint4(0u, 0u, 0u, 0u);                                               \
    }
#define RG_PREFETCH(CH) RG_LD1(xr0, 0, CH) RG_LD1(xr1, 1, CH) RG_LD1(xr2, 2, CH) RG_LD1(xr3, 3, CH)
    RG_PREFETCH(cbeg)
#pragma unroll 1
    for (int chunk = cbeg; chunk < cend; ++chunk) {
      const int pbase = chunk * 32;
      {
        float a[8], f[8];
#pragma unroll
        for (int jj = 0; jj < 8; ++jj) a[jj] = bcv[jj];
        unpack8(xr0, f);
#pragma unroll
        for (int jj = 0; jj < 8; ++jj) a[jj] += wcv[0][jj] * f[jj];
        unpack8(xr1, f);
#pragma unroll
        for (int jj = 0; jj < 8; ++jj) a[jj] += wcv[1][jj] * f[jj];
        unpack8(xr2, f);
#pragma unroll
        for (int jj = 0; jj < 8; ++jj) a[jj] += wcv[2][jj] * f[jj];
        unpack8(xr3, f);
#pragma unroll
        for (int jj = 0; jj < 8; ++jj) a[jj] += wcv[3][jj] * f[jj];
        *(float4*)(xc + spos * 64 + sseg * 8) = make_float4(a[0], a[1], a[2], a[3]);
        *(float4*)(xc + spos * 64 + sseg * 8 + 4) = make_float4(a[4], a[5], a[6], a[7]);
        *(uint4*)(xcb + spos * 72 + sseg * 8) = pack8(a);
      }
      __syncthreads();
      if (chunk + 1 < cend) { RG_PREFETCH(chunk + 1) }
      const int Rout = pos2row_seq(b, pbase + spos, dir);
      uint4* yp = (uint4*)(p.HL + (size_t)Rout * 1024 + 512 + sch);
      uint4 prev, gv;
      if (PASS == 1 && dir == 1) { prev = *yp; gv = *(const uint4*)(UB2 + (size_t)Rout * 2048 + 512 + sch); }
      {
        const int r = lane & 31, hh = lane >> 5;
        f32x16 acc;
#pragma unroll
        for (int q = 0; q < 16; ++q) acc[q] = 0.f;
#pragma unroll
        for (int ks = 0; ks < 4; ++ks) {
          bf16x8 A = *(const bf16x8*)(xcb + r * 72 + 16 * ks + 8 * hh);
          bf16x8 B = *(const bf16x8*)(WTl + (32 * wave + r) * 72 + 16 * ks + 8 * hh);
          acc = __builtin_amdgcn_mfma_f32_32x32x16_bf16(A, B, acc, 0, 0, 0);
        }
        float* dstp = (wave < 2) ? pa : pb;
        const int jc = (wave & 1) * 32 + r;
#pragma unroll
        for (int q = 0; q < 16; ++q) dstp[((q & 3) + 8 * (q >> 2) + 4 * hh) * 64 + jc] = acc[q];
      }
      __syncthreads();
#pragma unroll
      for (int i = 0; i < 8; ++i) {
        int e = tid + 256 * i;
        float r = sigmf(pa[e] + g_ba);
        float gi = sigmf(pb[e] + g_bx);
        float la = g_sp * r;
        float a = __expf(la);
        float bt = sqrtf(fmaxf(1.f - a * a, 0.f)) * gi * xc[e];
        pa[e] = a; pb[e] = bt;
      }
      __syncthreads();
      if (tid < 64) {
        float hh = hcarry;
#pragma unroll 8
        for (int pos = 0; pos < 32; ++pos) { float av = pa[pos * 64 + tid]; hh = av * hh + pb[pos * 64 + tid]; pb[pos * 64 + tid] = hh; aprod *= av; }
        hcarry = hh;
      }
      __syncthreads();
      if (PASS == 1) {
        float hv[8];
#pragma unroll
        for (int jj = 0; jj < 8; ++jj) hv[jj] = pb[spos * 64 + sseg * 8 + jj];
        if (dir == 1) {
          float f[8]; unpack8(prev, f);
          float gf[8]; unpack8(gv, gf);
#pragma unroll
          for (int jj = 0; jj < 8; ++jj) hv[jj] = (hv[jj] + f[jj]) * gf[jj];
        }
        *yp = pack8(hv);
      }
    }
    if (PASS == 0 && tid < 64) {
      float* sp = p.SUM + ((((size_t)b * 2 + dir) * 17 + sbd) * 512 + head * 64 + tid) * 2;
      sp[0] = aprod; sp[1] = hcarry;
    }
    __syncthreads();
  }
}

typedef bf16x8 __attribute__((aligned(2))) bf16x8_u;
typedef uint4 __attribute__((aligned(4))) uint4_a4;
__device__ __forceinline__ bf16x8 ld_win8(const u16* base, int y, uint32_t sh) {
  const uint32_t* wp = (const uint32_t*)base + (y >> 1);
  uint4 w = *(const uint4_a4*)wp;
  uint32_t w4 = wp[4];
  FragU f;
  f.u[0] = __builtin_amdgcn_alignbit(w.y, w.x, sh);
  f.u[1] = __builtin_amdgcn_alignbit(w.z, w.y, sh);
  f.u[2] = __builtin_amdgcn_alignbit(w.w, w.z, sh);
  f.u[3] = __builtin_amdgcn_alignbit(w4, w.w, sh);
  return f.v;
}

__device__ __forceinline__ void hy_conv3x8(const u16* col, int t8, int n, float w0, float w1, float w2, float bias, float* out) {
  float f[8]; unpack8(*(const uint4*)(col + t8), f);
  float prev = (t8 > 0) ? bf2f(col[t8 - 1]) : 0.f;
  float next = (t8 + 8 < n) ? bf2f(col[t8 + 8]) : 0.f;
#pragma unroll
  for (int j = 0; j < 8; ++j) {
    float a = (j == 0) ? prev : f[j - 1];
    float cnx = (j == 7) ? next : f[j + 1];
    out[j] = bias + w0 * a + w1 * f[j] + w2 * cnx;
  }
}

#define ZB 5128
#define ZJ 80
#define ZI(B, T) ((B) * ZB + ((T) >> 6) * ZJ + ((T) & 63))
__device__ __forceinline__ void hy_task(const P& p, int l, int c, float* sm) {
  int tid = threadIdx.x; asm volatile("" : "+v"(tid)); const int wave = tid >> 6, lane = tid & 63;
  const int r = lane & 31, h = lane >> 5;
  u16* krr = (u16*)sm;
  u16* zs = krr + 8192 + 64;
  float* red = (float*)(zs + 4 * ZB);
  const u16* UT = p.U;
  const float* cwp = p.hy_conv_w + (size_t)l * 3 * 1536;
  const float* cbp = p.hy_conv_b + (size_t)l * 1536;
  for (int o = 0; o < 2; ++o) {
    const u16* K = p.KF + (size_t)(o * 512 + c) * 8192;
    float asum = 0.f;
#pragma unroll
    for (int i = 0; i < 4; ++i) {
      int idx = (tid + 256 * i) * 8;
      uint4 v = *(const uint4*)(K + idx);
      *(uint4*)(krr + idx) = v;
      float f[8]; unpack8(v, f);
#pragma unroll
      for (int j = 0; j < 8; ++j) asum += fabsf(f[j]);
    }
    asum = wave_sum(asum);
    if (lane == 0) red[wave] = asum;
    if (o == 0) {
      const float w0 = cwp[c], w1 = cwp[1536 + c], w2 = cwp[3072 + c], bs = cbp[c];
#pragma unroll 2
      for (int e = tid; e < 2048; e += 256) {
        int b = e >> 9, t8 = (e & 511) * 8;
        float f[8];
        hy_conv3x8(UT + (size_t)c * NTOK + b * 4096, t8, 4096, w0, w1, w2, bs, f);
        *(uint4*)(zs + ZI(b, t8)) = pack8(f);
      }
    }
    __syncthreads();
    const float scale = 1.f / (red[0] + red[1] + red[2] + red[3] + 1e-6f);
    const float skip = p.hy_skip[(l * 2 + o) * 512 + c];
    f32x16 acc[2][2];
#pragma unroll
    for (int a = 0; a < 2; ++a)
#pragma unroll
      for (int b = 0; b < 2; ++b)
#pragma unroll
        for (int q = 0; q < 16; ++q) acc[a][b][q] = 0.f;
    const int I0 = wave * 16;
    const int Il0 = I0 + (r >> 2), Il1 = I0 + 8 + (r >> 2);
    const u16* zb = zs + (r & 3) * ZB + 8 * h;
    const int ybase = 4096 - r + 8 * h + 48;
    bf16x8 F0, F1, F2, F3, F4, F5;
    const uint32_t ysh = (uint32_t)((ybase & 1) * 16);
    {
      const int y0 = ybase - 64 * (I0 - 63);
      F0 = ld_win8(krr, y0, ysh); F1 = ld_win8(krr, y0 - 16, ysh); F2 = ld_win8(krr, y0 - 32, ysh);
      F3 = ld_win8(krr, y0 - 48, ysh); F4 = ld_win8(krr, y0 - 64, ysh); F5 = ld_win8(krr, y0 - 80, ysh);
    }
#pragma unroll 1
    for (int D = I0 - 63; D <= I0 + 15; ++D) {
      bf16x8 B0[4], B1[4];
      {
        int J0 = Il0 - D, J1 = Il1 - D;
        bool ok0 = (unsigned)J0 < 64u, ok1 = (unsigned)J1 < 64u;
        const u16* zp0 = zb + ZJ * J0; const u16* zp1 = zb + ZJ * J1;
#pragma unroll
        for (int ks = 0; ks < 4; ++ks) {
          bf16x8 z0 = {0, 0, 0, 0, 0, 0, 0, 0}, z1 = {0, 0, 0, 0, 0, 0, 0, 0};
          if (ok0) z0 = *(const bf16x8*)(zp0 + 16 * ks);
          if (ok1) z1 = *(const bf16x8*)(zp1 + 16 * ks);
          B0[ks] = z0; B1[ks] = z1;
        }
      }
      acc[0][0] = __builtin_amdgcn_mfma_f32_32x32x16_bf16(F3, B0[0], acc[0][0], 0, 0, 0);
      acc[0][1] = __builtin_amdgcn_mfma_f32_32x32x16_bf16(F3, B1[0], acc[0][1], 0, 0, 0);
      acc[1][0] = __builtin_amdgcn_mfma_f32_32x32x16_bf16(F5, B0[0], acc[1][0], 0, 0, 0);
      acc[1][1] = __builtin_amdgcn_mfma_f32_32x32x16_bf16(F5, B1[0], acc[1][1], 0, 0, 0);
      acc[0][0] = __builtin_amdgcn_mfma_f32_32x32x16_bf16(F2, B0[1], acc[0][0], 0, 0, 0);
      acc[0][1] = __builtin_amdgcn_mfma_f32_32x32x16_bf16(F2, B1[1], acc[0][1], 0, 0, 0);
      acc[1][0] = __builtin_amdgcn_mfma_f32_32x32x16_bf16(F4, B0[1], acc[1][0], 0, 0, 0);
      acc[1][1] = __builtin_amdgcn_mfma_f32_32x32x16_bf16(F4, B1[1], acc[1][1], 0, 0, 0);
      acc[0][0] = __builtin_amdgcn_mfma_f32_32x32x16_bf16(F1, B0[2], acc[0][0], 0, 0, 0);
      acc[0][1] = __builtin_amdgcn_mfma_f32_32x32x16_bf16(F1, B1[2], acc[0][1], 0, 0, 0);
      acc[1][0] = __builtin_amdgcn_mfma_f32_32x32x16_bf16(F3, B0[2], acc[1][0], 0, 0, 0);
      acc[1][1] = __builtin_amdgcn_mfma_f32_32x32x16_bf16(F3, B1[2], acc[1][1], 0, 0, 0);
      acc[0][0] = __builtin_amdgcn_mfma_f32_32x32x16_bf16(F0, B0[3], acc[0][0], 0, 0, 0);
      acc[0][1] = __builtin_amdgcn_mfma_f32_32x32x16_bf16(F0, B1[3], acc[0][1], 0, 0, 0);
      acc[1][0] = __builtin_amdgcn_mfma_f32_32x32x16_bf16(F2, B0[3], acc[1][0], 0, 0, 0);
      acc[1][1] = __builtin_amdgcn_mfma_f32_32x32x16_bf16(F2, B1[3], acc[1][1], 0, 0, 0);
      F0 = F4; F1 = F5;
      if (D < I0 + 15) {
        const int y1 = ybase - 64 * (D + 1);
        F2 = ld_win8(krr, y1 - 32, ysh); F3 = ld_win8(krr, y1 - 48, ysh);
        F4 = ld_win8(krr, y1 - 64, ysh); F5 = ld_win8(krr, y1 - 80, ysh);
      }
    }
    __syncthreads();
#pragma unroll
    for (int ni = 0; ni < 2; ++ni) {
      u16* zc = zs + (r & 3) * ZB + ZJ * (ni ? Il1 : Il0);
#pragma unroll
      for (int mi = 0; mi < 2; ++mi)
#pragma unroll
        for (int q = 0; q < 16; ++q) {
          int i = 32 * mi + (q & 3) + 8 * (q >> 2) + 4 * h;
          float zo = bf2f(zc[i]);
          zc[i] = f2bf(scale * acc[mi][ni][q] + skip * zo);
        }
    }
    __syncthreads();
    {
      const int ch = (o + 1) * 512 + c;
      const float w0 = cwp[ch], w1 = cwp[1536 + ch], w2 = cwp[3072 + ch], bs = cbp[ch];
#pragma unroll 2
      for (int e = tid; e < 2048; e += 256) {
        int b = e >> 9, t8 = (e & 511) * 8;
        float xg[8], y[8];
        hy_conv3x8(UT + (size_t)ch * NTOK + b * 4096, t8, 4096, w0, w1, w2, bs, xg);
        unpack8(*(const uint4*)(zs + ZI(b, t8)), y);
#pragma unroll
        for (int j = 0; j < 8; ++j) y[j] *= xg[j];
        if (o == 0) *(uint4*)(zs + ZI(b, t8)) = pack8(y);
        else {
          float gf[8]; unpack8(*(const uint4*)(UT + (size_t)(1536 + c) * NTOK + b * 4096 + t8), gf);
#pragma unroll
          for (int j = 0; j < 8; ++j) y[j] *= gf[j];
          *(uint4*)(p.U + (size_t)c * NTOK + b * 4096 + t8) = pack8(y);
        }
      }
    }
    __syncthreads();
  }
  if (l == 0) {
    const int t = tid;
    for (int o = 0; o < 2; ++o) {
      const u16* K = p.KFC + (size_t)(o * 512 + c) * 512;
      float asum = 0.f;
      {
        uint32_t w2 = *(const uint32_t*)(K + tid * 2);
        *(uint32_t*)(krr + tid * 2) = w2;
        asum = fabsf(bflo(w2)) + fabsf(bfhi(w2));
      }
      asum = wave_sum(asum);
      if (lane == 0) red[wave] = asum;
      if (o == 0) {
        const float w0 = cwp[c], w1 = cwp[1536 + c], w2 = cwp[3072 + c], bs = cbp[c];
        if (tid < 128) {
          int b = tid >> 5, t8 = (tid & 31) * 8;
          float f[8];
          hy_conv3x8(UT + (size_t)c * NTOK + NLAT + b * 256, t8, 256, w0, w1, w2, bs, f);
          *(uint4*)(zs + ZI(b, t8)) = pack8(f);
        }
      }
      __syncthreads();
      const float scale = 1.f / (red[0] + red[1] + red[2] + red[3] + 1e-6f);
      float a0 = 0, a1 = 0, a2 = 0, a3 = 0;
      for (int s2 = 0; s2 < 256; ++s2) {
        float kv = bf2f(krr[256 - t + s2]);
        a0 += kv * bf2f(zs[ZI(0, s2)]); a1 += kv * bf2f(zs[ZI(1, s2)]); a2 += kv * bf2f(zs[ZI(2, s2)]); a3 += kv * bf2f(zs[ZI(3, s2)]);
      }
      const float skip = p.hy_skip[(l * 2 + o) * 512 + c];
      float y[4];
      y[0] = scale * a0 + skip * bf2f(zs[ZI(0, t)]); y[1] = scale * a1 + skip * bf2f(zs[ZI(1, t)]);
      y[2] = scale * a2 + skip * bf2f(zs[ZI(2, t)]); y[3] = scale * a3 + skip * bf2f(zs[ZI(3, t)]);
      __syncthreads();
      {
        const int ch = (o + 1) * 512 + c;
        const float w0 = cwp[ch], w1 = cwp[1536 + ch], w2 = cwp[3072 + ch], bs = cbp[ch];
#pragma unroll
        for (int b = 0; b < 4; ++b) {
          const u16* col = UT + (size_t)ch * NTOK + NLAT + b * 256;
          float xg = bs + w1 * bf2f(col[t]);
          if (t > 0) xg += w0 * bf2f(col[t - 1]);
          if (t < 255) xg += w2 * bf2f(col[t + 1]);
          float zn = xg * y[b];
          if (o == 0) zs[ZI(b, t)] = f2bf(zn);
          else {
            size_t R = (size_t)NLAT + b * 256 + t;
            float gate = bf2f(UT[(size_t)(1536 + c) * NTOK + R]);
            p.U[(size_t)c * NTOK + R] = f2bf(zn * gate);
          }
        }
      }
      __syncthreads();
    }
  }
}

__device__ __forceinline__ void fin_rows(const P& p, int l, int chunk) {
  int tid = threadIdx.x; asm volatile("" : "+v"(tid)); const int wave = tid >> 6, lane = tid & 63;
  for (int rr = 0; rr < 16; ++rr) {
    int R = chunk * 64 + wave * 16 + rr;
    {
      uint4* yp = (uint4*)(p.Y2 + (size_t)R * 1024 + lane * 8);
      float o[8]; unpack8(*yp, o);
      float ss = 0;
#pragma unroll
      for (int j = 0; j < 8; ++j) ss += o[j] * o[j];
      ss += __shfl_xor(ss, 1); ss += __shfl_xor(ss, 2); ss += __shfl_xor(ss, 4); ss += __shfl_xor(ss, 8);
      float rinv = rsqrtf(ss * (1.f / 128.f) + EPS);
      float gf[8]; unpack8(*(const uint4*)(p.U + (size_t)NTOK * 2048 + (size_t)R * 2048 + 1024 + lane * 8), gf);
#pragma unroll
      for (int j = 0; j < 8; ++j) o[j] = o[j] * rinv * p.hg_norm_w[l * 512 + lane * 8 + j] * gf[j];
      *yp = pack8(o);
    }
    {
      uint4* yp = (uint4*)(p.Y2 + (size_t)R * 1024 + 512 + lane * 8);
      float o[8]; unpack8(*yp, o);
      float gf[8]; unpack8(*(const uint4*)(p.U + (size_t)NTOK * 2048 + (size_t)R * 2048 + 1536 + lane * 8), gf);
      float ss = 0;
#pragma unroll
      for (int j = 0; j < 8; ++j) { o[j] *= gf[j]; ss += o[j] * o[j]; }
      ss += __shfl_xor(ss, 1); ss += __shfl_xor(ss, 2); ss += __shfl_xor(ss, 4); ss += __shfl_xor(ss, 8); ss += __shfl_xor(ss, 16);
      float rinv = rsqrtf(ss * (1.f / 256.f) + EPS);
#pragma unroll
      for (int j = 0; j < 8; ++j) o[j] = o[j] * rinv * p.m2_norm_w[l * 512 + lane * 8 + j];
      *yp = pack8(o);
    }
  }
}

__device__ __forceinline__ void ph_mixB(const P& p, int l, int bid, int nb, float* sm) {
  for (int t = bid; t < 512 + 512; t += nb) {
    if (t < 512) { if (EN_RG) rg_task<0>(p, l, t, sm); }
    else { if (EN_HY) hy_task(p, l, t - 512, sm); }
    __syncthreads();
  }
}
__device__ __forceinline__ void hy_transpose(const P& p, int tile, u16* sm) {
  int tid = threadIdx.x; asm volatile("" : "+v"(tid));
  const int ct = tile & 7, rt = tile >> 3;
  const int c0 = ct * 64, R0 = rt * 64;
#pragma unroll
  for (int i = 0; i < 2; ++i) {
    int q = tid + 256 * i; int cc = q >> 3, seg = q & 7;
    *(uint4*)(sm + cc * 72 + seg * 8) = *(const uint4*)(p.U + (size_t)(c0 + cc) * NTOK + R0 + seg * 8);
  }
  __syncthreads();
#pragma unroll
  for (int i = 0; i < 2; ++i) {
    int q = tid + 256 * i; int rr = q >> 3, seg = q & 7;
    FragU f;
#pragma unroll
    for (int j = 0; j < 4; ++j)
      f.u[j] = (uint32_t)sm[(seg * 8 + 2 * j) * 72 + rr] | ((uint32_t)sm[(seg * 8 + 2 * j + 1) * 72 + rr] << 16);
    *(uint4*)(p.HL + (size_t)(R0 + rr) * 1024 + c0 + seg * 8) = f.q;
  }
}
__device__ __forceinline__ void ph_mixB2(const P& p, int l, int bid, int nb, float* sm) {
  const int nfin = (l == 0 ? NTOK : NLAT) / 64;
  const int ntr = nfin * 8;
  for (int t = bid; t < 512 + nfin + ntr; t += nb) {
    if (t < 512) { if (EN_RG) rg_task<1>(p, l, t, sm); }
    else if (t < 512 + nfin) fin_rows(p, l, t - 512);
    else hy_transpose(p, t - 512 - nfin, (u16*)sm);
    __syncthreads();
  }
}
__device__ __forceinline__ void ph_final(const P& p, int bid, int nb) {
  int tid = threadIdx.x; asm volatile("" : "+v"(tid)); const int wave = tid >> 6, lane = tid & 63;
  for (int R = bid * 4 + wave; R < NLAT; R += nb * 4) {
    float4* rp = (float4*)(p.out + (size_t)R * 1024);
    float4 v[4]; float ss = 0;
#pragma unroll
    for (int i = 0; i < 4; ++i) {
      v[i] = rp[lane + i * 64];
      ss += v[i].x * v[i].x + v[i].y * v[i].y + v[i].z * v[i].z + v[i].w * v[i].w;
    }
    ss = wave_sum(ss);
    float rinv = rsqrtf(ss * (1.f / 1024.f) + EPS);
#pragma unroll
    for (int i = 0; i < 4; ++i) {
      float4 w = *(const float4*)(p.final_norm_w + (lane + i * 64) * 4);
      float4 o; o.x = v[i].x * rinv * w.x; o.y = v[i].y * rinv * w.y; o.z = v[i].z * rinv * w.z; o.w = v[i].w * rinv * w.w;
      rp[lane + i * 64] = o;
    }
  }
}

#define SMEM_BYTES 57600
__global__ void __launch_bounds__(256, 2) mega(P p) {
  __shared__ __align__(16) unsigned char smem[SMEM_BYTES];
  cg::grid_group grid = cg::this_grid();
  const int bid = blockIdx.x, nb = gridDim.x;
  float* smf = (float*)smem; u16* smh = (u16*)smem;
#ifndef PHM
#define PHM 0xffff
#endif
  if (PHM & 1) ph_mod(p, bid, nb, smf);
  grid.sync();
  for (int l = 0; l < 2; ++l) {
    if (PHM & 2) ph_norm(p, l, bid, nb);
    if (PHM & 4) ph_wconv(p, l, bid, nb, smf, l == 0 ? 0 : 114 * 16, 114 * 16 + 16 * 32);
    grid.sync();
    if (PHM & 16) ph_gemm<0>(p, l, bid, nb, smh);
    grid.sync();
#if PROBE_DUP == 3
    ph_gemm<0>(p, l, bid, nb, smh);
    grid.sync();
#endif
#if PROBE_DUP == 10
    ph_norm(p, l, bid, nb);
    ph_wconv(p, l, bid, nb, smf);
    grid.sync();
#endif
    if (PHM & 32) ph_mixA0(p, l, bid, nb, smem);
    grid.sync();
    if (PHM & 32) ph_mixA1(p, l, bid, nb, smem);
    grid.sync();
#if PROBE_DUP == 8
    ph_mixA0(p, l, bid, nb, smem);
    grid.sync();
    ph_mixA1(p, l, bid, nb, smem);
    grid.sync();
#endif
    if (PHM & 64) ph_gemm<1>(p, l, bid, nb, smh);
    if (PHM & 8) ph_filt(p, l, bid, nb, smf);
    grid.sync();
#if PROBE_DUP == 2
    ph_mixB(p, l, bid, nb, smf);
    grid.sync();
#endif
#if PROBE_DUP == 4
    ph_gemm<1>(p, l, bid, nb, smh);
    grid.sync();
#endif
#if PROBE_DUP == 9
    ph_gemm<1>(p, l, bid, nb, smh, 1);
    grid.sync();
#endif
    if (PHM & 128) ph_mixB(p, l, bid, nb, smf);
    grid.sync();
    if (PHM & 128) ph_mixB2(p, l, bid, nb, smf);
    grid.sync();
#if PROBE_DUP == 7
    for (int t = bid; t < 512; t += nb) { rg_task<1>(p, l, t, smf); __syncthreads(); }
    grid.sync();
#endif
    if (PHM & 256) ph_gemm<2>(p, l, bid, nb, smh);
    if ((PHM & 4) && l == 0) ph_wconv(p, 1, bid, nb, smf, 0, 114 * 16);
    grid.sync();
  }
  if (PHM & 512) ph_final(p, bid, nb);
}

extern "C" void kernel_launch(void* const* d_in, const int* in_sizes, int n_in, void* d_out, int out_size,
                              void* d_ws, size_t ws_size, hipStream_t stream) {
  static int grid_blocks = 0;
  if (!grid_blocks) {
    int dev = 0, cus = 0, per_cu = 0;
    hipGetDevice(&dev);
    hipDeviceGetAttribute(&cus, hipDeviceAttributeMultiprocessorCount, dev);
    hipOccupancyMaxActiveBlocksPerMultiprocessor(&per_cu, mega, 256, 0);
    if (per_cu < 1) per_cu = 1;
    if (per_cu > 2) per_cu = 2;
    grid_blocks = cus * per_cu;
  }
  P p{};
  const float** fp = (const float**)&p;
  for (int i = 0; i < 34; ++i) fp[i] = (const float*)d_in[i];
  p.out = (float*)d_out;
  char* w = (char*)d_ws;
  size_t off = 0;
  auto take = [&](size_t bytes) { char* r = w + off; off += (bytes + 255) & ~(size_t)255; return r; };
  p.U = (u16*)take((size_t)NTOK * UW * 2);
  p.HL = (u16*)take((size_t)NTOK * 1024 * 2);
  p.Y2 = (u16*)take((size_t)NTOK * 1024 * 2);
  p.WT = (u16*)take((size_t)7296 * 1024 * 2);
  p.WoT = (u16*)take((size_t)1024 * 2048 * 2);
  p.KF = (u16*)take((size_t)1024 * 8192 * 2);
  p.DT = (float*)take((size_t)NTOK * 8 * 4);
  p.MOD = (float*)take((size_t)2 * 5 * 3072 * 4);
  p.SUM = (float*)take((size_t)4 * 2 * 17 * 512 * 2 * 4);
  {
    char* Z = take((size_t)16777216);
    p.SSH = (float*)Z; p.XC = (float*)(Z + 8388608); p.KFC = (u16*)(Z + 12582912);
  }
  p.PS = (float*)take((size_t)16 * 2 * 8 * 128 * 4);
  p.PA = (float*)take((size_t)16 * 2 * 8 * 4 * 4);
  if (off > ws_size) { fprintf(stderr, "workspace too small: need %zu have %zu\n", off, ws_size); return; }
  void* args[] = {&p};
  hipError_t e = hipLaunchCooperativeKernel((void*)mega, dim3(grid_blocks), dim3(256), args, 0, stream);
  if (e != hipSuccess) fprintf(stderr, "cooperative launch failed: %s (grid %d)\n", hipGetErrorString(e), grid_blocks);
}
```

```cpp
#include <hip/hip_runtime.h>
#include <hip/hip_bf16.h>
#include <hip/hip_cooperative_groups.h>
#include <cstdio>
#include <cstdint>
namespace cg = cooperative_groups;

typedef unsigned short u16;
using bf16x8 = __attribute__((ext_vector_type(8))) short;
using f32x16 = __attribute__((ext_vector_type(16))) float;

#define NTOK 17408
#define NLAT 16384
#define UW 4096
#define EPS 1e-6f

#ifndef PROBE_DUP
#define PROBE_DUP 0
#endif
#ifndef EN_HY
#define EN_HY 1
#endif
#ifndef EN_RG
#define EN_RG 1
#endif
#ifndef EN_HG
#define EN_HG 1
#endif
#ifndef EN_M2
#define EN_M2 1
#endif

struct P {
  const float *x, *c, *ctx, *c_ctx, *w_mod, *b_mod, *norm_w, *w_in, *w_out;
  const float *hy_conv_w, *hy_conv_b, *hy_w1, *hy_b1, *hy_w2, *hy_b2, *hy_w3, *hy_freq, *hy_skip;
  const float *rg_conv_w, *rg_conv_b, *rg_wa, *rg_ba, *rg_wx, *rg_bx, *rg_lam;
  const float *hg_lb, *hg_norm_w, *m2_conv_w, *m2_conv_b, *m2_dt_bias, *m2_a_log, *m2_d, *m2_norm_w, *final_norm_w;
  float* out;
  u16 *U, *HL, *Y2, *WT, *WoT, *KF, *KFC;
  float *XC, *DT, *MOD, *SUM, *SSH, *PS, *PA;
  unsigned* BAR;
};

typedef __bf16 bf2_t __attribute__((ext_vector_type(2)));
typedef float f2_t __attribute__((ext_vector_type(2)));
__device__ __forceinline__ uint32_t pack2(float a, float b) {
  f2_t v = {a, b};
  return __builtin_bit_cast(uint32_t, __builtin_convertvector(v, bf2_t));
}
__device__ __forceinline__ u16 f2bf(float f) { return (u16)(pack2(f, f) & 0xffffu); }
__device__ __forceinline__ float bf2f(u16 h) { return __uint_as_float(((uint32_t)h) << 16); }
__device__ __forceinline__ float bflo(uint32_t w) { return __uint_as_float(w << 16); }
__device__ __forceinline__ float bfhi(uint32_t w) { return __uint_as_float(w & 0xffff0000u); }
__device__ __forceinline__ float siluf(float x) { return x * __builtin_amdgcn_rcpf(1.f + __expf(-x)); }
__device__ __forceinline__ float sigmf(float x) { return __builtin_amdgcn_rcpf(1.f + __expf(-x)); }
__device__ __forceinline__ float softplusf(float x) { return x > 20.f ? x : log1pf(__expf(x)); }

__device__ __forceinline__ void unpack8(const uint4& v, float* f) {
  f[0] = bflo(v.x); f[1] = bfhi(v.x); f[2] = bflo(v.y); f[3] = bfhi(v.y);
  f[4] = bflo(v.z); f[5] = bfhi(v.z); f[6] = bflo(v.w); f[7] = bfhi(v.w);
}
__device__ __forceinline__ uint4 pack8(const float* f) {
  uint4 v; v.x = pack2(f[0], f[1]); v.y = pack2(f[2], f[3]); v.z = pack2(f[4], f[5]); v.w = pack2(f[6], f[7]);
  return v;
}
__device__ __forceinline__ float wave_sum(float v) {
#pragma unroll
  for (int o = 32; o >= 1; o >>= 1) v += __shfl_xor(v, o);
  return v;
}

__device__ __forceinline__ int pos2row_seq(int b, int p, int dir) {
  if (p < 256) { int t = dir ? 255 - p : p; return NLAT + b * 256 + t; }
  int j = p - 256; int t = dir ? 4095 - j : j; return b * 4096 + t;
}
__device__ __forceinline__ int pos2row_m2(int b, int p, int dir) {
  if (p < 256) { int t = dir ? 255 - p : p; return NLAT + b * 256 + t; }
  int j = p - 256; int jj = dir ? 4095 - j : j; int c = jj >> 6, r = jj & 63; return b * 4096 + r * 64 + c;
}

__device__ __forceinline__ void ph_mod(const P& p, int bid, int nb, float* sm) {
  int tid = threadIdx.x; asm volatile("" : "+v"(tid));
  for (int task = bid; task < 96; task += nb) {
    int l = task / 48, cgi = task % 48;
    int col = cgi * 64 + (tid & 63);
    int kq = tid >> 6;
    float a0 = 0, a1 = 0, a2 = 0, a3 = 0, a4 = 0;
#pragma unroll 8
    for (int k = kq * 256; k < kq * 256 + 256; ++k) {
      float w = p.w_mod[((size_t)l * 1024 + k) * 3072 + col];
      a0 += siluf(p.c[k]) * w; a1 += siluf(p.c[1024 + k]) * w; a2 += siluf(p.c[2048 + k]) * w;
      a3 += siluf(p.c[3072 + k]) * w; a4 += siluf(p.c_ctx[k]) * w;
    }
    sm[(kq * 5 + 0) * 64 + (tid & 63)] = a0; sm[(kq * 5 + 1) * 64 + (tid & 63)] = a1;
    sm[(kq * 5 + 2) * 64 + (tid & 63)] = a2; sm[(kq * 5 + 3) * 64 + (tid & 63)] = a3;
    sm[(kq * 5 + 4) * 64 + (tid & 63)] = a4;
    __syncthreads();
    if (tid < 64) {
      float bm = p.b_mod[l * 3072 + col];
#pragma unroll
      for (int j = 0; j < 5; ++j) {
        float s = sm[(0 * 5 + j) * 64 + tid] + sm[(1 * 5 + j) * 64 + tid] + sm[(2 * 5 + j) * 64 + tid] + sm[(3 * 5 + j) * 64 + tid];
        p.MOD[(size_t)(l * 5 + j) * 3072 + col] = s + bm;
      }
    }
    __syncthreads();
  }
}

__device__ __forceinline__ void ph_norm(const P& p, int l, int bid, int nb) {
  int tid = threadIdx.x; asm volatile("" : "+v"(tid)); const int wave = tid >> 6, lane = tid & 63;
  for (int R = bid * 4 + wave; R < NTOK; R += nb * 4) {
    const float* src; int mj;
    if (R < NLAT) { src = (l == 0 ? p.x : (const float*)p.out) + (size_t)R * 1024; mj = R >> 12; }
    else { int rc = R - NLAT; src = (l == 0 ? p.ctx : (const float*)p.XC) + (size_t)rc * 1024; mj = 4; }
    const float* mod = p.MOD + (size_t)(l * 5 + mj) * 3072;
    float4 v[4]; float ss = 0;
#pragma unroll
    for (int i = 0; i < 4; ++i) {
      v[i] = ((const float4*)src)[lane + i * 64];
      ss += v[i].x * v[i].x + v[i].y * v[i].y + v[i].z * v[i].z + v[i].w * v[i].w;
    }
    ss = wave_sum(ss);
    float rinv = rsqrtf(ss * (1.f / 1024.f) + EPS);
#pragma unroll
    for (int i = 0; i < 4; ++i) {
      int idx = (lane + i * 64) * 4;
      float4 nw = *(const float4*)(p.norm_w + l * 1024 + idx);
      float4 sh = *(const float4*)(mod + idx);
      float4 sc = *(const float4*)(mod + 1024 + idx);
      float h0 = v[i].x * rinv * nw.x * (1.f + sc.x) + sh.x;
      float h1 = v[i].y * rinv * nw.y * (1.f + sc.y) + sh.y;
      float h2 = v[i].z * rinv * nw.z * (1.f + sc.z) + sh.z;
      float h3 = v[i].w * rinv * nw.w * (1.f + sc.w) + sh.w;
      uint2 o; o.x = pack2(h0, h1); o.y = pack2(h2, h3);
      *(uint2*)(p.HL + (size_t)R * 1024 + idx) = o;
    }
  }
}

__device__ __forceinline__ void ph_wconv(const P& p, int l, int bid, int nb, float* sm, int tb, int te) {
  int tid = threadIdx.x; asm volatile("" : "+v"(tid));
  const int T1 = 114 * 16, T2 = 16 * 32;
  for (int t = tb + bid; t < te; t += nb) {
    const float* src; int ld, K, n0, k0, sc0, nvalid; u16* dst;
    if (t < T1) {
      int nt = t / 16, kt = t % 16; n0 = nt * 64; k0 = kt * 64;
      src = p.w_in + (size_t)l * 1024 * 7176; ld = 7176; K = 1024; dst = p.WT; nvalid = 64;
      if (n0 < 2048) sc0 = 3072 + n0;
      else if (n0 < 3072) sc0 = 5632 + (n0 - 2048);
      else if (n0 < 3200) { sc0 = 6656 + (n0 - 3072); nvalid = (n0 == 3072) ? 8 : 0; }
      else { int m = n0 - 3200; if (m < 3072) sc0 = m; else if (m < 3584) sc0 = 5120 + (m - 3072); else sc0 = 6664 + (m - 3584); }
    } else {
      int tt = t - T1; int nt = tt / 32, kt = tt % 32; n0 = nt * 64; k0 = kt * 64;
      src = p.w_out + (size_t)l * 2048 * 1024; ld = 1024; K = 2048; dst = p.WoT; nvalid = 64; sc0 = n0;
    }
#pragma unroll
    for (int i = 0; i < 4; ++i) {
      int kk = (tid >> 4) + 16 * i, cc = (tid & 15) * 4;
      const float* sp = src + (size_t)(k0 + kk) * ld + sc0 + cc;
      float4 v;
      if (nvalid == 64) v = *(const float4*)sp;
      else { v.x = (cc + 0 < nvalid) ? sp[0] : 0.f; v.y = (cc + 1 < nvalid) ? sp[1] : 0.f; v.z = (cc + 2 < nvalid) ? sp[2] : 0.f; v.w = (cc + 3 < nvalid) ? sp[3] : 0.f; }
      sm[kk * 65 + cc + 0] = v.x; sm[kk * 65 + cc + 1] = v.y; sm[kk * 65 + cc + 2] = v.z; sm[kk * 65 + cc + 3] = v.w;
    }
    __syncthreads();
#pragma unroll
    for (int i = 0; i < 2; ++i) {
      int q = tid + 256 * i; int nn = q >> 3, ks = q & 7;
      float f[8];
#pragma unroll
      for (int j = 0; j < 8; ++j) f[j] = sm[(ks * 8 + j) * 65 + nn];
      *(uint4*)(dst + (size_t)(n0 + nn) * K + k0 + ks * 8) = pack8(f);
    }
    __syncthreads();
  }
}

__device__ __forceinline__ void ph_filt(const P& p, int l, int bid, int nb, float* sm) {
  int tid = threadIdx.x; asm volatile("" : "+v"(tid));
  const float HY_MIN = -3.0701134573253945f, HY_MAX = -15.350567286626972f;
  int ntask = 256 + (l == 0 ? 16 : 0);
  float* zs = sm; float* h1 = sm + 544; float* h2 = sm + 544 + 1024;
  for (int task = bid; task < ntask; task += nb) {
    int n, t0; u16* K;
    if (task < 256) { n = 4096; t0 = task * 16; K = p.KF; } else { n = 256; t0 = (task - 256) * 16; K = p.KFC; }
    float inv_nm1 = 1.f / (float)(n - 1);
    for (int e = tid; e < 16 * 33; e += 256) {
      int tt = e / 33, f = e % 33; int t = t0 + tt; float val;
      if (f == 0) val = (float)t * inv_nm1;
      else {
        int bi = (f - 1) & 15;
        float band = 1e-4f + (float)bi * ((15.f - 1e-4f) / 15.f);
        float ang = (6.283185307179586f / (float)n) * (float)t * band;
        val = (f <= 16) ? cosf(ang) : -sinf(ang);
      }
      zs[e] = val;
    }
    __syncthreads();
    for (int e = tid; e < 1024; e += 256) {
      int tt = e >> 6, j = e & 63; float acc = p.hy_b1[l * 64 + j];
#pragma unroll 11
      for (int f = 0; f < 33; ++f) acc += zs[tt * 33 + f] * p.hy_w1[(l * 33 + f) * 64 + j];
      h1[e] = sinf(p.hy_freq[l * 64 + j] * acc);
    }
    __syncthreads();
    for (int e = tid; e < 1024; e += 256) {
      int tt = e >> 6, j = e & 63; float acc = p.hy_b2[l * 64 + j];
#pragma unroll 8
      for (int i = 0; i < 64; ++i) acc += h1[tt * 64 + i] * p.hy_w2[(l * 64 + i) * 64 + j];
      h2[e] = sinf(p.hy_freq[l * 64 + j] * acc);
    }
    __syncthreads();
    for (int r = 0; r < 8; ++r) {
      int col = tid + 256 * r; int o = col >> 10, side = (col >> 9) & 1, c = col & 511;
      float w[64];
#pragma unroll
      for (int i = 0; i < 64; ++i) w[i] = p.hy_w3[(size_t)(l * 64 + i) * 2048 + col];
      float delta = fabsf(HY_MIN + (HY_MAX - HY_MIN) * (float)c / 511.f);
      u16* Kc = K + (size_t)(o * 512 + c) * (2 * n);
      for (int tt = 0; tt < 16; ++tt) {
        float acc = 0;
#pragma unroll
        for (int i = 0; i < 64; ++i) acc += h2[tt * 64 + i] * w[i];
        int t = t0 + tt;
        float val = acc * __expf(-(float)t * inv_nm1 * delta);
        int idx;
        if (side == 0) idx = n - t; else { if (t == 0) { idx = 0; val = 0.f; } else idx = n + t; }
        Kc[idx] = f2bf(val);
      }
    }
    __syncthreads();
  }
}

#define LDSTR 72
template <int MODE>
__device__ __forceinline__ void gemm_tile(const P& p, int l, int mt, int nt, u16* sA, u16* sB, int noepi) {
  int tid = threadIdx.x; asm volatile("" : "+v"(tid)); const int wave = tid >> 6, lane = tid & 63;
  const int wm = wave >> 1, wn = wave & 1;
  const int KT = (MODE == 2) ? 2048 : 1024;
  const u16* Bsrc = (MODE == 0) ? p.WT + (size_t)(nt * 128) * 1024
                  : (MODE == 1) ? p.WT + (size_t)(3200 + nt * 128) * 1024
                                : p.WoT + (size_t)(nt * 128) * 2048;
  f32x16 acc[4][2];
#pragma unroll
  for (int a = 0; a < 4; ++a)
#pragma unroll
    for (int b = 0; b < 2; ++b)
#pragma unroll
      for (int r = 0; r < 16; ++r) acc[a][b][r] = 0.f;
  uint4 ra0, ra1, ra2, ra3, ra4, ra5, ra6, ra7, rb0, rb1, rb2, rb3;
  const int lrow = tid >> 3, lseg = tid & 7;
  const u16* Ab0 = p.HL + (size_t)(mt * 256 + lrow) * 1024 + lseg * 8;
  const u16* Ab1 = p.Y2 + (size_t)(mt * 256 + lrow) * 1024 + lseg * 8;
  const u16* Bb = Bsrc + (size_t)lrow * KT + lseg * 8;
#define GLOADS(K0)                                                                                  \
  {                                                                                                 \
    const u16* ap = (MODE == 2 && (K0) >= 1024) ? Ab1 + ((K0) - 1024) : Ab0 + (K0);                 \
    ra0 = *(const uint4*)(ap); ra1 = *(const uint4*)(ap + 32 * 1024);                               \
    ra2 = *(const uint4*)(ap + 64 * 1024); ra3 = *(const uint4*)(ap + 96 * 1024);                   \
    ra4 = *(const uint4*)(ap + 128 * 1024); ra5 = *(const uint4*)(ap + 160 * 1024);                 \
    ra6 = *(const uint4*)(ap + 192 * 1024); ra7 = *(const uint4*)(ap + 224 * 1024);                 \
    const u16* bp = Bb + (K0);                                                                      \
    rb0 = *(const uint4*)(bp); rb1 = *(const uint4*)(bp + (size_t)32 * KT);                         \
    rb2 = *(const uint4*)(bp + (size_t)64 * KT); rb3 = *(const uint4*)(bp + (size_t)96 * KT);       \
  }
  GLOADS(0)
#pragma unroll 1
  for (int k0 = 0; k0 < KT; k0 += 64) {
    *(uint4*)(sA + (lrow + 0) * LDSTR + lseg * 8) = ra0;   *(uint4*)(sA + (lrow + 32) * LDSTR + lseg * 8) = ra1;
    *(uint4*)(sA + (lrow + 64) * LDSTR + lseg * 8) = ra2;  *(uint4*)(sA + (lrow + 96) * LDSTR + lseg * 8) = ra3;
    *(uint4*)(sA + (lrow + 128) * LDSTR + lseg * 8) = ra4; *(uint4*)(sA + (lrow + 160) * LDSTR + lseg * 8) = ra5;
    *(uint4*)(sA + (lrow + 192) * LDSTR + lseg * 8) = ra6; *(uint4*)(sA + (lrow + 224) * LDSTR + lseg * 8) = ra7;
    *(uint4*)(sB + (lrow + 0) * LDSTR + lseg * 8) = rb0;   *(uint4*)(sB + (lrow + 32) * LDSTR + lseg * 8) = rb1;
    *(uint4*)(sB + (lrow + 64) * LDSTR + lseg * 8) = rb2;  *(uint4*)(sB + (lrow + 96) * LDSTR + lseg * 8) = rb3;
    __syncthreads();
    if (k0 + 64 < KT) GLOADS(k0 + 64)
    __builtin_amdgcn_s_setprio(1);
#pragma unroll
    for (int ks = 0; ks < 4; ++ks) {
      bf16x8 fa[4], fb[2];
#pragma unroll
      for (int mi = 0; mi < 4; ++mi)
        fa[mi] = *(const bf16x8*)(sA + (wm * 128 + mi * 32 + (lane & 31)) * LDSTR + ks * 16 + (lane >> 5) * 8);
#pragma unroll
      for (int ni = 0; ni < 2; ++ni)
        fb[ni] = *(const bf16x8*)(sB + (wn * 64 + ni * 32 + (lane & 31)) * LDSTR + ks * 16 + (lane >> 5) * 8);
#pragma unroll
      for (int mi = 0; mi < 4; ++mi)
#pragma unroll
        for (int ni = 0; ni < 2; ++ni)
          acc[mi][ni] = __builtin_amdgcn_mfma_f32_32x32x16_bf16(fa[mi], fb[ni], acc[mi][ni], 0, 0, 0);
    }
    __builtin_amdgcn_s_setprio(0);
    __syncthreads();
  }
  if (noepi) {
    float sacc = 0.f;
#pragma unroll
    for (int a = 0; a < 4; ++a)
#pragma unroll
      for (int b = 0; b < 2; ++b) sacc += acc[a][b][3];
    if (sacc == 1.2345e30f) p.DT[0] = sacc;
    return;
  }
  const int mj = (mt < 64) ? (mt >> 4) : 4;
  const int c31 = lane & 31, hh = lane >> 5;
  const int gcolA = nt * 128 + wn * 64 + c31, gcolB = gcolA + 32;
  if (MODE == 0 && nt == 24) {
    if (wn == 0 && c31 < 8) {
#pragma unroll
      for (int mi = 0; mi < 4; ++mi)
#pragma unroll
        for (int r = 0; r < 16; ++r) {
          const int R = mt * 256 + wm * 128 + mi * 32 + (r & 3) + 8 * (r >> 2) + 4 * hh;
          p.DT[(size_t)R * 8 + c31] = acc[mi][0][r];
        }
    }
    return;
  }
  if (MODE == 1 && nt < 16) {
    const bool sl = (gcolA >> 9) == 3;
#pragma unroll
    for (int mi = 0; mi < 4; ++mi)
#pragma unroll
      for (int ni = 0; ni < 2; ++ni)
#pragma unroll
        for (int g4 = 0; g4 < 4; ++g4) {
          float v0 = acc[mi][ni][4 * g4], v1 = acc[mi][ni][4 * g4 + 1], v2 = acc[mi][ni][4 * g4 + 2], v3 = acc[mi][ni][4 * g4 + 3];
          if (sl) { v0 = siluf(v0); v1 = siluf(v1); v2 = siluf(v2); v3 = siluf(v3); }
          int R0 = mt * 256 + wm * 128 + mi * 32 + 8 * g4 + 4 * hh;
          uint2 o; o.x = pack2(v0, v1); o.y = pack2(v2, v3);
          *(uint2*)(p.U + (size_t)(ni ? gcolB : gcolA) * NTOK + R0) = o;
        }
    return;
  }
  if (MODE != 2) {
    float lbA = 0.f, lbB = 0.f;
    int kindA = 0, kindB = 0;
    if (MODE == 0) {
      int pa_ = gcolA >> 9, pb_ = gcolB >> 9;
      kindA = (pa_ == 0) ? 1 : (pa_ == 1 || pa_ == 2) ? 2 : 0;
      kindB = (pb_ == 0) ? 1 : (pb_ == 1 || pb_ == 2) ? 2 : 0;
      if (l == 1) {
        if (kindA == 2) { int dir = pa_ - 1, ch = gcolA & 511; lbA = 1.f / (1.f + __expf(p.hg_lb[dir * 512 + ch] - p.hg_lb[(2 + dir) * 512 + ch])); }
        if (kindB == 2) { int dir = pb_ - 1, ch = gcolB & 511; lbB = 1.f / (1.f + __expf(p.hg_lb[dir * 512 + ch] - p.hg_lb[(2 + dir) * 512 + ch])); }
      }
    } else {
      int pa_ = gcolA >> 9, pb_ = gcolB >> 9;
      kindA = (pa_ == 3 || pa_ >= 5) ? 3 : 0;
      kindB = (pb_ == 3 || pb_ >= 5) ? 3 : 0;
    }
    u16* stg = sA + wave * (32 * 72);
    u16* dstbase = (MODE == 0) ? p.U + (size_t)(nt * 128 + wn * 64) : p.U + (size_t)NTOK * 2048 + (size_t)(nt * 128 - 2048 + wn * 64);
    const int ldo = (MODE == 0) ? UW : 2048;
#pragma unroll
    for (int mi = 0; mi < 4; ++mi) {
#pragma unroll
      for (int r = 0; r < 16; ++r) {
        const int rl = (r & 3) + 8 * (r >> 2) + 4 * hh;
        float va = acc[mi][0][r], vb = acc[mi][1][r];
        if (kindA == 1) va *= 0.08838834764831845f; else if (kindA == 2) va = (1.f - lbA) * __builtin_amdgcn_rcpf(1.f + __expf(va)); else if (kindA == 3) va = siluf(va);
        if (kindB == 1) vb *= 0.08838834764831845f; else if (kindB == 2) vb = (1.f - lbB) * __builtin_amdgcn_rcpf(1.f + __expf(vb)); else if (kindB == 3) vb = siluf(vb);
        stg[rl * 72 + c31] = f2bf(va);
        stg[rl * 72 + 32 + c31] = f2bf(vb);
      }
#pragma unroll
      for (int it = 0; it < 4; ++it) {
        const int rl = it * 8 + (lane >> 3), seg = lane & 7;
        uint4 v = *(const uint4*)(stg + rl * 72 + seg * 8);
        const int R = mt * 256 + wm * 128 + mi * 32 + rl;
        *(uint4*)(dstbase + (size_t)R * ldo + seg * 8) = v;
      }
    }
    return;
  }
  {
    float* stgf = (float*)sA + wave * (32 * 68);
    const int seg = lane & 15;
    const int gc0 = nt * 128 + wn * 64 + seg * 4;
    const float4 g4v = *(const float4*)(p.MOD + (size_t)(l * 5 + mj) * 3072 + 2048 + gc0);
#pragma unroll
    for (int mi = 0; mi < 4; ++mi) {
#pragma unroll
      for (int r = 0; r < 16; ++r) {
        const int rl = (r & 3) + 8 * (r >> 2) + 4 * hh;
        stgf[rl * 68 + c31] = acc[mi][0][r];
        stgf[rl * 68 + 32 + c31] = acc[mi][1][r];
      }
#pragma unroll
      for (int it = 0; it < 8; ++it) {
        const int rl = it * 4 + (lane >> 4);
        float4 v = *(const float4*)(stgf + rl * 68 + seg * 4);
        const int R = mt * 256 + wm * 128 + mi * 32 + rl;
        const float* src; float* dst;
        if (R < NLAT) { src = ((l == 0) ? p.x : (const float*)p.out) + (size_t)R * 1024 + gc0; dst = p.out + (size_t)R * 1024 + gc0; }
        else { int rc = R - NLAT; src = p.ctx + (size_t)rc * 1024 + gc0; dst = p.XC + (size_t)rc * 1024 + gc0; }
        float4 xv = *(const float4*)src;
        float4 o; o.x = xv.x + g4v.x * v.x; o.y = xv.y + g4v.y * v.y; o.z = xv.z + g4v.z * v.z; o.w = xv.w + g4v.w * v.w;
        *(float4*)dst = o;
      }
    }
  }
}

template <int MODE>
__device__ __forceinline__ void ph_gemm(const P& p, int l, int bid, int nb, u16* sm, int noepi = 0) {
  const int NT = (MODE == 0) ? 25 : (MODE == 1) ? 32 : 8;
  const int MT = (MODE == 2 && l == 1) ? 64 : 68;
  u16* sA = sm; u16* sB = sm + 256 * LDSTR;
  const int xcd = bid & 7, local = bid >> 3, npx = nb >> 3;
  const int mbase = MT >> 3, mextra = MT & 7;
  const int mper = mbase + (xcd < mextra ? 1 : 0);
  const int mstart = (xcd < mextra) ? xcd * (mbase + 1) : mextra * (mbase + 1) + (xcd - mextra) * mbase;
  const int total = mper * NT;
  const int fullb = NT >> 3, rem = NT & 7;
  for (int it = 0;; ++it) {
    int mt, nt;
    if ((nb & 7) == 0) {
      int q = local + npx * it;
      if (q >= total) break;
      int b, i, bw;
      if (q < fullb * mper * 8) { b = q / (mper * 8); i = q - b * mper * 8; bw = 8; }
      else { b = fullb; i = q - fullb * mper * 8; bw = rem; }
      int sub = i / (4 * bw);
      const int nsub = mper >> 2;
      int mt_off, nt_off;
      if (sub < nsub) { int j = i - sub * 4 * bw; mt_off = j & 3; nt_off = j >> 2; }
      else { int j = i - nsub * 4 * bw; sub = nsub; mt_off = 0; nt_off = j; }
      mt = mstart + sub * 4 + mt_off; nt = b * 8 + nt_off;
    } else {
      int t = bid + it * nb;
      if (t >= MT * NT) break;
      nt = t / MT; mt = t % MT;
    }
    __syncthreads();
    gemm_tile<MODE>(p, l, mt, nt, sA, sB, noepi);
  }
  __syncthreads();
}

__device__ __forceinline__ void hg_task(const P& p, int l, int task, float* sm) {
  int tid = threadIdx.x; asm volatile("" : "+v"(tid)); const int wave = tid >> 6, lane = tid & 63;
  const int b = task >> 5, h = (task >> 3) & 3, es = task & 7;
  const int dg = lane & 15, el = lane >> 4;
  float* qs = sm; float* ks = sm + 4096; float* vs = sm + 8192; float* os = sm + 8192 + 512;
  for (int dir = 0; dir < 2; ++dir) {
    float S[8];
#pragma unroll
    for (int r = 0; r < 8; ++r) S[r] = 0.f;
    for (int chunk = 0; chunk < 136; ++chunk) {
#pragma unroll
      for (int i = 0; i < 2; ++i) {
        int q = tid + 256 * i; int pos = q >> 4, seg = q & 15;
        int R = pos2row_seq(b, chunk * 32 + pos, dir);
        const u16* up = p.U + (size_t)R * UW + h * 128 + seg * 8;
        uint4 qv = *(const uint4*)up;
        uint4 kv = *(const uint4*)(up + 512 + dir * 512);
        float f[8];
        unpack8(qv, f);
        *(float4*)(qs + pos * 128 + seg * 8) = make_float4(f[0], f[1], f[2], f[3]);
        *(float4*)(qs + pos * 128 + seg * 8 + 4) = make_float4(f[4], f[5], f[6], f[7]);
        unpack8(kv, f);
        *(float4*)(ks + pos * 128 + seg * 8) = make_float4(f[0], f[1], f[2], f[3]);
        *(float4*)(ks + pos * 128 + seg * 8 + 4) = make_float4(f[4], f[5], f[6], f[7]);
      }
      {
        int pos = tid >> 3, e2 = (tid & 7) * 2;
        int R = pos2row_seq(b, chunk * 32 + pos, dir);
        uint32_t w = *(const uint32_t*)(p.U + (size_t)R * UW + 1536 + h * 128 + es * 16 + e2);
        vs[pos * 16 + e2] = bflo(w); vs[pos * 16 + e2 + 1] = bfhi(w);
      }
      __syncthreads();
#pragma unroll 4
      for (int i = 0; i < 32; ++i) {
        float4 q0 = *(const float4*)(qs + i * 128 + dg * 8), q1 = *(const float4*)(qs + i * 128 + dg * 8 + 4);
        float4 k0 = *(const float4*)(ks + i * 128 + dg * 8), k1 = *(const float4*)(ks + i * 128 + dg * 8 + 4);
        float v = vs[i * 16 + wave * 4 + el];
        S[0] += k0.x * (v - S[0]); S[1] += k0.y * (v - S[1]); S[2] += k0.z * (v - S[2]); S[3] += k0.w * (v - S[3]);
        S[4] += k1.x * (v - S[4]); S[5] += k1.y * (v - S[5]); S[6] += k1.z * (v - S[6]); S[7] += k1.w * (v - S[7]);
        float o = q0.x * S[0] + q0.y * S[1] + q0.z * S[2] + q0.w * S[3] + q1.x * S[4] + q1.y * S[5] + q1.z * S[6] + q1.w * S[7];
        o += __shfl_xor(o, 1); o += __shfl_xor(o, 2); o += __shfl_xor(o, 4); o += __shfl_xor(o, 8);
        if (dg == 0) os[i * 16 + wave * 4 + el] = o;
      }
      __syncthreads();
      {
        int pos = tid >> 3, e2 = (tid & 7) * 2;
        int R = pos2row_seq(b, chunk * 32 + pos, dir);
        uint32_t* yp = (uint32_t*)(p.Y2 + (size_t)R * 1024 + h * 128 + es * 16 + e2);
        float o0 = os[pos * 16 + e2], o1 = os[pos * 16 + e2 + 1];
        if (dir == 1) { uint32_t w = *yp; o0 += bflo(w); o1 += bfhi(w); }
        *yp = pack2(o0, o1);
      }
    }
    __syncthreads();
  }
}

__device__ __forceinline__ void m2_task(const P& p, int l, int task, float* sm) {
  int tid = threadIdx.x; asm volatile("" : "+v"(tid)); const int wave = tid >> 6, lane = tid & 63;
  const int b = task >> 5, head = (task >> 2) & 7, ps = task & 3;
  const int g = head >> 2;
  const int dg = lane & 15, el = lane >> 4;
  float* Cs = sm; float* Bs = sm + 4096; float* xs = sm + 8192; float* os = sm + 8192 + 512;
  float* dts = sm + 8192 + 1024; float* decs = dts + 32;
  for (int dir = 0; dir < 2; ++dir) {
    const float* cw = p.m2_conv_w + (size_t)(l * 2 + dir) * 4 * 1024;
    const float* cb = p.m2_conv_b + (size_t)(l * 2 + dir) * 1024;
    const float dtb = p.m2_dt_bias[(l * 2 + dir) * 8 + head];
    const float Aneg = -__expf(p.m2_a_log[(l * 2 + dir) * 8 + head]);
    const float Dsk = p.m2_d[(l * 2 + dir) * 8 + head];
    float S[8];
#pragma unroll
    for (int r = 0; r < 8; ++r) S[r] = 0.f;
    for (int chunk = 0; chunk < 136; ++chunk) {
      const int pbase = chunk * 32;
      const int seg0 = (pbase < 256) ? 0 : 256;
#pragma unroll
      for (int i = 0; i < 2; ++i) {
        int q = tid + 256 * i; int pos = q >> 4, seg = q & 15;
        int pp = pbase + pos;
        int chB = 512 + g * 128 + seg * 8, chC = 768 + g * 128 + seg * 8;
        float aB[8], aC[8];
#pragma unroll
        for (int j = 0; j < 8; ++j) { aB[j] = cb[chB + j]; aC[j] = cb[chC + j]; }
#pragma unroll
        for (int tap = 0; tap < 4; ++tap) {
          int pt = pp - 3 + tap;
          if (pt >= seg0) {
            int R = pos2row_m2(b, pt, dir);
            const u16* up = p.U + (size_t)R * UW + 2048;
            uint4 bv = *(const uint4*)(up + chB);
            uint4 cv = *(const uint4*)(up + chC);
            float f[8];
            unpack8(bv, f);
#pragma unroll
            for (int j = 0; j < 8; ++j) aB[j] += cw[tap * 1024 + chB + j] * f[j];
            unpack8(cv, f);
#pragma unroll
            for (int j = 0; j < 8; ++j) aC[j] += cw[tap * 1024 + chC + j] * f[j];
          }
        }
#pragma unroll
        for (int j = 0; j < 8; ++j) { aB[j] = siluf(aB[j]); aC[j] = siluf(aC[j]); }
        *(float4*)(Bs + pos * 128 + seg * 8) = make_float4(aB[0], aB[1], aB[2], aB[3]);
        *(float4*)(Bs + pos * 128 + seg * 8 + 4) = make_float4(aB[4], aB[5], aB[6], aB[7]);
        *(float4*)(Cs + pos * 128 + seg * 8) = make_float4(aC[0], aC[1], aC[2], aC[3]);
        *(float4*)(Cs + pos * 128 + seg * 8 + 4) = make_float4(aC[4], aC[5], aC[6], aC[7]);
      }
      {
        int pos = tid >> 3, e2 = (tid & 7) * 2;
        int pp = pbase + pos;
        int ch = head * 64 + ps * 16 + e2;
        float a0 = cb[ch], a1 = cb[ch + 1];
#pragma unroll
        for (int tap = 0; tap < 4; ++tap) {
          int pt = pp - 3 + tap;
          if (pt >= seg0) {
            int R = pos2row_m2(b, pt, dir);
            uint32_t w = *(const uint32_t*)(p.U + (size_t)R * UW + 2048 + ch);
            a0 += cw[tap * 1024 + ch] * bflo(w); a1 += cw[tap * 1024 + ch + 1] * bfhi(w);
          }
        }
        xs[pos * 16 + e2] = siluf(a0); xs[pos * 16 + e2 + 1] = siluf(a1);
      }
      if (tid < 32) {
        int R = pos2row_m2(b, pbase + tid, dir);
        float dtv = softplusf(p.DT[(size_t)R * 8 + head] + dtb);
        dts[tid] = dtv; decs[tid] = __expf(dtv * Aneg);
      }
      __syncthreads();
#pragma unroll 4
      for (int i = 0; i < 32; ++i) {
        float4 q0 = *(const float4*)(Cs + i * 128 + dg * 8), q1 = *(const float4*)(Cs + i * 128 + dg * 8 + 4);
        float4 k0 = *(const float4*)(Bs + i * 128 + dg * 8), k1 = *(const float4*)(Bs + i * 128 + dg * 8 + 4);
        float xv = xs[i * 16 + wave * 4 + el];
        float a = decs[i]; float v = xv * dts[i];
        S[0] = a * S[0] + k0.x * v; S[1] = a * S[1] + k0.y * v; S[2] = a * S[2] + k0.z * v; S[3] = a * S[3] + k0.w * v;
        S[4] = a * S[4] + k1.x * v; S[5] = a * S[5] + k1.y * v; S[6] = a * S[6] + k1.z * v; S[7] = a * S[7] + k1.w * v;
        float o = q0.x * S[0] + q0.y * S[1] + q0.z * S[2] + q0.w * S[3] + q1.x * S[4] + q1.y * S[5] + q1.z * S[6] + q1.w * S[7];
        o += __shfl_xor(o, 1); o += __shfl_xor(o, 2); o += __shfl_xor(o, 4); o += __shfl_xor(o, 8);
        if (dg == 0) os[i * 16 + wave * 4 + el] = o + Dsk * xv;
      }
      __syncthreads();
      {
        int pos = tid >> 3, e2 = (tid & 7) * 2;
        int R = pos2row_m2(b, pbase + pos, dir);
        uint32_t* yp = (uint32_t*)(p.Y2 + (size_t)R * 1024 + 512 + head * 64 + ps * 16 + e2);
        float o0 = os[pos * 16 + e2], o1 = os[pos * 16 + e2 + 1];
        if (dir == 1) { uint32_t w = *yp; o0 += bflo(w); o1 += bfhi(w); }
        *yp = pack2(o0, o1);
      }
    }
    __syncthreads();
  }
}

#ifndef M2_MFMA
#define M2_MFMA 1
#endif
#define QS 136
#define TS 40
union FragU { bf16x8 v; uint32_t u[4]; uint2 d[2]; uint4 q; };
__device__ __forceinline__ bf16x8 cvt_frag(const f32x16& x, int s2) {
  FragU f;
  f.u[0] = pack2(x[8 * s2 + 0], x[8 * s2 + 1]); f.u[1] = pack2(x[8 * s2 + 2], x[8 * s2 + 3]);
  f.u[2] = pack2(x[8 * s2 + 4], x[8 * s2 + 5]); f.u[3] = pack2(x[8 * s2 + 6], x[8 * s2 + 7]);
  return f.v;
}
__device__ __forceinline__ bf16x8 ld_frag_perm(const u16* base) {
  FragU f; f.d[0] = *(const uint2*)base; f.d[1] = *(const uint2*)(base + 8); return f.v;
}

template <int PASS>
__device__ __forceinline__ void hg_mfma(const P& p, int l, int task, int blk, int dir0, unsigned char* smem) {
  int tid = threadIdx.x; asm volatile("" : "+v"(tid)); const int wave = tid >> 6, lane = tid & 63;
  const int r = lane & 31, hh = lane >> 5;
  const int b = task >> 2, h = task & 3;
  u16* ks = (u16*)smem;
  u16* qs = ks + 32 * QS;
  u16* kT = qs + 32 * QS;
  u16* vT = kT + 128 * TS;
  float* tot = (float*)(vT + 128 * TS);
  float* eg = tot + 256;
  const int dd = tid & 127, half = tid >> 7;
  for (int dir = (PASS == 0 ? dir0 : 0); dir < (PASS == 0 ? dir0 + 1 : 2); ++dir) {
    const int sbd = (PASS == 0) ? blk : ((blk == 0) ? 0 : (dir ? 9 - blk : blk));
    const int c0 = (sbd == 0) ? 0 : 8 + 16 * (sbd - 1);
    const int c1 = (sbd == 0) ? 8 : 8 + 16 * sbd;
    float gsum = 0.f;
    f32x16 S[4];
#pragma unroll
    for (int i = 0; i < 4; ++i)
#pragma unroll
      for (int q = 0; q < 16; ++q) S[i][q] = 0.f;
    if (PASS == 1) {
      for (int qb = 0; qb < sbd; ++qb) {
        const size_t sidx = (size_t)((task * 2 + dir) * 8 + qb);
        if (half == 0) eg[dd] = __expf(p.PS[sidx * 128 + dd]);
        __syncthreads();
        const float* sp = p.SSH + sidx * 16384 + (size_t)wave * 4096 + lane;
#pragma unroll
        for (int dt = 0; dt < 4; ++dt)
#pragma unroll
          for (int q4 = 0; q4 < 4; ++q4) {
            float4 e4 = *(const float4*)(eg + 32 * dt + 8 * q4 + 4 * hh);
            S[dt][4 * q4 + 0] = S[dt][4 * q4 + 0] * e4.x + sp[(dt * 16 + 4 * q4 + 0) * 64];
            S[dt][4 * q4 + 1] = S[dt][4 * q4 + 1] * e4.y + sp[(dt * 16 + 4 * q4 + 1) * 64];
            S[dt][4 * q4 + 2] = S[dt][4 * q4 + 2] * e4.z + sp[(dt * 16 + 4 * q4 + 2) * 64];
            S[dt][4 * q4 + 3] = S[dt][4 * q4 + 3] * e4.w + sp[(dt * 16 + 4 * q4 + 3) * 64];
          }
        __syncthreads();
      }
    }
    uint4 pq0, pq1, pk0, pk1, pv0, pv1;
#define HG_PREFETCH(CH)                                                                     \
    {                                                                                       \
      int pos0 = tid >> 4, seg = tid & 15;                                                  \
      int R0 = pos2row_seq(b, (CH) * 32 + pos0, dir), R1 = pos2row_seq(b, (CH) * 32 + pos0 + 16, dir); \
      const u16* u0 = p.U + (size_t)R0 * UW + h * 128 + seg * 8;                            \
      const u16* u1 = p.U + (size_t)R1 * UW + h * 128 + seg * 8;                            \
      pq0 = *(const uint4*)u0; pq1 = *(const uint4*)u1;                                     \
      pk0 = *(const uint4*)(u0 + 512 + dir * 512); pk1 = *(const uint4*)(u1 + 512 + dir * 512); \
      int Rv = pos2row_seq(b, (CH) * 32 + (tid & 31), dir);                                 \
      const u16* uv = p.U + (size_t)Rv * UW + 1536 + h * 128 + (tid >> 5) * 16;             \
      pv0 = *(const uint4*)uv; pv1 = *(const uint4*)(uv + 8);                               \
    }
    HG_PREFETCH(c0)
#pragma unroll 1
    for (int chunk = c0; chunk < c1; ++chunk) {
      {
        int pos0 = tid >> 4, seg = tid & 15;
        *(uint4*)(qs + pos0 * QS + seg * 8) = pq0; *(uint4*)(qs + (pos0 + 16) * QS + seg * 8) = pq1;
        *(uint4*)(ks + pos0 * QS + seg * 8) = pk0; *(uint4*)(ks + (pos0 + 16) * QS + seg * 8) = pk1;
        FragU f0, f1; f0.q = pv0; f1.q = pv1;
        u16* vw = vT + ((tid >> 5) * 16) * TS + (tid & 31);
#pragma unroll
        for (int j = 0; j < 4; ++j) {
          vw[(2 * j) * TS] = (u16)(f0.u[j] & 0xffffu); vw[(2 * j + 1) * TS] = (u16)(f0.u[j] >> 16);
          vw[(8 + 2 * j) * TS] = (u16)(f1.u[j] & 0xffffu); vw[(8 + 2 * j + 1) * TS] = (u16)(f1.u[j] >> 16);
        }
      }
      __syncthreads();
      if (chunk + 1 < c1) HG_PREFETCH(chunk + 1)
      const int Rout = pos2row_seq(b, chunk * 32 + r, dir);
      u16* yrow = p.Y2 + (size_t)Rout * 1024 + h * 128 + wave * 32 + 4 * hh;
      uint2 yold[4];
      if (PASS == 1 && dir == 1) {
#pragma unroll
        for (int q4 = 0; q4 < 4; ++q4) yold[q4] = *(const uint2*)(yrow + 8 * q4);
      }
      float gl[16];
      {
        float run = 0.f;
#pragma unroll
        for (int i = 0; i < 16; ++i) {
          float kkv = bf2f(ks[(half * 16 + i) * QS + dd]);
          run += __logf(fmaxf(1.f - kkv, 1e-6f));
          gl[i] = run;
        }
        tot[half * 128 + dd] = run;
      }
      __syncthreads();
      {
        const float t0 = tot[dd], t1 = tot[128 + dd];
        const float off = half ? t0 : 0.f;
        const float g31 = t0 + t1;
        float k2[16];
#pragma unroll
        for (int i = 0; i < 16; ++i) {
          const int pos = half * 16 + i;
          const float g = gl[i] + off;
          const float kkv = bf2f(ks[pos * QS + dd]);
          const float qv = bf2f(qs[pos * QS + dd]);
          qs[pos * QS + dd] = f2bf(qv * __expf(g));
          ks[pos * QS + dd] = f2bf(kkv * __expf(fminf(-g, 60.f)));
          k2[i] = kkv * __expf(g31 - g);
        }
        *(uint4*)(kT + dd * TS + half * 16) = pack8(k2);
        *(uint4*)(kT + dd * TS + half * 16 + 8) = pack8(k2 + 8);
        if (half == 0) eg[dd] = __expf(g31);
        gsum += g31;
      }
      __syncthreads();
      f32x16 O;
      if (PASS == 1) {
      f32x16 att;
#pragma unroll
      for (int q = 0; q < 16; ++q) att[q] = 0.f;
#pragma unroll
      for (int k8 = 0; k8 < 8; ++k8) {
        bf16x8 A = *(const bf16x8*)(ks + r * QS + 16 * k8 + 8 * hh);
        bf16x8 B = *(const bf16x8*)(qs + r * QS + 16 * k8 + 8 * hh);
        att = __builtin_amdgcn_mfma_f32_32x32x16_bf16(A, B, att, 0, 0, 0);
      }
#pragma unroll
      for (int q = 0; q < 16; ++q) {
        int sidx = (q & 3) + 8 * (q >> 2) + 4 * hh;
        if (sidx > r) att[q] = 0.f;
      }
#pragma unroll
      for (int q = 0; q < 16; ++q) O[q] = 0.f;
#pragma unroll
      for (int dt = 0; dt < 4; ++dt)
#pragma unroll
        for (int s2 = 0; s2 < 2; ++s2) {
          bf16x8 A = cvt_frag(S[dt], s2);
          bf16x8 B = ld_frag_perm(qs + r * QS + 32 * dt + 16 * s2 + 4 * hh);
          O = __builtin_amdgcn_mfma_f32_32x32x16_bf16(A, B, O, 0, 0, 0);
        }
#pragma unroll
      for (int s2 = 0; s2 < 2; ++s2) {
        bf16x8 A = ld_frag_perm(vT + (32 * wave + r) * TS + 16 * s2 + 4 * hh);
        bf16x8 B = cvt_frag(att, s2);
        O = __builtin_amdgcn_mfma_f32_32x32x16_bf16(A, B, O, 0, 0, 0);
      }
      }
#pragma unroll
      for (int dt = 0; dt < 4; ++dt) {
#pragma unroll
        for (int q4 = 0; q4 < 4; ++q4) {
          float4 e4 = *(const float4*)(eg + 32 * dt + 8 * q4 + 4 * hh);
          S[dt][4 * q4 + 0] *= e4.x; S[dt][4 * q4 + 1] *= e4.y; S[dt][4 * q4 + 2] *= e4.z; S[dt][4 * q4 + 3] *= e4.w;
        }
#pragma unroll
        for (int s2 = 0; s2 < 2; ++s2) {
          bf16x8 A = *(const bf16x8*)(kT + (32 * dt + r) * TS + 16 * s2 + 8 * hh);
          bf16x8 B = *(const bf16x8*)(vT + (32 * wave + r) * TS + 16 * s2 + 8 * hh);
          S[dt] = __builtin_amdgcn_mfma_f32_32x32x16_bf16(A, B, S[dt], 0, 0, 0);
        }
      }
      if (PASS == 1) {
#pragma unroll
      for (int q4 = 0; q4 < 4; ++q4) {
        float o0 = O[4 * q4], o1 = O[4 * q4 + 1], o2 = O[4 * q4 + 2], o3 = O[4 * q4 + 3];
        if (dir == 1) { o0 += bflo(yold[q4].x); o1 += bfhi(yold[q4].x); o2 += bflo(yold[q4].y); o3 += bfhi(yold[q4].y); }
        uint2 ov; ov.x = pack2(o0, o1); ov.y = pack2(o2, o3);
        *(uint2*)(yrow + 8 * q4) = ov;
      }
      }
      __syncthreads();
    }
    if (PASS == 0) {
      const size_t sidx = (size_t)((task * 2 + dir) * 8 + sbd);
      if (half == 0) p.PS[sidx * 128 + dd] = gsum;
      float* sp = p.SSH + sidx * 16384 + (size_t)wave * 4096 + lane;
#pragma unroll
      for (int dt = 0; dt < 4; ++dt)
#pragma unroll
        for (int q = 0; q < 16; ++q) sp[(dt * 16 + q) * 64] = S[dt][q];
    }
    __syncthreads();
  }
}

#if M2_MFMA
#define M2_NTASK 16
template <int PASS>
__device__ __forceinline__ void m2_mfma(const P& p, int l, int task, int blk, int dir0, unsigned char* smem) {
  int tid = threadIdx.x; asm volatile("" : "+v"(tid)); const int wave = tid >> 6, lane = tid & 63;
  const int r = lane & 31, hh = lane >> 5;
  const int b = task >> 2, g = (task >> 1) & 1, hp = task & 1;
  const int hq = wave >> 1, ph = wave & 1;
  const int head = 4 * g + 2 * hp + hq;
  u16* Bm = (u16*)smem;
  u16* Cm = Bm + 32 * QS;
  u16* BmT = Cm + 32 * QS;
  u16* xsT = BmT + 128 * TS;
  float* Gs = (float*)(xsT + 128 * TS);
  float* dts = Gs + 64;
  float* wl = dts + 64;
  const int cp = (lane < 48) ? lane : 47;
  const bool act = lane < 48;
  const int chW = (cp < 16) ? ((4 * g + 2 * hp) * 64 + cp * 8) : (cp < 32) ? (512 + g * 128 + (cp - 16) * 8) : (768 + g * 128 + (cp - 32) * 8);
  const int chU = 2048 + chW;
  float* SSM = (float*)p.KF;
  for (int dir = (PASS == 0 ? dir0 : 0); dir < (PASS == 0 ? dir0 + 1 : 2); ++dir) {
    const int sbd = (PASS == 0) ? blk : ((blk == 0) ? 0 : (dir ? 9 - blk : blk));
    const int c0 = (sbd == 0) ? 0 : 8 + 16 * (sbd - 1);
    const int c1 = (sbd == 0) ? 8 : 8 + 16 * sbd;
    float lsum = 0.f;
    const float* cw = p.m2_conv_w + (size_t)(l * 2 + dir) * 4 * 1024;
    const float* cb = p.m2_conv_b + (size_t)(l * 2 + dir) * 1024;
    if (wave == 0) {
#pragma unroll
      for (int j = 0; j < 8; ++j) {
        wl[(4 * 8 + j) * 64 + lane] = cb[chW + j];
#pragma unroll
        for (int tap = 0; tap < 4; ++tap) wl[(tap * 8 + j) * 64 + lane] = cw[tap * 1024 + chW + j];
      }
    }
    __syncthreads();
    const int hd_t = 4 * g + 2 * hp + ((tid >> 5) & 1);
    const float dtb = p.m2_dt_bias[(l * 2 + dir) * 8 + hd_t];
    const float Aneg_t = -__expf(p.m2_a_log[(l * 2 + dir) * 8 + hd_t]);
    const float Dsk = p.m2_d[(l * 2 + dir) * 8 + head];
    f32x16 S[4];
#pragma unroll
    for (int i = 0; i < 4; ++i)
#pragma unroll
      for (int q = 0; q < 16; ++q) S[i][q] = 0.f;
    if (PASS == 1) {
      for (int qb = 0; qb < sbd; ++qb) {
        const size_t sidx = (size_t)((task * 2 + dir) * 8 + qb);
        const float a = __expf(p.PA[sidx * 4 + wave]);
        const float* sp = SSM + sidx * 16384 + (size_t)wave * 4096 + lane;
#pragma unroll
        for (int nt = 0; nt < 4; ++nt)
#pragma unroll
          for (int q = 0; q < 16; ++q) S[nt][q] = S[nt][q] * a + sp[(nt * 16 + q) * 64];
      }
    }
    uint4 raw0, raw1, raw2, raw3, raw4, raw5, raw6, raw7, raw8, raw9, raw10;
    float dtraw = 0.f;
#define M2_LD1(RW, I, CH)                                                                  \
    {                                                                                      \
      int pt = (CH) * 32 + wave * 8 + (I) - 3;                                             \
      int sg0 = ((CH) * 32 < 256) ? 0 : 256;                                               \
      if (pt >= sg0) { int Rr = pos2row_m2(b, pt, dir); RW = *(const uint4*)(p.U + (size_t)Rr * UW + chU); } \
      else RW = make_uint4(0u, 0u, 0u, 0u);                                                \
    }
#define M2_PREFETCH(CH)                                                                    \
    M2_LD1(raw0, 0, CH) M2_LD1(raw1, 1, CH) M2_LD1(raw2, 2, CH) M2_LD1(raw3, 3, CH) M2_LD1(raw4, 4, CH) M2_LD1(raw5, 5, CH) \
    M2_LD1(raw6, 6, CH) M2_LD1(raw7, 7, CH) M2_LD1(raw8, 8, CH) M2_LD1(raw9, 9, CH) M2_LD1(raw10, 10, CH)            \
    if (tid < 64) { int Rr = pos2row_m2(b, (CH) * 32 + (tid & 31), dir); dtraw = p.DT[(size_t)Rr * 8 + hd_t]; }
    M2_PREFETCH(c0)
#pragma unroll 1
    for (int chunk = c0; chunk < c1; ++chunk) {
      {
#define M2_RAWF(RW, J) (((J) & 1) ? bfhi((RW)) : bflo((RW)))
#define M2_CH(J, C0, C1, C2, C3, C4, C5, C6, C7, C8, C9, C10)                               \
        {                                                                                  \
          const float q0 = wl[(0 * 8 + (J)) * 64 + lane], q1 = wl[(1 * 8 + (J)) * 64 + lane]; \
          const float q2 = wl[(2 * 8 + (J)) * 64 + lane], q3 = wl[(3 * 8 + (J)) * 64 + lane]; \
          const float qb = wl[(4 * 8 + (J)) * 64 + lane];                                  \
          const float v0 = M2_RAWF(C0, J), v1 = M2_RAWF(C1, J), v2 = M2_RAWF(C2, J), v3 = M2_RAWF(C3, J); \
          const float v4 = M2_RAWF(C4, J), v5 = M2_RAWF(C5, J), v6 = M2_RAWF(C6, J), v7 = M2_RAWF(C7, J); \
          const float v8 = M2_RAWF(C8, J), v9 = M2_RAWF(C9, J), v10 = M2_RAWF(C10, J);      \
          float o[8];                                                                      \
          o[0] = siluf(qb + q0 * v0 + q1 * v1 + q2 * v2 + q3 * v3);                        \
          o[1] = siluf(qb + q0 * v1 + q1 * v2 + q2 * v3 + q3 * v4);                        \
          o[2] = siluf(qb + q0 * v2 + q1 * v3 + q2 * v4 + q3 * v5);                        \
          o[3] = siluf(qb + q0 * v3 + q1 * v4 + q2 * v5 + q3 * v6);                        \
          o[4] = siluf(qb + q0 * v4 + q1 * v5 + q2 * v6 + q3 * v7);                        \
          o[5] = siluf(qb + q0 * v5 + q1 * v6 + q2 * v7 + q3 * v8);                        \
          o[6] = siluf(qb + q0 * v6 + q1 * v7 + q2 * v8 + q3 * v9);                        \
          o[7] = siluf(qb + q0 * v7 + q1 * v8 + q2 * v9 + q3 * v10);                       \
          if (act) {                                                                       \
            if (cp < 16) {                                                                 \
              *(uint4*)(xsT + (cp * 8 + (J)) * TS + wave * 8) = pack8(o);                  \
            } else if (cp < 32) {                                                          \
              *(uint4*)(BmT + ((cp - 16) * 8 + (J)) * TS + wave * 8) = pack8(o);           \
              _Pragma("unroll") for (int i = 0; i < 8; ++i) Bm[(wave * 8 + i) * QS + (cp - 16) * 8 + (J)] = f2bf(o[i]); \
            } else {                                                                       \
              _Pragma("unroll") for (int i = 0; i < 8; ++i) Cm[(wave * 8 + i) * QS + (cp - 32) * 8 + (J)] = f2bf(o[i]); \
            }                                                                              \
          }                                                                                \
        }
        M2_CH(0, raw0.x, raw1.x, raw2.x, raw3.x, raw4.x, raw5.x, raw6.x, raw7.x, raw8.x, raw9.x, raw10.x)
        M2_CH(1, raw0.x, raw1.x, raw2.x, raw3.x, raw4.x, raw5.x, raw6.x, raw7.x, raw8.x, raw9.x, raw10.x)
        M2_CH(2, raw0.y, raw1.y, raw2.y, raw3.y, raw4.y, raw5.y, raw6.y, raw7.y, raw8.y, raw9.y, raw10.y)
        M2_CH(3, raw0.y, raw1.y, raw2.y, raw3.y, raw4.y, raw5.y, raw6.y, raw7.y, raw8.y, raw9.y, raw10.y)
        M2_CH(4, raw0.z, raw1.z, raw2.z, raw3.z, raw4.z, raw5.z, raw6.z, raw7.z, raw8.z, raw9.z, raw10.z)
        M2_CH(5, raw0.z, raw1.z, raw2.z, raw3.z, raw4.z, raw5.z, raw6.z, raw7.z, raw8.z, raw9.z, raw10.z)
        M2_CH(6, raw0.w, raw1.w, raw2.w, raw3.w, raw4.w, raw5.w, raw6.w, raw7.w, raw8.w, raw9.w, raw10.w)
        M2_CH(7, raw0.w, raw1.w, raw2.w, raw3.w, raw4.w, raw5.w, raw6.w, raw7.w, raw8.w, raw9.w, raw10.w)
      }
      if (tid < 64) {
        float dtv = softplusf(dtraw + dtb);
        float run = dtv * Aneg_t;
#pragma unroll
        for (int o = 1; o < 32; o <<= 1) { float n = __shfl_up(run, o, 32); if ((tid & 31) >= o) run += n; }
        Gs[tid] = run; dts[tid] = dtv;
      }
      __syncthreads();
      if (chunk + 1 < c1) { M2_PREFETCH(chunk + 1) }
      const int Rout = pos2row_m2(b, chunk * 32 + r, dir);
      u16* yrow = p.Y2 + (size_t)Rout * 1024 + 512 + head * 64 + 32 * ph + 4 * hh;
      uint2 yold[4];
      if (PASS == 1 && dir == 1) {
#pragma unroll
        for (int i = 0; i < 4; ++i) yold[i] = *(const uint2*)(yrow + 8 * i);
      }
      const float* Gw = Gs + hq * 32; const float* dw = dts + hq * 32;
      const float Gt = Gw[r], G31 = Gw[31];
      lsum += G31;
      const u16* xw = xsT + (hq * 64 + ph * 32) * TS;
      f32x16 O0;
      if (PASS == 1) {
      f32x16 att;
#pragma unroll
      for (int q = 0; q < 16; ++q) att[q] = 0.f;
#pragma unroll
      for (int k8 = 0; k8 < 8; ++k8) {
        bf16x8 A = *(const bf16x8*)(Bm + r * QS + 16 * k8 + 8 * hh);
        bf16x8 B = *(const bf16x8*)(Cm + r * QS + 16 * k8 + 8 * hh);
        att = __builtin_amdgcn_mfma_f32_32x32x16_bf16(A, B, att, 0, 0, 0);
      }
#pragma unroll
      for (int q4 = 0; q4 < 4; ++q4) {
        float4 gs4 = *(const float4*)(Gw + 8 * q4 + 4 * hh);
        float4 dt4 = *(const float4*)(dw + 8 * q4 + 4 * hh);
        int s0 = 8 * q4 + 4 * hh;
        att[4 * q4 + 0] = (s0 + 0 <= r) ? att[4 * q4 + 0] * __expf(Gt - gs4.x) * dt4.x : 0.f;
        att[4 * q4 + 1] = (s0 + 1 <= r) ? att[4 * q4 + 1] * __expf(Gt - gs4.y) * dt4.y : 0.f;
        att[4 * q4 + 2] = (s0 + 2 <= r) ? att[4 * q4 + 2] * __expf(Gt - gs4.z) * dt4.z : 0.f;
        att[4 * q4 + 3] = (s0 + 3 <= r) ? att[4 * q4 + 3] * __expf(Gt - gs4.w) * dt4.w : 0.f;
      }
#pragma unroll
      for (int q = 0; q < 16; ++q) O0[q] = 0.f;
#pragma unroll
      for (int nt = 0; nt < 4; ++nt)
#pragma unroll
        for (int s2 = 0; s2 < 2; ++s2) {
          bf16x8 B = ld_frag_perm(Cm + r * QS + 32 * nt + 16 * s2 + 4 * hh);
          O0 = __builtin_amdgcn_mfma_f32_32x32x16_bf16(cvt_frag(S[nt], s2), B, O0, 0, 0, 0);
        }
      {
        const float eGt = __expf(Gt);
#pragma unroll
        for (int q = 0; q < 16; ++q) O0[q] *= eGt;
      }
#pragma unroll
      for (int s2 = 0; s2 < 2; ++s2) {
        bf16x8 B = cvt_frag(att, s2);
        O0 = __builtin_amdgcn_mfma_f32_32x32x16_bf16(ld_frag_perm(xw + r * TS + 16 * s2 + 4 * hh), B, O0, 0, 0, 0);
      }
#pragma unroll
      for (int q = 0; q < 16; ++q) {
        int pp = (q & 3) + 8 * (q >> 2) + 4 * hh;
        O0[q] += Dsk * bf2f(xw[pp * TS + r]);
      }
      }
      {
        const float eG31 = __expf(G31);
#pragma unroll
        for (int nt = 0; nt < 4; ++nt)
#pragma unroll
          for (int q = 0; q < 16; ++q) S[nt][q] *= eG31;
#pragma unroll
        for (int s2 = 0; s2 < 2; ++s2) {
          float ws[8];
          {
            float4 ga = *(const float4*)(Gw + 16 * s2 + 8 * hh), gb = *(const float4*)(Gw + 16 * s2 + 8 * hh + 4);
            float4 da = *(const float4*)(dw + 16 * s2 + 8 * hh), db = *(const float4*)(dw + 16 * s2 + 8 * hh + 4);
            ws[0] = da.x * __expf(G31 - ga.x); ws[1] = da.y * __expf(G31 - ga.y); ws[2] = da.z * __expf(G31 - ga.z); ws[3] = da.w * __expf(G31 - ga.w);
            ws[4] = db.x * __expf(G31 - gb.x); ws[5] = db.y * __expf(G31 - gb.y); ws[6] = db.z * __expf(G31 - gb.z); ws[7] = db.w * __expf(G31 - gb.w);
          }
          bf16x8 Bf0;
          {
            float f[8]; unpack8(*(const uint4*)(xw + r * TS + 16 * s2 + 8 * hh), f);
#pragma unroll
            for (int j = 0; j < 8; ++j) f[j] *= ws[j];
            FragU u; u.q = pack8(f); Bf0 = u.v;
          }
#pragma unroll
          for (int nt = 0; nt < 4; ++nt) {
            bf16x8 A = *(const bf16x8*)(BmT + (32 * nt + r) * TS + 16 * s2 + 8 * hh);
            S[nt] = __builtin_amdgcn_mfma_f32_32x32x16_bf16(A, Bf0, S[nt], 0, 0, 0);
          }
        }
      }
      if (PASS == 1) {
#pragma unroll
      for (int q4 = 0; q4 < 4; ++q4) {
        float o0 = O0[4 * q4], o1 = O0[4 * q4 + 1], o2 = O0[4 * q4 + 2], o3 = O0[4 * q4 + 3];
        if (dir == 1) { o0 += bflo(yold[q4].x); o1 += bfhi(yold[q4].x); o2 += bflo(yold[q4].y); o3 += bfhi(yold[q4].y); }
        uint2 ov; ov.x = pack2(o0, o1); ov.y = pack2(o2, o3);
        *(uint2*)(yrow + 8 * q4) = ov;
      }
      }
      __syncthreads();
    }
    if (PASS == 0) {
      const size_t sidx = (size_t)((task * 2 + dir) * 8 + sbd);
      if (lane == 0) p.PA[sidx * 4 + wave] = lsum;
      float* sp = SSM + sidx * 16384 + (size_t)wave * 4096 + lane;
#pragma unroll
      for (int nt = 0; nt < 4; ++nt)
#pragma unroll
        for (int q = 0; q < 16; ++q) sp[(nt * 16 + q) * 64] = S[nt][q];
    }
    __syncthreads();
  }
}
#endif
__device__ __forceinline__ void ph_mixA0(const P& p, int l, int bid, int nb, unsigned char* sm) {
  for (int t = bid; t < 512; t += nb) {
    if (t < 256) hg_mfma<0>(p, l, t >> 4, (t >> 1) & 7, t & 1, sm);
    else { int u = t - 256; m2_mfma<0>(p, l, u >> 4, (u >> 1) & 7, u & 1, sm); }
    __syncthreads();
  }
}
__device__ __forceinline__ void ph_mixA1(const P& p, int l, int bid, int nb, unsigned char* sm) {
  for (int t = bid; t < 288; t += nb) {
    if (t < 128) hg_mfma<1>(p, l, t >> 3, 1 + (t & 7), 0, sm);
    else if (t < 256) { int u = t - 128; m2_mfma<1>(p, l, u >> 3, 1 + (u & 7), 0, sm); }
    else if (t < 272) hg_mfma<1>(p, l, t - 256, 0, 0, sm);
    else m2_mfma<1>(p, l, t - 272, 0, 0, sm);
    __syncthreads();
  }
}

template <int PASS>
__device__ __forceinline__ void rg_task(const P& p, int l, int task, float* sm) {
  int tid = threadIdx.x; asm volatile("" : "+v"(tid));
  const int wave = tid >> 6, lane = tid & 63;
  const int b = task >> 7, head = (task >> 4) & 7, sb = task & 15;
  float* xc = sm;
  float* pa = sm + 2048;
  float* pb = sm + 4096;
  u16* xcb = (u16*)(sm + 6144);
  u16* WTl = xcb + 32 * 72;
  const int j = tid & 63;
  const int spos = tid >> 3, sseg = tid & 7;
  const int sch = head * 64 + sseg * 8;
  const u16* UB2 = p.U + (size_t)NTOK * 2048;
  for (int dir = 0; dir < 2; ++dir) {
    const int ld = l * 2 + dir;
    {
      const float* wa = p.rg_wa + (size_t)(ld * 8 + head) * 4096;
      const float* wx = p.rg_wx + (size_t)(ld * 8 + head) * 4096;
#pragma unroll
      for (int it = 0; it < 4; ++it) {
        int i = (tid >> 4) + 16 * it, j4 = (tid & 15) * 4;
        float4 va = *(const float4*)(wa + i * 64 + j4);
        float4 vx = *(const float4*)(wx + i * 64 + j4);
        WTl[(j4 + 0) * 72 + i] = f2bf(va.x); WTl[(j4 + 1) * 72 + i] = f2bf(va.y);
        WTl[(j4 + 2) * 72 + i] = f2bf(va.z); WTl[(j4 + 3) * 72 + i] = f2bf(va.w);
        WTl[(64 + j4 + 0) * 72 + i] = f2bf(vx.x); WTl[(64 + j4 + 1) * 72 + i] = f2bf(vx.y);
        WTl[(64 + j4 + 2) * 72 + i] = f2bf(vx.z); WTl[(64 + j4 + 3) * 72 + i] = f2bf(vx.w);
      }
    }
    float wcv[4][8], bcv[8];
#pragma unroll
    for (int jj = 0; jj < 8; ++jj) {
      bcv[jj] = p.rg_conv_b[(size_t)ld * 512 + sch + jj];
#pragma unroll
      for (int tap = 0; tap < 4; ++tap) wcv[tap][jj] = p.rg_conv_w[((size_t)ld * 4 + tap) * 512 + sch + jj];
    }
    const int chg = head * 64 + j;
    const float g_ba = p.rg_ba[ld * 512 + chg], g_bx = p.rg_bx[ld * 512 + chg];
    const float g_sp = -8.0f * softplusf(-p.rg_lam[ld * 512 + chg]);
    const int sbd = (PASS == 0) ? sb : (dir ? (sb == 0 ? 0 : 16 - sb) : sb);
    int cbeg, cend;
    if (sbd == 0) { cbeg = 0; cend = 8; }
    else {
      const int jb = sbd - 1;
      if (dir == 0) { cbeg = 8 + (jb * 128) / 15; cend = 8 + ((jb + 1) * 128) / 15; }
      else { const int kb = 14 - jb; cbeg = 8 + 128 - ((kb + 1) * 128) / 15; cend = 8 + 128 - (kb * 128) / 15; }
    }
    float hcarry = 0.f, aprod = 1.f;
    if (PASS == 1 && tid < 64) {
      float2 sv[16];
#pragma unroll
      for (int q = 0; q < 16; ++q) {
        const float2* sp = (const float2*)(p.SUM + ((((size_t)b * 2 + dir) * 17 + q) * 512 + head * 64 + tid) * 2);
        sv[q] = (q < sbd) ? *sp : make_float2(1.f, 0.f);
      }
#pragma unroll
      for (int q = 0; q < 16; ++q) hcarry = sv[q].x * hcarry + sv[q].y;
    }
    uint4 xr0, xr1, xr2, xr3;
#define RG_LD1(XR, TAP, CH)                                                               \
    {                                                                                     \
      int pt = (CH) * 32 + spos - 3 + (TAP);                                              \
      int sg0 = ((CH) * 32 < 256) ? 0 : 256;                                              \
      if (pt >= sg0) { int Rr = pos2row_seq(b, pt, dir); XR = *(const uint4*)(UB2 + (size_t)Rr * 2048 + sch); } \
      else XR = make_uint4(0u, 0u, 0u, 0u);                                               \
    }
#define RG_PREFETCH(CH) RG_LD1(xr0, 0, CH) RG_LD1(xr1, 1, CH) RG_LD1(xr2, 2, CH) RG_LD1(xr3, 3, CH)
    RG_PREFETCH(cbeg)
#pragma unroll 1
    for (int chunk = cbeg; chunk < cend; ++chunk) {
      const int pbase = chunk * 32;
      {
        float a[8], f[8];
#pragma unroll
        for (int jj = 0; jj < 8; ++jj) a[jj] = bcv[jj];
        unpack8(xr0, f);
#pragma unroll
        for (int jj = 0; jj < 8; ++jj) a[jj] += wcv[0][jj] * f[jj];
        unpack8(xr1, f);
#pragma unroll
        for (int jj = 0; jj < 8; ++jj) a[jj] += wcv[1][jj] * f[jj];
        unpack8(xr2, f);
#pragma unroll
        for (int jj = 0; jj < 8; ++jj) a[jj] += wcv[2][jj] * f[jj];
        unpack8(xr3, f);
#pragma unroll
        for (int jj = 0; jj < 8; ++jj) a[jj] += wcv[3][jj] * f[jj];
        *(float4*)(xc + spos * 64 + sseg * 8) = make_float4(a[0], a[1], a[2], a[3]);
        *(float4*)(xc + spos * 64 + sseg * 8 + 4) = make_float4(a[4], a[5], a[6], a[7]);
        *(uint4*)(xcb + spos * 72 + sseg * 8) = pack8(a);
      }
      __syncthreads();
      if (chunk + 1 < cend) { RG_PREFETCH(chunk + 1) }
      const int Rout = pos2row_seq(b, pbase + spos, dir);
      uint4* yp = (uint4*)(p.HL + (size_t)Rout * 1024 + 512 + sch);
      uint4 prev, gv;
      if (PASS == 1 && dir == 1) { prev = *yp; gv = *(const uint4*)(UB2 + (size_t)Rout * 2048 + 512 + sch); }
      {
        const int r = lane & 31, hh = lane >> 5;
        f32x16 acc;
#pragma unroll
        for (int q = 0; q < 16; ++q) acc[q] = 0.f;
#pragma unroll
        for (int ks = 0; ks < 4; ++ks) {
          bf16x8 A = *(const bf16x8*)(xcb + r * 72 + 16 * ks + 8 * hh);
          bf16x8 B = *(const bf16x8*)(WTl + (32 * wave + r) * 72 + 16 * ks + 8 * hh);
          acc = __builtin_amdgcn_mfma_f32_32x32x16_bf16(A, B, acc, 0, 0, 0);
        }
        float* dstp = (wave < 2) ? pa : pb;
        const int jc = (wave & 1) * 32 + r;
#pragma unroll
        for (int q = 0; q < 16; ++q) dstp[((q & 3) + 8 * (q >> 2) + 4 * hh) * 64 + jc] = acc[q];
      }
      __syncthreads();
#pragma unroll
      for (int i = 0; i < 8; ++i) {
        int e = tid + 256 * i;
        float r = sigmf(pa[e] + g_ba);
        float gi = sigmf(pb[e] + g_bx);
        float la = g_sp * r;
        float a = __expf(la);
        float bt = sqrtf(fmaxf(1.f - a * a, 0.f)) * gi * xc[e];
        pa[e] = a; pb[e] = bt;
      }
      __syncthreads();
      if (tid < 64) {
        float hh = hcarry;
#pragma unroll 8
        for (int pos = 0; pos < 32; ++pos) { float av = pa[pos * 64 + tid]; hh = av * hh + pb[pos * 64 + tid]; pb[pos * 64 + tid] = hh; aprod *= av; }
        hcarry = hh;
      }
      __syncthreads();
      if (PASS == 1) {
        float hv[8];
#pragma unroll
        for (int jj = 0; jj < 8; ++jj) hv[jj] = pb[spos * 64 + sseg * 8 + jj];
        if (dir == 1) {
          float f[8]; unpack8(prev, f);
          float gf[8]; unpack8(gv, gf);
#pragma unroll
          for (int jj = 0; jj < 8; ++jj) hv[jj] = (hv[jj] + f[jj]) * gf[jj];
        }
        *yp = pack8(hv);
      }
    }
    if (PASS == 0 && tid < 64) {
      float* sp = p.SUM + ((((size_t)b * 2 + dir) * 17 + sbd) * 512 + head * 64 + tid) * 2;
      sp[0] = aprod; sp[1] = hcarry;
    }
    __syncthreads();
  }
}

typedef bf16x8 __attribute__((aligned(2))) bf16x8_u;
typedef uint4 __attribute__((aligned(4))) uint4_a4;
__device__ __forceinline__ bf16x8 ld_win8(const u16* base, int y, uint32_t sh) {
  const uint32_t* wp = (const uint32_t*)base + (y >> 1);
  uint4 w = *(const uint4_a4*)wp;
  uint32_t w4 = wp[4];
  FragU f;
  f.u[0] = __builtin_amdgcn_alignbit(w.y, w.x, sh);
  f.u[1] = __builtin_amdgcn_alignbit(w.z, w.y, sh);
  f.u[2] = __builtin_amdgcn_alignbit(w.w, w.z, sh);
  f.u[3] = __builtin_amdgcn_alignbit(w4, w.w, sh);
  return f.v;
}

__device__ __forceinline__ void hy_conv3x8(const u16* col, int t8, int n, float w0, float w1, float w2, float bias, float* out) {
  float f[8]; unpack8(*(const uint4*)(col + t8), f);
  float prev = (t8 > 0) ? bf2f(col[t8 - 1]) : 0.f;
  float next = (t8 + 8 < n) ? bf2f(col[t8 + 8]) : 0.f;
#pragma unroll
  for (int j = 0; j < 8; ++j) {
    float a = (j == 0) ? prev : f[j - 1];
    float cnx = (j == 7) ? next : f[j + 1];
    out[j] = bias + w0 * a + w1 * f[j] + w2 * cnx;
  }
}

#define ZB 5128
#define ZJ 80
#define ZI(B, T) ((B) * ZB + ((T) >> 6) * ZJ + ((T) & 63))
__device__ __forceinline__ void hy_task(const P& p, int l, int c, float* sm) {
  int tid = threadIdx.x; asm volatile("" : "+v"(tid)); const int wave = tid >> 6, lane = tid & 63;
  const int r = lane & 31, h = lane >> 5;
  u16* krr = (u16*)sm;
  u16* zs = krr + 8192 + 64;
  float* red = (float*)(zs + 4 * ZB);
  const u16* UT = p.U;
  const float* cwp = p.hy_conv_w + (size_t)l * 3 * 1536;
  const float* cbp = p.hy_conv_b + (size_t)l * 1536;
  for (int o = 0; o < 2; ++o) {
    const u16* K = p.KF + (size_t)(o * 512 + c) * 8192;
    float asum = 0.f;
#pragma unroll
    for (int i = 0; i < 4; ++i) {
      int idx = (tid + 256 * i) * 8;
      uint4 v = *(const uint4*)(K + idx);
      *(uint4*)(krr + idx) = v;
      float f[8]; unpack8(v, f);
#pragma unroll
      for (int j = 0; j < 8; ++j) asum += fabsf(f[j]);
    }
    asum = wave_sum(asum);
    if (lane == 0) red[wave] = asum;
    if (o == 0) {
      const float w0 = cwp[c], w1 = cwp[1536 + c], w2 = cwp[3072 + c], bs = cbp[c];
#pragma unroll 2
      for (int e = tid; e < 2048; e += 256) {
        int b = e >> 9, t8 = (e & 511) * 8;
        float f[8];
        hy_conv3x8(UT + (size_t)c * NTOK + b * 4096, t8, 4096, w0, w1, w2, bs, f);
        *(uint4*)(zs + ZI(b, t8)) = pack8(f);
      }
    }
    __syncthreads();
    const float scale = 1.f / (red[0] + red[1] + red[2] + red[3] + 1e-6f);
    const float skip = p.hy_skip[(l * 2 + o) * 512 + c];
    f32x16 acc[2][2];
#pragma unroll
    for (int a = 0; a < 2; ++a)
#pragma unroll
      for (int b = 0; b < 2; ++b)
#pragma unroll
        for (int q = 0; q < 16; ++q) acc[a][b][q] = 0.f;
    const int I0 = wave * 16;
    const int Il0 = I0 + (r >> 2), Il1 = I0 + 8 + (r >> 2);
    const u16* zb = zs + (r & 3) * ZB + 8 * h;
    const int ybase = 4096 - r + 8 * h + 48;
    bf16x8 F0, F1, F2, F3, F4, F5;
    const uint32_t ysh = (uint32_t)((ybase & 1) * 16);
    {
      const int y0 = ybase - 64 * (I0 - 63);
      F0 = ld_win8(krr, y0, ysh); F1 = ld_win8(krr, y0 - 16, ysh); F2 = ld_win8(krr, y0 - 32, ysh);
      F3 = ld_win8(krr, y0 - 48, ysh); F4 = ld_win8(krr, y0 - 64, ysh); F5 = ld_win8(krr, y0 - 80, ysh);
    }
#pragma unroll 1
    for (int D = I0 - 63; D <= I0 + 15; ++D) {
      bf16x8 B0[4], B1[4];
      {
        int J0 = Il0 - D, J1 = Il1 - D;
        bool ok0 = (unsigned)J0 < 64u, ok1 = (unsigned)J1 < 64u;
        const u16* zp0 = zb + ZJ * J0; const u16* zp1 = zb + ZJ * J1;
#pragma unroll
        for (int ks = 0; ks < 4; ++ks) {
          bf16x8 z0 = {0, 0, 0, 0, 0, 0, 0, 0}, z1 = {0, 0, 0, 0, 0, 0, 0, 0};
          if (ok0) z0 = *(const bf16x8*)(zp0 + 16 * ks);
          if (ok1) z1 = *(const bf16x8*)(zp1 + 16 * ks);
          B0[ks] = z0; B1[ks] = z1;
        }
      }
      acc[0][0] = __builtin_amdgcn_mfma_f32_32x32x16_bf16(F3, B0[0], acc[0][0], 0, 0, 0);
      acc[0][1] = __builtin_amdgcn_mfma_f32_32x32x16_bf16(F3, B1[0], acc[0][1], 0, 0, 0);
      acc[1][0] = __builtin_amdgcn_mfma_f32_32x32x16_bf16(F5, B0[0], acc[1][0], 0, 0, 0);
      acc[1][1] = __builtin_amdgcn_mfma_f32_32x32x16_bf16(F5, B1[0], acc[1][1], 0, 0, 0);
      acc[0][0] = __builtin_amdgcn_mfma_f32_32x32x16_bf16(F2, B0[1], acc[0][0], 0, 0, 0);
      acc[0][1] = __builtin_amdgcn_mfma_f32_32x32x16_bf16(F2, B1[1], acc[0][1], 0, 0, 0);
      acc[1][0] = __builtin_amdgcn_mfma_f32_32x32x16_bf16(F4, B0[1], acc[1][0], 0, 0, 0);
      acc[1][1] = __builtin_amdgcn_mfma_f32_32x32x16_bf16(F4, B1[1], acc[1][1], 0, 0, 0);
      acc[0][0] = __builtin_amdgcn_mfma_f32_32x32x16_bf16(F1, B0[2], acc[0][0], 0, 0, 0);
      acc[0][1] = __builtin_amdgcn_mfma_f32_32x32x16_bf16(F1, B1[2], acc[0][1], 0, 0, 0);
      acc[1][0] = __builtin_amdgcn_mfma_f32_32x32x16_bf16(F3, B0[2], acc[1][0], 0, 0, 0);
      acc[1][1] = __builtin_amdgcn_mfma_f32_32x32x16_bf16(F3, B1[2], acc[1][1], 0, 0, 0);
      acc[0][0] = __builtin_amdgcn_mfma_f32_32x32x16_bf16(F0, B0[3], acc[0][0], 0, 0, 0);
      acc[0][1] = __builtin_amdgcn_mfma_f32_32x32x16_bf16(F0, B1[3], acc[0][1], 0, 0, 0);
      acc[1][0] = __builtin_amdgcn_mfma_f32_32x32x16_bf16(F2, B0[3], acc[1][0], 0, 0, 0);
      acc[1][1] = __builtin_amdgcn_mfma_f32_32x32x16_bf16(F2, B1[3], acc[1][1], 0, 0, 0);
      F0 = F4; F1 = F5;
      if (D < I0 + 15) {
        const int y1 = ybase - 64 * (D + 1);
        F2 = ld_win8(krr, y1 - 32, ysh); F3 = ld_win8(krr, y1 - 48, ysh);
        F4 = ld_win8(krr, y1 - 64, ysh); F5 = ld_win8(krr, y1 - 80, ysh);
      }
    }
    __syncthreads();
#pragma unroll
    for (int ni = 0; ni < 2; ++ni) {
      u16* zc = zs + (r & 3) * ZB + ZJ * (ni ? Il1 : Il0);
#pragma unroll
      for (int mi = 0; mi < 2; ++mi)
#pragma unroll
        for (int q = 0; q < 16; ++q) {
          int i = 32 * mi + (q & 3) + 8 * (q >> 2) + 4 * h;
          float zo = bf2f(zc[i]);
          zc[i] = f2bf(scale * acc[mi][ni][q] + skip * zo);
        }
    }
    __syncthreads();
    {
      const int ch = (o + 1) * 512 + c;
      const float w0 = cwp[ch], w1 = cwp[1536 + ch], w2 = cwp[3072 + ch], bs = cbp[ch];
#pragma unroll 2
      for (int e = tid; e < 2048; e += 256) {
        int b = e >> 9, t8 = (e & 511) * 8;
        float xg[8], y[8];
        hy_conv3x8(UT + (size_t)ch * NTOK + b * 4096, t8, 4096, w0, w1, w2, bs, xg);
        unpack8(*(const uint4*)(zs + ZI(b, t8)), y);
#pragma unroll
        for (int j = 0; j < 8; ++j) y[j] *= xg[j];
        if (o == 0) *(uint4*)(zs + ZI(b, t8)) = pack8(y);
        else {
          float gf[8]; unpack8(*(const uint4*)(UT + (size_t)(1536 + c) * NTOK + b * 4096 + t8), gf);
#pragma unroll
          for (int j = 0; j < 8; ++j) y[j] *= gf[j];
          *(uint4*)(p.U + (size_t)c * NTOK + b * 4096 + t8) = pack8(y);
        }
      }
    }
    __syncthreads();
  }
  if (l == 0) {
    const int t = tid;
    for (int o = 0; o < 2; ++o) {
      const u16* K = p.KFC + (size_t)(o * 512 + c) * 512;
      float asum = 0.f;
      {
        uint32_t w2 = *(const uint32_t*)(K + tid * 2);
        *(uint32_t*)(krr + tid * 2) = w2;
        asum = fabsf(bflo(w2)) + fabsf(bfhi(w2));
      }
      asum = wave_sum(asum);
      if (lane == 0) red[wave] = asum;
      if (o == 0) {
        const float w0 = cwp[c], w1 = cwp[1536 + c], w2 = cwp[3072 + c], bs = cbp[c];
        if (tid < 128) {
          int b = tid >> 5, t8 = (tid & 31) * 8;
          float f[8];
          hy_conv3x8(UT + (size_t)c * NTOK + NLAT + b * 256, t8, 256, w0, w1, w2, bs, f);
          *(uint4*)(zs + ZI(b, t8)) = pack8(f);
        }
      }
      __syncthreads();
      const float scale = 1.f / (red[0] + red[1] + red[2] + red[3] + 1e-6f);
      float a0 = 0, a1 = 0, a2 = 0, a3 = 0;
      for (int s2 = 0; s2 < 256; ++s2) {
        float kv = bf2f(krr[256 - t + s2]);
        a0 += kv * bf2f(zs[ZI(0, s2)]); a1 += kv * bf2f(zs[ZI(1, s2)]); a2 += kv * bf2f(zs[ZI(2, s2)]); a3 += kv * bf2f(zs[ZI(3, s2)]);
      }
      const float skip = p.hy_skip[(l * 2 + o) * 512 + c];
      float y[4];
      y[0] = scale * a0 + skip * bf2f(zs[ZI(0, t)]); y[1] = scale * a1 + skip * bf2f(zs[ZI(1, t)]);
      y[2] = scale * a2 + skip * bf2f(zs[ZI(2, t)]); y[3] = scale * a3 + skip * bf2f(zs[ZI(3, t)]);
      __syncthreads();
      {
        const int ch = (o + 1) * 512 + c;
        const float w0 = cwp[ch], w1 = cwp[1536 + ch], w2 = cwp[3072 + ch], bs = cbp[ch];
#pragma unroll
        for (int b = 0; b < 4; ++b) {
          const u16* col = UT + (size_t)ch * NTOK + NLAT + b * 256;
          float xg = bs + w1 * bf2f(col[t]);
          if (t > 0) xg += w0 * bf2f(col[t - 1]);
          if (t < 255) xg += w2 * bf2f(col[t + 1]);
          float zn = xg * y[b];
          if (o == 0) zs[ZI(b, t)] = f2bf(zn);
          else {
            size_t R = (size_t)NLAT + b * 256 + t;
            float gate = bf2f(UT[(size_t)(1536 + c) * NTOK + R]);
            p.U[(size_t)c * NTOK + R] = f2bf(zn * gate);
          }
        }
      }
      __syncthreads();
    }
  }
}

__device__ __forceinline__ void fin_rows(const P& p, int l, int chunk) {
  int tid = threadIdx.x; asm volatile("" : "+v"(tid)); const int wave = tid >> 6, lane = tid & 63;
  for (int rr = 0; rr < 16; ++rr) {
    int R = chunk * 64 + wave * 16 + rr;
    {
      uint4* yp = (uint4*)(p.Y2 + (size_t)R * 1024 + lane * 8);
      float o[8]; unpack8(*yp, o);
      float ss = 0;
#pragma unroll
      for (int j = 0; j < 8; ++j) ss += o[j] * o[j];
      ss += __shfl_xor(ss, 1); ss += __shfl_xor(ss, 2); ss += __shfl_xor(ss, 4); ss += __shfl_xor(ss, 8);
      float rinv = rsqrtf(ss * (1.f / 128.f) + EPS);
      float gf[8]; unpack8(*(const uint4*)(p.U + (size_t)NTOK * 2048 + (size_t)R * 2048 + 1024 + lane * 8), gf);
#pragma unroll
      for (int j = 0; j < 8; ++j) o[j] = o[j] * rinv * p.hg_norm_w[l * 512 + lane * 8 + j] * gf[j];
      *yp = pack8(o);
    }
    {
      uint4* yp = (uint4*)(p.Y2 + (size_t)R * 1024 + 512 + lane * 8);
      float o[8]; unpack8(*yp, o);
      float gf[8]; unpack8(*(const uint4*)(p.U + (size_t)NTOK * 2048 + (size_t)R * 2048 + 1536 + lane * 8), gf);
      float ss = 0;
#pragma unroll
      for (int j = 0; j < 8; ++j) { o[j] *= gf[j]; ss += o[j] * o[j]; }
      ss += __shfl_xor(ss, 1); ss += __shfl_xor(ss, 2); ss += __shfl_xor(ss, 4); ss += __shfl_xor(ss, 8); ss += __shfl_xor(ss, 16);
      float rinv = rsqrtf(ss * (1.f / 256.f) + EPS);
#pragma unroll
      for (int j = 0; j < 8; ++j) o[j] = o[j] * rinv * p.m2_norm_w[l * 512 + lane * 8 + j];
      *yp = pack8(o);
    }
  }
}

__device__ __forceinline__ void ph_mixB(const P& p, int l, int bid, int nb, float* sm) {
  for (int t = bid; t < 512 + 512; t += nb) {
    if (t < 512) { if (EN_RG) rg_task<0>(p, l, t, sm); }
    else { if (EN_HY) hy_task(p, l, t - 512, sm); }
    __syncthreads();
  }
}
__device__ __forceinline__ void hy_transpose(const P& p, int tile, u16* sm) {
  int tid = threadIdx.x; asm volatile("" : "+v"(tid));
  const int ct = tile & 7, rt = tile >> 3;
  const int c0 = ct * 64, R0 = rt * 64;
#pragma unroll
  for (int i = 0; i < 2; ++i) {
    int q = tid + 256 * i; int cc = q >> 3, seg = q & 7;
    *(uint4*)(sm + cc * 72 + seg * 8) = *(const uint4*)(p.U + (size_t)(c0 + cc) * NTOK + R0 + seg * 8);
  }
  __syncthreads();
#pragma unroll
  for (int i = 0; i < 2; ++i) {
    int q = tid + 256 * i; int rr = q >> 3, seg = q & 7;
    FragU f;
#pragma unroll
    for (int j = 0; j < 4; ++j)
      f.u[j] = (uint32_t)sm[(seg * 8 + 2 * j) * 72 + rr] | ((uint32_t)sm[(seg * 8 + 2 * j + 1) * 72 + rr] << 16);
    *(uint4*)(p.HL + (size_t)(R0 + rr) * 1024 + c0 + seg * 8) = f.q;
  }
}
__device__ __forceinline__ void ph_mixB2(const P& p, int l, int bid, int nb, float* sm) {
  const int nfin = (l == 0 ? NTOK : NLAT) / 64;
  const int ntr = nfin * 8;
  for (int t = bid; t < 512 + nfin + ntr; t += nb) {
    if (t < 512) { if (EN_RG) rg_task<1>(p, l, t, sm); }
    else if (t < 512 + nfin) fin_rows(p, l, t - 512);
    else hy_transpose(p, t - 512 - nfin, (u16*)sm);
    __syncthreads();
  }
}
__device__ __forceinline__ void ph_final(const P& p, int bid, int nb) {
  int tid = threadIdx.x; asm volatile("" : "+v"(tid)); const int wave = tid >> 6, lane = tid & 63;
  for (int R = bid * 4 + wave; R < NLAT; R += nb * 4) {
    float4* rp = (float4*)(p.out + (size_t)R * 1024);
    float4 v[4]; float ss = 0;
#pragma unroll
    for (int i = 0; i < 4; ++i) {
      v[i] = rp[lane + i * 64];
      ss += v[i].x * v[i].x + v[i].y * v[i].y + v[i].z * v[i].z + v[i].w * v[i].w;
    }
    ss = wave_sum(ss);
    float rinv = rsqrtf(ss * (1.f / 1024.f) + EPS);
#pragma unroll
    for (int i = 0; i < 4; ++i) {
      float4 w = *(const float4*)(p.final_norm_w + (lane + i * 64) * 4);
      float4 o; o.x = v[i].x * rinv * w.x; o.y = v[i].y * rinv * w.y; o.z = v[i].z * rinv * w.z; o.w = v[i].w * rinv * w.w;
      rp[lane + i * 64] = o;
    }
  }
}

__device__ __forceinline__ void gbar(unsigned* cnt, unsigned target) {
  asm volatile("s_waitcnt vmcnt(0)" ::: "memory");
  __syncthreads();
  if (threadIdx.x == 0) {
    __builtin_amdgcn_fence(__ATOMIC_RELEASE, "agent");
    asm volatile("s_waitcnt vmcnt(0)" ::: "memory");
    (void)__hip_atomic_fetch_add(cnt, 1u, __ATOMIC_RELAXED, __HIP_MEMORY_SCOPE_AGENT);
    unsigned sp = 0;
    while (__hip_atomic_load(cnt, __ATOMIC_RELAXED, __HIP_MEMORY_SCOPE_AGENT) < target) {
      __builtin_amdgcn_s_sleep(1);
      if (++sp > (1u << 22)) break;
    }
    __builtin_amdgcn_fence(__ATOMIC_ACQUIRE, "agent");
    asm volatile("s_waitcnt vmcnt(0)" ::: "memory");
  }
  __syncthreads();
}

#define SMEM_BYTES 57600
__global__ void __launch_bounds__(256, 2) mega(P p) {
  __shared__ __align__(16) unsigned char smem[SMEM_BYTES];
  cg::grid_group grid = cg::this_grid();
  const int bid = blockIdx.x, nb = gridDim.x;
  float* smf = (float*)smem; u16* smh = (u16*)smem;
#ifndef PHM
#define PHM 0xffff
#endif
  if (PHM & 1) ph_mod(p, bid, nb, smf);
  grid.sync();
  unsigned nbar = 0;
  for (int l = 0; l < 2; ++l) {
    if (PHM & 2) ph_norm(p, l, bid, nb);
    if (PHM & 4) ph_wconv(p, l, bid, nb, smf, l == 0 ? 0 : 114 * 16, 114 * 16 + 16 * 32);
    gbar(p.BAR, (++nbar) * (unsigned)nb);
    if (PHM & 16) ph_gemm<0>(p, l, bid, nb, smh);
    gbar(p.BAR, (++nbar) * (unsigned)nb);
#if PROBE_DUP == 3
    ph_gemm<0>(p, l, bid, nb, smh);
    gbar(p.BAR, (++nbar) * (unsigned)nb);
#endif
#if PROBE_DUP == 10
    ph_norm(p, l, bid, nb);
    ph_wconv(p, l, bid, nb, smf);
    gbar(p.BAR, (++nbar) * (unsigned)nb);
#endif
    if (PHM & 32) ph_mixA0(p, l, bid, nb, smem);
    gbar(p.BAR, (++nbar) * (unsigned)nb);
    if (PHM & 32) ph_mixA1(p, l, bid, nb, smem);
    gbar(p.BAR, (++nbar) * (unsigned)nb);
#if PROBE_DUP == 8
    ph_mixA0(p, l, bid, nb, smem);
    gbar(p.BAR, (++nbar) * (unsigned)nb);
    ph_mixA1(p, l, bid, nb, smem);
    gbar(p.BAR, (++nbar) * (unsigned)nb);
#endif
    if (PHM & 64) ph_gemm<1>(p, l, bid, nb, smh);
    if (PHM & 8) ph_filt(p, l, bid, nb, smf);
    gbar(p.BAR, (++nbar) * (unsigned)nb);
#if PROBE_DUP == 2
    ph_mixB(p, l, bid, nb, smf);
    gbar(p.BAR, (++nbar) * (unsigned)nb);
#endif
#if PROBE_DUP == 4
    ph_gemm<1>(p, l, bid, nb, smh);
    gbar(p.BAR, (++nbar) * (unsigned)nb);
#endif
#if PROBE_DUP == 9
    ph_gemm<1>(p, l, bid, nb, smh, 1);
    gbar(p.BAR, (++nbar) * (unsigned)nb);
#endif
    if (PHM & 128) ph_mixB(p, l, bid, nb, smf);
    gbar(p.BAR, (++nbar) * (unsigned)nb);
    if (PHM & 128) ph_mixB2(p, l, bid, nb, smf);
    gbar(p.BAR, (++nbar) * (unsigned)nb);
#if PROBE_DUP == 7
    for (int t = bid; t < 512; t += nb) { rg_task<1>(p, l, t, smf); __syncthreads(); }
    gbar(p.BAR, (++nbar) * (unsigned)nb);
#endif
    if (PHM & 256) ph_gemm<2>(p, l, bid, nb, smh);
    if ((PHM & 4) && l == 0) ph_wconv(p, 1, bid, nb, smf, 0, 114 * 16);
    gbar(p.BAR, (++nbar) * (unsigned)nb);
  }
  if (PHM & 512) ph_final(p, bid, nb);
}

extern "C" void kernel_launch(void* const* d_in, const int* in_sizes, int n_in, void* d_out, int out_size,
                              void* d_ws, size_t ws_size, hipStream_t stream) {
  static int grid_blocks = 0;
  if (!grid_blocks) {
    int dev = 0, cus = 0, per_cu = 0;
    hipGetDevice(&dev);
    hipDeviceGetAttribute(&cus, hipDeviceAttributeMultiprocessorCount, dev);
    hipOccupancyMaxActiveBlocksPerMultiprocessor(&per_cu, mega, 256, 0);
    if (per_cu < 1) per_cu = 1;
    if (per_cu > 2) per_cu = 2;
    grid_blocks = cus * per_cu;
  }
  P p{};
  const float** fp = (const float**)&p;
  for (int i = 0; i < 34; ++i) fp[i] = (const float*)d_in[i];
  p.out = (float*)d_out;
  char* w = (char*)d_ws;
  size_t off = 0;
  auto take = [&](size_t bytes) { char* r = w + off; off += (bytes + 255) & ~(size_t)255; return r; };
  p.U = (u16*)take((size_t)NTOK * UW * 2);
  p.HL = (u16*)take((size_t)NTOK * 1024 * 2);
  p.Y2 = (u16*)take((size_t)NTOK * 1024 * 2);
  p.WT = (u16*)take((size_t)7296 * 1024 * 2);
  p.WoT = (u16*)take((size_t)1024 * 2048 * 2);
  p.KF = (u16*)take((size_t)1024 * 8192 * 2);
  p.DT = (float*)take((size_t)NTOK * 8 * 4);
  p.MOD = (float*)take((size_t)2 * 5 * 3072 * 4);
  p.SUM = (float*)take((size_t)4 * 2 * 17 * 512 * 2 * 4);
  {
    char* Z = take((size_t)16777216);
    p.SSH = (float*)Z; p.XC = (float*)(Z + 8388608); p.KFC = (u16*)(Z + 12582912);
  }
  p.PS = (float*)take((size_t)16 * 2 * 8 * 128 * 4);
  p.PA = (float*)take((size_t)16 * 2 * 8 * 4 * 4);
  p.BAR = (unsigned*)take((size_t)256);
  if (off > ws_size) { fprintf(stderr, "workspace too small: need %zu have %zu\n", off, ws_size); return; }
  (void)hipMemsetAsync(p.BAR, 0, 256, stream);
  void* args[] = {&p};
  hipError_t e = hipLaunchCooperativeKernel((void*)mega, dim3(grid_blocks), dim3(256), args, 0, stream);
  if (e != hipSuccess) fprintf(stderr, "cooperative launch failed: %s (grid %d)\n", hipGetErrorString(e), grid_blocks);
}
```

```cpp
#include <hip/hip_runtime.h>
#include <hip/hip_bf16.h>
#include <hip/hip_cooperative_groups.h>
#include <cstdio>
#include <cstdint>
namespace cg = cooperative_groups;

typedef unsigned short u16;
using bf16x8 = __attribute__((ext_vector_type(8))) short;
using f32x16 = __attribute__((ext_vector_type(16))) float;

#define NTOK 17408
#define NLAT 16384
#define UW 4096
#define EPS 1e-6f

#ifndef PROBE_DUP
#define PROBE_DUP 0
#endif
#ifndef EN_HY
#define EN_HY 1
#endif
#ifndef EN_RG
#define EN_RG 1
#endif
#ifndef EN_HG
#define EN_HG 1
#endif
#ifndef EN_M2
#define EN_M2 1
#endif

struct P {
  const float *x, *c, *ctx, *c_ctx, *w_mod, *b_mod, *norm_w, *w_in, *w_out;
  const float *hy_conv_w, *hy_conv_b, *hy_w1, *hy_b1, *hy_w2, *hy_b2, *hy_w3, *hy_freq, *hy_skip;
  const float *rg_conv_w, *rg_conv_b, *rg_wa, *rg_ba, *rg_wx, *rg_bx, *rg_lam;
  const float *hg_lb, *hg_norm_w, *m2_conv_w, *m2_conv_b, *m2_dt_bias, *m2_a_log, *m2_d, *m2_norm_w, *final_norm_w;
  float* out;
  u16 *U, *HL, *Y2, *WT, *WoT, *KF, *KFC;
  float *XC, *DT, *MOD, *SUM, *SSH, *PS, *PA;
  unsigned* BAR;
};

typedef __bf16 bf2_t __attribute__((ext_vector_type(2)));
typedef float f2_t __attribute__((ext_vector_type(2)));
__device__ __forceinline__ uint32_t pack2(float a, float b) {
  f2_t v = {a, b};
  return __builtin_bit_cast(uint32_t, __builtin_convertvector(v, bf2_t));
}
__device__ __forceinline__ u16 f2bf(float f) { return (u16)(pack2(f, f) & 0xffffu); }
__device__ __forceinline__ float bf2f(u16 h) { return __uint_as_float(((uint32_t)h) << 16); }
__device__ __forceinline__ float bflo(uint32_t w) { return __uint_as_float(w << 16); }
__device__ __forceinline__ float bfhi(uint32_t w) { return __uint_as_float(w & 0xffff0000u); }
__device__ __forceinline__ float siluf(float x) { return x * __builtin_amdgcn_rcpf(1.f + __expf(-x)); }
__device__ __forceinline__ float sigmf(float x) { return __builtin_amdgcn_rcpf(1.f + __expf(-x)); }
__device__ __forceinline__ float softplusf(float x) { return x > 20.f ? x : log1pf(__expf(x)); }

__device__ __forceinline__ void unpack8(const uint4& v, float* f) {
  f[0] = bflo(v.x); f[1] = bfhi(v.x); f[2] = bflo(v.y); f[3] = bfhi(v.y);
  f[4] = bflo(v.z); f[5] = bfhi(v.z); f[6] = bflo(v.w); f[7] = bfhi(v.w);
}
__device__ __forceinline__ uint4 pack8(const float* f) {
  uint4 v; v.x = pack2(f[0], f[1]); v.y = pack2(f[2], f[3]); v.z = pack2(f[4], f[5]); v.w = pack2(f[6], f[7]);
  return v;
}
__device__ __forceinline__ float wave_sum(float v) {
#pragma unroll
  for (int o = 32; o >= 1; o >>= 1) v += __shfl_xor(v, o);
  return v;
}

__device__ __forceinline__ int pos2row_seq(int b, int p, int dir) {
  if (p < 256) { int t = dir ? 255 - p : p; return NLAT + b * 256 + t; }
  int j = p - 256; int t = dir ? 4095 - j : j; return b * 4096 + t;
}
__device__ __forceinline__ int pos2row_m2(int b, int p, int dir) {
  if (p < 256) { int t = dir ? 255 - p : p; return NLAT + b * 256 + t; }
  int j = p - 256; int jj = dir ? 4095 - j : j; int c = jj >> 6, r = jj & 63; return b * 4096 + r * 64 + c;
}

__device__ __forceinline__ void ph_mod(const P& p, int bid, int nb, float* sm) {
  int tid = threadIdx.x; asm volatile("" : "+v"(tid));
  for (int task = bid; task < 96; task += nb) {
    int l = task / 48, cgi = task % 48;
    int col = cgi * 64 + (tid & 63);
    int kq = tid >> 6;
    float a0 = 0, a1 = 0, a2 = 0, a3 = 0, a4 = 0;
#pragma unroll 8
    for (int k = kq * 256; k < kq * 256 + 256; ++k) {
      float w = p.w_mod[((size_t)l * 1024 + k) * 3072 + col];
      a0 += siluf(p.c[k]) * w; a1 += siluf(p.c[1024 + k]) * w; a2 += siluf(p.c[2048 + k]) * w;
      a3 += siluf(p.c[3072 + k]) * w; a4 += siluf(p.c_ctx[k]) * w;
    }
    sm[(kq * 5 + 0) * 64 + (tid & 63)] = a0; sm[(kq * 5 + 1) * 64 + (tid & 63)] = a1;
    sm[(kq * 5 + 2) * 64 + (tid & 63)] = a2; sm[(kq * 5 + 3) * 64 + (tid & 63)] = a3;
    sm[(kq * 5 + 4) * 64 + (tid & 63)] = a4;
    __syncthreads();
    if (tid < 64) {
      float bm = p.b_mod[l * 3072 + col];
#pragma unroll
      for (int j = 0; j < 5; ++j) {
        float s = sm[(0 * 5 + j) * 64 + tid] + sm[(1 * 5 + j) * 64 + tid] + sm[(2 * 5 + j) * 64 + tid] + sm[(3 * 5 + j) * 64 + tid];
        p.MOD[(size_t)(l * 5 + j) * 3072 + col] = s + bm;
      }
    }
    __syncthreads();
  }
}

__device__ __forceinline__ void ph_norm(const P& p, int l, int bid, int nb) {
  int tid = threadIdx.x; asm volatile("" : "+v"(tid)); const int wave = tid >> 6, lane = tid & 63;
  for (int R = bid * 4 + wave; R < NTOK; R += nb * 4) {
    const float* src; int mj;
    if (R < NLAT) { src = (l == 0 ? p.x : (const float*)p.out) + (size_t)R * 1024; mj = R >> 12; }
    else { int rc = R - NLAT; src = (l == 0 ? p.ctx : (const float*)p.XC) + (size_t)rc * 1024; mj = 4; }
    const float* mod = p.MOD + (size_t)(l * 5 + mj) * 3072;
    float4 v[4]; float ss = 0;
#pragma unroll
    for (int i = 0; i < 4; ++i) {
      v[i] = ((const float4*)src)[lane + i * 64];
      ss += v[i].x * v[i].x + v[i].y * v[i].y + v[i].z * v[i].z + v[i].w * v[i].w;
    }
    ss = wave_sum(ss);
    float rinv = rsqrtf(ss * (1.f / 1024.f) + EPS);
#pragma unroll
    for (int i = 0; i < 4; ++i) {
      int idx = (lane + i * 64) * 4;
      float4 nw = *(const float4*)(p.norm_w + l * 1024 + idx);
      float4 sh = *(const float4*)(mod + idx);
      float4 sc = *(const float4*)(mod + 1024 + idx);
      float h0 = v[i].x * rinv * nw.x * (1.f + sc.x) + sh.x;
      float h1 = v[i].y * rinv * nw.y * (1.f + sc.y) + sh.y;
      float h2 = v[i].z * rinv * nw.z * (1.f + sc.z) + sh.z;
      float h3 = v[i].w * rinv * nw.w * (1.f + sc.w) + sh.w;
      uint2 o; o.x = pack2(h0, h1); o.y = pack2(h2, h3);
      *(uint2*)(p.HL + (size_t)R * 1024 + idx) = o;
    }
  }
}

__device__ __forceinline__ void ph_wconv(const P& p, int l, int bid, int nb, float* sm, int tb, int te) {
  int tid = threadIdx.x; asm volatile("" : "+v"(tid));
  const int T1 = 114 * 16, T2 = 16 * 32;
  for (int t = tb + bid; t < te; t += nb) {
    const float* src; int ld, K, n0, k0, sc0, nvalid; u16* dst;
    if (t < T1) {
      int nt = t / 16, kt = t % 16; n0 = nt * 64; k0 = kt * 64;
      src = p.w_in + (size_t)l * 1024 * 7176; ld = 7176; K = 1024; dst = p.WT; nvalid = 64;
      if (n0 < 2048) sc0 = 3072 + n0;
      else if (n0 < 3072) sc0 = 5632 + (n0 - 2048);
      else if (n0 < 3200) { sc0 = 6656 + (n0 - 3072); nvalid = (n0 == 3072) ? 8 : 0; }
      else { int m = n0 - 3200; if (m < 3072) sc0 = m; else if (m < 3584) sc0 = 5120 + (m - 3072); else sc0 = 6664 + (m - 3584); }
    } else {
      int tt = t - T1; int nt = tt / 32, kt = tt % 32; n0 = nt * 64; k0 = kt * 64;
      src = p.w_out + (size_t)l * 2048 * 1024; ld = 1024; K = 2048; dst = p.WoT; nvalid = 64; sc0 = n0;
    }
#pragma unroll
    for (int i = 0; i < 4; ++i) {
      int kk = (tid >> 4) + 16 * i, cc = (tid & 15) * 4;
      const float* sp = src + (size_t)(k0 + kk) * ld + sc0 + cc;
      float4 v;
      if (nvalid == 64) v = *(const float4*)sp;
      else { v.x = (cc + 0 < nvalid) ? sp[0] : 0.f; v.y = (cc + 1 < nvalid) ? sp[1] : 0.f; v.z = (cc + 2 < nvalid) ? sp[2] : 0.f; v.w = (cc + 3 < nvalid) ? sp[3] : 0.f; }
      sm[kk * 65 + cc + 0] = v.x; sm[kk * 65 + cc + 1] = v.y; sm[kk * 65 + cc + 2] = v.z; sm[kk * 65 + cc + 3] = v.w;
    }
    __syncthreads();
#pragma unroll
    for (int i = 0; i < 2; ++i) {
      int q = tid + 256 * i; int nn = q >> 3, ks = q & 7;
      float f[8];
#pragma unroll
      for (int j = 0; j < 8; ++j) f[j] = sm[(ks * 8 + j) * 65 + nn];
      *(uint4*)(dst + (size_t)(n0 + nn) * K + k0 + ks * 8) = pack8(f);
    }
    __syncthreads();
  }
}

__device__ __forceinline__ void ph_filt(const P& p, int l, int bid, int nb, float* sm) {
  int tid = threadIdx.x; asm volatile("" : "+v"(tid));
  const float HY_MIN = -3.0701134573253945f, HY_MAX = -15.350567286626972f;
  int ntask = 256 + (l == 0 ? 16 : 0);
  float* zs = sm; float* h1 = sm + 544; float* h2 = sm + 544 + 1024;
  for (int task = bid; task < ntask; task += nb) {
    int n, t0; u16* K;
    if (task < 256) { n = 4096; t0 = task * 16; K = p.KF; } else { n = 256; t0 = (task - 256) * 16; K = p.KFC; }
    float inv_nm1 = 1.f / (float)(n - 1);
    for (int e = tid; e < 16 * 33; e += 256) {
      int tt = e / 33, f = e % 33; int t = t0 + tt; float val;
      if (f == 0) val = (float)t * inv_nm1;
      else {
        int bi = (f - 1) & 15;
        float band = 1e-4f + (float)bi * ((15.f - 1e-4f) / 15.f);
        float ang = (6.283185307179586f / (float)n) * (float)t * band;
        val = (f <= 16) ? cosf(ang) : -sinf(ang);
      }
      zs[e] = val;
    }
    __syncthreads();
    for (int e = tid; e < 1024; e += 256) {
      int tt = e >> 6, j = e & 63; float acc = p.hy_b1[l * 64 + j];
#pragma unroll 11
      for (int f = 0; f < 33; ++f) acc += zs[tt * 33 + f] * p.hy_w1[(l * 33 + f) * 64 + j];
      h1[e] = sinf(p.hy_freq[l * 64 + j] * acc);
    }
    __syncthreads();
    for (int e = tid; e < 1024; e += 256) {
      int tt = e >> 6, j = e & 63; float acc = p.hy_b2[l * 64 + j];
#pragma unroll 8
      for (int i = 0; i < 64; ++i) acc += h1[tt * 64 + i] * p.hy_w2[(l * 64 + i) * 64 + j];
      h2[e] = sinf(p.hy_freq[l * 64 + j] * acc);
    }
    __syncthreads();
    for (int r = 0; r < 8; ++r) {
      int col = tid + 256 * r; int o = col >> 10, side = (col >> 9) & 1, c = col & 511;
      float w[64];
#pragma unroll
      for (int i = 0; i < 64; ++i) w[i] = p.hy_w3[(size_t)(l * 64 + i) * 2048 + col];
      float delta = fabsf(HY_MIN + (HY_MAX - HY_MIN) * (float)c / 511.f);
      u16* Kc = K + (size_t)(o * 512 + c) * (2 * n);
      for (int tt = 0; tt < 16; ++tt) {
        float acc = 0;
#pragma unroll
        for (int i = 0; i < 64; ++i) acc += h2[tt * 64 + i] * w[i];
        int t = t0 + tt;
        float val = acc * __expf(-(float)t * inv_nm1 * delta);
        int idx;
        if (side == 0) idx = n - t; else { if (t == 0) { idx = 0; val = 0.f; } else idx = n + t; }
        Kc[idx] = f2bf(val);
      }
    }
    __syncthreads();
  }
}

#define LDSTR 72
template <int MODE>
__device__ __forceinline__ void gemm_tile(const P& p, int l, int mt, int nt, u16* sA, u16* sB, int noepi) {
  int tid = threadIdx.x; asm volatile("" : "+v"(tid)); const int wave = tid >> 6, lane = tid & 63;
  const int wm = wave >> 1, wn = wave & 1;
  const int KT = (MODE == 2) ? 2048 : 1024;
  const u16* Bsrc = (MODE == 0) ? p.WT + (size_t)(nt * 128) * 1024
                  : (MODE == 1) ? p.WT + (size_t)(3200 + nt * 128) * 1024
                                : p.WoT + (size_t)(nt * 128) * 2048;
  f32x16 acc[4][2];
#pragma unroll
  for (int a = 0; a < 4; ++a)
#pragma unroll
    for (int b = 0; b < 2; ++b)
#pragma unroll
      for (int r = 0; r < 16; ++r) acc[a][b][r] = 0.f;
  uint4 ra0, ra1, ra2, ra3, ra4, ra5, ra6, ra7, rb0, rb1, rb2, rb3;
  const int lrow = tid >> 3, lseg = tid & 7;
  const u16* Ab0 = p.HL + (size_t)(mt * 256 + lrow) * 1024 + lseg * 8;
  const u16* Ab1 = p.Y2 + (size_t)(mt * 256 + lrow) * 1024 + lseg * 8;
  const u16* Bb = Bsrc + (size_t)lrow * KT + lseg * 8;
#define GLOADS(K0)                                                                                  \
  {                                                                                                 \
    const u16* ap = (MODE == 2 && (K0) >= 1024) ? Ab1 + ((K0) - 1024) : Ab0 + (K0);                 \
    ra0 = *(const uint4*)(ap); ra1 = *(const uint4*)(ap + 32 * 1024);                               \
    ra2 = *(const uint4*)(ap + 64 * 1024); ra3 = *(const uint4*)(ap + 96 * 1024);                   \
    ra4 = *(const uint4*)(ap + 128 * 1024); ra5 = *(const uint4*)(ap + 160 * 1024);                 \
    ra6 = *(const uint4*)(ap + 192 * 1024); ra7 = *(const uint4*)(ap + 224 * 1024);                 \
    const u16* bp = Bb + (K0);                                                                      \
    rb0 = *(const uint4*)(bp); rb1 = *(const uint4*)(bp + (size_t)32 * KT);                         \
    rb2 = *(const uint4*)(bp + (size_t)64 * KT); rb3 = *(const uint4*)(bp + (size_t)96 * KT);       \
  }
  GLOADS(0)
#pragma unroll 1
  for (int k0 = 0; k0 < KT; k0 += 64) {
    *(uint4*)(sA + (lrow + 0) * LDSTR + lseg * 8) = ra0;   *(uint4*)(sA + (lrow + 32) * LDSTR + lseg * 8) = ra1;
    *(uint4*)(sA + (lrow + 64) * LDSTR + lseg * 8) = ra2;  *(uint4*)(sA + (lrow + 96) * LDSTR + lseg * 8) = ra3;
    *(uint4*)(sA + (lrow + 128) * LDSTR + lseg * 8) = ra4; *(uint4*)(sA + (lrow + 160) * LDSTR + lseg * 8) = ra5;
    *(uint4*)(sA + (lrow + 192) * LDSTR + lseg * 8) = ra6; *(uint4*)(sA + (lrow + 224) * LDSTR + lseg * 8) = ra7;
    *(uint4*)(sB + (lrow + 0) * LDSTR + lseg * 8) = rb0;   *(uint4*)(sB + (lrow + 32) * LDSTR + lseg * 8) = rb1;
    *(uint4*)(sB + (lrow + 64) * LDSTR + lseg * 8) = rb2;  *(uint4*)(sB + (lrow + 96) * LDSTR + lseg * 8) = rb3;
    __syncthreads();
    if (k0 + 64 < KT) GLOADS(k0 + 64)
    __builtin_amdgcn_s_setprio(1);
#pragma unroll
    for (int ks = 0; ks < 4; ++ks) {
      bf16x8 fa[4], fb[2];
#pragma unroll
      for (int mi = 0; mi < 4; ++mi)
        fa[mi] = *(const bf16x8*)(sA + (wm * 128 + mi * 32 + (lane & 31)) * LDSTR + ks * 16 + (lane >> 5) * 8);
#pragma unroll
      for (int ni = 0; ni < 2; ++ni)
        fb[ni] = *(const bf16x8*)(sB + (wn * 64 + ni * 32 + (lane & 31)) * LDSTR + ks * 16 + (lane >> 5) * 8);
#pragma unroll
      for (int mi = 0; mi < 4; ++mi)
#pragma unroll
        for (int ni = 0; ni < 2; ++ni)
          acc[mi][ni] = __builtin_amdgcn_mfma_f32_32x32x16_bf16(fa[mi], fb[ni], acc[mi][ni], 0, 0, 0);
    }
    __builtin_amdgcn_s_setprio(0);
    __syncthreads();
  }
  if (noepi) {
    float sacc = 0.f;
#pragma unroll
    for (int a = 0; a < 4; ++a)
#pragma unroll
      for (int b = 0; b < 2; ++b) sacc += acc[a][b][3];
    if (sacc == 1.2345e30f) p.DT[0] = sacc;
    return;
  }
  const int mj = (mt < 64) ? (mt >> 4) : 4;
  const int c31 = lane & 31, hh = lane >> 5;
  const int gcolA = nt * 128 + wn * 64 + c31, gcolB = gcolA + 32;
  if (MODE == 0 && nt == 24) {
    if (wn == 0 && c31 < 8) {
#pragma unroll
      for (int mi = 0; mi < 4; ++mi)
#pragma unroll
        for (int r = 0; r < 16; ++r) {
          const int R = mt * 256 + wm * 128 + mi * 32 + (r & 3) + 8 * (r >> 2) + 4 * hh;
          p.DT[(size_t)R * 8 + c31] = acc[mi][0][r];
        }
    }
    return;
  }
  if (MODE == 1 && nt < 16) {
    const bool sl = (gcolA >> 9) == 3;
#pragma unroll
    for (int mi = 0; mi < 4; ++mi)
#pragma unroll
      for (int ni = 0; ni < 2; ++ni)
#pragma unroll
        for (int g4 = 0; g4 < 4; ++g4) {
          float v0 = acc[mi][ni][4 * g4], v1 = acc[mi][ni][4 * g4 + 1], v2 = acc[mi][ni][4 * g4 + 2], v3 = acc[mi][ni][4 * g4 + 3];
          if (sl) { v0 = siluf(v0); v1 = siluf(v1); v2 = siluf(v2); v3 = siluf(v3); }
          int R0 = mt * 256 + wm * 128 + mi * 32 + 8 * g4 + 4 * hh;
          uint2 o; o.x = pack2(v0, v1); o.y = pack2(v2, v3);
          *(uint2*)(p.U + (size_t)(ni ? gcolB : gcolA) * NTOK + R0) = o;
        }
    return;
  }
  if (MODE != 2) {
    float lbA = 0.f, lbB = 0.f;
    int kindA = 0, kindB = 0;
    if (MODE == 0) {
      int pa_ = gcolA >> 9, pb_ = gcolB >> 9;
      kindA = (pa_ == 0) ? 1 : (pa_ == 1 || pa_ == 2) ? 2 : 0;
      kindB = (pb_ == 0) ? 1 : (pb_ == 1 || pb_ == 2) ? 2 : 0;
      if (l == 1) {
        if (kindA == 2) { int dir = pa_ - 1, ch = gcolA & 511; lbA = 1.f / (1.f + __expf(p.hg_lb[dir * 512 + ch] - p.hg_lb[(2 + dir) * 512 + ch])); }
        if (kindB == 2) { int dir = pb_ - 1, ch = gcolB & 511; lbB = 1.f / (1.f + __expf(p.hg_lb[dir * 512 + ch] - p.hg_lb[(2 + dir) * 512 + ch])); }
      }
    } else {
      int pa_ = gcolA >> 9, pb_ = gcolB >> 9;
      kindA = (pa_ == 3 || pa_ >= 5) ? 3 : 0;
      kindB = (pb_ == 3 || pb_ >= 5) ? 3 : 0;
    }
    u16* stg = sA + wave * (32 * 72);
    u16* dstbase = (MODE == 0) ? p.U + (size_t)(nt * 128 + wn * 64) : p.U + (size_t)NTOK * 2048 + (size_t)(nt * 128 - 2048 + wn * 64);
    const int ldo = (MODE == 0) ? UW : 2048;
#pragma unroll
    for (int mi = 0; mi < 4; ++mi) {
#pragma unroll
      for (int r = 0; r < 16; ++r) {
        const int rl = (r & 3) + 8 * (r >> 2) + 4 * hh;
        float va = acc[mi][0][r], vb = acc[mi][1][r];
        if (kindA == 1) va *= 0.08838834764831845f; else if (kindA == 2) va = (1.f - lbA) * __builtin_amdgcn_rcpf(1.f + __expf(va)); else if (kindA == 3) va = siluf(va);
        if (kindB == 1) vb *= 0.08838834764831845f; else if (kindB == 2) vb = (1.f - lbB) * __builtin_amdgcn_rcpf(1.f + __expf(vb)); else if (kindB == 3) vb = siluf(vb);
        stg[rl * 72 + c31] = f2bf(va);
        stg[rl * 72 + 32 + c31] = f2bf(vb);
      }
#pragma unroll
      for (int it = 0; it < 4; ++it) {
        const int rl = it * 8 + (lane >> 3), seg = lane & 7;
        uint4 v = *(const uint4*)(stg + rl * 72 + seg * 8);
        const int R = mt * 256 + wm * 128 + mi * 32 + rl;
        *(uint4*)(dstbase + (size_t)R * ldo + seg * 8) = v;
      }
    }
    return;
  }
  {
    float* stgf = (float*)sA + wave * (32 * 68);
    const int seg = lane & 15;
    const int gc0 = nt * 128 + wn * 64 + seg * 4;
    const float4 g4v = *(const float4*)(p.MOD + (size_t)(l * 5 + mj) * 3072 + 2048 + gc0);
#pragma unroll
    for (int mi = 0; mi < 4; ++mi) {
#pragma unroll
      for (int r = 0; r < 16; ++r) {
        const int rl = (r & 3) + 8 * (r >> 2) + 4 * hh;
        stgf[rl * 68 + c31] = acc[mi][0][r];
        stgf[rl * 68 + 32 + c31] = acc[mi][1][r];
      }
#pragma unroll
      for (int it = 0; it < 8; ++it) {
        const int rl = it * 4 + (lane >> 4);
        float4 v = *(const float4*)(stgf + rl * 68 + seg * 4);
        const int R = mt * 256 + wm * 128 + mi * 32 + rl;
        const float* src; float* dst;
        if (R < NLAT) { src = ((l == 0) ? p.x : (const float*)p.out) + (size_t)R * 1024 + gc0; dst = p.out + (size_t)R * 1024 + gc0; }
        else { int rc = R - NLAT; src = p.ctx + (size_t)rc * 1024 + gc0; dst = p.XC + (size_t)rc * 1024 + gc0; }
        float4 xv = *(const float4*)src;
        float4 o; o.x = xv.x + g4v.x * v.x; o.y = xv.y + g4v.y * v.y; o.z = xv.z + g4v.z * v.z; o.w = xv.w + g4v.w * v.w;
        *(float4*)dst = o;
      }
    }
  }
}

template <int MODE>
__device__ __forceinline__ void ph_gemm(const P& p, int l, int bid, int nb, u16* sm, int noepi = 0) {
  const int NT = (MODE == 0) ? 25 : (MODE == 1) ? 32 : 8;
  const int MT = (MODE == 2 && l == 1) ? 64 : 68;
  u16* sA = sm; u16* sB = sm + 256 * LDSTR;
  const int xcd = bid & 7, local = bid >> 3, npx = nb >> 3;
  const int mbase = MT >> 3, mextra = MT & 7;
  const int mper = mbase + (xcd < mextra ? 1 : 0);
  const int mstart = (xcd < mextra) ? xcd * (mbase + 1) : mextra * (mbase + 1) + (xcd - mextra) * mbase;
  const int total = mper * NT;
  const int fullb = NT >> 3, rem = NT & 7;
  for (int it = 0;; ++it) {
    int mt, nt;
    if ((nb & 7) == 0) {
      int q = local + npx * it;
      if (q >= total) break;
      int b, i, bw;
      if (q < fullb * mper * 8) { b = q / (mper * 8); i = q - b * mper * 8; bw = 8; }
      else { b = fullb; i = q - fullb * mper * 8; bw = rem; }
      int sub = i / (4 * bw);
      const int nsub = mper >> 2;
      int mt_off, nt_off;
      if (sub < nsub) { int j = i - sub * 4 * bw; mt_off = j & 3; nt_off = j >> 2; }
      else { int j = i - nsub * 4 * bw; sub = nsub; mt_off = 0; nt_off = j; }
      mt = mstart + sub * 4 + mt_off; nt = b * 8 + nt_off;
    } else {
      int t = bid + it * nb;
      if (t >= MT * NT) break;
      nt = t / MT; mt = t % MT;
    }
    __syncthreads();
    gemm_tile<MODE>(p, l, mt, nt, sA, sB, noepi);
  }
  __syncthreads();
}

__device__ __forceinline__ void hg_task(const P& p, int l, int task, float* sm) {
  int tid = threadIdx.x; asm volatile("" : "+v"(tid)); const int wave = tid >> 6, lane = tid & 63;
  const int b = task >> 5, h = (task >> 3) & 3, es = task & 7;
  const int dg = lane & 15, el = lane >> 4;
  float* qs = sm; float* ks = sm + 4096; float* vs = sm + 8192; float* os = sm + 8192 + 512;
  for (int dir = 0; dir < 2; ++dir) {
    float S[8];
#pragma unroll
    for (int r = 0; r < 8; ++r) S[r] = 0.f;
    for (int chunk = 0; chunk < 136; ++chunk) {
#pragma unroll
      for (int i = 0; i < 2; ++i) {
        int q = tid + 256 * i; int pos = q >> 4, seg = q & 15;
        int R = pos2row_seq(b, chunk * 32 + pos, dir);
        const u16* up = p.U + (size_t)R * UW + h * 128 + seg * 8;
        uint4 qv = *(const uint4*)up;
        uint4 kv = *(const uint4*)(up + 512 + dir * 512);
        float f[8];
        unpack8(qv, f);
        *(float4*)(qs + pos * 128 + seg * 8) = make_float4(f[0], f[1], f[2], f[3]);
        *(float4*)(qs + pos * 128 + seg * 8 + 4) = make_float4(f[4], f[5], f[6], f[7]);
        unpack8(kv, f);
        *(float4*)(ks + pos * 128 + seg * 8) = make_float4(f[0], f[1], f[2], f[3]);
        *(float4*)(ks + pos * 128 + seg * 8 + 4) = make_float4(f[4], f[5], f[6], f[7]);
      }
      {
        int pos = tid >> 3, e2 = (tid & 7) * 2;
        int R = pos2row_seq(b, chunk * 32 + pos, dir);
        uint32_t w = *(const uint32_t*)(p.U + (size_t)R * UW + 1536 + h * 128 + es * 16 + e2);
        vs[pos * 16 + e2] = bflo(w); vs[pos * 16 + e2 + 1] = bfhi(w);
      }
      __syncthreads();
#pragma unroll 4
      for (int i = 0; i < 32; ++i) {
        float4 q0 = *(const float4*)(qs + i * 128 + dg * 8), q1 = *(const float4*)(qs + i * 128 + dg * 8 + 4);
        float4 k0 = *(const float4*)(ks + i * 128 + dg * 8), k1 = *(const float4*)(ks + i * 128 + dg * 8 + 4);
        float v = vs[i * 16 + wave * 4 + el];
        S[0] += k0.x * (v - S[0]); S[1] += k0.y * (v - S[1]); S[2] += k0.z * (v - S[2]); S[3] += k0.w * (v - S[3]);
        S[4] += k1.x * (v - S[4]); S[5] += k1.y * (v - S[5]); S[6] += k1.z * (v - S[6]); S[7] += k1.w * (v - S[7]);
        float o = q0.x * S[0] + q0.y * S[1] + q0.z * S[2] + q0.w * S[3] + q1.x * S[4] + q1.y * S[5] + q1.z * S[6] + q1.w * S[7];
        o += __shfl_xor(o, 1); o += __shfl_xor(o, 2); o += __shfl_xor(o, 4); o += __shfl_xor(o, 8);
        if (dg == 0) os[i * 16 + wave * 4 + el] = o;
      }
      __syncthreads();
      {
        int pos = tid >> 3, e2 = (tid & 7) * 2;
        int R = pos2row_seq(b, chunk * 32 + pos, dir);
        uint32_t* yp = (uint32_t*)(p.Y2 + (size_t)R * 1024 + h * 128 + es * 16 + e2);
        float o0 = os[pos * 16 + e2], o1 = os[pos * 16 + e2 + 1];
        if (dir == 1) { uint32_t w = *yp; o0 += bflo(w); o1 += bfhi(w); }
        *yp = pack2(o0, o1);
      }
    }
    __syncthreads();
  }
}

__device__ __forceinline__ void m2_task(const P& p, int l, int task, float* sm) {
  int tid = threadIdx.x; asm volatile("" : "+v"(tid)); const int wave = tid >> 6, lane = tid & 63;
  const int b = task >> 5, head = (task >> 2) & 7, ps = task & 3;
  const int g = head >> 2;
  const int dg = lane & 15, el = lane >> 4;
  float* Cs = sm; float* Bs = sm + 4096; float* xs = sm + 8192; float* os = sm + 8192 + 512;
  float* dts = sm + 8192 + 1024; float* decs = dts + 32;
  for (int dir = 0; dir < 2; ++dir) {
    const float* cw = p.m2_conv_w + (size_t)(l * 2 + dir) * 4 * 1024;
    const float* cb = p.m2_conv_b + (size_t)(l * 2 + dir) * 1024;
    const float dtb = p.m2_dt_bias[(l * 2 + dir) * 8 + head];
    const float Aneg = -__expf(p.m2_a_log[(l * 2 + dir) * 8 + head]);
    const float Dsk = p.m2_d[(l * 2 + dir) * 8 + head];
    float S[8];
#pragma unroll
    for (int r = 0; r < 8; ++r) S[r] = 0.f;
    for (int chunk = 0; chunk < 136; ++chunk) {
      const int pbase = chunk * 32;
      const int seg0 = (pbase < 256) ? 0 : 256;
#pragma unroll
      for (int i = 0; i < 2; ++i) {
        int q = tid + 256 * i; int pos = q >> 4, seg = q & 15;
        int pp = pbase + pos;
        int chB = 512 + g * 128 + seg * 8, chC = 768 + g * 128 + seg * 8;
        float aB[8], aC[8];
#pragma unroll
        for (int j = 0; j < 8; ++j) { aB[j] = cb[chB + j]; aC[j] = cb[chC + j]; }
#pragma unroll
        for (int tap = 0; tap < 4; ++tap) {
          int pt = pp - 3 + tap;
          if (pt >= seg0) {
            int R = pos2row_m2(b, pt, dir);
            const u16* up = p.U + (size_t)R * UW + 2048;
            uint4 bv = *(const uint4*)(up + chB);
            uint4 cv = *(const uint4*)(up + chC);
            float f[8];
            unpack8(bv, f);
#pragma unroll
            for (int j = 0; j < 8; ++j) aB[j] += cw[tap * 1024 + chB + j] * f[j];
            unpack8(cv, f);
#pragma unroll
            for (int j = 0; j < 8; ++j) aC[j] += cw[tap * 1024 + chC + j] * f[j];
          }
        }
#pragma unroll
        for (int j = 0; j < 8; ++j) { aB[j] = siluf(aB[j]); aC[j] = siluf(aC[j]); }
        *(float4*)(Bs + pos * 128 + seg * 8) = make_float4(aB[0], aB[1], aB[2], aB[3]);
        *(float4*)(Bs + pos * 128 + seg * 8 + 4) = make_float4(aB[4], aB[5], aB[6], aB[7]);
        *(float4*)(Cs + pos * 128 + seg * 8) = make_float4(aC[0], aC[1], aC[2], aC[3]);
        *(float4*)(Cs + pos * 128 + seg * 8 + 4) = make_float4(aC[4], aC[5], aC[6], aC[7]);
      }
      {
        int pos = tid >> 3, e2 = (tid & 7) * 2;
        int pp = pbase + pos;
        int ch = head * 64 + ps * 16 + e2;
        float a0 = cb[ch], a1 = cb[ch + 1];
#pragma unroll
        for (int tap = 0; tap < 4; ++tap) {
          int pt = pp - 3 + tap;
          if (pt >= seg0) {
            int R = pos2row_m2(b, pt, dir);
            uint32_t w = *(const uint32_t*)(p.U + (size_t)R * UW + 2048 + ch);
            a0 += cw[tap * 1024 + ch] * bflo(w); a1 += cw[tap * 1024 + ch + 1] * bfhi(w);
          }
        }
        xs[pos * 16 + e2] = siluf(a0); xs[pos * 16 + e2 + 1] = siluf(a1);
      }
      if (tid < 32) {
        int R = pos2row_m2(b, pbase + tid, dir);
        float dtv = softplusf(p.DT[(size_t)R * 8 + head] + dtb);
        dts[tid] = dtv; decs[tid] = __expf(dtv * Aneg);
      }
      __syncthreads();
#pragma unroll 4
      for (int i = 0; i < 32; ++i) {
        float4 q0 = *(const float4*)(Cs + i * 128 + dg * 8), q1 = *(const float4*)(Cs + i * 128 + dg * 8 + 4);
        float4 k0 = *(const float4*)(Bs + i * 128 + dg * 8), k1 = *(const float4*)(Bs + i * 128 + dg * 8 + 4);
        float xv = xs[i * 16 + wave * 4 + el];
        float a = decs[i]; float v = xv * dts[i];
        S[0] = a * S[0] + k0.x * v; S[1] = a * S[1] + k0.y * v; S[2] = a * S[2] + k0.z * v; S[3] = a * S[3] + k0.w * v;
        S[4] = a * S[4] + k1.x * v; S[5] = a * S[5] + k1.y * v; S[6] = a * S[6] + k1.z * v; S[7] = a * S[7] + k1.w * v;
        float o = q0.x * S[0] + q0.y * S[1] + q0.z * S[2] + q0.w * S[3] + q1.x * S[4] + q1.y * S[5] + q1.z * S[6] + q1.w * S[7];
        o += __shfl_xor(o, 1); o += __shfl_xor(o, 2); o += __shfl_xor(o, 4); o += __shfl_xor(o, 8);
        if (dg == 0) os[i * 16 + wave * 4 + el] = o + Dsk * xv;
      }
      __syncthreads();
      {
        int pos = tid >> 3, e2 = (tid & 7) * 2;
        int R = pos2row_m2(b, pbase + pos, dir);
        uint32_t* yp = (uint32_t*)(p.Y2 + (size_t)R * 1024 + 512 + head * 64 + ps * 16 + e2);
        float o0 = os[pos * 16 + e2], o1 = os[pos * 16 + e2 + 1];
        if (dir == 1) { uint32_t w = *yp; o0 += bflo(w); o1 += bfhi(w); }
        *yp = pack2(o0, o1);
      }
    }
    __syncthreads();
  }
}

#ifndef M2_MFMA
#define M2_MFMA 1
#endif
#define QS 136
#define TS 40
union FragU { bf16x8 v; uint32_t u[4]; uint2 d[2]; uint4 q; };
__device__ __forceinline__ bf16x8 cvt_frag(const f32x16& x, int s2) {
  FragU f;
  f.u[0] = pack2(x[8 * s2 + 0], x[8 * s2 + 1]); f.u[1] = pack2(x[8 * s2 + 2], x[8 * s2 + 3]);
  f.u[2] = pack2(x[8 * s2 + 4], x[8 * s2 + 5]); f.u[3] = pack2(x[8 * s2 + 6], x[8 * s2 + 7]);
  return f.v;
}
__device__ __forceinline__ bf16x8 ld_frag_perm(const u16* base) {
  FragU f; f.d[0] = *(const uint2*)base; f.d[1] = *(const uint2*)(base + 8); return f.v;
}

template <int PASS>
__device__ __forceinline__ void hg_mfma(const P& p, int l, int task, int blk, int dir0, unsigned char* smem) {
  int tid = threadIdx.x; asm volatile("" : "+v"(tid)); const int wave = tid >> 6, lane = tid & 63;
  const int r = lane & 31, hh = lane >> 5;
  const int b = task >> 2, h = task & 3;
  u16* ks = (u16*)smem;
  u16* qs = ks + 32 * QS;
  u16* kT = qs + 32 * QS;
  u16* vT = kT + 128 * TS;
  float* tot = (float*)(vT + 128 * TS);
  float* eg = tot + 256;
  const int dd = tid & 127, half = tid >> 7;
  for (int dir = (PASS == 0 ? dir0 : 0); dir < (PASS == 0 ? dir0 + 1 : 2); ++dir) {
    const int sbd = (PASS == 0) ? blk : ((blk == 0) ? 0 : (dir ? 9 - blk : blk));
    const int c0 = (sbd == 0) ? 0 : 8 + 16 * (sbd - 1);
    const int c1 = (sbd == 0) ? 8 : 8 + 16 * sbd;
    float gsum = 0.f;
    f32x16 S[4];
#pragma unroll
    for (int i = 0; i < 4; ++i)
#pragma unroll
      for (int q = 0; q < 16; ++q) S[i][q] = 0.f;
    if (PASS == 1) {
      for (int qb = 0; qb < sbd; ++qb) {
        const size_t sidx = (size_t)((task * 2 + dir) * 8 + qb);
        if (half == 0) eg[dd] = __expf(p.PS[sidx * 128 + dd]);
        __syncthreads();
        const float* sp = p.SSH + sidx * 16384 + (size_t)wave * 4096 + lane;
#pragma unroll
        for (int dt = 0; dt < 4; ++dt)
#pragma unroll
          for (int q4 = 0; q4 < 4; ++q4) {
            float4 e4 = *(const float4*)(eg + 32 * dt + 8 * q4 + 4 * hh);
            S[dt][4 * q4 + 0] = S[dt][4 * q4 + 0] * e4.x + sp[(dt * 16 + 4 * q4 + 0) * 64];
            S[dt][4 * q4 + 1] = S[dt][4 * q4 + 1] * e4.y + sp[(dt * 16 + 4 * q4 + 1) * 64];
            S[dt][4 * q4 + 2] = S[dt][4 * q4 + 2] * e4.z + sp[(dt * 16 + 4 * q4 + 2) * 64];
            S[dt][4 * q4 + 3] = S[dt][4 * q4 + 3] * e4.w + sp[(dt * 16 + 4 * q4 + 3) * 64];
          }
        __syncthreads();
      }
    }
    uint4 pq0, pq1, pk0, pk1, pv0, pv1;
#define HG_PREFETCH(CH)                                                                     \
    {                                                                                       \
      int pos0 = tid >> 4, seg = tid & 15;                                                  \
      int R0 = pos2row_seq(b, (CH) * 32 + pos0, dir), R1 = pos2row_seq(b, (CH) * 32 + pos0 + 16, dir); \
      const u16* u0 = p.U + (size_t)R0 * UW + h * 128 + seg * 8;                            \
      const u16* u1 = p.U + (size_t)R1 * UW + h * 128 + seg * 8;                            \
      pq0 = *(const uint4*)u0; pq1 = *(const uint4*)u1;                                     \
      pk0 = *(const uint4*)(u0 + 512 + dir * 512); pk1 = *(const uint4*)(u1 + 512 + dir * 512); \
      int Rv = pos2row_seq(b, (CH) * 32 + (tid & 31), dir);                                 \
      const u16* uv = p.U + (size_t)Rv * UW + 1536 + h * 128 + (tid >> 5) * 16;             \
      pv0 = *(const uint4*)uv; pv1 = *(const uint4*)(uv + 8);                               \
    }
    HG_PREFETCH(c0)
#pragma unroll 1
    for (int chunk = c0; chunk < c1; ++chunk) {
      {
        int pos0 = tid >> 4, seg = tid & 15;
        *(uint4*)(qs + pos0 * QS + seg * 8) = pq0; *(uint4*)(qs + (pos0 + 16) * QS + seg * 8) = pq1;
        *(uint4*)(ks + pos0 * QS + seg * 8) = pk0; *(uint4*)(ks + (pos0 + 16) * QS + seg * 8) = pk1;
        FragU f0, f1; f0.q = pv0; f1.q = pv1;
        u16* vw = vT + ((tid >> 5) * 16) * TS + (tid & 31);
#pragma unroll
        for (int j = 0; j < 4; ++j) {
          vw[(2 * j) * TS] = (u16)(f0.u[j] & 0xffffu); vw[(2 * j + 1) * TS] = (u16)(f0.u[j] >> 16);
          vw[(8 + 2 * j) * TS] = (u16)(f1.u[j] & 0xffffu); vw[(8 + 2 * j + 1) * TS] = (u16)(f1.u[j] >> 16);
        }
      }
      __syncthreads();
      if (chunk + 1 < c1) HG_PREFETCH(chunk + 1)
      const int Rout = pos2row_seq(b, chunk * 32 + r, dir);
      u16* yrow = p.Y2 + (size_t)Rout * 1024 + h * 128 + wave * 32 + 4 * hh;
      uint2 yold[4];
      if (PASS == 1 && dir == 1) {
#pragma unroll
        for (int q4 = 0; q4 < 4; ++q4) yold[q4] = *(const uint2*)(yrow + 8 * q4);
      }
      float gl[16];
      {
        float run = 0.f;
#pragma unroll
        for (int i = 0; i < 16; ++i) {
          float kkv = bf2f(ks[(half * 16 + i) * QS + dd]);
          run += __logf(fmaxf(1.f - kkv, 1e-6f));
          gl[i] = run;
        }
        tot[half * 128 + dd] = run;
      }
      __syncthreads();
      {
        const float t0 = tot[dd], t1 = tot[128 + dd];
        const float off = half ? t0 : 0.f;
        const float g31 = t0 + t1;
        float k2[16];
#pragma unroll
        for (int i = 0; i < 16; ++i) {
          const int pos = half * 16 + i;
          const float g = gl[i] + off;
          const float kkv = bf2f(ks[pos * QS + dd]);
          const float qv = bf2f(qs[pos * QS + dd]);
          qs[pos * QS + dd] = f2bf(qv * __expf(g));
          ks[pos * QS + dd] = f2bf(kkv * __expf(fminf(-g, 60.f)));
          k2[i] = kkv * __expf(g31 - g);
        }
        *(uint4*)(kT + dd * TS + half * 16) = pack8(k2);
        *(uint4*)(kT + dd * TS + half * 16 + 8) = pack8(k2 + 8);
        if (half == 0) eg[dd] = __expf(g31);
        gsum += g31;
      }
      __syncthreads();
      f32x16 O;
      if (PASS == 1) {
      f32x16 att;
#pragma unroll
      for (int q = 0; q < 16; ++q) att[q] = 0.f;
#pragma unroll
      for (int k8 = 0; k8 < 8; ++k8) {
        bf16x8 A = *(const bf16x8*)(ks + r * QS + 16 * k8 + 8 * hh);
        bf16x8 B = *(const bf16x8*)(qs + r * QS + 16 * k8 + 8 * hh);
        att = __builtin_amdgcn_mfma_f32_32x32x16_bf16(A, B, att, 0, 0, 0);
      }
#pragma unroll
      for (int q = 0; q < 16; ++q) {
        int sidx = (q & 3) + 8 * (q >> 2) + 4 * hh;
        if (sidx > r) att[q] = 0.f;
      }
#pragma unroll
      for (int q = 0; q < 16; ++q) O[q] = 0.f;
#pragma unroll
      for (int dt = 0; dt < 4; ++dt)
#pragma unroll
        for (int s2 = 0; s2 < 2; ++s2) {
          bf16x8 A = cvt_frag(S[dt], s2);
          bf16x8 B = ld_frag_perm(qs + r * QS + 32 * dt + 16 * s2 + 4 * hh);
          O = __builtin_amdgcn_mfma_f32_32x32x16_bf16(A, B, O, 0, 0, 0);
        }
#pragma unroll
      for (int s2 = 0; s2 < 2; ++s2) {
        bf16x8 A = ld_frag_perm(vT + (32 * wave + r) * TS + 16 * s2 + 4 * hh);
        bf16x8 B = cvt_frag(att, s2);
        O = __builtin_amdgcn_mfma_f32_32x32x16_bf16(A, B, O, 0, 0, 0);
      }
      }
#pragma unroll
      for (int dt = 0; dt < 4; ++dt) {
#pragma unroll
        for (int q4 = 0; q4 < 4; ++q4) {
          float4 e4 = *(const float4*)(eg + 32 * dt + 8 * q4 + 4 * hh);
          S[dt][4 * q4 + 0] *= e4.x; S[dt][4 * q4 + 1] *= e4.y; S[dt][4 * q4 + 2] *= e4.z; S[dt][4 * q4 + 3] *= e4.w;
        }
#pragma unroll
        for (int s2 = 0; s2 < 2; ++s2) {
          bf16x8 A = *(const bf16x8*)(kT + (32 * dt + r) * TS + 16 * s2 + 8 * hh);
          bf16x8 B = *(const bf16x8*)(vT + (32 * wave + r) * TS + 16 * s2 + 8 * hh);
          S[dt] = __builtin_amdgcn_mfma_f32_32x32x16_bf16(A, B, S[dt], 0, 0, 0);
        }
      }
      if (PASS == 1) {
#pragma unroll
      for (int q4 = 0; q4 < 4; ++q4) {
        float o0 = O[4 * q4], o1 = O[4 * q4 + 1], o2 = O[4 * q4 + 2], o3 = O[4 * q4 + 3];
        if (dir == 1) { o0 += bflo(yold[q4].x); o1 += bfhi(yold[q4].x); o2 += bflo(yold[q4].y); o3 += bfhi(yold[q4].y); }
        uint2 ov; ov.x = pack2(o0, o1); ov.y = pack2(o2, o3);
        *(uint2*)(yrow + 8 * q4) = ov;
      }
      }
      __syncthreads();
    }
    if (PASS == 0) {
      const size_t sidx = (size_t)((task * 2 + dir) * 8 + sbd);
      if (half == 0) p.PS[sidx * 128 + dd] = gsum;
      float* sp = p.SSH + sidx * 16384 + (size_t)wave * 4096 + lane;
#pragma unroll
      for (int dt = 0; dt < 4; ++dt)
#pragma unroll
        for (int q = 0; q < 16; ++q) sp[(dt * 16 + q) * 64] = S[dt][q];
    }
    __syncthreads();
  }
}

#if M2_MFMA
#define M2_NTASK 16
template <int PASS>
__device__ __forceinline__ void m2_mfma(const P& p, int l, int task, int blk, int dir0, unsigned char* smem) {
  int tid = threadIdx.x; asm volatile("" : "+v"(tid)); const int wave = tid >> 6, lane = tid & 63;
  const int r = lane & 31, hh = lane >> 5;
  const int b = task >> 2, g = (task >> 1) & 1, hp = task & 1;
  const int hq = wave >> 1, ph = wave & 1;
  const int head = 4 * g + 2 * hp + hq;
  u16* Bm = (u16*)smem;
  u16* Cm = Bm + 32 * QS;
  u16* BmT = Cm + 32 * QS;
  u16* xsT = BmT + 128 * TS;
  float* Gs = (float*)(xsT + 128 * TS);
  float* dts = Gs + 64;
  float* wl = dts + 64;
  const int cp = (lane < 48) ? lane : 47;
  const bool act = lane < 48;
  const int chW = (cp < 16) ? ((4 * g + 2 * hp) * 64 + cp * 8) : (cp < 32) ? (512 + g * 128 + (cp - 16) * 8) : (768 + g * 128 + (cp - 32) * 8);
  const int chU = 2048 + chW;
  float* SSM = (float*)p.KF;
  for (int dir = (PASS == 0 ? dir0 : 0); dir < (PASS == 0 ? dir0 + 1 : 2); ++dir) {
    const int sbd = (PASS == 0) ? blk : ((blk == 0) ? 0 : (dir ? 9 - blk : blk));
    const int c0 = (sbd == 0) ? 0 : 8 + 16 * (sbd - 1);
    const int c1 = (sbd == 0) ? 8 : 8 + 16 * sbd;
    float lsum = 0.f;
    const float* cw = p.m2_conv_w + (size_t)(l * 2 + dir) * 4 * 1024;
    const float* cb = p.m2_conv_b + (size_t)(l * 2 + dir) * 1024;
    if (wave == 0) {
#pragma unroll
      for (int j = 0; j < 8; ++j) {
        wl[(4 * 8 + j) * 64 + lane] = cb[chW + j];
#pragma unroll
        for (int tap = 0; tap < 4; ++tap) wl[(tap * 8 + j) * 64 + lane] = cw[tap * 1024 + chW + j];
      }
    }
    __syncthreads();
    const int hd_t = 4 * g + 2 * hp + ((tid >> 5) & 1);
    const float dtb = p.m2_dt_bias[(l * 2 + dir) * 8 + hd_t];
    const float Aneg_t = -__expf(p.m2_a_log[(l * 2 + dir) * 8 + hd_t]);
    const float Dsk = p.m2_d[(l * 2 + dir) * 8 + head];
    f32x16 S[4];
#pragma unroll
    for (int i = 0; i < 4; ++i)
#pragma unroll
      for (int q = 0; q < 16; ++q) S[i][q] = 0.f;
    if (PASS == 1) {
      for (int qb = 0; qb < sbd; ++qb) {
        const size_t sidx = (size_t)((task * 2 + dir) * 8 + qb);
        const float a = __expf(p.PA[sidx * 4 + wave]);
        const float* sp = SSM + sidx * 16384 + (size_t)wave * 4096 + lane;
#pragma unroll
        for (int nt = 0; nt < 4; ++nt)
#pragma unroll
          for (int q = 0; q < 16; ++q) S[nt][q] = S[nt][q] * a + sp[(nt * 16 + q) * 64];
      }
    }
    uint4 raw0, raw1, raw2, raw3, raw4, raw5, raw6, raw7, raw8, raw9, raw10;
    float dtraw = 0.f;
#define M2_LD1(RW, I, CH)                                                                  \
    {                                                                                      \
      int pt = (CH) * 32 + wave * 8 + (I) - 3;                                             \
      int sg0 = ((CH) * 32 < 256) ? 0 : 256;                                               \
      if (pt >= sg0) { int Rr = pos2row_m2(b, pt, dir); RW = *(const uint4*)(p.U + (size_t)Rr * UW + chU); } \
      else RW = make_uint4(0u, 0u, 0u, 0u);                                                \
    }
#define M2_PREFETCH(CH)                                                                    \
    M2_LD1(raw0, 0, CH) M2_LD1(raw1, 1, CH) M2_LD1(raw2, 2, CH) M2_LD1(raw3, 3, CH) M2_LD1(raw4, 4, CH) M2_LD1(raw5, 5, CH) \
    M2_LD1(raw6, 6, CH) M2_LD1(raw7, 7, CH) M2_LD1(raw8, 8, CH) M2_LD1(raw9, 9, CH) M2_LD1(raw10, 10, CH)            \
    if (tid < 64) { int Rr = pos2row_m2(b, (CH) * 32 + (tid & 31), dir); dtraw = p.DT[(size_t)Rr * 8 + hd_t]; }
    M2_PREFETCH(c0)
#pragma unroll 1
    for (int chunk = c0; chunk < c1; ++chunk) {
      {
#define M2_RAWF(RW, J) (((J) & 1) ? bfhi((RW)) : bflo((RW)))
#define M2_CH(J, C0, C1, C2, C3, C4, C5, C6, C7, C8, C9, C10)                               \
        {                                                                                  \
          const float q0 = wl[(0 * 8 + (J)) * 64 + lane], q1 = wl[(1 * 8 + (J)) * 64 + lane]; \
          const float q2 = wl[(2 * 8 + (J)) * 64 + lane], q3 = wl[(3 * 8 + (J)) * 64 + lane]; \
          const float qb = wl[(4 * 8 + (J)) * 64 + lane];                                  \
          const float v0 = M2_RAWF(C0, J), v1 = M2_RAWF(C1, J), v2 = M2_RAWF(C2, J), v3 = M2_RAWF(C3, J); \
          const float v4 = M2_RAWF(C4, J), v5 = M2_RAWF(C5, J), v6 = M2_RAWF(C6, J), v7 = M2_RAWF(C7, J); \
          const float v8 = M2_RAWF(C8, J), v9 = M2_RAWF(C9, J), v10 = M2_RAWF(C10, J);      \
          float o[8];                                                                      \
          o[0] = siluf(qb + q0 * v0 + q1 * v1 + q2 * v2 + q3 * v3);                        \
          o[1] = siluf(qb + q0 * v1 + q1 * v2 + q2 * v3 + q3 * v4);                        \
          o[2] = siluf(qb + q0 * v2 + q1 * v3 + q2 * v4 + q3 * v5);                        \
          o[3] = siluf(qb + q0 * v3 + q1 * v4 + q2 * v5 + q3 * v6);                        \
          o[4] = siluf(qb + q0 * v4 + q1 * v5 + q2 * v6 + q3 * v7);                        \
          o[5] = siluf(qb + q0 * v5 + q1 * v6 + q2 * v7 + q3 * v8);                        \
          o[6] = siluf(qb + q0 * v6 + q1 * v7 + q2 * v8 + q3 * v9);                        \
          o[7] = siluf(qb + q0 * v7 + q1 * v8 + q2 * v9 + q3 * v10);                       \
          if (act) {                                                                       \
            if (cp < 16) {                                                                 \
              *(uint4*)(xsT + (cp * 8 + (J)) * TS + wave * 8) = pack8(o);                  \
            } else if (cp < 32) {                                                          \
              *(uint4*)(BmT + ((cp - 16) * 8 + (J)) * TS + wave * 8) = pack8(o);           \
              _Pragma("unroll") for (int i = 0; i < 8; ++i) Bm[(wave * 8 + i) * QS + (cp - 16) * 8 + (J)] = f2bf(o[i]); \
            } else {                                                                       \
              _Pragma("unroll") for (int i = 0; i < 8; ++i) Cm[(wave * 8 + i) * QS + (cp - 32) * 8 + (J)] = f2bf(o[i]); \
            }                                                                              \
          }                                                                                \
        }
        M2_CH(0, raw0.x, raw1.x, raw2.x, raw3.x, raw4.x, raw5.x, raw6.x, raw7.x, raw8.x, raw9.x, raw10.x)
        M2_CH(1, raw0.x, raw1.x, raw2.x, raw3.x, raw4.x, raw5.x, raw6.x, raw7.x, raw8.x, raw9.x, raw10.x)
        M2_CH(2, raw0.y, raw1.y, raw2.y, raw3.y, raw4.y, raw5.y, raw6.y, raw7.y, raw8.y, raw9.y, raw10.y)
        M2_CH(3, raw0.y, raw1.y, raw2.y, raw3.y, raw4.y, raw5.y, raw6.y, raw7.y, raw8.y, raw9.y, raw10.y)
        M2_CH(4, raw0.z, raw1.z, raw2.z, raw3.z, raw4.z, raw5.z, raw6.z, raw7.z, raw8.z, raw9.z, raw10.z)
        M2_CH(5, raw0.z, raw1.z, raw2.z, raw3.z, raw4.z, raw5.z, raw6.z, raw7.z, raw8.z, raw9.z, raw10.z)
        M2_CH(6, raw0.w, raw1.w, raw2.w, raw3.w, raw4.w, raw5.w, raw6.w, raw7.w, raw8.w, raw9.w, raw10.w)
        M2_CH(7, raw0.w, raw1.w, raw2.w, raw3.w, raw4.w, raw5.w, raw6.w, raw7.w, raw8.w, raw9.w, raw10.w)
      }
      if (tid < 64) {
        float dtv = softplusf(dtraw + dtb);
        float run = dtv * Aneg_t;
#pragma unroll
        for (int o = 1; o < 32; o <<= 1) { float n = __shfl_up(run, o, 32); if ((tid & 31) >= o) run += n; }
        Gs[tid] = run; dts[tid] = dtv;
      }
      __syncthreads();
      if (chunk + 1 < c1) { M2_PREFETCH(chunk + 1) }
      const int Rout = pos2row_m2(b, chunk * 32 + r, dir);
      u16* yrow = p.Y2 + (size_t)Rout * 1024 + 512 + head * 64 + 32 * ph + 4 * hh;
      uint2 yold[4];
      if (PASS == 1 && dir == 1) {
#pragma unroll
        for (int i = 0; i < 4; ++i) yold[i] = *(const uint2*)(yrow + 8 * i);
      }
      const float* Gw = Gs + hq * 32; const float* dw = dts + hq * 32;
      const float Gt = Gw[r], G31 = Gw[31];
      lsum += G31;
      const u16* xw = xsT + (hq * 64 + ph * 32) * TS;
      f32x16 O0;
      if (PASS == 1) {
      f32x16 att;
#pragma unroll
      for (int q = 0; q < 16; ++q) att[q] = 0.f;
#pragma unroll
      for (int k8 = 0; k8 < 8; ++k8) {
        bf16x8 A = *(const bf16x8*)(Bm + r * QS + 16 * k8 + 8 * hh);
        bf16x8 B = *(const bf16x8*)(Cm + r * QS + 16 * k8 + 8 * hh);
        att = __builtin_amdgcn_mfma_f32_32x32x16_bf16(A, B, att, 0, 0, 0);
      }
#pragma unroll
      for (int q4 = 0; q4 < 4; ++q4) {
        float4 gs4 = *(const float4*)(Gw + 8 * q4 + 4 * hh);
        float4 dt4 = *(const float4*)(dw + 8 * q4 + 4 * hh);
        int s0 = 8 * q4 + 4 * hh;
        att[4 * q4 + 0] = (s0 + 0 <= r) ? att[4 * q4 + 0] * __expf(Gt - gs4.x) * dt4.x : 0.f;
        att[4 * q4 + 1] = (s0 + 1 <= r) ? att[4 * q4 + 1] * __expf(Gt - gs4.y) * dt4.y : 0.f;
        att[4 * q4 + 2] = (s0 + 2 <= r) ? att[4 * q4 + 2] * __expf(Gt - gs4.z) * dt4.z : 0.f;
        att[4 * q4 + 3] = (s0 + 3 <= r) ? att[4 * q4 + 3] * __expf(Gt - gs4.w) * dt4.w : 0.f;
      }
#pragma unroll
      for (int q = 0; q < 16; ++q) O0[q] = 0.f;
#pragma unroll
      for (int nt = 0; nt < 4; ++nt)
#pragma unroll
        for (int s2 = 0; s2 < 2; ++s2) {
          bf16x8 B = ld_frag_perm(Cm + r * QS + 32 * nt + 16 * s2 + 4 * hh);
          O0 = __builtin_amdgcn_mfma_f32_32x32x16_bf16(cvt_frag(S[nt], s2), B, O0, 0, 0, 0);
        }
      {
        const float eGt = __expf(Gt);
#pragma unroll
        for (int q = 0; q < 16; ++q) O0[q] *= eGt;
      }
#pragma unroll
      for (int s2 = 0; s2 < 2; ++s2) {
        bf16x8 B = cvt_frag(att, s2);
        O0 = __builtin_amdgcn_mfma_f32_32x32x16_bf16(ld_frag_perm(xw + r * TS + 16 * s2 + 4 * hh), B, O0, 0, 0, 0);
      }
#pragma unroll
      for (int q = 0; q < 16; ++q) {
        int pp = (q & 3) + 8 * (q >> 2) + 4 * hh;
        O0[q] += Dsk * bf2f(xw[pp * TS + r]);
      }
      }
      {
        const float eG31 = __expf(G31);
#pragma unroll
        for (int nt = 0; nt < 4; ++nt)
#pragma unroll
          for (int q = 0; q < 16; ++q) S[nt][q] *= eG31;
#pragma unroll
        for (int s2 = 0; s2 < 2; ++s2) {
          float ws[8];
          {
            float4 ga = *(const float4*)(Gw + 16 * s2 + 8 * hh), gb = *(const float4*)(Gw + 16 * s2 + 8 * hh + 4);
            float4 da = *(const float4*)(dw + 16 * s2 + 8 * hh), db = *(const float4*)(dw + 16 * s2 + 8 * hh + 4);
            ws[0] = da.x * __expf(G31 - ga.x); ws[1] = da.y * __expf(G31 - ga.y); ws[2] = da.z * __expf(G31 - ga.z); ws[3] = da.w * __expf(G31 - ga.w);
            ws[4] = db.x * __expf(G31 - gb.x); ws[5] = db.y * __expf(G31 - gb.y); ws[6] = db.z * __expf(G31 - gb.z); ws[7] = db.w * __expf(G31 - gb.w);
          }
          bf16x8 Bf0;
          {
            float f[8]; unpack8(*(const uint4*)(xw + r * TS + 16 * s2 + 8 * hh), f);
#pragma unroll
            for (int j = 0; j < 8; ++j) f[j] *= ws[j];
            FragU u; u.q = pack8(f); Bf0 = u.v;
          }
#pragma unroll
          for (int nt = 0; nt < 4; ++nt) {
            bf16x8 A = *(const bf16x8*)(BmT + (32 * nt + r) * TS + 16 * s2 + 8 * hh);
            S[nt] = __builtin_amdgcn_mfma_f32_32x32x16_bf16(A, Bf0, S[nt], 0, 0, 0);
          }
        }
      }
      if (PASS == 1) {
#pragma unroll
      for (int q4 = 0; q4 < 4; ++q4) {
        float o0 = O0[4 * q4], o1 = O0[4 * q4 + 1], o2 = O0[4 * q4 + 2], o3 = O0[4 * q4 + 3];
        if (dir == 1) { o0 += bflo(yold[q4].x); o1 += bfhi(yold[q4].x); o2 += bflo(yold[q4].y); o3 += bfhi(yold[q4].y); }
        uint2 ov; ov.x = pack2(o0, o1); ov.y = pack2(o2, o3);
        *(uint2*)(yrow + 8 * q4) = ov;
      }
      }
      __syncthreads();
    }
    if (PASS == 0) {
      const size_t sidx = (size_t)((task * 2 + dir) * 8 + sbd);
      if (lane == 0) p.PA[sidx * 4 + wave] = lsum;
      float* sp = SSM + sidx * 16384 + (size_t)wave * 4096 + lane;
#pragma unroll
      for (int nt = 0; nt < 4; ++nt)
#pragma unroll
        for (int q = 0; q < 16; ++q) sp[(nt * 16 + q) * 64] = S[nt][q];
    }
    __syncthreads();
  }
}
#endif
__device__ __forceinline__ void ph_mixA0(const P& p, int l, int bid, int nb, unsigned char* sm) {
  for (int t = bid; t < 512; t += nb) {
    if (t < 256) hg_mfma<0>(p, l, t >> 4, (t >> 1) & 7, t & 1, sm);
    else { int u = t - 256; m2_mfma<0>(p, l, u >> 4, (u >> 1) & 7, u & 1, sm); }
    __syncthreads();
  }
}
__device__ __forceinline__ void ph_mixA1(const P& p, int l, int bid, int nb, unsigned char* sm) {
  for (int t = bid; t < 288; t += nb) {
    if (t < 128) hg_mfma<1>(p, l, t >> 3, 1 + (t & 7), 0, sm);
    else if (t < 256) { int u = t - 128; m2_mfma<1>(p, l, u >> 3, 1 + (u & 7), 0, sm); }
    else if (t < 272) hg_mfma<1>(p, l, t - 256, 0, 0, sm);
    else m2_mfma<1>(p, l, t - 272, 0, 0, sm);
    __syncthreads();
  }
}

template <int PASS>
__device__ __forceinline__ void rg_task(const P& p, int l, int task, float* sm) {
  int tid = threadIdx.x; asm volatile("" : "+v"(tid));
  const int wave = tid >> 6, lane = tid & 63;
  const int b = task >> 7, head = (task >> 4) & 7, sb = task & 15;
  float* xc = sm;
  float* pa = sm + 2048;
  float* pb = sm + 4096;
  u16* xcb = (u16*)(sm + 6144);
  u16* WTl = xcb + 32 * 72;
  const int j = tid & 63;
  const int spos = tid >> 3, sseg = tid & 7;
  const int sch = head * 64 + sseg * 8;
  const u16* UB2 = p.U + (size_t)NTOK * 2048;
  for (int dir = 0; dir < 2; ++dir) {
    const int ld = l * 2 + dir;
    {
      const float* wa = p.rg_wa + (size_t)(ld * 8 + head) * 4096;
      const float* wx = p.rg_wx + (size_t)(ld * 8 + head) * 4096;
#pragma unroll
      for (int it = 0; it < 4; ++it) {
        int i = (tid >> 4) + 16 * it, j4 = (tid & 15) * 4;
        float4 va = *(const float4*)(wa + i * 64 + j4);
        float4 vx = *(const float4*)(wx + i * 64 + j4);
        WTl[(j4 + 0) * 72 + i] = f2bf(va.x); WTl[(j4 + 1) * 72 + i] = f2bf(va.y);
        WTl[(j4 + 2) * 72 + i] = f2bf(va.z); WTl[(j4 + 3) * 72 + i] = f2bf(va.w);
        WTl[(64 + j4 + 0) * 72 + i] = f2bf(vx.x); WTl[(64 + j4 + 1) * 72 + i] = f2bf(vx.y);
        WTl[(64 + j4 + 2) * 72 + i] = f2bf(vx.z); WTl[(64 + j4 + 3) * 72 + i] = f2bf(vx.w);
      }
    }
    float wcv[4][8], bcv[8];
#pragma unroll
    for (int jj = 0; jj < 8; ++jj) {
      bcv[jj] = p.rg_conv_b[(size_t)ld * 512 + sch + jj];
#pragma unroll
      for (int tap = 0; tap < 4; ++tap) wcv[tap][jj] = p.rg_conv_w[((size_t)ld * 4 + tap) * 512 + sch + jj];
    }
    const int chg = head * 64 + j;
    const float g_ba = p.rg_ba[ld * 512 + chg], g_bx = p.rg_bx[ld * 512 + chg];
    const float g_sp = -8.0f * softplusf(-p.rg_lam[ld * 512 + chg]);
    const int sbd = (PASS == 0) ? sb : (dir ? (sb == 0 ? 0 : 16 - sb) : sb);
    int cbeg, cend;
    if (sbd == 0) { cbeg = 0; cend = 8; }
    else {
      const int jb = sbd - 1;
      if (dir == 0) { cbeg = 8 + (jb * 128) / 15; cend = 8 + ((jb + 1) * 128) / 15; }
      else { const int kb = 14 - jb; cbeg = 8 + 128 - ((kb + 1) * 128) / 15; cend = 8 + 128 - (kb * 128) / 15; }
    }
    float hcarry = 0.f, aprod = 1.f;
    if (PASS == 1 && tid < 64) {
      float2 sv[16];
#pragma unroll
      for (int q = 0; q < 16; ++q) {
        const float2* sp = (const float2*)(p.SUM + ((((size_t)b * 2 + dir) * 17 + q) * 512 + head * 64 + tid) * 2);
        sv[q] = (q < sbd) ? *sp : make_float2(1.f, 0.f);
      }
#pragma unroll
      for (int q = 0; q < 16; ++q) hcarry = sv[q].x * hcarry + sv[q].y;
    }
    uint4 xr0, xr1, xr2, xr3;
#define RG_LD1(XR, TAP, CH)                                                               \
    {                                                                                     \
      int pt = (CH) * 32 + spos - 3 + (TAP);                                              \
      int sg0 = ((CH) * 32 < 256) ? 0 : 256;                                              \
      if (pt >= sg0) { int Rr = pos2row_seq(b, pt, dir); XR = *(const uint4*)(UB2 + (size_t)Rr * 2048 + sch); } \
      else XR = make_uint4(0u, 0u, 0u, 0u);                                               \
    }
#define RG_PREFETCH(CH) RG_LD1(xr0, 0, CH) RG_LD1(xr1, 1, CH) RG_LD1(xr2, 2, CH) RG_LD1(xr3, 3, CH)
    RG_PREFETCH(cbeg)
#pragma unroll 1
    for (int chunk = cbeg; chunk < cend; ++chunk) {
      const int pbase = chunk * 32;
      {
        float a[8], f[8];
#pragma unroll
        for (int jj = 0; jj < 8; ++jj) a[jj] = bcv[jj];
        unpack8(xr0, f);
#pragma unroll
        for (int jj = 0; jj < 8; ++jj) a[jj] += wcv[0][jj] * f[jj];
        unpack8(xr1, f);
#pragma unroll
        for (int jj = 0; jj < 8; ++jj) a[jj] += wcv[1][jj] * f[jj];
        unpack8(xr2, f);
#pragma unroll
        for (int jj = 0; jj < 8; ++jj) a[jj] += wcv[2][jj] * f[jj];
        unpack8(xr3, f);
#pragma unroll
        for (int jj = 0; jj < 8; ++jj) a[jj] += wcv[3][jj] * f[jj];
        *(float4*)(xc + spos * 64 + sseg * 8) = make_float4(a[0], a[1], a[2], a[3]);
        *(float4*)(xc + spos * 64 + sseg * 8 + 4) = make_float4(a[4], a[5], a[6], a[7]);
        *(uint4*)(xcb + spos * 72 + sseg * 8) = pack8(a);
      }
      __syncthreads();
      if (chunk + 1 < cend) { RG_PREFETCH(chunk + 1) }
      const int Rout = pos2row_seq(b, pbase + spos, dir);
      uint4* yp = (uint4*)(p.HL + (size_t)Rout * 1024 + 512 + sch);
      uint4 prev, gv;
      if (PASS == 1 && dir == 1) { prev = *yp; gv = *(const uint4*)(UB2 + (size_t)Rout * 2048 + 512 + sch); }
      {
        const int r = lane & 31, hh = lane >> 5;
        f32x16 acc;
#pragma unroll
        for (int q = 0; q < 16; ++q) acc[q] = 0.f;
#pragma unroll
        for (int ks = 0; ks < 4; ++ks) {
          bf16x8 A = *(const bf16x8*)(xcb + r * 72 + 16 * ks + 8 * hh);
          bf16x8 B = *(const bf16x8*)(WTl + (32 * wave + r) * 72 + 16 * ks + 8 * hh);
          acc = __builtin_amdgcn_mfma_f32_32x32x16_bf16(A, B, acc, 0, 0, 0);
        }
        float* dstp = (wave < 2) ? pa : pb;
        const int jc = (wave & 1) * 32 + r;
#pragma unroll
        for (int q = 0; q < 16; ++q) dstp[((q & 3) + 8 * (q >> 2) + 4 * hh) * 64 + jc] = acc[q];
      }
      __syncthreads();
#pragma unroll
      for (int i = 0; i < 8; ++i) {
        int e = tid + 256 * i;
        float r = sigmf(pa[e] + g_ba);
        float gi = sigmf(pb[e] + g_bx);
        float la = g_sp * r;
        float a = __expf(la);
        float bt = sqrtf(fmaxf(1.f - a * a, 0.f)) * gi * xc[e];
        pa[e] = a; pb[e] = bt;
      }
      __syncthreads();
      if (tid < 64) {
        float hh = hcarry;
#pragma unroll 8
        for (int pos = 0; pos < 32; ++pos) { float av = pa[pos * 64 + tid]; hh = av * hh + pb[pos * 64 + tid]; pb[pos * 64 + tid] = hh; aprod *= av; }
        hcarry = hh;
      }
      __syncthreads();
      if (PASS == 1) {
        float hv[8];
#pragma unroll
        for (int jj = 0; jj < 8; ++jj) hv[jj] = pb[spos * 64 + sseg * 8 + jj];
        if (dir == 1) {
          float f[8]; unpack8(prev, f);
          float gf[8]; unpack8(gv, gf);
#pragma unroll
          for (int jj = 0; jj < 8; ++jj) hv[jj] = (hv[jj] + f[jj]) * gf[jj];
        }
        *yp = pack8(hv);
      }
    }
    if (PASS == 0 && tid < 64) {
      float* sp = p.SUM + ((((size_t)b * 2 + dir) * 17 + sbd) * 512 + head * 64 + tid) * 2;
      sp[0] = aprod; sp[1] = hcarry;
    }
    __syncthreads();
  }
}

typedef bf16x8 __attribute__((aligned(2))) bf16x8_u;
typedef uint4 __attribute__((aligned(4))) uint4_a4;
__device__ __forceinline__ bf16x8 ld_win8(const u16* base, int y, uint32_t sh) {
  const uint32_t* wp = (const uint32_t*)base + (y >> 1);
  uint4 w = *(const uint4_a4*)wp;
  uint32_t w4 = wp[4];
  FragU f;
  f.u[0] = __builtin_amdgcn_alignbit(w.y, w.x, sh);
  f.u[1] = __builtin_amdgcn_alignbit(w.z, w.y, sh);
  f.u[2] = __builtin_amdgcn_alignbit(w.w, w.z, sh);
  f.u[3] = __builtin_amdgcn_alignbit(w4, w.w, sh);
  return f.v;
}

__device__ __forceinline__ void hy_conv3x8(const u16* col, int t8, int n, float w0, float w1, float w2, float bias, float* out) {
  float f[8]; unpack8(*(const uint4*)(col + t8), f);
  float prev = (t8 > 0) ? bf2f(col[t8 - 1]) : 0.f;
  float next = (t8 + 8 < n) ? bf2f(col[t8 + 8]) : 0.f;
#pragma unroll
  for (int j = 0; j < 8; ++j) {
    float a = (j == 0) ? prev : f[j - 1];
    float cnx = (j == 7) ? next : f[j + 1];
    out[j] = bias + w0 * a + w1 * f[j] + w2 * cnx;
  }
}

#define ZB 5128
#define ZJ 80
#define ZI(B, T) ((B) * ZB + ((T) >> 6) * ZJ + ((T) & 63))
__device__ __forceinline__ void hy_task(const P& p, int l, int c, float* sm) {
  int tid = threadIdx.x; asm volatile("" : "+v"(tid)); const int wave = tid >> 6, lane = tid & 63;
  const int r = lane & 31, h = lane >> 5;
  u16* krr = (u16*)sm;
  u16* zs = krr + 8192 + 64;
  float* red = (float*)(zs + 4 * ZB);
  const u16* UT = p.U;
  const float* cwp = p.hy_conv_w + (size_t)l * 3 * 1536;
  const float* cbp = p.hy_conv_b + (size_t)l * 1536;
  for (int o = 0; o < 2; ++o) {
    const u16* K = p.KF + (size_t)(o * 512 + c) * 8192;
    float asum = 0.f;
#pragma unroll
    for (int i = 0; i < 4; ++i) {
      int idx = (tid + 256 * i) * 8;
      uint4 v = *(const uint4*)(K + idx);
      *(uint4*)(krr + idx) = v;
      float f[8]; unpack8(v, f);
#pragma unroll
      for (int j = 0; j < 8; ++j) asum += fabsf(f[j]);
    }
    asum = wave_sum(asum);
    if (lane == 0) red[wave] = asum;
    if (o == 0) {
      const float w0 = cwp[c], w1 = cwp[1536 + c], w2 = cwp[3072 + c], bs = cbp[c];
#pragma unroll 2
      for (int e = tid; e < 2048; e += 256) {
        int b = e >> 9, t8 = (e & 511) * 8;
        float f[8];
        hy_conv3x8(UT + (size_t)c * NTOK + b * 4096, t8, 4096, w0, w1, w2, bs, f);
        *(uint4*)(zs + ZI(b, t8)) = pack8(f);
      }
    }
    __syncthreads();
    const float scale = 1.f / (red[0] + red[1] + red[2] + red[3] + 1e-6f);
    const float skip = p.hy_skip[(l * 2 + o) * 512 + c];
    f32x16 acc[2][2];
#pragma unroll
    for (int a = 0; a < 2; ++a)
#pragma unroll
      for (int b = 0; b < 2; ++b)
#pragma unroll
        for (int q = 0; q < 16; ++q) acc[a][b][q] = 0.f;
    const int I0 = wave * 16;
    const int Il0 = I0 + (r >> 2), Il1 = I0 + 8 + (r >> 2);
    const u16* zb = zs + (r & 3) * ZB + 8 * h;
    const int ybase = 4096 - r + 8 * h + 48;
    bf16x8 F0, F1, F2, F3, F4, F5;
    const uint32_t ysh = (uint32_t)((ybase & 1) * 16);
    {
      const int y0 = ybase - 64 * (I0 - 63);
      F0 = ld_win8(krr, y0, ysh); F1 = ld_win8(krr, y0 - 16, ysh); F2 = ld_win8(krr, y0 - 32, ysh);
      F3 = ld_win8(krr, y0 - 48, ysh); F4 = ld_win8(krr, y0 - 64, ysh); F5 = ld_win8(krr, y0 - 80, ysh);
    }
#pragma unroll 1
    for (int D = I0 - 63; D <= I0 + 15; ++D) {
      bf16x8 B0[4], B1[4];
      {
        int J0 = Il0 - D, J1 = Il1 - D;
        bool ok0 = (unsigned)J0 < 64u, ok1 = (unsigned)J1 < 64u;
        const u16* zp0 = zb + ZJ * J0; const u16* zp1 = zb + ZJ * J1;
#pragma unroll
        for (int ks = 0; ks < 4; ++ks) {
          bf16x8 z0 = {0, 0, 0, 0, 0, 0, 0, 0}, z1 = {0, 0, 0, 0, 0, 0, 0, 0};
          if (ok0) z0 = *(const bf16x8*)(zp0 + 16 * ks);
          if (ok1) z1 = *(const bf16x8*)(zp1 + 16 * ks);
          B0[ks] = z0; B1[ks] = z1;
        }
      }
      acc[0][0] = __builtin_amdgcn_mfma_f32_32x32x16_bf16(F3, B0[0], acc[0][0], 0, 0, 0);
      acc[0][1] = __builtin_amdgcn_mfma_f32_32x32x16_bf16(F3, B1[0], acc[0][1], 0, 0, 0);
      acc[1][0] = __builtin_amdgcn_mfma_f32_32x32x16_bf16(F5, B0[0], acc[1][0], 0, 0, 0);
      acc[1][1] = __builtin_amdgcn_mfma_f32_32x32x16_bf16(F5, B1[0], acc[1][1], 0, 0, 0);
      acc[0][0] = __builtin_amdgcn_mfma_f32_32x32x16_bf16(F2, B0[1], acc[0][0], 0, 0, 0);
      acc[0][1] = __builtin_amdgcn_mfma_f32_32x32x16_bf16(F2, B1[1], acc[0][1], 0, 0, 0);
      acc[1][0] = __builtin_amdgcn_mfma_f32_32x32x16_bf16(F4, B0[1], acc[1][0], 0, 0, 0);
      acc[1][1] = __builtin_amdgcn_mfma_f32_32x32x16_bf16(F4, B1[1], acc[1][1], 0, 0, 0);
      acc[0][0] = __builtin_amdgcn_mfma_f32_32x32x16_bf16(F1, B0[2], acc[0][0], 0, 0, 0);
      acc[0][1] = __builtin_amdgcn_mfma_f32_32x32x16_bf16(F1, B1[2], acc[0][1], 0, 0, 0);
      acc[1][0] = __builtin_amdgcn_mfma_f32_32x32x16_bf16(F3, B0[2], acc[1][0], 0, 0, 0);
      acc[1][1] = __builtin_amdgcn_mfma_f32_32x32x16_bf16(F3, B1[2], acc[1][1], 0, 0, 0);
      acc[0][0] = __builtin_amdgcn_mfma_f32_32x32x16_bf16(F0, B0[3], acc[0][0], 0, 0, 0);
      acc[0][1] = __builtin_amdgcn_mfma_f32_32x32x16_bf16(F0, B1[3], acc[0][1], 0, 0, 0);
      acc[1][0] = __builtin_amdgcn_mfma_f32_32x32x16_bf16(F2, B0[3], acc[1][0], 0, 0, 0);
      acc[1][1] = __builtin_amdgcn_mfma_f32_32x32x16_bf16(F2, B1[3], acc[1][1], 0, 0, 0);
      F0 = F4; F1 = F5;
      if (D < I0 + 15) {
        const int y1 = ybase - 64 * (D + 1);
        F2 = ld_win8(krr, y1 - 32, ysh); F3 = ld_win8(krr, y1 - 48, ysh);
        F4 = ld_win8(krr, y1 - 64, ysh); F5 = ld_win8(krr, y1 - 80, ysh);
      }
    }
    __syncthreads();
#pragma unroll
    for (int ni = 0; ni < 2; ++ni) {
      u16* zc = zs + (r & 3) * ZB + ZJ * (ni ? Il1 : Il0);
#pragma unroll
      for (int mi = 0; mi < 2; ++mi)
#pragma unroll
        for (int q = 0; q < 16; ++q) {
          int i = 32 * mi + (q & 3) + 8 * (q >> 2) + 4 * h;
          float zo = bf2f(zc[i]);
          zc[i] = f2bf(scale * acc[mi][ni][q] + skip * zo);
        }
    }
    __syncthreads();
    {
      const int ch = (o + 1) * 512 + c;
      const float w0 = cwp[ch], w1 = cwp[1536 + ch], w2 = cwp[3072 + ch], bs = cbp[ch];
#pragma unroll 2
      for (int e = tid; e < 2048; e += 256) {
        int b = e >> 9, t8 = (e & 511) * 8;
        float xg[8], y[8];
        hy_conv3x8(UT + (size_t)ch * NTOK + b * 4096, t8, 4096, w0, w1, w2, bs, xg);
        unpack8(*(const uint4*)(zs + ZI(b, t8)), y);
#pragma unroll
        for (int j = 0; j < 8; ++j) y[j] *= xg[j];
        if (o == 0) *(uint4*)(zs + ZI(b, t8)) = pack8(y);
        else {
          float gf[8]; unpack8(*(const uint4*)(UT + (size_t)(1536 + c) * NTOK + b * 4096 + t8), gf);
#pragma unroll
          for (int j = 0; j < 8; ++j) y[j] *= gf[j];
          *(uint4*)(p.U + (size_t)c * NTOK + b * 4096 + t8) = pack8(y);
        }
      }
    }
    __syncthreads();
  }
  if (l == 0) {
    const int t = tid;
    for (int o = 0; o < 2; ++o) {
      const u16* K = p.KFC + (size_t)(o * 512 + c) * 512;
      float asum = 0.f;
      {
        uint32_t w2 = *(const uint32_t*)(K + tid * 2);
        *(uint32_t*)(krr + tid * 2) = w2;
        asum = fabsf(bflo(w2)) + fabsf(bfhi(w2));
      }
      asum = wave_sum(asum);
      if (lane == 0) red[wave] = asum;
      if (o == 0) {
        const float w0 = cwp[c], w1 = cwp[1536 + c], w2 = cwp[3072 + c], bs = cbp[c];
        if (tid < 128) {
          int b = tid >> 5, t8 = (tid & 31) * 8;
          float f[8];
          hy_conv3x8(UT + (size_t)c * NTOK + NLAT + b * 256, t8, 256, w0, w1, w2, bs, f);
          *(uint4*)(zs + ZI(b, t8)) = pack8(f);
        }
      }
      __syncthreads();
      const float scale = 1.f / (red[0] + red[1] + red[2] + red[3] + 1e-6f);
      float a0 = 0, a1 = 0, a2 = 0, a3 = 0;
      for (int s2 = 0; s2 < 256; ++s2) {
        float kv = bf2f(krr[256 - t + s2]);
        a0 += kv * bf2f(zs[ZI(0, s2)]); a1 += kv * bf2f(zs[ZI(1, s2)]); a2 += kv * bf2f(zs[ZI(2, s2)]); a3 += kv * bf2f(zs[ZI(3, s2)]);
      }
      const float skip = p.hy_skip[(l * 2 + o) * 512 + c];
      float y[4];
      y[0] = scale * a0 + skip * bf2f(zs[ZI(0, t)]); y[1] = scale * a1 + skip * bf2f(zs[ZI(1, t)]);
      y[2] = scale * a2 + skip * bf2f(zs[ZI(2, t)]); y[3] = scale * a3 + skip * bf2f(zs[ZI(3, t)]);
      __syncthreads();
      {
        const int ch = (o + 1) * 512 + c;
        const float w0 = cwp[ch], w1 = cwp[1536 + ch], w2 = cwp[3072 + ch], bs = cbp[ch];
#pragma unroll
        for (int b = 0; b < 4; ++b) {
          const u16* col = UT + (size_t)ch * NTOK + NLAT + b * 256;
          float xg = bs + w1 * bf2f(col[t]);
          if (t > 0) xg += w0 * bf2f(col[t - 1]);
          if (t < 255) xg += w2 * bf2f(col[t + 1]);
          float zn = xg * y[b];
          if (o == 0) zs[ZI(b, t)] = f2bf(zn);
          else {
            size_t R = (size_t)NLAT + b * 256 + t;
            float gate = bf2f(UT[(size_t)(1536 + c) * NTOK + R]);
            p.U[(size_t)c * NTOK + R] = f2bf(zn * gate);
          }
        }
      }
      __syncthreads();
    }
  }
}

__device__ __forceinline__ void fin_rows(const P& p, int l, int chunk) {
  int tid = threadIdx.x; asm volatile("" : "+v"(tid)); const int wave = tid >> 6, lane = tid & 63;
  for (int rr = 0; rr < 16; ++rr) {
    int R = chunk * 64 + wave * 16 + rr;
    {
      uint4* yp = (uint4*)(p.Y2 + (size_t)R * 1024 + lane * 8);
      float o[8]; unpack8(*yp, o);
      float ss = 0;
#pragma unroll
      for (int j = 0; j < 8; ++j) ss += o[j] * o[j];
      ss += __shfl_xor(ss, 1); ss += __shfl_xor(ss, 2); ss += __shfl_xor(ss, 4); ss += __shfl_xor(ss, 8);
      float rinv = rsqrtf(ss * (1.f / 128.f) + EPS);
      float gf[8]; unpack8(*(const uint4*)(p.U + (size_t)NTOK * 2048 + (size_t)R * 2048 + 1024 + lane * 8), gf);
#pragma unroll
      for (int j = 0; j < 8; ++j) o[j] = o[j] * rinv * p.hg_norm_w[l * 512 + lane * 8 + j] * gf[j];
      *yp = pack8(o);
    }
    {
      uint4* yp = (uint4*)(p.Y2 + (size_t)R * 1024 + 512 + lane * 8);
      float o[8]; unpack8(*yp, o);
      float gf[8]; unpack8(*(const uint4*)(p.U + (size_t)NTOK * 2048 + (size_t)R * 2048 + 1536 + lane * 8), gf);
      float ss = 0;
#pragma unroll
      for (int j = 0; j < 8; ++j) { o[j] *= gf[j]; ss += o[j] * o[j]; }
      ss += __shfl_xor(ss, 1); ss += __shfl_xor(ss, 2); ss += __shfl_xor(ss, 4); ss += __shfl_xor(ss, 8); ss += __shfl_xor(ss, 16);
      float rinv = rsqrtf(ss * (1.f / 256.f) + EPS);
#pragma unroll
      for (int j = 0; j < 8; ++j) o[j] = o[j] * rinv * p.m2_norm_w[l * 512 + lane * 8 + j];
      *yp = pack8(o);
    }
  }
}

__device__ __forceinline__ void ph_mixB(const P& p, int l, int bid, int nb, float* sm) {
  for (int t = bid; t < 512 + 512; t += nb) {
    if (t < 512) { if (EN_RG) rg_task<0>(p, l, t, sm); }
    else { if (EN_HY) hy_task(p, l, t - 512, sm); }
    __syncthreads();
  }
}
__device__ __forceinline__ void hy_transpose(const P& p, int tile, u16* sm) {
  int tid = threadIdx.x; asm volatile("" : "+v"(tid));
  const int ct = tile & 7, rt = tile >> 3;
  const int c0 = ct * 64, R0 = rt * 64;
#pragma unroll
  for (int i = 0; i < 2; ++i) {
    int q = tid + 256 * i; int cc = q >> 3, seg = q & 7;
    *(uint4*)(sm + cc * 72 + seg * 8) = *(const uint4*)(p.U + (size_t)(c0 + cc) * NTOK + R0 + seg * 8);
  }
  __syncthreads();
#pragma unroll
  for (int i = 0; i < 2; ++i) {
    int q = tid + 256 * i; int rr = q >> 3, seg = q & 7;
    FragU f;
#pragma unroll
    for (int j = 0; j < 4; ++j)
      f.u[j] = (uint32_t)sm[(seg * 8 + 2 * j) * 72 + rr] | ((uint32_t)sm[(seg * 8 + 2 * j + 1) * 72 + rr] << 16);
    *(uint4*)(p.HL + (size_t)(R0 + rr) * 1024 + c0 + seg * 8) = f.q;
  }
}
__device__ __forceinline__ void ph_mixB2(const P& p, int l, int bid, int nb, float* sm) {
  const int nfin = (l == 0 ? NTOK : NLAT) / 64;
  const int ntr = nfin * 8;
  for (int t = bid; t < 512 + nfin + ntr; t += nb) {
    if (t < 512) { if (EN_RG) rg_task<1>(p, l, t, sm); }
    else if (t < 512 + nfin) fin_rows(p, l, t - 512);
    else hy_transpose(p, t - 512 - nfin, (u16*)sm);
    __syncthreads();
  }
}
__device__ __forceinline__ void ph_final(const P& p, int bid, int nb) {
  int tid = threadIdx.x; asm volatile("" : "+v"(tid)); const int wave = tid >> 6, lane = tid & 63;
  for (int R = bid * 4 + wave; R < NLAT; R += nb * 4) {
    float4* rp = (float4*)(p.out + (size_t)R * 1024);
    float4 v[4]; float ss = 0;
#pragma unroll
    for (int i = 0; i < 4; ++i) {
      v[i] = rp[lane + i * 64];
      ss += v[i].x * v[i].x + v[i].y * v[i].y + v[i].z * v[i].z + v[i].w * v[i].w;
    }
    ss = wave_sum(ss);
    float rinv = rsqrtf(ss * (1.f / 1024.f) + EPS);
#pragma unroll
    for (int i = 0; i < 4; ++i) {
      float4 w = *(const float4*)(p.final_norm_w + (lane + i * 64) * 4);
      float4 o; o.x = v[i].x * rinv * w.x; o.y = v[i].y * rinv * w.y; o.z = v[i].z * rinv * w.z; o.w = v[i].w * rinv * w.w;
      rp[lane + i * 64] = o;
    }
  }
}

#define XB_TMO      128
#define XB_XCNT(j)  (256  + 64 * (j))
#define XB_XSUB(j)  (1280 + 64 * (j))
#define XB_XGEN(j)  (2304 + 64 * (j))
#define XB_TOP      3328
#define XB_TOPGEN   3392
#define XCD_BAR_WORDS 3456
#define XB_SPIN_CAP (1u << 18)
#define LAS __attribute__((address_space(3)))

__device__ __forceinline__ unsigned xb_ld(unsigned* p)              { return __hip_atomic_load(p, __ATOMIC_RELAXED, __HIP_MEMORY_SCOPE_AGENT); }
__device__ __forceinline__ unsigned xb_add(unsigned* p, unsigned v) { return __hip_atomic_fetch_add(p, v, __ATOMIC_RELAXED, __HIP_MEMORY_SCOPE_AGENT); }
__device__ __forceinline__ unsigned xb_xcc_id() { return (unsigned)__builtin_amdgcn_s_getreg((3 << 11) | 20) & 0xFu; }
#define XB_SPIN(cond, bar) do { unsigned _sp = 0; while (cond) { __builtin_amdgcn_s_sleep(1); \
    if ((++_sp & 255u) == 0u) { if (xb_ld(&(bar)[XB_TMO])) break; if (_sp > XB_SPIN_CAP) { atomicAdd(&(bar)[XB_TMO], 1u); break; } } } } while (0)

struct XcdBarrier {
    unsigned* bar; unsigned x;
    volatile LAS unsigned* st;
};

__device__ __forceinline__ XcdBarrier xcd_barrier_post(unsigned* bar, volatile LAS unsigned* st) {
    XcdBarrier b; b.bar = bar; b.x = xb_xcc_id(); b.st = st;
    if (threadIdx.x == 0) (void)xb_add(&bar[XB_XCNT(b.x)], 1u);
    return b;
}
__device__ __forceinline__ void xcd_barrier_complete(unsigned* bar, unsigned x, unsigned& nloc, unsigned& nx) {
    const unsigned G = gridDim.x * gridDim.y * gridDim.z;
    unsigned sum, cnt, mine, sp = 0u;
    for (;;) {
        sum = 0u; cnt = 0u; mine = 0u;
#pragma unroll
        for (unsigned j = 0; j < 16; ++j) { const unsigned c = xb_ld(&bar[XB_XCNT(j)]); sum += c; cnt += (c > 0u) ? 1u : 0u; mine = (j == x) ? c : mine; }
        if (sum == G) break;
        __builtin_amdgcn_s_sleep(1);
        if ((++sp & 255u) == 0u) { if (xb_ld(&bar[XB_TMO])) break; if (sp > XB_SPIN_CAP) { atomicAdd(&bar[XB_TMO], 1u); break; } }
    }
    nloc = mine > 0u ? mine : 1u; nx = cnt > 0u ? cnt : 1u;
}

__device__ __forceinline__ void xcd_barrier(const XcdBarrier& b) {
    asm volatile("s_waitcnt vmcnt(0)" ::: "memory");
    __syncthreads();
    if (threadIdx.x == 0) {
        unsigned* bar = b.bar;
        __builtin_amdgcn_s_waitcnt(0);
        unsigned nloc = b.st[0], nx = b.st[1];
        if (nloc == 0u) { xcd_barrier_complete(bar, b.x, nloc, nx); b.st[0] = nloc; b.st[1] = nx; }
        const unsigned old = xb_add(&bar[XB_XSUB(b.x)], 1u);
        const unsigned gen = old / nloc;
        if (old + 1u == (gen + 1u) * nloc) {
            __builtin_amdgcn_fence(__ATOMIC_RELEASE, "agent");
            asm volatile("s_waitcnt vmcnt(0)" ::: "memory");
            const unsigned og = xb_add(&bar[XB_TOP], 1u);
            const unsigned tg = og / nx;
            if (og + 1u == (tg + 1u) * nx) xb_add(&bar[XB_TOPGEN], 1u);
            else XB_SPIN(xb_ld(&bar[XB_TOPGEN]) == tg, bar);
            __builtin_amdgcn_fence(__ATOMIC_ACQUIRE, "agent");
            xb_add(&bar[XB_XGEN(b.x)], 1u);
            asm volatile("s_waitcnt vmcnt(0)" ::: "memory");
        } else {
            XB_SPIN(xb_ld(&bar[XB_XGEN(b.x)]) == gen, bar);
            __builtin_amdgcn_fence(__ATOMIC_ACQUIRE, "agent");
            asm volatile("s_waitcnt vmcnt(0)" ::: "memory");
        }
    }
    __syncthreads();
}


__device__ __forceinline__ void gbar(unsigned* cnt, unsigned target) {
  asm volatile("s_waitcnt vmcnt(0)" ::: "memory");
  __syncthreads();
  if (threadIdx.x == 0) {
    __builtin_amdgcn_fence(__ATOMIC_RELEASE, "agent");
    asm volatile("s_waitcnt vmcnt(0)" ::: "memory");
    (void)__hip_atomic_fetch_add(cnt, 1u, __ATOMIC_RELAXED, __HIP_MEMORY_SCOPE_AGENT);
    unsigned sp = 0;
    while (__hip_atomic_load(cnt, __ATOMIC_RELAXED, __HIP_MEMORY_SCOPE_AGENT) < target) {
      __builtin_amdgcn_s_sleep(1);
      if (++sp > (1u << 22)) break;
    }
    __builtin_amdgcn_fence(__ATOMIC_ACQUIRE, "agent");
    asm volatile("s_waitcnt vmcnt(0)" ::: "memory");
  }
  __syncthreads();
}

#define SMEM_BYTES 57600
__global__ void __launch_bounds__(256, 2) mega(P p) {
  __shared__ __align__(16) unsigned char smem[SMEM_BYTES];
  cg::grid_group grid = cg::this_grid();
  __shared__ uint4 xb_words;
  if (threadIdx.x == 0) xb_words = make_uint4(0u, 0u, 0u, 0u);
  __syncthreads();
  XcdBarrier xbar = xcd_barrier_post(p.BAR, (volatile LAS unsigned*)&xb_words);
  const int bid = blockIdx.x, nb = gridDim.x;
  float* smf = (float*)smem; u16* smh = (u16*)smem;
#ifndef PHM
#define PHM 0xffff
#endif
  if (PHM & 1) ph_mod(p, bid, nb, smf);
  grid.sync();
  unsigned nbar = 0;
  for (int l = 0; l < 2; ++l) {
    if (PHM & 2) ph_norm(p, l, bid, nb);
    if (PHM & 4) ph_wconv(p, l, bid, nb, smf, l == 0 ? 0 : 114 * 16, 114 * 16 + 16 * 32);
    xcd_barrier(xbar);
    if (PHM & 16) ph_gemm<0>(p, l, bid, nb, smh);
    xcd_barrier(xbar);
#if PROBE_DUP == 3
    ph_gemm<0>(p, l, bid, nb, smh);
    xcd_barrier(xbar);
#endif
#if PROBE_DUP == 10
    ph_norm(p, l, bid, nb);
    ph_wconv(p, l, bid, nb, smf);
    xcd_barrier(xbar);
#endif
    if (PHM & 32) ph_mixA0(p, l, bid, nb, smem);
    xcd_barrier(xbar);
    if (PHM & 32) ph_mixA1(p, l, bid, nb, smem);
    xcd_barrier(xbar);
#if PROBE_DUP == 8
    ph_mixA0(p, l, bid, nb, smem);
    xcd_barrier(xbar);
    ph_mixA1(p, l, bid, nb, smem);
    xcd_barrier(xbar);
#endif
    if (PHM & 64) ph_gemm<1>(p, l, bid, nb, smh);
    if (PHM & 8) ph_filt(p, l, bid, nb, smf);
    xcd_barrier(xbar);
#if PROBE_DUP == 2
    ph_mixB(p, l, bid, nb, smf);
    xcd_barrier(xbar);
#endif
#if PROBE_DUP == 4
    ph_gemm<1>(p, l, bid, nb, smh);
    xcd_barrier(xbar);
#endif
#if PROBE_DUP == 9
    ph_gemm<1>(p, l, bid, nb, smh, 1);
    xcd_barrier(xbar);
#endif
    if (PHM & 128) ph_mixB(p, l, bid, nb, smf);
    xcd_barrier(xbar);
    if (PHM & 128) ph_mixB2(p, l, bid, nb, smf);
    xcd_barrier(xbar);
#if PROBE_DUP == 7
    for (int t = bid; t < 512; t += nb) { rg_task<1>(p, l, t, smf); __syncthreads(); }
    xcd_barrier(xbar);
#endif
    if (PHM & 256) ph_gemm<2>(p, l, bid, nb, smh);
    if ((PHM & 4) && l == 0) ph_wconv(p, 1, bid, nb, smf, 0, 114 * 16);
    xcd_barrier(xbar);
  }
  if (PHM & 512) ph_final(p, bid, nb);
}

extern "C" void kernel_launch(void* const* d_in, const int* in_sizes, int n_in, void* d_out, int out_size,
                              void* d_ws, size_t ws_size, hipStream_t stream) {
  static int grid_blocks = 0;
  if (!grid_blocks) {
    int dev = 0, cus = 0, per_cu = 0;
    hipGetDevice(&dev);
    hipDeviceGetAttribute(&cus, hipDeviceAttributeMultiprocessorCount, dev);
    hipOccupancyMaxActiveBlocksPerMultiprocessor(&per_cu, mega, 256, 0);
    if (per_cu < 1) per_cu = 1;
    if (per_cu > 2) per_cu = 2;
    grid_blocks = cus * per_cu;
  }
  P p{};
  const float** fp = (const float**)&p;
  for (int i = 0; i < 34; ++i) fp[i] = (const float*)d_in[i];
  p.out = (float*)d_out;
  char* w = (char*)d_ws;
  size_t off = 0;
  auto take = [&](size_t bytes) { char* r = w + off; off += (bytes + 255) & ~(size_t)255; return r; };
  p.U = (u16*)take((size_t)NTOK * UW * 2);
  p.HL = (u16*)take((size_t)NTOK * 1024 * 2);
  p.Y2 = (u16*)take((size_t)NTOK * 1024 * 2);
  p.WT = (u16*)take((size_t)7296 * 1024 * 2);
  p.WoT = (u16*)take((size_t)1024 * 2048 * 2);
  p.KF = (u16*)take((size_t)1024 * 8192 * 2);
  p.DT = (float*)take((size_t)NTOK * 8 * 4);
  p.MOD = (float*)take((size_t)2 * 5 * 3072 * 4);
  p.SUM = (float*)take((size_t)4 * 2 * 17 * 512 * 2 * 4);
  {
    char* Z = take((size_t)16777216);
    p.SSH = (float*)Z; p.XC = (float*)(Z + 8388608); p.KFC = (u16*)(Z + 12582912);
  }
  p.PS = (float*)take((size_t)16 * 2 * 8 * 128 * 4);
  p.PA = (float*)take((size_t)16 * 2 * 8 * 4 * 4);
  p.BAR = (unsigned*)take((size_t)XCD_BAR_WORDS * 4);
  if (off > ws_size) { fprintf(stderr, "workspace too small: need %zu have %zu\n", off, ws_size); return; }
  (void)hipMemsetAsync(p.BAR, 0, (size_t)XCD_BAR_WORDS * 4, stream);
  void* args[] = {&p};
  hipError_t e = hipLaunchCooperativeKernel((void*)mega, dim3(grid_blocks), dim3(256), args, 0, stream);
  if (e != hipSuccess) fprintf(stderr, "cooperative launch failed: %s (grid %d)\n", hipGetErrorString(e), grid_blocks);
}
```
